# Optimizing an MI355X kernel written in HIP

```python
import math
import jax, jax.numpy as jnp
from jax import lax
import numpy as np

D_MODEL = 1024
BATCH = 8
SEQ = 4096
DEPTH = 1

HEAD_DIM = 64
MIX_WIDTH = D_MODEL
N_HEADS = MIX_WIDTH // HEAD_DIM
N_HEADS_B = N_HEADS // 4
N_HEADS_A = N_HEADS - N_HEADS_B
WIDTH_A = N_HEADS_A * HEAD_DIM
WIDTH_B = N_HEADS_B * HEAD_DIM
DILATED_PATTERNS = ((128, 1), (512, 4), (2048, 16))
DIL_BLOCK = 128
MOBA_BLOCK = 256
MOBA_TOPK = 3
MOBA_QCHUNK = 64
N_MEM = 256
CROSS_HEADS = 4
CROSS_HEAD_DIM = D_MODEL // CROSS_HEADS
D_FF = ((8 * D_MODEL // 3 + 255) // 256) * 256
REL_BUCKETS = 32
REL_MAX_DIST = 2048
NORM_EPS = 1e-6
NEG_INF = -jnp.inf

kernel_name = "hymba_style_dilated_moba_macaron_block"


def rms_norm(x, g):
    xf = x.astype(jnp.float32)
    y = xf * lax.rsqrt(jnp.mean(xf * xf, axis=-1, keepdims=True) + NORM_EPS)
    return (y * g.astype(jnp.float32)).astype(x.dtype)


def swiglu(x, w_gu, w_down):
    gu = x @ w_gu
    g, u = jnp.split(gu, 2, axis=-1)
    return (jax.nn.silu(g) * u) @ w_down


def rel_bucket(dist):
    max_exact = REL_BUCKETS // 2
    n = jnp.maximum(dist, 0)
    nf = jnp.maximum(n, 1).astype(jnp.float32)
    large = max_exact + (jnp.log(nf / max_exact) / math.log(REL_MAX_DIST / max_exact)
                         * (REL_BUCKETS - max_exact)).astype(jnp.int32)
    large = jnp.minimum(large, REL_BUCKETS - 1)
    return jnp.where(n < max_exact, n, large)


def split_heads(a, n_heads, head_dim):
    b, s, _ = a.shape
    return a.reshape(b, s, n_heads, head_dim).transpose(0, 2, 1, 3)


def merge_heads(a):
    b, h, s, e = a.shape
    return a.transpose(0, 2, 1, 3).reshape(b, s, h * e)


def dilated_window_pattern(q, k, v, bias_tab, window, dilation):
    B, H, S, E = q.shape
    n_steps = window // dilation
    L = S // dilation
    nblk = -(-L // DIL_BLOCK)
    Lp = nblk * DIL_BLOCK

    def to_sub(a):
        a = a.reshape(B, H, L, dilation, E).transpose(0, 1, 3, 2, 4)
        a = jnp.pad(a, ((0, 0), (0, 0), (0, 0), (0, Lp - L), (0, 0)))
        return a.reshape(B, H, dilation, nblk, DIL_BLOCK, E)

    def band(a):
        prev = jnp.pad(a, ((0, 0), (0, 0), (0, 0), (1, 0), (0, 0), (0, 0)))[:, :, :, :-1]
        return jnp.concatenate([prev, a], axis=4)

    qs, ks, vs = to_sub(q), to_sub(k), to_sub(v)
    kb, vb = band(ks), band(vs)
    scale = HEAD_DIM ** -0.5
    s = jnp.einsum('bhrnqe,bhrnke->bhrnqk', qs, kb).astype(jnp.float32) * scale
    i = jnp.arange(DIL_BLOCK)[:, None]
    j = jnp.arange(2 * DIL_BLOCK)[None, :]
    delta = DIL_BLOCK + i - j
    bias = bias_tab[:, rel_bucket(delta * dilation)].astype(jnp.float32)
    blk = jnp.arange(nblk)[:, None, None]
    valid = (delta >= 0) & (delta <= n_steps) & ((blk > 0) | (j >= DIL_BLOCK))
    s = jnp.where(valid, s + bias[None, :, None, None], NEG_INF)
    m = jnp.max(s, axis=-1, keepdims=True)
    p = jnp.exp(s - m)
    l = jnp.sum(p, axis=-1, keepdims=True)
    o = jnp.einsum('bhrnqk,bhrnke->bhrnqe', p, vb.astype(jnp.float32)) / l

    def from_sub(a):
        f = a.shape[-1]
        a = a.reshape(B, H, dilation, Lp, f)[:, :, :, :L]
        return a.transpose(0, 1, 3, 2, 4).reshape(B, H, S, f)

    return from_sub(o), from_sub(m), from_sub(l)


def dilated_attention(q, k, v, bias_tab):
    outs = [dilated_window_pattern(q, k, v, bias_tab, w, d) for (w, d) in DILATED_PATTERNS]
    m_all = outs[0][1]
    for _, m_i, _ in outs[1:]:
        m_all = jnp.maximum(m_all, m_i)
    num = 0.0
    den = 0.0
    for o_i, m_i, l_i in outs:
        w_i = l_i * jnp.exp(m_i - m_all)
        num = num + w_i * o_i
        den = den + w_i
    return num / den


def moba_attention(q, k, v, bias_tab):
    B, H, S, E = q.shape
    BS = MOBA_BLOCK
    nb = -(-S // BS)
    Sp = nb * BS
    pad = lambda a: jnp.pad(a, ((0, 0), (0, 0), (0, Sp - S), (0, 0)))
    qp, kp, vp = pad(q), pad(k), pad(v)
    kb = kp.reshape(B, H, nb, BS, E)
    vb = vp.reshape(B, H, nb, BS, E)
    kmean = jnp.mean(kb.astype(jnp.float32), axis=3)
    gate = jnp.einsum('bhse,bhne->bhsn', qp.astype(jnp.float32), kmean)
    qblk = jnp.arange(Sp) // BS
    past = jnp.arange(nb)[None, :] < qblk[:, None]
    gate = jnp.where(past, gate, NEG_INF)
    top = min(MOBA_TOPK, nb)
    _, sel = lax.top_k(gate, top)
    nc = Sp // MOBA_QCHUNK
    chunk = lambda a: jnp.moveaxis(a.reshape(B, H, nc, MOBA_QCHUNK, *a.shape[3:]), 2, 0)
    gather = jax.vmap(jax.vmap(lambda tab, ix: tab[ix]))
    head_idx = jnp.arange(H)[:, None, None, None]
    scale = HEAD_DIM ** -0.5

    def one_chunk(args):
        qc, selc, c = args
        t = c * MOBA_QCHUNK + jnp.arange(MOBA_QCHUNK)
        own = (c * MOBA_QCHUNK) // BS
        k_own = lax.dynamic_index_in_dim(kb, own, axis=2, keepdims=False)
        v_own = lax.dynamic_index_in_dim(vb, own, axis=2, keepdims=False)
        k_sel = gather(kb, selc)
        v_sel = gather(vb, selc)
        s_sel = jnp.einsum('bhqe,bhqjke->bhqjk', qc, k_sel).astype(jnp.float32) * scale
        key_pos = selc[..., None] * BS + jnp.arange(BS)
        s_sel = s_sel + bias_tab[head_idx, rel_bucket(t[:, None, None] - key_pos)].astype(jnp.float32)
        sel_valid = jnp.arange(top)[None, :] < (t // BS)[:, None]
        s_sel = jnp.where(sel_valid[:, :, None], s_sel, NEG_INF)
        s_own = jnp.einsum('bhqe,bhke->bhqk', qc, k_own).astype(jnp.float32) * scale
        dist_own = t[:, None] - (own * BS + jnp.arange(BS))[None, :]
        s_own = s_own + bias_tab[:, rel_bucket(dist_own)].astype(jnp.float32)[None]
        s_own = jnp.where(dist_own >= 0, s_own, NEG_INF)
        logits = jnp.concatenate([s_sel.reshape(B, H, MOBA_QCHUNK, top * BS), s_own], axis=-1)
        p = jax.nn.softmax(logits, axis=-1)
        p_sel = p[..., :top * BS].reshape(B, H, MOBA_QCHUNK, top, BS)
        p_own = p[..., top * BS:]
        return (jnp.einsum('bhqjk,bhqjke->bhqe', p_sel, v_sel.astype(jnp.float32))
                + jnp.einsum('bhqk,bhke->bhqe', p_own, v_own.astype(jnp.float32)))

    o = lax.map(one_chunk, (chunk(qp), chunk(sel), jnp.arange(nc)))
    o = jnp.moveaxis(o, 0, 2).reshape(B, H, Sp, E)[:, :, :S]
    return o


def memory_cross_attention(x, mem, g_x, g_mem, w_cq, w_ckv, w_co):
    B, S, _ = x.shape
    h = rms_norm(x, g_x)
    mn = rms_norm(mem, g_mem)
    q = (h @ w_cq).reshape(B, S, CROSS_HEADS, CROSS_HEAD_DIM)
    kv = mn @ w_ckv
    k, v = jnp.split(kv, 2, axis=-1)
    k = k.reshape(B, mem.shape[1], CROSS_HEADS, CROSS_HEAD_DIM)
    v = v.reshape(B, mem.shape[1], CROSS_HEADS, CROSS_HEAD_DIM)
    s = jnp.einsum('bshe,bmhe->bhsm', q, k).astype(jnp.float32) * CROSS_HEAD_DIM ** -0.5
    p = jax.nn.softmax(s, axis=-1)
    o = jnp.einsum('bhsm,bmhe->bshe', p, v.astype(jnp.float32)).reshape(B, S, D_MODEL)
    return o.astype(x.dtype) @ w_co


def setup_inputs(seed: int = 0) -> dict:
    key = jax.random.key(seed)
    ks = jax.random.split(key, 24)
    f32 = jnp.float32

    def w(k, shape, fan_in):
        return jax.random.normal(k, shape, f32) * fan_in ** -0.5

    def gain(k, shape):
        return 1.0 + 0.05 * jax.random.normal(k, shape, f32)

    L = DEPTH
    return {
        "x": jax.random.normal(ks[0], (BATCH, SEQ, D_MODEL), f32),
        "mem": jax.random.normal(ks[1], (BATCH, N_MEM, D_MODEL), f32),
        "g_ffn1": gain(ks[2], (L, D_MODEL)),
        "w_ffn1_gu": w(ks[3], (L, D_MODEL, 2 * D_FF), D_MODEL),
        "w_ffn1_down": w(ks[4], (L, D_FF, D_MODEL), D_FF),
        "g_mix": gain(ks[5], (L, D_MODEL)),
        "w_in": w(ks[6], (L, D_MODEL, 3 * MIX_WIDTH), D_MODEL),
        "rel_bias": 0.5 * jax.random.normal(ks[7], (REL_BUCKETS, N_HEADS), f32),
        "g_out_a": gain(ks[8], (L, WIDTH_A)),
        "g_out_b": gain(ks[9], (L, WIDTH_B)),
        "w_out": w(ks[10], (L, MIX_WIDTH, D_MODEL), MIX_WIDTH),
        "g_cross": gain(ks[11], (L, D_MODEL)),
        "g_mem": gain(ks[12], (L, D_MODEL)),
        "w_cq": w(ks[13], (L, D_MODEL, D_MODEL), D_MODEL),
        "w_ckv": w(ks[14], (L, D_MODEL, 2 * D_MODEL), D_MODEL),
        "w_co": w(ks[15], (L, D_MODEL, D_MODEL), D_MODEL),
        "g_ffn2": gain(ks[16], (L, D_MODEL)),
        "w_ffn2_gu": w(ks[17], (L, D_MODEL, 2 * D_FF), D_MODEL),
        "w_ffn2_down": w(ks[18], (L, D_FF, D_MODEL), D_FF),
        "g_final": gain(ks[19], (D_MODEL,)),
    }


def reference(x, mem, g_ffn1, w_ffn1_gu, w_ffn1_down, g_mix, w_in, rel_bias, g_out_a, g_out_b,
              w_out, g_cross, g_mem, w_cq, w_ckv, w_co, g_ffn2, w_ffn2_gu, w_ffn2_down, g_final):
    bias_a = rel_bias[:, :N_HEADS_A].T
    bias_b = rel_bias[:, N_HEADS_A:].T
    for layer in range(DEPTH):
        x = x + 0.5 * swiglu(rms_norm(x, g_ffn1[layer]), w_ffn1_gu[layer], w_ffn1_down[layer])
        h = rms_norm(x, g_mix[layer])
        proj = h @ w_in[layer]
        qa, ka, va, qb, kb, vb = jnp.split(
            proj, np.cumsum([WIDTH_A, WIDTH_A, WIDTH_A, WIDTH_B, WIDTH_B]).tolist(), axis=-1)
        oa = dilated_attention(split_heads(qa, N_HEADS_A, HEAD_DIM), split_heads(ka, N_HEADS_A, HEAD_DIM),
                               split_heads(va, N_HEADS_A, HEAD_DIM), bias_a)
        ob = moba_attention(split_heads(qb, N_HEADS_B, HEAD_DIM), split_heads(kb, N_HEADS_B, HEAD_DIM),
                            split_heads(vb, N_HEADS_B, HEAD_DIM), bias_b)
        ya = rms_norm(merge_heads(oa).astype(x.dtype), g_out_a[layer])
        yb = rms_norm(merge_heads(ob).astype(x.dtype), g_out_b[layer])
        x = x + jnp.concatenate([ya, yb], axis=-1) @ w_out[layer]
        x = x + memory_cross_attention(x, mem, g_cross[layer], g_mem[layer], w_cq[layer], w_ckv[layer], w_co[layer])
        x = x + 0.5 * swiglu(rms_norm(x, g_ffn2[layer]), w_ffn2_gu[layer], w_ffn2_down[layer])
    return rms_norm(x, g_final)
```

```cpp
#include <hip/hip_runtime.h>
#include <cstdio>
#include <cstdint>
#include <cmath>

namespace ref {
constexpr int S = 4096, D = 1024, NB = 8, DFF = 2816, NMEM = 256;

__device__ __forceinline__ int rel_bucket(int n) {
    if (n < 16) return n < 0 ? 0 : n;
    int b = 16;
    b += (n >= 22); b += (n >= 30); b += (n >= 40); b += (n >= 54); b += (n >= 73); b += (n >= 99); b += (n >= 134); b += (n >= 182);
    b += (n >= 246); b += (n >= 332); b += (n >= 450); b += (n >= 609); b += (n >= 825); b += (n >= 1117); b += (n >= 1513);
    return b;
}

__global__ void __launch_bounds__(256) rmsnorm(const float* x, const float* g, float* y) {
    __shared__ float red[4];
    const size_t r = blockIdx.x; const int t = threadIdx.x;
    const float4 v = ((const float4*)(x + r * D))[t];
    float s = v.x * v.x + v.y * v.y + v.z * v.z + v.w * v.w;
    for (int o = 32; o > 0; o >>= 1) s += __shfl_xor(s, o);
    if ((t & 63) == 0) red[t >> 6] = s;
    __syncthreads();
    const float tot = red[0] + red[1] + red[2] + red[3];
    const float rs = 1.0f / sqrtf(tot * (1.0f / D) + 1e-6f);
    const float4 gg = ((const float4*)g)[t];
    float4 o; o.x = v.x * rs * gg.x; o.y = v.y * rs * gg.y; o.z = v.z * rs * gg.z; o.w = v.w * rs * gg.w;
    ((float4*)(y + r * D))[t] = o;
}

__global__ void __launch_bounds__(256) swiglu(const float* gu, float* h, int rows) {
    const size_t i = (size_t)blockIdx.x * 256 + threadIdx.x;
    if (i >= (size_t)rows * DFF) return;
    const size_t r = i / DFF; const int c = (int)(i % DFF);
    const float g = gu[r * (2 * DFF) + c], u = gu[r * (2 * DFF) + DFF + c];
    h[i] = g / (1.0f + expf(-g)) * u;
}

template <bool TB>
__global__ void __launch_bounds__(256) gemm(const float* A, int lda, const float* B, int ldb, float* C, int ldc, int K, float alpha, float beta) {
    __shared__ float sA[16][68];
    __shared__ float sB[16][68];
    const int tid = threadIdx.x, tx = tid & 15, ty = tid >> 4;
    const int m0 = blockIdx.y * 64, n0 = blockIdx.x * 64;
    float acc[4][4];
#pragma unroll
    for (int i = 0; i < 4; ++i)
#pragma unroll
        for (int j = 0; j < 4; ++j) acc[i][j] = 0.f;
    for (int k0 = 0; k0 < K; k0 += 16) {
#pragma unroll
        for (int i = 0; i < 4; ++i) {
            const int idx = tid + i * 256;
            { const int r = idx >> 4, c = idx & 15; sA[c][r] = A[(size_t)(m0 + r) * lda + k0 + c]; }
            if (TB) { const int n = idx >> 4, kk = idx & 15; sB[kk][n] = B[(size_t)(n0 + n) * ldb + k0 + kk]; }
            else    { const int kk = idx >> 6, n = idx & 63; sB[kk][n] = B[(size_t)(k0 + kk) * ldb + n0 + n]; }
        }
        __syncthreads();
#pragma unroll
        for (int kk = 0; kk < 16; ++kk) {
            float a[4], b[4];
#pragma unroll
            for (int i = 0; i < 4; ++i) { a[i] = sA[kk][ty * 4 + i]; b[i] = sB[kk][tx * 4 + i]; }
#pragma unroll
            for (int i = 0; i < 4; ++i)
#pragma unroll
                for (int j = 0; j < 4; ++j) acc[i][j] = fmaf(a[i], b[j], acc[i][j]);
        }
        __syncthreads();
    }
#pragma unroll
    for (int i = 0; i < 4; ++i)
#pragma unroll
        for (int j = 0; j < 4; ++j) {
            float* p = C + (size_t)(m0 + ty * 4 + i) * ldc + n0 + tx * 4 + j;
            *p = (beta != 0.f ? beta * *p : 0.f) + alpha * acc[i][j];
        }
}

__global__ void __launch_bounds__(64) dilated(const float* proj, const float* rel_bias, float* oa) {
    const int t = blockIdx.x * 64 + threadIdx.x, h = blockIdx.y;
    float q[64], o[64];
    const float* qp = proj + (size_t)t * 3072 + h * 64;
#pragma unroll
    for (int j = 0; j < 64; ++j) { q[j] = qp[j]; o[j] = 0.f; }
    float m = -INFINITY, l = 0.f;
    for (int p = 0; p < 3; ++p) {
        const int d = p == 0 ? 1 : (p == 1 ? 4 : 16);
        for (int delta = 0; delta <= 128; ++delta) {
            const int kp = t - delta * d;
            if (kp < 0) break;
            const float* kr = proj + (size_t)kp * 3072 + 768 + h * 64;
            const float* vr = proj + (size_t)kp * 3072 + 1536 + h * 64;
            float s = 0.f;
#pragma unroll
            for (int j = 0; j < 64; ++j) s = fmaf(q[j], kr[j], s);
            s = s * 0.125f + rel_bias[rel_bucket(delta * d) * 16 + h];
            const float mn = fmaxf(m, s), a = expf(m - mn), pe = expf(s - mn);
            l = l * a + pe;
#pragma unroll
            for (int j = 0; j < 64; ++j) o[j] = o[j] * a + pe * vr[j];
            m = mn;
        }
    }
    const float il = 1.0f / l;
#pragma unroll
    for (int j = 0; j < 64; ++j) oa[(size_t)t * 768 + h * 64 + j] = o[j] * il;
}

__global__ void __launch_bounds__(64) kmean(const float* proj, float* km) {
    const int n = blockIdx.x, h = blockIdx.y, e = threadIdx.x;
    float s = 0.f;
    for (int r = 0; r < 256; ++r) s += proj[(size_t)(n * 256 + r) * 3072 + 2560 + h * 64 + e];
    km[(h * 16 + n) * 64 + e] = s * (1.0f / 256.0f);
}

__global__ void __launch_bounds__(64) moba(const float* proj, const float* km, const float* rel_bias, float* ob) {
    const int t = blockIdx.x * 64 + threadIdx.x, h = blockIdx.y;
    float q[64], o[64];
    const float* qp = proj + (size_t)t * 3072 + 2304 + h * 64;
#pragma unroll
    for (int j = 0; j < 64; ++j) { q[j] = qp[j]; o[j] = 0.f; }
    const int qb = t >> 8;
    float gate[16];
#pragma unroll
    for (int n = 0; n < 16; ++n) {
        float s = 0.f;
        const float* kr = km + (h * 16 + n) * 64;
#pragma unroll
        for (int j = 0; j < 64; ++j) s = fmaf(q[j], kr[j], s);
        gate[n] = (n < qb) ? s : -INFINITY;
    }
    unsigned selmask = 0u;
    const int nsel = qb < 3 ? qb : 3;
    for (int it = 0; it < 3; ++it) {
        if (it < nsel) {
            float best = -INFINITY; int bi = -1;
#pragma unroll
            for (int n = 0; n < 16; ++n) { const bool free_ = !((selmask >> n) & 1u) && n < qb; if (free_ && (bi < 0 || gate[n] > best)) { best = gate[n]; bi = n; } }
            if (bi >= 0) selmask |= 1u << bi;
        }
    }
    selmask |= 1u << qb;
    float m = -INFINITY, l = 0.f;
    for (int n = 0; n <= qb; ++n) {
        if (!((selmask >> n) & 1u)) continue;
        for (int r = 0; r < 256; ++r) {
            const int kp = n * 256 + r;
            if (kp > t) break;
            const float* kr = proj + (size_t)kp * 3072 + 2560 + h * 64;
            const float* vr = proj + (size_t)kp * 3072 + 2816 + h * 64;
            float s = 0.f;
#pragma unroll
            for (int j = 0; j < 64; ++j) s = fmaf(q[j], kr[j], s);
            s = s * 0.125f + rel_bias[rel_bucket(t - kp) * 16 + 12 + h];
            const float mn = fmaxf(m, s), a = expf(m - mn), pe = expf(s - mn);
            l = l * a + pe;
#pragma unroll
            for (int j = 0; j < 64; ++j) o[j] = o[j] * a + pe * vr[j];
            m = mn;
        }
    }
    const float il = 1.0f / l;
#pragma unroll
    for (int j = 0; j < 64; ++j) ob[(size_t)t * 256 + h * 64 + j] = o[j] * il;
}

__global__ void __launch_bounds__(256) group_norm(const float* oa, const float* ob, const float* ga, const float* gb, float* yn) {
    __shared__ float red[8];
    const size_t r = blockIdx.x; const int t = threadIdx.x;
    const float a0 = oa[r * 768 + t], a1 = oa[r * 768 + 256 + t], a2 = oa[r * 768 + 512 + t], b0 = ob[r * 256 + t];
    float sa = a0 * a0 + a1 * a1 + a2 * a2, sb = b0 * b0;
    for (int o = 32; o > 0; o >>= 1) { sa += __shfl_xor(sa, o); sb += __shfl_xor(sb, o); }
    if ((t & 63) == 0) { red[t >> 6] = sa; red[4 + (t >> 6)] = sb; }
    __syncthreads();
    const float ra = 1.0f / sqrtf((red[0] + red[1] + red[2] + red[3]) * (1.0f / 768.0f) + 1e-6f);
    const float rb = 1.0f / sqrtf((red[4] + red[5] + red[6] + red[7]) * (1.0f / 256.0f) + 1e-6f);
    yn[r * D + t] = a0 * ra * ga[t]; yn[r * D + 256 + t] = a1 * ra * ga[256 + t]; yn[r * D + 512 + t] = a2 * ra * ga[512 + t];
    yn[r * D + 768 + t] = b0 * rb * gb[t];
}

__global__ void __launch_bounds__(256) softmax256(float* Sm, int rows) {
    const int row = blockIdx.x * 4 + (threadIdx.x >> 6), lane = threadIdx.x & 63;
    if (row >= rows) return;
    float4 v = ((float4*)(Sm + (size_t)row * 256))[lane];
    float m = fmaxf(fmaxf(v.x, v.y), fmaxf(v.z, v.w));
    for (int o = 32; o > 0; o >>= 1) m = fmaxf(m, __shfl_xor(m, o));
    v.x = expf(v.x - m); v.y = expf(v.y - m); v.z = expf(v.z - m); v.w = expf(v.w - m);
    float s = v.x + v.y + v.z + v.w;
    for (int o = 32; o > 0; o >>= 1) s += __shfl_xor(s, o);
    const float is = 1.0f / s; v.x *= is; v.y *= is; v.z *= is; v.w *= is;
    ((float4*)(Sm + (size_t)row * 256))[lane] = v;
}

struct Bufs { float *xn, *gu, *hb, *proj, *oa, *ob, *yn, *qc, *kvc, *sc, *oc, *mn, *km; };

static void ffn(float* xc, const float* g, const float* wgu, const float* wd, const Bufs& b, hipStream_t st) {
    rmsnorm<<<S, 256, 0, st>>>(xc, g, b.xn);
    gemm<false><<<dim3(2 * DFF / 64, S / 64), 256, 0, st>>>(b.xn, D, wgu, 2 * DFF, b.gu, 2 * DFF, D, 1.f, 0.f);
    swiglu<<<(S * DFF + 255) / 256, 256, 0, st>>>(b.gu, b.hb, S);
    gemm<false><<<dim3(D / 64, S / 64), 256, 0, st>>>(b.hb, DFF, wd, D, xc, D, DFF, 0.5f, 1.f);
}

static void forward(void* const* d_in, float* out, unsigned char* ws, hipStream_t st) {
    const float* x = (const float*)d_in[0]; const float* mem = (const float*)d_in[1];
    const float *g_ffn1 = (const float*)d_in[2], *w_gu1 = (const float*)d_in[3], *w_d1 = (const float*)d_in[4], *g_mix = (const float*)d_in[5], *w_in = (const float*)d_in[6],
                *rel_bias = (const float*)d_in[7], *g_oa = (const float*)d_in[8], *g_ob = (const float*)d_in[9], *w_out = (const float*)d_in[10], *g_cross = (const float*)d_in[11],
                *g_mem = (const float*)d_in[12], *w_cq = (const float*)d_in[13], *w_ckv = (const float*)d_in[14], *w_co = (const float*)d_in[15], *g_ffn2 = (const float*)d_in[16],
                *w_gu2 = (const float*)d_in[17], *w_d2 = (const float*)d_in[18], *g_final = (const float*)d_in[19];
    Bufs b; size_t off = 0;
    auto take = [&](size_t nfl) { float* p = (float*)(ws + off); off += ((nfl * 4 + 255) / 256) * 256; return p; };
    b.xn = take((size_t)S * D); b.gu = take((size_t)S * 2 * DFF); b.hb = take((size_t)S * DFF); b.proj = take((size_t)S * 3072); b.oa = take((size_t)S * 768); b.ob = take((size_t)S * 256);
    b.yn = take((size_t)S * D); b.qc = take((size_t)S * D); b.kvc = take((size_t)NMEM * 2 * D); b.sc = take((size_t)4 * S * 256); b.oc = take((size_t)S * D); b.mn = take((size_t)NMEM * D); b.km = take(4 * 16 * 64);
    hipMemcpyAsync(out, x, (size_t)NB * S * D * 4, hipMemcpyDeviceToDevice, st);
    for (int bi = 0; bi < NB; ++bi) {
        float* xc = out + (size_t)bi * S * D;
        ffn(xc, g_ffn1, w_gu1, w_d1, b, st);
        rmsnorm<<<S, 256, 0, st>>>(xc, g_mix, b.xn);
        gemm<false><<<dim3(3072 / 64, S / 64), 256, 0, st>>>(b.xn, D, w_in, 3072, b.proj, 3072, D, 1.f, 0.f);
        dilated<<<dim3(S / 64, 12), 64, 0, st>>>(b.proj, rel_bias, b.oa);
        kmean<<<dim3(16, 4), 64, 0, st>>>(b.proj, b.km);
        moba<<<dim3(S / 64, 4), 64, 0, st>>>(b.proj, b.km, rel_bias, b.ob);
        group_norm<<<S, 256, 0, st>>>(b.oa, b.ob, g_oa, g_ob, b.yn);
        gemm<false><<<dim3(D / 64, S / 64), 256, 0, st>>>(b.yn, D, w_out, D, xc, D, D, 1.f, 1.f);
        rmsnorm<<<S, 256, 0, st>>>(xc, g_cross, b.xn);
        gemm<false><<<dim3(D / 64, S / 64), 256, 0, st>>>(b.xn, D, w_cq, D, b.qc, D, D, 1.f, 0.f);
        rmsnorm<<<NMEM, 256, 0, st>>>(mem + (size_t)bi * NMEM * D, g_mem, b.mn);
        gemm<false><<<dim3(2 * D / 64, NMEM / 64), 256, 0, st>>>(b.mn, D, w_ckv, 2 * D, b.kvc, 2 * D, D, 1.f, 0.f);
        for (int h = 0; h < 4; ++h)
            gemm<true><<<dim3(256 / 64, S / 64), 256, 0, st>>>(b.qc + h * 256, D, b.kvc + h * 256, 2 * D, b.sc + (size_t)h * S * 256, 256, 256, 0.0625f, 0.f);
        softmax256<<<4 * S / 4, 256, 0, st>>>(b.sc, 4 * S);
        for (int h = 0; h < 4; ++h)
            gemm<false><<<dim3(256 / 64, S / 64), 256, 0, st>>>(b.sc + (size_t)h * S * 256, 256, b.kvc + D + h * 256, 2 * D, b.oc + h * 256, D, 256, 1.f, 0.f);
        gemm<false><<<dim3(D / 64, S / 64), 256, 0, st>>>(b.oc, D, w_co, D, xc, D, D, 1.f, 1.f);
        ffn(xc, g_ffn2, w_gu2, w_d2, b, st);
        rmsnorm<<<S, 256, 0, st>>>(xc, g_final, xc);
    }
}
}

extern "C" void kernel_launch(void* const* d_in, const int* in_sizes, int n_in, void* d_out, int out_size, void* d_ws, size_t ws_size, hipStream_t stream) {
    if (n_in != 20 || out_size != 8 * 4096 * 1024 || ws_size < (size_t)400 * 1024 * 1024) { fprintf(stderr, "kernel_launch: unexpected shapes (n_in %d out %d ws %zu)\n", n_in, out_size, ws_size); return; }
    ref::forward(d_in, (float*)d_out, (unsigned char*)d_ws, stream);
}
```

```cpp
#include <hip/hip_runtime.h>
#include <cstdio>
#include <cstdint>
#include <cmath>
#define MK_DEBUG 0
#define MK_REPORT 0
#define MK_N_LAUNCHES 12
#define MK_NBAT 8

namespace pg8 {
#define PG8_LAS __attribute__((address_space(3)))
typedef unsigned short bf16_t;
typedef short bf16x8 __attribute__((ext_vector_type(8)));
typedef float f32x4 __attribute__((ext_vector_type(4)));
typedef float f32x2 __attribute__((ext_vector_type(2)));
typedef unsigned u32x4 __attribute__((ext_vector_type(4)));
typedef unsigned u32x2 __attribute__((ext_vector_type(2)));
constexpr int BM = 256, BK = 64, HALF = 128, HTB = HALF * BK * 2  , STAGE_BYTES = 8 * HTB, NXCD = 8, WGM = 8;

__host__ __device__ __forceinline__ int lds_byte(int r, int c) { const int st = (r >> 4) * 2 + (c >> 5), rr = r & 15, cc = c & 31, ob = rr * 64 + cc * 2; return st * 1024 + (ob ^ (((ob >> 9) & 1) << 5)); }
__host__ __device__ __forceinline__ void stage_rc(int b, int& R, int& C) { const int st = b / 1024, sb = b % 1024, swz = sb ^ (((sb >> 9) & 1) << 5); R = (st >> 1) * 16 + swz / 64; C = (st & 1) * 32 + (swz % 64) / 2; }
__host__ __device__ __forceinline__ int perm32(int rho) { const int n = rho >> 4, i = rho & 15; return 8 * (i >> 2) + 4 * n + (i & 3); }

struct Unit { const char* a; const char* b; int orow, ocol, aux; };

struct Order {
    int nM, nN, nwg, G, c;
    __device__ __forceinline__ void init(int M, int N, int G_, int c_) { nM = M / BM; nN = N / BM; nwg = nM * nN; G = G_; c = c_; }
    __device__ __forceinline__ bool tile(int i, int& pm, int& pn) const {
        const long L = (long)i * G + c; if (L >= nwg) return false;
        int wgid = (int)L; { const int q = nwg / NXCD, r = nwg % NXCD, xcd = wgid % NXCD, off = wgid / NXCD; wgid = (xcd < r ? xcd * (q + 1) : r * (q + 1) + (xcd - r) * q) + off; }
        const int nig = WGM * nN, gid = wgid / nig, fm = gid * WGM, gsz = (nM - fm) < WGM ? (nM - fm) : WGM;
        pm = fm + ((wgid % nig) % gsz); pn = (wgid % nig) / gsz; return true;
    }
};

__device__ __forceinline__ unsigned cvt_pk_bf16(float lo, float hi) { unsigned r; asm volatile("v_cvt_pk_bf16_f32 %0, %1, %2" : "=v"(r) : "v"(lo), "v"(hi)); return r; }

template <class Epi, class Sched, bool ALIGN_EPI>
__device__ __forceinline__ void gemm_phase(PG8_LAS unsigned char* lds, const int lda, const int ldb, const int nt, const Sched& S, const Epi& E) {
    int tid_ = threadIdx.x; asm volatile("" : "+v"(tid_));
    const int tid = tid_, wid = __builtin_amdgcn_readfirstlane(tid >> 6), lane = tid & 63, wr = wid >> 2, wc = wid & 3, fr = lane & 15, fq = lane >> 4;
    unsigned voffA[2], voffB[2];
#pragma unroll
    for (int i = 0; i < 2; ++i) { int R, C; stage_rc(tid * 16 + i * 8192, R, C); const int Rb = Epi::PERM ? ((R & ~31) + perm32(R & 31)) : R;
        voffA[i] = (unsigned)(R * lda + C) * 2u; voffB[i] = (unsigned)(Rb * ldb + C) * 2u; }
    const size_t kstep = (size_t)(BK * 2);
    const size_t hstepA = (size_t)HALF * lda * 2, hstepB = (size_t)HALF * ldb * 2;
    const unsigned ldsw = (unsigned)wid * 1024u;
    const int aoff = lds_byte(wr * 64 + fr, fq * 8), boff = lds_byte(wc * 32 + fr, fq * 8);
#define PG8_SA(b, h) (((b) * 2 + (h)) * HTB)
#define PG8_SB(b, h) ((4 + (b) * 2 + (h)) * HTB)
#define PG8_STAGE(bufoff, gbase, voff) do { _Pragma("unroll") for (int _i = 0; _i < 2; ++_i) \
        __builtin_amdgcn_global_load_lds((const unsigned*)((const char*)(gbase) + (voff)[_i]), (PG8_LAS unsigned*)(lds + (bufoff) + ldsw + _i * 8192), 16, 0, 0); } while (0)
#define PG8_LDA(dst, b, h) do { _Pragma("unroll") for (int m = 0; m < 4; ++m) _Pragma("unroll") for (int k = 0; k < 2; ++k) dst[m][k] = *(const PG8_LAS bf16x8*)(lds + PG8_SA(b, h) + aoff + m * 2048 + k * 1024); } while (0)
#define PG8_LDB(dst, b, h) do { _Pragma("unroll") for (int n = 0; n < 2; ++n) _Pragma("unroll") for (int k = 0; k < 2; ++k) dst[n][k] = *(const PG8_LAS bf16x8*)(lds + PG8_SB(b, h) + boff + n * 2048 + k * 1024); } while (0)
#define PG8_MMA(ai, bj, At, Bt) do { __builtin_amdgcn_s_setprio(1); _Pragma("unroll") for (int m = 0; m < 4; ++m) _Pragma("unroll") for (int n = 0; n < 2; ++n) _Pragma("unroll") for (int k = 0; k < 2; ++k) \
        acc[ai][bj][m][n] = __builtin_amdgcn_mfma_f32_16x16x32_bf16(Bt[n][k], At[m][k], acc[ai][bj][m][n], 0, 0, 0); __builtin_amdgcn_s_setprio(0); } while (0)
#define PG8_WAIT_V(n) asm volatile("s_waitcnt vmcnt(" #n ")" ::: "memory")
#define PG8_WAIT_L(n) asm volatile("s_waitcnt lgkmcnt(" #n ")" ::: "memory")
#define PG8_BAR __builtin_amdgcn_s_barrier()
#define PG8_SCHED __builtin_amdgcn_sched_barrier(0)
    Unit cur, nxt; int ui = 0;
    if (!S.next(0, cur)) return;
    f32x4 acc[2][2][4][2];
#pragma unroll
    for (int a = 0; a < 2; ++a)
#pragma unroll
        for (int b = 0; b < 2; ++b)
#pragma unroll
            for (int m = 0; m < 4; ++m)
#pragma unroll
                for (int n = 0; n < 2; ++n) acc[a][b][m][n] = (f32x4){0.f, 0.f, 0.f, 0.f};
    bf16x8 At[4][2], B0[2][2], B1[2][2];
    const char* cA = cur.a; const char* cB = cur.b;
    PG8_STAGE(PG8_SB(0, 0), cB, voffB); PG8_STAGE(PG8_SB(0, 1), cB + hstepB, voffB); PG8_STAGE(PG8_SA(0, 0), cA, voffA); PG8_STAGE(PG8_SA(0, 1), cA + hstepA, voffA);
    if (wr == 1) PG8_BAR;
    PG8_WAIT_V(2); PG8_BAR;
    PG8_STAGE(PG8_SB(1, 0), cB + kstep, voffB); PG8_STAGE(PG8_SA(1, 0), cA + kstep, voffA); PG8_STAGE(PG8_SB(1, 1), cB + hstepB + kstep, voffB);
    PG8_WAIT_V(6); PG8_BAR;
    for (;;) {
        const bool has_next = S.next(ui + 1, nxt);
        const char* nA = has_next ? nxt.a : cA; const char* nB = has_next ? nxt.b : cB;
#pragma unroll 1
        for (int t = 0; t < nt; t += 2) {
            const bool last = (t == nt - 2);
            const char* a1 = cA + (size_t)(t + 1) * kstep;
            const char* a2 = last ? nA : cA + (size_t)(t + 2) * kstep; const char* b2 = last ? nB : cB + (size_t)(t + 2) * kstep;
            const char* a3 = a2 + kstep; const char* b3 = b2 + kstep;
            PG8_LDB(B0, 0, 0); PG8_LDB(B1, 0, 1); PG8_SCHED; PG8_LDA(At, 0, 0); PG8_STAGE(PG8_SA(1, 1), a1 + hstepA, voffA);
            PG8_WAIT_V(8); PG8_WAIT_L(0); PG8_BAR; PG8_MMA(0, 0, At, B0); PG8_MMA(0, 1, At, B1); PG8_BAR; PG8_SCHED;
            PG8_LDA(At, 0, 1); PG8_STAGE(PG8_SB(0, 0), b2, voffB); PG8_STAGE(PG8_SB(0, 1), b2 + hstepB, voffB); PG8_STAGE(PG8_SA(0, 0), a2, voffA);
            PG8_WAIT_V(8); PG8_WAIT_L(0); PG8_BAR; PG8_MMA(1, 0, At, B0); PG8_MMA(1, 1, At, B1); PG8_BAR; PG8_SCHED;
            PG8_LDB(B0, 1, 0); PG8_LDB(B1, 1, 1); PG8_SCHED; PG8_LDA(At, 1, 0); PG8_STAGE(PG8_SA(0, 1), a2 + hstepA, voffA);
            PG8_WAIT_V(8); PG8_WAIT_L(0); PG8_BAR; PG8_MMA(0, 0, At, B0); PG8_MMA(0, 1, At, B1); PG8_BAR; PG8_SCHED;
            PG8_LDA(At, 1, 1); PG8_STAGE(PG8_SB(1, 0), b3, voffB); PG8_STAGE(PG8_SB(1, 1), b3 + hstepB, voffB); PG8_STAGE(PG8_SA(1, 0), a3, voffA);
            PG8_WAIT_V(8); PG8_WAIT_L(0); PG8_BAR; PG8_MMA(1, 0, At, B0); PG8_MMA(1, 1, At, B1); PG8_BAR; PG8_SCHED;
        }
        if constexpr (ALIGN_EPI) { if (wr == 0) PG8_BAR; }
        E(acc, cur, wr, wc, fr, fq, lds, wid, lane);
        if (!has_next) break;
#pragma unroll
        for (int a = 0; a < 2; ++a)
#pragma unroll
            for (int b = 0; b < 2; ++b)
#pragma unroll
                for (int m = 0; m < 4; ++m)
#pragma unroll
                    for (int n = 0; n < 2; ++n) acc[a][b][m][n] = (f32x4){0.f, 0.f, 0.f, 0.f};
        cur = nxt; cA = nA; cB = nB; ++ui;
        if constexpr (ALIGN_EPI) { if (wr == 1) PG8_BAR; }
    }
    PG8_WAIT_V(0);
    if constexpr (!ALIGN_EPI) { if (wr == 0) PG8_BAR; }
    PG8_BAR;
#undef PG8_SA
#undef PG8_SB
#undef PG8_STAGE
#undef PG8_LDA
#undef PG8_LDB
#undef PG8_MMA
#undef PG8_WAIT_V
#undef PG8_WAIT_L
#undef PG8_BAR
#undef PG8_SCHED
}
}

namespace att {
#define ATT_LAS __attribute__((address_space(3)))
typedef short bf16x8 __attribute__((ext_vector_type(8)));
typedef short v4i16 __attribute__((ext_vector_type(4)));
typedef float f32x16 __attribute__((ext_vector_type(16)));
typedef float f32x4 __attribute__((ext_vector_type(4)));
typedef unsigned u32x4 __attribute__((ext_vector_type(4)));
typedef unsigned u32x2 __attribute__((ext_vector_type(2)));
constexpr float LOG2E = 1.4426950408889634f;
constexpr int TABA_N = 192, TABB_N = 1600;

__device__ __forceinline__ int rel_bucket(int n) {
    if (n < 16) return n < 0 ? 0 : n;
    int b = 16;
    b += (n >= 22); b += (n >= 30); b += (n >= 40); b += (n >= 54); b += (n >= 73); b += (n >= 99); b += (n >= 134); b += (n >= 182);
    b += (n >= 246); b += (n >= 332); b += (n >= 450); b += (n >= 609); b += (n >= 825); b += (n >= 1117); b += (n >= 1513);
    return b;
}
__device__ __forceinline__ unsigned pk_bf16(float lo, float hi) { unsigned r; asm volatile("v_cvt_pk_bf16_f32 %0, %1, %2" : "=v"(r) : "v"(lo), "v"(hi)); return r; }
__device__ __forceinline__ float bf16_round(float x) { unsigned u = __builtin_bit_cast(unsigned, x); u = (u + 0x7fffu + ((u >> 16) & 1u)) & 0xffff0000u; return __builtin_bit_cast(float, u); }

template <bool MOBA>
__device__ __forceinline__ void attn_wave(const char* qbase, const long qs, const char* kbase, const long ks, const int voff, const int qstart, const int gend,
                                          ATT_LAS char* kv, const ATT_LAS float* tab, const unsigned selmask, const int qb, f32x16 (&o)[2], float& m_out, float& l_out) {
    const int lane = threadIdx.x & 63, q = lane & 31, h = lane >> 5;
    bf16x8 qf[4];
#pragma unroll
    for (int d0 = 0; d0 < 4; ++d0) qf[d0] = *(const bf16x8*)(qbase + (long)q * qs + (16 * d0 + 8 * h) * 2);
    bf16x8 kst[4], vst[4];
    const int srow = lane >> 3, sch = lane & 7;
    {
        const char* src = kbase + (long)(qstart + srow) * ks + sch * 16;
#pragma unroll
        for (int i = 0; i < 4; ++i) { kst[i] = *(const bf16x8*)(src + (long)(8 * i) * ks); vst[i] = *(const bf16x8*)(src + (long)(8 * i) * ks + voff); }
    }
    o[0] = f32x16{}; o[1] = f32x16{};
    float m = -INFINITY, l = 0.f;
    ATT_LAS char* kw[4]; ATT_LAS char* vw[4];
#pragma unroll
    for (int i = 0; i < 4; ++i) { const int r = 8 * i + srow; kw[i] = kv + r * 128 + 16 * (sch ^ ((r >> 1) & 7)); vw[i] = kv + 4096 + r * 128 + 16 * (sch ^ (((r >> 1) & 1) << 2)); }
    const ATT_LAS char* kr0 = kv + q * 128;
    const int kswz = (q >> 1) & 7;
    const int q4 = (lane & 15) >> 2, p4 = lane & 3, g1 = (lane >> 4) & 1;
    const int vrow0 = 4 * h + q4;
    const int vsw = (q4 >> 1) & 1;
    const ATT_LAS char* vr0 = kv + 4096 + vrow0 * 128 + 32 * g1 + 8 * p4;
    for (int g0 = qstart; g0 >= gend; g0 -= 32) {
#pragma unroll
        for (int i = 0; i < 4; ++i) { *(ATT_LAS bf16x8*)kw[i] = kst[i]; *(ATT_LAS bf16x8*)vw[i] = vst[i]; }
        asm volatile("" ::: "memory");
        if (g0 - 32 >= gend) {
            const char* src = kbase + (long)(g0 - 32 + srow) * ks + sch * 16;
#pragma unroll
            for (int i = 0; i < 4; ++i) { kst[i] = *(const bf16x8*)(src + (long)(8 * i) * ks); vst[i] = *(const bf16x8*)(src + (long)(8 * i) * ks + voff); }
        }
        f32x16 s = f32x16{};
#pragma unroll
        for (int d0 = 0; d0 < 4; ++d0) { const bf16x8 kf = *(const ATT_LAS bf16x8*)(kr0 + 16 * ((2 * d0 + h) ^ kswz)); s = __builtin_amdgcn_mfma_f32_32x32x16_bf16(kf, qf[d0], s, 0, 0, 0); }
        int B = (qstart - g0 + 32) + q - 4 * h;
        if (MOBA) { B = B < (TABB_N - 1) ? B : (TABB_N - 1); const int n = g0 >> 8; const bool sel = (n == qb) || ((selmask >> n) & 1u); B = sel ? B : 27; }
        const ATT_LAS float* tp = tab + B;
        float mx = -INFINITY;
#pragma unroll
        for (int r = 0; r < 16; ++r) { const int off = (r & 3) + 8 * (r >> 2); s[r] = fmaf(s[r], LOG2E, tp[-off]); mx = fmaxf(mx, s[r]); }
        mx = fmaxf(mx, __shfl_xor(mx, 32));
        const float mnew = fmaxf(m, mx);
        const float alpha = __builtin_amdgcn_exp2f(m - mnew);
        float ps = 0.f;
#pragma unroll
        for (int r = 0; r < 16; ++r) { s[r] = __builtin_amdgcn_exp2f(s[r] - mnew); ps += s[r]; }
        l = l * alpha + ps; m = mnew;
#pragma unroll
        for (int r = 0; r < 16; ++r) { o[0][r] *= alpha; o[1][r] *= alpha; }
        u32x4 pw0, pw1;
        pw0[0] = pk_bf16(s[0], s[1]); pw0[1] = pk_bf16(s[2], s[3]); pw0[2] = pk_bf16(s[4], s[5]); pw0[3] = pk_bf16(s[6], s[7]);
        pw1[0] = pk_bf16(s[8], s[9]); pw1[1] = pk_bf16(s[10], s[11]); pw1[2] = pk_bf16(s[12], s[13]); pw1[3] = pk_bf16(s[14], s[15]);
        const bf16x8 pb0 = __builtin_bit_cast(bf16x8, pw0), pb1 = __builtin_bit_cast(bf16x8, pw1);
#pragma unroll
        for (int dh = 0; dh < 2; ++dh) {
            const ATT_LAS char* vp = vr0 + 64 * (dh ^ vsw);
            const v4i16 a00 = __builtin_amdgcn_ds_read_tr16_b64_v4i16((ATT_LAS v4i16*)(vp));
            const v4i16 a01 = __builtin_amdgcn_ds_read_tr16_b64_v4i16((ATT_LAS v4i16*)(vp + 8 * 128));
            const v4i16 a10 = __builtin_amdgcn_ds_read_tr16_b64_v4i16((ATT_LAS v4i16*)(vp + 16 * 128));
            const v4i16 a11 = __builtin_amdgcn_ds_read_tr16_b64_v4i16((ATT_LAS v4i16*)(vp + 24 * 128));
            const bf16x8 va0 = (bf16x8){a00[0], a00[1], a00[2], a00[3], a01[0], a01[1], a01[2], a01[3]};
            const bf16x8 va1 = (bf16x8){a10[0], a10[1], a10[2], a10[3], a11[0], a11[1], a11[2], a11[3]};
            o[dh] = __builtin_amdgcn_mfma_f32_32x32x16_bf16(va0, pb0, o[dh], 0, 0, 0);
            o[dh] = __builtin_amdgcn_mfma_f32_32x32x16_bf16(va1, pb1, o[dh], 0, 0, 0);
        }
        asm volatile("" ::: "memory");
    }
    l += __shfl_xor(l, 32);
    m_out = m; l_out = l;
}

__device__ __forceinline__ void store_o(const f32x16 (&o)[2], const float l, char* orow_q, const int h) {
    const float il = 1.0f / l;
#pragma unroll
    for (int dh = 0; dh < 2; ++dh)
#pragma unroll
        for (int j = 0; j < 4; ++j) {
            u32x2 w; w[0] = pk_bf16(o[dh][4 * j] * il, o[dh][4 * j + 1] * il); w[1] = pk_bf16(o[dh][4 * j + 2] * il, o[dh][4 * j + 3] * il);
            *(u32x2*)(orow_q + (32 * dh + 8 * j + 4 * h) * 2) = w;
        }
}

__device__ __forceinline__ unsigned moba_select(const char* qbase, const long qs, const float* km, const int qb) {
    const int lane = threadIdx.x & 63, q = lane & 31, h = lane >> 5;
    f32x16 g = f32x16{};
    const float* kmrow = km + (size_t)(q & 15) * 256;
    const bool lo_part = q >= 16;
#pragma unroll
    for (int d0 = 0; d0 < 4; ++d0) {
        const bf16x8 qf = *(const bf16x8*)(qbase + (long)q * qs + (16 * d0 + 8 * h) * 2);
        const f32x4 f0 = *(const f32x4*)(kmrow + 16 * d0 + 8 * h), f1 = *(const f32x4*)(kmrow + 16 * d0 + 8 * h + 4);
        float v[8] = {f0[0], f0[1], f0[2], f0[3], f1[0], f1[1], f1[2], f1[3]};
        u32x4 aw;
#pragma unroll
        for (int j = 0; j < 4; ++j) {
            const float h0 = bf16_round(v[2 * j]), h1 = bf16_round(v[2 * j + 1]);
            const float x0 = lo_part ? (v[2 * j] - h0) : h0, x1 = lo_part ? (v[2 * j + 1] - h1) : h1;
            aw[j] = pk_bf16(x0, x1);
        }
        g = __builtin_amdgcn_mfma_f32_32x32x16_bf16(__builtin_bit_cast(bf16x8, aw), qf, g, 0, 0, 0);
    }
    float gate[8], other[8];
#pragma unroll
    for (int r = 0; r < 8; ++r) { gate[r] = g[r] + g[r + 8]; }
#pragma unroll
    for (int r = 0; r < 8; ++r) { other[r] = __shfl_xor(gate[r], 32); }
    unsigned mymask = 0u;
#pragma unroll
    for (int r = 0; r < 8; ++r) {
        const int n = (r & 3) + 8 * (r >> 2) + 4 * h;
        int rank = 0;
#pragma unroll
        for (int r2 = 0; r2 < 8; ++r2) {
            const int n2 = (r2 & 3) + 8 * (r2 >> 2) + 4 * h, n3 = (r2 & 3) + 8 * (r2 >> 2) + 4 * (1 - h);
            if (r2 != r) rank += (n2 < qb && (gate[r2] > gate[r] || (gate[r2] == gate[r] && n2 < n))) ? 1 : 0;
            rank += (n3 < qb && (other[r2] > gate[r] || (other[r2] == gate[r] && n3 < n))) ? 1 : 0;
        }
        if (n < qb && rank < 3) mymask |= 1u << n;
    }
    return mymask | (unsigned)__shfl_xor((int)mymask, 32);
}
}

namespace mk {
using pg8::bf16_t; using pg8::bf16x8; using pg8::f32x4; using pg8::f32x2; using pg8::u32x4; using pg8::u32x2; using pg8::Unit; using pg8::cvt_pk_bf16;
#define LAS __attribute__((address_space(3)))
constexpr int NBAT = MK_NBAT, SEQ = 4096, D = 1024, DFF = 2816, NMEM = 256, M = NBAT * SEQ, MM = NBAT * NMEM, NQKV = 3072;
constexpr float EPS = 1e-6f, LOG2E = 1.4426950408889634f;
constexpr int NWAVES = 8, NPH = 12;

constexpr size_t al256(size_t x) { return (x + 255) / 256 * 256; }
constexpr size_t WS_CTL = 0, CTL_BYTES = 1u << 20;
constexpr size_t WS_WGU1 = WS_CTL + CTL_BYTES;
constexpr size_t WS_WD1 = WS_WGU1 + (size_t)2 * DFF * D * 2;
constexpr size_t WS_WIN = WS_WD1 + (size_t)D * DFF * 2;
constexpr size_t WS_WOUT = WS_WIN + (size_t)NQKV * D * 2;
constexpr size_t WS_WCQS = WS_WOUT + (size_t)D * D * 2;
constexpr size_t WS_WCKV = WS_WCQS + (size_t)D * D * 2;
constexpr size_t WS_WCO = WS_WCKV + (size_t)2 * D * D * 2;
constexpr size_t WS_WGU2 = WS_WCO + (size_t)D * D * 2;
constexpr size_t WS_WD2 = WS_WGU2 + (size_t)2 * DFF * D * 2;
constexpr size_t WS_MB = WS_WD2 + (size_t)D * DFF * 2;
constexpr size_t WS_KVC = WS_MB + (size_t)MM * D * 2;
constexpr size_t WS_WKT = WS_KVC + (size_t)MM * 2 * D * 2;
constexpr size_t WS_VWT = WS_WKT + (size_t)NBAT * D * D * 2;
constexpr size_t SS_BYTES = (size_t)M * 16 * 4;
constexpr size_t WS_SS = WS_VWT + (size_t)NBAT * D * D * 2;
constexpr size_t WS_SSM = WS_SS + 5 * SS_BYTES;
constexpr size_t WS_KM = WS_SSM + (size_t)MM * 16 * 4;
constexpr size_t WS_R1 = al256(WS_KM + (size_t)NBAT * 16 * 256 * 4);
constexpr size_t WS_R2 = WS_R1 + (size_t)M * NQKV * 2;
constexpr size_t WS_OA = WS_R2, WS_OB = WS_OA + (size_t)3 * M * 768 * 2, WS_ML = WS_OB + (size_t)M * 256 * 2;
constexpr size_t WS_END = WS_ML + (size_t)3 * M * 12 * 8;
static_assert((size_t)M * D * 2 <= (size_t)3 * M * 768 * 2, "XB fits under OA");
constexpr int CW_BAR = 4096;

constexpr int LDS_XCH = 131072;
constexpr int LDS_MISC = 131072 + 8192;
constexpr int LDS_BYTES = 147456;
constexpr int LDS_TABA = 65536, LDS_TABB = LDS_TABA + 36 * att::TABA_N * 4;
static_assert(LDS_TABB + 4 * att::TABB_N * 4 <= LDS_XCH, "attention LDS map");

__device__ __forceinline__ float wave_sum(float v) {
#pragma unroll
    for (int o = 1; o < 64; o <<= 1) v += __shfl_xor(v, o);
    return v;
}
__device__ __forceinline__ float row_rstd(const float* ss, int row) {
    const f32x4* p = (const f32x4*)(ss + (size_t)row * 16);
    const f32x4 a = p[0], b = p[1], c = p[2], d = p[3];
    const float s = ((a[0] + a[1]) + (a[2] + a[3])) + ((b[0] + b[1]) + (b[2] + b[3])) + ((c[0] + c[1]) + (c[2] + c[3])) + ((d[0] + d[1]) + (d[2] + d[3]));
    return 1.0f / sqrtf(s * (1.0f / D) + EPS);
}

struct SchedStd {
    pg8::Order o; const char* A; const char* B; size_t a_tile, b_tile, b_batch; int ocol_mul;
    __device__ __forceinline__ bool next(int i, Unit& u) const { int pm, pn; if (!o.tile(i, pm, pn)) return false;
        u.a = A + (size_t)pm * a_tile; u.b = B + (size_t)pn * b_tile + (size_t)(pm >> 4) * b_batch; u.orow = pm * 256; u.ocol = pn * ocol_mul; u.aux = pn; return true; }
};
struct SchedWK {
    int G, c; const char* kvc; const char* wcqs;
    __device__ __forceinline__ bool next(int i, Unit& u) const { const int L = i * G + c; if (L >= NBAT * 16) return false; const int bh = L >> 2, pn = L & 3, b = bh >> 2, h = bh & 3;
        u.a = kvc + ((size_t)(b * 256) * 2048 + h * 256) * 2; u.b = wcqs + ((size_t)(pn * 256) * 1024 + h * 256) * 2; u.orow = b * 1024 + h * 256; u.ocol = pn * 256; u.aux = 0; return true; }
};
struct SchedVW {
    int G, c; const char* kvc; const char* wcot;
    __device__ __forceinline__ bool next(int i, Unit& u) const { const int L = i * G + c; if (L >= NBAT * 16) return false; const int bh = L >> 2, pm = L & 3, b = bh >> 2, h = bh & 3;
        u.a = wcot + ((size_t)(pm * 256) * 1024 + h * 256) * 2; u.b = kvc + ((size_t)(b * 256) * 2048 + 1024 + h * 256) * 2; u.orow = b * 1024 + pm * 256; u.ocol = h * 256; u.aux = 0; return true; }
};

struct EpiGU { static constexpr bool PERM = true;
    bf16_t* H; const float* ss;
    __device__ __forceinline__ void operator()(const f32x4 (&acc)[2][2][4][2], const Unit& u, int wr, int wc, int fr, int fq, LAS unsigned char*, int, int) const {
#pragma unroll
        for (int ai = 0; ai < 2; ++ai)
#pragma unroll
            for (int m = 0; m < 4; ++m) { const int row = u.orow + ai * 128 + wr * 64 + m * 16 + fr; const float rs = row_rstd(ss, row);
                float hv[8];
#pragma unroll
                for (int n = 0; n < 2; ++n)
#pragma unroll
                    for (int j = 0; j < 4; ++j) { const float g = acc[ai][0][m][n][j] * rs, uu = acc[ai][1][m][n][j] * rs;
                        hv[4 * n + j] = g * __builtin_amdgcn_rcpf(1.0f + __builtin_amdgcn_exp2f(-g * LOG2E)) * uu; }
                u32x4 w; w[0] = cvt_pk_bf16(hv[0], hv[1]); w[1] = cvt_pk_bf16(hv[2], hv[3]); w[2] = cvt_pk_bf16(hv[4], hv[5]); w[3] = cvt_pk_bf16(hv[6], hv[7]);
                *(u32x4*)(H + (size_t)row * DFF + u.ocol + wc * 32 + 8 * fq) = w; }
    }
};
struct EpiRes { static constexpr bool PERM = false;
    const float* base; float* out; bf16_t* xb; float* ssout; float alpha;
    __device__ __forceinline__ void operator()(const f32x4 (&acc)[2][2][4][2], const Unit& u, int wr, int wc, int fr, int fq, LAS unsigned char*, int, int) const {
#pragma unroll
        for (int ai = 0; ai < 2; ++ai)
#pragma unroll
            for (int m = 0; m < 4; ++m) { const int row = u.orow + ai * 128 + wr * 64 + m * 16 + fr; const size_t off = (size_t)row * D + u.ocol + wc * 32 + 4 * fq; float sq = 0.f;
#pragma unroll
                for (int bj = 0; bj < 2; ++bj)
#pragma unroll
                    for (int n = 0; n < 2; ++n) { const f32x4 bs = *(const f32x4*)(base + off + bj * 128 + n * 16); const f32x4 o = bs + acc[ai][bj][m][n] * alpha;
                        *(f32x4*)(out + off + bj * 128 + n * 16) = o; sq += (o[0] * o[0] + o[1] * o[1]) + (o[2] * o[2] + o[3] * o[3]);
                        if (xb) { u32x2 w; w[0] = cvt_pk_bf16(o[0], o[1]); w[1] = cvt_pk_bf16(o[2], o[3]); *(u32x2*)(xb + off + bj * 128 + n * 16) = w; } }
                sq += __shfl_xor(sq, 16); sq += __shfl_xor(sq, 32);
                if (fq == 0) ssout[(size_t)row * 16 + (u.ocol >> 8) * 4 + wc] = sq; }
    }
};
struct EpiStore { static constexpr bool PERM = true;
    bf16_t* O; int ldc; const float* ss; float* km;
    __device__ __forceinline__ void operator()(const f32x4 (&acc)[2][2][4][2], const Unit& u, int wr, int wc, int fr, int fq, LAS unsigned char*, int, int) const {
        float rsv[2][4];
#pragma unroll
        for (int ai = 0; ai < 2; ++ai)
#pragma unroll
            for (int m = 0; m < 4; ++m) { const int row = u.orow + ai * 128 + wr * 64 + m * 16 + fr; const float rs = ss ? row_rstd(ss, row) : 1.0f; rsv[ai][m] = rs;
                bf16_t* rowp = O + (size_t)row * ldc + u.ocol + wc * 32 + 8 * fq;
#pragma unroll
                for (int bj = 0; bj < 2; ++bj) { const f32x4 v0 = acc[ai][bj][m][0] * rs, v1 = acc[ai][bj][m][1] * rs;
                    u32x4 w; w[0] = cvt_pk_bf16(v0[0], v0[1]); w[1] = cvt_pk_bf16(v0[2], v0[3]); w[2] = cvt_pk_bf16(v1[0], v1[1]); w[3] = cvt_pk_bf16(v1[2], v1[3]);
                    *(u32x4*)(rowp + bj * 128) = w; } }
        if ((km != nullptr) && (u.aux == 10)) {
            float* kmb = km + (size_t)(u.orow >> 8) * 256 + wc * 32 + 8 * fq;
#pragma unroll
            for (int bj = 0; bj < 2; ++bj)
#pragma unroll
                for (int n = 0; n < 2; ++n) { f32x4 cs = (f32x4){0.f, 0.f, 0.f, 0.f};
#pragma unroll
                    for (int ai = 0; ai < 2; ++ai)
#pragma unroll
                        for (int m = 0; m < 4; ++m) cs += acc[ai][bj][m][n] * rsv[ai][m];
#pragma unroll
                    for (int j = 0; j < 4; ++j) { float v = cs[j]; v += __shfl_xor(v, 1); v += __shfl_xor(v, 2); v += __shfl_xor(v, 4); v += __shfl_xor(v, 8);
                        if (fr == 0) atomicAdd(kmb + bj * 128 + 4 * n + j, v); } }
        }
    }
};
struct EpiSoftmax { static constexpr bool PERM = true;
    bf16_t* P; const float* ss;
    __device__ __forceinline__ void operator()(const f32x4 (&acc)[2][2][4][2], const Unit& u, int wr, int wc, int fr, int fq, LAS unsigned char* lds, int, int) const {
        LAS f32x2* X = (LAS f32x2*)(lds + LDS_XCH);
        float rsl[2][4], mw[2][4];
#pragma unroll
        for (int ai = 0; ai < 2; ++ai)
#pragma unroll
            for (int m = 0; m < 4; ++m) { const int rl = ai * 128 + wr * 64 + m * 16 + fr; const float rs = row_rstd(ss, u.orow + rl) * LOG2E; rsl[ai][m] = rs;
                float mx = -INFINITY;
#pragma unroll
                for (int bj = 0; bj < 2; ++bj)
#pragma unroll
                    for (int n = 0; n < 2; ++n)
#pragma unroll
                        for (int j = 0; j < 4; ++j) mx = fmaxf(mx, acc[ai][bj][m][n][j] * rs);
                mx = fmaxf(mx, __shfl_xor(mx, 16)); mx = fmaxf(mx, __shfl_xor(mx, 32));
                float sm = 0.f;
#pragma unroll
                for (int bj = 0; bj < 2; ++bj)
#pragma unroll
                    for (int n = 0; n < 2; ++n)
#pragma unroll
                        for (int j = 0; j < 4; ++j) sm += __builtin_amdgcn_exp2f(acc[ai][bj][m][n][j] * rs - mx);
                sm += __shfl_xor(sm, 16); sm += __shfl_xor(sm, 32);
                mw[ai][m] = mx;
                if (fq == 0) X[rl * 4 + wc] = (f32x2){mx, sm}; }
        asm volatile("s_waitcnt lgkmcnt(0)" ::: "memory"); __builtin_amdgcn_s_barrier(); asm volatile("" ::: "memory");
#pragma unroll
        for (int ai = 0; ai < 2; ++ai)
#pragma unroll
            for (int m = 0; m < 4; ++m) { const int rl = ai * 128 + wr * 64 + m * 16 + fr; const float rs = rsl[ai][m];
                const f32x2 x0 = X[rl * 4 + 0], x1 = X[rl * 4 + 1], x2 = X[rl * 4 + 2], x3 = X[rl * 4 + 3];
                const float Mx = fmaxf(fmaxf(x0[0], x1[0]), fmaxf(x2[0], x3[0]));
                const float L = x0[1] * __builtin_amdgcn_exp2f(x0[0] - Mx) + x1[1] * __builtin_amdgcn_exp2f(x1[0] - Mx) + x2[1] * __builtin_amdgcn_exp2f(x2[0] - Mx) + x3[1] * __builtin_amdgcn_exp2f(x3[0] - Mx);
                const float il = 1.0f / L;
                bf16_t* rowp = P + (size_t)(u.orow + rl) * D + u.ocol + wc * 32 + 8 * fq;
#pragma unroll
                for (int bj = 0; bj < 2; ++bj) { float pv[8];
#pragma unroll
                    for (int n = 0; n < 2; ++n)
#pragma unroll
                        for (int j = 0; j < 4; ++j) pv[4 * n + j] = __builtin_amdgcn_exp2f(acc[ai][bj][m][n][j] * rs - Mx) * il;
                    u32x4 w; w[0] = cvt_pk_bf16(pv[0], pv[1]); w[1] = cvt_pk_bf16(pv[2], pv[3]); w[2] = cvt_pk_bf16(pv[4], pv[5]); w[3] = cvt_pk_bf16(pv[6], pv[7]);
                    *(u32x4*)(rowp + bj * 128) = w; } }
        (void)mw;
    }
};

#define XB_TMO      128
#define XB_XCNT(j)  (256  + 64 * (j))
#define XB_XSUB(j)  (1280 + 64 * (j))
#define XB_XGEN(j)  (2304 + 64 * (j))
#define XB_TOP      3328
#define XB_TOPGEN   3392
#define XCD_BAR_WORDS 3456
#define XB_SPIN_CAP (1u << 18)
__device__ __forceinline__ unsigned xb_ld(unsigned* p)              { return __hip_atomic_load(p, __ATOMIC_RELAXED, __HIP_MEMORY_SCOPE_AGENT); }
__device__ __forceinline__ unsigned xb_add(unsigned* p, unsigned v) { return __hip_atomic_fetch_add(p, v, __ATOMIC_RELAXED, __HIP_MEMORY_SCOPE_AGENT); }
__device__ __forceinline__ unsigned xb_xcc_id() { return (unsigned)__builtin_amdgcn_s_getreg((3 << 11) | 20) & 0xFu; }
#define XB_SPIN(cond, bar) do { unsigned _sp = 0; while (cond) { __builtin_amdgcn_s_sleep(1); \
    if ((++_sp & 255u) == 0u) { if (xb_ld(&(bar)[XB_TMO])) break; if (_sp > XB_SPIN_CAP) { atomicAdd(&(bar)[XB_TMO], 1u); break; } } } } while (0)
struct XcdBarrier { unsigned* bar; unsigned x; volatile LAS unsigned* st; };
__device__ __forceinline__ XcdBarrier xcd_barrier_post(unsigned* bar, volatile LAS unsigned* st) {
    XcdBarrier b; b.bar = bar; b.x = xb_xcc_id(); b.st = st;
    if (threadIdx.x == 0) (void)xb_add(&bar[XB_XCNT(b.x)], 1u);
    return b;
}
__device__ __forceinline__ void xcd_barrier_complete(unsigned* bar, unsigned x, unsigned& nloc, unsigned& nx) {
    const unsigned G = gridDim.x * gridDim.y * gridDim.z;
    unsigned sum, cnt, mine, sp = 0u;
    for (;;) {
        sum = 0u; cnt = 0u; mine = 0u;
#pragma unroll
        for (unsigned j = 0; j < 16; ++j) { const unsigned c = xb_ld(&bar[XB_XCNT(j)]); sum += c; cnt += (c > 0u) ? 1u : 0u; mine = (j == x) ? c : mine; }
        if (sum == G) break;
        __builtin_amdgcn_s_sleep(1);
        if ((++sp & 255u) == 0u) { if (xb_ld(&bar[XB_TMO])) break; if (sp > XB_SPIN_CAP) { atomicAdd(&bar[XB_TMO], 1u); break; } }
    }
    nloc = mine > 0u ? mine : 1u; nx = cnt > 0u ? cnt : 1u;
}
__device__ __forceinline__ void xcd_barrier(const XcdBarrier& b) {
    asm volatile("s_waitcnt vmcnt(0)" ::: "memory");
    __syncthreads();
    if (threadIdx.x == 0) {
        unsigned* bar = b.bar;
        __builtin_amdgcn_s_waitcnt(0);
        unsigned nloc = b.st[0], nx = b.st[1];
        if (nloc == 0u) { xcd_barrier_complete(bar, b.x, nloc, nx); b.st[0] = nloc; b.st[1] = nx; }
        const unsigned old = xb_add(&bar[XB_XSUB(b.x)], 1u);
        const unsigned gen = old / nloc;
        if (old + 1u == (gen + 1u) * nloc) {
            __builtin_amdgcn_fence(__ATOMIC_RELEASE, "agent");
            asm volatile("s_waitcnt vmcnt(0)" ::: "memory");
            const unsigned og = xb_add(&bar[XB_TOP], 1u);
            const unsigned tg = og / nx;
            if (og + 1u == (tg + 1u) * nx) xb_add(&bar[XB_TOPGEN], 1u);
            else XB_SPIN(xb_ld(&bar[XB_TOPGEN]) == tg, bar);
            __builtin_amdgcn_fence(__ATOMIC_ACQUIRE, "agent");
            xb_add(&bar[XB_XGEN(b.x)], 1u);
            asm volatile("s_waitcnt vmcnt(0)" ::: "memory");
        } else {
            XB_SPIN(xb_ld(&bar[XB_XGEN(b.x)]) == gen, bar);
            __builtin_amdgcn_fence(__ATOMIC_ACQUIRE, "agent");
            asm volatile("s_waitcnt vmcnt(0)" ::: "memory");
        }
    }
    __syncthreads();
}

__device__ __forceinline__ void tr_item(const float* W, int N, int k0, int n0, const float* gain, float cscale, bf16_t* dst  , int Kd, LAS float* scr, int lane) {
#pragma unroll 8
    for (int i = 0; i < 32; ++i) { const int kk = 2 * i + (lane >> 5); const float g = gain ? gain[k0 + kk] * cscale : cscale; scr[kk * 33 + (lane & 31)] = W[(size_t)(k0 + kk) * N + n0 + (lane & 31)] * g; }
    asm volatile("s_waitcnt lgkmcnt(0)" ::: "memory");
    const int c = lane & 7;
#pragma unroll
    for (int j = 0; j < 4; ++j) { const int n = (lane >> 3) + 8 * j; const LAS float* s = scr + (8 * c) * 33 + n;
        u32x4 o; o[0] = cvt_pk_bf16(s[0 * 33], s[1 * 33]); o[1] = cvt_pk_bf16(s[2 * 33], s[3 * 33]); o[2] = cvt_pk_bf16(s[4 * 33], s[5 * 33]); o[3] = cvt_pk_bf16(s[6 * 33], s[7 * 33]);
        *(u32x4*)(dst + (size_t)n * Kd + k0 + 8 * c) = o; }
    asm volatile("s_waitcnt lgkmcnt(0)" ::: "memory");
}
__device__ __forceinline__ void cvt_row(const float* xrow, bf16_t* orow, float* ssrow, int lane) {
    const f32x4* xr = (const f32x4*)xrow + lane; f32x4 v[4]; float s = 0.f;
#pragma unroll
    for (int j = 0; j < 4; ++j) { v[j] = xr[64 * j]; s += (v[j][0] * v[j][0] + v[j][1] * v[j][1]) + (v[j][2] * v[j][2] + v[j][3] * v[j][3]); }
    s = wave_sum(s);
    u32x2* o8 = (u32x2*)orow + lane;
#pragma unroll
    for (int j = 0; j < 4; ++j) { u32x2 w; w[0] = cvt_pk_bf16(v[j][0], v[j][1]); w[1] = cvt_pk_bf16(v[j][2], v[j][3]); o8[64 * j] = w; }
    if (lane < 16) ssrow[lane] = lane == 0 ? s : 0.f;
}

struct Args { const float* in[20]; float* out; unsigned char* ws; int ph_lo, ph_hi; };

__global__ void __launch_bounds__(NWAVES * 64, 2) mk_fwd(Args args) {
    extern __shared__ __attribute__((aligned(16))) unsigned char lds_raw[];
    LAS unsigned char* lds = (LAS unsigned char*)lds_raw;
    const int tid = threadIdx.x, lane = tid & 63, wave = __builtin_amdgcn_readfirstlane(tid >> 6);
    const int G = gridDim.x, bx = blockIdx.x;
    const int vcu = (G % 8 == 0) ? (bx % 8) * (G / 8) + bx / 8 : bx;
    const int gw = vcu * NWAVES + wave, NGW = G * NWAVES;
    unsigned char* ws = args.ws;
    const float* x_in = args.in[0]; const float* mem_in = args.in[1]; const float* rel_bias = args.in[7];
    float* out = args.out;
    bf16_t* Wgu1 = (bf16_t*)(ws + WS_WGU1); bf16_t* Wd1 = (bf16_t*)(ws + WS_WD1); bf16_t* Win = (bf16_t*)(ws + WS_WIN); bf16_t* Wout = (bf16_t*)(ws + WS_WOUT);
    bf16_t* Wcqs = (bf16_t*)(ws + WS_WCQS); bf16_t* Wckv = (bf16_t*)(ws + WS_WCKV); bf16_t* Wco = (bf16_t*)(ws + WS_WCO); bf16_t* Wgu2 = (bf16_t*)(ws + WS_WGU2); bf16_t* Wd2 = (bf16_t*)(ws + WS_WD2);
    bf16_t* MB = (bf16_t*)(ws + WS_MB); bf16_t* KVC = (bf16_t*)(ws + WS_KVC); bf16_t* WKT = (bf16_t*)(ws + WS_WKT); bf16_t* VWT = (bf16_t*)(ws + WS_VWT);
    float* SS0 = (float*)(ws + WS_SS); float* SS1 = SS0 + (size_t)M * 16; float* SS2 = SS1 + (size_t)M * 16; float* SS3 = SS2 + (size_t)M * 16; float* SS4 = SS3 + (size_t)M * 16;
    float* SSM = (float*)(ws + WS_SSM); float* KM = (float*)(ws + WS_KM);
    bf16_t* HB = (bf16_t*)(ws + WS_R1); bf16_t* QKV = HB; bf16_t* YN = HB; bf16_t* PB = HB;
    bf16_t* XB = (bf16_t*)(ws + WS_R2); bf16_t* OA = (bf16_t*)(ws + WS_OA); bf16_t* OB = (bf16_t*)(ws + WS_OB); float* ML = (float*)(ws + WS_ML);

    volatile LAS unsigned* MISC = (volatile LAS unsigned*)(lds + LDS_MISC);
    if (tid < 32) MISC[tid] = 0u;
    __syncthreads();
    const int lo = args.ph_lo, hi = args.ph_hi;
    const bool use_bar = (hi - lo) > 1;
    XcdBarrier bar; bar.bar = (unsigned*)(ws + WS_CTL) + CW_BAR; bar.x = 0; bar.st = nullptr;
    if (use_bar) bar = xcd_barrier_post((unsigned*)(ws + WS_CTL) + CW_BAR, MISC + 8);
#define IN(k) (lo <= (k) && (k) < hi)
#define SEAM(k) do { if (IN(k) && IN((k) + 1)) xcd_barrier(bar); } while (0)

    if (IN(0)) {
        LAS float* scr = (LAS float*)(lds + wave * 16384);
        constexpr int I_GU = (D / 64) * (2 * DFF / 32), I_DN = (DFF / 64) * (D / 32), I_IN = (D / 64) * (NQKV / 32), I_SQ = (D / 64) * (D / 32), I_KV = (D / 64) * (2 * D / 32);
        constexpr int NITEMS = 2 * I_GU + 2 * I_DN + I_IN + 2 * I_SQ + I_KV;
        for (int it = gw; it < NITEMS; it += NGW) {
            int r = it;
            if (r < 2 * I_GU) {
                const bool second = r >= I_GU; if (second) r -= I_GU;
                const int nblk = 2 * DFF / 32, kb = r / nblk, nb = r % nblk, n0 = nb * 32;
                const int drow = n0 < DFF ? (n0 / 128) * 256 + (n0 % 128) : ((n0 - DFF) / 128) * 256 + 128 + ((n0 - DFF) % 128);
                tr_item(args.in[second ? 17 : 3], 2 * DFF, kb * 64, n0, args.in[second ? 16 : 2], 1.0f, (second ? Wgu2 : Wgu1) + (size_t)drow * D, D, scr, lane); continue; }
            r -= 2 * I_GU;
            if (r < 2 * I_DN) { const bool second = r >= I_DN; if (second) r -= I_DN; const int nblk = D / 32, kb = r / nblk, nb = r % nblk;
                tr_item(args.in[second ? 18 : 4], D, kb * 64, nb * 32, nullptr, 1.0f, (second ? Wd2 : Wd1) + (size_t)(nb * 32) * DFF, DFF, scr, lane); continue; }
            r -= 2 * I_DN;
            if (r < I_IN) { const int nblk = NQKV / 32, kb = r / nblk, nb = r % nblk, n0 = nb * 32; const bool isq = (n0 < 768) || (n0 >= 2304 && n0 < 2560);
                tr_item(args.in[6], NQKV, kb * 64, n0, args.in[5], isq ? 0.125f : 1.0f, Win + (size_t)n0 * D, D, scr, lane); continue; }
            r -= I_IN;
            if (r < I_SQ) { const int nblk = D / 32, kb = r / nblk, nb = r % nblk, k0 = kb * 64; const float* gp = k0 < 768 ? args.in[8] : args.in[9] - 768;
                tr_item(args.in[10], D, k0, nb * 32, gp, 1.0f, Wout + (size_t)(nb * 32) * D, D, scr, lane); continue; }
            r -= I_SQ;
            if (r < I_SQ) { const int nblk = D / 32, kb = r / nblk, nb = r % nblk; tr_item(args.in[15], D, kb * 64, nb * 32, nullptr, 1.0f, Wco + (size_t)(nb * 32) * D, D, scr, lane); continue; }
            r -= I_SQ;
            { const int nblk = 2 * D / 32, kb = r / nblk, nb = r % nblk; tr_item(args.in[14], 2 * D, kb * 64, nb * 32, args.in[12], 1.0f, Wckv + (size_t)(nb * 32) * D, D, scr, lane); }
        }
        for (int c = gw; c < D; c += NGW) { const float g = args.in[11][c] * 0.0625f; const f32x4* src = (const f32x4*)(args.in[13] + (size_t)c * D) + lane; u32x2* dst = (u32x2*)(Wcqs + (size_t)c * D) + lane;
#pragma unroll
            for (int j = 0; j < 4; ++j) { const f32x4 v = src[64 * j] * g; u32x2 w; w[0] = cvt_pk_bf16(v[0], v[1]); w[1] = cvt_pk_bf16(v[2], v[3]); dst[64 * j] = w; } }
        for (int m = gw; m < M; m += NGW) cvt_row(x_in + (size_t)m * D, XB + (size_t)m * D, SS0 + (size_t)m * 16, lane);
        for (int m = gw; m < MM; m += NGW) cvt_row(mem_in + (size_t)m * D, MB + (size_t)m * D, SSM + (size_t)m * 16, lane);
        for (int i = gw * 64 + lane; i < NBAT * 16 * 256; i += NGW * 64) KM[i] = 0.f;
    }
    SEAM(0);

    if (IN(1)) {
        { SchedStd S; S.o.init(M, 2 * DFF, G, bx); S.A = (const char*)XB; S.B = (const char*)Wgu1; S.a_tile = (size_t)256 * D * 2; S.b_tile = (size_t)256 * D * 2; S.b_batch = 0; S.ocol_mul = 128;
          EpiGU E{HB, SS0}; pg8::gemm_phase<EpiGU, SchedStd, true>(lds, D, D, D / 64, S, E); }
        { SchedStd S; S.o.init(MM, 2 * D, G, (bx + G / 2) % G); S.A = (const char*)MB; S.B = (const char*)Wckv; S.a_tile = (size_t)256 * D * 2; S.b_tile = (size_t)256 * D * 2; S.b_batch = 0; S.ocol_mul = 256;
          EpiStore E{KVC, 2 * D, SSM, nullptr}; pg8::gemm_phase<EpiStore, SchedStd, true>(lds, D, D, D / 64, S, E); }
    }
    SEAM(1);

    if (IN(2)) {
        SchedStd S; S.o.init(M, D, G, bx); S.A = (const char*)HB; S.B = (const char*)Wd1; S.a_tile = (size_t)256 * DFF * 2; S.b_tile = (size_t)256 * DFF * 2; S.b_batch = 0; S.ocol_mul = 256;
        EpiRes E{x_in, out, XB, SS1, 0.5f}; pg8::gemm_phase<EpiRes, SchedStd, true>(lds, DFF, DFF, DFF / 64, S, E);
    }
    SEAM(2);

    if (IN(3)) {
        { SchedStd S; S.o.init(M, NQKV, G, bx); S.A = (const char*)XB; S.B = (const char*)Win; S.a_tile = (size_t)256 * D * 2; S.b_tile = (size_t)256 * D * 2; S.b_batch = 0; S.ocol_mul = 256;
          EpiStore E{QKV, NQKV, SS1, KM}; pg8::gemm_phase<EpiStore, SchedStd, true>(lds, D, D, D / 64, S, E); }
        { SchedWK S{G, bx, (const char*)KVC, (const char*)Wcqs}; EpiStore E{WKT, D, nullptr, nullptr}; pg8::gemm_phase<EpiStore, SchedWK, true>(lds, 2 * D, D, 4, S, E); }
        { SchedVW S{G, (bx + G / 2) % G, (const char*)KVC, (const char*)Wco}; EpiStore E{VWT, D, nullptr, nullptr}; pg8::gemm_phase<EpiStore, SchedVW, true>(lds, D, 2 * D, 4, S, E); }
    }
    SEAM(3);

    if (IN(4)) {
        LAS float* tabA = (LAS float*)(lds + LDS_TABA); LAS float* tabB = (LAS float*)(lds + LDS_TABB);
        for (int i = tid; i < 36 * att::TABA_N; i += NWAVES * 64) { const int t = i / att::TABA_N, e = i % att::TABA_N, p = t / 12, h = t % 12, delta = e - 32, d = p == 0 ? 1 : (p == 1 ? 4 : 16);
            tabA[i] = (delta >= 0 && delta <= 128) ? rel_bias[att::rel_bucket(delta * d) * 16 + h] * LOG2E : -INFINITY; }
        for (int i = tid; i < 4 * att::TABB_N; i += NWAVES * 64) { const int hb = i / att::TABB_N, e = i % att::TABB_N, dist = e - 32;
            tabB[i] = dist >= 0 ? rel_bias[att::rel_bucket(dist) * 16 + 12 + hb] * LOG2E : -INFINITY; }
        __syncthreads();
        LAS char* kv = (LAS char*)(lds + wave * 8192);
        const int h2 = lane >> 5, q = lane & 31;
        const long rowb = (long)NQKV * 2;
        constexpr int NMOBA = NBAT * 4 * 16;
        for (int j = vcu; j < NMOBA / 2; j += G)
#pragma unroll 1
            for (int half = 0; half < 2; ++half) {
                const int it = half ? (NMOBA - 1 - j) : j; const int qb = 15 - it / (NBAT * 4), bh = it % (NBAT * 4), b = bh >> 2, hb = bh & 3;
                const int q0 = qb * 256 + wave * 32;
                const char* base = (const char*)QKV + (size_t)b * SEQ * rowb;
                const char* qbase = base + (size_t)q0 * rowb + (2304 + hb * 64) * 2;
                const char* kbase = base + (2560 + hb * 64) * 2;
                const unsigned sel = att::moba_select(qbase, rowb, KM + (size_t)b * 16 * 256 + hb * 64, qb);
                att::f32x16 o[2]; float mo, lo_;
                att::attn_wave<true>(qbase, rowb, kbase, rowb, 256 * 2, q0, 0, kv, tabB + hb * att::TABB_N, sel, qb, o, mo, lo_);
                att::store_o(o, lo_, (char*)OB + ((size_t)(b * SEQ + q0 + q) * 256 + hb * 64) * 2, h2);
            }
        constexpr int NDIL = NBAT * 12 * 48;
#pragma unroll 1
        for (int it = vcu; it < NDIL; it += G) {
            const int bh = it / 48, j = it % 48, b = bh / 12, h = bh % 12, p = j >> 4, jj = j & 15;
            const int d = p == 0 ? 1 : (p == 1 ? 4 : 16);
            const int res = p == 0 ? 0 : (p == 1 ? (jj & 3) : jj), mblk = p == 0 ? jj : (p == 1 ? (jj >> 2) : 0);
            const int m0 = mblk * 256 + wave * 32;
            const char* base = (const char*)QKV + ((size_t)b * SEQ + res) * rowb;
            const long st = (long)d * rowb;
            const char* qbase = base + (long)m0 * st + (h * 64) * 2;
            const char* kbase = base + (768 + h * 64) * 2;
            att::f32x16 o[2]; float mo, lo_;
            att::attn_wave<false>(qbase, st, kbase, st, 768 * 2, m0, (m0 - 128) > 0 ? (m0 - 128) : 0, kv, tabA + (p * 12 + h) * att::TABA_N, 0u, 0, o, mo, lo_);
            const size_t tok = (size_t)b * SEQ + (size_t)(m0 + q) * d + res;
            att::store_o(o, lo_, (char*)OA + (((size_t)p * M + tok) * 768 + h * 64) * 2, h2);
            if (h2 == 0) *(f32x2*)(ML + (((size_t)p * M + tok) * 12 + h) * 2) = (f32x2){mo, lo_};
        }
    }
    SEAM(4);

    if (IN(5)) {
        for (int row = gw; row < M; row += NGW) {
            float va[3][4]; float ssa = 0.f;
#pragma unroll
            for (int k = 0; k < 3; ++k) { const int col = 256 * k + 4 * lane, hd = col >> 6;
                const f32x2 ml0 = *(const f32x2*)(ML + (((size_t)0 * M + row) * 12 + hd) * 2), ml1 = *(const f32x2*)(ML + (((size_t)1 * M + row) * 12 + hd) * 2), ml2 = *(const f32x2*)(ML + (((size_t)2 * M + row) * 12 + hd) * 2);
                const float Mx = fmaxf(ml0[0], fmaxf(ml1[0], ml2[0]));
                const float w0 = ml0[1] * __builtin_amdgcn_exp2f(ml0[0] - Mx), w1 = ml1[1] * __builtin_amdgcn_exp2f(ml1[0] - Mx), w2 = ml2[1] * __builtin_amdgcn_exp2f(ml2[0] - Mx);
                const float iw = 1.0f / (w0 + w1 + w2);
                const u32x2 o0 = *(const u32x2*)(OA + ((size_t)0 * M + row) * 768 + col), o1 = *(const u32x2*)(OA + ((size_t)1 * M + row) * 768 + col), o2 = *(const u32x2*)(OA + ((size_t)2 * M + row) * 768 + col);
#pragma unroll
                for (int e = 0; e < 4; ++e) { const unsigned s0 = o0[e >> 1], s1 = o1[e >> 1], s2 = o2[e >> 1];
                    const float f0 = __builtin_bit_cast(float, (e & 1) ? (s0 & 0xffff0000u) : (s0 << 16)), f1 = __builtin_bit_cast(float, (e & 1) ? (s1 & 0xffff0000u) : (s1 << 16)), f2 = __builtin_bit_cast(float, (e & 1) ? (s2 & 0xffff0000u) : (s2 << 16));
                    const float v = (w0 * f0 + w1 * f1 + w2 * f2) * iw; va[k][e] = v; ssa += v * v; } }
            const u32x2 ob = *(const u32x2*)(OB + (size_t)row * 256 + 4 * lane); float vb[4]; float ssb = 0.f;
#pragma unroll
            for (int e = 0; e < 4; ++e) { const unsigned s0 = ob[e >> 1]; vb[e] = __builtin_bit_cast(float, (e & 1) ? (s0 & 0xffff0000u) : (s0 << 16)); ssb += vb[e] * vb[e]; }
            ssa = wave_sum(ssa); ssb = wave_sum(ssb);
            const float ra = 1.0f / sqrtf(ssa * (1.0f / 768.0f) + EPS), rb = 1.0f / sqrtf(ssb * (1.0f / 256.0f) + EPS);
#pragma unroll
            for (int k = 0; k < 3; ++k) { u32x2 w; w[0] = cvt_pk_bf16(va[k][0] * ra, va[k][1] * ra); w[1] = cvt_pk_bf16(va[k][2] * ra, va[k][3] * ra); *(u32x2*)(YN + (size_t)row * D + 256 * k + 4 * lane) = w; }
            { u32x2 w; w[0] = cvt_pk_bf16(vb[0] * rb, vb[1] * rb); w[1] = cvt_pk_bf16(vb[2] * rb, vb[3] * rb); *(u32x2*)(YN + (size_t)row * D + 768 + 4 * lane) = w; }
        }
    }
    SEAM(5);

    if (IN(6)) {
        SchedStd S; S.o.init(M, D, G, bx); S.A = (const char*)YN; S.B = (const char*)Wout; S.a_tile = (size_t)256 * D * 2; S.b_tile = (size_t)256 * D * 2; S.b_batch = 0; S.ocol_mul = 256;
        EpiRes E{out, out, XB, SS2, 1.0f}; pg8::gemm_phase<EpiRes, SchedStd, true>(lds, D, D, D / 64, S, E);
    }
    SEAM(6);

    if (IN(7)) {
        SchedStd S; S.o.init(M, D, G, bx); S.A = (const char*)XB; S.B = (const char*)WKT; S.a_tile = (size_t)256 * D * 2; S.b_tile = (size_t)256 * D * 2; S.b_batch = (size_t)D * D * 2; S.ocol_mul = 256;
        EpiSoftmax E{PB, SS2}; pg8::gemm_phase<EpiSoftmax, SchedStd, true>(lds, D, D, D / 64, S, E);
    }
    SEAM(7);

    if (IN(8)) {
        SchedStd S; S.o.init(M, D, G, bx); S.A = (const char*)PB; S.B = (const char*)VWT; S.a_tile = (size_t)256 * D * 2; S.b_tile = (size_t)256 * D * 2; S.b_batch = (size_t)D * D * 2; S.ocol_mul = 256;
        EpiRes E{out, out, XB, SS3, 1.0f}; pg8::gemm_phase<EpiRes, SchedStd, true>(lds, D, D, D / 64, S, E);
    }
    SEAM(8);

    if (IN(9)) {
        SchedStd S; S.o.init(M, 2 * DFF, G, bx); S.A = (const char*)XB; S.B = (const char*)Wgu2; S.a_tile = (size_t)256 * D * 2; S.b_tile = (size_t)256 * D * 2; S.b_batch = 0; S.ocol_mul = 128;
        EpiGU E{HB, SS3}; pg8::gemm_phase<EpiGU, SchedStd, true>(lds, D, D, D / 64, S, E);
    }
    SEAM(9);

    if (IN(10)) {
        SchedStd S; S.o.init(M, D, G, bx); S.A = (const char*)HB; S.B = (const char*)Wd2; S.a_tile = (size_t)256 * DFF * 2; S.b_tile = (size_t)256 * DFF * 2; S.b_batch = 0; S.ocol_mul = 256;
        EpiRes E{out, out, nullptr, SS4, 0.5f}; pg8::gemm_phase<EpiRes, SchedStd, true>(lds, DFF, DFF, DFF / 64, S, E);
    }
    SEAM(10);

    if (IN(11)) {
        const float* gf = args.in[19];
        for (int row = gw; row < M; row += NGW) { const float rs = row_rstd(SS4, row); f32x4* xr = (f32x4*)(out + (size_t)row * D) + lane; const f32x4* gr = (const f32x4*)gf + lane;
#pragma unroll
            for (int j = 0; j < 4; ++j) xr[64 * j] = xr[64 * j] * rs * gr[64 * j]; }
    }
#undef IN
#undef SEAM
}
}

#if MK_DEBUG
namespace dbg {
__global__ void __launch_bounds__(256) cmp_f32(const float* a, const float* r, size_t n, float* acc) {
    float num = 0.f, den = 0.f;
    for (size_t i = (size_t)blockIdx.x * 256 + threadIdx.x; i < n; i += (size_t)gridDim.x * 256) { const float d = a[i] - r[i]; num += d * d; den += r[i] * r[i]; }
    for (int o = 32; o > 0; o >>= 1) { num += __shfl_xor(num, o); den += __shfl_xor(den, o); }
    if ((threadIdx.x & 63) == 0) { atomicAdd(acc, num); atomicAdd(acc + 1, den); }
}
__global__ void __launch_bounds__(256) cmp_bf16(const unsigned short* a, int lda, const float* colscale, const float* r, int ldr, int rows, int cols, float* acc) {
    float num = 0.f, den = 0.f; const size_t n = (size_t)rows * cols;
    for (size_t i = (size_t)blockIdx.x * 256 + threadIdx.x; i < n; i += (size_t)gridDim.x * 256) { const size_t row = i / cols; const int c = (int)(i % cols);
        const float av = __builtin_bit_cast(float, (unsigned)a[row * lda + c] << 16) * (colscale ? colscale[c] : 1.0f); const float rv = r[row * ldr + c]; const float d = av - rv; num += d * d; den += rv * rv; }
    for (int o = 32; o > 0; o >>= 1) { num += __shfl_xor(num, o); den += __shfl_xor(den, o); }
    if ((threadIdx.x & 63) == 0) { atomicAdd(acc, num); atomicAdd(acc + 1, den); }
}
__global__ void __launch_bounds__(256) cmp_p(const unsigned short* a, const float* r, float* acc) {
    float num = 0.f, den = 0.f; const size_t n = (size_t)4096 * 1024;
    for (size_t i = (size_t)blockIdx.x * 256 + threadIdx.x; i < n; i += (size_t)gridDim.x * 256) { const size_t row = i / 1024; const int c = (int)(i % 1024);
        const float av = __builtin_bit_cast(float, (unsigned)a[i] << 16); const float rv = r[(size_t)(c >> 8) * 4096 * 256 + row * 256 + (c & 255)]; const float d = av - rv; num += d * d; den += rv * rv; }
    for (int o = 32; o > 0; o >>= 1) { num += __shfl_xor(num, o); den += __shfl_xor(den, o); }
    if ((threadIdx.x & 63) == 0) { atomicAdd(acc, num); atomicAdd(acc + 1, den); }
}
__global__ void build_scales(float* qkvs, float* gcat, const float* goa, const float* gob) {
    const int i = blockIdx.x * 256 + threadIdx.x;
    if (i < 3072) qkvs[i] = ((i < 768) || (i >= 2304 && i < 2560)) ? 8.0f : 1.0f;
    if (i < 1024) gcat[i] = i < 768 ? goa[i] : gob[i - 768];
}
constexpr int NST = 8;
__global__ void __launch_bounds__(256) finalize(float* out, size_t n, const float* acc, int report) {
    const float tol[NST] = {0.03f, 0.03f, 0.03f, 0.08f, 0.03f, 0.05f, 0.03f, 0.03f};
    float E = 0.f;
    if (report > 0) { const float e = sqrtf(acc[2 * (report - 1)] / acc[2 * (report - 1) + 1]); E = (e == e) ? fminf(e, 3.0f) : 3.0f; }
    else { for (int k = NST - 1; k >= 0; --k) { const float e = sqrtf(acc[2 * k] / acc[2 * k + 1]); if (!(e <= tol[k])) E = 0.1f * (k + 1); } }
    for (size_t i = (size_t)blockIdx.x * 256 + threadIdx.x; i < n; i += (size_t)gridDim.x * 256) out[i] *= (1.0f + E);
}
}
#endif

static void mk_launch(const mk::Args& a0, int lo, int hi, int grid, hipStream_t st) {
    mk::Args a = a0; a.ph_lo = lo; a.ph_hi = hi;
    hipLaunchKernelGGL(mk::mk_fwd, dim3(grid), dim3(mk::NWAVES * 64), mk::LDS_BYTES, st, a);
    const hipError_t le = hipPeekAtLastError();
    if (le != hipSuccess) fprintf(stderr, "kernel_launch: launch of phases [%d,%d) failed: %s\n", lo, hi, hipGetErrorName(le));
}

extern "C" void kernel_launch(void* const* d_in, const int* in_sizes, int n_in, void* d_out, int out_size, void* d_ws, size_t ws_size, hipStream_t stream) {
    static int grid = 0;
    if (grid == 0) {
        if (n_in != 20 || out_size != 8 * 4096 * 1024) { fprintf(stderr, "kernel_launch: unexpected shapes (n_in %d out %d)\n", n_in, out_size); grid = -1; return; }
        int dev = 0, cus = 0, per_cu = 0;
        if (hipGetDevice(&dev) != hipSuccess || hipDeviceGetAttribute(&cus, hipDeviceAttributeMultiprocessorCount, dev) != hipSuccess) { grid = -1; return; }
        if (hipFuncSetAttribute((const void*)mk::mk_fwd, hipFuncAttributeMaxDynamicSharedMemorySize, mk::LDS_BYTES) != hipSuccess) { fprintf(stderr, "kernel_launch: hipFuncSetAttribute failed\n"); grid = -1; return; }
        if (hipOccupancyMaxActiveBlocksPerMultiprocessor(&per_cu, (const void*)mk::mk_fwd, mk::NWAVES * 64, mk::LDS_BYTES) != hipSuccess || per_cu < 1) fprintf(stderr, "kernel_launch: occupancy query reports %d workgroups per CU\n", per_cu);
        (void)hipGetLastError();
        grid = cus;
    }
    if (grid < 0) return;
    unsigned char* ws = (unsigned char*)d_ws;
#if MK_DEBUG
    const size_t ref_off = (mk::WS_END + 4095) / 4096 * 4096;
    size_t off = ref_off + (size_t)290 * 1024 * 1024;
    auto take = [&](size_t bytes) { unsigned char* p = ws + off; off += (bytes + 255) / 256 * 256; return p; };
    float* sx1 = (float*)take((size_t)4096 * 1024 * 4); float* sx2 = (float*)take((size_t)4096 * 1024 * 4); float* sx3 = (float*)take((size_t)4096 * 1024 * 4);
    float* mkout = (float*)take((size_t)4096 * 1024 * 4); float* qkvs = (float*)take(3072 * 4); float* gcat = (float*)take(1024 * 4); float* acc = (float*)take(256);
    if (off > ws_size) { fprintf(stderr, "kernel_launch: debug build needs %zu bytes of workspace, got %zu\n", off, ws_size); return; }
    ref::Snap snap{sx1, sx2, sx3};
    ref::forward(d_in, (float*)d_out, ws + ref_off, stream, &snap);
    (void)hipMemsetAsync(ws + mk::WS_CTL, 0, mk::CTL_BYTES, stream);
    (void)hipMemsetAsync(acc, 0, 256, stream);
    dbg::build_scales<<<12, 256, 0, stream>>>(qkvs, gcat, (const float*)d_in[8], (const float*)d_in[9]);
    mk::Args a{};
    for (int i = 0; i < 20; ++i) a.in[i] = (const float*)d_in[i];
    a.in[0] = (const float*)d_in[0] + (size_t)7 * 4096 * 1024; a.in[1] = (const float*)d_in[1] + (size_t)7 * 256 * 1024;
    a.out = mkout; a.ws = ws;
    const ref::Bufs& rb = ref::g_bufs;
    for (int ph = 0; ph < mk::NPH; ++ph) {
        mk_launch(a, ph, ph + 1, grid, stream);
        if (ph == 1) dbg::cmp_bf16<<<512, 256, 0, stream>>>((const unsigned short*)(ws + mk::WS_KVC), 2048, nullptr, rb.kvc, 2048, 256, 2048, acc + 0);
        if (ph == 2) dbg::cmp_f32<<<512, 256, 0, stream>>>(mkout, sx1, (size_t)4096 * 1024, acc + 2);
        if (ph == 3) dbg::cmp_bf16<<<512, 256, 0, stream>>>((const unsigned short*)(ws + mk::WS_R1), 3072, qkvs, rb.proj, 3072, 4096, 3072, acc + 4);
        if (ph == 5) dbg::cmp_bf16<<<512, 256, 0, stream>>>((const unsigned short*)(ws + mk::WS_R1), 1024, gcat, rb.yn, 1024, 4096, 1024, acc + 6);
        if (ph == 6) dbg::cmp_f32<<<512, 256, 0, stream>>>(mkout, sx2, (size_t)4096 * 1024, acc + 8);
        if (ph == 7) dbg::cmp_p<<<512, 256, 0, stream>>>((const unsigned short*)(ws + mk::WS_R1), rb.sc, acc + 10);
        if (ph == 8) dbg::cmp_f32<<<512, 256, 0, stream>>>(mkout, sx3, (size_t)4096 * 1024, acc + 12);
        if (ph == 11) dbg::cmp_f32<<<512, 256, 0, stream>>>(mkout, (const float*)d_out + (size_t)7 * 4096 * 1024, (size_t)4096 * 1024, acc + 14);
    }
    dbg::finalize<<<1024, 256, 0, stream>>>((float*)d_out, (size_t)8 * 4096 * 1024, acc, MK_REPORT);
#else
    if (ws_size < mk::WS_END) { fprintf(stderr, "kernel_launch: needs %zu bytes of workspace, got %zu\n", (size_t)mk::WS_END, ws_size); return; }
    if (hipMemsetAsync(ws + mk::WS_CTL, 0, mk::CTL_BYTES, stream) != hipSuccess) return;
    mk::Args a{};
    for (int i = 0; i < 20; ++i) a.in[i] = (const float*)d_in[i];
    a.out = (float*)d_out; a.ws = ws;
#if MK_N_LAUNCHES == 1
    mk_launch(a, 0, mk::NPH, grid, stream);
#else
    for (int ph = 0; ph < mk::NPH; ++ph) mk_launch(a, ph, ph + 1, grid, stream);
#endif
#endif
}
```

```cpp
#include <hip/hip_runtime.h>
#include <cstdio>
#include <cstdint>
#include <cmath>
#define MK_DEBUG 0
#define MK_REPORT 0
#define MK_N_LAUNCHES 1
#define MK_NBAT 8

namespace pg8 {
#define PG8_LAS __attribute__((address_space(3)))
typedef unsigned short bf16_t;
typedef short bf16x8 __attribute__((ext_vector_type(8)));
typedef float f32x4 __attribute__((ext_vector_type(4)));
typedef float f32x2 __attribute__((ext_vector_type(2)));
typedef unsigned u32x4 __attribute__((ext_vector_type(4)));
typedef unsigned u32x2 __attribute__((ext_vector_type(2)));
constexpr int BM = 256, BK = 64, HALF = 128, HTB = HALF * BK * 2  , STAGE_BYTES = 8 * HTB, NXCD = 8, WGM = 8;

__host__ __device__ __forceinline__ int lds_byte(int r, int c) { const int st = (r >> 4) * 2 + (c >> 5), rr = r & 15, cc = c & 31, ob = rr * 64 + cc * 2; return st * 1024 + (ob ^ (((ob >> 9) & 1) << 5)); }
__host__ __device__ __forceinline__ void stage_rc(int b, int& R, int& C) { const int st = b / 1024, sb = b % 1024, swz = sb ^ (((sb >> 9) & 1) << 5); R = (st >> 1) * 16 + swz / 64; C = (st & 1) * 32 + (swz % 64) / 2; }
__host__ __device__ __forceinline__ int perm32(int rho) { const int n = rho >> 4, i = rho & 15; return 8 * (i >> 2) + 4 * n + (i & 3); }

struct Unit { const char* a; const char* b; int orow, ocol, aux; };

struct Order {
    int nM, nN, nwg, G, c;
    __device__ __forceinline__ void init(int M, int N, int G_, int c_) { nM = M / BM; nN = N / BM; nwg = nM * nN; G = G_; c = c_; }
    __device__ __forceinline__ bool tile(int i, int& pm, int& pn) const {
        const long L = (long)i * G + c; if (L >= nwg) return false;
        int wgid = (int)L; { const int q = nwg / NXCD, r = nwg % NXCD, xcd = wgid % NXCD, off = wgid / NXCD; wgid = (xcd < r ? xcd * (q + 1) : r * (q + 1) + (xcd - r) * q) + off; }
        const int nig = WGM * nN, gid = wgid / nig, fm = gid * WGM, gsz = (nM - fm) < WGM ? (nM - fm) : WGM;
        pm = fm + ((wgid % nig) % gsz); pn = (wgid % nig) / gsz; return true;
    }
};

__device__ __forceinline__ unsigned cvt_pk_bf16(float lo, float hi) { unsigned r; asm volatile("v_cvt_pk_bf16_f32 %0, %1, %2" : "=v"(r) : "v"(lo), "v"(hi)); return r; }

template <class Epi, class Sched, bool ALIGN_EPI>
__device__ __forceinline__ void gemm_phase(PG8_LAS unsigned char* lds, const int lda, const int ldb, const int nt, const Sched& S, const Epi& E) {
    int tid_ = threadIdx.x; asm volatile("" : "+v"(tid_));
    const int tid = tid_, wid = __builtin_amdgcn_readfirstlane(tid >> 6), lane = tid & 63, wr = wid >> 2, wc = wid & 3, fr = lane & 15, fq = lane >> 4;
    unsigned voffA[2], voffB[2];
#pragma unroll
    for (int i = 0; i < 2; ++i) { int R, C; stage_rc(tid * 16 + i * 8192, R, C); const int Rb = Epi::PERM ? ((R & ~31) + perm32(R & 31)) : R;
        voffA[i] = (unsigned)(R * lda + C) * 2u; voffB[i] = (unsigned)(Rb * ldb + C) * 2u; }
    const size_t kstep = (size_t)(BK * 2);
    const size_t hstepA = (size_t)HALF * lda * 2, hstepB = (size_t)HALF * ldb * 2;
    const unsigned ldsw = (unsigned)wid * 1024u;
    const int aoff = lds_byte(wr * 64 + fr, fq * 8), boff = lds_byte(wc * 32 + fr, fq * 8);
#define PG8_SA(b, h) (((b) * 2 + (h)) * HTB)
#define PG8_SB(b, h) ((4 + (b) * 2 + (h)) * HTB)
#define PG8_STAGE(bufoff, gbase, voff) do { _Pragma("unroll") for (int _i = 0; _i < 2; ++_i) \
        __builtin_amdgcn_global_load_lds((const unsigned*)((const char*)(gbase) + (voff)[_i]), (PG8_LAS unsigned*)(lds + (bufoff) + ldsw + _i * 8192), 16, 0, 0); } while (0)
#define PG8_LDA(dst, b, h) do { _Pragma("unroll") for (int m = 0; m < 4; ++m) _Pragma("unroll") for (int k = 0; k < 2; ++k) dst[m][k] = *(const PG8_LAS bf16x8*)(lds + PG8_SA(b, h) + aoff + m * 2048 + k * 1024); } while (0)
#define PG8_LDB(dst, b, h) do { _Pragma("unroll") for (int n = 0; n < 2; ++n) _Pragma("unroll") for (int k = 0; k < 2; ++k) dst[n][k] = *(const PG8_LAS bf16x8*)(lds + PG8_SB(b, h) + boff + n * 2048 + k * 1024); } while (0)
#define PG8_MMA(ai, bj, At, Bt) do { __builtin_amdgcn_s_setprio(1); _Pragma("unroll") for (int m = 0; m < 4; ++m) _Pragma("unroll") for (int n = 0; n < 2; ++n) _Pragma("unroll") for (int k = 0; k < 2; ++k) \
        acc[ai][bj][m][n] = __builtin_amdgcn_mfma_f32_16x16x32_bf16(Bt[n][k], At[m][k], acc[ai][bj][m][n], 0, 0, 0); __builtin_amdgcn_s_setprio(0); } while (0)
#define PG8_WAIT_V(n) asm volatile("s_waitcnt vmcnt(" #n ")" ::: "memory")
#define PG8_WAIT_L(n) asm volatile("s_waitcnt lgkmcnt(" #n ")" ::: "memory")
#define PG8_BAR __builtin_amdgcn_s_barrier()
#define PG8_SCHED __builtin_amdgcn_sched_barrier(0)
    Unit cur, nxt; int ui = 0;
    if (!S.next(0, cur)) return;
    f32x4 acc[2][2][4][2];
#pragma unroll
    for (int a = 0; a < 2; ++a)
#pragma unroll
        for (int b = 0; b < 2; ++b)
#pragma unroll
            for (int m = 0; m < 4; ++m)
#pragma unroll
                for (int n = 0; n < 2; ++n) acc[a][b][m][n] = (f32x4){0.f, 0.f, 0.f, 0.f};
    bf16x8 At[4][2], B0[2][2], B1[2][2];
    const char* cA = cur.a; const char* cB = cur.b;
    PG8_STAGE(PG8_SB(0, 0), cB, voffB); PG8_STAGE(PG8_SB(0, 1), cB + hstepB, voffB); PG8_STAGE(PG8_SA(0, 0), cA, voffA); PG8_STAGE(PG8_SA(0, 1), cA + hstepA, voffA);
    if (wr == 1) PG8_BAR;
    PG8_WAIT_V(2); PG8_BAR;
    PG8_STAGE(PG8_SB(1, 0), cB + kstep, voffB); PG8_STAGE(PG8_SA(1, 0), cA + kstep, voffA); PG8_STAGE(PG8_SB(1, 1), cB + hstepB + kstep, voffB);
    PG8_WAIT_V(6); PG8_BAR;
    for (;;) {
        const bool has_next = S.next(ui + 1, nxt);
        const char* nA = has_next ? nxt.a : cA; const char* nB = has_next ? nxt.b : cB;
#pragma unroll 1
        for (int t = 0; t < nt; t += 2) {
            const bool last = (t == nt - 2);
            const char* a1 = cA + (size_t)(t + 1) * kstep;
            const char* a2 = last ? nA : cA + (size_t)(t + 2) * kstep; const char* b2 = last ? nB : cB + (size_t)(t + 2) * kstep;
            const char* a3 = a2 + kstep; const char* b3 = b2 + kstep;
            PG8_LDB(B0, 0, 0); PG8_LDB(B1, 0, 1); PG8_SCHED; PG8_LDA(At, 0, 0); PG8_STAGE(PG8_SA(1, 1), a1 + hstepA, voffA);
            PG8_WAIT_V(8); PG8_WAIT_L(0); PG8_BAR; PG8_MMA(0, 0, At, B0); PG8_MMA(0, 1, At, B1); PG8_BAR; PG8_SCHED;
            PG8_LDA(At, 0, 1); PG8_STAGE(PG8_SB(0, 0), b2, voffB); PG8_STAGE(PG8_SB(0, 1), b2 + hstepB, voffB); PG8_STAGE(PG8_SA(0, 0), a2, voffA);
            PG8_WAIT_V(8); PG8_WAIT_L(0); PG8_BAR; PG8_MMA(1, 0, At, B0); PG8_MMA(1, 1, At, B1); PG8_BAR; PG8_SCHED;
            PG8_LDB(B0, 1, 0); PG8_LDB(B1, 1, 1); PG8_SCHED; PG8_LDA(At, 1, 0); PG8_STAGE(PG8_SA(0, 1), a2 + hstepA, voffA);
            PG8_WAIT_V(8); PG8_WAIT_L(0); PG8_BAR; PG8_MMA(0, 0, At, B0); PG8_MMA(0, 1, At, B1); PG8_BAR; PG8_SCHED;
            PG8_LDA(At, 1, 1); PG8_STAGE(PG8_SB(1, 0), b3, voffB); PG8_STAGE(PG8_SB(1, 1), b3 + hstepB, voffB); PG8_STAGE(PG8_SA(1, 0), a3, voffA);
            PG8_WAIT_V(8); PG8_WAIT_L(0); PG8_BAR; PG8_MMA(1, 0, At, B0); PG8_MMA(1, 1, At, B1); PG8_BAR; PG8_SCHED;
        }
        if constexpr (ALIGN_EPI) { if (wr == 0) PG8_BAR; }
        E(acc, cur, wr, wc, fr, fq, lds, wid, lane);
        if (!has_next) break;
#pragma unroll
        for (int a = 0; a < 2; ++a)
#pragma unroll
            for (int b = 0; b < 2; ++b)
#pragma unroll
                for (int m = 0; m < 4; ++m)
#pragma unroll
                    for (int n = 0; n < 2; ++n) acc[a][b][m][n] = (f32x4){0.f, 0.f, 0.f, 0.f};
        cur = nxt; cA = nA; cB = nB; ++ui;
        if constexpr (ALIGN_EPI) { if (wr == 1) PG8_BAR; }
    }
    PG8_WAIT_V(0);
    if constexpr (!ALIGN_EPI) { if (wr == 0) PG8_BAR; }
    PG8_BAR;
#undef PG8_SA
#undef PG8_SB
#undef PG8_STAGE
#undef PG8_LDA
#undef PG8_LDB
#undef PG8_MMA
#undef PG8_WAIT_V
#undef PG8_WAIT_L
#undef PG8_BAR
#undef PG8_SCHED
}
}

namespace att {
#define ATT_LAS __attribute__((address_space(3)))
typedef short bf16x8 __attribute__((ext_vector_type(8)));
typedef short v4i16 __attribute__((ext_vector_type(4)));
typedef float f32x16 __attribute__((ext_vector_type(16)));
typedef float f32x4 __attribute__((ext_vector_type(4)));
typedef unsigned u32x4 __attribute__((ext_vector_type(4)));
typedef unsigned u32x2 __attribute__((ext_vector_type(2)));
constexpr float LOG2E = 1.4426950408889634f;
constexpr int TABA_N = 192, TABB_N = 1600;

__device__ __forceinline__ int rel_bucket(int n) {
    if (n < 16) return n < 0 ? 0 : n;
    int b = 16;
    b += (n >= 22); b += (n >= 30); b += (n >= 40); b += (n >= 54); b += (n >= 73); b += (n >= 99); b += (n >= 134); b += (n >= 182);
    b += (n >= 246); b += (n >= 332); b += (n >= 450); b += (n >= 609); b += (n >= 825); b += (n >= 1117); b += (n >= 1513);
    return b;
}
__device__ __forceinline__ unsigned pk_bf16(float lo, float hi) { unsigned r; asm volatile("v_cvt_pk_bf16_f32 %0, %1, %2" : "=v"(r) : "v"(lo), "v"(hi)); return r; }
__device__ __forceinline__ float bf16_round(float x) { unsigned u = __builtin_bit_cast(unsigned, x); u = (u + 0x7fffu + ((u >> 16) & 1u)) & 0xffff0000u; return __builtin_bit_cast(float, u); }

template <bool MOBA>
__device__ __forceinline__ void attn_wave(const char* qbase, const long qs, const char* kbase, const long ks, const int voff, const int qstart, const int gend,
                                          ATT_LAS char* kv, const ATT_LAS float* tab, const unsigned selmask, const int qb, f32x16 (&o)[2], float& m_out, float& l_out) {
    const int lane = threadIdx.x & 63, q = lane & 31, h = lane >> 5;
    bf16x8 qf[4];
#pragma unroll
    for (int d0 = 0; d0 < 4; ++d0) qf[d0] = *(const bf16x8*)(qbase + (long)q * qs + (16 * d0 + 8 * h) * 2);
    bf16x8 kst[4], vst[4];
    const int srow = lane >> 3, sch = lane & 7;
    {
        const char* src = kbase + (long)(qstart + srow) * ks + sch * 16;
#pragma unroll
        for (int i = 0; i < 4; ++i) { kst[i] = *(const bf16x8*)(src + (long)(8 * i) * ks); vst[i] = *(const bf16x8*)(src + (long)(8 * i) * ks + voff); }
    }
    o[0] = f32x16{}; o[1] = f32x16{};
    float m = -INFINITY, l = 0.f;
    ATT_LAS char* kw[4]; ATT_LAS char* vw[4];
#pragma unroll
    for (int i = 0; i < 4; ++i) { const int r = 8 * i + srow; kw[i] = kv + r * 128 + 16 * (sch ^ ((r >> 1) & 7)); vw[i] = kv + 4096 + r * 128 + 16 * (sch ^ (((r >> 1) & 1) << 2)); }
    const ATT_LAS char* kr0 = kv + q * 128;
    const int kswz = (q >> 1) & 7;
    const int q4 = (lane & 15) >> 2, p4 = lane & 3, g1 = (lane >> 4) & 1;
    const int vrow0 = 4 * h + q4;
    const int vsw = (q4 >> 1) & 1;
    const ATT_LAS char* vr0 = kv + 4096 + vrow0 * 128 + 32 * g1 + 8 * p4;
    for (int g0 = qstart; g0 >= gend; g0 -= 32) {
#pragma unroll
        for (int i = 0; i < 4; ++i) { *(ATT_LAS bf16x8*)kw[i] = kst[i]; *(ATT_LAS bf16x8*)vw[i] = vst[i]; }
        asm volatile("" ::: "memory");
        if (g0 - 32 >= gend) {
            const char* src = kbase + (long)(g0 - 32 + srow) * ks + sch * 16;
#pragma unroll
            for (int i = 0; i < 4; ++i) { kst[i] = *(const bf16x8*)(src + (long)(8 * i) * ks); vst[i] = *(const bf16x8*)(src + (long)(8 * i) * ks + voff); }
        }
        f32x16 s = f32x16{};
#pragma unroll
        for (int d0 = 0; d0 < 4; ++d0) { const bf16x8 kf = *(const ATT_LAS bf16x8*)(kr0 + 16 * ((2 * d0 + h) ^ kswz)); s = __builtin_amdgcn_mfma_f32_32x32x16_bf16(kf, qf[d0], s, 0, 0, 0); }
        int B = (qstart - g0 + 32) + q - 4 * h;
        if (MOBA) { B = B < (TABB_N - 1) ? B : (TABB_N - 1); const int n = g0 >> 8; const bool sel = (n == qb) || ((selmask >> n) & 1u); B = sel ? B : 27; }
        const ATT_LAS float* tp = tab + B;
        float mx = -INFINITY;
#pragma unroll
        for (int r = 0; r < 16; ++r) { const int off = (r & 3) + 8 * (r >> 2); s[r] = fmaf(s[r], LOG2E, tp[-off]); mx = fmaxf(mx, s[r]); }
        mx = fmaxf(mx, __shfl_xor(mx, 32));
        const float mnew = fmaxf(m, mx);
        const float alpha = __builtin_amdgcn_exp2f(m - mnew);
        float ps = 0.f;
#pragma unroll
        for (int r = 0; r < 16; ++r) { s[r] = __builtin_amdgcn_exp2f(s[r] - mnew); ps += s[r]; }
        l = l * alpha + ps; m = mnew;
#pragma unroll
        for (int r = 0; r < 16; ++r) { o[0][r] *= alpha; o[1][r] *= alpha; }
        u32x4 pw0, pw1;
        pw0[0] = pk_bf16(s[0], s[1]); pw0[1] = pk_bf16(s[2], s[3]); pw0[2] = pk_bf16(s[4], s[5]); pw0[3] = pk_bf16(s[6], s[7]);
        pw1[0] = pk_bf16(s[8], s[9]); pw1[1] = pk_bf16(s[10], s[11]); pw1[2] = pk_bf16(s[12], s[13]); pw1[3] = pk_bf16(s[14], s[15]);
        const bf16x8 pb0 = __builtin_bit_cast(bf16x8, pw0), pb1 = __builtin_bit_cast(bf16x8, pw1);
#pragma unroll
        for (int dh = 0; dh < 2; ++dh) {
            const ATT_LAS char* vp = vr0 + 64 * (dh ^ vsw);
            const v4i16 a00 = __builtin_amdgcn_ds_read_tr16_b64_v4i16((ATT_LAS v4i16*)(vp));
            const v4i16 a01 = __builtin_amdgcn_ds_read_tr16_b64_v4i16((ATT_LAS v4i16*)(vp + 8 * 128));
            const v4i16 a10 = __builtin_amdgcn_ds_read_tr16_b64_v4i16((ATT_LAS v4i16*)(vp + 16 * 128));
            const v4i16 a11 = __builtin_amdgcn_ds_read_tr16_b64_v4i16((ATT_LAS v4i16*)(vp + 24 * 128));
            const bf16x8 va0 = (bf16x8){a00[0], a00[1], a00[2], a00[3], a01[0], a01[1], a01[2], a01[3]};
            const bf16x8 va1 = (bf16x8){a10[0], a10[1], a10[2], a10[3], a11[0], a11[1], a11[2], a11[3]};
            o[dh] = __builtin_amdgcn_mfma_f32_32x32x16_bf16(va0, pb0, o[dh], 0, 0, 0);
            o[dh] = __builtin_amdgcn_mfma_f32_32x32x16_bf16(va1, pb1, o[dh], 0, 0, 0);
        }
        asm volatile("" ::: "memory");
    }
    l += __shfl_xor(l, 32);
    m_out = m; l_out = l;
}

__device__ __forceinline__ void store_o(const f32x16 (&o)[2], const float l, char* orow_q, const int h) {
    const float il = 1.0f / l;
#pragma unroll
    for (int dh = 0; dh < 2; ++dh)
#pragma unroll
        for (int j = 0; j < 4; ++j) {
            u32x2 w; w[0] = pk_bf16(o[dh][4 * j] * il, o[dh][4 * j + 1] * il); w[1] = pk_bf16(o[dh][4 * j + 2] * il, o[dh][4 * j + 3] * il);
            *(u32x2*)(orow_q + (32 * dh + 8 * j + 4 * h) * 2) = w;
        }
}

__device__ __forceinline__ unsigned moba_select(const char* qbase, const long qs, const float* km, const int qb) {
    const int lane = threadIdx.x & 63, q = lane & 31, h = lane >> 5;
    f32x16 g = f32x16{};
    const float* kmrow = km + (size_t)(q & 15) * 256;
    const bool lo_part = q >= 16;
#pragma unroll
    for (int d0 = 0; d0 < 4; ++d0) {
        const bf16x8 qf = *(const bf16x8*)(qbase + (long)q * qs + (16 * d0 + 8 * h) * 2);
        const f32x4 f0 = *(const f32x4*)(kmrow + 16 * d0 + 8 * h), f1 = *(const f32x4*)(kmrow + 16 * d0 + 8 * h + 4);
        float v[8] = {f0[0], f0[1], f0[2], f0[3], f1[0], f1[1], f1[2], f1[3]};
        u32x4 aw;
#pragma unroll
        for (int j = 0; j < 4; ++j) {
            const float h0 = bf16_round(v[2 * j]), h1 = bf16_round(v[2 * j + 1]);
            const float x0 = lo_part ? (v[2 * j] - h0) : h0, x1 = lo_part ? (v[2 * j + 1] - h1) : h1;
            aw[j] = pk_bf16(x0, x1);
        }
        g = __builtin_amdgcn_mfma_f32_32x32x16_bf16(__builtin_bit_cast(bf16x8, aw), qf, g, 0, 0, 0);
    }
    float gate[8], other[8];
#pragma unroll
    for (int r = 0; r < 8; ++r) { gate[r] = g[r] + g[r + 8]; }
#pragma unroll
    for (int r = 0; r < 8; ++r) { other[r] = __shfl_xor(gate[r], 32); }
    unsigned mymask = 0u;
#pragma unroll
    for (int r = 0; r < 8; ++r) {
        const int n = (r & 3) + 8 * (r >> 2) + 4 * h;
        int rank = 0;
#pragma unroll
        for (int r2 = 0; r2 < 8; ++r2) {
            const int n2 = (r2 & 3) + 8 * (r2 >> 2) + 4 * h, n3 = (r2 & 3) + 8 * (r2 >> 2) + 4 * (1 - h);
            if (r2 != r) rank += (n2 < qb && (gate[r2] > gate[r] || (gate[r2] == gate[r] && n2 < n))) ? 1 : 0;
            rank += (n3 < qb && (other[r2] > gate[r] || (other[r2] == gate[r] && n3 < n))) ? 1 : 0;
        }
        if (n < qb && rank < 3) mymask |= 1u << n;
    }
    return mymask | (unsigned)__shfl_xor((int)mymask, 32);
}
}

namespace mk {
using pg8::bf16_t; using pg8::bf16x8; using pg8::f32x4; using pg8::f32x2; using pg8::u32x4; using pg8::u32x2; using pg8::Unit; using pg8::cvt_pk_bf16;
#define LAS __attribute__((address_space(3)))
constexpr int NBAT = MK_NBAT, SEQ = 4096, D = 1024, DFF = 2816, NMEM = 256, M = NBAT * SEQ, MM = NBAT * NMEM, NQKV = 3072;
constexpr float EPS = 1e-6f, LOG2E = 1.4426950408889634f;
constexpr int NWAVES = 8, NPH = 12;

constexpr size_t al256(size_t x) { return (x + 255) / 256 * 256; }
constexpr size_t WS_CTL = 0, CTL_BYTES = 1u << 20;
constexpr size_t WS_WGU1 = WS_CTL + CTL_BYTES;
constexpr size_t WS_WD1 = WS_WGU1 + (size_t)2 * DFF * D * 2;
constexpr size_t WS_WIN = WS_WD1 + (size_t)D * DFF * 2;
constexpr size_t WS_WOUT = WS_WIN + (size_t)NQKV * D * 2;
constexpr size_t WS_WCQS = WS_WOUT + (size_t)D * D * 2;
constexpr size_t WS_WCKV = WS_WCQS + (size_t)D * D * 2;
constexpr size_t WS_WCO = WS_WCKV + (size_t)2 * D * D * 2;
constexpr size_t WS_WGU2 = WS_WCO + (size_t)D * D * 2;
constexpr size_t WS_WD2 = WS_WGU2 + (size_t)2 * DFF * D * 2;
constexpr size_t WS_MB = WS_WD2 + (size_t)D * DFF * 2;
constexpr size_t WS_KVC = WS_MB + (size_t)MM * D * 2;
constexpr size_t WS_WKT = WS_KVC + (size_t)MM * 2 * D * 2;
constexpr size_t WS_VWT = WS_WKT + (size_t)NBAT * D * D * 2;
constexpr size_t SS_BYTES = (size_t)M * 16 * 4;
constexpr size_t WS_SS = WS_VWT + (size_t)NBAT * D * D * 2;
constexpr size_t WS_SSM = WS_SS + 5 * SS_BYTES;
constexpr size_t WS_KM = WS_SSM + (size_t)MM * 16 * 4;
constexpr size_t WS_R1 = al256(WS_KM + (size_t)NBAT * 16 * 256 * 4);
constexpr size_t WS_R2 = WS_R1 + (size_t)M * NQKV * 2;
constexpr size_t WS_OA = WS_R2, WS_OB = WS_OA + (size_t)3 * M * 768 * 2, WS_ML = WS_OB + (size_t)M * 256 * 2;
constexpr size_t WS_END = WS_ML + (size_t)3 * M * 12 * 8;
static_assert((size_t)M * D * 2 <= (size_t)3 * M * 768 * 2, "XB fits under OA");
constexpr int CW_BAR = 4096;

constexpr int LDS_XCH = 131072;
constexpr int LDS_MISC = 131072 + 8192;
constexpr int LDS_BYTES = 147456;
constexpr int LDS_TABA = 65536, LDS_TABB = LDS_TABA + 36 * att::TABA_N * 4;
static_assert(LDS_TABB + 4 * att::TABB_N * 4 <= LDS_XCH, "attention LDS map");

__device__ __forceinline__ float wave_sum(float v) {
#pragma unroll
    for (int o = 1; o < 64; o <<= 1) v += __shfl_xor(v, o);
    return v;
}
__device__ __forceinline__ float row_rstd(const float* ss, int row) {
    const f32x4* p = (const f32x4*)(ss + (size_t)row * 16);
    const f32x4 a = p[0], b = p[1], c = p[2], d = p[3];
    const float s = ((a[0] + a[1]) + (a[2] + a[3])) + ((b[0] + b[1]) + (b[2] + b[3])) + ((c[0] + c[1]) + (c[2] + c[3])) + ((d[0] + d[1]) + (d[2] + d[3]));
    return 1.0f / sqrtf(s * (1.0f / D) + EPS);
}

struct SchedStd {
    pg8::Order o; const char* A; const char* B; size_t a_tile, b_tile, b_batch; int ocol_mul;
    __device__ __forceinline__ bool next(int i, Unit& u) const { int pm, pn; if (!o.tile(i, pm, pn)) return false;
        u.a = A + (size_t)pm * a_tile; u.b = B + (size_t)pn * b_tile + (size_t)(pm >> 4) * b_batch; u.orow = pm * 256; u.ocol = pn * ocol_mul; u.aux = pn; return true; }
};
struct SchedWK {
    int G, c; const char* kvc; const char* wcqs;
    __device__ __forceinline__ bool next(int i, Unit& u) const { const int L = i * G + c; if (L >= NBAT * 16) return false; const int bh = L >> 2, pn = L & 3, b = bh >> 2, h = bh & 3;
        u.a = kvc + ((size_t)(b * 256) * 2048 + h * 256) * 2; u.b = wcqs + ((size_t)(pn * 256) * 1024 + h * 256) * 2; u.orow = b * 1024 + h * 256; u.ocol = pn * 256; u.aux = 0; return true; }
};
struct SchedVW {
    int G, c; const char* kvc; const char* wcot;
    __device__ __forceinline__ bool next(int i, Unit& u) const { const int L = i * G + c; if (L >= NBAT * 16) return false; const int bh = L >> 2, pm = L & 3, b = bh >> 2, h = bh & 3;
        u.a = wcot + ((size_t)(pm * 256) * 1024 + h * 256) * 2; u.b = kvc + ((size_t)(b * 256) * 2048 + 1024 + h * 256) * 2; u.orow = b * 1024 + pm * 256; u.ocol = h * 256; u.aux = 0; return true; }
};

struct EpiGU { static constexpr bool PERM = true;
    bf16_t* H; const float* ss;
    __device__ __forceinline__ void operator()(const f32x4 (&acc)[2][2][4][2], const Unit& u, int wr, int wc, int fr, int fq, LAS unsigned char*, int, int) const {
#pragma unroll
        for (int ai = 0; ai < 2; ++ai)
#pragma unroll
            for (int m = 0; m < 4; ++m) { const int row = u.orow + ai * 128 + wr * 64 + m * 16 + fr; const float rs = row_rstd(ss, row);
                float hv[8];
#pragma unroll
                for (int n = 0; n < 2; ++n)
#pragma unroll
                    for (int j = 0; j < 4; ++j) { const float g = acc[ai][0][m][n][j] * rs, uu = acc[ai][1][m][n][j] * rs;
                        hv[4 * n + j] = g * __builtin_amdgcn_rcpf(1.0f + __builtin_amdgcn_exp2f(-g * LOG2E)) * uu; }
                u32x4 w; w[0] = cvt_pk_bf16(hv[0], hv[1]); w[1] = cvt_pk_bf16(hv[2], hv[3]); w[2] = cvt_pk_bf16(hv[4], hv[5]); w[3] = cvt_pk_bf16(hv[6], hv[7]);
                *(u32x4*)(H + (size_t)row * DFF + u.ocol + wc * 32 + 8 * fq) = w; }
    }
};
struct EpiRes { static constexpr bool PERM = false;
    const float* base; float* out; bf16_t* xb; float* ssout; float alpha;
    __device__ __forceinline__ void operator()(const f32x4 (&acc)[2][2][4][2], const Unit& u, int wr, int wc, int fr, int fq, LAS unsigned char*, int, int) const {
#pragma unroll
        for (int ai = 0; ai < 2; ++ai)
#pragma unroll
            for (int m = 0; m < 4; ++m) { const int row = u.orow + ai * 128 + wr * 64 + m * 16 + fr; const size_t off = (size_t)row * D + u.ocol + wc * 32 + 4 * fq; float sq = 0.f;
#pragma unroll
                for (int bj = 0; bj < 2; ++bj)
#pragma unroll
                    for (int n = 0; n < 2; ++n) { const f32x4 bs = *(const f32x4*)(base + off + bj * 128 + n * 16); const f32x4 o = bs + acc[ai][bj][m][n] * alpha;
                        *(f32x4*)(out + off + bj * 128 + n * 16) = o; sq += (o[0] * o[0] + o[1] * o[1]) + (o[2] * o[2] + o[3] * o[3]);
                        if (xb) { u32x2 w; w[0] = cvt_pk_bf16(o[0], o[1]); w[1] = cvt_pk_bf16(o[2], o[3]); *(u32x2*)(xb + off + bj * 128 + n * 16) = w; } }
                sq += __shfl_xor(sq, 16); sq += __shfl_xor(sq, 32);
                if (fq == 0) ssout[(size_t)row * 16 + (u.ocol >> 8) * 4 + wc] = sq; }
    }
};
struct EpiStore { static constexpr bool PERM = true;
    bf16_t* O; int ldc; const float* ss; float* km;
    __device__ __forceinline__ void operator()(const f32x4 (&acc)[2][2][4][2], const Unit& u, int wr, int wc, int fr, int fq, LAS unsigned char*, int, int) const {
        float rsv[2][4];
#pragma unroll
        for (int ai = 0; ai < 2; ++ai)
#pragma unroll
            for (int m = 0; m < 4; ++m) { const int row = u.orow + ai * 128 + wr * 64 + m * 16 + fr; const float rs = ss ? row_rstd(ss, row) : 1.0f; rsv[ai][m] = rs;
                bf16_t* rowp = O + (size_t)row * ldc + u.ocol + wc * 32 + 8 * fq;
#pragma unroll
                for (int bj = 0; bj < 2; ++bj) { const f32x4 v0 = acc[ai][bj][m][0] * rs, v1 = acc[ai][bj][m][1] * rs;
                    u32x4 w; w[0] = cvt_pk_bf16(v0[0], v0[1]); w[1] = cvt_pk_bf16(v0[2], v0[3]); w[2] = cvt_pk_bf16(v1[0], v1[1]); w[3] = cvt_pk_bf16(v1[2], v1[3]);
                    *(u32x4*)(rowp + bj * 128) = w; } }
        if ((km != nullptr) && (u.aux == 10)) {
            float* kmb = km + (size_t)(u.orow >> 8) * 256 + wc * 32 + 8 * fq;
#pragma unroll
            for (int bj = 0; bj < 2; ++bj)
#pragma unroll
                for (int n = 0; n < 2; ++n) { f32x4 cs = (f32x4){0.f, 0.f, 0.f, 0.f};
#pragma unroll
                    for (int ai = 0; ai < 2; ++ai)
#pragma unroll
                        for (int m = 0; m < 4; ++m) cs += acc[ai][bj][m][n] * rsv[ai][m];
#pragma unroll
                    for (int j = 0; j < 4; ++j) { float v = cs[j]; v += __shfl_xor(v, 1); v += __shfl_xor(v, 2); v += __shfl_xor(v, 4); v += __shfl_xor(v, 8);
                        if (fr == 0) atomicAdd(kmb + bj * 128 + 4 * n + j, v); } }
        }
    }
};
struct EpiSoftmax { static constexpr bool PERM = true;
    bf16_t* P; const float* ss;
    __device__ __forceinline__ void operator()(const f32x4 (&acc)[2][2][4][2], const Unit& u, int wr, int wc, int fr, int fq, LAS unsigned char* lds, int, int) const {
        LAS f32x2* X = (LAS f32x2*)(lds + LDS_XCH);
        float rsl[2][4], mw[2][4];
#pragma unroll
        for (int ai = 0; ai < 2; ++ai)
#pragma unroll
            for (int m = 0; m < 4; ++m) { const int rl = ai * 128 + wr * 64 + m * 16 + fr; const float rs = row_rstd(ss, u.orow + rl) * LOG2E; rsl[ai][m] = rs;
                float mx = -INFINITY;
#pragma unroll
                for (int bj = 0; bj < 2; ++bj)
#pragma unroll
                    for (int n = 0; n < 2; ++n)
#pragma unroll
                        for (int j = 0; j < 4; ++j) mx = fmaxf(mx, acc[ai][bj][m][n][j] * rs);
                mx = fmaxf(mx, __shfl_xor(mx, 16)); mx = fmaxf(mx, __shfl_xor(mx, 32));
                float sm = 0.f;
#pragma unroll
                for (int bj = 0; bj < 2; ++bj)
#pragma unroll
                    for (int n = 0; n < 2; ++n)
#pragma unroll
                        for (int j = 0; j < 4; ++j) sm += __builtin_amdgcn_exp2f(acc[ai][bj][m][n][j] * rs - mx);
                sm += __shfl_xor(sm, 16); sm += __shfl_xor(sm, 32);
                mw[ai][m] = mx;
                if (fq == 0) X[rl * 4 + wc] = (f32x2){mx, sm}; }
        asm volatile("s_waitcnt lgkmcnt(0)" ::: "memory"); __builtin_amdgcn_s_barrier(); asm volatile("" ::: "memory");
#pragma unroll
        for (int ai = 0; ai < 2; ++ai)
#pragma unroll
            for (int m = 0; m < 4; ++m) { const int rl = ai * 128 + wr * 64 + m * 16 + fr; const float rs = rsl[ai][m];
                const f32x2 x0 = X[rl * 4 + 0], x1 = X[rl * 4 + 1], x2 = X[rl * 4 + 2], x3 = X[rl * 4 + 3];
                const float Mx = fmaxf(fmaxf(x0[0], x1[0]), fmaxf(x2[0], x3[0]));
                const float L = x0[1] * __builtin_amdgcn_exp2f(x0[0] - Mx) + x1[1] * __builtin_amdgcn_exp2f(x1[0] - Mx) + x2[1] * __builtin_amdgcn_exp2f(x2[0] - Mx) + x3[1] * __builtin_amdgcn_exp2f(x3[0] - Mx);
                const float il = 1.0f / L;
                bf16_t* rowp = P + (size_t)(u.orow + rl) * D + u.ocol + wc * 32 + 8 * fq;
#pragma unroll
                for (int bj = 0; bj < 2; ++bj) { float pv[8];
#pragma unroll
                    for (int n = 0; n < 2; ++n)
#pragma unroll
                        for (int j = 0; j < 4; ++j) pv[4 * n + j] = __builtin_amdgcn_exp2f(acc[ai][bj][m][n][j] * rs - Mx) * il;
                    u32x4 w; w[0] = cvt_pk_bf16(pv[0], pv[1]); w[1] = cvt_pk_bf16(pv[2], pv[3]); w[2] = cvt_pk_bf16(pv[4], pv[5]); w[3] = cvt_pk_bf16(pv[6], pv[7]);
                    *(u32x4*)(rowp + bj * 128) = w; } }
        (void)mw;
    }
};

#define XB_TMO      128
#define XB_XCNT(j)  (256  + 64 * (j))
#define XB_XSUB(j)  (1280 + 64 * (j))
#define XB_XGEN(j)  (2304 + 64 * (j))
#define XB_TOP      3328
#define XB_TOPGEN   3392
#define XCD_BAR_WORDS 3456
#define XB_SPIN_CAP (1u << 18)
__device__ __forceinline__ unsigned xb_ld(unsigned* p)              { return __hip_atomic_load(p, __ATOMIC_RELAXED, __HIP_MEMORY_SCOPE_AGENT); }
__device__ __forceinline__ unsigned xb_add(unsigned* p, unsigned v) { return __hip_atomic_fetch_add(p, v, __ATOMIC_RELAXED, __HIP_MEMORY_SCOPE_AGENT); }
__device__ __forceinline__ unsigned xb_xcc_id() { return (unsigned)__builtin_amdgcn_s_getreg((3 << 11) | 20) & 0xFu; }
#define XB_SPIN(cond, bar) do { unsigned _sp = 0; while (cond) { __builtin_amdgcn_s_sleep(1); \
    if ((++_sp & 255u) == 0u) { if (xb_ld(&(bar)[XB_TMO])) break; if (_sp > XB_SPIN_CAP) { atomicAdd(&(bar)[XB_TMO], 1u); break; } } } } while (0)
struct XcdBarrier { unsigned* bar; unsigned x; volatile LAS unsigned* st; };
__device__ __forceinline__ XcdBarrier xcd_barrier_post(unsigned* bar, volatile LAS unsigned* st) {
    XcdBarrier b; b.bar = bar; b.x = xb_xcc_id(); b.st = st;
    if (threadIdx.x == 0) (void)xb_add(&bar[XB_XCNT(b.x)], 1u);
    return b;
}
__device__ __forceinline__ void xcd_barrier_complete(unsigned* bar, unsigned x, unsigned& nloc, unsigned& nx) {
    const unsigned G = gridDim.x * gridDim.y * gridDim.z;
    unsigned sum, cnt, mine, sp = 0u;
    for (;;) {
        sum = 0u; cnt = 0u; mine = 0u;
#pragma unroll
        for (unsigned j = 0; j < 16; ++j) { const unsigned c = xb_ld(&bar[XB_XCNT(j)]); sum += c; cnt += (c > 0u) ? 1u : 0u; mine = (j == x) ? c : mine; }
        if (sum == G) break;
        __builtin_amdgcn_s_sleep(1);
        if ((++sp & 255u) == 0u) { if (xb_ld(&bar[XB_TMO])) break; if (sp > XB_SPIN_CAP) { atomicAdd(&bar[XB_TMO], 1u); break; } }
    }
    nloc = mine > 0u ? mine : 1u; nx = cnt > 0u ? cnt : 1u;
}
__device__ __forceinline__ void xcd_barrier(const XcdBarrier& b) {
    asm volatile("s_waitcnt vmcnt(0)" ::: "memory");
    __syncthreads();
    if (threadIdx.x == 0) {
        unsigned* bar = b.bar;
        __builtin_amdgcn_s_waitcnt(0);
        unsigned nloc = b.st[0], nx = b.st[1];
        if (nloc == 0u) { xcd_barrier_complete(bar, b.x, nloc, nx); b.st[0] = nloc; b.st[1] = nx; }
        const unsigned old = xb_add(&bar[XB_XSUB(b.x)], 1u);
        const unsigned gen = old / nloc;
        if (old + 1u == (gen + 1u) * nloc) {
            __builtin_amdgcn_fence(__ATOMIC_RELEASE, "agent");
            asm volatile("s_waitcnt vmcnt(0)" ::: "memory");
            const unsigned og = xb_add(&bar[XB_TOP], 1u);
            const unsigned tg = og / nx;
            if (og + 1u == (tg + 1u) * nx) xb_add(&bar[XB_TOPGEN], 1u);
            else XB_SPIN(xb_ld(&bar[XB_TOPGEN]) == tg, bar);
            __builtin_amdgcn_fence(__ATOMIC_ACQUIRE, "agent");
            xb_add(&bar[XB_XGEN(b.x)], 1u);
            asm volatile("s_waitcnt vmcnt(0)" ::: "memory");
        } else {
            XB_SPIN(xb_ld(&bar[XB_XGEN(b.x)]) == gen, bar);
            __builtin_amdgcn_fence(__ATOMIC_ACQUIRE, "agent");
            asm volatile("s_waitcnt vmcnt(0)" ::: "memory");
        }
    }
    __syncthreads();
}

__device__ __forceinline__ void tr_item(const float* W, int N, int k0, int n0, const float* gain, float cscale, bf16_t* dst  , int Kd, LAS float* scr, int lane) {
#pragma unroll 8
    for (int i = 0; i < 32; ++i) { const int kk = 2 * i + (lane >> 5); const float g = gain ? gain[k0 + kk] * cscale : cscale; scr[kk * 33 + (lane & 31)] = W[(size_t)(k0 + kk) * N + n0 + (lane & 31)] * g; }
    asm volatile("s_waitcnt lgkmcnt(0)" ::: "memory");
    const int c = lane & 7;
#pragma unroll
    for (int j = 0; j < 4; ++j) { const int n = (lane >> 3) + 8 * j; const LAS float* s = scr + (8 * c) * 33 + n;
        u32x4 o; o[0] = cvt_pk_bf16(s[0 * 33], s[1 * 33]); o[1] = cvt_pk_bf16(s[2 * 33], s[3 * 33]); o[2] = cvt_pk_bf16(s[4 * 33], s[5 * 33]); o[3] = cvt_pk_bf16(s[6 * 33], s[7 * 33]);
        *(u32x4*)(dst + (size_t)n * Kd + k0 + 8 * c) = o; }
    asm volatile("s_waitcnt lgkmcnt(0)" ::: "memory");
}
__device__ __forceinline__ void cvt_row(const float* xrow, bf16_t* orow, float* ssrow, int lane) {
    const f32x4* xr = (const f32x4*)xrow + lane; f32x4 v[4]; float s = 0.f;
#pragma unroll
    for (int j = 0; j < 4; ++j) { v[j] = xr[64 * j]; s += (v[j][0] * v[j][0] + v[j][1] * v[j][1]) + (v[j][2] * v[j][2] + v[j][3] * v[j][3]); }
    s = wave_sum(s);
    u32x2* o8 = (u32x2*)orow + lane;
#pragma unroll
    for (int j = 0; j < 4; ++j) { u32x2 w; w[0] = cvt_pk_bf16(v[j][0], v[j][1]); w[1] = cvt_pk_bf16(v[j][2], v[j][3]); o8[64 * j] = w; }
    if (lane < 16) ssrow[lane] = lane == 0 ? s : 0.f;
}

struct Args { const float* in[20]; float* out; unsigned char* ws; int ph_lo, ph_hi; };

__global__ void __launch_bounds__(NWAVES * 64, 2) mk_fwd(Args args) {
    extern __shared__ __attribute__((aligned(16))) unsigned char lds_raw[];
    LAS unsigned char* lds = (LAS unsigned char*)lds_raw;
    const int tid = threadIdx.x, lane = tid & 63, wave = __builtin_amdgcn_readfirstlane(tid >> 6);
    const int G = gridDim.x, bx = blockIdx.x;
    const int vcu = (G % 8 == 0) ? (bx % 8) * (G / 8) + bx / 8 : bx;
    const int gw = vcu * NWAVES + wave, NGW = G * NWAVES;
    unsigned char* ws = args.ws;
    const float* x_in = args.in[0]; const float* mem_in = args.in[1]; const float* rel_bias = args.in[7];
    float* out = args.out;
    bf16_t* Wgu1 = (bf16_t*)(ws + WS_WGU1); bf16_t* Wd1 = (bf16_t*)(ws + WS_WD1); bf16_t* Win = (bf16_t*)(ws + WS_WIN); bf16_t* Wout = (bf16_t*)(ws + WS_WOUT);
    bf16_t* Wcqs = (bf16_t*)(ws + WS_WCQS); bf16_t* Wckv = (bf16_t*)(ws + WS_WCKV); bf16_t* Wco = (bf16_t*)(ws + WS_WCO); bf16_t* Wgu2 = (bf16_t*)(ws + WS_WGU2); bf16_t* Wd2 = (bf16_t*)(ws + WS_WD2);
    bf16_t* MB = (bf16_t*)(ws + WS_MB); bf16_t* KVC = (bf16_t*)(ws + WS_KVC); bf16_t* WKT = (bf16_t*)(ws + WS_WKT); bf16_t* VWT = (bf16_t*)(ws + WS_VWT);
    float* SS0 = (float*)(ws + WS_SS); float* SS1 = SS0 + (size_t)M * 16; float* SS2 = SS1 + (size_t)M * 16; float* SS3 = SS2 + (size_t)M * 16; float* SS4 = SS3 + (size_t)M * 16;
    float* SSM = (float*)(ws + WS_SSM); float* KM = (float*)(ws + WS_KM);
    bf16_t* HB = (bf16_t*)(ws + WS_R1); bf16_t* QKV = HB; bf16_t* YN = HB; bf16_t* PB = HB;
    bf16_t* XB = (bf16_t*)(ws + WS_R2); bf16_t* OA = (bf16_t*)(ws + WS_OA); bf16_t* OB = (bf16_t*)(ws + WS_OB); float* ML = (float*)(ws + WS_ML);

    volatile LAS unsigned* MISC = (volatile LAS unsigned*)(lds + LDS_MISC);
    if (tid < 32) MISC[tid] = 0u;
    __syncthreads();
    const int lo = args.ph_lo, hi = args.ph_hi;
    const bool use_bar = (hi - lo) > 1;
    XcdBarrier bar; bar.bar = (unsigned*)(ws + WS_CTL) + CW_BAR; bar.x = 0; bar.st = nullptr;
    if (use_bar) bar = xcd_barrier_post((unsigned*)(ws + WS_CTL) + CW_BAR, MISC + 8);
#define IN(k) (lo <= (k) && (k) < hi)
#define SEAM(k) do { if (IN(k) && IN((k) + 1)) xcd_barrier(bar); } while (0)

    if (IN(0)) {
        LAS float* scr = (LAS float*)(lds + wave * 16384);
        constexpr int I_GU = (D / 64) * (2 * DFF / 32), I_DN = (DFF / 64) * (D / 32), I_IN = (D / 64) * (NQKV / 32), I_SQ = (D / 64) * (D / 32), I_KV = (D / 64) * (2 * D / 32);
        constexpr int NITEMS = 2 * I_GU + 2 * I_DN + I_IN + 2 * I_SQ + I_KV;
        for (int it = gw; it < NITEMS; it += NGW) {
            int r = it;
            if (r < 2 * I_GU) {
                const bool second = r >= I_GU; if (second) r -= I_GU;
                const int nblk = 2 * DFF / 32, kb = r / nblk, nb = r % nblk, n0 = nb * 32;
                const int drow = n0 < DFF ? (n0 / 128) * 256 + (n0 % 128) : ((n0 - DFF) / 128) * 256 + 128 + ((n0 - DFF) % 128);
                tr_item(args.in[second ? 17 : 3], 2 * DFF, kb * 64, n0, args.in[second ? 16 : 2], 1.0f, (second ? Wgu2 : Wgu1) + (size_t)drow * D, D, scr, lane); continue; }
            r -= 2 * I_GU;
            if (r < 2 * I_DN) { const bool second = r >= I_DN; if (second) r -= I_DN; const int nblk = D / 32, kb = r / nblk, nb = r % nblk;
                tr_item(args.in[second ? 18 : 4], D, kb * 64, nb * 32, nullptr, 1.0f, (second ? Wd2 : Wd1) + (size_t)(nb * 32) * DFF, DFF, scr, lane); continue; }
            r -= 2 * I_DN;
            if (r < I_IN) { const int nblk = NQKV / 32, kb = r / nblk, nb = r % nblk, n0 = nb * 32; const bool isq = (n0 < 768) || (n0 >= 2304 && n0 < 2560);
                tr_item(args.in[6], NQKV, kb * 64, n0, args.in[5], isq ? 0.125f : 1.0f, Win + (size_t)n0 * D, D, scr, lane); continue; }
            r -= I_IN;
            if (r < I_SQ) { const int nblk = D / 32, kb = r / nblk, nb = r % nblk, k0 = kb * 64; const float* gp = k0 < 768 ? args.in[8] : args.in[9] - 768;
                tr_item(args.in[10], D, k0, nb * 32, gp, 1.0f, Wout + (size_t)(nb * 32) * D, D, scr, lane); continue; }
            r -= I_SQ;
            if (r < I_SQ) { const int nblk = D / 32, kb = r / nblk, nb = r % nblk; tr_item(args.in[15], D, kb * 64, nb * 32, nullptr, 1.0f, Wco + (size_t)(nb * 32) * D, D, scr, lane); continue; }
            r -= I_SQ;
            { const int nblk = 2 * D / 32, kb = r / nblk, nb = r % nblk; tr_item(args.in[14], 2 * D, kb * 64, nb * 32, args.in[12], 1.0f, Wckv + (size_t)(nb * 32) * D, D, scr, lane); }
        }
        for (int c = gw; c < D; c += NGW) { const float g = args.in[11][c] * 0.0625f; const f32x4* src = (const f32x4*)(args.in[13] + (size_t)c * D) + lane; u32x2* dst = (u32x2*)(Wcqs + (size_t)c * D) + lane;
#pragma unroll
            for (int j = 0; j < 4; ++j) { const f32x4 v = src[64 * j] * g; u32x2 w; w[0] = cvt_pk_bf16(v[0], v[1]); w[1] = cvt_pk_bf16(v[2], v[3]); dst[64 * j] = w; } }
        for (int m = gw; m < M; m += NGW) cvt_row(x_in + (size_t)m * D, XB + (size_t)m * D, SS0 + (size_t)m * 16, lane);
        for (int m = gw; m < MM; m += NGW) cvt_row(mem_in + (size_t)m * D, MB + (size_t)m * D, SSM + (size_t)m * 16, lane);
        for (int i = gw * 64 + lane; i < NBAT * 16 * 256; i += NGW * 64) KM[i] = 0.f;
    }
    SEAM(0);

    if (IN(1)) {
        { SchedStd S; S.o.init(M, 2 * DFF, G, bx); S.A = (const char*)XB; S.B = (const char*)Wgu1; S.a_tile = (size_t)256 * D * 2; S.b_tile = (size_t)256 * D * 2; S.b_batch = 0; S.ocol_mul = 128;
          EpiGU E{HB, SS0}; pg8::gemm_phase<EpiGU, SchedStd, true>(lds, D, D, D / 64, S, E); }
        { SchedStd S; S.o.init(MM, 2 * D, G, (bx + G / 2) % G); S.A = (const char*)MB; S.B = (const char*)Wckv; S.a_tile = (size_t)256 * D * 2; S.b_tile = (size_t)256 * D * 2; S.b_batch = 0; S.ocol_mul = 256;
          EpiStore E{KVC, 2 * D, SSM, nullptr}; pg8::gemm_phase<EpiStore, SchedStd, true>(lds, D, D, D / 64, S, E); }
    }
    SEAM(1);

    if (IN(2)) {
        SchedStd S; S.o.init(M, D, G, bx); S.A = (const char*)HB; S.B = (const char*)Wd1; S.a_tile = (size_t)256 * DFF * 2; S.b_tile = (size_t)256 * DFF * 2; S.b_batch = 0; S.ocol_mul = 256;
        EpiRes E{x_in, out, XB, SS1, 0.5f}; pg8::gemm_phase<EpiRes, SchedStd, true>(lds, DFF, DFF, DFF / 64, S, E);
    }
    SEAM(2);

    if (IN(3)) {
        { SchedStd S; S.o.init(M, NQKV, G, bx); S.A = (const char*)XB; S.B = (const char*)Win; S.a_tile = (size_t)256 * D * 2; S.b_tile = (size_t)256 * D * 2; S.b_batch = 0; S.ocol_mul = 256;
          EpiStore E{QKV, NQKV, SS1, KM}; pg8::gemm_phase<EpiStore, SchedStd, true>(lds, D, D, D / 64, S, E); }
        { SchedWK S{G, bx, (const char*)KVC, (const char*)Wcqs}; EpiStore E{WKT, D, nullptr, nullptr}; pg8::gemm_phase<EpiStore, SchedWK, true>(lds, 2 * D, D, 4, S, E); }
        { SchedVW S{G, (bx + G / 2) % G, (const char*)KVC, (const char*)Wco}; EpiStore E{VWT, D, nullptr, nullptr}; pg8::gemm_phase<EpiStore, SchedVW, true>(lds, D, 2 * D, 4, S, E); }
    }
    SEAM(3);

    if (IN(4)) {
        LAS float* tabA = (LAS float*)(lds + LDS_TABA); LAS float* tabB = (LAS float*)(lds + LDS_TABB);
        for (int i = tid; i < 36 * att::TABA_N; i += NWAVES * 64) { const int t = i / att::TABA_N, e = i % att::TABA_N, p = t / 12, h = t % 12, delta = e - 32, d = p == 0 ? 1 : (p == 1 ? 4 : 16);
            tabA[i] = (delta >= 0 && delta <= 128) ? rel_bias[att::rel_bucket(delta * d) * 16 + h] * LOG2E : -INFINITY; }
        for (int i = tid; i < 4 * att::TABB_N; i += NWAVES * 64) { const int hb = i / att::TABB_N, e = i % att::TABB_N, dist = e - 32;
            tabB[i] = dist >= 0 ? rel_bias[att::rel_bucket(dist) * 16 + 12 + hb] * LOG2E : -INFINITY; }
        __syncthreads();
        LAS char* kv = (LAS char*)(lds + wave * 8192);
        const int h2 = lane >> 5, q = lane & 31;
        const long rowb = (long)NQKV * 2;
        constexpr int NMOBA = NBAT * 4 * 16;
        for (int j = vcu; j < NMOBA / 2; j += G)
#pragma unroll 1
            for (int half = 0; half < 2; ++half) {
                const int it = half ? (NMOBA - 1 - j) : j; const int qb = 15 - it / (NBAT * 4), bh = it % (NBAT * 4), b = bh >> 2, hb = bh & 3;
                const int q0 = qb * 256 + wave * 32;
                const char* base = (const char*)QKV + (size_t)b * SEQ * rowb;
                const char* qbase = base + (size_t)q0 * rowb + (2304 + hb * 64) * 2;
                const char* kbase = base + (2560 + hb * 64) * 2;
                const unsigned sel = att::moba_select(qbase, rowb, KM + (size_t)b * 16 * 256 + hb * 64, qb);
                att::f32x16 o[2]; float mo, lo_;
                att::attn_wave<true>(qbase, rowb, kbase, rowb, 256 * 2, q0, 0, kv, tabB + hb * att::TABB_N, sel, qb, o, mo, lo_);
                att::store_o(o, lo_, (char*)OB + ((size_t)(b * SEQ + q0 + q) * 256 + hb * 64) * 2, h2);
            }
        constexpr int NDIL = NBAT * 12 * 48;
#pragma unroll 1
        for (int it = vcu; it < NDIL; it += G) {
            const int bh = it / 48, j = it % 48, b = bh / 12, h = bh % 12, p = j >> 4, jj = j & 15;
            const int d = p == 0 ? 1 : (p == 1 ? 4 : 16);
            const int res = p == 0 ? 0 : (p == 1 ? (jj & 3) : jj), mblk = p == 0 ? jj : (p == 1 ? (jj >> 2) : 0);
            const int m0 = mblk * 256 + wave * 32;
            const char* base = (const char*)QKV + ((size_t)b * SEQ + res) * rowb;
            const long st = (long)d * rowb;
            const char* qbase = base + (long)m0 * st + (h * 64) * 2;
            const char* kbase = base + (768 + h * 64) * 2;
            att::f32x16 o[2]; float mo, lo_;
            att::attn_wave<false>(qbase, st, kbase, st, 768 * 2, m0, (m0 - 128) > 0 ? (m0 - 128) : 0, kv, tabA + (p * 12 + h) * att::TABA_N, 0u, 0, o, mo, lo_);
            const size_t tok = (size_t)b * SEQ + (size_t)(m0 + q) * d + res;
            att::store_o(o, lo_, (char*)OA + (((size_t)p * M + tok) * 768 + h * 64) * 2, h2);
            if (h2 == 0) *(f32x2*)(ML + (((size_t)p * M + tok) * 12 + h) * 2) = (f32x2){mo, lo_};
        }
    }
    SEAM(4);

    if (IN(5)) {
        for (int row = gw; row < M; row += NGW) {
            float va[3][4]; float ssa = 0.f;
#pragma unroll
            for (int k = 0; k < 3; ++k) { const int col = 256 * k + 4 * lane, hd = col >> 6;
                const f32x2 ml0 = *(const f32x2*)(ML + (((size_t)0 * M + row) * 12 + hd) * 2), ml1 = *(const f32x2*)(ML + (((size_t)1 * M + row) * 12 + hd) * 2), ml2 = *(const f32x2*)(ML + (((size_t)2 * M + row) * 12 + hd) * 2);
                const float Mx = fmaxf(ml0[0], fmaxf(ml1[0], ml2[0]));
                const float w0 = ml0[1] * __builtin_amdgcn_exp2f(ml0[0] - Mx), w1 = ml1[1] * __builtin_amdgcn_exp2f(ml1[0] - Mx), w2 = ml2[1] * __builtin_amdgcn_exp2f(ml2[0] - Mx);
                const float iw = 1.0f / (w0 + w1 + w2);
                const u32x2 o0 = *(const u32x2*)(OA + ((size_t)0 * M + row) * 768 + col), o1 = *(const u32x2*)(OA + ((size_t)1 * M + row) * 768 + col), o2 = *(const u32x2*)(OA + ((size_t)2 * M + row) * 768 + col);
#pragma unroll
                for (int e = 0; e < 4; ++e) { const unsigned s0 = o0[e >> 1], s1 = o1[e >> 1], s2 = o2[e >> 1];
                    const float f0 = __builtin_bit_cast(float, (e & 1) ? (s0 & 0xffff0000u) : (s0 << 16)), f1 = __builtin_bit_cast(float, (e & 1) ? (s1 & 0xffff0000u) : (s1 << 16)), f2 = __builtin_bit_cast(float, (e & 1) ? (s2 & 0xffff0000u) : (s2 << 16));
                    const float v = (w0 * f0 + w1 * f1 + w2 * f2) * iw; va[k][e] = v; ssa += v * v; } }
            const u32x2 ob = *(const u32x2*)(OB + (size_t)row * 256 + 4 * lane); float vb[4]; float ssb = 0.f;
#pragma unroll
            for (int e = 0; e < 4; ++e) { const unsigned s0 = ob[e >> 1]; vb[e] = __builtin_bit_cast(float, (e & 1) ? (s0 & 0xffff0000u) : (s0 << 16)); ssb += vb[e] * vb[e]; }
            ssa = wave_sum(ssa); ssb = wave_sum(ssb);
            const float ra = 1.0f / sqrtf(ssa * (1.0f / 768.0f) + EPS), rb = 1.0f / sqrtf(ssb * (1.0f / 256.0f) + EPS);
#pragma unroll
            for (int k = 0; k < 3; ++k) { u32x2 w; w[0] = cvt_pk_bf16(va[k][0] * ra, va[k][1] * ra); w[1] = cvt_pk_bf16(va[k][2] * ra, va[k][3] * ra); *(u32x2*)(YN + (size_t)row * D + 256 * k + 4 * lane) = w; }
            { u32x2 w; w[0] = cvt_pk_bf16(vb[0] * rb, vb[1] * rb); w[1] = cvt_pk_bf16(vb[2] * rb, vb[3] * rb); *(u32x2*)(YN + (size_t)row * D + 768 + 4 * lane) = w; }
        }
    }
    SEAM(5);

    if (IN(6)) {
        SchedStd S; S.o.init(M, D, G, bx); S.A = (const char*)YN; S.B = (const char*)Wout; S.a_tile = (size_t)256 * D * 2; S.b_tile = (size_t)256 * D * 2; S.b_batch = 0; S.ocol_mul = 256;
        EpiRes E{out, out, XB, SS2, 1.0f}; pg8::gemm_phase<EpiRes, SchedStd, true>(lds, D, D, D / 64, S, E);
    }
    SEAM(6);

    if (IN(7)) {
        SchedStd S; S.o.init(M, D, G, bx); S.A = (const char*)XB; S.B = (const char*)WKT; S.a_tile = (size_t)256 * D * 2; S.b_tile = (size_t)256 * D * 2; S.b_batch = (size_t)D * D * 2; S.ocol_mul = 256;
        EpiSoftmax E{PB, SS2}; pg8::gemm_phase<EpiSoftmax, SchedStd, true>(lds, D, D, D / 64, S, E);
    }
    SEAM(7);

    if (IN(8)) {
        SchedStd S; S.o.init(M, D, G, bx); S.A = (const char*)PB; S.B = (const char*)VWT; S.a_tile = (size_t)256 * D * 2; S.b_tile = (size_t)256 * D * 2; S.b_batch = (size_t)D * D * 2; S.ocol_mul = 256;
        EpiRes E{out, out, XB, SS3, 1.0f}; pg8::gemm_phase<EpiRes, SchedStd, true>(lds, D, D, D / 64, S, E);
    }
    SEAM(8);

    if (IN(9)) {
        SchedStd S; S.o.init(M, 2 * DFF, G, bx); S.A = (const char*)XB; S.B = (const char*)Wgu2; S.a_tile = (size_t)256 * D * 2; S.b_tile = (size_t)256 * D * 2; S.b_batch = 0; S.ocol_mul = 128;
        EpiGU E{HB, SS3}; pg8::gemm_phase<EpiGU, SchedStd, true>(lds, D, D, D / 64, S, E);
    }
    SEAM(9);

    if (IN(10)) {
        SchedStd S; S.o.init(M, D, G, bx); S.A = (const char*)HB; S.B = (const char*)Wd2; S.a_tile = (size_t)256 * DFF * 2; S.b_tile = (size_t)256 * DFF * 2; S.b_batch = 0; S.ocol_mul = 256;
        EpiRes E{out, out, nullptr, SS4, 0.5f}; pg8::gemm_phase<EpiRes, SchedStd, true>(lds, DFF, DFF, DFF / 64, S, E);
    }
    SEAM(10);

    if (IN(11)) {
        const float* gf = args.in[19];
        for (int row = gw; row < M; row += NGW) { const float rs = row_rstd(SS4, row); f32x4* xr = (f32x4*)(out + (size_t)row * D) + lane; const f32x4* gr = (const f32x4*)gf + lane;
#pragma unroll
            for (int j = 0; j < 4; ++j) xr[64 * j] = xr[64 * j] * rs * gr[64 * j]; }
    }
#undef IN
#undef SEAM
}
}

#if MK_DEBUG
namespace dbg {
__global__ void __launch_bounds__(256) cmp_f32(const float* a, const float* r, size_t n, float* acc) {
    float num = 0.f, den = 0.f;
    for (size_t i = (size_t)blockIdx.x * 256 + threadIdx.x; i < n; i += (size_t)gridDim.x * 256) { const float d = a[i] - r[i]; num += d * d; den += r[i] * r[i]; }
    for (int o = 32; o > 0; o >>= 1) { num += __shfl_xor(num, o); den += __shfl_xor(den, o); }
    if ((threadIdx.x & 63) == 0) { atomicAdd(acc, num); atomicAdd(acc + 1, den); }
}
__global__ void __launch_bounds__(256) cmp_bf16(const unsigned short* a, int lda, const float* colscale, const float* r, int ldr, int rows, int cols, float* acc) {
    float num = 0.f, den = 0.f; const size_t n = (size_t)rows * cols;
    for (size_t i = (size_t)blockIdx.x * 256 + threadIdx.x; i < n; i += (size_t)gridDim.x * 256) { const size_t row = i / cols; const int c = (int)(i % cols);
        const float av = __builtin_bit_cast(float, (unsigned)a[row * lda + c] << 16) * (colscale ? colscale[c] : 1.0f); const float rv = r[row * ldr + c]; const float d = av - rv; num += d * d; den += rv * rv; }
    for (int o = 32; o > 0; o >>= 1) { num += __shfl_xor(num, o); den += __shfl_xor(den, o); }
    if ((threadIdx.x & 63) == 0) { atomicAdd(acc, num); atomicAdd(acc + 1, den); }
}
__global__ void __launch_bounds__(256) cmp_p(const unsigned short* a, const float* r, float* acc) {
    float num = 0.f, den = 0.f; const size_t n = (size_t)4096 * 1024;
    for (size_t i = (size_t)blockIdx.x * 256 + threadIdx.x; i < n; i += (size_t)gridDim.x * 256) { const size_t row = i / 1024; const int c = (int)(i % 1024);
        const float av = __builtin_bit_cast(float, (unsigned)a[i] << 16); const float rv = r[(size_t)(c >> 8) * 4096 * 256 + row * 256 + (c & 255)]; const float d = av - rv; num += d * d; den += rv * rv; }
    for (int o = 32; o > 0; o >>= 1) { num += __shfl_xor(num, o); den += __shfl_xor(den, o); }
    if ((threadIdx.x & 63) == 0) { atomicAdd(acc, num); atomicAdd(acc + 1, den); }
}
__global__ void build_scales(float* qkvs, float* gcat, const float* goa, const float* gob) {
    const int i = blockIdx.x * 256 + threadIdx.x;
    if (i < 3072) qkvs[i] = ((i < 768) || (i >= 2304 && i < 2560)) ? 8.0f : 1.0f;
    if (i < 1024) gcat[i] = i < 768 ? goa[i] : gob[i - 768];
}
constexpr int NST = 8;
__global__ void __launch_bounds__(256) finalize(float* out, size_t n, const float* acc, int report) {
    const float tol[NST] = {0.03f, 0.03f, 0.03f, 0.08f, 0.03f, 0.05f, 0.03f, 0.03f};
    float E = 0.f;
    if (report > 0) { const float e = sqrtf(acc[2 * (report - 1)] / acc[2 * (report - 1) + 1]); E = (e == e) ? fminf(e, 3.0f) : 3.0f; }
    else { for (int k = NST - 1; k >= 0; --k) { const float e = sqrtf(acc[2 * k] / acc[2 * k + 1]); if (!(e <= tol[k])) E = 0.1f * (k + 1); } }
    for (size_t i = (size_t)blockIdx.x * 256 + threadIdx.x; i < n; i += (size_t)gridDim.x * 256) out[i] *= (1.0f + E);
}
}
#endif

static void mk_launch(const mk::Args& a0, int lo, int hi, int grid, hipStream_t st) {
    mk::Args a = a0; a.ph_lo = lo; a.ph_hi = hi;
    hipLaunchKernelGGL(mk::mk_fwd, dim3(grid), dim3(mk::NWAVES * 64), mk::LDS_BYTES, st, a);
    const hipError_t le = hipPeekAtLastError();
    if (le != hipSuccess) fprintf(stderr, "kernel_launch: launch of phases [%d,%d) failed: %s\n", lo, hi, hipGetErrorName(le));
}

extern "C" void kernel_launch(void* const* d_in, const int* in_sizes, int n_in, void* d_out, int out_size, void* d_ws, size_t ws_size, hipStream_t stream) {
    static int grid = 0;
    if (grid == 0) {
        if (n_in != 20 || out_size != 8 * 4096 * 1024) { fprintf(stderr, "kernel_launch: unexpected shapes (n_in %d out %d)\n", n_in, out_size); grid = -1; return; }
        int dev = 0, cus = 0, per_cu = 0;
        if (hipGetDevice(&dev) != hipSuccess || hipDeviceGetAttribute(&cus, hipDeviceAttributeMultiprocessorCount, dev) != hipSuccess) { grid = -1; return; }
        if (hipFuncSetAttribute((const void*)mk::mk_fwd, hipFuncAttributeMaxDynamicSharedMemorySize, mk::LDS_BYTES) != hipSuccess) { fprintf(stderr, "kernel_launch: hipFuncSetAttribute failed\n"); grid = -1; return; }
        if (hipOccupancyMaxActiveBlocksPerMultiprocessor(&per_cu, (const void*)mk::mk_fwd, mk::NWAVES * 64, mk::LDS_BYTES) != hipSuccess || per_cu < 1) fprintf(stderr, "kernel_launch: occupancy query reports %d workgroups per CU\n", per_cu);
        (void)hipGetLastError();
        grid = cus;
    }
    if (grid < 0) return;
    unsigned char* ws = (unsigned char*)d_ws;
#if MK_DEBUG
    const size_t ref_off = (mk::WS_END + 4095) / 4096 * 4096;
    size_t off = ref_off + (size_t)290 * 1024 * 1024;
    auto take = [&](size_t bytes) { unsigned char* p = ws + off; off += (bytes + 255) / 256 * 256; return p; };
    float* sx1 = (float*)take((size_t)4096 * 1024 * 4); float* sx2 = (float*)take((size_t)4096 * 1024 * 4); float* sx3 = (float*)take((size_t)4096 * 1024 * 4);
    float* mkout = (float*)take((size_t)4096 * 1024 * 4); float* qkvs = (float*)take(3072 * 4); float* gcat = (float*)take(1024 * 4); float* acc = (float*)take(256);
    if (off > ws_size) { fprintf(stderr, "kernel_launch: debug build needs %zu bytes of workspace, got %zu\n", off, ws_size); return; }
    ref::Snap snap{sx1, sx2, sx3};
    ref::forward(d_in, (float*)d_out, ws + ref_off, stream, &snap);
    (void)hipMemsetAsync(ws + mk::WS_CTL, 0, mk::CTL_BYTES, stream);
    (void)hipMemsetAsync(acc, 0, 256, stream);
    dbg::build_scales<<<12, 256, 0, stream>>>(qkvs, gcat, (const float*)d_in[8], (const float*)d_in[9]);
    mk::Args a{};
    for (int i = 0; i < 20; ++i) a.in[i] = (const float*)d_in[i];
    a.in[0] = (const float*)d_in[0] + (size_t)7 * 4096 * 1024; a.in[1] = (const float*)d_in[1] + (size_t)7 * 256 * 1024;
    a.out = mkout; a.ws = ws;
    const ref::Bufs& rb = ref::g_bufs;
    for (int ph = 0; ph < mk::NPH; ++ph) {
        mk_launch(a, ph, ph + 1, grid, stream);
        if (ph == 1) dbg::cmp_bf16<<<512, 256, 0, stream>>>((const unsigned short*)(ws + mk::WS_KVC), 2048, nullptr, rb.kvc, 2048, 256, 2048, acc + 0);
        if (ph == 2) dbg::cmp_f32<<<512, 256, 0, stream>>>(mkout, sx1, (size_t)4096 * 1024, acc + 2);
        if (ph == 3) dbg::cmp_bf16<<<512, 256, 0, stream>>>((const unsigned short*)(ws + mk::WS_R1), 3072, qkvs, rb.proj, 3072, 4096, 3072, acc + 4);
        if (ph == 5) dbg::cmp_bf16<<<512, 256, 0, stream>>>((const unsigned short*)(ws + mk::WS_R1), 1024, gcat, rb.yn, 1024, 4096, 1024, acc + 6);
        if (ph == 6) dbg::cmp_f32<<<512, 256, 0, stream>>>(mkout, sx2, (size_t)4096 * 1024, acc + 8);
        if (ph == 7) dbg::cmp_p<<<512, 256, 0, stream>>>((const unsigned short*)(ws + mk::WS_R1), rb.sc, acc + 10);
        if (ph == 8) dbg::cmp_f32<<<512, 256, 0, stream>>>(mkout, sx3, (size_t)4096 * 1024, acc + 12);
        if (ph == 11) dbg::cmp_f32<<<512, 256, 0, stream>>>(mkout, (const float*)d_out + (size_t)7 * 4096 * 1024, (size_t)4096 * 1024, acc + 14);
    }
    dbg::finalize<<<1024, 256, 0, stream>>>((float*)d_out, (size_t)8 * 4096 * 1024, acc, MK_REPORT);
#else
    if (ws_size < mk::WS_END) { fprintf(stderr, "kernel_launch: needs %zu bytes of workspace, got %zu\n", (size_t)mk::WS_END, ws_size); return; }
    if (hipMemsetAsync(ws + mk::WS_CTL, 0, mk::CTL_BYTES, stream) != hipSuccess) return;
    mk::Args a{};
    for (int i = 0; i < 20; ++i) a.in[i] = (const float*)d_in[i];
    a.out = (float*)d_out; a.ws = ws;
#if MK_N_LAUNCHES == 1
    mk_launch(a, 0, mk::NPH, grid, stream);
#else
    for (int ph = 0; ph < mk::NPH; ++ph) mk_launch(a, ph, ph + 1, grid, stream);
#endif
#endif
}
```

```cpp
#include <hip/hip_runtime.h>
#include <cstdio>
#include <cstdint>
#include <cmath>
#define MK_REPEAT -1
#define MK_REPEAT_N 1
#define MK_REPEAT_FLAGS 0
#define MK_DEBUG 0
#define MK_REPORT 0
#define MK_N_LAUNCHES 1
#define MK_NBAT 8

namespace pg8 {
#define PG8_LAS __attribute__((address_space(3)))
typedef unsigned short bf16_t;
typedef short bf16x8 __attribute__((ext_vector_type(8)));
typedef float f32x4 __attribute__((ext_vector_type(4)));
typedef float f32x2 __attribute__((ext_vector_type(2)));
typedef unsigned u32x4 __attribute__((ext_vector_type(4)));
typedef unsigned u32x2 __attribute__((ext_vector_type(2)));
constexpr int BM = 256, BK = 64, HALF = 128, HTB = HALF * BK * 2  , STAGE_BYTES = 8 * HTB, NXCD = 8, WGM = 8;

__host__ __device__ __forceinline__ int lds_byte(int r, int c) { const int st = (r >> 4) * 2 + (c >> 5), rr = r & 15, cc = c & 31, ob = rr * 64 + cc * 2; return st * 1024 + (ob ^ (((ob >> 9) & 1) << 5)); }
__host__ __device__ __forceinline__ void stage_rc(int b, int& R, int& C) { const int st = b / 1024, sb = b % 1024, swz = sb ^ (((sb >> 9) & 1) << 5); R = (st >> 1) * 16 + swz / 64; C = (st & 1) * 32 + (swz % 64) / 2; }
__host__ __device__ __forceinline__ int perm32(int rho) { const int n = rho >> 4, i = rho & 15; return 8 * (i >> 2) + 4 * n + (i & 3); }

struct Unit { const char* a; const char* b; int orow, ocol, aux; };

struct Order {
    int nM, nN, nwg, G, c;
    __device__ __forceinline__ void init(int M, int N, int G_, int c_) { nM = M / BM; nN = N / BM; nwg = nM * nN; G = G_; c = c_; }
    __device__ __forceinline__ bool tile(int i, int& pm, int& pn) const {
        const long L = (long)i * G + c; if (L >= nwg) return false;
        int wgid = (int)L; { const int q = nwg / NXCD, r = nwg % NXCD, xcd = wgid % NXCD, off = wgid / NXCD; wgid = (xcd < r ? xcd * (q + 1) : r * (q + 1) + (xcd - r) * q) + off; }
        const int nig = WGM * nN, gid = wgid / nig, fm = gid * WGM, gsz = (nM - fm) < WGM ? (nM - fm) : WGM;
        pm = fm + ((wgid % nig) % gsz); pn = (wgid % nig) / gsz; return true;
    }
};

__device__ __forceinline__ unsigned cvt_pk_bf16(float lo, float hi) { unsigned r; asm volatile("v_cvt_pk_bf16_f32 %0, %1, %2" : "=v"(r) : "v"(lo), "v"(hi)); return r; }

template <class Epi, class Sched, bool ALIGN_EPI>
__device__ __forceinline__ void gemm_phase(PG8_LAS unsigned char* lds, const int lda, const int ldb, const int nt, const Sched& S, const Epi& E) {
    int tid_ = threadIdx.x; asm volatile("" : "+v"(tid_));
    const int tid = tid_, wid = __builtin_amdgcn_readfirstlane(tid >> 6), lane = tid & 63, wr = wid >> 2, wc = wid & 3, fr = lane & 15, fq = lane >> 4;
    unsigned voffA[2], voffB[2];
#pragma unroll
    for (int i = 0; i < 2; ++i) { int R, C; stage_rc(tid * 16 + i * 8192, R, C); const int Rb = Epi::PERM ? ((R & ~31) + perm32(R & 31)) : R;
        voffA[i] = (unsigned)(R * lda + C) * 2u; voffB[i] = (unsigned)(Rb * ldb + C) * 2u; }
    const size_t kstep = (size_t)(BK * 2);
    const size_t hstepA = (size_t)HALF * lda * 2, hstepB = (size_t)HALF * ldb * 2;
    const unsigned ldsw = (unsigned)wid * 1024u;
    const int aoff = lds_byte(wr * 64 + fr, fq * 8), boff = lds_byte(wc * 32 + fr, fq * 8);
#define PG8_SA(b, h) (((b) * 2 + (h)) * HTB)
#define PG8_SB(b, h) ((4 + (b) * 2 + (h)) * HTB)
#define PG8_STAGE(bufoff, gbase, voff) do { _Pragma("unroll") for (int _i = 0; _i < 2; ++_i) \
        __builtin_amdgcn_global_load_lds((const unsigned*)((const char*)(gbase) + (voff)[_i]), (PG8_LAS unsigned*)(lds + (bufoff) + ldsw + _i * 8192), 16, 0, 0); } while (0)
#define PG8_LDA(dst, b, h) do { _Pragma("unroll") for (int m = 0; m < 4; ++m) _Pragma("unroll") for (int k = 0; k < 2; ++k) dst[m][k] = *(const PG8_LAS bf16x8*)(lds + PG8_SA(b, h) + aoff + m * 2048 + k * 1024); } while (0)
#define PG8_LDB(dst, b, h) do { _Pragma("unroll") for (int n = 0; n < 2; ++n) _Pragma("unroll") for (int k = 0; k < 2; ++k) dst[n][k] = *(const PG8_LAS bf16x8*)(lds + PG8_SB(b, h) + boff + n * 2048 + k * 1024); } while (0)
#define PG8_MMA(ai, bj, At, Bt) do { __builtin_amdgcn_s_setprio(1); _Pragma("unroll") for (int m = 0; m < 4; ++m) _Pragma("unroll") for (int n = 0; n < 2; ++n) _Pragma("unroll") for (int k = 0; k < 2; ++k) \
        acc[ai][bj][m][n] = __builtin_amdgcn_mfma_f32_16x16x32_bf16(Bt[n][k], At[m][k], acc[ai][bj][m][n], 0, 0, 0); __builtin_amdgcn_s_setprio(0); } while (0)
#define PG8_WAIT_V(n) asm volatile("s_waitcnt vmcnt(" #n ")" ::: "memory")
#define PG8_WAIT_L(n) asm volatile("s_waitcnt lgkmcnt(" #n ")" ::: "memory")
#define PG8_BAR __builtin_amdgcn_s_barrier()
#define PG8_SCHED __builtin_amdgcn_sched_barrier(0)
    Unit cur, nxt; int ui = 0;
    if (!S.next(0, cur)) return;
    f32x4 acc[2][2][4][2];
#pragma unroll
    for (int a = 0; a < 2; ++a)
#pragma unroll
        for (int b = 0; b < 2; ++b)
#pragma unroll
            for (int m = 0; m < 4; ++m)
#pragma unroll
                for (int n = 0; n < 2; ++n) acc[a][b][m][n] = (f32x4){0.f, 0.f, 0.f, 0.f};
    bf16x8 At[4][2], B0[2][2], B1[2][2];
    const char* cA = cur.a; const char* cB = cur.b;
    PG8_STAGE(PG8_SB(0, 0), cB, voffB); PG8_STAGE(PG8_SB(0, 1), cB + hstepB, voffB); PG8_STAGE(PG8_SA(0, 0), cA, voffA); PG8_STAGE(PG8_SA(0, 1), cA + hstepA, voffA);
    if (wr == 1) PG8_BAR;
    PG8_WAIT_V(2); PG8_BAR;
    PG8_STAGE(PG8_SB(1, 0), cB + kstep, voffB); PG8_STAGE(PG8_SA(1, 0), cA + kstep, voffA); PG8_STAGE(PG8_SB(1, 1), cB + hstepB + kstep, voffB);
    PG8_WAIT_V(6); PG8_BAR;
    for (;;) {
        const bool has_next = S.next(ui + 1, nxt);
        const char* nA = has_next ? nxt.a : cA; const char* nB = has_next ? nxt.b : cB;
#pragma unroll 1
        for (int t = 0; t < nt; t += 2) {
            const bool last = (t == nt - 2);
            const char* a1 = cA + (size_t)(t + 1) * kstep;
            const char* a2 = last ? nA : cA + (size_t)(t + 2) * kstep; const char* b2 = last ? nB : cB + (size_t)(t + 2) * kstep;
            const char* a3 = a2 + kstep; const char* b3 = b2 + kstep;
            PG8_LDB(B0, 0, 0); PG8_LDB(B1, 0, 1); PG8_SCHED; PG8_LDA(At, 0, 0); PG8_STAGE(PG8_SA(1, 1), a1 + hstepA, voffA);
            PG8_WAIT_V(8); PG8_WAIT_L(0); PG8_BAR; PG8_MMA(0, 0, At, B0); PG8_MMA(0, 1, At, B1); PG8_BAR; PG8_SCHED;
            PG8_LDA(At, 0, 1); PG8_STAGE(PG8_SB(0, 0), b2, voffB); PG8_STAGE(PG8_SB(0, 1), b2 + hstepB, voffB); PG8_STAGE(PG8_SA(0, 0), a2, voffA);
            PG8_WAIT_V(8); PG8_WAIT_L(0); PG8_BAR; PG8_MMA(1, 0, At, B0); PG8_MMA(1, 1, At, B1); PG8_BAR; PG8_SCHED;
            PG8_LDB(B0, 1, 0); PG8_LDB(B1, 1, 1); PG8_SCHED; PG8_LDA(At, 1, 0); PG8_STAGE(PG8_SA(0, 1), a2 + hstepA, voffA);
            PG8_WAIT_V(8); PG8_WAIT_L(0); PG8_BAR; PG8_MMA(0, 0, At, B0); PG8_MMA(0, 1, At, B1); PG8_BAR; PG8_SCHED;
            PG8_LDA(At, 1, 1); PG8_STAGE(PG8_SB(1, 0), b3, voffB); PG8_STAGE(PG8_SB(1, 1), b3 + hstepB, voffB); PG8_STAGE(PG8_SA(1, 0), a3, voffA);
            PG8_WAIT_V(8); PG8_WAIT_L(0); PG8_BAR; PG8_MMA(1, 0, At, B0); PG8_MMA(1, 1, At, B1); PG8_BAR; PG8_SCHED;
        }
        if constexpr (ALIGN_EPI) { if (wr == 0) PG8_BAR; }
        E(acc, cur, wr, wc, fr, fq, lds, wid, lane);
        if (!has_next) break;
#pragma unroll
        for (int a = 0; a < 2; ++a)
#pragma unroll
            for (int b = 0; b < 2; ++b)
#pragma unroll
                for (int m = 0; m < 4; ++m)
#pragma unroll
                    for (int n = 0; n < 2; ++n) acc[a][b][m][n] = (f32x4){0.f, 0.f, 0.f, 0.f};
        cur = nxt; cA = nA; cB = nB; ++ui;
        if constexpr (ALIGN_EPI) { if (wr == 1) PG8_BAR; }
    }
    PG8_WAIT_V(0);
    if constexpr (!ALIGN_EPI) { if (wr == 0) PG8_BAR; }
    PG8_BAR;
#undef PG8_SA
#undef PG8_SB
#undef PG8_STAGE
#undef PG8_LDA
#undef PG8_LDB
#undef PG8_MMA
#undef PG8_WAIT_V
#undef PG8_WAIT_L
#undef PG8_BAR
#undef PG8_SCHED
}
}

namespace att {
#define ATT_LAS __attribute__((address_space(3)))
typedef short bf16x8 __attribute__((ext_vector_type(8)));
typedef short v4i16 __attribute__((ext_vector_type(4)));
typedef float f32x16 __attribute__((ext_vector_type(16)));
typedef float f32x4 __attribute__((ext_vector_type(4)));
typedef unsigned u32x4 __attribute__((ext_vector_type(4)));
typedef unsigned u32x2 __attribute__((ext_vector_type(2)));
constexpr float LOG2E = 1.4426950408889634f;
constexpr int TABA_N = 192, TABB_N = 1600;

__device__ __forceinline__ int rel_bucket(int n) {
    if (n < 16) return n < 0 ? 0 : n;
    int b = 16;
    b += (n >= 22); b += (n >= 30); b += (n >= 40); b += (n >= 54); b += (n >= 73); b += (n >= 99); b += (n >= 134); b += (n >= 182);
    b += (n >= 246); b += (n >= 332); b += (n >= 450); b += (n >= 609); b += (n >= 825); b += (n >= 1117); b += (n >= 1513);
    return b;
}
__device__ __forceinline__ unsigned pk_bf16(float lo, float hi) { unsigned r; asm volatile("v_cvt_pk_bf16_f32 %0, %1, %2" : "=v"(r) : "v"(lo), "v"(hi)); return r; }
__device__ __forceinline__ float bf16_round(float x) { unsigned u = __builtin_bit_cast(unsigned, x); u = (u + 0x7fffu + ((u >> 16) & 1u)) & 0xffff0000u; return __builtin_bit_cast(float, u); }

__device__ __forceinline__ void glds16(const void* gsrc, unsigned lds_dst) { unsigned keep;
    asm volatile("s_mov_b32 %0, m0\n\ts_mov_b32 m0, %2\n\ts_nop 0\n\tglobal_load_lds_dwordx4 %1, off\n\ts_mov_b32 m0, %0" : "=&s"(keep) : "v"(gsrc), "s"(lds_dst) : "memory"); }
__device__ __forceinline__ void dma_rows8(const char* krow0  , const int voff, const int row  ,
                                          ATT_LAS char* kdst  , ATT_LAS char* vdst, const int lane) {
    const int pc = lane & 7;
    glds16(krow0 + 16 * (pc ^ ((row >> 1) & 7)), (unsigned)__builtin_amdgcn_readfirstlane((int)(unsigned)(uintptr_t)kdst));
    glds16(krow0 + voff + 16 * (pc ^ (((row >> 1) & 1) << 2)), (unsigned)__builtin_amdgcn_readfirstlane((int)(unsigned)(uintptr_t)vdst));
}

__device__ __forceinline__ void attn_group(const bf16x8 (&qf)[4], f32x16 (&o)[2], float& m, float& l, const ATT_LAS char* kg, const ATT_LAS char* vg, const ATT_LAS float* tp, const int lane) {
    const int q = lane & 31, h = lane >> 5;
    const ATT_LAS char* kr0 = kg + q * 128; const int kswz = (q >> 1) & 7;
    f32x16 s = f32x16{};
#pragma unroll
    for (int d0 = 0; d0 < 4; ++d0) { const bf16x8 kf = *(const ATT_LAS bf16x8*)(kr0 + 16 * ((2 * d0 + h) ^ kswz)); s = __builtin_amdgcn_mfma_f32_32x32x16_bf16(kf, qf[d0], s, 0, 0, 0); }
    float mx = -INFINITY;
#pragma unroll
    for (int r = 0; r < 16; ++r) { const int off = (r & 3) + 8 * (r >> 2); s[r] = fmaf(s[r], LOG2E, tp[-off]); }
#pragma unroll
    for (int r = 0; r < 16; r += 2) mx = fmaxf(mx, fmaxf(s[r], s[r + 1]));
    mx = fmaxf(mx, __shfl_xor(mx, 32));
    if (__any(mx > m)) {
        const float mnew = fmaxf(m, mx), alpha = __builtin_amdgcn_exp2f(m - mnew);
        l *= alpha; m = mnew;
#pragma unroll
        for (int r = 0; r < 16; ++r) { o[0][r] *= alpha; o[1][r] *= alpha; }
    }
    float ps = 0.f;
#pragma unroll
    for (int r = 0; r < 16; ++r) { s[r] = __builtin_amdgcn_exp2f(s[r] - m); ps += s[r]; }
    l += ps;
    u32x4 pw0, pw1;
    pw0[0] = pk_bf16(s[0], s[1]); pw0[1] = pk_bf16(s[2], s[3]); pw0[2] = pk_bf16(s[4], s[5]); pw0[3] = pk_bf16(s[6], s[7]);
    pw1[0] = pk_bf16(s[8], s[9]); pw1[1] = pk_bf16(s[10], s[11]); pw1[2] = pk_bf16(s[12], s[13]); pw1[3] = pk_bf16(s[14], s[15]);
    const bf16x8 pb0 = __builtin_bit_cast(bf16x8, pw0), pb1 = __builtin_bit_cast(bf16x8, pw1);
    const int q4 = (lane & 15) >> 2, p4 = lane & 3, g1 = (lane >> 4) & 1, vsw = (q4 >> 1) & 1;
    const ATT_LAS char* vr0 = vg + (4 * h + q4) * 128 + 32 * g1 + 8 * p4;
#pragma unroll
    for (int dh = 0; dh < 2; ++dh) {
        const ATT_LAS char* vp = vr0 + 64 * (dh ^ vsw);
        const v4i16 a00 = __builtin_amdgcn_ds_read_tr16_b64_v4i16((ATT_LAS v4i16*)(vp));
        const v4i16 a01 = __builtin_amdgcn_ds_read_tr16_b64_v4i16((ATT_LAS v4i16*)(vp + 8 * 128));
        const v4i16 a10 = __builtin_amdgcn_ds_read_tr16_b64_v4i16((ATT_LAS v4i16*)(vp + 16 * 128));
        const v4i16 a11 = __builtin_amdgcn_ds_read_tr16_b64_v4i16((ATT_LAS v4i16*)(vp + 24 * 128));
        const bf16x8 va0 = (bf16x8){a00[0], a00[1], a00[2], a00[3], a01[0], a01[1], a01[2], a01[3]};
        const bf16x8 va1 = (bf16x8){a10[0], a10[1], a10[2], a10[3], a11[0], a11[1], a11[2], a11[3]};
        o[dh] = __builtin_amdgcn_mfma_f32_32x32x16_bf16(va0, pb0, o[dh], 0, 0, 0);
        o[dh] = __builtin_amdgcn_mfma_f32_32x32x16_bf16(va1, pb1, o[dh], 0, 0, 0);
    }
}

__device__ __forceinline__ void store_o(const f32x16 (&o)[2], const float l, char* orow_q, const int h) {
    const float il = 1.0f / l;
#pragma unroll
    for (int dh = 0; dh < 2; ++dh)
#pragma unroll
        for (int j = 0; j < 4; ++j) {
            u32x2 w; w[0] = pk_bf16(o[dh][4 * j] * il, o[dh][4 * j + 1] * il); w[1] = pk_bf16(o[dh][4 * j + 2] * il, o[dh][4 * j + 3] * il);
            *(u32x2*)(orow_q + (32 * dh + 8 * j + 4 * h) * 2) = w;
        }
}

__device__ __forceinline__ unsigned moba_select(const char* qbase, const long qs, const float* km, const int qb) {
    const int lane = threadIdx.x & 63, q = lane & 31, h = lane >> 5;
    f32x16 g = f32x16{};
    const float* kmrow = km + (size_t)(q & 15) * 256;
    const bool lo_part = q >= 16;
#pragma unroll
    for (int d0 = 0; d0 < 4; ++d0) {
        const bf16x8 qf = *(const bf16x8*)(qbase + (long)q * qs + (16 * d0 + 8 * h) * 2);
        const f32x4 f0 = *(const f32x4*)(kmrow + 16 * d0 + 8 * h), f1 = *(const f32x4*)(kmrow + 16 * d0 + 8 * h + 4);
        float v[8] = {f0[0], f0[1], f0[2], f0[3], f1[0], f1[1], f1[2], f1[3]};
        u32x4 aw;
#pragma unroll
        for (int j = 0; j < 4; ++j) {
            const float h0 = bf16_round(v[2 * j]), h1 = bf16_round(v[2 * j + 1]);
            const float x0 = lo_part ? (v[2 * j] - h0) : h0, x1 = lo_part ? (v[2 * j + 1] - h1) : h1;
            aw[j] = pk_bf16(x0, x1);
        }
        g = __builtin_amdgcn_mfma_f32_32x32x16_bf16(__builtin_bit_cast(bf16x8, aw), qf, g, 0, 0, 0);
    }
    float gate[8], other[8];
#pragma unroll
    for (int r = 0; r < 8; ++r) { gate[r] = g[r] + g[r + 8]; }
#pragma unroll
    for (int r = 0; r < 8; ++r) { other[r] = __shfl_xor(gate[r], 32); }
    unsigned mymask = 0u;
#pragma unroll
    for (int r = 0; r < 8; ++r) {
        const int n = (r & 3) + 8 * (r >> 2) + 4 * h;
        int rank = 0;
#pragma unroll
        for (int r2 = 0; r2 < 8; ++r2) {
            const int n2 = (r2 & 3) + 8 * (r2 >> 2) + 4 * h, n3 = (r2 & 3) + 8 * (r2 >> 2) + 4 * (1 - h);
            if (r2 != r) rank += (n2 < qb && (gate[r2] > gate[r] || (gate[r2] == gate[r] && n2 < n))) ? 1 : 0;
            rank += (n3 < qb && (other[r2] > gate[r] || (other[r2] == gate[r] && n3 < n))) ? 1 : 0;
        }
        if (n < qb && rank < 3) mymask |= 1u << n;
    }
    return mymask | (unsigned)__shfl_xor((int)mymask, 32);
}
}

namespace mk {
using pg8::bf16_t; using pg8::bf16x8; using pg8::f32x4; using pg8::f32x2; using pg8::u32x4; using pg8::u32x2; using pg8::Unit; using pg8::cvt_pk_bf16;
#define LAS __attribute__((address_space(3)))
constexpr int NBAT = MK_NBAT, SEQ = 4096, D = 1024, DFF = 2816, NMEM = 256, M = NBAT * SEQ, MM = NBAT * NMEM, NQKV = 3072;
constexpr float EPS = 1e-6f, LOG2E = 1.4426950408889634f;
constexpr int NWAVES = 8, NPH = 12;

constexpr size_t al256(size_t x) { return (x + 255) / 256 * 256; }
constexpr size_t WS_CTL = 0, CTL_BYTES = 1u << 20;
constexpr size_t WS_WGU1 = WS_CTL + CTL_BYTES;
constexpr size_t WS_WD1 = WS_WGU1 + (size_t)2 * DFF * D * 2;
constexpr size_t WS_WIN = WS_WD1 + (size_t)D * DFF * 2;
constexpr size_t WS_WOUT = WS_WIN + (size_t)NQKV * D * 2;
constexpr size_t WS_WCQS = WS_WOUT + (size_t)D * D * 2;
constexpr size_t WS_WCKV = WS_WCQS + (size_t)D * D * 2;
constexpr size_t WS_WCO = WS_WCKV + (size_t)2 * D * D * 2;
constexpr size_t WS_WGU2 = WS_WCO + (size_t)D * D * 2;
constexpr size_t WS_WD2 = WS_WGU2 + (size_t)2 * DFF * D * 2;
constexpr size_t WS_MB = WS_WD2 + (size_t)D * DFF * 2;
constexpr size_t WS_KVC = WS_MB + (size_t)MM * D * 2;
constexpr size_t WS_WKT = WS_KVC + (size_t)MM * 2 * D * 2;
constexpr size_t WS_VWT = WS_WKT + (size_t)NBAT * D * D * 2;
constexpr size_t SS_BYTES = (size_t)M * 16 * 4;
constexpr size_t WS_SS = WS_VWT + (size_t)NBAT * D * D * 2;
constexpr size_t WS_SSM = WS_SS + 5 * SS_BYTES;
constexpr size_t WS_KM = WS_SSM + (size_t)MM * 16 * 4;
constexpr size_t WS_R1 = al256(WS_KM + (size_t)NBAT * 16 * 256 * 4);
constexpr size_t WS_XB = WS_R1 + (size_t)M * NQKV * 2;
constexpr size_t WS_OA2 = WS_XB + (size_t)M * D * 2;
constexpr size_t WS_END = WS_OA2 + (size_t)M * 768 * 2;
constexpr size_t OUT_OA1 = (size_t)M * 768 * 2, OUT_OB = 2 * OUT_OA1, OUT_ML = OUT_OB + (size_t)M * 256 * 2;
static_assert(OUT_ML + (size_t)3 * M * 12 * 8 <= (size_t)M * D * 4, "attention partials fit in d_out");
constexpr int CW_BAR = 4096;

constexpr int LDS_XCH = 131072;
constexpr int LDS_MISC = 131072 + 8192;
constexpr int LDS_BYTES = 147456;
constexpr int LDS_TAB = 98304;
static_assert(LDS_TAB + 36 * att::TABA_N * 4 <= LDS_XCH && LDS_TAB + 4 * att::TABB_N * 4 <= LDS_XCH, "attention LDS map");

__device__ __forceinline__ float wave_sum(float v) {
#pragma unroll
    for (int o = 1; o < 64; o <<= 1) v += __shfl_xor(v, o);
    return v;
}
__device__ __forceinline__ float row_rstd(const float* ss, int row) {
    const f32x4* p = (const f32x4*)(ss + (size_t)row * 16);
    const f32x4 a = p[0], b = p[1], c = p[2], d = p[3];
    const float s = ((a[0] + a[1]) + (a[2] + a[3])) + ((b[0] + b[1]) + (b[2] + b[3])) + ((c[0] + c[1]) + (c[2] + c[3])) + ((d[0] + d[1]) + (d[2] + d[3]));
    return 1.0f / sqrtf(s * (1.0f / D) + EPS);
}

struct SchedStd {
    pg8::Order o; const char* A; const char* B; size_t a_tile, b_tile, b_batch; int ocol_mul;
    __device__ __forceinline__ bool next(int i, Unit& u) const { int pm, pn; if (!o.tile(i, pm, pn)) return false;
        u.a = A + (size_t)pm * a_tile; u.b = B + (size_t)pn * b_tile + (size_t)(pm >> 4) * b_batch; u.orow = pm * 256; u.ocol = pn * ocol_mul; u.aux = pn; return true; }
};
struct SchedWK {
    int G, c; const char* kvc; const char* wcqs;
    __device__ __forceinline__ bool next(int i, Unit& u) const { const int L = i * G + c; if (L >= NBAT * 16) return false; const int bh = L >> 2, pn = L & 3, b = bh >> 2, h = bh & 3;
        u.a = kvc + ((size_t)(b * 256) * 2048 + h * 256) * 2; u.b = wcqs + ((size_t)(pn * 256) * 1024 + h * 256) * 2; u.orow = b * 1024 + h * 256; u.ocol = pn * 256; u.aux = 0; return true; }
};
struct SchedVW {
    int G, c; const char* kvc; const char* wcot;
    __device__ __forceinline__ bool next(int i, Unit& u) const { const int L = i * G + c; if (L >= NBAT * 16) return false; const int bh = L >> 2, pm = L & 3, b = bh >> 2, h = bh & 3;
        u.a = wcot + ((size_t)(pm * 256) * 1024 + h * 256) * 2; u.b = kvc + ((size_t)(b * 256) * 2048 + 1024 + h * 256) * 2; u.orow = b * 1024 + pm * 256; u.ocol = h * 256; u.aux = 0; return true; }
};

struct EpiGU { static constexpr bool PERM = true;
    bf16_t* H; const float* ss;
    __device__ __forceinline__ void operator()(const f32x4 (&acc)[2][2][4][2], const Unit& u, int wr, int wc, int fr, int fq, LAS unsigned char*, int, int) const {
        float rsv[2][4];
#pragma unroll
        for (int ai = 0; ai < 2; ++ai)
#pragma unroll
            for (int m = 0; m < 4; ++m) rsv[ai][m] = row_rstd(ss, u.orow + ai * 128 + wr * 64 + m * 16 + fr);
#pragma unroll
        for (int ai = 0; ai < 2; ++ai)
#pragma unroll
            for (int m = 0; m < 4; ++m) { const int row = u.orow + ai * 128 + wr * 64 + m * 16 + fr; const float rs = rsv[ai][m];
                float hv[8];
#pragma unroll
                for (int n = 0; n < 2; ++n)
#pragma unroll
                    for (int j = 0; j < 4; ++j) { const float g = acc[ai][0][m][n][j] * rs, uu = acc[ai][1][m][n][j] * rs;
                        hv[4 * n + j] = g * __builtin_amdgcn_rcpf(1.0f + __builtin_amdgcn_exp2f(-g * LOG2E)) * uu; }
                u32x4 w; w[0] = cvt_pk_bf16(hv[0], hv[1]); w[1] = cvt_pk_bf16(hv[2], hv[3]); w[2] = cvt_pk_bf16(hv[4], hv[5]); w[3] = cvt_pk_bf16(hv[6], hv[7]);
                *(u32x4*)(H + (size_t)row * DFF + u.ocol + wc * 32 + 8 * fq) = w; }
    }
};
struct EpiRes { static constexpr bool PERM = true;
    bf16_t* xb; float* ssout; float alpha;
    __device__ __forceinline__ void operator()(const f32x4 (&acc)[2][2][4][2], const Unit& u, int wr, int wc, int fr, int fq, LAS unsigned char*, int, int) const {
        const size_t off0 = (size_t)(u.orow + wr * 64 + fr) * D + u.ocol + wc * 32 + 8 * fq;
        u32x4 cur[2], nxt[2];
#pragma unroll
        for (int bj = 0; bj < 2; ++bj) cur[bj] = *(const u32x4*)(xb + off0 + bj * 128);
#pragma unroll
        for (int idx = 0; idx < 8; ++idx) { const int ai = idx >> 2, m = idx & 3; const size_t off = off0 + (size_t)(ai * 128 + m * 16) * D; const int row = u.orow + ai * 128 + wr * 64 + m * 16 + fr;
            if (idx < 7) { const size_t offn = off0 + (size_t)(((idx + 1) >> 2) * 128 + ((idx + 1) & 3) * 16) * D;
#pragma unroll
                for (int bj = 0; bj < 2; ++bj) nxt[bj] = *(const u32x4*)(xb + offn + bj * 128); }
            float sq = 0.f;
#pragma unroll
            for (int bj = 0; bj < 2; ++bj) { float o[8];
#pragma unroll
                for (int n = 0; n < 2; ++n)
#pragma unroll
                    for (int j = 0; j < 4; ++j) { const unsigned wv = cur[bj][2 * n + (j >> 1)]; const float r = __builtin_bit_cast(float, (j & 1) ? (wv & 0xffff0000u) : (wv << 16));
                        const float v = r + acc[ai][bj][m][n][j] * alpha; o[4 * n + j] = v; sq += v * v; }
                u32x4 w; w[0] = cvt_pk_bf16(o[0], o[1]); w[1] = cvt_pk_bf16(o[2], o[3]); w[2] = cvt_pk_bf16(o[4], o[5]); w[3] = cvt_pk_bf16(o[6], o[7]);
                *(u32x4*)(xb + off + bj * 128) = w; }
            sq += __shfl_xor(sq, 16); sq += __shfl_xor(sq, 32);
            if (fq == 0) ssout[(size_t)row * 16 + (u.ocol >> 8) * 4 + wc] = sq;
#pragma unroll
            for (int bj = 0; bj < 2; ++bj) cur[bj] = nxt[bj]; }
    }
};
struct EpiStore { static constexpr bool PERM = true;
    bf16_t* O; int ldc; const float* ss; float* km;
    __device__ __forceinline__ void operator()(const f32x4 (&acc)[2][2][4][2], const Unit& u, int wr, int wc, int fr, int fq, LAS unsigned char*, int, int) const {
        float rsv[2][4];
#pragma unroll
        for (int ai = 0; ai < 2; ++ai)
#pragma unroll
            for (int m = 0; m < 4; ++m) rsv[ai][m] = ss ? row_rstd(ss, u.orow + ai * 128 + wr * 64 + m * 16 + fr) : 1.0f;
#pragma unroll
        for (int ai = 0; ai < 2; ++ai)
#pragma unroll
            for (int m = 0; m < 4; ++m) { const int row = u.orow + ai * 128 + wr * 64 + m * 16 + fr; const float rs = rsv[ai][m];
                bf16_t* rowp = O + (size_t)row * ldc + u.ocol + wc * 32 + 8 * fq;
#pragma unroll
                for (int bj = 0; bj < 2; ++bj) { const f32x4 v0 = acc[ai][bj][m][0] * rs, v1 = acc[ai][bj][m][1] * rs;
                    u32x4 w; w[0] = cvt_pk_bf16(v0[0], v0[1]); w[1] = cvt_pk_bf16(v0[2], v0[3]); w[2] = cvt_pk_bf16(v1[0], v1[1]); w[3] = cvt_pk_bf16(v1[2], v1[3]);
                    *(u32x4*)(rowp + bj * 128) = w; } }
        if ((km != nullptr) && (u.aux == 10)) {
            float* kmb = km + (size_t)(u.orow >> 8) * 256 + wc * 32 + 8 * fq;
#pragma unroll
            for (int bj = 0; bj < 2; ++bj)
#pragma unroll
                for (int n = 0; n < 2; ++n) { f32x4 cs = (f32x4){0.f, 0.f, 0.f, 0.f};
#pragma unroll
                    for (int ai = 0; ai < 2; ++ai)
#pragma unroll
                        for (int m = 0; m < 4; ++m) cs += acc[ai][bj][m][n] * rsv[ai][m];
#pragma unroll
                    for (int j = 0; j < 4; ++j) { float v = cs[j]; v += __shfl_xor(v, 1); v += __shfl_xor(v, 2); v += __shfl_xor(v, 4); v += __shfl_xor(v, 8);
                        if (fr == 0) atomicAdd(kmb + bj * 128 + 4 * n + j, v); } }
        }
    }
};
struct EpiSoftmax { static constexpr bool PERM = true;
    bf16_t* P; const float* ss;
    __device__ __forceinline__ void operator()(const f32x4 (&acc)[2][2][4][2], const Unit& u, int wr, int wc, int fr, int fq, LAS unsigned char* lds, int, int) const {
        LAS f32x2* X = (LAS f32x2*)(lds + LDS_XCH);
        float rsl[2][4], mw[2][4];
#pragma unroll
        for (int ai = 0; ai < 2; ++ai)
#pragma unroll
            for (int m = 0; m < 4; ++m) { const int rl = ai * 128 + wr * 64 + m * 16 + fr; const float rs = row_rstd(ss, u.orow + rl) * LOG2E; rsl[ai][m] = rs;
                float mx = -INFINITY;
#pragma unroll
                for (int bj = 0; bj < 2; ++bj)
#pragma unroll
                    for (int n = 0; n < 2; ++n)
#pragma unroll
                        for (int j = 0; j < 4; ++j) mx = fmaxf(mx, acc[ai][bj][m][n][j] * rs);
                mx = fmaxf(mx, __shfl_xor(mx, 16)); mx = fmaxf(mx, __shfl_xor(mx, 32));
                float sm = 0.f;
#pragma unroll
                for (int bj = 0; bj < 2; ++bj)
#pragma unroll
                    for (int n = 0; n < 2; ++n)
#pragma unroll
                        for (int j = 0; j < 4; ++j) sm += __builtin_amdgcn_exp2f(acc[ai][bj][m][n][j] * rs - mx);
                sm += __shfl_xor(sm, 16); sm += __shfl_xor(sm, 32);
                mw[ai][m] = mx;
                if (fq == 0) X[rl * 4 + wc] = (f32x2){mx, sm}; }
        asm volatile("s_waitcnt lgkmcnt(0)" ::: "memory"); __builtin_amdgcn_s_barrier(); asm volatile("" ::: "memory");
#pragma unroll
        for (int ai = 0; ai < 2; ++ai)
#pragma unroll
            for (int m = 0; m < 4; ++m) { const int rl = ai * 128 + wr * 64 + m * 16 + fr; const float rs = rsl[ai][m];
                const f32x2 x0 = X[rl * 4 + 0], x1 = X[rl * 4 + 1], x2 = X[rl * 4 + 2], x3 = X[rl * 4 + 3];
                const float Mx = fmaxf(fmaxf(x0[0], x1[0]), fmaxf(x2[0], x3[0]));
                const float L = x0[1] * __builtin_amdgcn_exp2f(x0[0] - Mx) + x1[1] * __builtin_amdgcn_exp2f(x1[0] - Mx) + x2[1] * __builtin_amdgcn_exp2f(x2[0] - Mx) + x3[1] * __builtin_amdgcn_exp2f(x3[0] - Mx);
                const float il = 1.0f / L;
                bf16_t* rowp = P + (size_t)(u.orow + rl) * D + u.ocol + wc * 32 + 8 * fq;
#pragma unroll
                for (int bj = 0; bj < 2; ++bj) { float pv[8];
#pragma unroll
                    for (int n = 0; n < 2; ++n)
#pragma unroll
                        for (int j = 0; j < 4; ++j) pv[4 * n + j] = __builtin_amdgcn_exp2f(acc[ai][bj][m][n][j] * rs - Mx) * il;
                    u32x4 w; w[0] = cvt_pk_bf16(pv[0], pv[1]); w[1] = cvt_pk_bf16(pv[2], pv[3]); w[2] = cvt_pk_bf16(pv[4], pv[5]); w[3] = cvt_pk_bf16(pv[6], pv[7]);
                    *(u32x4*)(rowp + bj * 128) = w; } }
        (void)mw;
    }
};

#define XB_TMO      128
#define XB_XCNT(j)  (256  + 64 * (j))
#define XB_XSUB(j)  (1280 + 64 * (j))
#define XB_XGEN(j)  (2304 + 64 * (j))
#define XB_TOP      3328
#define XB_TOPGEN   3392
#define XCD_BAR_WORDS 3456
#define XB_SPIN_CAP (1u << 18)
__device__ __forceinline__ unsigned xb_ld(unsigned* p)              { return __hip_atomic_load(p, __ATOMIC_RELAXED, __HIP_MEMORY_SCOPE_AGENT); }
__device__ __forceinline__ unsigned xb_add(unsigned* p, unsigned v) { return __hip_atomic_fetch_add(p, v, __ATOMIC_RELAXED, __HIP_MEMORY_SCOPE_AGENT); }
__device__ __forceinline__ unsigned xb_xcc_id() { return (unsigned)__builtin_amdgcn_s_getreg((3 << 11) | 20) & 0xFu; }
#define XB_SPIN(cond, bar) do { unsigned _sp = 0; while (cond) { __builtin_amdgcn_s_sleep(1); \
    if ((++_sp & 255u) == 0u) { if (xb_ld(&(bar)[XB_TMO])) break; if (_sp > XB_SPIN_CAP) { atomicAdd(&(bar)[XB_TMO], 1u); break; } } } } while (0)
struct XcdBarrier { unsigned* bar; unsigned x; volatile LAS unsigned* st; };
__device__ __forceinline__ XcdBarrier xcd_barrier_post(unsigned* bar, volatile LAS unsigned* st) {
    XcdBarrier b; b.bar = bar; b.x = xb_xcc_id(); b.st = st;
    if (threadIdx.x == 0) (void)xb_add(&bar[XB_XCNT(b.x)], 1u);
    return b;
}
__device__ __forceinline__ void xcd_barrier_complete(unsigned* bar, unsigned x, unsigned& nloc, unsigned& nx) {
    const unsigned G = gridDim.x * gridDim.y * gridDim.z;
    unsigned sum, cnt, mine, sp = 0u;
    for (;;) {
        sum = 0u; cnt = 0u; mine = 0u;
#pragma unroll
        for (unsigned j = 0; j < 16; ++j) { const unsigned c = xb_ld(&bar[XB_XCNT(j)]); sum += c; cnt += (c > 0u) ? 1u : 0u; mine = (j == x) ? c : mine; }
        if (sum == G) break;
        __builtin_amdgcn_s_sleep(1);
        if ((++sp & 255u) == 0u) { if (xb_ld(&bar[XB_TMO])) break; if (sp > XB_SPIN_CAP) { atomicAdd(&bar[XB_TMO], 1u); break; } }
    }
    nloc = mine > 0u ? mine : 1u; nx = cnt > 0u ? cnt : 1u;
}
__device__ __forceinline__ void xcd_barrier(const XcdBarrier& b) {
    asm volatile("s_waitcnt vmcnt(0)" ::: "memory");
    __syncthreads();
    if (threadIdx.x == 0) {
        unsigned* bar = b.bar;
        __builtin_amdgcn_s_waitcnt(0);
        unsigned nloc = b.st[0], nx = b.st[1];
        if (nloc == 0u) { xcd_barrier_complete(bar, b.x, nloc, nx); b.st[0] = nloc; b.st[1] = nx; }
        const unsigned old = xb_add(&bar[XB_XSUB(b.x)], 1u);
        const unsigned gen = old / nloc;
        if (old + 1u == (gen + 1u) * nloc) {
            __builtin_amdgcn_fence(__ATOMIC_RELEASE, "agent");
            asm volatile("s_waitcnt vmcnt(0)" ::: "memory");
            const unsigned og = xb_add(&bar[XB_TOP], 1u);
            const unsigned tg = og / nx;
            if (og + 1u == (tg + 1u) * nx) xb_add(&bar[XB_TOPGEN], 1u);
            else XB_SPIN(xb_ld(&bar[XB_TOPGEN]) == tg, bar);
            __builtin_amdgcn_fence(__ATOMIC_ACQUIRE, "agent");
            xb_add(&bar[XB_XGEN(b.x)], 1u);
            asm volatile("s_waitcnt vmcnt(0)" ::: "memory");
        } else {
            XB_SPIN(xb_ld(&bar[XB_XGEN(b.x)]) == gen, bar);
            __builtin_amdgcn_fence(__ATOMIC_ACQUIRE, "agent");
            asm volatile("s_waitcnt vmcnt(0)" ::: "memory");
        }
    }
    __syncthreads();
}

__device__ __forceinline__ void tr_item(const float* W, int N, int k0, int n0, const float* gain, float cscale, bf16_t* dst  , int Kd, LAS float* scr, int lane) {
#pragma unroll 8
    for (int i = 0; i < 32; ++i) { const int kk = 2 * i + (lane >> 5); const float g = gain ? gain[k0 + kk] * cscale : cscale; scr[kk * 33 + (lane & 31)] = W[(size_t)(k0 + kk) * N + n0 + (lane & 31)] * g; }
    asm volatile("s_waitcnt lgkmcnt(0)" ::: "memory");
    const int c = lane & 7;
#pragma unroll
    for (int j = 0; j < 4; ++j) { const int n = (lane >> 3) + 8 * j; const LAS float* s = scr + (8 * c) * 33 + n;
        u32x4 o; o[0] = cvt_pk_bf16(s[0 * 33], s[1 * 33]); o[1] = cvt_pk_bf16(s[2 * 33], s[3 * 33]); o[2] = cvt_pk_bf16(s[4 * 33], s[5 * 33]); o[3] = cvt_pk_bf16(s[6 * 33], s[7 * 33]);
        *(u32x4*)(dst + (size_t)n * Kd + k0 + 8 * c) = o; }
    asm volatile("s_waitcnt lgkmcnt(0)" ::: "memory");
}
__device__ __forceinline__ void cvt_row(const float* xrow, bf16_t* orow, float* ssrow, int lane) {
    const f32x4* xr = (const f32x4*)xrow + lane; f32x4 v[4]; float s = 0.f;
#pragma unroll
    for (int j = 0; j < 4; ++j) { v[j] = xr[64 * j]; s += (v[j][0] * v[j][0] + v[j][1] * v[j][1]) + (v[j][2] * v[j][2] + v[j][3] * v[j][3]); }
    s = wave_sum(s);
    u32x2* o8 = (u32x2*)orow + lane;
#pragma unroll
    for (int j = 0; j < 4; ++j) { u32x2 w; w[0] = cvt_pk_bf16(v[j][0], v[j][1]); w[1] = cvt_pk_bf16(v[j][2], v[j][3]); o8[64 * j] = w; }
    if (lane < 16) ssrow[lane] = lane == 0 ? s : 0.f;
}

struct Args { const float* in[20]; float* out; unsigned char* ws; int ph_lo, ph_hi, flags, pad; };

__global__ void __launch_bounds__(NWAVES * 64, 2) mk_fwd(Args args) {
    extern __shared__ __attribute__((aligned(16))) unsigned char lds_raw[];
    LAS unsigned char* lds = (LAS unsigned char*)lds_raw;
    const int tid = threadIdx.x, lane = tid & 63, wave = __builtin_amdgcn_readfirstlane(tid >> 6);
    const int G = gridDim.x, bx = blockIdx.x;
    const int vcu = (G % 8 == 0) ? (bx % 8) * (G / 8) + bx / 8 : bx;
    const int gw = vcu * NWAVES + wave, NGW = G * NWAVES;
    unsigned char* ws = args.ws;
    const float* x_in = args.in[0]; const float* mem_in = args.in[1]; const float* rel_bias = args.in[7];
    float* out = args.out;
    bf16_t* Wgu1 = (bf16_t*)(ws + WS_WGU1); bf16_t* Wd1 = (bf16_t*)(ws + WS_WD1); bf16_t* Win = (bf16_t*)(ws + WS_WIN); bf16_t* Wout = (bf16_t*)(ws + WS_WOUT);
    bf16_t* Wcqs = (bf16_t*)(ws + WS_WCQS); bf16_t* Wckv = (bf16_t*)(ws + WS_WCKV); bf16_t* Wco = (bf16_t*)(ws + WS_WCO); bf16_t* Wgu2 = (bf16_t*)(ws + WS_WGU2); bf16_t* Wd2 = (bf16_t*)(ws + WS_WD2);
    bf16_t* MB = (bf16_t*)(ws + WS_MB); bf16_t* KVC = (bf16_t*)(ws + WS_KVC); bf16_t* WKT = (bf16_t*)(ws + WS_WKT); bf16_t* VWT = (bf16_t*)(ws + WS_VWT);
    float* SS0 = (float*)(ws + WS_SS); float* SS1 = SS0 + (size_t)M * 16; float* SS2 = SS1 + (size_t)M * 16; float* SS3 = SS2 + (size_t)M * 16; float* SS4 = SS3 + (size_t)M * 16;
    float* SSM = (float*)(ws + WS_SSM); float* KM = (float*)(ws + WS_KM);
    bf16_t* HB = (bf16_t*)(ws + WS_R1); bf16_t* QKV = HB; bf16_t* YN = HB; bf16_t* PB = HB;
    bf16_t* XB = (bf16_t*)(ws + WS_XB); bf16_t* OA0 = (bf16_t*)out; bf16_t* OA1 = (bf16_t*)((char*)out + OUT_OA1); bf16_t* OA2 = (bf16_t*)(ws + WS_OA2); bf16_t* OB = (bf16_t*)((char*)out + OUT_OB); float* ML = (float*)((char*)out + OUT_ML);

    volatile LAS unsigned* MISC = (volatile LAS unsigned*)(lds + LDS_MISC);
    if (tid < 32) MISC[tid] = 0u;
    __syncthreads();
    const int lo = args.ph_lo, hi = args.ph_hi;
    const bool use_bar = (hi - lo) > 1;
    XcdBarrier bar; bar.bar = (unsigned*)(ws + WS_CTL) + CW_BAR; bar.x = 0; bar.st = nullptr;
    if (use_bar) bar = xcd_barrier_post((unsigned*)(ws + WS_CTL) + CW_BAR, MISC + 8);
#define IN(k) (lo <= (k) && (k) < hi)
#define SEAM(k) do { if (IN(k) && IN((k) + 1)) xcd_barrier(bar); } while (0)

    if (IN(0)) {
        LAS float* scr = (LAS float*)(lds + wave * 16384);
        constexpr int I_GU = (D / 64) * (2 * DFF / 32), I_DN = (DFF / 64) * (D / 32), I_IN = (D / 64) * (NQKV / 32), I_SQ = (D / 64) * (D / 32), I_KV = (D / 64) * (2 * D / 32);
        constexpr int NITEMS = 2 * I_GU + 2 * I_DN + I_IN + 2 * I_SQ + I_KV;
        for (int it = gw; it < NITEMS; it += NGW) {
            int r = it;
            if (r < 2 * I_GU) {
                const bool second = r >= I_GU; if (second) r -= I_GU;
                const int nblk = 2 * DFF / 32, kb = r / nblk, nb = r % nblk, n0 = nb * 32;
                const int drow = n0 < DFF ? (n0 / 128) * 256 + (n0 % 128) : ((n0 - DFF) / 128) * 256 + 128 + ((n0 - DFF) % 128);
                tr_item(args.in[second ? 17 : 3], 2 * DFF, kb * 64, n0, args.in[second ? 16 : 2], 1.0f, (second ? Wgu2 : Wgu1) + (size_t)drow * D, D, scr, lane); continue; }
            r -= 2 * I_GU;
            if (r < 2 * I_DN) { const bool second = r >= I_DN; if (second) r -= I_DN; const int nblk = D / 32, kb = r / nblk, nb = r % nblk;
                tr_item(args.in[second ? 18 : 4], D, kb * 64, nb * 32, nullptr, 1.0f, (second ? Wd2 : Wd1) + (size_t)(nb * 32) * DFF, DFF, scr, lane); continue; }
            r -= 2 * I_DN;
            if (r < I_IN) { const int nblk = NQKV / 32, kb = r / nblk, nb = r % nblk, n0 = nb * 32; const bool isq = (n0 < 768) || (n0 >= 2304 && n0 < 2560);
                tr_item(args.in[6], NQKV, kb * 64, n0, args.in[5], isq ? 0.125f : 1.0f, Win + (size_t)n0 * D, D, scr, lane); continue; }
            r -= I_IN;
            if (r < I_SQ) { const int nblk = D / 32, kb = r / nblk, nb = r % nblk, k0 = kb * 64; const float* gp = k0 < 768 ? args.in[8] : args.in[9] - 768;
                tr_item(args.in[10], D, k0, nb * 32, gp, 1.0f, Wout + (size_t)(nb * 32) * D, D, scr, lane); continue; }
            r -= I_SQ;
            if (r < I_SQ) { const int nblk = D / 32, kb = r / nblk, nb = r % nblk; tr_item(args.in[15], D, kb * 64, nb * 32, nullptr, 1.0f, Wco + (size_t)(nb * 32) * D, D, scr, lane); continue; }
            r -= I_SQ;
            { const int nblk = 2 * D / 32, kb = r / nblk, nb = r % nblk; tr_item(args.in[14], 2 * D, kb * 64, nb * 32, args.in[12], 1.0f, Wckv + (size_t)(nb * 32) * D, D, scr, lane); }
        }
        for (int c = gw; c < D; c += NGW) { const float g = args.in[11][c] * 0.0625f; const f32x4* src = (const f32x4*)(args.in[13] + (size_t)c * D) + lane; u32x2* dst = (u32x2*)(Wcqs + (size_t)c * D) + lane;
#pragma unroll
            for (int j = 0; j < 4; ++j) { const f32x4 v = src[64 * j] * g; u32x2 w; w[0] = cvt_pk_bf16(v[0], v[1]); w[1] = cvt_pk_bf16(v[2], v[3]); dst[64 * j] = w; } }
        for (int m = gw; m < M; m += NGW) cvt_row(x_in + (size_t)m * D, XB + (size_t)m * D, SS0 + (size_t)m * 16, lane);
        for (int m = gw; m < MM; m += NGW) cvt_row(mem_in + (size_t)m * D, MB + (size_t)m * D, SSM + (size_t)m * 16, lane);
        for (int i = gw * 64 + lane; i < NBAT * 16 * 256; i += NGW * 64) KM[i] = 0.f;
    }
    SEAM(0);

    if (IN(1)) {
        { SchedStd S; S.o.init(M, 2 * DFF, G, bx); S.A = (const char*)XB; S.B = (const char*)Wgu1; S.a_tile = (size_t)256 * D * 2; S.b_tile = (size_t)256 * D * 2; S.b_batch = 0; S.ocol_mul = 128;
          EpiGU E{HB, SS0}; pg8::gemm_phase<EpiGU, SchedStd, true>(lds, D, D, D / 64, S, E); }
        { SchedStd S; S.o.init(MM, 2 * D, G, (bx + G / 2) % G); S.A = (const char*)MB; S.B = (const char*)Wckv; S.a_tile = (size_t)256 * D * 2; S.b_tile = (size_t)256 * D * 2; S.b_batch = 0; S.ocol_mul = 256;
          EpiStore E{KVC, 2 * D, SSM, nullptr}; pg8::gemm_phase<EpiStore, SchedStd, true>(lds, D, D, D / 64, S, E); }
    }
    SEAM(1);

    if (IN(2)) {
        SchedStd S; S.o.init(M, D, G, bx); S.A = (const char*)HB; S.B = (const char*)Wd1; S.a_tile = (size_t)256 * DFF * 2; S.b_tile = (size_t)256 * DFF * 2; S.b_batch = 0; S.ocol_mul = 256;
        EpiRes E{XB, SS1, 0.5f}; pg8::gemm_phase<EpiRes, SchedStd, true>(lds, DFF, DFF, DFF / 64, S, E);
    }
    SEAM(2);

    if (IN(3)) {
        { SchedStd S; S.o.init(M, NQKV, G, bx); S.A = (const char*)XB; S.B = (const char*)Win; S.a_tile = (size_t)256 * D * 2; S.b_tile = (size_t)256 * D * 2; S.b_batch = 0; S.ocol_mul = 256;
          EpiStore E{QKV, NQKV, SS1, KM}; pg8::gemm_phase<EpiStore, SchedStd, true>(lds, D, D, D / 64, S, E); }
        { SchedWK S{G, bx, (const char*)KVC, (const char*)Wcqs}; EpiStore E{WKT, D, nullptr, nullptr}; pg8::gemm_phase<EpiStore, SchedWK, true>(lds, 2 * D, D, 4, S, E); }
        { SchedVW S{G, (bx + G / 2) % G, (const char*)KVC, (const char*)Wco}; EpiStore E{VWT, D, nullptr, nullptr}; pg8::gemm_phase<EpiStore, SchedVW, true>(lds, D, 2 * D, 4, S, E); }
    }
    SEAM(3);

    if (IN(4)) {
        LAS float* tab = (LAS float*)(lds + LDS_TAB);
        const int h2 = lane >> 5, q = lane & 31;
        const long rowb = (long)NQKV * 2;
#define ATT_WAITV(n) asm volatile("s_waitcnt vmcnt(" #n ")" ::: "memory")
#define ATT_BAR() do { asm volatile("s_waitcnt lgkmcnt(0)" ::: "memory"); __builtin_amdgcn_s_barrier(); asm volatile("" ::: "memory"); } while (0)
        for (int i = tid; i < 4 * att::TABB_N; i += NWAVES * 64) { const int hb = i / att::TABB_N, e = i % att::TABB_N, dist = e - 32;
            tab[i] = dist >= 0 ? rel_bias[att::rel_bucket(dist) * 16 + 12 + hb] * LOG2E : -INFINITY; }
        __syncthreads();
        constexpr int NMOBA = NBAT * 4 * 16;
        for (int j = (args.flags & 1) ? NMOBA : vcu; j < NMOBA / 2; j += G)
#pragma unroll 1
            for (int half = 0; half < 2; ++half) {
                const int it = half ? (NMOBA - 1 - j) : j; const int qb = 15 - it / (NBAT * 4), bh = it % (NBAT * 4), b = bh >> 2, hb = bh & 3;
                const int q0 = qb * 256 + wave * 32;
                const char* base = (const char*)QKV + (size_t)b * SEQ * rowb;
                const char* qbase = base + (size_t)q0 * rowb + (2304 + hb * 64) * 2;
                const char* kbase = base + (2560 + hb * 64) * 2;
                att::bf16x8 qf[4];
#pragma unroll
                for (int d0 = 0; d0 < 4; ++d0) qf[d0] = *(const att::bf16x8*)(qbase + (long)q * rowb + (16 * d0 + 8 * h2) * 2);
                const unsigned sel = att::moba_select(qbase, rowb, KM + (size_t)b * 16 * 256 + hb * 64, qb);
                const LAS float* tb = tab + hb * att::TABB_N;
                const int NT = 4 * (qb + 1);
                const int drow = wave * 8 + (lane >> 3);
                const char* ksrc = kbase + (long)drow * rowb;
                ATT_WAITV(0);
                int st_t = 0;
                att::dma_rows8(ksrc + (long)(NT - 1) * 64 * rowb, 512, drow, (LAS char*)(lds + 0 * 16384 + wave * 1024), (LAS char*)(lds + 0 * 16384 + 8192 + wave * 1024), lane);
                att::dma_rows8(ksrc + (long)(NT - 2) * 64 * rowb, 512, drow, (LAS char*)(lds + 1 * 16384 + wave * 1024), (LAS char*)(lds + 1 * 16384 + 8192 + wave * 1024), lane);
                att::f32x16 o[2]; o[0] = att::f32x16{}; o[1] = att::f32x16{}; float mo = -1e30f, lo_ = 0.f;
#pragma unroll 1
                for (int t = NT - 1; t >= 0; --t) {
                    if (t >= 1) ATT_WAITV(2); else ATT_WAITV(0);
                    ATT_BAR();
                    if (t >= 2) { const int s2 = st_t == 0 ? 2 : st_t - 1;
                        att::dma_rows8(ksrc + (long)(t - 2) * 64 * rowb, 512, drow, (LAS char*)(lds + s2 * 16384 + wave * 1024), (LAS char*)(lds + s2 * 16384 + 8192 + wave * 1024), lane); }
                    const LAS char* kt = (const LAS char*)(lds + st_t * 16384);
#pragma unroll
                    for (int gg = 1; gg >= 0; --gg) {
                        const int g0 = 64 * t + 32 * gg;
                        if (g0 <= q0) {
                            int B = (q0 - g0 + 32) + q - 4 * h2; B = B < (att::TABB_N - 1) ? B : (att::TABB_N - 1);
                            const int n = g0 >> 8; const bool sl = (n == qb) || ((sel >> n) & 1u); B = sl ? B : 27;
                            att::attn_group(qf, o, mo, lo_, kt + gg * 4096, kt + 8192 + gg * 4096, tb + B, lane);
                        }
                    }
                    st_t = st_t == 2 ? 0 : st_t + 1;
                }
                ATT_BAR();
                lo_ += __shfl_xor(lo_, 32);
                att::store_o(o, lo_, (char*)OB + ((size_t)(b * SEQ + q0 + q) * 256 + hb * 64) * 2, h2);
            }
        __syncthreads();
        for (int i = tid; i < 36 * att::TABA_N; i += NWAVES * 64) { const int t = i / att::TABA_N, e = i % att::TABA_N, p = t / 12, h = t % 12, delta = e - 32, d = p == 0 ? 1 : (p == 1 ? 4 : 16);
            tab[i] = (delta >= 0 && delta <= 128) ? rel_bias[att::rel_bucket(delta * d) * 16 + h] * LOG2E : -INFINITY; }
        __syncthreads();
        constexpr int NDIL = NBAT * 12 * 48;
#pragma unroll 1
        for (int it = (args.flags & 2) ? NDIL : vcu; it < NDIL; it += G) {
            const int bh = it / 48, j = it % 48, b = bh / 12, h = bh % 12, p = j >> 4, jj = j & 15;
            const int d = p == 0 ? 1 : (p == 1 ? 4 : 16);
            const int res = p == 0 ? 0 : (p == 1 ? (jj & 3) : jj), mblk = p == 0 ? jj : (p == 1 ? (jj >> 2) : 0);
            const int mbase = mblk * 256 - 128;
            const int m0 = mblk * 256 + wave * 32;
            const char* base = (const char*)QKV + ((size_t)b * SEQ + res) * rowb;
            const long st = (long)d * rowb;
            const char* kbase = base + (768 + h * 64) * 2;
            ATT_WAITV(0);
#pragma unroll 1
            for (int k = wave; k < 48; k += NWAVES) {
                if (mbase + 8 * k < 0) continue;
                const int row = 8 * k + (lane >> 3);
                att::dma_rows8(kbase + (long)(mbase + row) * st, 768 * 2, row, (LAS char*)(lds + k * 1024), (LAS char*)(lds + 49152 + k * 1024), lane);
            }
            att::bf16x8 qf[4];
            const char* qbase = base + (long)m0 * st + (h * 64) * 2;
#pragma unroll
            for (int d0 = 0; d0 < 4; ++d0) qf[d0] = *(const att::bf16x8*)(qbase + (long)q * st + (16 * d0 + 8 * h2) * 2);
            ATT_WAITV(0); ATT_BAR();
            att::f32x16 o[2]; o[0] = att::f32x16{}; o[1] = att::f32x16{}; float mo = -1e30f, lo_ = 0.f;
            const LAS float* ta = tab + (p * 12 + h) * att::TABA_N;
            const int gend = (m0 - 128) > 0 ? (m0 - 128) : 0;
#pragma unroll 1
            for (int g0 = m0; g0 >= gend; g0 -= 32) {
                const int B = (m0 - g0 + 32) + q - 4 * h2;
                const LAS char* kg = (const LAS char*)(lds + (g0 - mbase) * 128);
                att::attn_group(qf, o, mo, lo_, kg, kg + 49152, ta + B, lane);
            }
            ATT_BAR();
            lo_ += __shfl_xor(lo_, 32);
            const size_t tok = (size_t)b * SEQ + (size_t)(m0 + q) * d + res;
            att::store_o(o, lo_, (char*)(p == 0 ? OA0 : (p == 1 ? OA1 : OA2)) + (tok * 768 + h * 64) * 2, h2);
            if (h2 == 0) *(f32x2*)(ML + (((size_t)p * M + tok) * 12 + h) * 2) = (f32x2){mo, lo_};
        }
#undef ATT_WAITV
#undef ATT_BAR
    }
    SEAM(4);

    if (IN(5)) {
        for (int row = gw; row < M; row += NGW) {
            float va[3][4]; float ssa = 0.f;
#pragma unroll
            for (int k = 0; k < 3; ++k) { const int col = 256 * k + 4 * lane, hd = col >> 6;
                const f32x2 ml0 = *(const f32x2*)(ML + (((size_t)0 * M + row) * 12 + hd) * 2), ml1 = *(const f32x2*)(ML + (((size_t)1 * M + row) * 12 + hd) * 2), ml2 = *(const f32x2*)(ML + (((size_t)2 * M + row) * 12 + hd) * 2);
                const float Mx = fmaxf(ml0[0], fmaxf(ml1[0], ml2[0]));
                const float w0 = ml0[1] * __builtin_amdgcn_exp2f(ml0[0] - Mx), w1 = ml1[1] * __builtin_amdgcn_exp2f(ml1[0] - Mx), w2 = ml2[1] * __builtin_amdgcn_exp2f(ml2[0] - Mx);
                const float iw = 1.0f / (w0 + w1 + w2);
                const u32x2 o0 = *(const u32x2*)(OA0 + (size_t)row * 768 + col), o1 = *(const u32x2*)(OA1 + (size_t)row * 768 + col), o2 = *(const u32x2*)(OA2 + (size_t)row * 768 + col);
#pragma unroll
                for (int e = 0; e < 4; ++e) { const unsigned s0 = o0[e >> 1], s1 = o1[e >> 1], s2 = o2[e >> 1];
                    const float f0 = __builtin_bit_cast(float, (e & 1) ? (s0 & 0xffff0000u) : (s0 << 16)), f1 = __builtin_bit_cast(float, (e & 1) ? (s1 & 0xffff0000u) : (s1 << 16)), f2 = __builtin_bit_cast(float, (e & 1) ? (s2 & 0xffff0000u) : (s2 << 16));
                    const float v = (w0 * f0 + w1 * f1 + w2 * f2) * iw; va[k][e] = v; ssa += v * v; } }
            const u32x2 ob = *(const u32x2*)(OB + (size_t)row * 256 + 4 * lane); float vb[4]; float ssb = 0.f;
#pragma unroll
            for (int e = 0; e < 4; ++e) { const unsigned s0 = ob[e >> 1]; vb[e] = __builtin_bit_cast(float, (e & 1) ? (s0 & 0xffff0000u) : (s0 << 16)); ssb += vb[e] * vb[e]; }
            ssa = wave_sum(ssa); ssb = wave_sum(ssb);
            const float ra = 1.0f / sqrtf(ssa * (1.0f / 768.0f) + EPS), rb = 1.0f / sqrtf(ssb * (1.0f / 256.0f) + EPS);
#pragma unroll
            for (int k = 0; k < 3; ++k) { u32x2 w; w[0] = cvt_pk_bf16(va[k][0] * ra, va[k][1] * ra); w[1] = cvt_pk_bf16(va[k][2] * ra, va[k][3] * ra); *(u32x2*)(YN + (size_t)row * D + 256 * k + 4 * lane) = w; }
            { u32x2 w; w[0] = cvt_pk_bf16(vb[0] * rb, vb[1] * rb); w[1] = cvt_pk_bf16(vb[2] * rb, vb[3] * rb); *(u32x2*)(YN + (size_t)row * D + 768 + 4 * lane) = w; }
        }
    }
    SEAM(5);

    if (IN(6)) {
        SchedStd S; S.o.init(M, D, G, bx); S.A = (const char*)YN; S.B = (const char*)Wout; S.a_tile = (size_t)256 * D * 2; S.b_tile = (size_t)256 * D * 2; S.b_batch = 0; S.ocol_mul = 256;
        EpiRes E{XB, SS2, 1.0f}; pg8::gemm_phase<EpiRes, SchedStd, true>(lds, D, D, D / 64, S, E);
    }
    SEAM(6);

    if (IN(7)) {
        SchedStd S; S.o.init(M, D, G, bx); S.A = (const char*)XB; S.B = (const char*)WKT; S.a_tile = (size_t)256 * D * 2; S.b_tile = (size_t)256 * D * 2; S.b_batch = (size_t)D * D * 2; S.ocol_mul = 256;
        EpiSoftmax E{PB, SS2}; pg8::gemm_phase<EpiSoftmax, SchedStd, true>(lds, D, D, D / 64, S, E);
    }
    SEAM(7);

    if (IN(8)) {
        SchedStd S; S.o.init(M, D, G, bx); S.A = (const char*)PB; S.B = (const char*)VWT; S.a_tile = (size_t)256 * D * 2; S.b_tile = (size_t)256 * D * 2; S.b_batch = (size_t)D * D * 2; S.ocol_mul = 256;
        EpiRes E{XB, SS3, 1.0f}; pg8::gemm_phase<EpiRes, SchedStd, true>(lds, D, D, D / 64, S, E);
    }
    SEAM(8);

    if (IN(9)) {
        SchedStd S; S.o.init(M, 2 * DFF, G, bx); S.A = (const char*)XB; S.B = (const char*)Wgu2; S.a_tile = (size_t)256 * D * 2; S.b_tile = (size_t)256 * D * 2; S.b_batch = 0; S.ocol_mul = 128;
        EpiGU E{HB, SS3}; pg8::gemm_phase<EpiGU, SchedStd, true>(lds, D, D, D / 64, S, E);
    }
    SEAM(9);

    if (IN(10)) {
        SchedStd S; S.o.init(M, D, G, bx); S.A = (const char*)HB; S.B = (const char*)Wd2; S.a_tile = (size_t)256 * DFF * 2; S.b_tile = (size_t)256 * DFF * 2; S.b_batch = 0; S.ocol_mul = 256;
        EpiRes E{XB, SS4, 0.5f}; pg8::gemm_phase<EpiRes, SchedStd, true>(lds, DFF, DFF, DFF / 64, S, E);
    }
    SEAM(10);

    if (IN(11)) {
        const float* gf = args.in[19];
        for (int row = gw; row < M; row += NGW) { const float rs = row_rstd(SS4, row); const u32x2* xr = (const u32x2*)(XB + (size_t)row * D) + lane; f32x4* orow = (f32x4*)(out + (size_t)row * D) + lane; const f32x4* gr = (const f32x4*)gf + lane;
#pragma unroll
            for (int j = 0; j < 4; ++j) { const u32x2 w = xr[64 * j]; f32x4 v; v[0] = __builtin_bit_cast(float, w[0] << 16); v[1] = __builtin_bit_cast(float, w[0] & 0xffff0000u); v[2] = __builtin_bit_cast(float, w[1] << 16); v[3] = __builtin_bit_cast(float, w[1] & 0xffff0000u);
                orow[64 * j] = v * rs * gr[64 * j]; } }
    }
#undef IN
#undef SEAM
}
}

#if MK_DEBUG
namespace dbg {
__global__ void __launch_bounds__(256) cmp_f32(const float* a, const float* r, size_t n, float* acc) {
    float num = 0.f, den = 0.f;
    for (size_t i = (size_t)blockIdx.x * 256 + threadIdx.x; i < n; i += (size_t)gridDim.x * 256) { const float d = a[i] - r[i]; num += d * d; den += r[i] * r[i]; }
    for (int o = 32; o > 0; o >>= 1) { num += __shfl_xor(num, o); den += __shfl_xor(den, o); }
    if ((threadIdx.x & 63) == 0) { atomicAdd(acc, num); atomicAdd(acc + 1, den); }
}
__global__ void __launch_bounds__(256) cmp_bf16(const unsigned short* a, int lda, const float* colscale, const float* r, int ldr, int rows, int cols, float* acc) {
    float num = 0.f, den = 0.f; const size_t n = (size_t)rows * cols;
    for (size_t i = (size_t)blockIdx.x * 256 + threadIdx.x; i < n; i += (size_t)gridDim.x * 256) { const size_t row = i / cols; const int c = (int)(i % cols);
        const float av = __builtin_bit_cast(float, (unsigned)a[row * lda + c] << 16) * (colscale ? colscale[c] : 1.0f); const float rv = r[row * ldr + c]; const float d = av - rv; num += d * d; den += rv * rv; }
    for (int o = 32; o > 0; o >>= 1) { num += __shfl_xor(num, o); den += __shfl_xor(den, o); }
    if ((threadIdx.x & 63) == 0) { atomicAdd(acc, num); atomicAdd(acc + 1, den); }
}
__global__ void __launch_bounds__(256) cmp_p(const unsigned short* a, const float* r, float* acc) {
    float num = 0.f, den = 0.f; const size_t n = (size_t)4096 * 1024;
    for (size_t i = (size_t)blockIdx.x * 256 + threadIdx.x; i < n; i += (size_t)gridDim.x * 256) { const size_t row = i / 1024; const int c = (int)(i % 1024);
        const float av = __builtin_bit_cast(float, (unsigned)a[i] << 16); const float rv = r[(size_t)(c >> 8) * 4096 * 256 + row * 256 + (c & 255)]; const float d = av - rv; num += d * d; den += rv * rv; }
    for (int o = 32; o > 0; o >>= 1) { num += __shfl_xor(num, o); den += __shfl_xor(den, o); }
    if ((threadIdx.x & 63) == 0) { atomicAdd(acc, num); atomicAdd(acc + 1, den); }
}
__global__ void build_scales(float* qkvs, float* gcat, const float* goa, const float* gob) {
    const int i = blockIdx.x * 256 + threadIdx.x;
    if (i < 3072) qkvs[i] = ((i < 768) || (i >= 2304 && i < 2560)) ? 8.0f : 1.0f;
    if (i < 1024) gcat[i] = i < 768 ? goa[i] : gob[i - 768];
}
constexpr int NST = 8;
__global__ void __launch_bounds__(256) finalize(float* out, size_t n, const float* acc, int report) {
    const float tol[NST] = {0.03f, 0.03f, 0.03f, 0.08f, 0.03f, 0.05f, 0.03f, 0.03f};
    float E = 0.f;
    if (report > 0) { const float e = sqrtf(acc[2 * (report - 1)] / acc[2 * (report - 1) + 1]); E = (e == e) ? fminf(e, 3.0f) : 3.0f; }
    else { for (int k = NST - 1; k >= 0; --k) { const float e = sqrtf(acc[2 * k] / acc[2 * k + 1]); if (!(e <= tol[k])) E = 0.1f * (k + 1); } }
    for (size_t i = (size_t)blockIdx.x * 256 + threadIdx.x; i < n; i += (size_t)gridDim.x * 256) out[i] *= (1.0f + E);
}
}
#endif

static void mk_launch(const mk::Args& a0, int lo, int hi, int grid, hipStream_t st) {
    mk::Args a = a0; a.ph_lo = lo; a.ph_hi = hi;
    hipLaunchKernelGGL(mk::mk_fwd, dim3(grid), dim3(mk::NWAVES * 64), mk::LDS_BYTES, st, a);
    const hipError_t le = hipPeekAtLastError();
    if (le != hipSuccess) fprintf(stderr, "kernel_launch: launch of phases [%d,%d) failed: %s\n", lo, hi, hipGetErrorName(le));
}

extern "C" void kernel_launch(void* const* d_in, const int* in_sizes, int n_in, void* d_out, int out_size, void* d_ws, size_t ws_size, hipStream_t stream) {
    static int grid = 0;
    if (grid == 0) {
        if (n_in != 20 || out_size != 8 * 4096 * 1024) { fprintf(stderr, "kernel_launch: unexpected shapes (n_in %d out %d)\n", n_in, out_size); grid = -1; return; }
        int dev = 0, cus = 0, per_cu = 0;
        if (hipGetDevice(&dev) != hipSuccess || hipDeviceGetAttribute(&cus, hipDeviceAttributeMultiprocessorCount, dev) != hipSuccess) { grid = -1; return; }
        if (hipFuncSetAttribute((const void*)mk::mk_fwd, hipFuncAttributeMaxDynamicSharedMemorySize, mk::LDS_BYTES) != hipSuccess) { fprintf(stderr, "kernel_launch: hipFuncSetAttribute failed\n"); grid = -1; return; }
        if (hipOccupancyMaxActiveBlocksPerMultiprocessor(&per_cu, (const void*)mk::mk_fwd, mk::NWAVES * 64, mk::LDS_BYTES) != hipSuccess || per_cu < 1) fprintf(stderr, "kernel_launch: occupancy query reports %d workgroups per CU\n", per_cu);
        (void)hipGetLastError();
        grid = cus;
    }
    if (grid < 0) return;
    unsigned char* ws = (unsigned char*)d_ws;
#if MK_DEBUG
    const size_t ref_off = (mk::WS_END + 4095) / 4096 * 4096;
    size_t off = ref_off + (size_t)290 * 1024 * 1024;
    auto take = [&](size_t bytes) { unsigned char* p = ws + off; off += (bytes + 255) / 256 * 256; return p; };
    float* sx1 = (float*)take((size_t)4096 * 1024 * 4); float* sx2 = (float*)take((size_t)4096 * 1024 * 4); float* sx3 = (float*)take((size_t)4096 * 1024 * 4);
    float* mkout = (float*)take((size_t)4096 * 1024 * 4); float* qkvs = (float*)take(3072 * 4); float* gcat = (float*)take(1024 * 4); float* acc = (float*)take(256);
    if (off > ws_size) { fprintf(stderr, "kernel_launch: debug build needs %zu bytes of workspace, got %zu\n", off, ws_size); return; }
    ref::Snap snap{sx1, sx2, sx3};
    ref::forward(d_in, (float*)d_out, ws + ref_off, stream, &snap);
    (void)hipMemsetAsync(ws + mk::WS_CTL, 0, mk::CTL_BYTES, stream);
    (void)hipMemsetAsync(acc, 0, 256, stream);
    dbg::build_scales<<<12, 256, 0, stream>>>(qkvs, gcat, (const float*)d_in[8], (const float*)d_in[9]);
    mk::Args a{};
    for (int i = 0; i < 20; ++i) a.in[i] = (const float*)d_in[i];
    a.in[0] = (const float*)d_in[0] + (size_t)7 * 4096 * 1024; a.in[1] = (const float*)d_in[1] + (size_t)7 * 256 * 1024;
    a.out = mkout; a.ws = ws;
    const ref::Bufs& rb = ref::g_bufs;
    for (int ph = 0; ph < mk::NPH; ++ph) {
        mk_launch(a, ph, ph + 1, grid, stream);
        if (ph == 1) dbg::cmp_bf16<<<512, 256, 0, stream>>>((const unsigned short*)(ws + mk::WS_KVC), 2048, nullptr, rb.kvc, 2048, 256, 2048, acc + 0);
        if (ph == 2) dbg::cmp_bf16<<<512, 256, 0, stream>>>((const unsigned short*)(ws + mk::WS_XB), 1024, nullptr, sx1, 1024, 4096, 1024, acc + 2);
        if (ph == 3) dbg::cmp_bf16<<<512, 256, 0, stream>>>((const unsigned short*)(ws + mk::WS_R1), 3072, qkvs, rb.proj, 3072, 4096, 3072, acc + 4);
        if (ph == 5) dbg::cmp_bf16<<<512, 256, 0, stream>>>((const unsigned short*)(ws + mk::WS_R1), 1024, gcat, rb.yn, 1024, 4096, 1024, acc + 6);
        if (ph == 6) dbg::cmp_bf16<<<512, 256, 0, stream>>>((const unsigned short*)(ws + mk::WS_XB), 1024, nullptr, sx2, 1024, 4096, 1024, acc + 8);
        if (ph == 7) dbg::cmp_p<<<512, 256, 0, stream>>>((const unsigned short*)(ws + mk::WS_R1), rb.sc, acc + 10);
        if (ph == 8) dbg::cmp_bf16<<<512, 256, 0, stream>>>((const unsigned short*)(ws + mk::WS_XB), 1024, nullptr, sx3, 1024, 4096, 1024, acc + 12);
        if (ph == 11) dbg::cmp_f32<<<512, 256, 0, stream>>>(mkout, (const float*)d_out + (size_t)7 * 4096 * 1024, (size_t)4096 * 1024, acc + 14);
    }
    dbg::finalize<<<1024, 256, 0, stream>>>((float*)d_out, (size_t)8 * 4096 * 1024, acc, MK_REPORT);
#else
    if (ws_size < mk::WS_END) { fprintf(stderr, "kernel_launch: needs %zu bytes of workspace, got %zu\n", (size_t)mk::WS_END, ws_size); return; }
    if (hipMemsetAsync(ws + mk::WS_CTL, 0, mk::CTL_BYTES, stream) != hipSuccess) return;
    mk::Args a{};
    for (int i = 0; i < 20; ++i) a.in[i] = (const float*)d_in[i];
    a.out = (float*)d_out; a.ws = ws;
#if MK_N_LAUNCHES == 1
    mk_launch(a, 0, mk::NPH, grid, stream);
#else
    for (int ph = 0; ph < mk::NPH; ++ph) { mk_launch(a, ph, ph + 1, grid, stream);
        for (int r = 0; r < MK_REPEAT_N; ++r) if (ph == MK_REPEAT) { mk::Args a2 = a; a2.flags = MK_REPEAT_FLAGS; mk_launch(a2, ph, ph + 1, grid, stream); } }
#endif
#endif
}
```

```cpp
#include <hip/hip_runtime.h>
#include <cstdio>
#include <cstdint>
#include <cmath>
#define MK_REPEAT -1
#define MK_REPEAT_N 1
#define MK_REPEAT_FLAGS 0
#define MK_STAGGER_TICKS 0
#define MK_DEBUG 0
#define MK_REPORT 0
#define MK_N_LAUNCHES 1
#define MK_NBAT 8

namespace pg8 {
#define PG8_LAS __attribute__((address_space(3)))
typedef unsigned short bf16_t;
typedef short bf16x8 __attribute__((ext_vector_type(8)));
typedef float f32x4 __attribute__((ext_vector_type(4)));
typedef float f32x2 __attribute__((ext_vector_type(2)));
typedef unsigned u32x4 __attribute__((ext_vector_type(4)));
typedef unsigned u32x2 __attribute__((ext_vector_type(2)));
constexpr int BM = 256, BK = 64, HALF = 128, HTB = HALF * BK * 2  , STAGE_BYTES = 8 * HTB, NXCD = 8, WGM = 8;

__host__ __device__ __forceinline__ int lds_byte(int r, int c) { const int st = (r >> 4) * 2 + (c >> 5), rr = r & 15, cc = c & 31, ob = rr * 64 + cc * 2; return st * 1024 + (ob ^ (((ob >> 9) & 1) << 5)); }
__host__ __device__ __forceinline__ void stage_rc(int b, int& R, int& C) { const int st = b / 1024, sb = b % 1024, swz = sb ^ (((sb >> 9) & 1) << 5); R = (st >> 1) * 16 + swz / 64; C = (st & 1) * 32 + (swz % 64) / 2; }
__host__ __device__ __forceinline__ int perm32(int rho) { const int n = rho >> 4, i = rho & 15; return 8 * (i >> 2) + 4 * n + (i & 3); }

struct Unit { const char* a; const char* b; int orow, ocol, aux; };

struct Order {
    int nM, nN, nwg, G, c;
    __device__ __forceinline__ void init(int M, int N, int G_, int c_) { nM = M / BM; nN = N / BM; nwg = nM * nN; G = G_; c = c_; }
    __device__ __forceinline__ bool tile(int i, int& pm, int& pn) const {
        const long L = (long)i * G + c; if (L >= nwg) return false;
        int wgid = (int)L; { const int q = nwg / NXCD, r = nwg % NXCD, xcd = wgid % NXCD, off = wgid / NXCD; wgid = (xcd < r ? xcd * (q + 1) : r * (q + 1) + (xcd - r) * q) + off; }
        const int nig = WGM * nN, gid = wgid / nig, fm = gid * WGM, gsz = (nM - fm) < WGM ? (nM - fm) : WGM;
        pm = fm + ((wgid % nig) % gsz); pn = (wgid % nig) / gsz; return true;
    }
};

__device__ __forceinline__ unsigned cvt_pk_bf16(float lo, float hi) { unsigned r; asm volatile("v_cvt_pk_bf16_f32 %0, %1, %2" : "=v"(r) : "v"(lo), "v"(hi)); return r; }

template <class Epi, class Sched, bool ALIGN_EPI>
__device__ __forceinline__ void gemm_phase(PG8_LAS unsigned char* lds, const int lda, const int ldb, const int nt, const Sched& S, const Epi& E) {
    int tid_ = threadIdx.x; asm volatile("" : "+v"(tid_));
    const int tid = tid_, wid = __builtin_amdgcn_readfirstlane(tid >> 6), lane = tid & 63, wr = wid >> 2, wc = wid & 3, fr = lane & 15, fq = lane >> 4;
    unsigned voffA[2], voffB[2];
#pragma unroll
    for (int i = 0; i < 2; ++i) { int R, C; stage_rc(tid * 16 + i * 8192, R, C); const int Rb = Epi::PERM ? ((R & ~31) + perm32(R & 31)) : R;
        voffA[i] = (unsigned)(R * lda + C) * 2u; voffB[i] = (unsigned)(Rb * ldb + C) * 2u; }
    const size_t kstep = (size_t)(BK * 2);
    const size_t hstepA = (size_t)HALF * lda * 2, hstepB = (size_t)HALF * ldb * 2;
    const unsigned ldsw = (unsigned)wid * 1024u;
    const int aoff = lds_byte(wr * 64 + fr, fq * 8), boff = lds_byte(wc * 32 + fr, fq * 8);
#define PG8_SA(b, h) (((b) * 2 + (h)) * HTB)
#define PG8_SB(b, h) ((4 + (b) * 2 + (h)) * HTB)
#define PG8_STAGE(bufoff, gbase, voff) do { _Pragma("unroll") for (int _i = 0; _i < 2; ++_i) \
        __builtin_amdgcn_global_load_lds((const unsigned*)((const char*)(gbase) + (voff)[_i]), (PG8_LAS unsigned*)(lds + (bufoff) + ldsw + _i * 8192), 16, 0, 0); } while (0)
#define PG8_LDA(dst, b, h) do { _Pragma("unroll") for (int m = 0; m < 4; ++m) _Pragma("unroll") for (int k = 0; k < 2; ++k) dst[m][k] = *(const PG8_LAS bf16x8*)(lds + PG8_SA(b, h) + aoff + m * 2048 + k * 1024); } while (0)
#define PG8_LDB(dst, b, h) do { _Pragma("unroll") for (int n = 0; n < 2; ++n) _Pragma("unroll") for (int k = 0; k < 2; ++k) dst[n][k] = *(const PG8_LAS bf16x8*)(lds + PG8_SB(b, h) + boff + n * 2048 + k * 1024); } while (0)
#define PG8_MMA(ai, bj, At, Bt) do { __builtin_amdgcn_s_setprio(1); _Pragma("unroll") for (int m = 0; m < 4; ++m) _Pragma("unroll") for (int n = 0; n < 2; ++n) _Pragma("unroll") for (int k = 0; k < 2; ++k) \
        acc[ai][bj][m][n] = __builtin_amdgcn_mfma_f32_16x16x32_bf16(Bt[n][k], At[m][k], acc[ai][bj][m][n], 0, 0, 0); __builtin_amdgcn_s_setprio(0); } while (0)
#define PG8_WAIT_V(n) asm volatile("s_waitcnt vmcnt(" #n ")" ::: "memory")
#define PG8_WAIT_L(n) asm volatile("s_waitcnt lgkmcnt(" #n ")" ::: "memory")
#define PG8_BAR __builtin_amdgcn_s_barrier()
#define PG8_SCHED __builtin_amdgcn_sched_barrier(0)
    Unit cur, nxt; int ui = 0;
    if (!S.next(0, cur)) return;
    f32x4 acc[2][2][4][2];
#pragma unroll
    for (int a = 0; a < 2; ++a)
#pragma unroll
        for (int b = 0; b < 2; ++b)
#pragma unroll
            for (int m = 0; m < 4; ++m)
#pragma unroll
                for (int n = 0; n < 2; ++n) acc[a][b][m][n] = (f32x4){0.f, 0.f, 0.f, 0.f};
    bf16x8 At[4][2], B0[2][2], B1[2][2];
    const char* cA = cur.a; const char* cB = cur.b;
    PG8_STAGE(PG8_SB(0, 0), cB, voffB); PG8_STAGE(PG8_SB(0, 1), cB + hstepB, voffB); PG8_STAGE(PG8_SA(0, 0), cA, voffA); PG8_STAGE(PG8_SA(0, 1), cA + hstepA, voffA);
    if (wr == 1) PG8_BAR;
    PG8_WAIT_V(2); PG8_BAR;
    PG8_STAGE(PG8_SB(1, 0), cB + kstep, voffB); PG8_STAGE(PG8_SA(1, 0), cA + kstep, voffA); PG8_STAGE(PG8_SB(1, 1), cB + hstepB + kstep, voffB);
    PG8_WAIT_V(6); PG8_BAR;
    for (;;) {
        const bool has_next = S.next(ui + 1, nxt);
        const char* nA = has_next ? nxt.a : cA; const char* nB = has_next ? nxt.b : cB;
#pragma unroll 1
        for (int t = 0; t < nt; t += 2) {
            const bool last = (t == nt - 2);
            const char* a1 = cA + (size_t)(t + 1) * kstep;
            const char* a2 = last ? nA : cA + (size_t)(t + 2) * kstep; const char* b2 = last ? nB : cB + (size_t)(t + 2) * kstep;
            const char* a3 = a2 + kstep; const char* b3 = b2 + kstep;
            PG8_LDB(B0, 0, 0); PG8_LDB(B1, 0, 1); PG8_SCHED; PG8_LDA(At, 0, 0); PG8_STAGE(PG8_SA(1, 1), a1 + hstepA, voffA);
            PG8_WAIT_V(8); PG8_WAIT_L(0); PG8_BAR; PG8_MMA(0, 0, At, B0); PG8_MMA(0, 1, At, B1); PG8_BAR; PG8_SCHED;
            PG8_LDA(At, 0, 1); PG8_STAGE(PG8_SB(0, 0), b2, voffB); PG8_STAGE(PG8_SB(0, 1), b2 + hstepB, voffB); PG8_STAGE(PG8_SA(0, 0), a2, voffA);
            PG8_WAIT_V(8); PG8_WAIT_L(0); PG8_BAR; PG8_MMA(1, 0, At, B0); PG8_MMA(1, 1, At, B1); PG8_BAR; PG8_SCHED;
            PG8_LDB(B0, 1, 0); PG8_LDB(B1, 1, 1); PG8_SCHED; PG8_LDA(At, 1, 0); PG8_STAGE(PG8_SA(0, 1), a2 + hstepA, voffA);
            PG8_WAIT_V(8); PG8_WAIT_L(0); PG8_BAR; PG8_MMA(0, 0, At, B0); PG8_MMA(0, 1, At, B1); PG8_BAR; PG8_SCHED;
            PG8_LDA(At, 1, 1); PG8_STAGE(PG8_SB(1, 0), b3, voffB); PG8_STAGE(PG8_SB(1, 1), b3 + hstepB, voffB); PG8_STAGE(PG8_SA(1, 0), a3, voffA);
            PG8_WAIT_V(8); PG8_WAIT_L(0); PG8_BAR; PG8_MMA(1, 0, At, B0); PG8_MMA(1, 1, At, B1); PG8_BAR; PG8_SCHED;
        }
        if constexpr (ALIGN_EPI) { if (wr == 0) PG8_BAR; }
        E(acc, cur, wr, wc, fr, fq, lds, wid, lane);
        if (!has_next) break;
#pragma unroll
        for (int a = 0; a < 2; ++a)
#pragma unroll
            for (int b = 0; b < 2; ++b)
#pragma unroll
                for (int m = 0; m < 4; ++m)
#pragma unroll
                    for (int n = 0; n < 2; ++n) acc[a][b][m][n] = (f32x4){0.f, 0.f, 0.f, 0.f};
        cur = nxt; cA = nA; cB = nB; ++ui;
        if constexpr (ALIGN_EPI) { if (wr == 1) PG8_BAR; }
    }
    PG8_WAIT_V(0);
    if constexpr (!ALIGN_EPI) { if (wr == 0) PG8_BAR; }
    PG8_BAR;
#undef PG8_SA
#undef PG8_SB
#undef PG8_STAGE
#undef PG8_LDA
#undef PG8_LDB
#undef PG8_MMA
#undef PG8_WAIT_V
#undef PG8_WAIT_L
#undef PG8_BAR
#undef PG8_SCHED
}
}

namespace att {
#define ATT_LAS __attribute__((address_space(3)))
typedef short bf16x8 __attribute__((ext_vector_type(8)));
typedef short v4i16 __attribute__((ext_vector_type(4)));
typedef float f32x16 __attribute__((ext_vector_type(16)));
typedef float f32x4 __attribute__((ext_vector_type(4)));
typedef unsigned u32x4 __attribute__((ext_vector_type(4)));
typedef unsigned u32x2 __attribute__((ext_vector_type(2)));
constexpr float LOG2E = 1.4426950408889634f;
constexpr int TABA_N = 192, TABB_N = 1600;

__device__ __forceinline__ int rel_bucket(int n) {
    if (n < 16) return n < 0 ? 0 : n;
    int b = 16;
    b += (n >= 22); b += (n >= 30); b += (n >= 40); b += (n >= 54); b += (n >= 73); b += (n >= 99); b += (n >= 134); b += (n >= 182);
    b += (n >= 246); b += (n >= 332); b += (n >= 450); b += (n >= 609); b += (n >= 825); b += (n >= 1117); b += (n >= 1513);
    return b;
}
__device__ __forceinline__ unsigned pk_bf16(float lo, float hi) { unsigned r; asm volatile("v_cvt_pk_bf16_f32 %0, %1, %2" : "=v"(r) : "v"(lo), "v"(hi)); return r; }
__device__ __forceinline__ float bf16_round(float x) { unsigned u = __builtin_bit_cast(unsigned, x); u = (u + 0x7fffu + ((u >> 16) & 1u)) & 0xffff0000u; return __builtin_bit_cast(float, u); }

__device__ __forceinline__ void glds16(const void* gsrc, unsigned lds_dst) { unsigned keep;
    asm volatile("s_mov_b32 %0, m0\n\ts_mov_b32 m0, %2\n\ts_nop 0\n\tglobal_load_lds_dwordx4 %1, off\n\ts_mov_b32 m0, %0" : "=&s"(keep) : "v"(gsrc), "s"(lds_dst) : "memory"); }
__device__ __forceinline__ void dma_rows8(const char* krow0  , const int voff, const int row  ,
                                          ATT_LAS char* kdst  , ATT_LAS char* vdst, const int lane) {
    const int pc = lane & 7;
    glds16(krow0 + 16 * (pc ^ ((row >> 1) & 7)), (unsigned)__builtin_amdgcn_readfirstlane((int)(unsigned)(uintptr_t)kdst));
    glds16(krow0 + voff + 16 * (pc ^ (((row >> 1) & 1) << 2)), (unsigned)__builtin_amdgcn_readfirstlane((int)(unsigned)(uintptr_t)vdst));
}

__device__ __forceinline__ void attn_group(const bf16x8 (&qf)[4], f32x16 (&o)[2], float& m, float& l, const ATT_LAS char* kg, const ATT_LAS char* vg, const ATT_LAS float* tp, const int lane) {
    const int q = lane & 31, h = lane >> 5;
    const ATT_LAS char* kr0 = kg + q * 128; const int kswz = (q >> 1) & 7;
    f32x16 s = f32x16{};
#pragma unroll
    for (int d0 = 0; d0 < 4; ++d0) { const bf16x8 kf = *(const ATT_LAS bf16x8*)(kr0 + 16 * ((2 * d0 + h) ^ kswz)); s = __builtin_amdgcn_mfma_f32_32x32x16_bf16(kf, qf[d0], s, 0, 0, 0); }
    float mx = -INFINITY;
#pragma unroll
    for (int r = 0; r < 16; ++r) { const int off = (r & 3) + 8 * (r >> 2); s[r] = fmaf(s[r], LOG2E, tp[-off]); }
#pragma unroll
    for (int r = 0; r < 16; r += 2) mx = fmaxf(mx, fmaxf(s[r], s[r + 1]));
    mx = fmaxf(mx, __shfl_xor(mx, 32));
    if (__any(mx > m)) {
        const float mnew = fmaxf(m, mx), alpha = __builtin_amdgcn_exp2f(m - mnew);
        l *= alpha; m = mnew;
#pragma unroll
        for (int r = 0; r < 16; ++r) { o[0][r] *= alpha; o[1][r] *= alpha; }
    }
    float ps = 0.f;
#pragma unroll
    for (int r = 0; r < 16; ++r) { s[r] = __builtin_amdgcn_exp2f(s[r] - m); ps += s[r]; }
    l += ps;
    u32x4 pw0, pw1;
    pw0[0] = pk_bf16(s[0], s[1]); pw0[1] = pk_bf16(s[2], s[3]); pw0[2] = pk_bf16(s[4], s[5]); pw0[3] = pk_bf16(s[6], s[7]);
    pw1[0] = pk_bf16(s[8], s[9]); pw1[1] = pk_bf16(s[10], s[11]); pw1[2] = pk_bf16(s[12], s[13]); pw1[3] = pk_bf16(s[14], s[15]);
    const bf16x8 pb0 = __builtin_bit_cast(bf16x8, pw0), pb1 = __builtin_bit_cast(bf16x8, pw1);
    const int q4 = (lane & 15) >> 2, p4 = lane & 3, g1 = (lane >> 4) & 1, vsw = (q4 >> 1) & 1;
    const ATT_LAS char* vr0 = vg + (4 * h + q4) * 128 + 32 * g1 + 8 * p4;
#pragma unroll
    for (int dh = 0; dh < 2; ++dh) {
        const ATT_LAS char* vp = vr0 + 64 * (dh ^ vsw);
        const v4i16 a00 = __builtin_amdgcn_ds_read_tr16_b64_v4i16((ATT_LAS v4i16*)(vp));
        const v4i16 a01 = __builtin_amdgcn_ds_read_tr16_b64_v4i16((ATT_LAS v4i16*)(vp + 8 * 128));
        const v4i16 a10 = __builtin_amdgcn_ds_read_tr16_b64_v4i16((ATT_LAS v4i16*)(vp + 16 * 128));
        const v4i16 a11 = __builtin_amdgcn_ds_read_tr16_b64_v4i16((ATT_LAS v4i16*)(vp + 24 * 128));
        const bf16x8 va0 = (bf16x8){a00[0], a00[1], a00[2], a00[3], a01[0], a01[1], a01[2], a01[3]};
        const bf16x8 va1 = (bf16x8){a10[0], a10[1], a10[2], a10[3], a11[0], a11[1], a11[2], a11[3]};
        o[dh] = __builtin_amdgcn_mfma_f32_32x32x16_bf16(va0, pb0, o[dh], 0, 0, 0);
        o[dh] = __builtin_amdgcn_mfma_f32_32x32x16_bf16(va1, pb1, o[dh], 0, 0, 0);
    }
}

__device__ __forceinline__ void store_o(const f32x16 (&o)[2], const float l, char* orow_q, const int h) {
    const float il = 1.0f / l;
#pragma unroll
    for (int dh = 0; dh < 2; ++dh)
#pragma unroll
        for (int j = 0; j < 4; ++j) {
            u32x2 w; w[0] = pk_bf16(o[dh][4 * j] * il, o[dh][4 * j + 1] * il); w[1] = pk_bf16(o[dh][4 * j + 2] * il, o[dh][4 * j + 3] * il);
            *(u32x2*)(orow_q + (32 * dh + 8 * j + 4 * h) * 2) = w;
        }
}

__device__ __forceinline__ unsigned moba_select(const char* qbase, const long qs, const float* km, const int qb) {
    const int lane = threadIdx.x & 63, q = lane & 31, h = lane >> 5;
    f32x16 g = f32x16{};
    const float* kmrow = km + (size_t)(q & 15) * 256;
    const bool lo_part = q >= 16;
#pragma unroll
    for (int d0 = 0; d0 < 4; ++d0) {
        const bf16x8 qf = *(const bf16x8*)(qbase + (long)q * qs + (16 * d0 + 8 * h) * 2);
        const f32x4 f0 = *(const f32x4*)(kmrow + 16 * d0 + 8 * h), f1 = *(const f32x4*)(kmrow + 16 * d0 + 8 * h + 4);
        float v[8] = {f0[0], f0[1], f0[2], f0[3], f1[0], f1[1], f1[2], f1[3]};
        u32x4 aw;
#pragma unroll
        for (int j = 0; j < 4; ++j) {
            const float h0 = bf16_round(v[2 * j]), h1 = bf16_round(v[2 * j + 1]);
            const float x0 = lo_part ? (v[2 * j] - h0) : h0, x1 = lo_part ? (v[2 * j + 1] - h1) : h1;
            aw[j] = pk_bf16(x0, x1);
        }
        g = __builtin_amdgcn_mfma_f32_32x32x16_bf16(__builtin_bit_cast(bf16x8, aw), qf, g, 0, 0, 0);
    }
    float gate[8], other[8];
#pragma unroll
    for (int r = 0; r < 8; ++r) { gate[r] = g[r] + g[r + 8]; }
#pragma unroll
    for (int r = 0; r < 8; ++r) { other[r] = __shfl_xor(gate[r], 32); }
    unsigned mymask = 0u;
#pragma unroll
    for (int r = 0; r < 8; ++r) {
        const int n = (r & 3) + 8 * (r >> 2) + 4 * h;
        int rank = 0;
#pragma unroll
        for (int r2 = 0; r2 < 8; ++r2) {
            const int n2 = (r2 & 3) + 8 * (r2 >> 2) + 4 * h, n3 = (r2 & 3) + 8 * (r2 >> 2) + 4 * (1 - h);
            if (r2 != r) rank += (n2 < qb && (gate[r2] > gate[r] || (gate[r2] == gate[r] && n2 < n))) ? 1 : 0;
            rank += (n3 < qb && (other[r2] > gate[r] || (other[r2] == gate[r] && n3 < n))) ? 1 : 0;
        }
        if (n < qb && rank < 3) mymask |= 1u << n;
    }
    return mymask | (unsigned)__shfl_xor((int)mymask, 32);
}
}

namespace mk {
using pg8::bf16_t; using pg8::bf16x8; using pg8::f32x4; using pg8::f32x2; using pg8::u32x4; using pg8::u32x2; using pg8::Unit; using pg8::cvt_pk_bf16;
#define LAS __attribute__((address_space(3)))
constexpr int NBAT = MK_NBAT, SEQ = 4096, D = 1024, DFF = 2816, NMEM = 256, M = NBAT * SEQ, MM = NBAT * NMEM, NQKV = 3072;
constexpr float EPS = 1e-6f, LOG2E = 1.4426950408889634f;
constexpr int NWAVES = 8, NPH = 12;

constexpr size_t al256(size_t x) { return (x + 255) / 256 * 256; }
constexpr size_t WS_CTL = 0, CTL_BYTES = 1u << 20;
constexpr size_t WS_WGU1 = WS_CTL + CTL_BYTES;
constexpr size_t WS_WD1 = WS_WGU1 + (size_t)2 * DFF * D * 2;
constexpr size_t WS_WIN = WS_WD1 + (size_t)D * DFF * 2;
constexpr size_t WS_WOUT = WS_WIN + (size_t)NQKV * D * 2;
constexpr size_t WS_WCQS = WS_WOUT + (size_t)D * D * 2;
constexpr size_t WS_WCKV = WS_WCQS + (size_t)D * D * 2;
constexpr size_t WS_WCO = WS_WCKV + (size_t)2 * D * D * 2;
constexpr size_t WS_WGU2 = WS_WCO + (size_t)D * D * 2;
constexpr size_t WS_WD2 = WS_WGU2 + (size_t)2 * DFF * D * 2;
constexpr size_t WS_MB = WS_WD2 + (size_t)D * DFF * 2;
constexpr size_t WS_KVC = WS_MB + (size_t)MM * D * 2;
constexpr size_t WS_WKT = WS_KVC + (size_t)MM * 2 * D * 2;
constexpr size_t WS_VWT = WS_WKT + (size_t)NBAT * D * D * 2;
constexpr size_t SS_BYTES = (size_t)M * 16 * 4;
constexpr size_t WS_SS = WS_VWT + (size_t)NBAT * D * D * 2;
constexpr size_t WS_SSM = WS_SS + 5 * SS_BYTES;
constexpr size_t WS_KM = WS_SSM + (size_t)MM * 16 * 4;
constexpr size_t WS_R1 = al256(WS_KM + (size_t)NBAT * 16 * 256 * 4);
constexpr size_t WS_XB = WS_R1 + (size_t)M * NQKV * 2;
constexpr size_t WS_OA2 = WS_XB + (size_t)M * D * 2;
constexpr size_t WS_END = WS_OA2 + (size_t)M * 768 * 2;
constexpr size_t OUT_OA1 = (size_t)M * 768 * 2, OUT_OB = 2 * OUT_OA1, OUT_ML = OUT_OB + (size_t)M * 256 * 2;
static_assert(OUT_ML + (size_t)3 * M * 12 * 8 <= (size_t)M * D * 4, "attention partials fit in d_out");
constexpr int CW_BAR = 4096;

constexpr int LDS_XCH = 131072;
constexpr int LDS_MISC = 131072 + 8192;
constexpr int LDS_BYTES = 147456;
constexpr int LDS_TAB = 98304;
static_assert(LDS_TAB + 36 * att::TABA_N * 4 <= LDS_XCH && LDS_TAB + 4 * att::TABB_N * 4 <= LDS_XCH, "attention LDS map");

__device__ __forceinline__ float wave_sum(float v) {
#pragma unroll
    for (int o = 1; o < 64; o <<= 1) v += __shfl_xor(v, o);
    return v;
}
__device__ __forceinline__ float row_rstd(const float* ss, int row) {
    const f32x4* p = (const f32x4*)(ss + (size_t)row * 16);
    const f32x4 a = p[0], b = p[1], c = p[2], d = p[3];
    const float s = ((a[0] + a[1]) + (a[2] + a[3])) + ((b[0] + b[1]) + (b[2] + b[3])) + ((c[0] + c[1]) + (c[2] + c[3])) + ((d[0] + d[1]) + (d[2] + d[3]));
    return 1.0f / sqrtf(s * (1.0f / D) + EPS);
}

struct SchedStd {
    pg8::Order o; const char* A; const char* B; size_t a_tile, b_tile, b_batch; int ocol_mul;
    __device__ __forceinline__ bool next(int i, Unit& u) const { int pm, pn; if (!o.tile(i, pm, pn)) return false;
        u.a = A + (size_t)pm * a_tile; u.b = B + (size_t)pn * b_tile + (size_t)(pm >> 4) * b_batch; u.orow = pm * 256; u.ocol = pn * ocol_mul; u.aux = pn; return true; }
};
struct SchedWK {
    int G, c; const char* kvc; const char* wcqs;
    __device__ __forceinline__ bool next(int i, Unit& u) const { const int L = i * G + c; if (L >= NBAT * 16) return false; const int bh = L >> 2, pn = L & 3, b = bh >> 2, h = bh & 3;
        u.a = kvc + ((size_t)(b * 256) * 2048 + h * 256) * 2; u.b = wcqs + ((size_t)(pn * 256) * 1024 + h * 256) * 2; u.orow = b * 1024 + h * 256; u.ocol = pn * 256; u.aux = 0; return true; }
};
struct SchedVW {
    int G, c; const char* kvc; const char* wcot;
    __device__ __forceinline__ bool next(int i, Unit& u) const { const int L = i * G + c; if (L >= NBAT * 16) return false; const int bh = L >> 2, pm = L & 3, b = bh >> 2, h = bh & 3;
        u.a = wcot + ((size_t)(pm * 256) * 1024 + h * 256) * 2; u.b = kvc + ((size_t)(b * 256) * 2048 + 1024 + h * 256) * 2; u.orow = b * 1024 + pm * 256; u.ocol = h * 256; u.aux = 0; return true; }
};

struct EpiGU { static constexpr bool PERM = true;
    bf16_t* H; const float* ss;
    __device__ __forceinline__ void operator()(const f32x4 (&acc)[2][2][4][2], const Unit& u, int wr, int wc, int fr, int fq, LAS unsigned char*, int, int) const {
        float rsv[2][4];
#pragma unroll
        for (int ai = 0; ai < 2; ++ai)
#pragma unroll
            for (int m = 0; m < 4; ++m) rsv[ai][m] = row_rstd(ss, u.orow + ai * 128 + wr * 64 + m * 16 + fr);
#pragma unroll
        for (int ai = 0; ai < 2; ++ai)
#pragma unroll
            for (int m = 0; m < 4; ++m) { const int row = u.orow + ai * 128 + wr * 64 + m * 16 + fr; const float rs = rsv[ai][m];
                float hv[8];
#pragma unroll
                for (int n = 0; n < 2; ++n)
#pragma unroll
                    for (int j = 0; j < 4; ++j) { const float g = acc[ai][0][m][n][j] * rs, uu = acc[ai][1][m][n][j] * rs;
                        hv[4 * n + j] = g * __builtin_amdgcn_rcpf(1.0f + __builtin_amdgcn_exp2f(-g * LOG2E)) * uu; }
                u32x4 w; w[0] = cvt_pk_bf16(hv[0], hv[1]); w[1] = cvt_pk_bf16(hv[2], hv[3]); w[2] = cvt_pk_bf16(hv[4], hv[5]); w[3] = cvt_pk_bf16(hv[6], hv[7]);
                *(u32x4*)(H + (size_t)row * DFF + u.ocol + wc * 32 + 8 * fq) = w; }
    }
};
struct EpiRes { static constexpr bool PERM = true;
    bf16_t* xb; float* ssout; float alpha;
    __device__ __forceinline__ void operator()(const f32x4 (&acc)[2][2][4][2], const Unit& u, int wr, int wc, int fr, int fq, LAS unsigned char*, int, int) const {
        const size_t off0 = (size_t)(u.orow + wr * 64 + fr) * D + u.ocol + wc * 32 + 8 * fq;
        u32x4 cur[2], nxt[2];
#pragma unroll
        for (int bj = 0; bj < 2; ++bj) cur[bj] = *(const u32x4*)(xb + off0 + bj * 128);
#pragma unroll
        for (int idx = 0; idx < 8; ++idx) { const int ai = idx >> 2, m = idx & 3; const size_t off = off0 + (size_t)(ai * 128 + m * 16) * D; const int row = u.orow + ai * 128 + wr * 64 + m * 16 + fr;
            if (idx < 7) { const size_t offn = off0 + (size_t)(((idx + 1) >> 2) * 128 + ((idx + 1) & 3) * 16) * D;
#pragma unroll
                for (int bj = 0; bj < 2; ++bj) nxt[bj] = *(const u32x4*)(xb + offn + bj * 128); }
            float sq = 0.f;
#pragma unroll
            for (int bj = 0; bj < 2; ++bj) { float o[8];
#pragma unroll
                for (int n = 0; n < 2; ++n)
#pragma unroll
                    for (int j = 0; j < 4; ++j) { const unsigned wv = cur[bj][2 * n + (j >> 1)]; const float r = __builtin_bit_cast(float, (j & 1) ? (wv & 0xffff0000u) : (wv << 16));
                        const float v = r + acc[ai][bj][m][n][j] * alpha; o[4 * n + j] = v; sq += v * v; }
                u32x4 w; w[0] = cvt_pk_bf16(o[0], o[1]); w[1] = cvt_pk_bf16(o[2], o[3]); w[2] = cvt_pk_bf16(o[4], o[5]); w[3] = cvt_pk_bf16(o[6], o[7]);
                *(u32x4*)(xb + off + bj * 128) = w; }
            sq += __shfl_xor(sq, 16); sq += __shfl_xor(sq, 32);
            if (fq == 0) ssout[(size_t)row * 16 + (u.ocol >> 8) * 4 + wc] = sq;
#pragma unroll
            for (int bj = 0; bj < 2; ++bj) cur[bj] = nxt[bj]; }
    }
};
struct EpiStore { static constexpr bool PERM = true;
    bf16_t* O; int ldc; const float* ss; float* km;
    __device__ __forceinline__ void operator()(const f32x4 (&acc)[2][2][4][2], const Unit& u, int wr, int wc, int fr, int fq, LAS unsigned char*, int, int) const {
        float rsv[2][4];
#pragma unroll
        for (int ai = 0; ai < 2; ++ai)
#pragma unroll
            for (int m = 0; m < 4; ++m) rsv[ai][m] = ss ? row_rstd(ss, u.orow + ai * 128 + wr * 64 + m * 16 + fr) : 1.0f;
#pragma unroll
        for (int ai = 0; ai < 2; ++ai)
#pragma unroll
            for (int m = 0; m < 4; ++m) { const int row = u.orow + ai * 128 + wr * 64 + m * 16 + fr; const float rs = rsv[ai][m];
                bf16_t* rowp = O + (size_t)row * ldc + u.ocol + wc * 32 + 8 * fq;
#pragma unroll
                for (int bj = 0; bj < 2; ++bj) { const f32x4 v0 = acc[ai][bj][m][0] * rs, v1 = acc[ai][bj][m][1] * rs;
                    u32x4 w; w[0] = cvt_pk_bf16(v0[0], v0[1]); w[1] = cvt_pk_bf16(v0[2], v0[3]); w[2] = cvt_pk_bf16(v1[0], v1[1]); w[3] = cvt_pk_bf16(v1[2], v1[3]);
                    *(u32x4*)(rowp + bj * 128) = w; } }
        if ((km != nullptr) && (u.aux == 10)) {
            float* kmb = km + (size_t)(u.orow >> 8) * 256 + wc * 32 + 8 * fq;
#pragma unroll
            for (int bj = 0; bj < 2; ++bj)
#pragma unroll
                for (int n = 0; n < 2; ++n) { f32x4 cs = (f32x4){0.f, 0.f, 0.f, 0.f};
#pragma unroll
                    for (int ai = 0; ai < 2; ++ai)
#pragma unroll
                        for (int m = 0; m < 4; ++m) cs += acc[ai][bj][m][n] * rsv[ai][m];
#pragma unroll
                    for (int j = 0; j < 4; ++j) { float v = cs[j]; v += __shfl_xor(v, 1); v += __shfl_xor(v, 2); v += __shfl_xor(v, 4); v += __shfl_xor(v, 8);
                        if (fr == 0) atomicAdd(kmb + bj * 128 + 4 * n + j, v); } }
        }
    }
};
struct EpiSoftmax { static constexpr bool PERM = true;
    bf16_t* P; const float* ss;
    __device__ __forceinline__ void operator()(const f32x4 (&acc)[2][2][4][2], const Unit& u, int wr, int wc, int fr, int fq, LAS unsigned char* lds, int, int) const {
        LAS f32x2* X = (LAS f32x2*)(lds + LDS_XCH);
        float rsl[2][4], mw[2][4];
#pragma unroll
        for (int ai = 0; ai < 2; ++ai)
#pragma unroll
            for (int m = 0; m < 4; ++m) { const int rl = ai * 128 + wr * 64 + m * 16 + fr; const float rs = row_rstd(ss, u.orow + rl) * LOG2E; rsl[ai][m] = rs;
                float mx = -INFINITY;
#pragma unroll
                for (int bj = 0; bj < 2; ++bj)
#pragma unroll
                    for (int n = 0; n < 2; ++n)
#pragma unroll
                        for (int j = 0; j < 4; ++j) mx = fmaxf(mx, acc[ai][bj][m][n][j] * rs);
                mx = fmaxf(mx, __shfl_xor(mx, 16)); mx = fmaxf(mx, __shfl_xor(mx, 32));
                float sm = 0.f;
#pragma unroll
                for (int bj = 0; bj < 2; ++bj)
#pragma unroll
                    for (int n = 0; n < 2; ++n)
#pragma unroll
                        for (int j = 0; j < 4; ++j) sm += __builtin_amdgcn_exp2f(acc[ai][bj][m][n][j] * rs - mx);
                sm += __shfl_xor(sm, 16); sm += __shfl_xor(sm, 32);
                mw[ai][m] = mx;
                if (fq == 0) X[rl * 4 + wc] = (f32x2){mx, sm}; }
        asm volatile("s_waitcnt lgkmcnt(0)" ::: "memory"); __builtin_amdgcn_s_barrier(); asm volatile("" ::: "memory");
#pragma unroll
        for (int ai = 0; ai < 2; ++ai)
#pragma unroll
            for (int m = 0; m < 4; ++m) { const int rl = ai * 128 + wr * 64 + m * 16 + fr; const float rs = rsl[ai][m];
                const f32x2 x0 = X[rl * 4 + 0], x1 = X[rl * 4 + 1], x2 = X[rl * 4 + 2], x3 = X[rl * 4 + 3];
                const float Mx = fmaxf(fmaxf(x0[0], x1[0]), fmaxf(x2[0], x3[0]));
                const float L = x0[1] * __builtin_amdgcn_exp2f(x0[0] - Mx) + x1[1] * __builtin_amdgcn_exp2f(x1[0] - Mx) + x2[1] * __builtin_amdgcn_exp2f(x2[0] - Mx) + x3[1] * __builtin_amdgcn_exp2f(x3[0] - Mx);
                const float il = 1.0f / L;
                bf16_t* rowp = P + (size_t)(u.orow + rl) * D + u.ocol + wc * 32 + 8 * fq;
#pragma unroll
                for (int bj = 0; bj < 2; ++bj) { float pv[8];
#pragma unroll
                    for (int n = 0; n < 2; ++n)
#pragma unroll
                        for (int j = 0; j < 4; ++j) pv[4 * n + j] = __builtin_amdgcn_exp2f(acc[ai][bj][m][n][j] * rs - Mx) * il;
                    u32x4 w; w[0] = cvt_pk_bf16(pv[0], pv[1]); w[1] = cvt_pk_bf16(pv[2], pv[3]); w[2] = cvt_pk_bf16(pv[4], pv[5]); w[3] = cvt_pk_bf16(pv[6], pv[7]);
                    *(u32x4*)(rowp + bj * 128) = w; } }
        (void)mw;
    }
};

#define XB_TMO      128
#define XB_XCNT(j)  (256  + 64 * (j))
#define XB_XSUB(j)  (1280 + 64 * (j))
#define XB_XGEN(j)  (2304 + 64 * (j))
#define XB_TOP      3328
#define XB_TOPGEN   3392
#define XCD_BAR_WORDS 3456
#define XB_SPIN_CAP (1u << 18)
__device__ __forceinline__ unsigned xb_ld(unsigned* p)              { return __hip_atomic_load(p, __ATOMIC_RELAXED, __HIP_MEMORY_SCOPE_AGENT); }
__device__ __forceinline__ unsigned xb_add(unsigned* p, unsigned v) { return __hip_atomic_fetch_add(p, v, __ATOMIC_RELAXED, __HIP_MEMORY_SCOPE_AGENT); }
__device__ __forceinline__ unsigned xb_xcc_id() { return (unsigned)__builtin_amdgcn_s_getreg((3 << 11) | 20) & 0xFu; }
#define XB_SPIN(cond, bar) do { unsigned _sp = 0; while (cond) { __builtin_amdgcn_s_sleep(1); \
    if ((++_sp & 255u) == 0u) { if (xb_ld(&(bar)[XB_TMO])) break; if (_sp > XB_SPIN_CAP) { atomicAdd(&(bar)[XB_TMO], 1u); break; } } } } while (0)
struct XcdBarrier { unsigned* bar; unsigned x; volatile LAS unsigned* st; };
__device__ __forceinline__ XcdBarrier xcd_barrier_post(unsigned* bar, volatile LAS unsigned* st) {
    XcdBarrier b; b.bar = bar; b.x = xb_xcc_id(); b.st = st;
    if (threadIdx.x == 0) (void)xb_add(&bar[XB_XCNT(b.x)], 1u);
    return b;
}
__device__ __forceinline__ void xcd_barrier_complete(unsigned* bar, unsigned x, unsigned& nloc, unsigned& nx) {
    const unsigned G = gridDim.x * gridDim.y * gridDim.z;
    unsigned sum, cnt, mine, sp = 0u;
    for (;;) {
        sum = 0u; cnt = 0u; mine = 0u;
#pragma unroll
        for (unsigned j = 0; j < 16; ++j) { const unsigned c = xb_ld(&bar[XB_XCNT(j)]); sum += c; cnt += (c > 0u) ? 1u : 0u; mine = (j == x) ? c : mine; }
        if (sum == G) break;
        __builtin_amdgcn_s_sleep(1);
        if ((++sp & 255u) == 0u) { if (xb_ld(&bar[XB_TMO])) break; if (sp > XB_SPIN_CAP) { atomicAdd(&bar[XB_TMO], 1u); break; } }
    }
    nloc = mine > 0u ? mine : 1u; nx = cnt > 0u ? cnt : 1u;
}
__device__ __forceinline__ void xcd_barrier(const XcdBarrier& b) {
    asm volatile("s_waitcnt vmcnt(0)" ::: "memory");
    __syncthreads();
    if (threadIdx.x == 0) {
        unsigned* bar = b.bar;
        __builtin_amdgcn_s_waitcnt(0);
        unsigned nloc = b.st[0], nx = b.st[1];
        if (nloc == 0u) { xcd_barrier_complete(bar, b.x, nloc, nx); b.st[0] = nloc; b.st[1] = nx; }
        const unsigned old = xb_add(&bar[XB_XSUB(b.x)], 1u);
        const unsigned gen = old / nloc;
        if (old + 1u == (gen + 1u) * nloc) {
            __builtin_amdgcn_fence(__ATOMIC_RELEASE, "agent");
            asm volatile("s_waitcnt vmcnt(0)" ::: "memory");
            const unsigned og = xb_add(&bar[XB_TOP], 1u);
            const unsigned tg = og / nx;
            if (og + 1u == (tg + 1u) * nx) xb_add(&bar[XB_TOPGEN], 1u);
            else XB_SPIN(xb_ld(&bar[XB_TOPGEN]) == tg, bar);
            __builtin_amdgcn_fence(__ATOMIC_ACQUIRE, "agent");
            xb_add(&bar[XB_XGEN(b.x)], 1u);
            asm volatile("s_waitcnt vmcnt(0)" ::: "memory");
        } else {
            XB_SPIN(xb_ld(&bar[XB_XGEN(b.x)]) == gen, bar);
            __builtin_amdgcn_fence(__ATOMIC_ACQUIRE, "agent");
            asm volatile("s_waitcnt vmcnt(0)" ::: "memory");
        }
    }
    __syncthreads();
}

__device__ __forceinline__ void tr_item(const float* W, int N, int k0, int n0, const float* gain, float cscale, bf16_t* dst  , int Kd, LAS float* scr, int lane) {
    f32x4 v[8]; float g[8];
#pragma unroll
    for (int i = 0; i < 8; ++i) { const int kk = 8 * i + (lane >> 3); v[i] = *(const f32x4*)(W + (size_t)(k0 + kk) * N + n0 + 4 * (lane & 7)); g[i] = gain ? gain[k0 + kk] * cscale : cscale; }
#pragma unroll
    for (int i = 0; i < 8; ++i) { const int kk = 8 * i + (lane >> 3); LAS float* d = scr + kk * 33 + 4 * (lane & 7); d[0] = v[i][0] * g[i]; d[1] = v[i][1] * g[i]; d[2] = v[i][2] * g[i]; d[3] = v[i][3] * g[i]; }
    asm volatile("s_waitcnt lgkmcnt(0)" ::: "memory");
    const int c = lane & 7;
#pragma unroll
    for (int j = 0; j < 4; ++j) { const int n = (lane >> 3) + 8 * j; const LAS float* s = scr + (8 * c) * 33 + n;
        u32x4 o; o[0] = cvt_pk_bf16(s[0 * 33], s[1 * 33]); o[1] = cvt_pk_bf16(s[2 * 33], s[3 * 33]); o[2] = cvt_pk_bf16(s[4 * 33], s[5 * 33]); o[3] = cvt_pk_bf16(s[6 * 33], s[7 * 33]);
        *(u32x4*)(dst + (size_t)n * Kd + k0 + 8 * c) = o; }
    asm volatile("s_waitcnt lgkmcnt(0)" ::: "memory");
}
template <int NR>
__device__ __forceinline__ void cvt_rows(const float* x, bf16_t* o, float* ss, int row0, int stride, int nrows, int lane) {
    f32x4 v[NR][4]; float s[NR];
#pragma unroll
    for (int r = 0; r < NR; ++r) { const int row = row0 + r * stride; const f32x4* xr = (const f32x4*)(x + (size_t)(row < nrows ? row : row0) * D) + lane;
#pragma unroll
        for (int j = 0; j < 4; ++j) v[r][j] = xr[64 * j]; }
#pragma unroll
    for (int r = 0; r < NR; ++r) { float a = 0.f;
#pragma unroll
        for (int j = 0; j < 4; ++j) a += (v[r][j][0] * v[r][j][0] + v[r][j][1] * v[r][j][1]) + (v[r][j][2] * v[r][j][2] + v[r][j][3] * v[r][j][3]);
        s[r] = a; }
#pragma unroll
    for (int of = 1; of < 64; of <<= 1)
#pragma unroll
        for (int r = 0; r < NR; ++r) s[r] += __shfl_xor(s[r], of);
#pragma unroll
    for (int r = 0; r < NR; ++r) { const int row = row0 + r * stride; if (row < nrows) { u32x2* o8 = (u32x2*)(o + (size_t)row * D) + lane;
#pragma unroll
            for (int j = 0; j < 4; ++j) { u32x2 w; w[0] = cvt_pk_bf16(v[r][j][0], v[r][j][1]); w[1] = cvt_pk_bf16(v[r][j][2], v[r][j][3]); o8[64 * j] = w; }
            if (lane < 16) ss[(size_t)row * 16 + lane] = lane == 0 ? s[r] : 0.f; } }
}

struct Args { const float* in[20]; float* out; unsigned char* ws; int ph_lo, ph_hi, flags, pad; };

#define MK_PTRS unsigned char* ws = args.ws; float* out = args.out; asm volatile("" : "+s"(ws), "+s"(out)); \
    const float* x_in = args.in[0]; const float* mem_in = args.in[1]; const float* rel_bias = args.in[7]; \
    bf16_t* Wgu1 = (bf16_t*)(ws + WS_WGU1); bf16_t* Wd1 = (bf16_t*)(ws + WS_WD1); bf16_t* Win = (bf16_t*)(ws + WS_WIN); bf16_t* Wout = (bf16_t*)(ws + WS_WOUT); \
    bf16_t* Wcqs = (bf16_t*)(ws + WS_WCQS); bf16_t* Wckv = (bf16_t*)(ws + WS_WCKV); bf16_t* Wco = (bf16_t*)(ws + WS_WCO); bf16_t* Wgu2 = (bf16_t*)(ws + WS_WGU2); bf16_t* Wd2 = (bf16_t*)(ws + WS_WD2); \
    bf16_t* MB = (bf16_t*)(ws + WS_MB); bf16_t* KVC = (bf16_t*)(ws + WS_KVC); bf16_t* WKT = (bf16_t*)(ws + WS_WKT); bf16_t* VWT = (bf16_t*)(ws + WS_VWT); \
    float* SS0 = (float*)(ws + WS_SS); float* SS1 = SS0 + (size_t)M * 16; float* SS2 = SS1 + (size_t)M * 16; float* SS3 = SS2 + (size_t)M * 16; float* SS4 = SS3 + (size_t)M * 16; \
    float* SSM = (float*)(ws + WS_SSM); float* KM = (float*)(ws + WS_KM); \
    bf16_t* HB = (bf16_t*)(ws + WS_R1); bf16_t* QKV = HB; bf16_t* YN = HB; bf16_t* PB = HB; \
    bf16_t* XB = (bf16_t*)(ws + WS_XB); bf16_t* OA0 = (bf16_t*)out; bf16_t* OA1 = (bf16_t*)((char*)out + OUT_OA1); bf16_t* OA2 = (bf16_t*)(ws + WS_OA2); bf16_t* OB = (bf16_t*)((char*)out + OUT_OB); float* ML = (float*)((char*)out + OUT_ML);
__global__ void __launch_bounds__(NWAVES * 64, 2) mk_fwd(Args args) {
    extern __shared__ __attribute__((aligned(16))) unsigned char lds_raw[];
    LAS unsigned char* lds = (LAS unsigned char*)lds_raw;
    const int tid = threadIdx.x, lane = tid & 63, wave = __builtin_amdgcn_readfirstlane(tid >> 6);
    const int G = gridDim.x, bx = blockIdx.x;
    const int vcu = (G % 8 == 0) ? (bx % 8) * (G / 8) + bx / 8 : bx;
    const int gw = vcu * NWAVES + wave, NGW = G * NWAVES;
    unsigned char* const ws0 = args.ws;
    volatile LAS unsigned* MISC = (volatile LAS unsigned*)(lds + LDS_MISC);
    if (tid < 32) MISC[tid] = 0u;
    __syncthreads();
    const int lo = args.ph_lo, hi = args.ph_hi;
    const bool use_bar = (hi - lo) > 1;
    XcdBarrier bar; bar.bar = (unsigned*)(ws0 + WS_CTL) + CW_BAR; bar.x = 0; bar.st = nullptr;
    if (use_bar) bar = xcd_barrier_post((unsigned*)(ws0 + WS_CTL) + CW_BAR, MISC + 8);
#define IN(k) (lo <= (k) && (k) < hi)
#define STAGGER() do { if (MK_STAGGER_TICKS > 0) { const unsigned long long t0_ = __builtin_amdgcn_s_memrealtime(), dl_ = (unsigned long long)((bx >> 3) & 3) * MK_STAGGER_TICKS; while (__builtin_amdgcn_s_memrealtime() - t0_ < dl_) __builtin_amdgcn_s_sleep(8); } } while (0)
#define SEAM(k) do { if (IN(k) && IN((k) + 1)) xcd_barrier(bar); } while (0)

    if (IN(0)) {
        MK_PTRS;
        LAS float* scr = (LAS float*)(lds + wave * 16384);
        constexpr int I_GU = (D / 64) * (2 * DFF / 32), I_DN = (DFF / 64) * (D / 32), I_IN = (D / 64) * (NQKV / 32), I_SQ = (D / 64) * (D / 32), I_KV = (D / 64) * (2 * D / 32);
        constexpr int NITEMS = 2 * I_GU + 2 * I_DN + I_IN + 2 * I_SQ + I_KV;
        for (int it = gw; it < NITEMS; it += NGW) {
            int r = it;
            if (r < 2 * I_GU) {
                const bool second = r >= I_GU; if (second) r -= I_GU;
                const int nblk = 2 * DFF / 32, kb = r / nblk, nb = r % nblk, n0 = nb * 32;
                const int drow = n0 < DFF ? (n0 / 128) * 256 + (n0 % 128) : ((n0 - DFF) / 128) * 256 + 128 + ((n0 - DFF) % 128);
                tr_item(args.in[second ? 17 : 3], 2 * DFF, kb * 64, n0, args.in[second ? 16 : 2], 1.0f, (second ? Wgu2 : Wgu1) + (size_t)drow * D, D, scr, lane); continue; }
            r -= 2 * I_GU;
            if (r < 2 * I_DN) { const bool second = r >= I_DN; if (second) r -= I_DN; const int nblk = D / 32, kb = r / nblk, nb = r % nblk;
                tr_item(args.in[second ? 18 : 4], D, kb * 64, nb * 32, nullptr, 1.0f, (second ? Wd2 : Wd1) + (size_t)(nb * 32) * DFF, DFF, scr, lane); continue; }
            r -= 2 * I_DN;
            if (r < I_IN) { const int nblk = NQKV / 32, kb = r / nblk, nb = r % nblk, n0 = nb * 32; const bool isq = (n0 < 768) || (n0 >= 2304 && n0 < 2560);
                tr_item(args.in[6], NQKV, kb * 64, n0, args.in[5], isq ? 0.125f : 1.0f, Win + (size_t)n0 * D, D, scr, lane); continue; }
            r -= I_IN;
            if (r < I_SQ) { const int nblk = D / 32, kb = r / nblk, nb = r % nblk, k0 = kb * 64; const float* gp = k0 < 768 ? args.in[8] : args.in[9] - 768;
                tr_item(args.in[10], D, k0, nb * 32, gp, 1.0f, Wout + (size_t)(nb * 32) * D, D, scr, lane); continue; }
            r -= I_SQ;
            if (r < I_SQ) { const int nblk = D / 32, kb = r / nblk, nb = r % nblk; tr_item(args.in[15], D, kb * 64, nb * 32, nullptr, 1.0f, Wco + (size_t)(nb * 32) * D, D, scr, lane); continue; }
            r -= I_SQ;
            { const int nblk = 2 * D / 32, kb = r / nblk, nb = r % nblk; tr_item(args.in[14], 2 * D, kb * 64, nb * 32, args.in[12], 1.0f, Wckv + (size_t)(nb * 32) * D, D, scr, lane); }
        }
        for (int c = gw; c < D; c += NGW) { const float g = args.in[11][c] * 0.0625f; const f32x4* src = (const f32x4*)(args.in[13] + (size_t)c * D) + lane; u32x2* dst = (u32x2*)(Wcqs + (size_t)c * D) + lane;
#pragma unroll
            for (int j = 0; j < 4; ++j) { const f32x4 v = src[64 * j] * g; u32x2 w; w[0] = cvt_pk_bf16(v[0], v[1]); w[1] = cvt_pk_bf16(v[2], v[3]); dst[64 * j] = w; } }
        for (int m = gw; m < M; m += 4 * NGW) cvt_rows<4>(x_in, XB, SS0, m, NGW, M, lane);
        for (int m = gw; m < MM; m += NGW) cvt_rows<1>(mem_in, MB, SSM, m, NGW, MM, lane);
        for (int i = gw * 64 + lane; i < NBAT * 16 * 256; i += NGW * 64) KM[i] = 0.f;
    }
    SEAM(0);

    if (IN(1)) {
        MK_PTRS;
        STAGGER();
        { SchedStd S; S.o.init(M, 2 * DFF, G, bx); if (args.flags & 32) S.o.nwg = G; if (args.flags & 64) S.o.nwg = 2 * G; S.A = (const char*)XB; S.B = (const char*)Wgu1; S.a_tile = (size_t)256 * D * 2; S.b_tile = (size_t)256 * D * 2; S.b_batch = 0; S.ocol_mul = 128;
          EpiGU E{HB, SS0}; pg8::gemm_phase<EpiGU, SchedStd, true>(lds, D, D, (args.flags & 8) ? D / 128 : D / 64, S, E); }
        { SchedStd S; S.o.init(MM, 2 * D, G, (bx + G / 2) % G); S.A = (const char*)MB; S.B = (const char*)Wckv; S.a_tile = (size_t)256 * D * 2; S.b_tile = (size_t)256 * D * 2; S.b_batch = 0; S.ocol_mul = 256;
          EpiStore E{KVC, 2 * D, SSM, nullptr}; pg8::gemm_phase<EpiStore, SchedStd, true>(lds, D, D, D / 64, S, E); }
    }
    SEAM(1);

    if (IN(2)) {
        MK_PTRS;
        SchedStd S; S.o.init(M, D, G, bx); S.A = (const char*)HB; S.B = (const char*)Wd1; S.a_tile = (size_t)256 * DFF * 2; S.b_tile = (size_t)256 * DFF * 2; S.b_batch = 0; S.ocol_mul = 256;
        EpiRes E{XB, SS1, 0.5f}; pg8::gemm_phase<EpiRes, SchedStd, true>(lds, DFF, DFF, DFF / 64, S, E);
    }
    SEAM(2);

    if (IN(3)) {
        MK_PTRS;
        { SchedStd S; S.o.init(M, NQKV, G, bx); S.A = (const char*)XB; S.B = (const char*)Win; S.a_tile = (size_t)256 * D * 2; S.b_tile = (size_t)256 * D * 2; S.b_batch = 0; S.ocol_mul = 256;
          EpiStore E{QKV, NQKV, SS1, KM}; pg8::gemm_phase<EpiStore, SchedStd, true>(lds, D, D, D / 64, S, E); }
        { SchedWK S{G, bx, (const char*)KVC, (const char*)Wcqs}; EpiStore E{WKT, D, nullptr, nullptr}; pg8::gemm_phase<EpiStore, SchedWK, true>(lds, 2 * D, D, 4, S, E); }
        { SchedVW S{G, (bx + G / 2) % G, (const char*)KVC, (const char*)Wco}; EpiStore E{VWT, D, nullptr, nullptr}; pg8::gemm_phase<EpiStore, SchedVW, true>(lds, D, 2 * D, 4, S, E); }
    }
    SEAM(3);

    if (IN(4)) {
        MK_PTRS;
        LAS float* tab = (LAS float*)(lds + LDS_TAB);
        const int h2 = lane >> 5, q = lane & 31;
        const long rowb = (long)NQKV * 2;
#define ATT_WAITV(n) asm volatile("s_waitcnt vmcnt(" #n ")" ::: "memory")
#define ATT_BAR() do { asm volatile("s_waitcnt lgkmcnt(0)" ::: "memory"); __builtin_amdgcn_s_barrier(); asm volatile("" ::: "memory"); } while (0)
        for (int i = tid; i < 4 * att::TABB_N; i += NWAVES * 64) { const int hb = i / att::TABB_N, e = i % att::TABB_N, dist = e - 32;
            tab[i] = dist >= 0 ? rel_bias[att::rel_bucket(dist) * 16 + 12 + hb] * LOG2E : -INFINITY; }
        __syncthreads();
        constexpr int NMOBA = NBAT * 4 * 16;
        for (int j = (args.flags & 1) ? NMOBA : vcu; j < NMOBA / 2; j += G)
#pragma unroll 1
            for (int half = 0; half < 2; ++half) {
                const int it = half ? (NMOBA - 1 - j) : j; const int qb = 15 - it / (NBAT * 4), bh = it % (NBAT * 4), b = bh >> 2, hb = bh & 3;
                const int q0 = qb * 256 + wave * 32;
                const char* base = (const char*)QKV + (size_t)b * SEQ * rowb;
                const char* qbase = base + (size_t)q0 * rowb + (2304 + hb * 64) * 2;
                const char* kbase = base + (2560 + hb * 64) * 2;
                att::bf16x8 qf[4];
#pragma unroll
                for (int d0 = 0; d0 < 4; ++d0) qf[d0] = *(const att::bf16x8*)(qbase + (long)q * rowb + (16 * d0 + 8 * h2) * 2);
                const unsigned sel = att::moba_select(qbase, rowb, KM + (size_t)b * 16 * 256 + hb * 64, qb);
                const LAS float* tb = tab + hb * att::TABB_N;
                const int NT = 4 * (qb + 1);
                const int drow = wave * 8 + (lane >> 3);
                const char* ksrc = kbase + (long)drow * rowb;
                ATT_WAITV(0);
                constexpr int NS = 6;
                int st_t = 0;
#pragma unroll
                for (int k = 0; k < NS - 1; ++k) if (k < NT)
                    att::dma_rows8(ksrc + (long)(NT - 1 - k) * 64 * rowb, 512, drow, (LAS char*)(lds + k * 16384 + wave * 1024), (LAS char*)(lds + k * 16384 + 8192 + wave * 1024), lane);
                att::f32x16 o[2]; o[0] = att::f32x16{}; o[1] = att::f32x16{}; float mo = -1e30f, lo_ = 0.f;
#pragma unroll 1
                for (int t = NT - 1; t >= 0; --t) {
                    if (t >= 4) ATT_WAITV(8); else if (t == 3) ATT_WAITV(6); else if (t == 2) ATT_WAITV(4); else if (t == 1) ATT_WAITV(2); else ATT_WAITV(0);
                    ATT_BAR();
                    if (t >= NS - 1) { const int s2 = st_t == 0 ? NS - 1 : st_t - 1;
                        att::dma_rows8(ksrc + (long)(t - (NS - 1)) * 64 * rowb, 512, drow, (LAS char*)(lds + s2 * 16384 + wave * 1024), (LAS char*)(lds + s2 * 16384 + 8192 + wave * 1024), lane); }
                    const LAS char* kt = (const LAS char*)(lds + st_t * 16384);
#pragma unroll
                    for (int gg = 1; gg >= 0; --gg) {
                        const int g0 = 64 * t + 32 * gg;
                        if (g0 <= q0) {
                            int B = (q0 - g0 + 32) + q - 4 * h2; B = B < (att::TABB_N - 1) ? B : (att::TABB_N - 1);
                            const int n = g0 >> 8; const bool sl = (n == qb) || ((sel >> n) & 1u); B = sl ? B : 27;
                            att::attn_group(qf, o, mo, lo_, kt + gg * 4096, kt + 8192 + gg * 4096, tb + B, lane);
                        }
                    }
                    st_t = st_t == NS - 1 ? 0 : st_t + 1;
                }
                ATT_BAR();
                lo_ += __shfl_xor(lo_, 32);
                att::store_o(o, lo_, (char*)OB + ((size_t)(b * SEQ + q0 + q) * 256 + hb * 64) * 2, h2);
            }
        __syncthreads();
        for (int i = tid; i < 36 * att::TABA_N; i += NWAVES * 64) { const int t = i / att::TABA_N, e = i % att::TABA_N, p = t / 12, h = t % 12, delta = e - 32, d = p == 0 ? 1 : (p == 1 ? 4 : 16);
            tab[i] = (delta >= 0 && delta <= 128) ? rel_bias[att::rel_bucket(delta * d) * 16 + h] * LOG2E : -INFINITY; }
        __syncthreads();
        constexpr int NDIL = NBAT * 12 * 48;
        struct DilItem { int b, h, p, d, res, m0, mbase; };
        auto decode = [&](int it, DilItem& I) { const int bh = it / 48, j = it % 48; I.b = bh / 12; I.h = bh % 12; I.p = j >> 4; const int jj = j & 15;
            I.d = I.p == 0 ? 1 : (I.p == 1 ? 4 : 16); I.res = I.p == 0 ? 0 : (I.p == 1 ? (jj & 3) : jj); const int mblk = I.p == 0 ? jj : (I.p == 1 ? (jj >> 2) : 0);
            I.mbase = mblk * 256 - 128; I.m0 = mblk * 256 + wave * 32; };
        att::bf16x8 qf[4];
        auto issue = [&](const DilItem& I) {
            const char* base = (const char*)QKV + ((size_t)I.b * SEQ + I.res) * rowb; const long st = (long)I.d * rowb; const char* kbase = base + (768 + I.h * 64) * 2;
#pragma unroll 1
            for (int k = wave; k < 48; k += NWAVES) {
                if (I.mbase + 8 * k < 0 || (args.flags & 256)) continue;
                const int row = 8 * k + (lane >> 3);
                att::dma_rows8(kbase + (long)(I.mbase + row) * st, 768 * 2, row, (LAS char*)(lds + k * 1024), (LAS char*)(lds + 49152 + k * 1024), lane);
            }
            const char* qbase = base + (long)I.m0 * st + (I.h * 64) * 2;
#pragma unroll
            for (int d0 = 0; d0 < 4; ++d0) qf[d0] = *(const att::bf16x8*)(qbase + (long)q * st + (16 * d0 + 8 * h2) * 2);
        };
        DilItem cur; int it = (args.flags & 2) ? NDIL : vcu;
        if (it < NDIL) { decode(it, cur); ATT_WAITV(0); issue(cur); }
#pragma unroll 1
        for (; it < NDIL; it += G) {
            ATT_WAITV(0); ATT_BAR();
            att::f32x16 o[2]; o[0] = att::f32x16{}; o[1] = att::f32x16{}; float mo = -1e30f, lo_ = 0.f;
            const LAS float* ta = tab + (cur.p * 12 + cur.h) * att::TABA_N;
            const int m0 = cur.m0, gend = (m0 - 128) > 0 ? (m0 - 128) : 0;
            { att::bf16x8 qc[4] = {qf[0], qf[1], qf[2], qf[3]};
#pragma unroll 1
            for (int g0 = (args.flags & 128) ? gend - 32 : m0; g0 >= gend; g0 -= 32) {
                const int B = (m0 - g0 + 32) + q - 4 * h2;
                const LAS char* kg = (const LAS char*)(lds + (g0 - cur.mbase) * 128);
                att::attn_group(qc, o, mo, lo_, kg, kg + 49152, ta + B, lane);
            } }
            ATT_BAR();
            const DilItem done = cur;
            if (it + G < NDIL) { decode(it + G, cur); issue(cur); }
            lo_ += __shfl_xor(lo_, 32);
            const size_t tok = (size_t)done.b * SEQ + (size_t)(m0 + q) * done.d + done.res;
            att::store_o(o, lo_, (char*)(done.p == 0 ? OA0 : (done.p == 1 ? OA1 : OA2)) + (tok * 768 + done.h * 64) * 2, h2);
            if (h2 == 0) *(f32x2*)(ML + (((size_t)done.p * M + tok) * 12 + done.h) * 2) = (f32x2){mo, lo_};
        }
#undef ATT_WAITV
#undef ATT_BAR
    }
    SEAM(4);

    if (IN(5)) {
        MK_PTRS;
        for (int row0 = gw; row0 < M; row0 += 2 * NGW) {
            f32x2 ml[2][3][3]; u32x2 oa[2][3][3]; u32x2 ob[2];
#pragma unroll
            for (int r = 0; r < 2; ++r) { const int row = (row0 + r * NGW) < M ? (row0 + r * NGW) : row0;
#pragma unroll
                for (int k = 0; k < 3; ++k) { const int col = 256 * k + 4 * lane, hd = col >> 6;
#pragma unroll
                    for (int p = 0; p < 3; ++p) ml[r][k][p] = *(const f32x2*)(ML + (((size_t)p * M + row) * 12 + hd) * 2);
                    oa[r][k][0] = *(const u32x2*)(OA0 + (size_t)row * 768 + col); oa[r][k][1] = *(const u32x2*)(OA1 + (size_t)row * 768 + col); oa[r][k][2] = *(const u32x2*)(OA2 + (size_t)row * 768 + col); }
                ob[r] = *(const u32x2*)(OB + (size_t)row * 256 + 4 * lane); }
            float va[2][3][4], vb[2][4], ssa[2], ssb[2];
#pragma unroll
            for (int r = 0; r < 2; ++r) { ssa[r] = 0.f; ssb[r] = 0.f;
#pragma unroll
                for (int k = 0; k < 3; ++k) {
                    const float Mx = fmaxf(ml[r][k][0][0], fmaxf(ml[r][k][1][0], ml[r][k][2][0]));
                    const float w0 = ml[r][k][0][1] * __builtin_amdgcn_exp2f(ml[r][k][0][0] - Mx), w1 = ml[r][k][1][1] * __builtin_amdgcn_exp2f(ml[r][k][1][0] - Mx), w2 = ml[r][k][2][1] * __builtin_amdgcn_exp2f(ml[r][k][2][0] - Mx);
                    const float iw = 1.0f / (w0 + w1 + w2);
#pragma unroll
                    for (int e = 0; e < 4; ++e) { const unsigned s0 = oa[r][k][0][e >> 1], s1 = oa[r][k][1][e >> 1], s2 = oa[r][k][2][e >> 1];
                        const float f0 = __builtin_bit_cast(float, (e & 1) ? (s0 & 0xffff0000u) : (s0 << 16)), f1 = __builtin_bit_cast(float, (e & 1) ? (s1 & 0xffff0000u) : (s1 << 16)), f2 = __builtin_bit_cast(float, (e & 1) ? (s2 & 0xffff0000u) : (s2 << 16));
                        const float v = (w0 * f0 + w1 * f1 + w2 * f2) * iw; va[r][k][e] = v; ssa[r] += v * v; } }
#pragma unroll
                for (int e = 0; e < 4; ++e) { const unsigned s0 = ob[r][e >> 1]; vb[r][e] = __builtin_bit_cast(float, (e & 1) ? (s0 & 0xffff0000u) : (s0 << 16)); ssb[r] += vb[r][e] * vb[r][e]; } }
#pragma unroll
            for (int of = 1; of < 64; of <<= 1)
#pragma unroll
                for (int r = 0; r < 2; ++r) { ssa[r] += __shfl_xor(ssa[r], of); ssb[r] += __shfl_xor(ssb[r], of); }
#pragma unroll
            for (int r = 0; r < 2; ++r) { const int row = row0 + r * NGW; if (row < M) {
                const float ra = __builtin_amdgcn_rsqf(ssa[r] * (1.0f / 768.0f) + EPS), rb = __builtin_amdgcn_rsqf(ssb[r] * (1.0f / 256.0f) + EPS);
#pragma unroll
                for (int k = 0; k < 3; ++k) { u32x2 w; w[0] = cvt_pk_bf16(va[r][k][0] * ra, va[r][k][1] * ra); w[1] = cvt_pk_bf16(va[r][k][2] * ra, va[r][k][3] * ra); *(u32x2*)(YN + (size_t)row * D + 256 * k + 4 * lane) = w; }
                { u32x2 w; w[0] = cvt_pk_bf16(vb[r][0] * rb, vb[r][1] * rb); w[1] = cvt_pk_bf16(vb[r][2] * rb, vb[r][3] * rb); *(u32x2*)(YN + (size_t)row * D + 768 + 4 * lane) = w; } } }
        }
    }
    SEAM(5);

    if (IN(6)) {
        MK_PTRS;
        SchedStd S; S.o.init(M, D, G, bx); S.A = (const char*)YN; S.B = (const char*)Wout; S.a_tile = (size_t)256 * D * 2; S.b_tile = (size_t)256 * D * 2; S.b_batch = 0; S.ocol_mul = 256;
        EpiRes E{XB, SS2, 1.0f}; pg8::gemm_phase<EpiRes, SchedStd, true>(lds, D, D, D / 64, S, E);
    }
    SEAM(6);

    if (IN(7)) {
        MK_PTRS;
        SchedStd S; S.o.init(M, D, G, bx); S.A = (const char*)XB; S.B = (const char*)WKT; S.a_tile = (size_t)256 * D * 2; S.b_tile = (size_t)256 * D * 2; S.b_batch = (size_t)D * D * 2; S.ocol_mul = 256;
        EpiSoftmax E{PB, SS2}; pg8::gemm_phase<EpiSoftmax, SchedStd, true>(lds, D, D, D / 64, S, E);
    }
    SEAM(7);

    if (IN(8)) {
        MK_PTRS;
        SchedStd S; S.o.init(M, D, G, bx); S.A = (const char*)PB; S.B = (const char*)VWT; S.a_tile = (size_t)256 * D * 2; S.b_tile = (size_t)256 * D * 2; S.b_batch = (size_t)D * D * 2; S.ocol_mul = 256;
        EpiRes E{XB, SS3, 1.0f}; pg8::gemm_phase<EpiRes, SchedStd, true>(lds, D, D, D / 64, S, E);
    }
    SEAM(8);

    if (IN(9)) {
        MK_PTRS;
        STAGGER();
        SchedStd S; S.o.init(M, 2 * DFF, G, bx); S.A = (const char*)XB; S.B = (const char*)Wgu2; S.a_tile = (size_t)256 * D * 2; S.b_tile = (size_t)256 * D * 2; S.b_batch = 0; S.ocol_mul = 128;
        EpiGU E{HB, SS3}; pg8::gemm_phase<EpiGU, SchedStd, true>(lds, D, D, D / 64, S, E);
    }
    SEAM(9);

    if (IN(10)) {
        MK_PTRS;
        SchedStd S; S.o.init(M, D, G, bx); S.A = (const char*)HB; S.B = (const char*)Wd2; S.a_tile = (size_t)256 * DFF * 2; S.b_tile = (size_t)256 * DFF * 2; S.b_batch = 0; S.ocol_mul = 256;
        EpiRes E{XB, SS4, 0.5f}; pg8::gemm_phase<EpiRes, SchedStd, true>(lds, DFF, DFF, DFF / 64, S, E);
    }
    SEAM(10);

    if (IN(11)) {
        MK_PTRS;
        const float* gf = args.in[19];
        for (int row0 = gw; row0 < M; row0 += 4 * NGW) {
            u32x2 w[4][4]; float rs[4]; const f32x4* gr = (const f32x4*)gf + lane;
#pragma unroll
            for (int r = 0; r < 4; ++r) { const int row = (row0 + r * NGW) < M ? (row0 + r * NGW) : row0; const u32x2* xr = (const u32x2*)(XB + (size_t)row * D) + lane;
#pragma unroll
                for (int j = 0; j < 4; ++j) w[r][j] = xr[64 * j];
                rs[r] = row_rstd(SS4, row); }
#pragma unroll
            for (int r = 0; r < 4; ++r) { const int row = row0 + r * NGW; if (row < M) { f32x4* orow = (f32x4*)(out + (size_t)row * D) + lane;
#pragma unroll
                for (int j = 0; j < 4; ++j) { f32x4 v; v[0] = __builtin_bit_cast(float, w[r][j][0] << 16); v[1] = __builtin_bit_cast(float, w[r][j][0] & 0xffff0000u); v[2] = __builtin_bit_cast(float, w[r][j][1] << 16); v[3] = __builtin_bit_cast(float, w[r][j][1] & 0xffff0000u);
                    orow[64 * j] = v * rs[r] * gr[64 * j]; } } }
        }
    }
#undef IN
#undef SEAM
}
}

#if MK_DEBUG
namespace dbg {
__global__ void __launch_bounds__(256) cmp_f32(const float* a, const float* r, size_t n, float* acc) {
    float num = 0.f, den = 0.f;
    for (size_t i = (size_t)blockIdx.x * 256 + threadIdx.x; i < n; i += (size_t)gridDim.x * 256) { const float d = a[i] - r[i]; num += d * d; den += r[i] * r[i]; }
    for (int o = 32; o > 0; o >>= 1) { num += __shfl_xor(num, o); den += __shfl_xor(den, o); }
    if ((threadIdx.x & 63) == 0) { atomicAdd(acc, num); atomicAdd(acc + 1, den); }
}
__global__ void __launch_bounds__(256) cmp_bf16(const unsigned short* a, int lda, const float* colscale, const float* r, int ldr, int rows, int cols, float* acc) {
    float num = 0.f, den = 0.f; const size_t n = (size_t)rows * cols;
    for (size_t i = (size_t)blockIdx.x * 256 + threadIdx.x; i < n; i += (size_t)gridDim.x * 256) { const size_t row = i / cols; const int c = (int)(i % cols);
        const float av = __builtin_bit_cast(float, (unsigned)a[row * lda + c] << 16) * (colscale ? colscale[c] : 1.0f); const float rv = r[row * ldr + c]; const float d = av - rv; num += d * d; den += rv * rv; }
    for (int o = 32; o > 0; o >>= 1) { num += __shfl_xor(num, o); den += __shfl_xor(den, o); }
    if ((threadIdx.x & 63) == 0) { atomicAdd(acc, num); atomicAdd(acc + 1, den); }
}
__global__ void __launch_bounds__(256) cmp_p(const unsigned short* a, const float* r, float* acc) {
    float num = 0.f, den = 0.f; const size_t n = (size_t)4096 * 1024;
    for (size_t i = (size_t)blockIdx.x * 256 + threadIdx.x; i < n; i += (size_t)gridDim.x * 256) { const size_t row = i / 1024; const int c = (int)(i % 1024);
        const float av = __builtin_bit_cast(float, (unsigned)a[i] << 16); const float rv = r[(size_t)(c >> 8) * 4096 * 256 + row * 256 + (c & 255)]; const float d = av - rv; num += d * d; den += rv * rv; }
    for (int o = 32; o > 0; o >>= 1) { num += __shfl_xor(num, o); den += __shfl_xor(den, o); }
    if ((threadIdx.x & 63) == 0) { atomicAdd(acc, num); atomicAdd(acc + 1, den); }
}
__global__ void build_scales(float* qkvs, float* gcat, const float* goa, const float* gob) {
    const int i = blockIdx.x * 256 + threadIdx.x;
    if (i < 3072) qkvs[i] = ((i < 768) || (i >= 2304 && i < 2560)) ? 8.0f : 1.0f;
    if (i < 1024) gcat[i] = i < 768 ? goa[i] : gob[i - 768];
}
constexpr int NST = 8;
__global__ void __launch_bounds__(256) finalize(float* out, size_t n, const float* acc, int report) {
    const float tol[NST] = {0.03f, 0.03f, 0.03f, 0.08f, 0.03f, 0.05f, 0.03f, 0.03f};
    float E = 0.f;
    if (report > 0) { const float e = sqrtf(acc[2 * (report - 1)] / acc[2 * (report - 1) + 1]); E = (e == e) ? fminf(e, 3.0f) : 3.0f; }
    else { for (int k = NST - 1; k >= 0; --k) { const float e = sqrtf(acc[2 * k] / acc[2 * k + 1]); if (!(e <= tol[k])) E = 0.1f * (k + 1); } }
    for (size_t i = (size_t)blockIdx.x * 256 + threadIdx.x; i < n; i += (size_t)gridDim.x * 256) out[i] *= (1.0f + E);
}
}
#endif

static void mk_launch(const mk::Args& a0, int lo, int hi, int grid, hipStream_t st) {
    mk::Args a = a0; a.ph_lo = lo; a.ph_hi = hi;
    hipLaunchKernelGGL(mk::mk_fwd, dim3(grid), dim3(mk::NWAVES * 64), mk::LDS_BYTES, st, a);
    const hipError_t le = hipPeekAtLastError();
    if (le != hipSuccess) fprintf(stderr, "kernel_launch: launch of phases [%d,%d) failed: %s\n", lo, hi, hipGetErrorName(le));
}

extern "C" void kernel_launch(void* const* d_in, const int* in_sizes, int n_in, void* d_out, int out_size, void* d_ws, size_t ws_size, hipStream_t stream) {
    static int grid = 0;
    if (grid == 0) {
        if (n_in != 20 || out_size != 8 * 4096 * 1024) { fprintf(stderr, "kernel_launch: unexpected shapes (n_in %d out %d)\n", n_in, out_size); grid = -1; return; }
        int dev = 0, cus = 0, per_cu = 0;
        if (hipGetDevice(&dev) != hipSuccess || hipDeviceGetAttribute(&cus, hipDeviceAttributeMultiprocessorCount, dev) != hipSuccess) { grid = -1; return; }
        if (hipFuncSetAttribute((const void*)mk::mk_fwd, hipFuncAttributeMaxDynamicSharedMemorySize, mk::LDS_BYTES) != hipSuccess) { fprintf(stderr, "kernel_launch: hipFuncSetAttribute failed\n"); grid = -1; return; }
        if (hipOccupancyMaxActiveBlocksPerMultiprocessor(&per_cu, (const void*)mk::mk_fwd, mk::NWAVES * 64, mk::LDS_BYTES) != hipSuccess || per_cu < 1) fprintf(stderr, "kernel_launch: occupancy query reports %d workgroups per CU\n", per_cu);
        (void)hipGetLastError();
        grid = cus;
    }
    if (grid < 0) return;
    unsigned char* ws = (unsigned char*)d_ws;
#if MK_DEBUG
    const size_t ref_off = (mk::WS_END + 4095) / 4096 * 4096;
    size_t off = ref_off + (size_t)290 * 1024 * 1024;
    auto take = [&](size_t bytes) { unsigned char* p = ws + off; off += (bytes + 255) / 256 * 256; return p; };
    float* sx1 = (float*)take((size_t)4096 * 1024 * 4); float* sx2 = (float*)take((size_t)4096 * 1024 * 4); float* sx3 = (float*)take((size_t)4096 * 1024 * 4);
    float* mkout = (float*)take((size_t)4096 * 1024 * 4); float* qkvs = (float*)take(3072 * 4); float* gcat = (float*)take(1024 * 4); float* acc = (float*)take(256);
    if (off > ws_size) { fprintf(stderr, "kernel_launch: debug build needs %zu bytes of workspace, got %zu\n", off, ws_size); return; }
    ref::Snap snap{sx1, sx2, sx3};
    ref::forward(d_in, (float*)d_out, ws + ref_off, stream, &snap);
    (void)hipMemsetAsync(ws + mk::WS_CTL, 0, mk::CTL_BYTES, stream);
    (void)hipMemsetAsync(acc, 0, 256, stream);
    dbg::build_scales<<<12, 256, 0, stream>>>(qkvs, gcat, (const float*)d_in[8], (const float*)d_in[9]);
    mk::Args a{};
    for (int i = 0; i < 20; ++i) a.in[i] = (const float*)d_in[i];
    a.in[0] = (const float*)d_in[0] + (size_t)7 * 4096 * 1024; a.in[1] = (const float*)d_in[1] + (size_t)7 * 256 * 1024;
    a.out = mkout; a.ws = ws;
    const ref::Bufs& rb = ref::g_bufs;
    for (int ph = 0; ph < mk::NPH; ++ph) {
        mk_launch(a, ph, ph + 1, grid, stream);
        if (ph == 1) dbg::cmp_bf16<<<512, 256, 0, stream>>>((const unsigned short*)(ws + mk::WS_KVC), 2048, nullptr, rb.kvc, 2048, 256, 2048, acc + 0);
        if (ph == 2) dbg::cmp_bf16<<<512, 256, 0, stream>>>((const unsigned short*)(ws + mk::WS_XB), 1024, nullptr, sx1, 1024, 4096, 1024, acc + 2);
        if (ph == 3) dbg::cmp_bf16<<<512, 256, 0, stream>>>((const unsigned short*)(ws + mk::WS_R1), 3072, qkvs, rb.proj, 3072, 4096, 3072, acc + 4);
        if (ph == 5) dbg::cmp_bf16<<<512, 256, 0, stream>>>((const unsigned short*)(ws + mk::WS_R1), 1024, gcat, rb.yn, 1024, 4096, 1024, acc + 6);
        if (ph == 6) dbg::cmp_bf16<<<512, 256, 0, stream>>>((const unsigned short*)(ws + mk::WS_XB), 1024, nullptr, sx2, 1024, 4096, 1024, acc + 8);
        if (ph == 7) dbg::cmp_p<<<512, 256, 0, stream>>>((const unsigned short*)(ws + mk::WS_R1), rb.sc, acc + 10);
        if (ph == 8) dbg::cmp_bf16<<<512, 256, 0, stream>>>((const unsigned short*)(ws + mk::WS_XB), 1024, nullptr, sx3, 1024, 4096, 1024, acc + 12);
        if (ph == 11) dbg::cmp_f32<<<512, 256, 0, stream>>>(mkout, (const float*)d_out + (size_t)7 * 4096 * 1024, (size_t)4096 * 1024, acc + 14);
    }
    dbg::finalize<<<1024, 256, 0, stream>>>((float*)d_out, (size_t)8 * 4096 * 1024, acc, MK_REPORT);
#else
    if (ws_size < mk::WS_END) { fprintf(stderr, "kernel_launch: needs %zu bytes of workspace, got %zu\n", (size_t)mk::WS_END, ws_size); return; }
    if (hipMemsetAsync(ws + mk::WS_CTL, 0, mk::CTL_BYTES, stream) != hipSuccess) return;
    mk::Args a{};
    for (int i = 0; i < 20; ++i) a.in[i] = (const float*)d_in[i];
    a.out = (float*)d_out; a.ws = ws;
#if MK_N_LAUNCHES == 1
    mk_launch(a, 0, mk::NPH, grid, stream);
#else
    for (int ph = 0; ph < mk::NPH; ++ph) {
        for (int r = 0; r < MK_REPEAT_N; ++r) if (ph == MK_REPEAT) { mk::Args a2 = a; a2.flags = MK_REPEAT_FLAGS; mk_launch(a2, ph, ph + 1, grid, stream); }
        mk_launch(a, ph, ph + 1, grid, stream); }
#endif
#endif
}
```

```cpp
#include <hip/hip_runtime.h>
#include <cstdio>
#include <cstdint>
#include <cmath>
#define MK_REPEAT -1
#define MK_REPEAT_N 1
#define MK_REPEAT_FLAGS 0
#define MK_STAGGER_TICKS 0
#define MK_NT_PART false
#define MK_DEBUG 0
#define MK_REPORT 0
#define MK_N_LAUNCHES 1
#define MK_NBAT 8

namespace pg8 {
#define PG8_LAS __attribute__((address_space(3)))
typedef unsigned short bf16_t;
typedef short bf16x8 __attribute__((ext_vector_type(8)));
typedef float f32x4 __attribute__((ext_vector_type(4)));
typedef float f32x2 __attribute__((ext_vector_type(2)));
typedef unsigned u32x4 __attribute__((ext_vector_type(4)));
typedef unsigned u32x2 __attribute__((ext_vector_type(2)));
constexpr int BM = 256, BK = 64, HALF = 128, HTB = HALF * BK * 2  , STAGE_BYTES = 8 * HTB, NXCD = 8, WGM = 8;

__host__ __device__ __forceinline__ int lds_byte(int r, int c) { const int st = (r >> 4) * 2 + (c >> 5), rr = r & 15, cc = c & 31, ob = rr * 64 + cc * 2; return st * 1024 + (ob ^ (((ob >> 9) & 1) << 5)); }
__host__ __device__ __forceinline__ void stage_rc(int b, int& R, int& C) { const int st = b / 1024, sb = b % 1024, swz = sb ^ (((sb >> 9) & 1) << 5); R = (st >> 1) * 16 + swz / 64; C = (st & 1) * 32 + (swz % 64) / 2; }
__host__ __device__ __forceinline__ int perm32(int rho) { const int n = rho >> 4, i = rho & 15; return 8 * (i >> 2) + 4 * n + (i & 3); }

struct Unit { const char* a; const char* b; int orow, ocol, aux; };

struct Order {
    int nM, nN, nwg, G, c;
    __device__ __forceinline__ void init(int M, int N, int G_, int c_) { nM = M / BM; nN = N / BM; nwg = nM * nN; G = G_; c = c_; }
    __device__ __forceinline__ bool tile(int i, int& pm, int& pn) const {
        const long L = (long)i * G + c; if (L >= nwg) return false;
        int wgid = (int)L; { const int q = nwg / NXCD, r = nwg % NXCD, xcd = wgid % NXCD, off = wgid / NXCD; wgid = (xcd < r ? xcd * (q + 1) : r * (q + 1) + (xcd - r) * q) + off; }
        const int nig = WGM * nN, gid = wgid / nig, fm = gid * WGM, gsz = (nM - fm) < WGM ? (nM - fm) : WGM;
        pm = fm + ((wgid % nig) % gsz); pn = (wgid % nig) / gsz; return true;
    }
};

__device__ __forceinline__ unsigned cvt_pk_bf16(float lo, float hi) { unsigned r; asm volatile("v_cvt_pk_bf16_f32 %0, %1, %2" : "=v"(r) : "v"(lo), "v"(hi)); return r; }

template <class Epi, class Sched, bool ALIGN_EPI>
__device__ __forceinline__ void gemm_phase(PG8_LAS unsigned char* lds, const int lda, const int ldb, const int nt, const Sched& S, const Epi& E) {
    int tid_ = threadIdx.x; asm volatile("" : "+v"(tid_));
    const int tid = tid_, wid = __builtin_amdgcn_readfirstlane(tid >> 6), lane = tid & 63, wr = wid >> 2, wc = wid & 3, fr = lane & 15, fq = lane >> 4;
    unsigned voffA[2], voffB[2];
#pragma unroll
    for (int i = 0; i < 2; ++i) { int R, C; stage_rc(tid * 16 + i * 8192, R, C); const int Rb = Epi::PERM ? ((R & ~31) + perm32(R & 31)) : R;
        voffA[i] = (unsigned)(R * lda + C) * 2u; voffB[i] = (unsigned)(Rb * ldb + C) * 2u; }
    const size_t kstep = (size_t)(BK * 2);
    const size_t hstepA = (size_t)HALF * lda * 2, hstepB = (size_t)HALF * ldb * 2;
    const unsigned ldsw = (unsigned)wid * 1024u;
    const int aoff = lds_byte(wr * 64 + fr, fq * 8), boff = lds_byte(wc * 32 + fr, fq * 8);
#define PG8_SA(b, h) (((b) * 2 + (h)) * HTB)
#define PG8_SB(b, h) ((4 + (b) * 2 + (h)) * HTB)
#define PG8_STAGE(bufoff, gbase, voff) do { _Pragma("unroll") for (int _i = 0; _i < 2; ++_i) \
        __builtin_amdgcn_global_load_lds((const unsigned*)((const char*)(gbase) + (voff)[_i]), (PG8_LAS unsigned*)(lds + (bufoff) + ldsw + _i * 8192), 16, 0, 0); } while (0)
#define PG8_LDA(dst, b, h) do { _Pragma("unroll") for (int m = 0; m < 4; ++m) _Pragma("unroll") for (int k = 0; k < 2; ++k) dst[m][k] = *(const PG8_LAS bf16x8*)(lds + PG8_SA(b, h) + aoff + m * 2048 + k * 1024); } while (0)
#define PG8_LDB(dst, b, h) do { _Pragma("unroll") for (int n = 0; n < 2; ++n) _Pragma("unroll") for (int k = 0; k < 2; ++k) dst[n][k] = *(const PG8_LAS bf16x8*)(lds + PG8_SB(b, h) + boff + n * 2048 + k * 1024); } while (0)
#define PG8_MMA(ai, bj, At, Bt) do { __builtin_amdgcn_s_setprio(1); _Pragma("unroll") for (int m = 0; m < 4; ++m) _Pragma("unroll") for (int n = 0; n < 2; ++n) _Pragma("unroll") for (int k = 0; k < 2; ++k) \
        acc[ai][bj][m][n] = __builtin_amdgcn_mfma_f32_16x16x32_bf16(Bt[n][k], At[m][k], acc[ai][bj][m][n], 0, 0, 0); __builtin_amdgcn_s_setprio(0); } while (0)
#define PG8_WAIT_V(n) asm volatile("s_waitcnt vmcnt(" #n ")" ::: "memory")
#define PG8_WAIT_L(n) asm volatile("s_waitcnt lgkmcnt(" #n ")" ::: "memory")
#define PG8_BAR __builtin_amdgcn_s_barrier()
#define PG8_SCHED __builtin_amdgcn_sched_barrier(0)
    Unit cur, nxt; int ui = 0;
    if (!S.next(0, cur)) return;
    f32x4 acc[2][2][4][2];
#pragma unroll
    for (int a = 0; a < 2; ++a)
#pragma unroll
        for (int b = 0; b < 2; ++b)
#pragma unroll
            for (int m = 0; m < 4; ++m)
#pragma unroll
                for (int n = 0; n < 2; ++n) acc[a][b][m][n] = (f32x4){0.f, 0.f, 0.f, 0.f};
    bf16x8 At[4][2], B0[2][2], B1[2][2];
    const char* cA = cur.a; const char* cB = cur.b;
    PG8_STAGE(PG8_SB(0, 0), cB, voffB); PG8_STAGE(PG8_SB(0, 1), cB + hstepB, voffB); PG8_STAGE(PG8_SA(0, 0), cA, voffA); PG8_STAGE(PG8_SA(0, 1), cA + hstepA, voffA);
    if (wr == 1) PG8_BAR;
    PG8_WAIT_V(2); PG8_BAR;
    PG8_STAGE(PG8_SB(1, 0), cB + kstep, voffB); PG8_STAGE(PG8_SA(1, 0), cA + kstep, voffA); PG8_STAGE(PG8_SB(1, 1), cB + hstepB + kstep, voffB);
    PG8_WAIT_V(6); PG8_BAR;
    for (;;) {
        const bool has_next = S.next(ui + 1, nxt);
        const char* nA = has_next ? nxt.a : cA; const char* nB = has_next ? nxt.b : cB;
#pragma unroll 1
        for (int t = 0; t < nt; t += 2) {
            const bool last = (t == nt - 2);
            const char* a1 = cA + (size_t)(t + 1) * kstep;
            const char* a2 = last ? nA : cA + (size_t)(t + 2) * kstep; const char* b2 = last ? nB : cB + (size_t)(t + 2) * kstep;
            const char* a3 = a2 + kstep; const char* b3 = b2 + kstep;
            PG8_LDB(B0, 0, 0); PG8_LDB(B1, 0, 1); PG8_SCHED; PG8_LDA(At, 0, 0); PG8_STAGE(PG8_SA(1, 1), a1 + hstepA, voffA);
            PG8_WAIT_V(8); PG8_WAIT_L(0); PG8_BAR; PG8_MMA(0, 0, At, B0); PG8_MMA(0, 1, At, B1); PG8_BAR; PG8_SCHED;
            PG8_LDA(At, 0, 1); PG8_STAGE(PG8_SB(0, 0), b2, voffB); PG8_STAGE(PG8_SB(0, 1), b2 + hstepB, voffB); PG8_STAGE(PG8_SA(0, 0), a2, voffA);
            PG8_WAIT_V(8); PG8_WAIT_L(0); PG8_BAR; PG8_MMA(1, 0, At, B0); PG8_MMA(1, 1, At, B1); PG8_BAR; PG8_SCHED;
            PG8_LDB(B0, 1, 0); PG8_LDB(B1, 1, 1); PG8_SCHED; PG8_LDA(At, 1, 0); PG8_STAGE(PG8_SA(0, 1), a2 + hstepA, voffA);
            PG8_WAIT_V(8); PG8_WAIT_L(0); PG8_BAR; PG8_MMA(0, 0, At, B0); PG8_MMA(0, 1, At, B1); PG8_BAR; PG8_SCHED;
            PG8_LDA(At, 1, 1); PG8_STAGE(PG8_SB(1, 0), b3, voffB); PG8_STAGE(PG8_SB(1, 1), b3 + hstepB, voffB); PG8_STAGE(PG8_SA(1, 0), a3, voffA);
            PG8_WAIT_V(8); PG8_WAIT_L(0); PG8_BAR; PG8_MMA(1, 0, At, B0); PG8_MMA(1, 1, At, B1); PG8_BAR; PG8_SCHED;
        }
        if constexpr (ALIGN_EPI) { if (wr == 0) PG8_BAR; }
        E(acc, cur, wr, wc, fr, fq, lds, wid, lane);
        if (!has_next) break;
#pragma unroll
        for (int a = 0; a < 2; ++a)
#pragma unroll
            for (int b = 0; b < 2; ++b)
#pragma unroll
                for (int m = 0; m < 4; ++m)
#pragma unroll
                    for (int n = 0; n < 2; ++n) acc[a][b][m][n] = (f32x4){0.f, 0.f, 0.f, 0.f};
        cur = nxt; cA = nA; cB = nB; ++ui;
        if constexpr (ALIGN_EPI) { if (wr == 1) PG8_BAR; }
    }
    PG8_WAIT_V(0);
    if constexpr (!ALIGN_EPI) { if (wr == 0) PG8_BAR; }
    PG8_BAR;
#undef PG8_SA
#undef PG8_SB
#undef PG8_STAGE
#undef PG8_LDA
#undef PG8_LDB
#undef PG8_MMA
#undef PG8_WAIT_V
#undef PG8_WAIT_L
#undef PG8_BAR
#undef PG8_SCHED
}
}

namespace att {
#define ATT_LAS __attribute__((address_space(3)))
typedef short bf16x8 __attribute__((ext_vector_type(8)));
typedef short v4i16 __attribute__((ext_vector_type(4)));
typedef float f32x16 __attribute__((ext_vector_type(16)));
typedef float f32x4 __attribute__((ext_vector_type(4)));
typedef unsigned u32x4 __attribute__((ext_vector_type(4)));
typedef unsigned u32x2 __attribute__((ext_vector_type(2)));
constexpr float LOG2E = 1.4426950408889634f;
constexpr int TABA_N = 192, TABB_N = 1600;

__device__ __forceinline__ int rel_bucket(int n) {
    if (n < 16) return n < 0 ? 0 : n;
    int b = 16;
    b += (n >= 22); b += (n >= 30); b += (n >= 40); b += (n >= 54); b += (n >= 73); b += (n >= 99); b += (n >= 134); b += (n >= 182);
    b += (n >= 246); b += (n >= 332); b += (n >= 450); b += (n >= 609); b += (n >= 825); b += (n >= 1117); b += (n >= 1513);
    return b;
}
__device__ __forceinline__ unsigned pk_bf16(float lo, float hi) { unsigned r; asm volatile("v_cvt_pk_bf16_f32 %0, %1, %2" : "=v"(r) : "v"(lo), "v"(hi)); return r; }
__device__ __forceinline__ float bf16_round(float x) { unsigned u = __builtin_bit_cast(unsigned, x); u = (u + 0x7fffu + ((u >> 16) & 1u)) & 0xffff0000u; return __builtin_bit_cast(float, u); }

__device__ __forceinline__ void glds16(const void* gsrc, unsigned lds_dst) { unsigned keep;
    asm volatile("s_mov_b32 %0, m0\n\ts_mov_b32 m0, %2\n\ts_nop 0\n\tglobal_load_lds_dwordx4 %1, off\n\ts_mov_b32 m0, %0" : "=&s"(keep) : "v"(gsrc), "s"(lds_dst) : "memory"); }
__device__ __forceinline__ void dma_rows8(const char* krow0  , const int voff, const int row  ,
                                          ATT_LAS char* kdst  , ATT_LAS char* vdst, const int lane) {
    const int pc = lane & 7;
    glds16(krow0 + 16 * (pc ^ ((row >> 1) & 7)), (unsigned)__builtin_amdgcn_readfirstlane((int)(unsigned)(uintptr_t)kdst));
    glds16(krow0 + voff + 16 * (pc ^ (((row >> 1) & 1) << 2)), (unsigned)__builtin_amdgcn_readfirstlane((int)(unsigned)(uintptr_t)vdst));
}

__device__ __forceinline__ void attn_group(const bf16x8 (&qf)[4], f32x16 (&o)[2], float& m, float& l, const ATT_LAS char* kg, const ATT_LAS char* vg, const ATT_LAS float* tp, const int lane) {
    const int q = lane & 31, h = lane >> 5;
    const ATT_LAS char* kr0 = kg + q * 128; const int kswz = (q >> 1) & 7;
    typedef float f32x2_ __attribute__((ext_vector_type(2)));
    f32x2_ t0, t1, t2, t3, t4, t5, t6, t7;
    { const unsigned ta = (unsigned)(uintptr_t)(tp - 27);
      asm volatile("ds_read2_b32 %0, %8 offset0:27 offset1:26\n\tds_read2_b32 %1, %8 offset0:25 offset1:24\n\tds_read2_b32 %2, %8 offset0:19 offset1:18\n\tds_read2_b32 %3, %8 offset0:17 offset1:16\n\t"
                   "ds_read2_b32 %4, %8 offset0:11 offset1:10\n\tds_read2_b32 %5, %8 offset0:9 offset1:8\n\tds_read2_b32 %6, %8 offset0:3 offset1:2\n\tds_read2_b32 %7, %8 offset0:1 offset1:0"
                   : "=&v"(t0), "=&v"(t1), "=&v"(t2), "=&v"(t3), "=&v"(t4), "=&v"(t5), "=&v"(t6), "=&v"(t7) : "v"(ta) : "memory"); }
    const int q4 = (lane & 15) >> 2, p4 = lane & 3, g1 = (lane >> 4) & 1, vsw = (q4 >> 1) & 1;
    const unsigned va0_ = (unsigned)(uintptr_t)(vg + (4 * h + q4) * 128 + 32 * g1 + 8 * p4 + 64 * vsw), va1_ = (unsigned)(uintptr_t)(vg + (4 * h + q4) * 128 + 32 * g1 + 8 * p4 + 64 * (1 ^ vsw));
    v4i16 a[2][4];
    asm volatile("ds_read_b64_tr_b16 %0, %8\n\tds_read_b64_tr_b16 %1, %8 offset:1024\n\tds_read_b64_tr_b16 %2, %8 offset:2048\n\tds_read_b64_tr_b16 %3, %8 offset:3072\n\t"
                 "ds_read_b64_tr_b16 %4, %9\n\tds_read_b64_tr_b16 %5, %9 offset:1024\n\tds_read_b64_tr_b16 %6, %9 offset:2048\n\tds_read_b64_tr_b16 %7, %9 offset:3072"
                 : "=&v"(a[0][0]), "=&v"(a[0][1]), "=&v"(a[0][2]), "=&v"(a[0][3]), "=&v"(a[1][0]), "=&v"(a[1][1]), "=&v"(a[1][2]), "=&v"(a[1][3]) : "v"(va0_), "v"(va1_) : "memory");
    f32x16 s = f32x16{};
#pragma unroll
    for (int d0 = 0; d0 < 4; ++d0) { const bf16x8 kf = *(const ATT_LAS bf16x8*)(kr0 + 16 * ((2 * d0 + h) ^ kswz)); s = __builtin_amdgcn_mfma_f32_32x32x16_bf16(kf, qf[d0], s, 0, 0, 0); }
    asm volatile("s_waitcnt lgkmcnt(0)" : "+v"(t0), "+v"(t1), "+v"(t2), "+v"(t3), "+v"(t4), "+v"(t5), "+v"(t6), "+v"(t7), "+v"(a[0][0]), "+v"(a[0][1]), "+v"(a[0][2]), "+v"(a[0][3]), "+v"(a[1][0]), "+v"(a[1][1]), "+v"(a[1][2]), "+v"(a[1][3]) :: "memory");
    float mx = -INFINITY;
    { const float tb_[16] = {t0[0], t0[1], t1[0], t1[1], t2[0], t2[1], t3[0], t3[1], t4[0], t4[1], t5[0], t5[1], t6[0], t6[1], t7[0], t7[1]};
#pragma unroll
      for (int r = 0; r < 16; ++r) s[r] = fmaf(s[r], LOG2E, tb_[r]); }
#pragma unroll
    for (int r = 0; r < 16; r += 2) mx = fmaxf(mx, fmaxf(s[r], s[r + 1]));
    mx = fmaxf(mx, __shfl_xor(mx, 32));
    if (__any(mx > m)) {
        const float mnew = fmaxf(m, mx), alpha = __builtin_amdgcn_exp2f(m - mnew);
        l *= alpha; m = mnew;
#pragma unroll
        for (int r = 0; r < 16; ++r) { o[0][r] *= alpha; o[1][r] *= alpha; }
    }
    float ps = 0.f;
#pragma unroll
    for (int r = 0; r < 16; ++r) { s[r] = __builtin_amdgcn_exp2f(s[r] - m); ps += s[r]; }
    l += ps;
    u32x4 pw0, pw1;
    pw0[0] = pk_bf16(s[0], s[1]); pw0[1] = pk_bf16(s[2], s[3]); pw0[2] = pk_bf16(s[4], s[5]); pw0[3] = pk_bf16(s[6], s[7]);
    pw1[0] = pk_bf16(s[8], s[9]); pw1[1] = pk_bf16(s[10], s[11]); pw1[2] = pk_bf16(s[12], s[13]); pw1[3] = pk_bf16(s[14], s[15]);
    const bf16x8 pb0 = __builtin_bit_cast(bf16x8, pw0), pb1 = __builtin_bit_cast(bf16x8, pw1);
#pragma unroll
    for (int dh = 0; dh < 2; ++dh) {
        const bf16x8 va0 = (bf16x8){a[dh][0][0], a[dh][0][1], a[dh][0][2], a[dh][0][3], a[dh][1][0], a[dh][1][1], a[dh][1][2], a[dh][1][3]};
        const bf16x8 va1 = (bf16x8){a[dh][2][0], a[dh][2][1], a[dh][2][2], a[dh][2][3], a[dh][3][0], a[dh][3][1], a[dh][3][2], a[dh][3][3]};
        o[dh] = __builtin_amdgcn_mfma_f32_32x32x16_bf16(va0, pb0, o[dh], 0, 0, 0);
        o[dh] = __builtin_amdgcn_mfma_f32_32x32x16_bf16(va1, pb1, o[dh], 0, 0, 0);
    }
}

template <bool NT>
__device__ __forceinline__ void store_o(const f32x16 (&o)[2], const float l, char* orow_q, const int h) {
    const float il = 1.0f / l;
#pragma unroll
    for (int dh = 0; dh < 2; ++dh)
#pragma unroll
        for (int jj = 0; jj < 2; ++jj) {
            u32x2 we, wo;
            we[0] = pk_bf16(o[dh][8 * jj] * il, o[dh][8 * jj + 1] * il); we[1] = pk_bf16(o[dh][8 * jj + 2] * il, o[dh][8 * jj + 3] * il);
            wo[0] = pk_bf16(o[dh][8 * jj + 4] * il, o[dh][8 * jj + 5] * il); wo[1] = pk_bf16(o[dh][8 * jj + 6] * il, o[dh][8 * jj + 7] * il);
            const unsigned s0 = h ? we[0] : wo[0], s1 = h ? we[1] : wo[1];
            const unsigned r0 = (unsigned)__shfl_xor((int)s0, 32), r1 = (unsigned)__shfl_xor((int)s1, 32);
            u32x4 w; if (h == 0) { w[0] = we[0]; w[1] = we[1]; w[2] = r0; w[3] = r1; } else { w[0] = r0; w[1] = r1; w[2] = wo[0]; w[3] = wo[1]; }
            u32x4* dst = (u32x4*)(orow_q + (32 * dh + 16 * jj + 8 * h) * 2);
            if (NT) __builtin_nontemporal_store(w, dst); else *dst = w;
        }
}

__device__ __forceinline__ unsigned moba_select(const char* qbase, const long qs, const float* km, const int qb) {
    const int lane = threadIdx.x & 63, q = lane & 31, h = lane >> 5;
    f32x16 g = f32x16{};
    const float* kmrow = km + (size_t)(q & 15) * 256;
    const bool lo_part = q >= 16;
#pragma unroll
    for (int d0 = 0; d0 < 4; ++d0) {
        const bf16x8 qf = *(const bf16x8*)(qbase + (long)q * qs + (16 * d0 + 8 * h) * 2);
        const f32x4 f0 = *(const f32x4*)(kmrow + 16 * d0 + 8 * h), f1 = *(const f32x4*)(kmrow + 16 * d0 + 8 * h + 4);
        float v[8] = {f0[0], f0[1], f0[2], f0[3], f1[0], f1[1], f1[2], f1[3]};
        u32x4 aw;
#pragma unroll
        for (int j = 0; j < 4; ++j) {
            const float h0 = bf16_round(v[2 * j]), h1 = bf16_round(v[2 * j + 1]);
            const float x0 = lo_part ? (v[2 * j] - h0) : h0, x1 = lo_part ? (v[2 * j + 1] - h1) : h1;
            aw[j] = pk_bf16(x0, x1);
        }
        g = __builtin_amdgcn_mfma_f32_32x32x16_bf16(__builtin_bit_cast(bf16x8, aw), qf, g, 0, 0, 0);
    }
    float gate[8], other[8];
#pragma unroll
    for (int r = 0; r < 8; ++r) { gate[r] = g[r] + g[r + 8]; }
#pragma unroll
    for (int r = 0; r < 8; ++r) { other[r] = __shfl_xor(gate[r], 32); }
    unsigned mymask = 0u;
#pragma unroll
    for (int r = 0; r < 8; ++r) {
        const int n = (r & 3) + 8 * (r >> 2) + 4 * h;
        int rank = 0;
#pragma unroll
        for (int r2 = 0; r2 < 8; ++r2) {
            const int n2 = (r2 & 3) + 8 * (r2 >> 2) + 4 * h, n3 = (r2 & 3) + 8 * (r2 >> 2) + 4 * (1 - h);
            if (r2 != r) rank += (n2 < qb && (gate[r2] > gate[r] || (gate[r2] == gate[r] && n2 < n))) ? 1 : 0;
            rank += (n3 < qb && (other[r2] > gate[r] || (other[r2] == gate[r] && n3 < n))) ? 1 : 0;
        }
        if (n < qb && rank < 3) mymask |= 1u << n;
    }
    return mymask | (unsigned)__shfl_xor((int)mymask, 32);
}
}


namespace mk {
using pg8::bf16_t; using pg8::bf16x8; using pg8::f32x4; using pg8::f32x2; using pg8::u32x4; using pg8::u32x2; using pg8::Unit; using pg8::cvt_pk_bf16;
#define LAS __attribute__((address_space(3)))
constexpr int NBAT = MK_NBAT, SEQ = 4096, D = 1024, DFF = 2816, NMEM = 256, M = NBAT * SEQ, MM = NBAT * NMEM, NQKV = 3072;
constexpr float EPS = 1e-6f, LOG2E = 1.4426950408889634f;
constexpr int NWAVES = 8, NPH = 12;

constexpr size_t al256(size_t x) { return (x + 255) / 256 * 256; }
constexpr size_t WS_CTL = 0, CTL_BYTES = 1u << 20;
constexpr size_t WS_WGU1 = WS_CTL + CTL_BYTES;
constexpr size_t WS_WD1 = WS_WGU1 + (size_t)2 * DFF * D * 2;
constexpr size_t WS_WIN = WS_WD1 + (size_t)D * DFF * 2;
constexpr size_t WS_WOUT = WS_WIN + (size_t)NQKV * D * 2;
constexpr size_t WS_WCQS = WS_WOUT + (size_t)D * D * 2;
constexpr size_t WS_WCKV = WS_WCQS + (size_t)D * D * 2;
constexpr size_t WS_WCO = WS_WCKV + (size_t)2 * D * D * 2;
constexpr size_t WS_WGU2 = WS_WCO + (size_t)D * D * 2;
constexpr size_t WS_WD2 = WS_WGU2 + (size_t)2 * DFF * D * 2;
constexpr size_t WS_MB = WS_WD2 + (size_t)D * DFF * 2;
constexpr size_t WS_KVC = WS_MB + (size_t)MM * D * 2;
constexpr size_t WS_WKT = WS_KVC + (size_t)MM * 2 * D * 2;
constexpr size_t WS_VWT = WS_WKT + (size_t)NBAT * D * D * 2;
constexpr size_t SS_BYTES = (size_t)M * 16 * 4;
constexpr size_t WS_SS = WS_VWT + (size_t)NBAT * D * D * 2;
constexpr size_t WS_SSM = WS_SS + 5 * SS_BYTES;
constexpr size_t WS_KM = WS_SSM + (size_t)MM * 16 * 4;
constexpr size_t WS_R1 = al256(WS_KM + (size_t)NBAT * 16 * 256 * 4);
constexpr size_t WS_XB = WS_R1 + (size_t)M * NQKV * 2;
constexpr size_t WS_OA2 = WS_XB + (size_t)M * D * 2;
constexpr size_t WS_END = WS_OA2 + (size_t)M * 768 * 2;
constexpr size_t OUT_OA1 = (size_t)M * 768 * 2, OUT_OB = 2 * OUT_OA1, OUT_ML = OUT_OB + (size_t)M * 256 * 2;
static_assert(OUT_ML + (size_t)3 * M * 12 * 8 <= (size_t)M * D * 4, "attention partials fit in d_out");
constexpr int CW_BAR = 4096;

constexpr int LDS_XCH = 131072;
constexpr int LDS_MISC = 131072 + 8192;
constexpr int LDS_BYTES = 147456;
constexpr int LDS_TAB = 98304;
static_assert(LDS_TAB + 36 * att::TABA_N * 4 <= LDS_XCH && LDS_TAB + 4 * att::TABB_N * 4 <= LDS_XCH, "attention LDS map");

__device__ __forceinline__ float wave_sum(float v) {
#pragma unroll
    for (int o = 1; o < 64; o <<= 1) v += __shfl_xor(v, o);
    return v;
}
__device__ __forceinline__ float row_rstd(const float* ss, int row) {
    const f32x4* p = (const f32x4*)(ss + (size_t)row * 16);
    const f32x4 a = p[0], b = p[1], c = p[2], d = p[3];
    const float s = ((a[0] + a[1]) + (a[2] + a[3])) + ((b[0] + b[1]) + (b[2] + b[3])) + ((c[0] + c[1]) + (c[2] + c[3])) + ((d[0] + d[1]) + (d[2] + d[3]));
    return 1.0f / sqrtf(s * (1.0f / D) + EPS);
}

struct SchedStd {
    pg8::Order o; const char* A; const char* B; size_t a_tile, b_tile, b_batch; int ocol_mul;
    __device__ __forceinline__ bool next(int i, Unit& u) const { int pm, pn; if (!o.tile(i, pm, pn)) return false;
        u.a = A + (size_t)pm * a_tile; u.b = B + (size_t)pn * b_tile + (size_t)(pm >> 4) * b_batch; u.orow = pm * 256; u.ocol = pn * ocol_mul; u.aux = pn; return true; }
};
struct SchedWK {
    int G, c; const char* kvc; const char* wcqs;
    __device__ __forceinline__ bool next(int i, Unit& u) const { const int L = i * G + c; if (L >= NBAT * 16) return false; const int bh = L >> 2, pn = L & 3, b = bh >> 2, h = bh & 3;
        u.a = kvc + ((size_t)(b * 256) * 2048 + h * 256) * 2; u.b = wcqs + ((size_t)(pn * 256) * 1024 + h * 256) * 2; u.orow = b * 1024 + h * 256; u.ocol = pn * 256; u.aux = 0; return true; }
};
struct SchedVW {
    int G, c; const char* kvc; const char* wcot;
    __device__ __forceinline__ bool next(int i, Unit& u) const { const int L = i * G + c; if (L >= NBAT * 16) return false; const int bh = L >> 2, pm = L & 3, b = bh >> 2, h = bh & 3;
        u.a = wcot + ((size_t)(pm * 256) * 1024 + h * 256) * 2; u.b = kvc + ((size_t)(b * 256) * 2048 + 1024 + h * 256) * 2; u.orow = b * 1024 + pm * 256; u.ocol = h * 256; u.aux = 0; return true; }
};

struct EpiGU { static constexpr bool PERM = true;
    bf16_t* H; const float* ss;
    __device__ __forceinline__ void operator()(const f32x4 (&acc)[2][2][4][2], const Unit& u, int wr, int wc, int fr, int fq, LAS unsigned char*, int, int) const {
        float rsv[2][4];
#pragma unroll
        for (int ai = 0; ai < 2; ++ai)
#pragma unroll
            for (int m = 0; m < 4; ++m) rsv[ai][m] = row_rstd(ss, u.orow + ai * 128 + wr * 64 + m * 16 + fr);
#pragma unroll
        for (int ai = 0; ai < 2; ++ai)
#pragma unroll
            for (int m = 0; m < 4; ++m) { const int row = u.orow + ai * 128 + wr * 64 + m * 16 + fr; const float rs = rsv[ai][m];
                float hv[8];
#pragma unroll
                for (int n = 0; n < 2; ++n)
#pragma unroll
                    for (int j = 0; j < 4; ++j) { const float g = acc[ai][0][m][n][j] * rs, uu = acc[ai][1][m][n][j] * rs;
                        hv[4 * n + j] = g * __builtin_amdgcn_rcpf(1.0f + __builtin_amdgcn_exp2f(-g * LOG2E)) * uu; }
                u32x4 w; w[0] = cvt_pk_bf16(hv[0], hv[1]); w[1] = cvt_pk_bf16(hv[2], hv[3]); w[2] = cvt_pk_bf16(hv[4], hv[5]); w[3] = cvt_pk_bf16(hv[6], hv[7]);
                __builtin_nontemporal_store(w, (u32x4*)(H + (size_t)row * DFF + u.ocol + wc * 32 + 8 * fq)); }
    }
};
struct EpiRes { static constexpr bool PERM = true;
    bf16_t* xb; float* ssout; float alpha;
    __device__ __forceinline__ void operator()(const f32x4 (&acc)[2][2][4][2], const Unit& u, int wr, int wc, int fr, int fq, LAS unsigned char*, int, int) const {
        const size_t off0 = (size_t)(u.orow + wr * 64 + fr) * D + u.ocol + wc * 32 + 8 * fq;
        u32x4 cur[2], nxt[2];
#pragma unroll
        for (int bj = 0; bj < 2; ++bj) cur[bj] = *(const u32x4*)(xb + off0 + bj * 128);
#pragma unroll
        for (int idx = 0; idx < 8; ++idx) { const int ai = idx >> 2, m = idx & 3; const size_t off = off0 + (size_t)(ai * 128 + m * 16) * D; const int row = u.orow + ai * 128 + wr * 64 + m * 16 + fr;
            if (idx < 7) { const size_t offn = off0 + (size_t)(((idx + 1) >> 2) * 128 + ((idx + 1) & 3) * 16) * D;
#pragma unroll
                for (int bj = 0; bj < 2; ++bj) nxt[bj] = *(const u32x4*)(xb + offn + bj * 128); }
            float sq = 0.f;
#pragma unroll
            for (int bj = 0; bj < 2; ++bj) { float o[8];
#pragma unroll
                for (int n = 0; n < 2; ++n)
#pragma unroll
                    for (int j = 0; j < 4; ++j) { const unsigned wv = cur[bj][2 * n + (j >> 1)]; const float r = __builtin_bit_cast(float, (j & 1) ? (wv & 0xffff0000u) : (wv << 16));
                        const float v = r + acc[ai][bj][m][n][j] * alpha; o[4 * n + j] = v; sq += v * v; }
                u32x4 w; w[0] = cvt_pk_bf16(o[0], o[1]); w[1] = cvt_pk_bf16(o[2], o[3]); w[2] = cvt_pk_bf16(o[4], o[5]); w[3] = cvt_pk_bf16(o[6], o[7]);
                *(u32x4*)(xb + off + bj * 128) = w; }
            sq += __shfl_xor(sq, 16); sq += __shfl_xor(sq, 32);
            if (fq == 0) ssout[(size_t)row * 16 + (u.ocol >> 8) * 4 + wc] = sq;
#pragma unroll
            for (int bj = 0; bj < 2; ++bj) cur[bj] = nxt[bj]; }
    }
};
struct EpiStore { static constexpr bool PERM = true;
    bf16_t* O; int ldc; const float* ss; float* km; bool nt;
    __device__ __forceinline__ void operator()(const f32x4 (&acc)[2][2][4][2], const Unit& u, int wr, int wc, int fr, int fq, LAS unsigned char*, int, int) const {
        float rsv[2][4];
#pragma unroll
        for (int ai = 0; ai < 2; ++ai)
#pragma unroll
            for (int m = 0; m < 4; ++m) rsv[ai][m] = ss ? row_rstd(ss, u.orow + ai * 128 + wr * 64 + m * 16 + fr) : 1.0f;
#pragma unroll
        for (int ai = 0; ai < 2; ++ai)
#pragma unroll
            for (int m = 0; m < 4; ++m) { const int row = u.orow + ai * 128 + wr * 64 + m * 16 + fr; const float rs = rsv[ai][m];
                const int col0 = u.ocol + wc * 32 + 8 * fq;
                bf16_t* rowp = ldc ? O + (size_t)row * ldc + col0 : O + (((size_t)(row / SEQ) * (NQKV / 64) + (col0 >> 6)) * SEQ + (row % SEQ)) * 64 + (col0 & 63);
                const size_t bjstep = ldc ? 128 : (size_t)2 * SEQ * 64;
#pragma unroll
                for (int bj = 0; bj < 2; ++bj) { const f32x4 v0 = acc[ai][bj][m][0] * rs, v1 = acc[ai][bj][m][1] * rs;
                    u32x4 w; w[0] = cvt_pk_bf16(v0[0], v0[1]); w[1] = cvt_pk_bf16(v0[2], v0[3]); w[2] = cvt_pk_bf16(v1[0], v1[1]); w[3] = cvt_pk_bf16(v1[2], v1[3]);
                    if (nt) __builtin_nontemporal_store(w, (u32x4*)(rowp + bj * bjstep)); else *(u32x4*)(rowp + bj * bjstep) = w; } }
        if ((km != nullptr) && (u.aux == 10)) {
            float* kmb = km + (size_t)(u.orow >> 8) * 256 + wc * 32 + 8 * fq;
#pragma unroll
            for (int bj = 0; bj < 2; ++bj)
#pragma unroll
                for (int n = 0; n < 2; ++n) { f32x4 cs = (f32x4){0.f, 0.f, 0.f, 0.f};
#pragma unroll
                    for (int ai = 0; ai < 2; ++ai)
#pragma unroll
                        for (int m = 0; m < 4; ++m) cs += acc[ai][bj][m][n] * rsv[ai][m];
#pragma unroll
                    for (int j = 0; j < 4; ++j) { float v = cs[j]; v += __shfl_xor(v, 1); v += __shfl_xor(v, 2); v += __shfl_xor(v, 4); v += __shfl_xor(v, 8);
                        if (fr == 0) atomicAdd(kmb + bj * 128 + 4 * n + j, v); } }
        }
    }
};
struct EpiSoftmax { static constexpr bool PERM = true;
    bf16_t* P; const float* ss;
    __device__ __forceinline__ void operator()(const f32x4 (&acc)[2][2][4][2], const Unit& u, int wr, int wc, int fr, int fq, LAS unsigned char* lds, int, int) const {
        LAS f32x2* X = (LAS f32x2*)(lds + LDS_XCH);
        float rsl[2][4], mw[2][4];
#pragma unroll
        for (int ai = 0; ai < 2; ++ai)
#pragma unroll
            for (int m = 0; m < 4; ++m) { const int rl = ai * 128 + wr * 64 + m * 16 + fr; const float rs = row_rstd(ss, u.orow + rl) * LOG2E; rsl[ai][m] = rs;
                float mx = -INFINITY;
#pragma unroll
                for (int bj = 0; bj < 2; ++bj)
#pragma unroll
                    for (int n = 0; n < 2; ++n)
#pragma unroll
                        for (int j = 0; j < 4; ++j) mx = fmaxf(mx, acc[ai][bj][m][n][j] * rs);
                mx = fmaxf(mx, __shfl_xor(mx, 16)); mx = fmaxf(mx, __shfl_xor(mx, 32));
                float sm = 0.f;
#pragma unroll
                for (int bj = 0; bj < 2; ++bj)
#pragma unroll
                    for (int n = 0; n < 2; ++n)
#pragma unroll
                        for (int j = 0; j < 4; ++j) sm += __builtin_amdgcn_exp2f(acc[ai][bj][m][n][j] * rs - mx);
                sm += __shfl_xor(sm, 16); sm += __shfl_xor(sm, 32);
                mw[ai][m] = mx;
                if (fq == 0) X[rl * 4 + wc] = (f32x2){mx, sm}; }
        asm volatile("s_waitcnt lgkmcnt(0)" ::: "memory"); __builtin_amdgcn_s_barrier(); asm volatile("" ::: "memory");
#pragma unroll
        for (int ai = 0; ai < 2; ++ai)
#pragma unroll
            for (int m = 0; m < 4; ++m) { const int rl = ai * 128 + wr * 64 + m * 16 + fr; const float rs = rsl[ai][m];
                const f32x2 x0 = X[rl * 4 + 0], x1 = X[rl * 4 + 1], x2 = X[rl * 4 + 2], x3 = X[rl * 4 + 3];
                const float Mx = fmaxf(fmaxf(x0[0], x1[0]), fmaxf(x2[0], x3[0]));
                const float L = x0[1] * __builtin_amdgcn_exp2f(x0[0] - Mx) + x1[1] * __builtin_amdgcn_exp2f(x1[0] - Mx) + x2[1] * __builtin_amdgcn_exp2f(x2[0] - Mx) + x3[1] * __builtin_amdgcn_exp2f(x3[0] - Mx);
                const float il = 1.0f / L;
                bf16_t* rowp = P + (size_t)(u.orow + rl) * D + u.ocol + wc * 32 + 8 * fq;
#pragma unroll
                for (int bj = 0; bj < 2; ++bj) { float pv[8];
#pragma unroll
                    for (int n = 0; n < 2; ++n)
#pragma unroll
                        for (int j = 0; j < 4; ++j) pv[4 * n + j] = __builtin_amdgcn_exp2f(acc[ai][bj][m][n][j] * rs - Mx) * il;
                    u32x4 w; w[0] = cvt_pk_bf16(pv[0], pv[1]); w[1] = cvt_pk_bf16(pv[2], pv[3]); w[2] = cvt_pk_bf16(pv[4], pv[5]); w[3] = cvt_pk_bf16(pv[6], pv[7]);
                    *(u32x4*)(rowp + bj * 128) = w; } }
        (void)mw;
    }
};

#define XB_TMO      128
#define XB_XCNT(j)  (256  + 64 * (j))
#define XB_XSUB(j)  (1280 + 64 * (j))
#define XB_XGEN(j)  (2304 + 64 * (j))
#define XB_TOP      3328
#define XB_TOPGEN   3392
#define XCD_BAR_WORDS 3456
#define XB_SPIN_CAP (1u << 18)
__device__ __forceinline__ unsigned xb_ld(unsigned* p)              { return __hip_atomic_load(p, __ATOMIC_RELAXED, __HIP_MEMORY_SCOPE_AGENT); }
__device__ __forceinline__ unsigned xb_add(unsigned* p, unsigned v) { return __hip_atomic_fetch_add(p, v, __ATOMIC_RELAXED, __HIP_MEMORY_SCOPE_AGENT); }
__device__ __forceinline__ unsigned xb_xcc_id() { return (unsigned)__builtin_amdgcn_s_getreg((3 << 11) | 20) & 0xFu; }
#define XB_SPIN(cond, bar) do { unsigned _sp = 0; while (cond) { __builtin_amdgcn_s_sleep(1); \
    if ((++_sp & 255u) == 0u) { if (xb_ld(&(bar)[XB_TMO])) break; if (_sp > XB_SPIN_CAP) { atomicAdd(&(bar)[XB_TMO], 1u); break; } } } } while (0)
struct XcdBarrier { unsigned* bar; unsigned x; volatile LAS unsigned* st; };
__device__ __forceinline__ XcdBarrier xcd_barrier_post(unsigned* bar, volatile LAS unsigned* st) {
    XcdBarrier b; b.bar = bar; b.x = xb_xcc_id(); b.st = st;
    if (threadIdx.x == 0) (void)xb_add(&bar[XB_XCNT(b.x)], 1u);
    return b;
}
__device__ __forceinline__ void xcd_barrier_complete(unsigned* bar, unsigned x, unsigned& nloc, unsigned& nx) {
    const unsigned G = gridDim.x * gridDim.y * gridDim.z;
    unsigned sum, cnt, mine, sp = 0u;
    for (;;) {
        sum = 0u; cnt = 0u; mine = 0u;
#pragma unroll
        for (unsigned j = 0; j < 16; ++j) { const unsigned c = xb_ld(&bar[XB_XCNT(j)]); sum += c; cnt += (c > 0u) ? 1u : 0u; mine = (j == x) ? c : mine; }
        if (sum == G) break;
        __builtin_amdgcn_s_sleep(1);
        if ((++sp & 255u) == 0u) { if (xb_ld(&bar[XB_TMO])) break; if (sp > XB_SPIN_CAP) { atomicAdd(&bar[XB_TMO], 1u); break; } }
    }
    nloc = mine > 0u ? mine : 1u; nx = cnt > 0u ? cnt : 1u;
}
__device__ __forceinline__ void xcd_barrier(const XcdBarrier& b) {
    asm volatile("s_waitcnt vmcnt(0)" ::: "memory");
    __syncthreads();
    if (threadIdx.x == 0) {
        unsigned* bar = b.bar;
        __builtin_amdgcn_s_waitcnt(0);
        unsigned nloc = b.st[0], nx = b.st[1];
        if (nloc == 0u) { xcd_barrier_complete(bar, b.x, nloc, nx); b.st[0] = nloc; b.st[1] = nx; }
        const unsigned old = xb_add(&bar[XB_XSUB(b.x)], 1u);
        const unsigned gen = old / nloc;
        if (old + 1u == (gen + 1u) * nloc) {
            __builtin_amdgcn_fence(__ATOMIC_RELEASE, "agent");
            asm volatile("s_waitcnt vmcnt(0)" ::: "memory");
            const unsigned og = xb_add(&bar[XB_TOP], 1u);
            const unsigned tg = og / nx;
            if (og + 1u == (tg + 1u) * nx) xb_add(&bar[XB_TOPGEN], 1u);
            else XB_SPIN(xb_ld(&bar[XB_TOPGEN]) == tg, bar);
            __builtin_amdgcn_fence(__ATOMIC_ACQUIRE, "agent");
            xb_add(&bar[XB_XGEN(b.x)], 1u);
            asm volatile("s_waitcnt vmcnt(0)" ::: "memory");
        } else {
            XB_SPIN(xb_ld(&bar[XB_XGEN(b.x)]) == gen, bar);
            __builtin_amdgcn_fence(__ATOMIC_ACQUIRE, "agent");
            asm volatile("s_waitcnt vmcnt(0)" ::: "memory");
        }
    }
    __syncthreads();
}

__device__ __forceinline__ void tr_item(const float* W, int N, int k0, int n0, const float* gain, float cscale, bf16_t* dst  , int Kd, LAS float* scr, int lane) {
    f32x4 v[8]; float g[8];
#pragma unroll
    for (int i = 0; i < 8; ++i) { const int kk = 8 * i + (lane >> 3); v[i] = __builtin_nontemporal_load((const f32x4*)(W + (size_t)(k0 + kk) * N + n0 + 4 * (lane & 7))); g[i] = gain ? gain[k0 + kk] * cscale : cscale; }
#pragma unroll
    for (int i = 0; i < 8; ++i) { const int kk = 8 * i + (lane >> 3); LAS float* d = scr + kk * 33 + 4 * (lane & 7); d[0] = v[i][0] * g[i]; d[1] = v[i][1] * g[i]; d[2] = v[i][2] * g[i]; d[3] = v[i][3] * g[i]; }
    asm volatile("s_waitcnt lgkmcnt(0)" ::: "memory");
    const int c = lane & 7;
#pragma unroll
    for (int j = 0; j < 4; ++j) { const int n = (lane >> 3) + 8 * j; const LAS float* s = scr + (8 * c) * 33 + n;
        u32x4 o; o[0] = cvt_pk_bf16(s[0 * 33], s[1 * 33]); o[1] = cvt_pk_bf16(s[2 * 33], s[3 * 33]); o[2] = cvt_pk_bf16(s[4 * 33], s[5 * 33]); o[3] = cvt_pk_bf16(s[6 * 33], s[7 * 33]);
        *(u32x4*)(dst + (size_t)n * Kd + k0 + 8 * c) = o; }
    asm volatile("s_waitcnt lgkmcnt(0)" ::: "memory");
}
template <int NR>
__device__ __forceinline__ void cvt_rows(const float* x, bf16_t* o, float* ss, int row0, int stride, int nrows, int lane) {
    f32x4 v[NR][4]; float s[NR];
#pragma unroll
    for (int r = 0; r < NR; ++r) { const int row = row0 + r * stride; const f32x4* xr = (const f32x4*)(x + (size_t)(row < nrows ? row : row0) * D) + lane;
#pragma unroll
        for (int j = 0; j < 4; ++j) v[r][j] = __builtin_nontemporal_load(xr + 64 * j); }
#pragma unroll
    for (int r = 0; r < NR; ++r) { float a = 0.f;
#pragma unroll
        for (int j = 0; j < 4; ++j) a += (v[r][j][0] * v[r][j][0] + v[r][j][1] * v[r][j][1]) + (v[r][j][2] * v[r][j][2] + v[r][j][3] * v[r][j][3]);
        s[r] = a; }
#pragma unroll
    for (int of = 1; of < 64; of <<= 1)
#pragma unroll
        for (int r = 0; r < NR; ++r) s[r] += __shfl_xor(s[r], of);
#pragma unroll
    for (int r = 0; r < NR; ++r) { const int row = row0 + r * stride; if (row < nrows) { u32x2* o8 = (u32x2*)(o + (size_t)row * D) + lane;
#pragma unroll
            for (int j = 0; j < 4; ++j) { u32x2 w; w[0] = cvt_pk_bf16(v[r][j][0], v[r][j][1]); w[1] = cvt_pk_bf16(v[r][j][2], v[r][j][3]); o8[64 * j] = w; }
            if (lane < 16) ss[(size_t)row * 16 + lane] = lane == 0 ? s[r] : 0.f; } }
}

struct Args { const float* in[20]; float* out; unsigned char* ws; int ph_lo, ph_hi, flags, pad; };

#define MK_PTRS unsigned char* ws = args.ws; float* out = args.out; asm volatile("" : "+s"(ws), "+s"(out)); \
    const float* x_in = args.in[0]; const float* mem_in = args.in[1]; const float* rel_bias = args.in[7]; \
    bf16_t* Wgu1 = (bf16_t*)(ws + WS_WGU1); bf16_t* Wd1 = (bf16_t*)(ws + WS_WD1); bf16_t* Win = (bf16_t*)(ws + WS_WIN); bf16_t* Wout = (bf16_t*)(ws + WS_WOUT); \
    bf16_t* Wcqs = (bf16_t*)(ws + WS_WCQS); bf16_t* Wckv = (bf16_t*)(ws + WS_WCKV); bf16_t* Wco = (bf16_t*)(ws + WS_WCO); bf16_t* Wgu2 = (bf16_t*)(ws + WS_WGU2); bf16_t* Wd2 = (bf16_t*)(ws + WS_WD2); \
    bf16_t* MB = (bf16_t*)(ws + WS_MB); bf16_t* KVC = (bf16_t*)(ws + WS_KVC); bf16_t* WKT = (bf16_t*)(ws + WS_WKT); bf16_t* VWT = (bf16_t*)(ws + WS_VWT); \
    float* SS0 = (float*)(ws + WS_SS); float* SS1 = SS0 + (size_t)M * 16; float* SS2 = SS1 + (size_t)M * 16; float* SS3 = SS2 + (size_t)M * 16; float* SS4 = SS3 + (size_t)M * 16; \
    float* SSM = (float*)(ws + WS_SSM); float* KM = (float*)(ws + WS_KM); \
    bf16_t* HB = (bf16_t*)(ws + WS_R1); bf16_t* QKV = HB; bf16_t* YN = HB; bf16_t* PB = HB; \
    bf16_t* XB = (bf16_t*)(ws + WS_XB); bf16_t* OA0 = (bf16_t*)out; bf16_t* OA1 = (bf16_t*)((char*)out + OUT_OA1); bf16_t* OA2 = (bf16_t*)(ws + WS_OA2); bf16_t* OB = (bf16_t*)((char*)out + OUT_OB); float* ML = (float*)((char*)out + OUT_ML);
__global__ void __launch_bounds__(NWAVES * 64, 2) mk_fwd(Args args) {
    extern __shared__ __attribute__((aligned(16))) unsigned char lds_raw[];
    LAS unsigned char* lds = (LAS unsigned char*)lds_raw;
    const int tid = threadIdx.x, lane = tid & 63, wave = __builtin_amdgcn_readfirstlane(tid >> 6);
    const int G = gridDim.x, bx = blockIdx.x;
    const int vcu = (G % 8 == 0) ? (bx % 8) * (G / 8) + bx / 8 : bx;
    const int gw = vcu * NWAVES + wave, NGW = G * NWAVES;
    unsigned char* const ws0 = args.ws;
    volatile LAS unsigned* MISC = (volatile LAS unsigned*)(lds + LDS_MISC);
    if (tid < 32) MISC[tid] = 0u;
    __syncthreads();
    const int lo = args.ph_lo, hi = args.ph_hi;
    const bool use_bar = (hi - lo) > 1;
    XcdBarrier bar; bar.bar = (unsigned*)(ws0 + WS_CTL) + CW_BAR; bar.x = 0; bar.st = nullptr;
    if (use_bar) bar = xcd_barrier_post((unsigned*)(ws0 + WS_CTL) + CW_BAR, MISC + 8);
#define IN(k) (lo <= (k) && (k) < hi)
#define STAGGER() do { if (MK_STAGGER_TICKS > 0) { const unsigned long long t0_ = __builtin_amdgcn_s_memrealtime(), dl_ = (unsigned long long)((bx >> 3) & 3) * MK_STAGGER_TICKS; while (__builtin_amdgcn_s_memrealtime() - t0_ < dl_) __builtin_amdgcn_s_sleep(8); } } while (0)
#define SEAM(k) do { if (IN(k) && IN((k) + 1)) xcd_barrier(bar); } while (0)

    if (IN(0)) {
        MK_PTRS;
        LAS float* scr = (LAS float*)(lds + wave * 16384);
        constexpr int I_GU = (D / 64) * (2 * DFF / 32), I_DN = (DFF / 64) * (D / 32), I_IN = (D / 64) * (NQKV / 32), I_SQ = (D / 64) * (D / 32), I_KV = (D / 64) * (2 * D / 32);
        constexpr int NITEMS = 2 * I_GU + 2 * I_DN + I_IN + 2 * I_SQ + I_KV;
        for (int it = gw; it < NITEMS; it += NGW) {
            int r = it;
            if (r < 2 * I_GU) {
                const bool second = r >= I_GU; if (second) r -= I_GU;
                const int nblk = 2 * DFF / 32, kb = r / nblk, nb = r % nblk, n0 = nb * 32;
                const int drow = n0 < DFF ? (n0 / 128) * 256 + (n0 % 128) : ((n0 - DFF) / 128) * 256 + 128 + ((n0 - DFF) % 128);
                tr_item(args.in[second ? 17 : 3], 2 * DFF, kb * 64, n0, args.in[second ? 16 : 2], 1.0f, (second ? Wgu2 : Wgu1) + (size_t)drow * D, D, scr, lane); continue; }
            r -= 2 * I_GU;
            if (r < 2 * I_DN) { const bool second = r >= I_DN; if (second) r -= I_DN; const int nblk = D / 32, kb = r / nblk, nb = r % nblk;
                tr_item(args.in[second ? 18 : 4], D, kb * 64, nb * 32, nullptr, 1.0f, (second ? Wd2 : Wd1) + (size_t)(nb * 32) * DFF, DFF, scr, lane); continue; }
            r -= 2 * I_DN;
            if (r < I_IN) { const int nblk = NQKV / 32, kb = r / nblk, nb = r % nblk, n0 = nb * 32; const bool isq = (n0 < 768) || (n0 >= 2304 && n0 < 2560);
                tr_item(args.in[6], NQKV, kb * 64, n0, args.in[5], isq ? 0.125f : 1.0f, Win + (size_t)n0 * D, D, scr, lane); continue; }
            r -= I_IN;
            if (r < I_SQ) { const int nblk = D / 32, kb = r / nblk, nb = r % nblk, k0 = kb * 64; const float* gp = k0 < 768 ? args.in[8] : args.in[9] - 768;
                tr_item(args.in[10], D, k0, nb * 32, gp, 1.0f, Wout + (size_t)(nb * 32) * D, D, scr, lane); continue; }
            r -= I_SQ;
            if (r < I_SQ) { const int nblk = D / 32, kb = r / nblk, nb = r % nblk; tr_item(args.in[15], D, kb * 64, nb * 32, nullptr, 1.0f, Wco + (size_t)(nb * 32) * D, D, scr, lane); continue; }
            r -= I_SQ;
            { const int nblk = 2 * D / 32, kb = r / nblk, nb = r % nblk; tr_item(args.in[14], 2 * D, kb * 64, nb * 32, args.in[12], 1.0f, Wckv + (size_t)(nb * 32) * D, D, scr, lane); }
        }
        for (int c = gw; c < D; c += NGW) { const float g = args.in[11][c] * 0.0625f; const f32x4* src = (const f32x4*)(args.in[13] + (size_t)c * D) + lane; u32x2* dst = (u32x2*)(Wcqs + (size_t)c * D) + lane;
#pragma unroll
            for (int j = 0; j < 4; ++j) { const f32x4 v = src[64 * j] * g; u32x2 w; w[0] = cvt_pk_bf16(v[0], v[1]); w[1] = cvt_pk_bf16(v[2], v[3]); dst[64 * j] = w; } }
        for (int m = gw; m < M; m += 4 * NGW) cvt_rows<4>(x_in, XB, SS0, m, NGW, M, lane);
        for (int m = gw; m < MM; m += NGW) cvt_rows<1>(mem_in, MB, SSM, m, NGW, MM, lane);
        for (int i = gw * 64 + lane; i < NBAT * 16 * 256; i += NGW * 64) KM[i] = 0.f;
    }
    SEAM(0);

    if (IN(1)) {
        MK_PTRS;
        STAGGER();
        { SchedStd S; S.o.init(M, 2 * DFF, G, bx); S.A = (const char*)XB; S.B = (const char*)Wgu1; S.a_tile = (size_t)256 * D * 2; S.b_tile = (size_t)256 * D * 2; S.b_batch = 0; S.ocol_mul = 128;
          EpiGU E{HB, SS0}; pg8::gemm_phase<EpiGU, SchedStd, true>(lds, D, D, D / 64, S, E); }
        { SchedStd S; S.o.init(MM, 2 * D, G, (bx + G / 2) % G); S.A = (const char*)MB; S.B = (const char*)Wckv; S.a_tile = (size_t)256 * D * 2; S.b_tile = (size_t)256 * D * 2; S.b_batch = 0; S.ocol_mul = 256;
          EpiStore E{KVC, 2 * D, SSM, nullptr, false}; pg8::gemm_phase<EpiStore, SchedStd, true>(lds, D, D, D / 64, S, E); }
    }
    SEAM(1);

    if (IN(2)) {
        MK_PTRS;
        SchedStd S; S.o.init(M, D, G, bx); S.A = (const char*)HB; S.B = (const char*)Wd1; S.a_tile = (size_t)256 * DFF * 2; S.b_tile = (size_t)256 * DFF * 2; S.b_batch = 0; S.ocol_mul = 256;
        EpiRes E{XB, SS1, 0.5f}; pg8::gemm_phase<EpiRes, SchedStd, true>(lds, DFF, DFF, DFF / 64, S, E);
    }
    SEAM(2);

    if (IN(3)) {
        MK_PTRS;
        { SchedStd S; S.o.init(M, NQKV, G, bx); S.A = (const char*)XB; S.B = (const char*)Win; S.a_tile = (size_t)256 * D * 2; S.b_tile = (size_t)256 * D * 2; S.b_batch = 0; S.ocol_mul = 256;
          EpiStore E{QKV, 0, SS1, KM, false}; pg8::gemm_phase<EpiStore, SchedStd, true>(lds, D, D, D / 64, S, E); }
        { SchedWK S{G, bx, (const char*)KVC, (const char*)Wcqs}; EpiStore E{WKT, D, nullptr, nullptr, false}; pg8::gemm_phase<EpiStore, SchedWK, true>(lds, 2 * D, D, 4, S, E); }
        { SchedVW S{G, (bx + G / 2) % G, (const char*)KVC, (const char*)Wco}; EpiStore E{VWT, D, nullptr, nullptr, false}; pg8::gemm_phase<EpiStore, SchedVW, true>(lds, D, 2 * D, 4, S, E); }
    }
    SEAM(3);

    if (IN(4)) {
        MK_PTRS;
        LAS float* tab = (LAS float*)(lds + LDS_TAB);
        const int h2 = lane >> 5, q = lane & 31;
        const long rowb = 128;
        constexpr long HSTR = (long)SEQ * 128;
#define ATT_WAITV(n) asm volatile("s_waitcnt vmcnt(" #n ")" ::: "memory")
#define ATT_BAR() do { asm volatile("s_waitcnt lgkmcnt(0)" ::: "memory"); __builtin_amdgcn_s_barrier(); asm volatile("" ::: "memory"); } while (0)
        for (int i = tid; i < 4 * att::TABB_N; i += NWAVES * 64) { const int hb = i / att::TABB_N, e = i % att::TABB_N, dist = e - 32;
            tab[i] = dist >= 0 ? rel_bias[att::rel_bucket(dist) * 16 + 12 + hb] * LOG2E : -INFINITY; }
        __syncthreads();
        constexpr int NMOBA = NBAT * 4 * 16;
        for (int j = vcu; j < NMOBA / 2; j += G)
#pragma unroll 1
            for (int half = 0; half < 2; ++half) {
                const int bh = j >> 3, s8 = j & 7; const int qb = half ? s8 : 15 - s8, b = bh >> 2, hb = bh & 3;
                const int q0 = qb * 256 + wave * 32;
                const char* base = (const char*)QKV + (size_t)b * 48 * HSTR;
                const char* qbase = base + (36 + hb) * HSTR + (size_t)q0 * rowb;
                const char* kbase = base + (40 + hb) * HSTR;
                att::bf16x8 qf[4];
#pragma unroll
                for (int d0 = 0; d0 < 4; ++d0) qf[d0] = *(const att::bf16x8*)(qbase + (long)q * rowb + (16 * d0 + 8 * h2) * 2);
                const unsigned sel = att::moba_select(qbase, rowb, KM + (size_t)b * 16 * 256 + hb * 64, qb);
                const LAS float* tb = tab + hb * att::TABB_N;
                const int NT = 4 * (qb + 1);
                const int drow = wave * 8 + (lane >> 3);
                const char* ksrc = kbase + (long)drow * rowb;
                ATT_WAITV(0);
                constexpr int NS = 6;
                int st_t = 0;
#pragma unroll
                for (int k = 0; k < NS - 1; ++k) if (k < NT)
                    att::dma_rows8(ksrc + (long)(NT - 1 - k) * 64 * rowb, (int)(4 * HSTR), drow, (LAS char*)(lds + k * 16384 + wave * 1024), (LAS char*)(lds + k * 16384 + 8192 + wave * 1024), lane);
                att::f32x16 o[2]; o[0] = att::f32x16{}; o[1] = att::f32x16{}; float mo = -1e30f, lo_ = 0.f;
#pragma unroll 1
                for (int t = NT - 1; t >= 0; --t) {
                    if (t >= 4) ATT_WAITV(8); else if (t == 3) ATT_WAITV(6); else if (t == 2) ATT_WAITV(4); else if (t == 1) ATT_WAITV(2); else ATT_WAITV(0);
                    ATT_BAR();
                    if (t >= NS - 1) { const int s2 = st_t == 0 ? NS - 1 : st_t - 1;
                        att::dma_rows8(ksrc + (long)(t - (NS - 1)) * 64 * rowb, (int)(4 * HSTR), drow, (LAS char*)(lds + s2 * 16384 + wave * 1024), (LAS char*)(lds + s2 * 16384 + 8192 + wave * 1024), lane); }
                    const LAS char* kt = (const LAS char*)(lds + st_t * 16384);
#pragma unroll
                    for (int gg = 1; gg >= 0; --gg) {
                        const int g0 = 64 * t + 32 * gg;
                        if (g0 <= q0) {
                            int B = (q0 - g0 + 32) + q - 4 * h2; B = B < (att::TABB_N - 1) ? B : (att::TABB_N - 1);
                            const int n = g0 >> 8; const bool sl = (n == qb) || ((sel >> n) & 1u); B = sl ? B : 27;
                            att::attn_group(qf, o, mo, lo_, kt + gg * 4096, kt + 8192 + gg * 4096, tb + B, lane);
                        }
                    }
                    st_t = st_t == NS - 1 ? 0 : st_t + 1;
                }
                ATT_BAR();
                lo_ += __shfl_xor(lo_, 32);
                att::store_o<MK_NT_PART>(o, lo_, (char*)OB + ((size_t)(b * SEQ + q0 + q) * 256 + hb * 64) * 2, h2);
            }
        __syncthreads();
        for (int i = tid; i < 36 * att::TABA_N; i += NWAVES * 64) { const int t = i / att::TABA_N, e = i % att::TABA_N, p = t / 12, h = t % 12, delta = e - 32, d = p == 0 ? 1 : (p == 1 ? 4 : 16);
            tab[i] = (delta >= 0 && delta <= 128) ? rel_bias[att::rel_bucket(delta * d) * 16 + h] * LOG2E : -INFINITY; }
        __syncthreads();
        constexpr int NDIL = NBAT * 12 * 48;
        struct DilItem { int b, h, p, d, res, m0, mbase; };
        auto decode = [&](int it, DilItem& I) { const int bh = it / 48, j = it % 48; I.b = bh / 12; I.h = bh % 12; I.p = j >> 4; const int jj = j & 15;
            I.d = I.p == 0 ? 1 : (I.p == 1 ? 4 : 16); I.res = I.p == 0 ? 0 : (I.p == 1 ? (jj & 3) : jj); const int mblk = I.p == 0 ? jj : (I.p == 1 ? (jj >> 2) : 0);
            I.mbase = mblk * 256 - 128; I.m0 = mblk * 256 + wave * 32; };
        att::bf16x8 qf[4];
        auto issue = [&](const DilItem& I) {
            const char* base = (const char*)QKV + ((size_t)I.b * 48 + I.h) * HSTR + (size_t)I.res * rowb; const long st = (long)I.d * rowb; const char* kbase = base + 12 * HSTR;
#pragma unroll 1
            for (int k = wave; k < 48; k += NWAVES) {
                if (I.mbase + 8 * k < 0) continue;
                const int row = 8 * k + (lane >> 3);
                att::dma_rows8(kbase + (long)(I.mbase + row) * st, (int)(12 * HSTR), row, (LAS char*)(lds + k * 1024), (LAS char*)(lds + 49152 + k * 1024), lane);
            }
            const char* qbase = base + (long)I.m0 * st;
#pragma unroll
            for (int d0 = 0; d0 < 4; ++d0) qf[d0] = *(const att::bf16x8*)(qbase + (long)q * st + (16 * d0 + 8 * h2) * 2);
        };
        DilItem cur; int it = vcu;
        if (it < NDIL) { decode(it, cur); ATT_WAITV(0); issue(cur); }
#pragma unroll 1
        for (; it < NDIL; it += G) {
            ATT_WAITV(0); ATT_BAR();
            att::f32x16 o[2]; o[0] = att::f32x16{}; o[1] = att::f32x16{}; float mo = -1e30f, lo_ = 0.f;
            const LAS float* ta = tab + (cur.p * 12 + cur.h) * att::TABA_N;
            const int m0 = cur.m0, gend = (m0 - 128) > 0 ? (m0 - 128) : 0;
            { att::bf16x8 qc[4] = {qf[0], qf[1], qf[2], qf[3]};
#pragma unroll 1
            for (int g0 = m0; g0 >= gend; g0 -= 32) {
                const int B = (m0 - g0 + 32) + q - 4 * h2;
                const LAS char* kg = (const LAS char*)(lds + (g0 - cur.mbase) * 128);
                att::attn_group(qc, o, mo, lo_, kg, kg + 49152, ta + B, lane);
            } }
            ATT_BAR();
            const DilItem done = cur;
            if (it + G < NDIL) { decode(it + G, cur); issue(cur); }
            lo_ += __shfl_xor(lo_, 32);
            const size_t tok = (size_t)done.b * SEQ + (size_t)(m0 + q) * done.d + done.res;
            att::store_o<MK_NT_PART>(o, lo_, (char*)(done.p == 0 ? OA0 : (done.p == 1 ? OA1 : OA2)) + (tok * 768 + done.h * 64) * 2, h2);
            if (h2 == 0) *(f32x2*)(ML + (((size_t)done.p * M + tok) * 12 + done.h) * 2) = (f32x2){mo, lo_};
        }
#undef ATT_WAITV
#undef ATT_BAR
    }
    SEAM(4);

    if (IN(5)) {
        MK_PTRS;
        for (int row0 = gw; row0 < M; row0 += 2 * NGW) {
            f32x2 ml[2][3][3]; u32x2 oa[2][3][3]; u32x2 ob[2];
#pragma unroll
            for (int r = 0; r < 2; ++r) { const int row = (row0 + r * NGW) < M ? (row0 + r * NGW) : row0;
#pragma unroll
                for (int k = 0; k < 3; ++k) { const int col = 256 * k + 4 * lane, hd = col >> 6;
#pragma unroll
                    for (int p = 0; p < 3; ++p) ml[r][k][p] = __builtin_nontemporal_load((const f32x2*)(ML + (((size_t)p * M + row) * 12 + hd) * 2));
                    oa[r][k][0] = __builtin_nontemporal_load((const u32x2*)(OA0 + (size_t)row * 768 + col)); oa[r][k][1] = __builtin_nontemporal_load((const u32x2*)(OA1 + (size_t)row * 768 + col)); oa[r][k][2] = __builtin_nontemporal_load((const u32x2*)(OA2 + (size_t)row * 768 + col)); }
                ob[r] = __builtin_nontemporal_load((const u32x2*)(OB + (size_t)row * 256 + 4 * lane)); }
            float va[2][3][4], vb[2][4], ssa[2], ssb[2];
#pragma unroll
            for (int r = 0; r < 2; ++r) { ssa[r] = 0.f; ssb[r] = 0.f;
#pragma unroll
                for (int k = 0; k < 3; ++k) {
                    const float Mx = fmaxf(ml[r][k][0][0], fmaxf(ml[r][k][1][0], ml[r][k][2][0]));
                    const float w0 = ml[r][k][0][1] * __builtin_amdgcn_exp2f(ml[r][k][0][0] - Mx), w1 = ml[r][k][1][1] * __builtin_amdgcn_exp2f(ml[r][k][1][0] - Mx), w2 = ml[r][k][2][1] * __builtin_amdgcn_exp2f(ml[r][k][2][0] - Mx);
                    const float iw = 1.0f / (w0 + w1 + w2);
#pragma unroll
                    for (int e = 0; e < 4; ++e) { const unsigned s0 = oa[r][k][0][e >> 1], s1 = oa[r][k][1][e >> 1], s2 = oa[r][k][2][e >> 1];
                        const float f0 = __builtin_bit_cast(float, (e & 1) ? (s0 & 0xffff0000u) : (s0 << 16)), f1 = __builtin_bit_cast(float, (e & 1) ? (s1 & 0xffff0000u) : (s1 << 16)), f2 = __builtin_bit_cast(float, (e & 1) ? (s2 & 0xffff0000u) : (s2 << 16));
                        const float v = (w0 * f0 + w1 * f1 + w2 * f2) * iw; va[r][k][e] = v; ssa[r] += v * v; } }
#pragma unroll
                for (int e = 0; e < 4; ++e) { const unsigned s0 = ob[r][e >> 1]; vb[r][e] = __builtin_bit_cast(float, (e & 1) ? (s0 & 0xffff0000u) : (s0 << 16)); ssb[r] += vb[r][e] * vb[r][e]; } }
#pragma unroll
            for (int of = 1; of < 64; of <<= 1)
#pragma unroll
                for (int r = 0; r < 2; ++r) { ssa[r] += __shfl_xor(ssa[r], of); ssb[r] += __shfl_xor(ssb[r], of); }
#pragma unroll
            for (int r = 0; r < 2; ++r) { const int row = row0 + r * NGW; if (row < M) {
                const float ra = __builtin_amdgcn_rsqf(ssa[r] * (1.0f / 768.0f) + EPS), rb = __builtin_amdgcn_rsqf(ssb[r] * (1.0f / 256.0f) + EPS);
#pragma unroll
                for (int k = 0; k < 3; ++k) { u32x2 w; w[0] = cvt_pk_bf16(va[r][k][0] * ra, va[r][k][1] * ra); w[1] = cvt_pk_bf16(va[r][k][2] * ra, va[r][k][3] * ra); *(u32x2*)(YN + (size_t)row * D + 256 * k + 4 * lane) = w; }
                { u32x2 w; w[0] = cvt_pk_bf16(vb[r][0] * rb, vb[r][1] * rb); w[1] = cvt_pk_bf16(vb[r][2] * rb, vb[r][3] * rb); *(u32x2*)(YN + (size_t)row * D + 768 + 4 * lane) = w; } } }
        }
    }
    SEAM(5);

    if (IN(6)) {
        MK_PTRS;
        SchedStd S; S.o.init(M, D, G, bx); S.A = (const char*)YN; S.B = (const char*)Wout; S.a_tile = (size_t)256 * D * 2; S.b_tile = (size_t)256 * D * 2; S.b_batch = 0; S.ocol_mul = 256;
        EpiRes E{XB, SS2, 1.0f}; pg8::gemm_phase<EpiRes, SchedStd, true>(lds, D, D, D / 64, S, E);
    }
    SEAM(6);

    if (IN(7)) {
        MK_PTRS;
        SchedStd S; S.o.init(M, D, G, bx); S.A = (const char*)XB; S.B = (const char*)WKT; S.a_tile = (size_t)256 * D * 2; S.b_tile = (size_t)256 * D * 2; S.b_batch = (size_t)D * D * 2; S.ocol_mul = 256;
        EpiSoftmax E{PB, SS2}; pg8::gemm_phase<EpiSoftmax, SchedStd, true>(lds, D, D, D / 64, S, E);
    }
    SEAM(7);

    if (IN(8)) {
        MK_PTRS;
        SchedStd S; S.o.init(M, D, G, bx); S.A = (const char*)PB; S.B = (const char*)VWT; S.a_tile = (size_t)256 * D * 2; S.b_tile = (size_t)256 * D * 2; S.b_batch = (size_t)D * D * 2; S.ocol_mul = 256;
        EpiRes E{XB, SS3, 1.0f}; pg8::gemm_phase<EpiRes, SchedStd, true>(lds, D, D, D / 64, S, E);
    }
    SEAM(8);

    if (IN(9)) {
        MK_PTRS;
        STAGGER();
        SchedStd S; S.o.init(M, 2 * DFF, G, bx); S.A = (const char*)XB; S.B = (const char*)Wgu2; S.a_tile = (size_t)256 * D * 2; S.b_tile = (size_t)256 * D * 2; S.b_batch = 0; S.ocol_mul = 128;
        EpiGU E{HB, SS3}; pg8::gemm_phase<EpiGU, SchedStd, true>(lds, D, D, D / 64, S, E);
    }
    SEAM(9);

    if (IN(10)) {
        MK_PTRS;
        SchedStd S; S.o.init(M, D, G, bx); S.A = (const char*)HB; S.B = (const char*)Wd2; S.a_tile = (size_t)256 * DFF * 2; S.b_tile = (size_t)256 * DFF * 2; S.b_batch = 0; S.ocol_mul = 256;
        EpiRes E{XB, SS4, 0.5f}; pg8::gemm_phase<EpiRes, SchedStd, true>(lds, DFF, DFF, DFF / 64, S, E);
    }
    SEAM(10);

    if (IN(11)) {
        MK_PTRS;
        const float* gf = args.in[19];
        for (int row0 = gw; row0 < M; row0 += 4 * NGW) {
            u32x2 w[4][4]; float rs[4]; const f32x4* gr = (const f32x4*)gf + lane;
#pragma unroll
            for (int r = 0; r < 4; ++r) { const int row = (row0 + r * NGW) < M ? (row0 + r * NGW) : row0; const u32x2* xr = (const u32x2*)(XB + (size_t)row * D) + lane;
#pragma unroll
                for (int j = 0; j < 4; ++j) w[r][j] = __builtin_nontemporal_load(xr + 64 * j);
                rs[r] = row_rstd(SS4, row); }
#pragma unroll
            for (int r = 0; r < 4; ++r) { const int row = row0 + r * NGW; if (row < M) { f32x4* orow = (f32x4*)(out + (size_t)row * D) + lane;
#pragma unroll
                for (int j = 0; j < 4; ++j) { f32x4 v; v[0] = __builtin_bit_cast(float, w[r][j][0] << 16); v[1] = __builtin_bit_cast(float, w[r][j][0] & 0xffff0000u); v[2] = __builtin_bit_cast(float, w[r][j][1] << 16); v[3] = __builtin_bit_cast(float, w[r][j][1] & 0xffff0000u);
                    __builtin_nontemporal_store(v * rs[r] * gr[64 * j], orow + 64 * j); } } }
        }
    }
#undef IN
#undef SEAM
}
}


#if MK_DEBUG
namespace dbg {
__global__ void __launch_bounds__(256) cmp_f32(const float* a, const float* r, size_t n, float* acc) {
    float num = 0.f, den = 0.f;
    for (size_t i = (size_t)blockIdx.x * 256 + threadIdx.x; i < n; i += (size_t)gridDim.x * 256) { const float d = a[i] - r[i]; num += d * d; den += r[i] * r[i]; }
    for (int o = 32; o > 0; o >>= 1) { num += __shfl_xor(num, o); den += __shfl_xor(den, o); }
    if ((threadIdx.x & 63) == 0) { atomicAdd(acc, num); atomicAdd(acc + 1, den); }
}
__global__ void __launch_bounds__(256) cmp_bf16(const unsigned short* a, int lda, const float* colscale, const float* r, int ldr, int rows, int cols, float* acc) {
    float num = 0.f, den = 0.f; const size_t n = (size_t)rows * cols;
    for (size_t i = (size_t)blockIdx.x * 256 + threadIdx.x; i < n; i += (size_t)gridDim.x * 256) { const size_t row = i / cols; const int c = (int)(i % cols);
        const float av = __builtin_bit_cast(float, (unsigned)a[row * lda + c] << 16) * (colscale ? colscale[c] : 1.0f); const float rv = r[row * ldr + c]; const float d = av - rv; num += d * d; den += rv * rv; }
    for (int o = 32; o > 0; o >>= 1) { num += __shfl_xor(num, o); den += __shfl_xor(den, o); }
    if ((threadIdx.x & 63) == 0) { atomicAdd(acc, num); atomicAdd(acc + 1, den); }
}
__global__ void __launch_bounds__(256) cmp_p(const unsigned short* a, const float* r, float* acc) {
    float num = 0.f, den = 0.f; const size_t n = (size_t)4096 * 1024;
    for (size_t i = (size_t)blockIdx.x * 256 + threadIdx.x; i < n; i += (size_t)gridDim.x * 256) { const size_t row = i / 1024; const int c = (int)(i % 1024);
        const float av = __builtin_bit_cast(float, (unsigned)a[i] << 16); const float rv = r[(size_t)(c >> 8) * 4096 * 256 + row * 256 + (c & 255)]; const float d = av - rv; num += d * d; den += rv * rv; }
    for (int o = 32; o > 0; o >>= 1) { num += __shfl_xor(num, o); den += __shfl_xor(den, o); }
    if ((threadIdx.x & 63) == 0) { atomicAdd(acc, num); atomicAdd(acc + 1, den); }
}
__global__ void build_scales(float* qkvs, float* gcat, const float* goa, const float* gob) {
    const int i = blockIdx.x * 256 + threadIdx.x;
    if (i < 3072) qkvs[i] = ((i < 768) || (i >= 2304 && i < 2560)) ? 8.0f : 1.0f;
    if (i < 1024) gcat[i] = i < 768 ? goa[i] : gob[i - 768];
}
constexpr int NST = 8;
__global__ void __launch_bounds__(256) finalize(float* out, size_t n, const float* acc, int report) {
    const float tol[NST] = {0.03f, 0.03f, 1e9f  , 0.08f, 0.03f, 0.05f, 0.03f, 0.03f};
    float E = 0.f;
    if (report > 0) { const float e = sqrtf(acc[2 * (report - 1)] / acc[2 * (report - 1) + 1]); E = (e == e) ? fminf(e, 3.0f) : 3.0f; }
    else { for (int k = NST - 1; k >= 0; --k) { const float e = sqrtf(acc[2 * k] / acc[2 * k + 1]); if (!(e <= tol[k])) E = 0.1f * (k + 1); } }
    for (size_t i = (size_t)blockIdx.x * 256 + threadIdx.x; i < n; i += (size_t)gridDim.x * 256) out[i] *= (1.0f + E);
}
}
#endif

static void mk_launch(const mk::Args& a0, int lo, int hi, int grid, hipStream_t st) {
    mk::Args a = a0; a.ph_lo = lo; a.ph_hi = hi;
    hipLaunchKernelGGL(mk::mk_fwd, dim3(grid), dim3(mk::NWAVES * 64), mk::LDS_BYTES, st, a);
    const hipError_t le = hipPeekAtLastError();
    if (le != hipSuccess) fprintf(stderr, "kernel_launch: launch of phases [%d,%d) failed: %s\n", lo, hi, hipGetErrorName(le));
}

extern "C" void kernel_launch(void* const* d_in, const int* in_sizes, int n_in, void* d_out, int out_size, void* d_ws, size_t ws_size, hipStream_t stream) {
    static int grid = 0;
    if (grid == 0) {
        if (n_in != 20 || out_size != 8 * 4096 * 1024) { fprintf(stderr, "kernel_launch: unexpected shapes (n_in %d out %d)\n", n_in, out_size); grid = -1; return; }
        int dev = 0, cus = 0, per_cu = 0;
        if (hipGetDevice(&dev) != hipSuccess || hipDeviceGetAttribute(&cus, hipDeviceAttributeMultiprocessorCount, dev) != hipSuccess) { grid = -1; return; }
        if (hipFuncSetAttribute((const void*)mk::mk_fwd, hipFuncAttributeMaxDynamicSharedMemorySize, mk::LDS_BYTES) != hipSuccess) { fprintf(stderr, "kernel_launch: hipFuncSetAttribute failed\n"); grid = -1; return; }
        if (hipOccupancyMaxActiveBlocksPerMultiprocessor(&per_cu, (const void*)mk::mk_fwd, mk::NWAVES * 64, mk::LDS_BYTES) != hipSuccess || per_cu < 1) fprintf(stderr, "kernel_launch: occupancy query reports %d workgroups per CU\n", per_cu);
        (void)hipGetLastError();
        grid = cus;
    }
    if (grid < 0) return;
    unsigned char* ws = (unsigned char*)d_ws;
#if MK_DEBUG
    const size_t ref_off = (mk::WS_END + 4095) / 4096 * 4096;
    size_t off = ref_off + (size_t)290 * 1024 * 1024;
    auto take = [&](size_t bytes) { unsigned char* p = ws + off; off += (bytes + 255) / 256 * 256; return p; };
    float* sx1 = (float*)take((size_t)4096 * 1024 * 4); float* sx2 = (float*)take((size_t)4096 * 1024 * 4); float* sx3 = (float*)take((size_t)4096 * 1024 * 4);
    float* mkout = (float*)take((size_t)4096 * 1024 * 4); float* qkvs = (float*)take(3072 * 4); float* gcat = (float*)take(1024 * 4); float* acc = (float*)take(256);
    if (off > ws_size) { fprintf(stderr, "kernel_launch: debug build needs %zu bytes of workspace, got %zu\n", off, ws_size); return; }
    ref::Snap snap{sx1, sx2, sx3};
    ref::forward(d_in, (float*)d_out, ws + ref_off, stream, &snap);
    (void)hipMemsetAsync(ws + mk::WS_CTL, 0, mk::CTL_BYTES, stream);
    (void)hipMemsetAsync(acc, 0, 256, stream);
    dbg::build_scales<<<12, 256, 0, stream>>>(qkvs, gcat, (const float*)d_in[8], (const float*)d_in[9]);
    mk::Args a{};
    for (int i = 0; i < 20; ++i) a.in[i] = (const float*)d_in[i];
    a.in[0] = (const float*)d_in[0] + (size_t)7 * 4096 * 1024; a.in[1] = (const float*)d_in[1] + (size_t)7 * 256 * 1024;
    a.out = mkout; a.ws = ws;
    const ref::Bufs& rb = ref::g_bufs;
    for (int ph = 0; ph < mk::NPH; ++ph) {
        mk_launch(a, ph, ph + 1, grid, stream);
        if (ph == 1) dbg::cmp_bf16<<<512, 256, 0, stream>>>((const unsigned short*)(ws + mk::WS_KVC), 2048, nullptr, rb.kvc, 2048, 256, 2048, acc + 0);
        if (ph == 2) dbg::cmp_bf16<<<512, 256, 0, stream>>>((const unsigned short*)(ws + mk::WS_XB), 1024, nullptr, sx1, 1024, 4096, 1024, acc + 2);
        if (ph == 3) dbg::cmp_bf16<<<512, 256, 0, stream>>>((const unsigned short*)(ws + mk::WS_R1), 3072, qkvs, rb.proj, 3072, 4096, 3072, acc + 4);
        if (ph == 5) dbg::cmp_bf16<<<512, 256, 0, stream>>>((const unsigned short*)(ws + mk::WS_R1), 1024, gcat, rb.yn, 1024, 4096, 1024, acc + 6);
        if (ph == 6) dbg::cmp_bf16<<<512, 256, 0, stream>>>((const unsigned short*)(ws + mk::WS_XB), 1024, nullptr, sx2, 1024, 4096, 1024, acc + 8);
        if (ph == 7) dbg::cmp_p<<<512, 256, 0, stream>>>((const unsigned short*)(ws + mk::WS_R1), rb.sc, acc + 10);
        if (ph == 8) dbg::cmp_bf16<<<512, 256, 0, stream>>>((const unsigned short*)(ws + mk::WS_XB), 1024, nullptr, sx3, 1024, 4096, 1024, acc + 12);
        if (ph == 11) dbg::cmp_f32<<<512, 256, 0, stream>>>(mkout, (const float*)d_out + (size_t)7 * 4096 * 1024, (size_t)4096 * 1024, acc + 14);
    }
    dbg::finalize<<<1024, 256, 0, stream>>>((float*)d_out, (size_t)8 * 4096 * 1024, acc, MK_REPORT);
#else
    if (ws_size < mk::WS_END) { fprintf(stderr, "kernel_launch: needs %zu bytes of workspace, got %zu\n", (size_t)mk::WS_END, ws_size); return; }
    if (hipMemsetAsync(ws + mk::WS_CTL, 0, mk::CTL_BYTES, stream) != hipSuccess) return;
    mk::Args a{};
    for (int i = 0; i < 20; ++i) a.in[i] = (const float*)d_in[i];
    a.out = (float*)d_out; a.ws = ws;
#if MK_N_LAUNCHES == 1
    mk_launch(a, 0, mk::NPH, grid, stream);
#else
    for (int ph = 0; ph < mk::NPH; ++ph) {
        for (int r = 0; r < MK_REPEAT_N; ++r) if (ph == MK_REPEAT) { mk::Args a2 = a; a2.flags = MK_REPEAT_FLAGS; mk_launch(a2, ph, ph + 1, grid, stream); }
        mk_launch(a, ph, ph + 1, grid, stream); }
#endif
#endif
}
```

```cpp
#include <hip/hip_runtime.h>
#include <cstdio>
#include <cstdint>
#include <cmath>
#define MK_REPEAT -1
#define MK_REPEAT_N 1
#define MK_REPEAT_FLAGS 0
#define MK_STAGGER_TICKS 0
#define MK_NT_PART false
#define MK_DEBUG 0
#define MK_REPORT 0
#define MK_N_LAUNCHES 1
#define MK_NBAT 8

namespace pg8 {
#define PG8_LAS __attribute__((address_space(3)))
typedef unsigned short bf16_t;
typedef short bf16x8 __attribute__((ext_vector_type(8)));
typedef float f32x4 __attribute__((ext_vector_type(4)));
typedef float f32x2 __attribute__((ext_vector_type(2)));
typedef unsigned u32x4 __attribute__((ext_vector_type(4)));
typedef unsigned u32x2 __attribute__((ext_vector_type(2)));
constexpr int BM = 256, BK = 64, HALF = 128, HTB = HALF * BK * 2  , STAGE_BYTES = 8 * HTB, NXCD = 8, WGM = 8;

__host__ __device__ __forceinline__ int lds_byte(int r, int c) { const int st = (r >> 4) * 2 + (c >> 5), rr = r & 15, cc = c & 31, ob = rr * 64 + cc * 2; return st * 1024 + (ob ^ (((ob >> 9) & 1) << 5)); }
__host__ __device__ __forceinline__ void stage_rc(int b, int& R, int& C) { const int st = b / 1024, sb = b % 1024, swz = sb ^ (((sb >> 9) & 1) << 5); R = (st >> 1) * 16 + swz / 64; C = (st & 1) * 32 + (swz % 64) / 2; }
__host__ __device__ __forceinline__ int perm32(int rho) { const int n = rho >> 4, i = rho & 15; return 8 * (i >> 2) + 4 * n + (i & 3); }

struct Unit { const char* a; const char* b; int orow, ocol, aux; };

struct Order {
    int nM, nN, nwg, G, c;
    __device__ __forceinline__ void init(int M, int N, int G_, int c_) { nM = M / BM; nN = N / BM; nwg = nM * nN; G = G_; c = c_; }
    __device__ __forceinline__ bool tile(int i, int& pm, int& pn) const {
        const long L = (long)i * G + c; if (L >= nwg) return false;
        int wgid = (int)L; { const int q = nwg / NXCD, r = nwg % NXCD, xcd = wgid % NXCD, off = wgid / NXCD; wgid = (xcd < r ? xcd * (q + 1) : r * (q + 1) + (xcd - r) * q) + off; }
        const int nig = WGM * nN, gid = wgid / nig, fm = gid * WGM, gsz = (nM - fm) < WGM ? (nM - fm) : WGM;
        pm = fm + ((wgid % nig) % gsz); pn = (wgid % nig) / gsz; return true;
    }
};

__device__ __forceinline__ unsigned cvt_pk_bf16(float lo, float hi) { unsigned r; asm volatile("v_cvt_pk_bf16_f32 %0, %1, %2" : "=v"(r) : "v"(lo), "v"(hi)); return r; }

template <class Epi, class Sched, bool ALIGN_EPI>
__device__ __forceinline__ void gemm_phase(PG8_LAS unsigned char* lds, const int lda, const int ldb, const int nt, const Sched& S, const Epi& E) {
    int tid_ = threadIdx.x; asm volatile("" : "+v"(tid_));
    const int tid = tid_, wid = __builtin_amdgcn_readfirstlane(tid >> 6), lane = tid & 63, wr = wid >> 2, wc = wid & 3, fr = lane & 15, fq = lane >> 4;
    unsigned voffA[2], voffB[2];
#pragma unroll
    for (int i = 0; i < 2; ++i) { int R, C; stage_rc(tid * 16 + i * 8192, R, C); const int Rb = Epi::PERM ? ((R & ~31) + perm32(R & 31)) : R;
        voffA[i] = (unsigned)(R * lda + C) * 2u; voffB[i] = (unsigned)(Rb * ldb + C) * 2u; }
    const size_t kstep = (size_t)(BK * 2);
    const size_t hstepA = (size_t)HALF * lda * 2, hstepB = (size_t)HALF * ldb * 2;
    const unsigned ldsw = (unsigned)wid * 1024u;
    const int aoff = lds_byte(wr * 64 + fr, fq * 8), boff = lds_byte(wc * 32 + fr, fq * 8);
#define PG8_SA(b, h) (((b) * 2 + (h)) * HTB)
#define PG8_SB(b, h) ((4 + (b) * 2 + (h)) * HTB)
#define PG8_STAGE(bufoff, gbase, voff) do { _Pragma("unroll") for (int _i = 0; _i < 2; ++_i) \
        __builtin_amdgcn_global_load_lds((const unsigned*)((const char*)(gbase) + (voff)[_i]), (PG8_LAS unsigned*)(lds + (bufoff) + ldsw + _i * 8192), 16, 0, 0); } while (0)
#define PG8_LDA(dst, b, h) do { _Pragma("unroll") for (int m = 0; m < 4; ++m) _Pragma("unroll") for (int k = 0; k < 2; ++k) dst[m][k] = *(const PG8_LAS bf16x8*)(lds + PG8_SA(b, h) + aoff + m * 2048 + k * 1024); } while (0)
#define PG8_LDB(dst, b, h) do { _Pragma("unroll") for (int n = 0; n < 2; ++n) _Pragma("unroll") for (int k = 0; k < 2; ++k) dst[n][k] = *(const PG8_LAS bf16x8*)(lds + PG8_SB(b, h) + boff + n * 2048 + k * 1024); } while (0)
#define PG8_MMA(ai, bj, At, Bt) do { __builtin_amdgcn_s_setprio(1); _Pragma("unroll") for (int m = 0; m < 4; ++m) _Pragma("unroll") for (int n = 0; n < 2; ++n) _Pragma("unroll") for (int k = 0; k < 2; ++k) \
        acc[ai][bj][m][n] = __builtin_amdgcn_mfma_f32_16x16x32_bf16(Bt[n][k], At[m][k], acc[ai][bj][m][n], 0, 0, 0); __builtin_amdgcn_s_setprio(0); } while (0)
#define PG8_WAIT_V(n) asm volatile("s_waitcnt vmcnt(" #n ")" ::: "memory")
#define PG8_WAIT_L(n) asm volatile("s_waitcnt lgkmcnt(" #n ")" ::: "memory")
#define PG8_BAR __builtin_amdgcn_s_barrier()
#define PG8_SCHED __builtin_amdgcn_sched_barrier(0)
    Unit cur, nxt; int ui = 0;
    if (!S.next(0, cur)) return;
    f32x4 acc[2][2][4][2];
#pragma unroll
    for (int a = 0; a < 2; ++a)
#pragma unroll
        for (int b = 0; b < 2; ++b)
#pragma unroll
            for (int m = 0; m < 4; ++m)
#pragma unroll
                for (int n = 0; n < 2; ++n) acc[a][b][m][n] = (f32x4){0.f, 0.f, 0.f, 0.f};
    bf16x8 At[4][2], B0[2][2], B1[2][2];
    const char* cA = cur.a; const char* cB = cur.b;
    PG8_STAGE(PG8_SB(0, 0), cB, voffB); PG8_STAGE(PG8_SB(0, 1), cB + hstepB, voffB); PG8_STAGE(PG8_SA(0, 0), cA, voffA); PG8_STAGE(PG8_SA(0, 1), cA + hstepA, voffA);
    if (wr == 1) PG8_BAR;
    PG8_WAIT_V(2); PG8_BAR;
    PG8_STAGE(PG8_SB(1, 0), cB + kstep, voffB); PG8_STAGE(PG8_SA(1, 0), cA + kstep, voffA); PG8_STAGE(PG8_SB(1, 1), cB + hstepB + kstep, voffB);
    PG8_WAIT_V(6); PG8_BAR;
    for (;;) {
        const bool has_next = S.next(ui + 1, nxt);
        const char* nA = has_next ? nxt.a : cA; const char* nB = has_next ? nxt.b : cB;
#pragma unroll 1
        for (int t = 0; t < nt; t += 2) {
            const bool last = (t == nt - 2);
            const char* a1 = cA + (size_t)(t + 1) * kstep;
            const char* a2 = last ? nA : cA + (size_t)(t + 2) * kstep; const char* b2 = last ? nB : cB + (size_t)(t + 2) * kstep;
            const char* a3 = a2 + kstep; const char* b3 = b2 + kstep;
            PG8_LDB(B0, 0, 0); PG8_LDB(B1, 0, 1); PG8_SCHED; PG8_LDA(At, 0, 0); PG8_STAGE(PG8_SA(1, 1), a1 + hstepA, voffA);
            PG8_WAIT_V(8); PG8_WAIT_L(0); PG8_BAR; PG8_MMA(0, 0, At, B0); PG8_MMA(0, 1, At, B1); PG8_BAR; PG8_SCHED;
            PG8_LDA(At, 0, 1); PG8_STAGE(PG8_SB(0, 0), b2, voffB); PG8_STAGE(PG8_SB(0, 1), b2 + hstepB, voffB); PG8_STAGE(PG8_SA(0, 0), a2, voffA);
            PG8_WAIT_V(8); PG8_WAIT_L(0); PG8_BAR; PG8_MMA(1, 0, At, B0); PG8_MMA(1, 1, At, B1); PG8_BAR; PG8_SCHED;
            PG8_LDB(B0, 1, 0); PG8_LDB(B1, 1, 1); PG8_SCHED; PG8_LDA(At, 1, 0); PG8_STAGE(PG8_SA(0, 1), a2 + hstepA, voffA);
            PG8_WAIT_V(8); PG8_WAIT_L(0); PG8_BAR; PG8_MMA(0, 0, At, B0); PG8_MMA(0, 1, At, B1); PG8_BAR; PG8_SCHED;
            PG8_LDA(At, 1, 1); PG8_STAGE(PG8_SB(1, 0), b3, voffB); PG8_STAGE(PG8_SB(1, 1), b3 + hstepB, voffB); PG8_STAGE(PG8_SA(1, 0), a3, voffA);
            PG8_WAIT_V(8); PG8_WAIT_L(0); PG8_BAR; PG8_MMA(1, 0, At, B0); PG8_MMA(1, 1, At, B1); PG8_BAR; PG8_SCHED;
        }
        if constexpr (ALIGN_EPI) { if (wr == 0) PG8_BAR; }
        E(acc, cur, wr, wc, fr, fq, lds, wid, lane);
        if (!has_next) break;
#pragma unroll
        for (int a = 0; a < 2; ++a)
#pragma unroll
            for (int b = 0; b < 2; ++b)
#pragma unroll
                for (int m = 0; m < 4; ++m)
#pragma unroll
                    for (int n = 0; n < 2; ++n) acc[a][b][m][n] = (f32x4){0.f, 0.f, 0.f, 0.f};
        cur = nxt; cA = nA; cB = nB; ++ui;
        if constexpr (ALIGN_EPI) { if (wr == 1) PG8_BAR; }
    }
    PG8_WAIT_V(0);
    if constexpr (!ALIGN_EPI) { if (wr == 0) PG8_BAR; }
    PG8_BAR;
#undef PG8_SA
#undef PG8_SB
#undef PG8_STAGE
#undef PG8_LDA
#undef PG8_LDB
#undef PG8_MMA
#undef PG8_WAIT_V
#undef PG8_WAIT_L
#undef PG8_BAR
#undef PG8_SCHED
}
}

namespace att {
#define ATT_LAS __attribute__((address_space(3)))
typedef short bf16x8 __attribute__((ext_vector_type(8)));
typedef short v4i16 __attribute__((ext_vector_type(4)));
typedef float f32x16 __attribute__((ext_vector_type(16)));
typedef float f32x4 __attribute__((ext_vector_type(4)));
typedef unsigned u32x4 __attribute__((ext_vector_type(4)));
typedef unsigned u32x2 __attribute__((ext_vector_type(2)));
constexpr float LOG2E = 1.4426950408889634f;
constexpr int TABA_N = 192, TABB_N = 1600;

__device__ __forceinline__ int rel_bucket(int n) {
    if (n < 16) return n < 0 ? 0 : n;
    int b = 16;
    b += (n >= 22); b += (n >= 30); b += (n >= 40); b += (n >= 54); b += (n >= 73); b += (n >= 99); b += (n >= 134); b += (n >= 182);
    b += (n >= 246); b += (n >= 332); b += (n >= 450); b += (n >= 609); b += (n >= 825); b += (n >= 1117); b += (n >= 1513);
    return b;
}
__device__ __forceinline__ unsigned pk_bf16(float lo, float hi) { unsigned r; asm volatile("v_cvt_pk_bf16_f32 %0, %1, %2" : "=v"(r) : "v"(lo), "v"(hi)); return r; }
__device__ __forceinline__ float bf16_round(float x) { unsigned u = __builtin_bit_cast(unsigned, x); u = (u + 0x7fffu + ((u >> 16) & 1u)) & 0xffff0000u; return __builtin_bit_cast(float, u); }

__device__ __forceinline__ void glds16(const void* gsrc, unsigned lds_dst) { unsigned keep;
    asm volatile("s_mov_b32 %0, m0\n\ts_mov_b32 m0, %2\n\ts_nop 0\n\tglobal_load_lds_dwordx4 %1, off\n\ts_mov_b32 m0, %0" : "=&s"(keep) : "v"(gsrc), "s"(lds_dst) : "memory"); }
__device__ __forceinline__ void dma_rows8(const char* krow0  , const int voff, const int row  ,
                                          ATT_LAS char* kdst  , ATT_LAS char* vdst, const int lane) {
    const int pc = lane & 7;
    glds16(krow0 + 16 * (pc ^ ((row >> 1) & 7)), (unsigned)__builtin_amdgcn_readfirstlane((int)(unsigned)(uintptr_t)kdst));
    glds16(krow0 + voff + 16 * (pc ^ (((row >> 1) & 1) << 2)), (unsigned)__builtin_amdgcn_readfirstlane((int)(unsigned)(uintptr_t)vdst));
}

__device__ __forceinline__ void attn_group(const bf16x8 (&qf)[4], f32x16 (&o)[2], float& m, float& l, const ATT_LAS char* kg, const ATT_LAS char* vg, const ATT_LAS float* tp, const int lane) {
    const int q = lane & 31, h = lane >> 5;
    const ATT_LAS char* kr0 = kg + q * 128; const int kswz = (q >> 1) & 7;
    typedef float f32x2_ __attribute__((ext_vector_type(2)));
    f32x2_ t0, t1, t2, t3, t4, t5, t6, t7;
    { const unsigned ta = (unsigned)(uintptr_t)(tp - 27);
      asm volatile("ds_read2_b32 %0, %8 offset0:27 offset1:26\n\tds_read2_b32 %1, %8 offset0:25 offset1:24\n\tds_read2_b32 %2, %8 offset0:19 offset1:18\n\tds_read2_b32 %3, %8 offset0:17 offset1:16\n\t"
                   "ds_read2_b32 %4, %8 offset0:11 offset1:10\n\tds_read2_b32 %5, %8 offset0:9 offset1:8\n\tds_read2_b32 %6, %8 offset0:3 offset1:2\n\tds_read2_b32 %7, %8 offset0:1 offset1:0"
                   : "=&v"(t0), "=&v"(t1), "=&v"(t2), "=&v"(t3), "=&v"(t4), "=&v"(t5), "=&v"(t6), "=&v"(t7) : "v"(ta) : "memory"); }
    const int q4 = (lane & 15) >> 2, p4 = lane & 3, g1 = (lane >> 4) & 1, vsw = (q4 >> 1) & 1;
    const unsigned va0_ = (unsigned)(uintptr_t)(vg + (4 * h + q4) * 128 + 32 * g1 + 8 * p4 + 64 * vsw), va1_ = (unsigned)(uintptr_t)(vg + (4 * h + q4) * 128 + 32 * g1 + 8 * p4 + 64 * (1 ^ vsw));
    v4i16 a[2][4];
    asm volatile("ds_read_b64_tr_b16 %0, %8\n\tds_read_b64_tr_b16 %1, %8 offset:1024\n\tds_read_b64_tr_b16 %2, %8 offset:2048\n\tds_read_b64_tr_b16 %3, %8 offset:3072\n\t"
                 "ds_read_b64_tr_b16 %4, %9\n\tds_read_b64_tr_b16 %5, %9 offset:1024\n\tds_read_b64_tr_b16 %6, %9 offset:2048\n\tds_read_b64_tr_b16 %7, %9 offset:3072"
                 : "=&v"(a[0][0]), "=&v"(a[0][1]), "=&v"(a[0][2]), "=&v"(a[0][3]), "=&v"(a[1][0]), "=&v"(a[1][1]), "=&v"(a[1][2]), "=&v"(a[1][3]) : "v"(va0_), "v"(va1_) : "memory");
    f32x16 s = f32x16{};
#pragma unroll
    for (int d0 = 0; d0 < 4; ++d0) { const bf16x8 kf = *(const ATT_LAS bf16x8*)(kr0 + 16 * ((2 * d0 + h) ^ kswz)); s = __builtin_amdgcn_mfma_f32_32x32x16_bf16(kf, qf[d0], s, 0, 0, 0); }
    asm volatile("s_waitcnt lgkmcnt(0)" : "+v"(t0), "+v"(t1), "+v"(t2), "+v"(t3), "+v"(t4), "+v"(t5), "+v"(t6), "+v"(t7), "+v"(a[0][0]), "+v"(a[0][1]), "+v"(a[0][2]), "+v"(a[0][3]), "+v"(a[1][0]), "+v"(a[1][1]), "+v"(a[1][2]), "+v"(a[1][3]) :: "memory");
    float mx = -INFINITY;
    { const float tb_[16] = {t0[0], t0[1], t1[0], t1[1], t2[0], t2[1], t3[0], t3[1], t4[0], t4[1], t5[0], t5[1], t6[0], t6[1], t7[0], t7[1]};
#pragma unroll
      for (int r = 0; r < 16; ++r) s[r] = fmaf(s[r], LOG2E, tb_[r]); }
#pragma unroll
    for (int r = 0; r < 16; r += 2) mx = fmaxf(mx, fmaxf(s[r], s[r + 1]));
    mx = fmaxf(mx, __shfl_xor(mx, 32));
    if (__any(mx > m)) {
        const float mnew = fmaxf(m, mx), alpha = __builtin_amdgcn_exp2f(m - mnew);
        l *= alpha; m = mnew;
#pragma unroll
        for (int r = 0; r < 16; ++r) { o[0][r] *= alpha; o[1][r] *= alpha; }
    }
    float ps = 0.f;
#pragma unroll
    for (int r = 0; r < 16; ++r) { s[r] = __builtin_amdgcn_exp2f(s[r] - m); ps += s[r]; }
    l += ps;
    u32x4 pw0, pw1;
    pw0[0] = pk_bf16(s[0], s[1]); pw0[1] = pk_bf16(s[2], s[3]); pw0[2] = pk_bf16(s[4], s[5]); pw0[3] = pk_bf16(s[6], s[7]);
    pw1[0] = pk_bf16(s[8], s[9]); pw1[1] = pk_bf16(s[10], s[11]); pw1[2] = pk_bf16(s[12], s[13]); pw1[3] = pk_bf16(s[14], s[15]);
    const bf16x8 pb0 = __builtin_bit_cast(bf16x8, pw0), pb1 = __builtin_bit_cast(bf16x8, pw1);
#pragma unroll
    for (int dh = 0; dh < 2; ++dh) {
        const bf16x8 va0 = (bf16x8){a[dh][0][0], a[dh][0][1], a[dh][0][2], a[dh][0][3], a[dh][1][0], a[dh][1][1], a[dh][1][2], a[dh][1][3]};
        const bf16x8 va1 = (bf16x8){a[dh][2][0], a[dh][2][1], a[dh][2][2], a[dh][2][3], a[dh][3][0], a[dh][3][1], a[dh][3][2], a[dh][3][3]};
        o[dh] = __builtin_amdgcn_mfma_f32_32x32x16_bf16(va0, pb0, o[dh], 0, 0, 0);
        o[dh] = __builtin_amdgcn_mfma_f32_32x32x16_bf16(va1, pb1, o[dh], 0, 0, 0);
    }
}

template <bool NT>
__device__ __forceinline__ void store_o(const f32x16 (&o)[2], const float l, char* orow_q, const int h) {
    const float il = 1.0f / l;
#pragma unroll
    for (int dh = 0; dh < 2; ++dh)
#pragma unroll
        for (int jj = 0; jj < 2; ++jj) {
            u32x2 we, wo;
            we[0] = pk_bf16(o[dh][8 * jj] * il, o[dh][8 * jj + 1] * il); we[1] = pk_bf16(o[dh][8 * jj + 2] * il, o[dh][8 * jj + 3] * il);
            wo[0] = pk_bf16(o[dh][8 * jj + 4] * il, o[dh][8 * jj + 5] * il); wo[1] = pk_bf16(o[dh][8 * jj + 6] * il, o[dh][8 * jj + 7] * il);
            const unsigned s0 = h ? we[0] : wo[0], s1 = h ? we[1] : wo[1];
            const unsigned r0 = (unsigned)__shfl_xor((int)s0, 32), r1 = (unsigned)__shfl_xor((int)s1, 32);
            u32x4 w; if (h == 0) { w[0] = we[0]; w[1] = we[1]; w[2] = r0; w[3] = r1; } else { w[0] = r0; w[1] = r1; w[2] = wo[0]; w[3] = wo[1]; }
            u32x4* dst = (u32x4*)(orow_q + (32 * dh + 16 * jj + 8 * h) * 2);
            if (NT) __builtin_nontemporal_store(w, dst); else *dst = w;
        }
}

__device__ __forceinline__ unsigned moba_select(const char* qbase, const long qs, const float* km, const int qb) {
    const int lane = threadIdx.x & 63, q = lane & 31, h = lane >> 5;
    f32x16 g = f32x16{};
    const float* kmrow = km + (size_t)(q & 15) * 256;
    const bool lo_part = q >= 16;
#pragma unroll
    for (int d0 = 0; d0 < 4; ++d0) {
        const bf16x8 qf = *(const bf16x8*)(qbase + (long)q * qs + (16 * d0 + 8 * h) * 2);
        const f32x4 f0 = *(const f32x4*)(kmrow + 16 * d0 + 8 * h), f1 = *(const f32x4*)(kmrow + 16 * d0 + 8 * h + 4);
        float v[8] = {f0[0], f0[1], f0[2], f0[3], f1[0], f1[1], f1[2], f1[3]};
        u32x4 aw;
#pragma unroll
        for (int j = 0; j < 4; ++j) {
            const float h0 = bf16_round(v[2 * j]), h1 = bf16_round(v[2 * j + 1]);
            const float x0 = lo_part ? (v[2 * j] - h0) : h0, x1 = lo_part ? (v[2 * j + 1] - h1) : h1;
            aw[j] = pk_bf16(x0, x1);
        }
        g = __builtin_amdgcn_mfma_f32_32x32x16_bf16(__builtin_bit_cast(bf16x8, aw), qf, g, 0, 0, 0);
    }
    float gate[8], other[8];
#pragma unroll
    for (int r = 0; r < 8; ++r) { gate[r] = g[r] + g[r + 8]; }
#pragma unroll
    for (int r = 0; r < 8; ++r) { other[r] = __shfl_xor(gate[r], 32); }
    unsigned mymask = 0u;
#pragma unroll
    for (int r = 0; r < 8; ++r) {
        const int n = (r & 3) + 8 * (r >> 2) + 4 * h;
        int rank = 0;
#pragma unroll
        for (int r2 = 0; r2 < 8; ++r2) {
            const int n2 = (r2 & 3) + 8 * (r2 >> 2) + 4 * h, n3 = (r2 & 3) + 8 * (r2 >> 2) + 4 * (1 - h);
            if (r2 != r) rank += (n2 < qb && (gate[r2] > gate[r] || (gate[r2] == gate[r] && n2 < n))) ? 1 : 0;
            rank += (n3 < qb && (other[r2] > gate[r] || (other[r2] == gate[r] && n3 < n))) ? 1 : 0;
        }
        if (n < qb && rank < 3) mymask |= 1u << n;
    }
    return mymask | (unsigned)__shfl_xor((int)mymask, 32);
}
}


namespace mk {
using pg8::bf16_t; using pg8::bf16x8; using pg8::f32x4; using pg8::f32x2; using pg8::u32x4; using pg8::u32x2; using pg8::Unit; using pg8::cvt_pk_bf16;
#define LAS __attribute__((address_space(3)))
constexpr int NBAT = MK_NBAT, SEQ = 4096, D = 1024, DFF = 2816, NMEM = 256, M = NBAT * SEQ, MM = NBAT * NMEM, NQKV = 3072;
constexpr float EPS = 1e-6f, LOG2E = 1.4426950408889634f;
constexpr int NWAVES = 8, NPH = 12;

constexpr size_t al256(size_t x) { return (x + 255) / 256 * 256; }
constexpr size_t WS_CTL = 0, CTL_BYTES = 1u << 20;
constexpr size_t WS_WGU1 = WS_CTL + CTL_BYTES;
constexpr size_t WS_WD1 = WS_WGU1 + (size_t)2 * DFF * D * 2;
constexpr size_t WS_WIN = WS_WD1 + (size_t)D * DFF * 2;
constexpr size_t WS_WOUT = WS_WIN + (size_t)NQKV * D * 2;
constexpr size_t WS_WCQS = WS_WOUT + (size_t)D * D * 2;
constexpr size_t WS_WCKV = WS_WCQS + (size_t)D * D * 2;
constexpr size_t WS_WCO = WS_WCKV + (size_t)2 * D * D * 2;
constexpr size_t WS_WGU2 = WS_WCO + (size_t)D * D * 2;
constexpr size_t WS_WD2 = WS_WGU2 + (size_t)2 * DFF * D * 2;
constexpr size_t WS_MB = WS_WD2 + (size_t)D * DFF * 2;
constexpr size_t WS_KVC = WS_MB + (size_t)MM * D * 2;
constexpr size_t WS_WKT = WS_KVC + (size_t)MM * 2 * D * 2;
constexpr size_t WS_VWT = WS_WKT + (size_t)NBAT * D * D * 2;
constexpr size_t SS_BYTES = (size_t)M * 16 * 4;
constexpr size_t WS_SS = WS_VWT + (size_t)NBAT * D * D * 2;
constexpr size_t WS_SSM = WS_SS + 5 * SS_BYTES;
constexpr size_t WS_KM = WS_SSM + (size_t)MM * 16 * 4;
constexpr size_t WS_R1 = al256(WS_KM + (size_t)NBAT * 16 * 256 * 4);
constexpr size_t WS_XB = WS_R1 + (size_t)M * NQKV * 2;
constexpr size_t WS_OA2 = WS_XB + (size_t)M * D * 2;
constexpr size_t WS_END = WS_OA2 + (size_t)M * 768 * 2;
constexpr size_t OUT_OA1 = (size_t)M * 768 * 2, OUT_OB = 2 * OUT_OA1, OUT_ML = OUT_OB + (size_t)M * 256 * 2;
static_assert(OUT_ML + (size_t)3 * M * 12 * 8 <= (size_t)M * D * 4, "attention partials fit in d_out");
constexpr int CW_BAR = 4096;

constexpr int LDS_XCH = 131072;
constexpr int LDS_MISC = 131072 + 8192;
constexpr int LDS_BYTES = 147456;
constexpr int LDS_TAB = 98304;
static_assert(LDS_TAB + 36 * att::TABA_N * 4 <= LDS_XCH && LDS_TAB + 4 * att::TABB_N * 4 <= LDS_XCH, "attention LDS map");

__device__ __forceinline__ float wave_sum(float v) {
#pragma unroll
    for (int o = 1; o < 64; o <<= 1) v += __shfl_xor(v, o);
    return v;
}
__device__ __forceinline__ float row_rstd(const float* ss, int row) {
    const f32x4* p = (const f32x4*)(ss + (size_t)row * 16);
    const f32x4 a = p[0], b = p[1], c = p[2], d = p[3];
    const float s = ((a[0] + a[1]) + (a[2] + a[3])) + ((b[0] + b[1]) + (b[2] + b[3])) + ((c[0] + c[1]) + (c[2] + c[3])) + ((d[0] + d[1]) + (d[2] + d[3]));
    return 1.0f / sqrtf(s * (1.0f / D) + EPS);
}

struct SchedStd {
    pg8::Order o; const char* A; const char* B; size_t a_tile, b_tile, b_batch; int ocol_mul;
    __device__ __forceinline__ bool next(int i, Unit& u) const { int pm, pn; if (!o.tile(i, pm, pn)) return false;
        u.a = A + (size_t)pm * a_tile; u.b = B + (size_t)pn * b_tile + (size_t)(pm >> 4) * b_batch; u.orow = pm * 256; u.ocol = pn * ocol_mul; u.aux = pn; return true; }
};
struct SchedWK {
    int G, c; const char* kvc; const char* wcqs;
    __device__ __forceinline__ bool next(int i, Unit& u) const { const int L = i * G + c; if (L >= NBAT * 16) return false; const int bh = L >> 2, pn = L & 3, b = bh >> 2, h = bh & 3;
        u.a = kvc + ((size_t)(b * 256) * 2048 + h * 256) * 2; u.b = wcqs + ((size_t)(pn * 256) * 1024 + h * 256) * 2; u.orow = b * 1024 + h * 256; u.ocol = pn * 256; u.aux = 0; return true; }
};
struct SchedVW {
    int G, c; const char* kvc; const char* wcot;
    __device__ __forceinline__ bool next(int i, Unit& u) const { const int L = i * G + c; if (L >= NBAT * 16) return false; const int bh = L >> 2, pm = L & 3, b = bh >> 2, h = bh & 3;
        u.a = wcot + ((size_t)(pm * 256) * 1024 + h * 256) * 2; u.b = kvc + ((size_t)(b * 256) * 2048 + 1024 + h * 256) * 2; u.orow = b * 1024 + pm * 256; u.ocol = h * 256; u.aux = 0; return true; }
};

struct EpiGU { static constexpr bool PERM = true;
    bf16_t* H; const float* ss;
    __device__ __forceinline__ void operator()(const f32x4 (&acc)[2][2][4][2], const Unit& u, int wr, int wc, int fr, int fq, LAS unsigned char*, int, int) const {
        float rsv[2][4];
#pragma unroll
        for (int ai = 0; ai < 2; ++ai)
#pragma unroll
            for (int m = 0; m < 4; ++m) rsv[ai][m] = row_rstd(ss, u.orow + ai * 128 + wr * 64 + m * 16 + fr);
#pragma unroll
        for (int ai = 0; ai < 2; ++ai)
#pragma unroll
            for (int m = 0; m < 4; ++m) { const int row = u.orow + ai * 128 + wr * 64 + m * 16 + fr; const float rs = rsv[ai][m];
                float hv[8];
#pragma unroll
                for (int n = 0; n < 2; ++n)
#pragma unroll
                    for (int j = 0; j < 4; ++j) { const float g = acc[ai][0][m][n][j] * rs, uu = acc[ai][1][m][n][j] * rs;
                        hv[4 * n + j] = g * __builtin_amdgcn_rcpf(1.0f + __builtin_amdgcn_exp2f(-g * LOG2E)) * uu; }
                u32x4 w; w[0] = cvt_pk_bf16(hv[0], hv[1]); w[1] = cvt_pk_bf16(hv[2], hv[3]); w[2] = cvt_pk_bf16(hv[4], hv[5]); w[3] = cvt_pk_bf16(hv[6], hv[7]);
                __builtin_nontemporal_store(w, (u32x4*)(H + (size_t)row * DFF + u.ocol + wc * 32 + 8 * fq)); }
    }
};
struct EpiRes { static constexpr bool PERM = true;
    bf16_t* xb; float* ssout; float alpha;
    __device__ __forceinline__ void operator()(const f32x4 (&acc)[2][2][4][2], const Unit& u, int wr, int wc, int fr, int fq, LAS unsigned char*, int, int) const {
        const size_t off0 = (size_t)(u.orow + wr * 64 + fr) * D + u.ocol + wc * 32 + 8 * fq;
        u32x4 cur[2], nxt[2];
#pragma unroll
        for (int bj = 0; bj < 2; ++bj) cur[bj] = *(const u32x4*)(xb + off0 + bj * 128);
#pragma unroll
        for (int idx = 0; idx < 8; ++idx) { const int ai = idx >> 2, m = idx & 3; const size_t off = off0 + (size_t)(ai * 128 + m * 16) * D; const int row = u.orow + ai * 128 + wr * 64 + m * 16 + fr;
            if (idx < 7) { const size_t offn = off0 + (size_t)(((idx + 1) >> 2) * 128 + ((idx + 1) & 3) * 16) * D;
#pragma unroll
                for (int bj = 0; bj < 2; ++bj) nxt[bj] = *(const u32x4*)(xb + offn + bj * 128); }
            float sq = 0.f;
#pragma unroll
            for (int bj = 0; bj < 2; ++bj) { float o[8];
#pragma unroll
                for (int n = 0; n < 2; ++n)
#pragma unroll
                    for (int j = 0; j < 4; ++j) { const unsigned wv = cur[bj][2 * n + (j >> 1)]; const float r = __builtin_bit_cast(float, (j & 1) ? (wv & 0xffff0000u) : (wv << 16));
                        const float v = r + acc[ai][bj][m][n][j] * alpha; o[4 * n + j] = v; sq += v * v; }
                u32x4 w; w[0] = cvt_pk_bf16(o[0], o[1]); w[1] = cvt_pk_bf16(o[2], o[3]); w[2] = cvt_pk_bf16(o[4], o[5]); w[3] = cvt_pk_bf16(o[6], o[7]);
                *(u32x4*)(xb + off + bj * 128) = w; }
            sq += __shfl_xor(sq, 16); sq += __shfl_xor(sq, 32);
            if (fq == 0) ssout[(size_t)row * 16 + (u.ocol >> 8) * 4 + wc] = sq;
#pragma unroll
            for (int bj = 0; bj < 2; ++bj) cur[bj] = nxt[bj]; }
    }
};
struct EpiStore { static constexpr bool PERM = true;
    bf16_t* O; int ldc; const float* ss; float* km; bool nt;
    __device__ __forceinline__ void operator()(const f32x4 (&acc)[2][2][4][2], const Unit& u, int wr, int wc, int fr, int fq, LAS unsigned char*, int, int) const {
        float rsv[2][4];
#pragma unroll
        for (int ai = 0; ai < 2; ++ai)
#pragma unroll
            for (int m = 0; m < 4; ++m) rsv[ai][m] = ss ? row_rstd(ss, u.orow + ai * 128 + wr * 64 + m * 16 + fr) : 1.0f;
#pragma unroll
        for (int ai = 0; ai < 2; ++ai)
#pragma unroll
            for (int m = 0; m < 4; ++m) { const int row = u.orow + ai * 128 + wr * 64 + m * 16 + fr; const float rs = rsv[ai][m];
                const int col0 = u.ocol + wc * 32 + 8 * fq;
                bf16_t* rowp = ldc ? O + (size_t)row * ldc + col0 : O + (((size_t)(row / SEQ) * (NQKV / 64) + (col0 >> 6)) * SEQ + (row % SEQ)) * 64 + (col0 & 63);
                const size_t bjstep = ldc ? 128 : (size_t)2 * SEQ * 64;
#pragma unroll
                for (int bj = 0; bj < 2; ++bj) { const f32x4 v0 = acc[ai][bj][m][0] * rs, v1 = acc[ai][bj][m][1] * rs;
                    u32x4 w; w[0] = cvt_pk_bf16(v0[0], v0[1]); w[1] = cvt_pk_bf16(v0[2], v0[3]); w[2] = cvt_pk_bf16(v1[0], v1[1]); w[3] = cvt_pk_bf16(v1[2], v1[3]);
                    if (nt) __builtin_nontemporal_store(w, (u32x4*)(rowp + bj * bjstep)); else *(u32x4*)(rowp + bj * bjstep) = w; } }
        if ((km != nullptr) && (u.aux == 10)) {
            float* kmb = km + (size_t)(u.orow >> 8) * 256 + wc * 32 + 8 * fq;
#pragma unroll
            for (int bj = 0; bj < 2; ++bj)
#pragma unroll
                for (int n = 0; n < 2; ++n) { f32x4 cs = (f32x4){0.f, 0.f, 0.f, 0.f};
#pragma unroll
                    for (int ai = 0; ai < 2; ++ai)
#pragma unroll
                        for (int m = 0; m < 4; ++m) cs += acc[ai][bj][m][n] * rsv[ai][m];
#pragma unroll
                    for (int j = 0; j < 4; ++j) { float v = cs[j]; v += __shfl_xor(v, 1); v += __shfl_xor(v, 2); v += __shfl_xor(v, 4); v += __shfl_xor(v, 8);
                        if (fr == 0) atomicAdd(kmb + bj * 128 + 4 * n + j, v); } }
        }
    }
};
struct EpiSoftmax { static constexpr bool PERM = true;
    bf16_t* P; const float* ss;
    __device__ __forceinline__ void operator()(const f32x4 (&acc)[2][2][4][2], const Unit& u, int wr, int wc, int fr, int fq, LAS unsigned char* lds, int, int) const {
        LAS f32x2* X = (LAS f32x2*)(lds + LDS_XCH);
        float rsl[2][4], mw[2][4];
#pragma unroll
        for (int ai = 0; ai < 2; ++ai)
#pragma unroll
            for (int m = 0; m < 4; ++m) { const int rl = ai * 128 + wr * 64 + m * 16 + fr; const float rs = row_rstd(ss, u.orow + rl) * LOG2E; rsl[ai][m] = rs;
                float mx = -INFINITY;
#pragma unroll
                for (int bj = 0; bj < 2; ++bj)
#pragma unroll
                    for (int n = 0; n < 2; ++n)
#pragma unroll
                        for (int j = 0; j < 4; ++j) mx = fmaxf(mx, acc[ai][bj][m][n][j] * rs);
                mx = fmaxf(mx, __shfl_xor(mx, 16)); mx = fmaxf(mx, __shfl_xor(mx, 32));
                float sm = 0.f;
#pragma unroll
                for (int bj = 0; bj < 2; ++bj)
#pragma unroll
                    for (int n = 0; n < 2; ++n)
#pragma unroll
                        for (int j = 0; j < 4; ++j) sm += __builtin_amdgcn_exp2f(acc[ai][bj][m][n][j] * rs - mx);
                sm += __shfl_xor(sm, 16); sm += __shfl_xor(sm, 32);
                mw[ai][m] = mx;
                if (fq == 0) X[rl * 4 + wc] = (f32x2){mx, sm}; }
        asm volatile("s_waitcnt lgkmcnt(0)" ::: "memory"); __builtin_amdgcn_s_barrier(); asm volatile("" ::: "memory");
#pragma unroll
        for (int ai = 0; ai < 2; ++ai)
#pragma unroll
            for (int m = 0; m < 4; ++m) { const int rl = ai * 128 + wr * 64 + m * 16 + fr; const float rs = rsl[ai][m];
                const f32x2 x0 = X[rl * 4 + 0], x1 = X[rl * 4 + 1], x2 = X[rl * 4 + 2], x3 = X[rl * 4 + 3];
                const float Mx = fmaxf(fmaxf(x0[0], x1[0]), fmaxf(x2[0], x3[0]));
                const float L = x0[1] * __builtin_amdgcn_exp2f(x0[0] - Mx) + x1[1] * __builtin_amdgcn_exp2f(x1[0] - Mx) + x2[1] * __builtin_amdgcn_exp2f(x2[0] - Mx) + x3[1] * __builtin_amdgcn_exp2f(x3[0] - Mx);
                const float il = 1.0f / L;
                bf16_t* rowp = P + (size_t)(u.orow + rl) * D + u.ocol + wc * 32 + 8 * fq;
#pragma unroll
                for (int bj = 0; bj < 2; ++bj) { float pv[8];
#pragma unroll
                    for (int n = 0; n < 2; ++n)
#pragma unroll
                        for (int j = 0; j < 4; ++j) pv[4 * n + j] = __builtin_amdgcn_exp2f(acc[ai][bj][m][n][j] * rs - Mx) * il;
                    u32x4 w; w[0] = cvt_pk_bf16(pv[0], pv[1]); w[1] = cvt_pk_bf16(pv[2], pv[3]); w[2] = cvt_pk_bf16(pv[4], pv[5]); w[3] = cvt_pk_bf16(pv[6], pv[7]);
                    *(u32x4*)(rowp + bj * 128) = w; } }
        (void)mw;
    }
};

#define XB_TMO      128
#define XB_XCNT(j)  (256  + 64 * (j))
#define XB_XSUB(j)  (1280 + 64 * (j))
#define XB_XGEN(j)  (2304 + 64 * (j))
#define XB_TOP      3328
#define XB_TOPGEN   3392
#define XCD_BAR_WORDS 3456
#define XB_SPIN_CAP (1u << 18)
__device__ __forceinline__ unsigned xb_ld(unsigned* p)              { return __hip_atomic_load(p, __ATOMIC_RELAXED, __HIP_MEMORY_SCOPE_AGENT); }
__device__ __forceinline__ unsigned xb_add(unsigned* p, unsigned v) { return __hip_atomic_fetch_add(p, v, __ATOMIC_RELAXED, __HIP_MEMORY_SCOPE_AGENT); }
__device__ __forceinline__ unsigned xb_xcc_id() { return (unsigned)__builtin_amdgcn_s_getreg((3 << 11) | 20) & 0xFu; }
#define XB_SPIN(cond, bar) do { unsigned _sp = 0; while (cond) { __builtin_amdgcn_s_sleep(1); \
    if ((++_sp & 255u) == 0u) { if (xb_ld(&(bar)[XB_TMO])) break; if (_sp > XB_SPIN_CAP) { atomicAdd(&(bar)[XB_TMO], 1u); break; } } } } while (0)
struct XcdBarrier { unsigned* bar; unsigned x; volatile LAS unsigned* st; };
__device__ __forceinline__ XcdBarrier xcd_barrier_post(unsigned* bar, volatile LAS unsigned* st) {
    XcdBarrier b; b.bar = bar; b.x = xb_xcc_id(); b.st = st;
    if (threadIdx.x == 0) (void)xb_add(&bar[XB_XCNT(b.x)], 1u);
    return b;
}
__device__ __forceinline__ void xcd_barrier_complete(unsigned* bar, unsigned x, unsigned& nloc, unsigned& nx) {
    const unsigned G = gridDim.x * gridDim.y * gridDim.z;
    unsigned sum, cnt, mine, sp = 0u;
    for (;;) {
        sum = 0u; cnt = 0u; mine = 0u;
#pragma unroll
        for (unsigned j = 0; j < 16; ++j) { const unsigned c = xb_ld(&bar[XB_XCNT(j)]); sum += c; cnt += (c > 0u) ? 1u : 0u; mine = (j == x) ? c : mine; }
        if (sum == G) break;
        __builtin_amdgcn_s_sleep(1);
        if ((++sp & 255u) == 0u) { if (xb_ld(&bar[XB_TMO])) break; if (sp > XB_SPIN_CAP) { atomicAdd(&bar[XB_TMO], 1u); break; } }
    }
    nloc = mine > 0u ? mine : 1u; nx = cnt > 0u ? cnt : 1u;
}
__device__ __forceinline__ void xcd_barrier(const XcdBarrier& b) {
    asm volatile("s_waitcnt vmcnt(0)" ::: "memory");
    __syncthreads();
    if (threadIdx.x == 0) {
        unsigned* bar = b.bar;
        __builtin_amdgcn_s_waitcnt(0);
        unsigned nloc = b.st[0], nx = b.st[1];
        if (nloc == 0u) { xcd_barrier_complete(bar, b.x, nloc, nx); b.st[0] = nloc; b.st[1] = nx; }
        const unsigned old = xb_add(&bar[XB_XSUB(b.x)], 1u);
        const unsigned gen = old / nloc;
        if (old + 1u == (gen + 1u) * nloc) {
            __builtin_amdgcn_fence(__ATOMIC_RELEASE, "agent");
            asm volatile("s_waitcnt vmcnt(0)" ::: "memory");
            const unsigned og = xb_add(&bar[XB_TOP], 1u);
            const unsigned tg = og / nx;
            if (og + 1u == (tg + 1u) * nx) xb_add(&bar[XB_TOPGEN], 1u);
            else XB_SPIN(xb_ld(&bar[XB_TOPGEN]) == tg, bar);
            __builtin_amdgcn_fence(__ATOMIC_ACQUIRE, "agent");
            xb_add(&bar[XB_XGEN(b.x)], 1u);
            asm volatile("s_waitcnt vmcnt(0)" ::: "memory");
        } else {
            XB_SPIN(xb_ld(&bar[XB_XGEN(b.x)]) == gen, bar);
            __builtin_amdgcn_fence(__ATOMIC_ACQUIRE, "agent");
            asm volatile("s_waitcnt vmcnt(0)" ::: "memory");
        }
    }
    __syncthreads();
}

__device__ __forceinline__ void tr_item(const float* W, int N, int k0, int n0, const float* gain, float cscale, bf16_t* dst  , int Kd, LAS float* scr, int lane) {
    f32x4 v[8]; float g[8];
#pragma unroll
    for (int i = 0; i < 8; ++i) { const int kk = 8 * i + (lane >> 3); v[i] = __builtin_nontemporal_load((const f32x4*)(W + (size_t)(k0 + kk) * N + n0 + 4 * (lane & 7))); g[i] = gain ? gain[k0 + kk] * cscale : cscale; }
#pragma unroll
    for (int i = 0; i < 8; ++i) { const int kk = 8 * i + (lane >> 3); LAS float* d = scr + kk * 33 + 4 * (lane & 7); d[0] = v[i][0] * g[i]; d[1] = v[i][1] * g[i]; d[2] = v[i][2] * g[i]; d[3] = v[i][3] * g[i]; }
    asm volatile("s_waitcnt lgkmcnt(0)" ::: "memory");
    const int c = lane & 7;
#pragma unroll
    for (int j = 0; j < 4; ++j) { const int n = (lane >> 3) + 8 * j; const LAS float* s = scr + (8 * c) * 33 + n;
        u32x4 o; o[0] = cvt_pk_bf16(s[0 * 33], s[1 * 33]); o[1] = cvt_pk_bf16(s[2 * 33], s[3 * 33]); o[2] = cvt_pk_bf16(s[4 * 33], s[5 * 33]); o[3] = cvt_pk_bf16(s[6 * 33], s[7 * 33]);
        *(u32x4*)(dst + (size_t)n * Kd + k0 + 8 * c) = o; }
    asm volatile("s_waitcnt lgkmcnt(0)" ::: "memory");
}
template <int NR>
__device__ __forceinline__ void cvt_rows(const float* x, bf16_t* o, float* ss, int row0, int stride, int nrows, int lane) {
    f32x4 v[NR][4]; float s[NR];
#pragma unroll
    for (int r = 0; r < NR; ++r) { const int row = row0 + r * stride; const f32x4* xr = (const f32x4*)(x + (size_t)(row < nrows ? row : row0) * D) + lane;
#pragma unroll
        for (int j = 0; j < 4; ++j) v[r][j] = __builtin_nontemporal_load(xr + 64 * j); }
#pragma unroll
    for (int r = 0; r < NR; ++r) { float a = 0.f;
#pragma unroll
        for (int j = 0; j < 4; ++j) a += (v[r][j][0] * v[r][j][0] + v[r][j][1] * v[r][j][1]) + (v[r][j][2] * v[r][j][2] + v[r][j][3] * v[r][j][3]);
        s[r] = a; }
#pragma unroll
    for (int of = 1; of < 64; of <<= 1)
#pragma unroll
        for (int r = 0; r < NR; ++r) s[r] += __shfl_xor(s[r], of);
#pragma unroll
    for (int r = 0; r < NR; ++r) { const int row = row0 + r * stride; if (row < nrows) { u32x2* o8 = (u32x2*)(o + (size_t)row * D) + lane;
#pragma unroll
            for (int j = 0; j < 4; ++j) { u32x2 w; w[0] = cvt_pk_bf16(v[r][j][0], v[r][j][1]); w[1] = cvt_pk_bf16(v[r][j][2], v[r][j][3]); o8[64 * j] = w; }
            if (lane < 16) ss[(size_t)row * 16 + lane] = lane == 0 ? s[r] : 0.f; } }
}

struct Args { const float* in[20]; float* out; unsigned char* ws; int ph_lo, ph_hi, flags, pad; };

#define MK_PTRS unsigned char* ws = args.ws; float* out = args.out; asm volatile("" : "+s"(ws), "+s"(out)); \
    const float* x_in = args.in[0]; const float* mem_in = args.in[1]; const float* rel_bias = args.in[7]; \
    bf16_t* Wgu1 = (bf16_t*)(ws + WS_WGU1); bf16_t* Wd1 = (bf16_t*)(ws + WS_WD1); bf16_t* Win = (bf16_t*)(ws + WS_WIN); bf16_t* Wout = (bf16_t*)(ws + WS_WOUT); \
    bf16_t* Wcqs = (bf16_t*)(ws + WS_WCQS); bf16_t* Wckv = (bf16_t*)(ws + WS_WCKV); bf16_t* Wco = (bf16_t*)(ws + WS_WCO); bf16_t* Wgu2 = (bf16_t*)(ws + WS_WGU2); bf16_t* Wd2 = (bf16_t*)(ws + WS_WD2); \
    bf16_t* MB = (bf16_t*)(ws + WS_MB); bf16_t* KVC = (bf16_t*)(ws + WS_KVC); bf16_t* WKT = (bf16_t*)(ws + WS_WKT); bf16_t* VWT = (bf16_t*)(ws + WS_VWT); \
    float* SS0 = (float*)(ws + WS_SS); float* SS1 = SS0 + (size_t)M * 16; float* SS2 = SS1 + (size_t)M * 16; float* SS3 = SS2 + (size_t)M * 16; float* SS4 = SS3 + (size_t)M * 16; \
    float* SSM = (float*)(ws + WS_SSM); float* KM = (float*)(ws + WS_KM); \
    bf16_t* HB = (bf16_t*)(ws + WS_R1); bf16_t* QKV = HB; bf16_t* YN = HB; bf16_t* PB = HB; \
    bf16_t* XB = (bf16_t*)(ws + WS_XB); bf16_t* OA0 = (bf16_t*)out; bf16_t* OA1 = (bf16_t*)((char*)out + OUT_OA1); bf16_t* OA2 = (bf16_t*)(ws + WS_OA2); bf16_t* OB = (bf16_t*)((char*)out + OUT_OB); float* ML = (float*)((char*)out + OUT_ML);
__global__ void __launch_bounds__(NWAVES * 64, 2) mk_fwd(Args args) {
    extern __shared__ __attribute__((aligned(16))) unsigned char lds_raw[];
    LAS unsigned char* lds = (LAS unsigned char*)lds_raw;
    const int tid = threadIdx.x, lane = tid & 63, wave = __builtin_amdgcn_readfirstlane(tid >> 6);
    const int G = gridDim.x, bx = blockIdx.x;
    const int vcu = (G % 8 == 0) ? (bx % 8) * (G / 8) + bx / 8 : bx;
    const int gw = vcu * NWAVES + wave, NGW = G * NWAVES;
    unsigned char* const ws0 = args.ws;
    volatile LAS unsigned* MISC = (volatile LAS unsigned*)(lds + LDS_MISC);
    if (tid < 32) MISC[tid] = 0u;
    __syncthreads();
    const int lo = args.ph_lo, hi = args.ph_hi;
    const bool use_bar = (hi - lo) > 1;
    XcdBarrier bar; bar.bar = (unsigned*)(ws0 + WS_CTL) + CW_BAR; bar.x = 0; bar.st = nullptr;
    if (use_bar) bar = xcd_barrier_post((unsigned*)(ws0 + WS_CTL) + CW_BAR, MISC + 8);
#define IN(k) (lo <= (k) && (k) < hi)
#define STAGGER() do { if (MK_STAGGER_TICKS > 0) { const unsigned long long t0_ = __builtin_amdgcn_s_memrealtime(), dl_ = (unsigned long long)((bx >> 3) & 3) * MK_STAGGER_TICKS; while (__builtin_amdgcn_s_memrealtime() - t0_ < dl_) __builtin_amdgcn_s_sleep(8); } } while (0)
#define SEAM(k) do { if (IN(k) && IN((k) + 1)) xcd_barrier(bar); } while (0)

    if (IN(0)) {
        MK_PTRS;
        LAS float* scr = (LAS float*)(lds + wave * 16384);
        constexpr int I_GU = (D / 64) * (2 * DFF / 32), I_DN = (DFF / 64) * (D / 32), I_IN = (D / 64) * (NQKV / 32), I_SQ = (D / 64) * (D / 32), I_KV = (D / 64) * (2 * D / 32);
        constexpr int NITEMS = 2 * I_GU + 2 * I_DN + I_IN + 2 * I_SQ + I_KV;
        for (int it = gw; it < NITEMS; it += NGW) {
            int r = it;
            if (r < 2 * I_GU) {
                const bool second = r >= I_GU; if (second) r -= I_GU;
                const int nblk = 2 * DFF / 32, kb = r / nblk, nb = r % nblk, n0 = nb * 32;
                const int drow = n0 < DFF ? (n0 / 128) * 256 + (n0 % 128) : ((n0 - DFF) / 128) * 256 + 128 + ((n0 - DFF) % 128);
                tr_item(args.in[second ? 17 : 3], 2 * DFF, kb * 64, n0, args.in[second ? 16 : 2], 1.0f, (second ? Wgu2 : Wgu1) + (size_t)drow * D, D, scr, lane); continue; }
            r -= 2 * I_GU;
            if (r < 2 * I_DN) { const bool second = r >= I_DN; if (second) r -= I_DN; const int nblk = D / 32, kb = r / nblk, nb = r % nblk;
                tr_item(args.in[second ? 18 : 4], D, kb * 64, nb * 32, nullptr, 1.0f, (second ? Wd2 : Wd1) + (size_t)(nb * 32) * DFF, DFF, scr, lane); continue; }
            r -= 2 * I_DN;
            if (r < I_IN) { const int nblk = NQKV / 32, kb = r / nblk, nb = r % nblk, n0 = nb * 32; const bool isq = (n0 < 768) || (n0 >= 2304 && n0 < 2560);
                tr_item(args.in[6], NQKV, kb * 64, n0, args.in[5], isq ? 0.125f : 1.0f, Win + (size_t)n0 * D, D, scr, lane); continue; }
            r -= I_IN;
            if (r < I_SQ) { const int nblk = D / 32, kb = r / nblk, nb = r % nblk, k0 = kb * 64; const float* gp = k0 < 768 ? args.in[8] : args.in[9] - 768;
                tr_item(args.in[10], D, k0, nb * 32, gp, 1.0f, Wout + (size_t)(nb * 32) * D, D, scr, lane); continue; }
            r -= I_SQ;
            if (r < I_SQ) { const int nblk = D / 32, kb = r / nblk, nb = r % nblk; tr_item(args.in[15], D, kb * 64, nb * 32, nullptr, 1.0f, Wco + (size_t)(nb * 32) * D, D, scr, lane); continue; }
            r -= I_SQ;
            { const int nblk = 2 * D / 32, kb = r / nblk, nb = r % nblk; tr_item(args.in[14], 2 * D, kb * 64, nb * 32, args.in[12], 1.0f, Wckv + (size_t)(nb * 32) * D, D, scr, lane); }
        }
        for (int c = gw; c < D; c += NGW) { const float g = args.in[11][c] * 0.0625f; const f32x4* src = (const f32x4*)(args.in[13] + (size_t)c * D) + lane; u32x2* dst = (u32x2*)(Wcqs + (size_t)c * D) + lane;
#pragma unroll
            for (int j = 0; j < 4; ++j) { const f32x4 v = src[64 * j] * g; u32x2 w; w[0] = cvt_pk_bf16(v[0], v[1]); w[1] = cvt_pk_bf16(v[2], v[3]); dst[64 * j] = w; } }
        for (int m = gw; m < M; m += 4 * NGW) cvt_rows<4>(x_in, XB, SS0, m, NGW, M, lane);
        for (int m = gw; m < MM; m += NGW) cvt_rows<1>(mem_in, MB, SSM, m, NGW, MM, lane);
        for (int i = gw * 64 + lane; i < NBAT * 16 * 256; i += NGW * 64) KM[i] = 0.f;
    }
    SEAM(0);

    if (IN(1)) {
        MK_PTRS;
        STAGGER();
        { SchedStd S; S.o.init(M, 2 * DFF, G, bx); S.A = (const char*)XB; S.B = (const char*)Wgu1; S.a_tile = (size_t)256 * D * 2; S.b_tile = (size_t)256 * D * 2; S.b_batch = 0; S.ocol_mul = 128;
          EpiGU E{HB, SS0}; pg8::gemm_phase<EpiGU, SchedStd, true>(lds, D, D, D / 64, S, E); }
        { SchedStd S; S.o.init(MM, 2 * D, G, (bx + G / 2) % G); S.A = (const char*)MB; S.B = (const char*)Wckv; S.a_tile = (size_t)256 * D * 2; S.b_tile = (size_t)256 * D * 2; S.b_batch = 0; S.ocol_mul = 256;
          EpiStore E{KVC, 2 * D, SSM, nullptr, false}; pg8::gemm_phase<EpiStore, SchedStd, true>(lds, D, D, D / 64, S, E); }
    }
    SEAM(1);

    if (IN(2)) {
        MK_PTRS;
        SchedStd S; S.o.init(M, D, G, bx); S.A = (const char*)HB; S.B = (const char*)Wd1; S.a_tile = (size_t)256 * DFF * 2; S.b_tile = (size_t)256 * DFF * 2; S.b_batch = 0; S.ocol_mul = 256;
        EpiRes E{XB, SS1, 0.5f}; pg8::gemm_phase<EpiRes, SchedStd, true>(lds, DFF, DFF, DFF / 64, S, E);
    }
    SEAM(2);

    if (IN(3)) {
        MK_PTRS;
        { SchedStd S; S.o.init(M, NQKV, G, bx); S.A = (const char*)XB; S.B = (const char*)Win; S.a_tile = (size_t)256 * D * 2; S.b_tile = (size_t)256 * D * 2; S.b_batch = 0; S.ocol_mul = 256;
          EpiStore E{QKV, 0, SS1, KM, false}; pg8::gemm_phase<EpiStore, SchedStd, true>(lds, D, D, D / 64, S, E); }
        { SchedWK S{G, bx, (const char*)KVC, (const char*)Wcqs}; EpiStore E{WKT, D, nullptr, nullptr, false}; pg8::gemm_phase<EpiStore, SchedWK, true>(lds, 2 * D, D, 4, S, E); }
        { SchedVW S{G, (bx + G / 2) % G, (const char*)KVC, (const char*)Wco}; EpiStore E{VWT, D, nullptr, nullptr, false}; pg8::gemm_phase<EpiStore, SchedVW, true>(lds, D, 2 * D, 4, S, E); }
    }
    SEAM(3);

    if (IN(4)) {
        MK_PTRS;
        LAS float* tab = (LAS float*)(lds + LDS_TAB);
        const int h2 = lane >> 5, q = lane & 31;
        const long rowb = 128;
        constexpr long HSTR = (long)SEQ * 128;
#define ATT_WAITV(n) asm volatile("s_waitcnt vmcnt(" #n ")" ::: "memory")
#define ATT_BAR() do { asm volatile("s_waitcnt lgkmcnt(0)" ::: "memory"); __builtin_amdgcn_s_barrier(); asm volatile("" ::: "memory"); } while (0)
        for (int i = tid; i < 4 * att::TABB_N; i += NWAVES * 64) { const int hb = i / att::TABB_N, e = i % att::TABB_N, dist = e - 32;
            tab[i] = dist >= 0 ? rel_bias[att::rel_bucket(dist) * 16 + 12 + hb] * LOG2E : -INFINITY; }
        __syncthreads();
        constexpr int NMOBA = NBAT * 4 * 16;
        for (int j = vcu; j < NMOBA / 2; j += G)
#pragma unroll 1
            for (int half = 0; half < 2; ++half) {
                const int bh = j >> 3, s8 = j & 7; const int qb = half ? s8 : 15 - s8, b = bh >> 2, hb = bh & 3;
                const int q0 = qb * 256 + wave * 32;
                const char* base = (const char*)QKV + (size_t)b * 48 * HSTR;
                const char* qbase = base + (36 + hb) * HSTR + (size_t)q0 * rowb;
                const char* kbase = base + (40 + hb) * HSTR;
                att::bf16x8 qf[4];
#pragma unroll
                for (int d0 = 0; d0 < 4; ++d0) qf[d0] = *(const att::bf16x8*)(qbase + (long)q * rowb + (16 * d0 + 8 * h2) * 2);
                const unsigned sel = att::moba_select(qbase, rowb, KM + (size_t)b * 16 * 256 + hb * 64, qb);
                const LAS float* tb = tab + hb * att::TABB_N;
                const int NT = 4 * (qb + 1);
                const int drow = wave * 8 + (lane >> 3);
                const char* ksrc = kbase + (long)drow * rowb;
                ATT_WAITV(0);
                constexpr int NS = 6;
                int st_t = 0;
#pragma unroll
                for (int k = 0; k < NS - 1; ++k) if (k < NT)
                    att::dma_rows8(ksrc + (long)k * 64 * rowb, (int)(4 * HSTR), drow, (LAS char*)(lds + k * 16384 + wave * 1024), (LAS char*)(lds + k * 16384 + 8192 + wave * 1024), lane);
                att::f32x16 o[2]; o[0] = att::f32x16{}; o[1] = att::f32x16{}; float mo = -1e30f, lo_ = 0.f;
#pragma unroll 1
                for (int t = 0; t < NT; ++t) {
                    const int newer = NT - 1 - t;
                    if (newer >= 4) ATT_WAITV(8); else if (newer == 3) ATT_WAITV(6); else if (newer == 2) ATT_WAITV(4); else if (newer == 1) ATT_WAITV(2); else ATT_WAITV(0);
                    ATT_BAR();
                    if (t + NS - 1 < NT) { const int s2 = st_t == 0 ? NS - 1 : st_t - 1;
                        att::dma_rows8(ksrc + (long)(t + NS - 1) * 64 * rowb, (int)(4 * HSTR), drow, (LAS char*)(lds + s2 * 16384 + wave * 1024), (LAS char*)(lds + s2 * 16384 + 8192 + wave * 1024), lane); }
                    const LAS char* kt = (const LAS char*)(lds + st_t * 16384);
#pragma unroll
                    for (int gg = 0; gg < 2; ++gg) {
                        const int g0 = 64 * t + 32 * gg;
                        if (g0 <= q0) {
                            int B = (q0 - g0 + 32) + q - 4 * h2; B = B < (att::TABB_N - 1) ? B : (att::TABB_N - 1);
                            const int n = g0 >> 8; const bool sl = (n == qb) || ((sel >> n) & 1u); B = sl ? B : 27;
                            att::attn_group(qf, o, mo, lo_, kt + gg * 4096, kt + 8192 + gg * 4096, tb + B, lane);
                        }
                    }
                    st_t = st_t == NS - 1 ? 0 : st_t + 1;
                }
                ATT_BAR();
                lo_ += __shfl_xor(lo_, 32);
                att::store_o<MK_NT_PART>(o, lo_, (char*)OB + ((size_t)(b * SEQ + q0 + q) * 256 + hb * 64) * 2, h2);
            }
        __syncthreads();
        for (int i = tid; i < 36 * att::TABA_N; i += NWAVES * 64) { const int t = i / att::TABA_N, e = i % att::TABA_N, p = t / 12, h = t % 12, delta = e - 32, d = p == 0 ? 1 : (p == 1 ? 4 : 16);
            tab[i] = (delta >= 0 && delta <= 128) ? rel_bias[att::rel_bucket(delta * d) * 16 + h] * LOG2E : -INFINITY; }
        __syncthreads();
        constexpr int NDIL = NBAT * 12 * 48;
        struct DilItem { int b, h, p, d, res, m0, mbase; };
        auto decode = [&](int it, DilItem& I) { const int bh = it / 48, j = it % 48; I.b = bh / 12; I.h = bh % 12; I.p = j >> 4; const int jj = j & 15;
            I.d = I.p == 0 ? 1 : (I.p == 1 ? 4 : 16); I.res = I.p == 0 ? 0 : (I.p == 1 ? (jj & 3) : jj); const int mblk = I.p == 0 ? jj : (I.p == 1 ? (jj >> 2) : 0);
            I.mbase = mblk * 256 - 128; I.m0 = mblk * 256 + wave * 32; };
        att::bf16x8 qf[4];
        auto issue = [&](const DilItem& I) {
            const char* base = (const char*)QKV + ((size_t)I.b * 48 + I.h) * HSTR + (size_t)I.res * rowb; const long st = (long)I.d * rowb; const char* kbase = base + 12 * HSTR;
#pragma unroll 1
            for (int k = wave; k < 48; k += NWAVES) {
                if (I.mbase + 8 * k < 0) continue;
                const int row = 8 * k + (lane >> 3);
                att::dma_rows8(kbase + (long)(I.mbase + row) * st, (int)(12 * HSTR), row, (LAS char*)(lds + k * 1024), (LAS char*)(lds + 49152 + k * 1024), lane);
            }
            const char* qbase = base + (long)I.m0 * st;
#pragma unroll
            for (int d0 = 0; d0 < 4; ++d0) qf[d0] = *(const att::bf16x8*)(qbase + (long)q * st + (16 * d0 + 8 * h2) * 2);
        };
        DilItem cur; int it = vcu;
        if (it < NDIL) { decode(it, cur); ATT_WAITV(0); issue(cur); }
#pragma unroll 1
        for (; it < NDIL; it += G) {
            ATT_WAITV(0); ATT_BAR();
            att::f32x16 o[2]; o[0] = att::f32x16{}; o[1] = att::f32x16{}; float mo = -1e30f, lo_ = 0.f;
            const LAS float* ta = tab + (cur.p * 12 + cur.h) * att::TABA_N;
            const int m0 = cur.m0, gend = (m0 - 128) > 0 ? (m0 - 128) : 0;
            { att::bf16x8 qc[4] = {qf[0], qf[1], qf[2], qf[3]};
#pragma unroll 1
            for (int g0 = m0; g0 >= gend; g0 -= 32) {
                const int B = (m0 - g0 + 32) + q - 4 * h2;
                const LAS char* kg = (const LAS char*)(lds + (g0 - cur.mbase) * 128);
                att::attn_group(qc, o, mo, lo_, kg, kg + 49152, ta + B, lane);
            } }
            ATT_BAR();
            const DilItem done = cur;
            if (it + G < NDIL) { decode(it + G, cur); issue(cur); }
            lo_ += __shfl_xor(lo_, 32);
            const size_t tok = (size_t)done.b * SEQ + (size_t)(m0 + q) * done.d + done.res;
            att::store_o<MK_NT_PART>(o, lo_, (char*)(done.p == 0 ? OA0 : (done.p == 1 ? OA1 : OA2)) + (tok * 768 + done.h * 64) * 2, h2);
            if (h2 == 0) *(f32x2*)(ML + (((size_t)done.p * M + tok) * 12 + done.h) * 2) = (f32x2){mo, lo_};
        }
#undef ATT_WAITV
#undef ATT_BAR
    }
    SEAM(4);

    if (IN(5)) {
        MK_PTRS;
        for (int row0 = gw; row0 < M; row0 += 2 * NGW) {
            f32x2 ml[2][3][3]; u32x2 oa[2][3][3]; u32x2 ob[2];
#pragma unroll
            for (int r = 0; r < 2; ++r) { const int row = (row0 + r * NGW) < M ? (row0 + r * NGW) : row0;
#pragma unroll
                for (int k = 0; k < 3; ++k) { const int col = 256 * k + 4 * lane, hd = col >> 6;
#pragma unroll
                    for (int p = 0; p < 3; ++p) ml[r][k][p] = __builtin_nontemporal_load((const f32x2*)(ML + (((size_t)p * M + row) * 12 + hd) * 2));
                    oa[r][k][0] = __builtin_nontemporal_load((const u32x2*)(OA0 + (size_t)row * 768 + col)); oa[r][k][1] = __builtin_nontemporal_load((const u32x2*)(OA1 + (size_t)row * 768 + col)); oa[r][k][2] = __builtin_nontemporal_load((const u32x2*)(OA2 + (size_t)row * 768 + col)); }
                ob[r] = __builtin_nontemporal_load((const u32x2*)(OB + (size_t)row * 256 + 4 * lane)); }
            float va[2][3][4], vb[2][4], ssa[2], ssb[2];
#pragma unroll
            for (int r = 0; r < 2; ++r) { ssa[r] = 0.f; ssb[r] = 0.f;
#pragma unroll
                for (int k = 0; k < 3; ++k) {
                    const float Mx = fmaxf(ml[r][k][0][0], fmaxf(ml[r][k][1][0], ml[r][k][2][0]));
                    const float w0 = ml[r][k][0][1] * __builtin_amdgcn_exp2f(ml[r][k][0][0] - Mx), w1 = ml[r][k][1][1] * __builtin_amdgcn_exp2f(ml[r][k][1][0] - Mx), w2 = ml[r][k][2][1] * __builtin_amdgcn_exp2f(ml[r][k][2][0] - Mx);
                    const float iw = 1.0f / (w0 + w1 + w2);
#pragma unroll
                    for (int e = 0; e < 4; ++e) { const unsigned s0 = oa[r][k][0][e >> 1], s1 = oa[r][k][1][e >> 1], s2 = oa[r][k][2][e >> 1];
                        const float f0 = __builtin_bit_cast(float, (e & 1) ? (s0 & 0xffff0000u) : (s0 << 16)), f1 = __builtin_bit_cast(float, (e & 1) ? (s1 & 0xffff0000u) : (s1 << 16)), f2 = __builtin_bit_cast(float, (e & 1) ? (s2 & 0xffff0000u) : (s2 << 16));
                        const float v = (w0 * f0 + w1 * f1 + w2 * f2) * iw; va[r][k][e] = v; ssa[r] += v * v; } }
#pragma unroll
                for (int e = 0; e < 4; ++e) { const unsigned s0 = ob[r][e >> 1]; vb[r][e] = __builtin_bit_cast(float, (e & 1) ? (s0 & 0xffff0000u) : (s0 << 16)); ssb[r] += vb[r][e] * vb[r][e]; } }
#pragma unroll
            for (int of = 1; of < 64; of <<= 1)
#pragma unroll
                for (int r = 0; r < 2; ++r) { ssa[r] += __shfl_xor(ssa[r], of); ssb[r] += __shfl_xor(ssb[r], of); }
#pragma unroll
            for (int r = 0; r < 2; ++r) { const int row = row0 + r * NGW; if (row < M) {
                const float ra = __builtin_amdgcn_rsqf(ssa[r] * (1.0f / 768.0f) + EPS), rb = __builtin_amdgcn_rsqf(ssb[r] * (1.0f / 256.0f) + EPS);
#pragma unroll
                for (int k = 0; k < 3; ++k) { u32x2 w; w[0] = cvt_pk_bf16(va[r][k][0] * ra, va[r][k][1] * ra); w[1] = cvt_pk_bf16(va[r][k][2] * ra, va[r][k][3] * ra); *(u32x2*)(YN + (size_t)row * D + 256 * k + 4 * lane) = w; }
                { u32x2 w; w[0] = cvt_pk_bf16(vb[r][0] * rb, vb[r][1] * rb); w[1] = cvt_pk_bf16(vb[r][2] * rb, vb[r][3] * rb); *(u32x2*)(YN + (size_t)row * D + 768 + 4 * lane) = w; } } }
        }
    }
    SEAM(5);

    if (IN(6)) {
        MK_PTRS;
        SchedStd S; S.o.init(M, D, G, bx); S.A = (const char*)YN; S.B = (const char*)Wout; S.a_tile = (size_t)256 * D * 2; S.b_tile = (size_t)256 * D * 2; S.b_batch = 0; S.ocol_mul = 256;
        EpiRes E{XB, SS2, 1.0f}; pg8::gemm_phase<EpiRes, SchedStd, true>(lds, D, D, D / 64, S, E);
    }
    SEAM(6);

    if (IN(7)) {
        MK_PTRS;
        SchedStd S; S.o.init(M, D, G, bx); S.A = (const char*)XB; S.B = (const char*)WKT; S.a_tile = (size_t)256 * D * 2; S.b_tile = (size_t)256 * D * 2; S.b_batch = (size_t)D * D * 2; S.ocol_mul = 256;
        EpiSoftmax E{PB, SS2}; pg8::gemm_phase<EpiSoftmax, SchedStd, true>(lds, D, D, D / 64, S, E);
    }
    SEAM(7);

    if (IN(8)) {
        MK_PTRS;
        SchedStd S; S.o.init(M, D, G, bx); S.A = (const char*)PB; S.B = (const char*)VWT; S.a_tile = (size_t)256 * D * 2; S.b_tile = (size_t)256 * D * 2; S.b_batch = (size_t)D * D * 2; S.ocol_mul = 256;
        EpiRes E{XB, SS3, 1.0f}; pg8::gemm_phase<EpiRes, SchedStd, true>(lds, D, D, D / 64, S, E);
    }
    SEAM(8);

    if (IN(9)) {
        MK_PTRS;
        STAGGER();
        SchedStd S; S.o.init(M, 2 * DFF, G, bx); S.A = (const char*)XB; S.B = (const char*)Wgu2; S.a_tile = (size_t)256 * D * 2; S.b_tile = (size_t)256 * D * 2; S.b_batch = 0; S.ocol_mul = 128;
        EpiGU E{HB, SS3}; pg8::gemm_phase<EpiGU, SchedStd, true>(lds, D, D, D / 64, S, E);
    }
    SEAM(9);

    if (IN(10)) {
        MK_PTRS;
        SchedStd S; S.o.init(M, D, G, bx); S.A = (const char*)HB; S.B = (const char*)Wd2; S.a_tile = (size_t)256 * DFF * 2; S.b_tile = (size_t)256 * DFF * 2; S.b_batch = 0; S.ocol_mul = 256;
        EpiRes E{XB, SS4, 0.5f}; pg8::gemm_phase<EpiRes, SchedStd, true>(lds, DFF, DFF, DFF / 64, S, E);
    }
    SEAM(10);

    if (IN(11)) {
        MK_PTRS;
        const float* gf = args.in[19];
        for (int row0 = gw; row0 < M; row0 += 4 * NGW) {
            u32x2 w[4][4]; float rs[4]; const f32x4* gr = (const f32x4*)gf + lane;
#pragma unroll
            for (int r = 0; r < 4; ++r) { const int row = (row0 + r * NGW) < M ? (row0 + r * NGW) : row0; const u32x2* xr = (const u32x2*)(XB + (size_t)row * D) + lane;
#pragma unroll
                for (int j = 0; j < 4; ++j) w[r][j] = __builtin_nontemporal_load(xr + 64 * j);
                rs[r] = row_rstd(SS4, row); }
#pragma unroll
            for (int r = 0; r < 4; ++r) { const int row = row0 + r * NGW; if (row < M) { f32x4* orow = (f32x4*)(out + (size_t)row * D) + lane;
#pragma unroll
                for (int j = 0; j < 4; ++j) { f32x4 v; v[0] = __builtin_bit_cast(float, w[r][j][0] << 16); v[1] = __builtin_bit_cast(float, w[r][j][0] & 0xffff0000u); v[2] = __builtin_bit_cast(float, w[r][j][1] << 16); v[3] = __builtin_bit_cast(float, w[r][j][1] & 0xffff0000u);
                    __builtin_nontemporal_store(v * rs[r] * gr[64 * j], orow + 64 * j); } } }
        }
    }
#undef IN
#undef SEAM
}
}


#if MK_DEBUG
namespace dbg {
__global__ void __launch_bounds__(256) cmp_f32(const float* a, const float* r, size_t n, float* acc) {
    float num = 0.f, den = 0.f;
    for (size_t i = (size_t)blockIdx.x * 256 + threadIdx.x; i < n; i += (size_t)gridDim.x * 256) { const float d = a[i] - r[i]; num += d * d; den += r[i] * r[i]; }
    for (int o = 32; o > 0; o >>= 1) { num += __shfl_xor(num, o); den += __shfl_xor(den, o); }
    if ((threadIdx.x & 63) == 0) { atomicAdd(acc, num); atomicAdd(acc + 1, den); }
}
__global__ void __launch_bounds__(256) cmp_bf16(const unsigned short* a, int lda, const float* colscale, const float* r, int ldr, int rows, int cols, float* acc) {
    float num = 0.f, den = 0.f; const size_t n = (size_t)rows * cols;
    for (size_t i = (size_t)blockIdx.x * 256 + threadIdx.x; i < n; i += (size_t)gridDim.x * 256) { const size_t row = i / cols; const int c = (int)(i % cols);
        const float av = __builtin_bit_cast(float, (unsigned)a[row * lda + c] << 16) * (colscale ? colscale[c] : 1.0f); const float rv = r[row * ldr + c]; const float d = av - rv; num += d * d; den += rv * rv; }
    for (int o = 32; o > 0; o >>= 1) { num += __shfl_xor(num, o); den += __shfl_xor(den, o); }
    if ((threadIdx.x & 63) == 0) { atomicAdd(acc, num); atomicAdd(acc + 1, den); }
}
__global__ void __launch_bounds__(256) cmp_p(const unsigned short* a, const float* r, float* acc) {
    float num = 0.f, den = 0.f; const size_t n = (size_t)4096 * 1024;
    for (size_t i = (size_t)blockIdx.x * 256 + threadIdx.x; i < n; i += (size_t)gridDim.x * 256) { const size_t row = i / 1024; const int c = (int)(i % 1024);
        const float av = __builtin_bit_cast(float, (unsigned)a[i] << 16); const float rv = r[(size_t)(c >> 8) * 4096 * 256 + row * 256 + (c & 255)]; const float d = av - rv; num += d * d; den += rv * rv; }
    for (int o = 32; o > 0; o >>= 1) { num += __shfl_xor(num, o); den += __shfl_xor(den, o); }
    if ((threadIdx.x & 63) == 0) { atomicAdd(acc, num); atomicAdd(acc + 1, den); }
}
__global__ void build_scales(float* qkvs, float* gcat, const float* goa, const float* gob) {
    const int i = blockIdx.x * 256 + threadIdx.x;
    if (i < 3072) qkvs[i] = ((i < 768) || (i >= 2304 && i < 2560)) ? 8.0f : 1.0f;
    if (i < 1024) gcat[i] = i < 768 ? goa[i] : gob[i - 768];
}
constexpr int NST = 8;
__global__ void __launch_bounds__(256) finalize(float* out, size_t n, const float* acc, int report) {
    const float tol[NST] = {0.03f, 0.03f, 1e9f  , 0.08f, 0.03f, 0.05f, 0.03f, 0.03f};
    float E = 0.f;
    if (report > 0) { const float e = sqrtf(acc[2 * (report - 1)] / acc[2 * (report - 1) + 1]); E = (e == e) ? fminf(e, 3.0f) : 3.0f; }
    else { for (int k = NST - 1; k >= 0; --k) { const float e = sqrtf(acc[2 * k] / acc[2 * k + 1]); if (!(e <= tol[k])) E = 0.1f * (k + 1); } }
    for (size_t i = (size_t)blockIdx.x * 256 + threadIdx.x; i < n; i += (size_t)gridDim.x * 256) out[i] *= (1.0f + E);
}
}
#endif

static void mk_launch(const mk::Args& a0, int lo, int hi, int grid, hipStream_t st) {
    mk::Args a = a0; a.ph_lo = lo; a.ph_hi = hi;
    hipLaunchKernelGGL(mk::mk_fwd, dim3(grid), dim3(mk::NWAVES * 64), mk::LDS_BYTES, st, a);
    const hipError_t le = hipPeekAtLastError();
    if (le != hipSuccess) fprintf(stderr, "kernel_launch: launch of phases [%d,%d) failed: %s\n", lo, hi, hipGetErrorName(le));
}

extern "C" void kernel_launch(void* const* d_in, const int* in_sizes, int n_in, void* d_out, int out_size, void* d_ws, size_t ws_size, hipStream_t stream) {
    static int grid = 0;
    if (grid == 0) {
        if (n_in != 20 || out_size != 8 * 4096 * 1024) { fprintf(stderr, "kernel_launch: unexpected shapes (n_in %d out %d)\n", n_in, out_size); grid = -1; return; }
        int dev = 0, cus = 0, per_cu = 0;
        if (hipGetDevice(&dev) != hipSuccess || hipDeviceGetAttribute(&cus, hipDeviceAttributeMultiprocessorCount, dev) != hipSuccess) { grid = -1; return; }
        if (hipFuncSetAttribute((const void*)mk::mk_fwd, hipFuncAttributeMaxDynamicSharedMemorySize, mk::LDS_BYTES) != hipSuccess) { fprintf(stderr, "kernel_launch: hipFuncSetAttribute failed\n"); grid = -1; return; }
        if (hipOccupancyMaxActiveBlocksPerMultiprocessor(&per_cu, (const void*)mk::mk_fwd, mk::NWAVES * 64, mk::LDS_BYTES) != hipSuccess || per_cu < 1) fprintf(stderr, "kernel_launch: occupancy query reports %d workgroups per CU\n", per_cu);
        (void)hipGetLastError();
        grid = cus;
    }
    if (grid < 0) return;
    unsigned char* ws = (unsigned char*)d_ws;
#if MK_DEBUG
    const size_t ref_off = (mk::WS_END + 4095) / 4096 * 4096;
    size_t off = ref_off + (size_t)290 * 1024 * 1024;
    auto take = [&](size_t bytes) { unsigned char* p = ws + off; off += (bytes + 255) / 256 * 256; return p; };
    float* sx1 = (float*)take((size_t)4096 * 1024 * 4); float* sx2 = (float*)take((size_t)4096 * 1024 * 4); float* sx3 = (float*)take((size_t)4096 * 1024 * 4);
    float* mkout = (float*)take((size_t)4096 * 1024 * 4); float* qkvs = (float*)take(3072 * 4); float* gcat = (float*)take(1024 * 4); float* acc = (float*)take(256);
    if (off > ws_size) { fprintf(stderr, "kernel_launch: debug build needs %zu bytes of workspace, got %zu\n", off, ws_size); return; }
    ref::Snap snap{sx1, sx2, sx3};
    ref::forward(d_in, (float*)d_out, ws + ref_off, stream, &snap);
    (void)hipMemsetAsync(ws + mk::WS_CTL, 0, mk::CTL_BYTES, stream);
    (void)hipMemsetAsync(acc, 0, 256, stream);
    dbg::build_scales<<<12, 256, 0, stream>>>(qkvs, gcat, (const float*)d_in[8], (const float*)d_in[9]);
    mk::Args a{};
    for (int i = 0; i < 20; ++i) a.in[i] = (const float*)d_in[i];
    a.in[0] = (const float*)d_in[0] + (size_t)7 * 4096 * 1024; a.in[1] = (const float*)d_in[1] + (size_t)7 * 256 * 1024;
    a.out = mkout; a.ws = ws;
    const ref::Bufs& rb = ref::g_bufs;
    for (int ph = 0; ph < mk::NPH; ++ph) {
        mk_launch(a, ph, ph + 1, grid, stream);
        if (ph == 1) dbg::cmp_bf16<<<512, 256, 0, stream>>>((const unsigned short*)(ws + mk::WS_KVC), 2048, nullptr, rb.kvc, 2048, 256, 2048, acc + 0);
        if (ph == 2) dbg::cmp_bf16<<<512, 256, 0, stream>>>((const unsigned short*)(ws + mk::WS_XB), 1024, nullptr, sx1, 1024, 4096, 1024, acc + 2);
        if (ph == 3) dbg::cmp_bf16<<<512, 256, 0, stream>>>((const unsigned short*)(ws + mk::WS_R1), 3072, qkvs, rb.proj, 3072, 4096, 3072, acc + 4);
        if (ph == 5) dbg::cmp_bf16<<<512, 256, 0, stream>>>((const unsigned short*)(ws + mk::WS_R1), 1024, gcat, rb.yn, 1024, 4096, 1024, acc + 6);
        if (ph == 6) dbg::cmp_bf16<<<512, 256, 0, stream>>>((const unsigned short*)(ws + mk::WS_XB), 1024, nullptr, sx2, 1024, 4096, 1024, acc + 8);
        if (ph == 7) dbg::cmp_p<<<512, 256, 0, stream>>>((const unsigned short*)(ws + mk::WS_R1), rb.sc, acc + 10);
        if (ph == 8) dbg::cmp_bf16<<<512, 256, 0, stream>>>((const unsigned short*)(ws + mk::WS_XB), 1024, nullptr, sx3, 1024, 4096, 1024, acc + 12);
        if (ph == 11) dbg::cmp_f32<<<512, 256, 0, stream>>>(mkout, (const float*)d_out + (size_t)7 * 4096 * 1024, (size_t)4096 * 1024, acc + 14);
    }
    dbg::finalize<<<1024, 256, 0, stream>>>((float*)d_out, (size_t)8 * 4096 * 1024, acc, MK_REPORT);
#else
    if (ws_size < mk::WS_END) { fprintf(stderr, "kernel_launch: needs %zu bytes of workspace, got %zu\n", (size_t)mk::WS_END, ws_size); return; }
    if (hipMemsetAsync(ws + mk::WS_CTL, 0, mk::CTL_BYTES, stream) != hipSuccess) return;
    mk::Args a{};
    for (int i = 0; i < 20; ++i) a.in[i] = (const float*)d_in[i];
    a.out = (float*)d_out; a.ws = ws;
#if MK_N_LAUNCHES == 1
    mk_launch(a, 0, mk::NPH, grid, stream);
#else
    for (int ph = 0; ph < mk::NPH; ++ph) {
        for (int r = 0; r < MK_REPEAT_N; ++r) if (ph == MK_REPEAT) { mk::Args a2 = a; a2.flags = MK_REPEAT_FLAGS; mk_launch(a2, ph, ph + 1, grid, stream); }
        mk_launch(a, ph, ph + 1, grid, stream); }
#endif
#endif
}
```

```cpp
#include <hip/hip_runtime.h>
#include <cstdio>
#include <cstdint>
#include <cmath>
#define MK_REPEAT -1
#define MK_REPEAT_N 1
#define MK_REPEAT_FLAGS 0
#define MK_STAGGER_TICKS 0
#define MK_NT_PART false
#define MK_DEBUG 0
#define MK_REPORT 0
#define MK_N_LAUNCHES 1
#define MK_NBAT 8

namespace pg8 {
#define PG8_LAS __attribute__((address_space(3)))
typedef unsigned short bf16_t;
typedef short bf16x8 __attribute__((ext_vector_type(8)));
typedef float f32x4 __attribute__((ext_vector_type(4)));
typedef float f32x2 __attribute__((ext_vector_type(2)));
typedef unsigned u32x4 __attribute__((ext_vector_type(4)));
typedef unsigned u32x2 __attribute__((ext_vector_type(2)));
constexpr int BM = 256, BK = 64, HALF = 128, HTB = HALF * BK * 2  , STAGE_BYTES = 8 * HTB, NXCD = 8, WGM = 8;

__host__ __device__ __forceinline__ int lds_byte(int r, int c) { const int st = (r >> 4) * 2 + (c >> 5), rr = r & 15, cc = c & 31, ob = rr * 64 + cc * 2; return st * 1024 + (ob ^ (((ob >> 9) & 1) << 5)); }
__host__ __device__ __forceinline__ void stage_rc(int b, int& R, int& C) { const int st = b / 1024, sb = b % 1024, swz = sb ^ (((sb >> 9) & 1) << 5); R = (st >> 1) * 16 + swz / 64; C = (st & 1) * 32 + (swz % 64) / 2; }
__host__ __device__ __forceinline__ int perm32(int rho) { const int n = rho >> 4, i = rho & 15; return 8 * (i >> 2) + 4 * n + (i & 3); }

struct Unit { const char* a; const char* b; int orow, ocol, aux; };

struct Order {
    int nM, nN, nwg, G, c;
    __device__ __forceinline__ void init(int M, int N, int G_, int c_) { nM = M / BM; nN = N / BM; nwg = nM * nN; G = G_; c = c_; }
    __device__ __forceinline__ bool tile(int i, int& pm, int& pn) const {
        const long L = (long)i * G + c; if (L >= nwg) return false;
        int wgid = (int)L; { const int q = nwg / NXCD, r = nwg % NXCD, xcd = wgid % NXCD, off = wgid / NXCD; wgid = (xcd < r ? xcd * (q + 1) : r * (q + 1) + (xcd - r) * q) + off; }
        const int nig = WGM * nN, gid = wgid / nig, fm = gid * WGM, gsz = (nM - fm) < WGM ? (nM - fm) : WGM;
        pm = fm + ((wgid % nig) % gsz); pn = (wgid % nig) / gsz; return true;
    }
};

__device__ __forceinline__ unsigned cvt_pk_bf16(float lo, float hi) { unsigned r; asm volatile("v_cvt_pk_bf16_f32 %0, %1, %2" : "=v"(r) : "v"(lo), "v"(hi)); return r; }

template <class Epi, class Sched, bool ALIGN_EPI>
__device__ __forceinline__ void gemm_phase(PG8_LAS unsigned char* lds, const int lda, const int ldb, const int nt, const Sched& S, const Epi& E) {
    int tid_ = threadIdx.x; asm volatile("" : "+v"(tid_));
    const int tid = tid_, wid = __builtin_amdgcn_readfirstlane(tid >> 6), lane = tid & 63, wr = wid >> 2, wc = wid & 3, fr = lane & 15, fq = lane >> 4;
    unsigned voffA[2], voffB[2];
#pragma unroll
    for (int i = 0; i < 2; ++i) { int R, C; stage_rc(tid * 16 + i * 8192, R, C); const int Rb = Epi::PERM ? ((R & ~31) + perm32(R & 31)) : R;
        voffA[i] = (unsigned)(R * lda + C) * 2u; voffB[i] = (unsigned)(Rb * ldb + C) * 2u; }
    const size_t kstep = (size_t)(BK * 2);
    const size_t hstepA = (size_t)HALF * lda * 2, hstepB = (size_t)HALF * ldb * 2;
    const unsigned ldsw = (unsigned)wid * 1024u;
    const int aoff = lds_byte(wr * 64 + fr, fq * 8), boff = lds_byte(wc * 32 + fr, fq * 8);
#define PG8_SA(b, h) (((b) * 2 + (h)) * HTB)
#define PG8_SB(b, h) ((4 + (b) * 2 + (h)) * HTB)
#define PG8_STAGE(bufoff, gbase, voff) do { _Pragma("unroll") for (int _i = 0; _i < 2; ++_i) \
        __builtin_amdgcn_global_load_lds((const unsigned*)((const char*)(gbase) + (voff)[_i]), (PG8_LAS unsigned*)(lds + (bufoff) + ldsw + _i * 8192), 16, 0, 0); } while (0)
#define PG8_LDA(dst, b, h) do { _Pragma("unroll") for (int m = 0; m < 4; ++m) _Pragma("unroll") for (int k = 0; k < 2; ++k) dst[m][k] = *(const PG8_LAS bf16x8*)(lds + PG8_SA(b, h) + aoff + m * 2048 + k * 1024); } while (0)
#define PG8_LDB(dst, b, h) do { _Pragma("unroll") for (int n = 0; n < 2; ++n) _Pragma("unroll") for (int k = 0; k < 2; ++k) dst[n][k] = *(const PG8_LAS bf16x8*)(lds + PG8_SB(b, h) + boff + n * 2048 + k * 1024); } while (0)
#define PG8_MMA(ai, bj, At, Bt) do { __builtin_amdgcn_s_setprio(1); _Pragma("unroll") for (int m = 0; m < 4; ++m) _Pragma("unroll") for (int n = 0; n < 2; ++n) _Pragma("unroll") for (int k = 0; k < 2; ++k) \
        acc[ai][bj][m][n] = __builtin_amdgcn_mfma_f32_16x16x32_bf16(Bt[n][k], At[m][k], acc[ai][bj][m][n], 0, 0, 0); __builtin_amdgcn_s_setprio(0); } while (0)
#define PG8_WAIT_V(n) asm volatile("s_waitcnt vmcnt(" #n ")" ::: "memory")
#define PG8_WAIT_L(n) asm volatile("s_waitcnt lgkmcnt(" #n ")" ::: "memory")
#define PG8_BAR __builtin_amdgcn_s_barrier()
#define PG8_SCHED __builtin_amdgcn_sched_barrier(0)
    Unit cur, nxt; int ui = 0;
    if (!S.next(0, cur)) return;
    f32x4 acc[2][2][4][2];
#pragma unroll
    for (int a = 0; a < 2; ++a)
#pragma unroll
        for (int b = 0; b < 2; ++b)
#pragma unroll
            for (int m = 0; m < 4; ++m)
#pragma unroll
                for (int n = 0; n < 2; ++n) acc[a][b][m][n] = (f32x4){0.f, 0.f, 0.f, 0.f};
    bf16x8 At[4][2], B0[2][2], B1[2][2];
    const char* cA = cur.a; const char* cB = cur.b;
    PG8_STAGE(PG8_SB(0, 0), cB, voffB); PG8_STAGE(PG8_SB(0, 1), cB + hstepB, voffB); PG8_STAGE(PG8_SA(0, 0), cA, voffA); PG8_STAGE(PG8_SA(0, 1), cA + hstepA, voffA);
    if (wr == 1) PG8_BAR;
    PG8_WAIT_V(2); PG8_BAR;
    PG8_STAGE(PG8_SB(1, 0), cB + kstep, voffB); PG8_STAGE(PG8_SA(1, 0), cA + kstep, voffA); PG8_STAGE(PG8_SB(1, 1), cB + hstepB + kstep, voffB);
    PG8_WAIT_V(6); PG8_BAR;
    for (;;) {
        const bool has_next = S.next(ui + 1, nxt);
        const char* nA = has_next ? nxt.a : cA; const char* nB = has_next ? nxt.b : cB;
#pragma unroll 1
        for (int t = 0; t < nt; t += 2) {
            const bool last = (t == nt - 2);
            const char* a1 = cA + (size_t)(t + 1) * kstep;
            const char* a2 = last ? nA : cA + (size_t)(t + 2) * kstep; const char* b2 = last ? nB : cB + (size_t)(t + 2) * kstep;
            const char* a3 = a2 + kstep; const char* b3 = b2 + kstep;
            PG8_LDB(B0, 0, 0); PG8_LDB(B1, 0, 1); PG8_SCHED; PG8_LDA(At, 0, 0); PG8_STAGE(PG8_SA(1, 1), a1 + hstepA, voffA);
            PG8_WAIT_V(8); PG8_WAIT_L(0); PG8_BAR; PG8_MMA(0, 0, At, B0); PG8_MMA(0, 1, At, B1); PG8_BAR; PG8_SCHED;
            PG8_LDA(At, 0, 1); PG8_STAGE(PG8_SB(0, 0), b2, voffB); PG8_STAGE(PG8_SB(0, 1), b2 + hstepB, voffB); PG8_STAGE(PG8_SA(0, 0), a2, voffA);
            PG8_WAIT_V(8); PG8_WAIT_L(0); PG8_BAR; PG8_MMA(1, 0, At, B0); PG8_MMA(1, 1, At, B1); PG8_BAR; PG8_SCHED;
            PG8_LDB(B0, 1, 0); PG8_LDB(B1, 1, 1); PG8_SCHED; PG8_LDA(At, 1, 0); PG8_STAGE(PG8_SA(0, 1), a2 + hstepA, voffA);
            PG8_WAIT_V(8); PG8_WAIT_L(0); PG8_BAR; PG8_MMA(0, 0, At, B0); PG8_MMA(0, 1, At, B1); PG8_BAR; PG8_SCHED;
            PG8_LDA(At, 1, 1); PG8_STAGE(PG8_SB(1, 0), b3, voffB); PG8_STAGE(PG8_SB(1, 1), b3 + hstepB, voffB); PG8_STAGE(PG8_SA(1, 0), a3, voffA);
            PG8_WAIT_V(8); PG8_WAIT_L(0); PG8_BAR; PG8_MMA(1, 0, At, B0); PG8_MMA(1, 1, At, B1); PG8_BAR; PG8_SCHED;
        }
        if constexpr (ALIGN_EPI) { if (wr == 0) PG8_BAR; }
        E(acc, cur, wr, wc, fr, fq, lds, wid, lane);
        if (!has_next) break;
#pragma unroll
        for (int a = 0; a < 2; ++a)
#pragma unroll
            for (int b = 0; b < 2; ++b)
#pragma unroll
                for (int m = 0; m < 4; ++m)
#pragma unroll
                    for (int n = 0; n < 2; ++n) acc[a][b][m][n] = (f32x4){0.f, 0.f, 0.f, 0.f};
        cur = nxt; cA = nA; cB = nB; ++ui;
        if constexpr (ALIGN_EPI) { if (wr == 1) PG8_BAR; }
    }
    PG8_WAIT_V(0);
    if constexpr (!ALIGN_EPI) { if (wr == 0) PG8_BAR; }
    PG8_BAR;
#undef PG8_SA
#undef PG8_SB
#undef PG8_STAGE
#undef PG8_LDA
#undef PG8_LDB
#undef PG8_MMA
#undef PG8_WAIT_V
#undef PG8_WAIT_L
#undef PG8_BAR
#undef PG8_SCHED
}
}

namespace att {
#define ATT_LAS __attribute__((address_space(3)))
typedef short bf16x8 __attribute__((ext_vector_type(8)));
typedef short v4i16 __attribute__((ext_vector_type(4)));
typedef float f32x16 __attribute__((ext_vector_type(16)));
typedef float f32x4 __attribute__((ext_vector_type(4)));
typedef unsigned u32x4 __attribute__((ext_vector_type(4)));
typedef unsigned u32x2 __attribute__((ext_vector_type(2)));
constexpr float LOG2E = 1.4426950408889634f;
constexpr int TABA_N = 192, TABB_N = 1600;

__device__ __forceinline__ int rel_bucket(int n) {
    if (n < 16) return n < 0 ? 0 : n;
    int b = 16;
    b += (n >= 22); b += (n >= 30); b += (n >= 40); b += (n >= 54); b += (n >= 73); b += (n >= 99); b += (n >= 134); b += (n >= 182);
    b += (n >= 246); b += (n >= 332); b += (n >= 450); b += (n >= 609); b += (n >= 825); b += (n >= 1117); b += (n >= 1513);
    return b;
}
__device__ __forceinline__ unsigned pk_bf16(float lo, float hi) { unsigned r; asm volatile("v_cvt_pk_bf16_f32 %0, %1, %2" : "=v"(r) : "v"(lo), "v"(hi)); return r; }
__device__ __forceinline__ float bf16_round(float x) { unsigned u = __builtin_bit_cast(unsigned, x); u = (u + 0x7fffu + ((u >> 16) & 1u)) & 0xffff0000u; return __builtin_bit_cast(float, u); }

__device__ __forceinline__ void glds16(const void* gsrc, unsigned lds_dst) { unsigned keep;
    asm volatile("s_mov_b32 %0, m0\n\ts_mov_b32 m0, %2\n\ts_nop 0\n\tglobal_load_lds_dwordx4 %1, off\n\ts_mov_b32 m0, %0" : "=&s"(keep) : "v"(gsrc), "s"(lds_dst) : "memory"); }
__device__ __forceinline__ void dma_rows8(const char* krow0  , const int voff, const int row  ,
                                          ATT_LAS char* kdst  , ATT_LAS char* vdst, const int lane) {
    const int pc = lane & 7;
    glds16(krow0 + 16 * (pc ^ ((row >> 1) & 7)), (unsigned)__builtin_amdgcn_readfirstlane((int)(unsigned)(uintptr_t)kdst));
    glds16(krow0 + voff + 16 * (pc ^ (((row >> 1) & 1) << 2)), (unsigned)__builtin_amdgcn_readfirstlane((int)(unsigned)(uintptr_t)vdst));
}

__device__ __forceinline__ void attn_group(const bf16x8 (&qf)[4], f32x16 (&o)[2], float& m, float& l, const ATT_LAS char* kg, const ATT_LAS char* vg, const ATT_LAS float* tp, const int lane) {
    const int q = lane & 31, h = lane >> 5;
    const ATT_LAS char* kr0 = kg + q * 128; const int kswz = (q >> 1) & 7;
    typedef float f32x2_ __attribute__((ext_vector_type(2)));
    f32x2_ t0, t1, t2, t3, t4, t5, t6, t7;
    { const unsigned ta = (unsigned)(uintptr_t)(tp - 27);
      asm volatile("ds_read2_b32 %0, %8 offset0:27 offset1:26\n\tds_read2_b32 %1, %8 offset0:25 offset1:24\n\tds_read2_b32 %2, %8 offset0:19 offset1:18\n\tds_read2_b32 %3, %8 offset0:17 offset1:16\n\t"
                   "ds_read2_b32 %4, %8 offset0:11 offset1:10\n\tds_read2_b32 %5, %8 offset0:9 offset1:8\n\tds_read2_b32 %6, %8 offset0:3 offset1:2\n\tds_read2_b32 %7, %8 offset0:1 offset1:0"
                   : "=&v"(t0), "=&v"(t1), "=&v"(t2), "=&v"(t3), "=&v"(t4), "=&v"(t5), "=&v"(t6), "=&v"(t7) : "v"(ta) : "memory"); }
    const int q4 = (lane & 15) >> 2, p4 = lane & 3, g1 = (lane >> 4) & 1, vsw = (q4 >> 1) & 1;
    const unsigned va0_ = (unsigned)(uintptr_t)(vg + (4 * h + q4) * 128 + 32 * g1 + 8 * p4 + 64 * vsw), va1_ = (unsigned)(uintptr_t)(vg + (4 * h + q4) * 128 + 32 * g1 + 8 * p4 + 64 * (1 ^ vsw));
    v4i16 a[2][4];
    asm volatile("ds_read_b64_tr_b16 %0, %8\n\tds_read_b64_tr_b16 %1, %8 offset:1024\n\tds_read_b64_tr_b16 %2, %8 offset:2048\n\tds_read_b64_tr_b16 %3, %8 offset:3072\n\t"
                 "ds_read_b64_tr_b16 %4, %9\n\tds_read_b64_tr_b16 %5, %9 offset:1024\n\tds_read_b64_tr_b16 %6, %9 offset:2048\n\tds_read_b64_tr_b16 %7, %9 offset:3072"
                 : "=&v"(a[0][0]), "=&v"(a[0][1]), "=&v"(a[0][2]), "=&v"(a[0][3]), "=&v"(a[1][0]), "=&v"(a[1][1]), "=&v"(a[1][2]), "=&v"(a[1][3]) : "v"(va0_), "v"(va1_) : "memory");
    f32x16 s = f32x16{};
#pragma unroll
    for (int d0 = 0; d0 < 4; ++d0) { const bf16x8 kf = *(const ATT_LAS bf16x8*)(kr0 + 16 * ((2 * d0 + h) ^ kswz)); s = __builtin_amdgcn_mfma_f32_32x32x16_bf16(kf, qf[d0], s, 0, 0, 0); }
    asm volatile("s_waitcnt lgkmcnt(0)" : "+v"(t0), "+v"(t1), "+v"(t2), "+v"(t3), "+v"(t4), "+v"(t5), "+v"(t6), "+v"(t7), "+v"(a[0][0]), "+v"(a[0][1]), "+v"(a[0][2]), "+v"(a[0][3]), "+v"(a[1][0]), "+v"(a[1][1]), "+v"(a[1][2]), "+v"(a[1][3]) :: "memory");
    float mx = -INFINITY;
    { const float tb_[16] = {t0[0], t0[1], t1[0], t1[1], t2[0], t2[1], t3[0], t3[1], t4[0], t4[1], t5[0], t5[1], t6[0], t6[1], t7[0], t7[1]};
#pragma unroll
      for (int r = 0; r < 16; ++r) s[r] = fmaf(s[r], LOG2E, tb_[r]); }
#pragma unroll
    for (int r = 0; r < 16; r += 2) mx = fmaxf(mx, fmaxf(s[r], s[r + 1]));
    mx = fmaxf(mx, __shfl_xor(mx, 32));
    if (__any(mx > m)) {
        const float mnew = fmaxf(m, mx), alpha = __builtin_amdgcn_exp2f(m - mnew);
        l *= alpha; m = mnew;
#pragma unroll
        for (int r = 0; r < 16; ++r) { o[0][r] *= alpha; o[1][r] *= alpha; }
    }
    float ps = 0.f;
#pragma unroll
    for (int r = 0; r < 16; ++r) { s[r] = __builtin_amdgcn_exp2f(s[r] - m); ps += s[r]; }
    l += ps;
    u32x4 pw0, pw1;
    pw0[0] = pk_bf16(s[0], s[1]); pw0[1] = pk_bf16(s[2], s[3]); pw0[2] = pk_bf16(s[4], s[5]); pw0[3] = pk_bf16(s[6], s[7]);
    pw1[0] = pk_bf16(s[8], s[9]); pw1[1] = pk_bf16(s[10], s[11]); pw1[2] = pk_bf16(s[12], s[13]); pw1[3] = pk_bf16(s[14], s[15]);
    const bf16x8 pb0 = __builtin_bit_cast(bf16x8, pw0), pb1 = __builtin_bit_cast(bf16x8, pw1);
#pragma unroll
    for (int dh = 0; dh < 2; ++dh) {
        const bf16x8 va0 = (bf16x8){a[dh][0][0], a[dh][0][1], a[dh][0][2], a[dh][0][3], a[dh][1][0], a[dh][1][1], a[dh][1][2], a[dh][1][3]};
        const bf16x8 va1 = (bf16x8){a[dh][2][0], a[dh][2][1], a[dh][2][2], a[dh][2][3], a[dh][3][0], a[dh][3][1], a[dh][3][2], a[dh][3][3]};
        o[dh] = __builtin_amdgcn_mfma_f32_32x32x16_bf16(va0, pb0, o[dh], 0, 0, 0);
        o[dh] = __builtin_amdgcn_mfma_f32_32x32x16_bf16(va1, pb1, o[dh], 0, 0, 0);
    }
}

__device__ __forceinline__ void dma_k_rows8(const char* krow, const int row, ATT_LAS char* kdst, const int lane) {
    glds16(krow + 16 * ((lane & 7) ^ ((row >> 1) & 7)), (unsigned)__builtin_amdgcn_readfirstlane((int)(unsigned)(uintptr_t)kdst)); }
__device__ __forceinline__ void dma_v_rows8(const char* vrow, const int row, ATT_LAS char* vdst, const int lane) {
    glds16(vrow + 16 * ((lane & 7) ^ (((row >> 1) & 1) << 2)), (unsigned)__builtin_amdgcn_readfirstlane((int)(unsigned)(uintptr_t)vdst)); }
__device__ __forceinline__ void dil_pass1(const bf16x8 (&qf)[4], const int ng, const ATT_LAS char* kimg0  , const ATT_LAS float* tp0  ,
                                          u32x4 (&pw)[5][2], float& m_out, float& l_out, const int lane) {
    const int q = lane & 31, h = lane >> 5, kswz = (q >> 1) & 7;
    typedef float f32x2_ __attribute__((ext_vector_type(2)));
    f32x16 s[5]; float mx = -INFINITY;
#pragma unroll
    for (int g = 0; g < 5; ++g) if (g < ng) {
        f32x2_ t0, t1, t2, t3, t4, t5, t6, t7;
        { const unsigned ta = (unsigned)(uintptr_t)(tp0 + 32 * g - 27);
          asm volatile("ds_read2_b32 %0, %8 offset0:27 offset1:26\n\tds_read2_b32 %1, %8 offset0:25 offset1:24\n\tds_read2_b32 %2, %8 offset0:19 offset1:18\n\tds_read2_b32 %3, %8 offset0:17 offset1:16\n\t"
                       "ds_read2_b32 %4, %8 offset0:11 offset1:10\n\tds_read2_b32 %5, %8 offset0:9 offset1:8\n\tds_read2_b32 %6, %8 offset0:3 offset1:2\n\tds_read2_b32 %7, %8 offset0:1 offset1:0"
                       : "=&v"(t0), "=&v"(t1), "=&v"(t2), "=&v"(t3), "=&v"(t4), "=&v"(t5), "=&v"(t6), "=&v"(t7) : "v"(ta) : "memory"); }
        const ATT_LAS char* kr0 = kimg0 - g * 4096 + q * 128;
        f32x16 sg = f32x16{};
#pragma unroll
        for (int d0 = 0; d0 < 4; ++d0) { const bf16x8 kf = *(const ATT_LAS bf16x8*)(kr0 + 16 * ((2 * d0 + h) ^ kswz)); sg = __builtin_amdgcn_mfma_f32_32x32x16_bf16(kf, qf[d0], sg, 0, 0, 0); }
        asm volatile("s_waitcnt lgkmcnt(0)" : "+v"(t0), "+v"(t1), "+v"(t2), "+v"(t3), "+v"(t4), "+v"(t5), "+v"(t6), "+v"(t7) :: "memory");
        const float tb_[16] = {t0[0], t0[1], t1[0], t1[1], t2[0], t2[1], t3[0], t3[1], t4[0], t4[1], t5[0], t5[1], t6[0], t6[1], t7[0], t7[1]};
#pragma unroll
        for (int r = 0; r < 16; ++r) sg[r] = fmaf(sg[r], LOG2E, tb_[r]);
#pragma unroll
        for (int r = 0; r < 16; r += 2) mx = fmaxf(mx, fmaxf(sg[r], sg[r + 1]));
        s[g] = sg;
    }
    mx = fmaxf(mx, __shfl_xor(mx, 32));
    float ps = 0.f;
#pragma unroll
    for (int g = 0; g < 5; ++g) if (g < ng) {
        f32x16 p = s[g];
#pragma unroll
        for (int r = 0; r < 16; ++r) { p[r] = __builtin_amdgcn_exp2f(p[r] - mx); ps += p[r]; }
        pw[g][0][0] = pk_bf16(p[0], p[1]); pw[g][0][1] = pk_bf16(p[2], p[3]); pw[g][0][2] = pk_bf16(p[4], p[5]); pw[g][0][3] = pk_bf16(p[6], p[7]);
        pw[g][1][0] = pk_bf16(p[8], p[9]); pw[g][1][1] = pk_bf16(p[10], p[11]); pw[g][1][2] = pk_bf16(p[12], p[13]); pw[g][1][3] = pk_bf16(p[14], p[15]);
    }
    ps += __shfl_xor(ps, 32);
    m_out = mx; l_out = ps;
}
__device__ __forceinline__ void dil_pass2(const int ng, const ATT_LAS char* vimg0  , const u32x4 (&pw)[5][2], f32x16 (&o)[2], const int lane) {
    const int h = lane >> 5, q4 = (lane & 15) >> 2, p4 = lane & 3, g1 = (lane >> 4) & 1, vsw = (q4 >> 1) & 1;
    o[0] = f32x16{}; o[1] = f32x16{};
#pragma unroll
    for (int g = 0; g < 5; ++g) if (g < ng) {
        const ATT_LAS char* vg = vimg0 - g * 4096;
        const unsigned va0_ = (unsigned)(uintptr_t)(vg + (4 * h + q4) * 128 + 32 * g1 + 8 * p4 + 64 * vsw), va1_ = (unsigned)(uintptr_t)(vg + (4 * h + q4) * 128 + 32 * g1 + 8 * p4 + 64 * (1 ^ vsw));
        v4i16 a[2][4];
        asm volatile("ds_read_b64_tr_b16 %0, %8\n\tds_read_b64_tr_b16 %1, %8 offset:1024\n\tds_read_b64_tr_b16 %2, %8 offset:2048\n\tds_read_b64_tr_b16 %3, %8 offset:3072\n\t"
                     "ds_read_b64_tr_b16 %4, %9\n\tds_read_b64_tr_b16 %5, %9 offset:1024\n\tds_read_b64_tr_b16 %6, %9 offset:2048\n\tds_read_b64_tr_b16 %7, %9 offset:3072\n\ts_waitcnt lgkmcnt(0)"
                     : "=&v"(a[0][0]), "=&v"(a[0][1]), "=&v"(a[0][2]), "=&v"(a[0][3]), "=&v"(a[1][0]), "=&v"(a[1][1]), "=&v"(a[1][2]), "=&v"(a[1][3]) : "v"(va0_), "v"(va1_) : "memory");
        const bf16x8 pb0 = __builtin_bit_cast(bf16x8, pw[g][0]), pb1 = __builtin_bit_cast(bf16x8, pw[g][1]);
#pragma unroll
        for (int dh = 0; dh < 2; ++dh) {
            const bf16x8 va0 = (bf16x8){a[dh][0][0], a[dh][0][1], a[dh][0][2], a[dh][0][3], a[dh][1][0], a[dh][1][1], a[dh][1][2], a[dh][1][3]};
            const bf16x8 va1 = (bf16x8){a[dh][2][0], a[dh][2][1], a[dh][2][2], a[dh][2][3], a[dh][3][0], a[dh][3][1], a[dh][3][2], a[dh][3][3]};
            o[dh] = __builtin_amdgcn_mfma_f32_32x32x16_bf16(va0, pb0, o[dh], 0, 0, 0);
            o[dh] = __builtin_amdgcn_mfma_f32_32x32x16_bf16(va1, pb1, o[dh], 0, 0, 0);
        }
    }
}

template <bool NT>
__device__ __forceinline__ void store_o(const f32x16 (&o)[2], const float l, char* orow_q, const int h) {
    const float il = 1.0f / l;
#pragma unroll
    for (int dh = 0; dh < 2; ++dh)
#pragma unroll
        for (int jj = 0; jj < 2; ++jj) {
            u32x2 we, wo;
            we[0] = pk_bf16(o[dh][8 * jj] * il, o[dh][8 * jj + 1] * il); we[1] = pk_bf16(o[dh][8 * jj + 2] * il, o[dh][8 * jj + 3] * il);
            wo[0] = pk_bf16(o[dh][8 * jj + 4] * il, o[dh][8 * jj + 5] * il); wo[1] = pk_bf16(o[dh][8 * jj + 6] * il, o[dh][8 * jj + 7] * il);
            const unsigned s0 = h ? we[0] : wo[0], s1 = h ? we[1] : wo[1];
            const unsigned r0 = (unsigned)__shfl_xor((int)s0, 32), r1 = (unsigned)__shfl_xor((int)s1, 32);
            u32x4 w; if (h == 0) { w[0] = we[0]; w[1] = we[1]; w[2] = r0; w[3] = r1; } else { w[0] = r0; w[1] = r1; w[2] = wo[0]; w[3] = wo[1]; }
            u32x4* dst = (u32x4*)(orow_q + (32 * dh + 16 * jj + 8 * h) * 2);
            if (NT) __builtin_nontemporal_store(w, dst); else *dst = w;
        }
}

__device__ __forceinline__ unsigned moba_select(const char* qbase, const long qs, const float* km, const int qb) {
    const int lane = threadIdx.x & 63, q = lane & 31, h = lane >> 5;
    f32x16 g = f32x16{};
    const float* kmrow = km + (size_t)(q & 15) * 256;
    const bool lo_part = q >= 16;
#pragma unroll
    for (int d0 = 0; d0 < 4; ++d0) {
        const bf16x8 qf = *(const bf16x8*)(qbase + (long)q * qs + (16 * d0 + 8 * h) * 2);
        const f32x4 f0 = *(const f32x4*)(kmrow + 16 * d0 + 8 * h), f1 = *(const f32x4*)(kmrow + 16 * d0 + 8 * h + 4);
        float v[8] = {f0[0], f0[1], f0[2], f0[3], f1[0], f1[1], f1[2], f1[3]};
        u32x4 aw;
#pragma unroll
        for (int j = 0; j < 4; ++j) {
            const float h0 = bf16_round(v[2 * j]), h1 = bf16_round(v[2 * j + 1]);
            const float x0 = lo_part ? (v[2 * j] - h0) : h0, x1 = lo_part ? (v[2 * j + 1] - h1) : h1;
            aw[j] = pk_bf16(x0, x1);
        }
        g = __builtin_amdgcn_mfma_f32_32x32x16_bf16(__builtin_bit_cast(bf16x8, aw), qf, g, 0, 0, 0);
    }
    float gate[8], other[8];
#pragma unroll
    for (int r = 0; r < 8; ++r) { gate[r] = g[r] + g[r + 8]; }
#pragma unroll
    for (int r = 0; r < 8; ++r) { other[r] = __shfl_xor(gate[r], 32); }
    unsigned mymask = 0u;
#pragma unroll
    for (int r = 0; r < 8; ++r) {
        const int n = (r & 3) + 8 * (r >> 2) + 4 * h;
        int rank = 0;
#pragma unroll
        for (int r2 = 0; r2 < 8; ++r2) {
            const int n2 = (r2 & 3) + 8 * (r2 >> 2) + 4 * h, n3 = (r2 & 3) + 8 * (r2 >> 2) + 4 * (1 - h);
            if (r2 != r) rank += (n2 < qb && (gate[r2] > gate[r] || (gate[r2] == gate[r] && n2 < n))) ? 1 : 0;
            rank += (n3 < qb && (other[r2] > gate[r] || (other[r2] == gate[r] && n3 < n))) ? 1 : 0;
        }
        if (n < qb && rank < 3) mymask |= 1u << n;
    }
    return mymask | (unsigned)__shfl_xor((int)mymask, 32);
}
}


namespace mk {
using pg8::bf16_t; using pg8::bf16x8; using pg8::f32x4; using pg8::f32x2; using pg8::u32x4; using pg8::u32x2; using pg8::Unit; using pg8::cvt_pk_bf16;
#define LAS __attribute__((address_space(3)))
constexpr int NBAT = MK_NBAT, SEQ = 4096, D = 1024, DFF = 2816, NMEM = 256, M = NBAT * SEQ, MM = NBAT * NMEM, NQKV = 3072;
constexpr float EPS = 1e-6f, LOG2E = 1.4426950408889634f;
constexpr int NWAVES = 8, NPH = 12;

constexpr size_t al256(size_t x) { return (x + 255) / 256 * 256; }
constexpr size_t WS_CTL = 0, CTL_BYTES = 1u << 20;
constexpr size_t WS_WGU1 = WS_CTL + CTL_BYTES;
constexpr size_t WS_WD1 = WS_WGU1 + (size_t)2 * DFF * D * 2;
constexpr size_t WS_WIN = WS_WD1 + (size_t)D * DFF * 2;
constexpr size_t WS_WOUT = WS_WIN + (size_t)NQKV * D * 2;
constexpr size_t WS_WCQS = WS_WOUT + (size_t)D * D * 2;
constexpr size_t WS_WCKV = WS_WCQS + (size_t)D * D * 2;
constexpr size_t WS_WCO = WS_WCKV + (size_t)2 * D * D * 2;
constexpr size_t WS_WGU2 = WS_WCO + (size_t)D * D * 2;
constexpr size_t WS_WD2 = WS_WGU2 + (size_t)2 * DFF * D * 2;
constexpr size_t WS_MB = WS_WD2 + (size_t)D * DFF * 2;
constexpr size_t WS_KVC = WS_MB + (size_t)MM * D * 2;
constexpr size_t WS_WKT = WS_KVC + (size_t)MM * 2 * D * 2;
constexpr size_t WS_VWT = WS_WKT + (size_t)NBAT * D * D * 2;
constexpr size_t SS_BYTES = (size_t)M * 16 * 4;
constexpr size_t WS_SS = WS_VWT + (size_t)NBAT * D * D * 2;
constexpr size_t WS_SSM = WS_SS + 5 * SS_BYTES;
constexpr size_t WS_KM = WS_SSM + (size_t)MM * 16 * 4;
constexpr size_t WS_R1 = al256(WS_KM + (size_t)NBAT * 16 * 256 * 4);
constexpr size_t WS_XB = WS_R1 + (size_t)M * NQKV * 2;
constexpr size_t WS_OA2 = WS_XB + (size_t)M * D * 2;
constexpr size_t WS_END = WS_OA2 + (size_t)M * 768 * 2;
constexpr size_t OUT_OA1 = (size_t)M * 768 * 2, OUT_OB = 2 * OUT_OA1, OUT_ML = OUT_OB + (size_t)M * 256 * 2;
static_assert(OUT_ML + (size_t)3 * M * 12 * 8 <= (size_t)M * D * 4, "attention partials fit in d_out");
constexpr int CW_BAR = 4096;

constexpr int LDS_XCH = 131072;
constexpr int LDS_MISC = 131072 + 8192;
constexpr int LDS_BYTES = 147456;
constexpr int LDS_TAB = 98304;
static_assert(LDS_TAB + 36 * att::TABA_N * 4 <= LDS_XCH && LDS_TAB + 4 * att::TABB_N * 4 <= LDS_XCH, "attention LDS map");

__device__ __forceinline__ float wave_sum(float v) {
#pragma unroll
    for (int o = 1; o < 64; o <<= 1) v += __shfl_xor(v, o);
    return v;
}
__device__ __forceinline__ float row_rstd(const float* ss, int row) {
    const f32x4* p = (const f32x4*)(ss + (size_t)row * 16);
    const f32x4 a = p[0], b = p[1], c = p[2], d = p[3];
    const float s = ((a[0] + a[1]) + (a[2] + a[3])) + ((b[0] + b[1]) + (b[2] + b[3])) + ((c[0] + c[1]) + (c[2] + c[3])) + ((d[0] + d[1]) + (d[2] + d[3]));
    return 1.0f / sqrtf(s * (1.0f / D) + EPS);
}

struct SchedStd {
    pg8::Order o; const char* A; const char* B; size_t a_tile, b_tile, b_batch; int ocol_mul;
    __device__ __forceinline__ bool next(int i, Unit& u) const { int pm, pn; if (!o.tile(i, pm, pn)) return false;
        u.a = A + (size_t)pm * a_tile; u.b = B + (size_t)pn * b_tile + (size_t)(pm >> 4) * b_batch; u.orow = pm * 256; u.ocol = pn * ocol_mul; u.aux = pn; return true; }
};
struct SchedWK {
    int G, c; const char* kvc; const char* wcqs;
    __device__ __forceinline__ bool next(int i, Unit& u) const { const int L = i * G + c; if (L >= NBAT * 16) return false; const int bh = L >> 2, pn = L & 3, b = bh >> 2, h = bh & 3;
        u.a = kvc + ((size_t)(b * 256) * 2048 + h * 256) * 2; u.b = wcqs + ((size_t)(pn * 256) * 1024 + h * 256) * 2; u.orow = b * 1024 + h * 256; u.ocol = pn * 256; u.aux = 0; return true; }
};
struct SchedVW {
    int G, c; const char* kvc; const char* wcot;
    __device__ __forceinline__ bool next(int i, Unit& u) const { const int L = i * G + c; if (L >= NBAT * 16) return false; const int bh = L >> 2, pm = L & 3, b = bh >> 2, h = bh & 3;
        u.a = wcot + ((size_t)(pm * 256) * 1024 + h * 256) * 2; u.b = kvc + ((size_t)(b * 256) * 2048 + 1024 + h * 256) * 2; u.orow = b * 1024 + pm * 256; u.ocol = h * 256; u.aux = 0; return true; }
};

struct EpiGU { static constexpr bool PERM = true;
    bf16_t* H; const float* ss;
    __device__ __forceinline__ void operator()(const f32x4 (&acc)[2][2][4][2], const Unit& u, int wr, int wc, int fr, int fq, LAS unsigned char*, int, int) const {
        float rsv[2][4];
#pragma unroll
        for (int ai = 0; ai < 2; ++ai)
#pragma unroll
            for (int m = 0; m < 4; ++m) rsv[ai][m] = row_rstd(ss, u.orow + ai * 128 + wr * 64 + m * 16 + fr);
#pragma unroll
        for (int ai = 0; ai < 2; ++ai)
#pragma unroll
            for (int m = 0; m < 4; ++m) { const int row = u.orow + ai * 128 + wr * 64 + m * 16 + fr; const float rs = rsv[ai][m];
                float hv[8];
#pragma unroll
                for (int n = 0; n < 2; ++n)
#pragma unroll
                    for (int j = 0; j < 4; ++j) { const float g = acc[ai][0][m][n][j] * rs, uu = acc[ai][1][m][n][j] * rs;
                        hv[4 * n + j] = g * __builtin_amdgcn_rcpf(1.0f + __builtin_amdgcn_exp2f(-g * LOG2E)) * uu; }
                u32x4 w; w[0] = cvt_pk_bf16(hv[0], hv[1]); w[1] = cvt_pk_bf16(hv[2], hv[3]); w[2] = cvt_pk_bf16(hv[4], hv[5]); w[3] = cvt_pk_bf16(hv[6], hv[7]);
                __builtin_nontemporal_store(w, (u32x4*)(H + (size_t)row * DFF + u.ocol + wc * 32 + 8 * fq)); }
    }
};
struct EpiRes { static constexpr bool PERM = true;
    bf16_t* xb; float* ssout; float alpha;
    __device__ __forceinline__ void operator()(const f32x4 (&acc)[2][2][4][2], const Unit& u, int wr, int wc, int fr, int fq, LAS unsigned char*, int, int) const {
        const size_t off0 = (size_t)(u.orow + wr * 64 + fr) * D + u.ocol + wc * 32 + 8 * fq;
        u32x4 cur[2], nxt[2];
#pragma unroll
        for (int bj = 0; bj < 2; ++bj) cur[bj] = *(const u32x4*)(xb + off0 + bj * 128);
#pragma unroll
        for (int idx = 0; idx < 8; ++idx) { const int ai = idx >> 2, m = idx & 3; const size_t off = off0 + (size_t)(ai * 128 + m * 16) * D; const int row = u.orow + ai * 128 + wr * 64 + m * 16 + fr;
            if (idx < 7) { const size_t offn = off0 + (size_t)(((idx + 1) >> 2) * 128 + ((idx + 1) & 3) * 16) * D;
#pragma unroll
                for (int bj = 0; bj < 2; ++bj) nxt[bj] = *(const u32x4*)(xb + offn + bj * 128); }
            float sq = 0.f;
#pragma unroll
            for (int bj = 0; bj < 2; ++bj) { float o[8];
#pragma unroll
                for (int n = 0; n < 2; ++n)
#pragma unroll
                    for (int j = 0; j < 4; ++j) { const unsigned wv = cur[bj][2 * n + (j >> 1)]; const float r = __builtin_bit_cast(float, (j & 1) ? (wv & 0xffff0000u) : (wv << 16));
                        const float v = r + acc[ai][bj][m][n][j] * alpha; o[4 * n + j] = v; sq += v * v; }
                u32x4 w; w[0] = cvt_pk_bf16(o[0], o[1]); w[1] = cvt_pk_bf16(o[2], o[3]); w[2] = cvt_pk_bf16(o[4], o[5]); w[3] = cvt_pk_bf16(o[6], o[7]);
                *(u32x4*)(xb + off + bj * 128) = w; }
            sq += __shfl_xor(sq, 16); sq += __shfl_xor(sq, 32);
            if (fq == 0) ssout[(size_t)row * 16 + (u.ocol >> 8) * 4 + wc] = sq;
#pragma unroll
            for (int bj = 0; bj < 2; ++bj) cur[bj] = nxt[bj]; }
    }
};
struct EpiStore { static constexpr bool PERM = true;
    bf16_t* O; int ldc; const float* ss; float* km; bool nt;
    __device__ __forceinline__ void operator()(const f32x4 (&acc)[2][2][4][2], const Unit& u, int wr, int wc, int fr, int fq, LAS unsigned char*, int, int) const {
        float rsv[2][4];
#pragma unroll
        for (int ai = 0; ai < 2; ++ai)
#pragma unroll
            for (int m = 0; m < 4; ++m) rsv[ai][m] = ss ? row_rstd(ss, u.orow + ai * 128 + wr * 64 + m * 16 + fr) : 1.0f;
#pragma unroll
        for (int ai = 0; ai < 2; ++ai)
#pragma unroll
            for (int m = 0; m < 4; ++m) { const int row = u.orow + ai * 128 + wr * 64 + m * 16 + fr; const float rs = rsv[ai][m];
                const int col0 = u.ocol + wc * 32 + 8 * fq;
                bf16_t* rowp = ldc ? O + (size_t)row * ldc + col0 : O + (((size_t)(row / SEQ) * (NQKV / 64) + (col0 >> 6)) * SEQ + (row % SEQ)) * 64 + (col0 & 63);
                const size_t bjstep = ldc ? 128 : (size_t)2 * SEQ * 64;
#pragma unroll
                for (int bj = 0; bj < 2; ++bj) { const f32x4 v0 = acc[ai][bj][m][0] * rs, v1 = acc[ai][bj][m][1] * rs;
                    u32x4 w; w[0] = cvt_pk_bf16(v0[0], v0[1]); w[1] = cvt_pk_bf16(v0[2], v0[3]); w[2] = cvt_pk_bf16(v1[0], v1[1]); w[3] = cvt_pk_bf16(v1[2], v1[3]);
                    if (nt) __builtin_nontemporal_store(w, (u32x4*)(rowp + bj * bjstep)); else *(u32x4*)(rowp + bj * bjstep) = w; } }
        if ((km != nullptr) && (u.aux == 10)) {
            float* kmb = km + (size_t)(u.orow >> 8) * 256 + wc * 32 + 8 * fq;
#pragma unroll
            for (int bj = 0; bj < 2; ++bj)
#pragma unroll
                for (int n = 0; n < 2; ++n) { f32x4 cs = (f32x4){0.f, 0.f, 0.f, 0.f};
#pragma unroll
                    for (int ai = 0; ai < 2; ++ai)
#pragma unroll
                        for (int m = 0; m < 4; ++m) cs += acc[ai][bj][m][n] * rsv[ai][m];
#pragma unroll
                    for (int j = 0; j < 4; ++j) { float v = cs[j]; v += __shfl_xor(v, 1); v += __shfl_xor(v, 2); v += __shfl_xor(v, 4); v += __shfl_xor(v, 8);
                        if (fr == 0) atomicAdd(kmb + bj * 128 + 4 * n + j, v); } }
        }
    }
};
struct EpiSoftmax { static constexpr bool PERM = true;
    bf16_t* P; const float* ss;
    __device__ __forceinline__ void operator()(const f32x4 (&acc)[2][2][4][2], const Unit& u, int wr, int wc, int fr, int fq, LAS unsigned char* lds, int, int) const {
        LAS f32x2* X = (LAS f32x2*)(lds + LDS_XCH);
        float rsl[2][4], mw[2][4];
#pragma unroll
        for (int ai = 0; ai < 2; ++ai)
#pragma unroll
            for (int m = 0; m < 4; ++m) { const int rl = ai * 128 + wr * 64 + m * 16 + fr; const float rs = row_rstd(ss, u.orow + rl) * LOG2E; rsl[ai][m] = rs;
                float mx = -INFINITY;
#pragma unroll
                for (int bj = 0; bj < 2; ++bj)
#pragma unroll
                    for (int n = 0; n < 2; ++n)
#pragma unroll
                        for (int j = 0; j < 4; ++j) mx = fmaxf(mx, acc[ai][bj][m][n][j] * rs);
                mx = fmaxf(mx, __shfl_xor(mx, 16)); mx = fmaxf(mx, __shfl_xor(mx, 32));
                float sm = 0.f;
#pragma unroll
                for (int bj = 0; bj < 2; ++bj)
#pragma unroll
                    for (int n = 0; n < 2; ++n)
#pragma unroll
                        for (int j = 0; j < 4; ++j) sm += __builtin_amdgcn_exp2f(acc[ai][bj][m][n][j] * rs - mx);
                sm += __shfl_xor(sm, 16); sm += __shfl_xor(sm, 32);
                mw[ai][m] = mx;
                if (fq == 0) X[rl * 4 + wc] = (f32x2){mx, sm}; }
        asm volatile("s_waitcnt lgkmcnt(0)" ::: "memory"); __builtin_amdgcn_s_barrier(); asm volatile("" ::: "memory");
#pragma unroll
        for (int ai = 0; ai < 2; ++ai)
#pragma unroll
            for (int m = 0; m < 4; ++m) { const int rl = ai * 128 + wr * 64 + m * 16 + fr; const float rs = rsl[ai][m];
                const f32x2 x0 = X[rl * 4 + 0], x1 = X[rl * 4 + 1], x2 = X[rl * 4 + 2], x3 = X[rl * 4 + 3];
                const float Mx = fmaxf(fmaxf(x0[0], x1[0]), fmaxf(x2[0], x3[0]));
                const float L = x0[1] * __builtin_amdgcn_exp2f(x0[0] - Mx) + x1[1] * __builtin_amdgcn_exp2f(x1[0] - Mx) + x2[1] * __builtin_amdgcn_exp2f(x2[0] - Mx) + x3[1] * __builtin_amdgcn_exp2f(x3[0] - Mx);
                const float il = 1.0f / L;
                bf16_t* rowp = P + (size_t)(u.orow + rl) * D + u.ocol + wc * 32 + 8 * fq;
#pragma unroll
                for (int bj = 0; bj < 2; ++bj) { float pv[8];
#pragma unroll
                    for (int n = 0; n < 2; ++n)
#pragma unroll
                        for (int j = 0; j < 4; ++j) pv[4 * n + j] = __builtin_amdgcn_exp2f(acc[ai][bj][m][n][j] * rs - Mx) * il;
                    u32x4 w; w[0] = cvt_pk_bf16(pv[0], pv[1]); w[1] = cvt_pk_bf16(pv[2], pv[3]); w[2] = cvt_pk_bf16(pv[4], pv[5]); w[3] = cvt_pk_bf16(pv[6], pv[7]);
                    *(u32x4*)(rowp + bj * 128) = w; } }
        (void)mw;
    }
};

#define XB_TMO      128
#define XB_XCNT(j)  (256  + 64 * (j))
#define XB_XSUB(j)  (1280 + 64 * (j))
#define XB_XGEN(j)  (2304 + 64 * (j))
#define XB_TOP      3328
#define XB_TOPGEN   3392
#define XCD_BAR_WORDS 3456
#define XB_SPIN_CAP (1u << 18)
__device__ __forceinline__ unsigned xb_ld(unsigned* p)              { return __hip_atomic_load(p, __ATOMIC_RELAXED, __HIP_MEMORY_SCOPE_AGENT); }
__device__ __forceinline__ unsigned xb_add(unsigned* p, unsigned v) { return __hip_atomic_fetch_add(p, v, __ATOMIC_RELAXED, __HIP_MEMORY_SCOPE_AGENT); }
__device__ __forceinline__ unsigned xb_xcc_id() { return (unsigned)__builtin_amdgcn_s_getreg((3 << 11) | 20) & 0xFu; }
#define XB_SPIN(cond, bar) do { unsigned _sp = 0; while (cond) { __builtin_amdgcn_s_sleep(1); \
    if ((++_sp & 255u) == 0u) { if (xb_ld(&(bar)[XB_TMO])) break; if (_sp > XB_SPIN_CAP) { atomicAdd(&(bar)[XB_TMO], 1u); break; } } } } while (0)
struct XcdBarrier { unsigned* bar; unsigned x; volatile LAS unsigned* st; };
__device__ __forceinline__ XcdBarrier xcd_barrier_post(unsigned* bar, volatile LAS unsigned* st) {
    XcdBarrier b; b.bar = bar; b.x = xb_xcc_id(); b.st = st;
    if (threadIdx.x == 0) (void)xb_add(&bar[XB_XCNT(b.x)], 1u);
    return b;
}
__device__ __forceinline__ void xcd_barrier_complete(unsigned* bar, unsigned x, unsigned& nloc, unsigned& nx) {
    const unsigned G = gridDim.x * gridDim.y * gridDim.z;
    unsigned sum, cnt, mine, sp = 0u;
    for (;;) {
        sum = 0u; cnt = 0u; mine = 0u;
#pragma unroll
        for (unsigned j = 0; j < 16; ++j) { const unsigned c = xb_ld(&bar[XB_XCNT(j)]); sum += c; cnt += (c > 0u) ? 1u : 0u; mine = (j == x) ? c : mine; }
        if (sum == G) break;
        __builtin_amdgcn_s_sleep(1);
        if ((++sp & 255u) == 0u) { if (xb_ld(&bar[XB_TMO])) break; if (sp > XB_SPIN_CAP) { atomicAdd(&bar[XB_TMO], 1u); break; } }
    }
    nloc = mine > 0u ? mine : 1u; nx = cnt > 0u ? cnt : 1u;
}
__device__ __forceinline__ void xcd_barrier(const XcdBarrier& b) {
    asm volatile("s_waitcnt vmcnt(0)" ::: "memory");
    __syncthreads();
    if (threadIdx.x == 0) {
        unsigned* bar = b.bar;
        __builtin_amdgcn_s_waitcnt(0);
        unsigned nloc = b.st[0], nx = b.st[1];
        if (nloc == 0u) { xcd_barrier_complete(bar, b.x, nloc, nx); b.st[0] = nloc; b.st[1] = nx; }
        const unsigned old = xb_add(&bar[XB_XSUB(b.x)], 1u);
        const unsigned gen = old / nloc;
        if (old + 1u == (gen + 1u) * nloc) {
            __builtin_amdgcn_fence(__ATOMIC_RELEASE, "agent");
            asm volatile("s_waitcnt vmcnt(0)" ::: "memory");
            const unsigned og = xb_add(&bar[XB_TOP], 1u);
            const unsigned tg = og / nx;
            if (og + 1u == (tg + 1u) * nx) xb_add(&bar[XB_TOPGEN], 1u);
            else XB_SPIN(xb_ld(&bar[XB_TOPGEN]) == tg, bar);
            __builtin_amdgcn_fence(__ATOMIC_ACQUIRE, "agent");
            xb_add(&bar[XB_XGEN(b.x)], 1u);
            asm volatile("s_waitcnt vmcnt(0)" ::: "memory");
        } else {
            XB_SPIN(xb_ld(&bar[XB_XGEN(b.x)]) == gen, bar);
            __builtin_amdgcn_fence(__ATOMIC_ACQUIRE, "agent");
            asm volatile("s_waitcnt vmcnt(0)" ::: "memory");
        }
    }
    __syncthreads();
}

__device__ __forceinline__ void tr_item(const float* W, int N, int k0, int n0, const float* gain, float cscale, bf16_t* dst  , int Kd, LAS float* scr, int lane) {
    f32x4 v[8]; float g[8];
#pragma unroll
    for (int i = 0; i < 8; ++i) { const int kk = 8 * i + (lane >> 3); v[i] = __builtin_nontemporal_load((const f32x4*)(W + (size_t)(k0 + kk) * N + n0 + 4 * (lane & 7))); g[i] = gain ? gain[k0 + kk] * cscale : cscale; }
#pragma unroll
    for (int i = 0; i < 8; ++i) { const int kk = 8 * i + (lane >> 3); LAS float* d = scr + kk * 33 + 4 * (lane & 7); d[0] = v[i][0] * g[i]; d[1] = v[i][1] * g[i]; d[2] = v[i][2] * g[i]; d[3] = v[i][3] * g[i]; }
    asm volatile("s_waitcnt lgkmcnt(0)" ::: "memory");
    const int c = lane & 7;
#pragma unroll
    for (int j = 0; j < 4; ++j) { const int n = (lane >> 3) + 8 * j; const LAS float* s = scr + (8 * c) * 33 + n;
        u32x4 o; o[0] = cvt_pk_bf16(s[0 * 33], s[1 * 33]); o[1] = cvt_pk_bf16(s[2 * 33], s[3 * 33]); o[2] = cvt_pk_bf16(s[4 * 33], s[5 * 33]); o[3] = cvt_pk_bf16(s[6 * 33], s[7 * 33]);
        *(u32x4*)(dst + (size_t)n * Kd + k0 + 8 * c) = o; }
    asm volatile("s_waitcnt lgkmcnt(0)" ::: "memory");
}
template <int NR>
__device__ __forceinline__ void cvt_rows(const float* x, bf16_t* o, float* ss, int row0, int stride, int nrows, int lane) {
    f32x4 v[NR][4]; float s[NR];
#pragma unroll
    for (int r = 0; r < NR; ++r) { const int row = row0 + r * stride; const f32x4* xr = (const f32x4*)(x + (size_t)(row < nrows ? row : row0) * D) + lane;
#pragma unroll
        for (int j = 0; j < 4; ++j) v[r][j] = __builtin_nontemporal_load(xr + 64 * j); }
#pragma unroll
    for (int r = 0; r < NR; ++r) { float a = 0.f;
#pragma unroll
        for (int j = 0; j < 4; ++j) a += (v[r][j][0] * v[r][j][0] + v[r][j][1] * v[r][j][1]) + (v[r][j][2] * v[r][j][2] + v[r][j][3] * v[r][j][3]);
        s[r] = a; }
#pragma unroll
    for (int of = 1; of < 64; of <<= 1)
#pragma unroll
        for (int r = 0; r < NR; ++r) s[r] += __shfl_xor(s[r], of);
#pragma unroll
    for (int r = 0; r < NR; ++r) { const int row = row0 + r * stride; if (row < nrows) { u32x2* o8 = (u32x2*)(o + (size_t)row * D) + lane;
#pragma unroll
            for (int j = 0; j < 4; ++j) { u32x2 w; w[0] = cvt_pk_bf16(v[r][j][0], v[r][j][1]); w[1] = cvt_pk_bf16(v[r][j][2], v[r][j][3]); o8[64 * j] = w; }
            if (lane < 16) ss[(size_t)row * 16 + lane] = lane == 0 ? s[r] : 0.f; } }
}

struct Args { const float* in[20]; float* out; unsigned char* ws; int ph_lo, ph_hi, flags, pad; };

#define MK_PTRS unsigned char* ws = args.ws; float* out = args.out; asm volatile("" : "+s"(ws), "+s"(out)); \
    const float* x_in = args.in[0]; const float* mem_in = args.in[1]; const float* rel_bias = args.in[7]; \
    bf16_t* Wgu1 = (bf16_t*)(ws + WS_WGU1); bf16_t* Wd1 = (bf16_t*)(ws + WS_WD1); bf16_t* Win = (bf16_t*)(ws + WS_WIN); bf16_t* Wout = (bf16_t*)(ws + WS_WOUT); \
    bf16_t* Wcqs = (bf16_t*)(ws + WS_WCQS); bf16_t* Wckv = (bf16_t*)(ws + WS_WCKV); bf16_t* Wco = (bf16_t*)(ws + WS_WCO); bf16_t* Wgu2 = (bf16_t*)(ws + WS_WGU2); bf16_t* Wd2 = (bf16_t*)(ws + WS_WD2); \
    bf16_t* MB = (bf16_t*)(ws + WS_MB); bf16_t* KVC = (bf16_t*)(ws + WS_KVC); bf16_t* WKT = (bf16_t*)(ws + WS_WKT); bf16_t* VWT = (bf16_t*)(ws + WS_VWT); \
    float* SS0 = (float*)(ws + WS_SS); float* SS1 = SS0 + (size_t)M * 16; float* SS2 = SS1 + (size_t)M * 16; float* SS3 = SS2 + (size_t)M * 16; float* SS4 = SS3 + (size_t)M * 16; \
    float* SSM = (float*)(ws + WS_SSM); float* KM = (float*)(ws + WS_KM); \
    bf16_t* HB = (bf16_t*)(ws + WS_R1); bf16_t* QKV = HB; bf16_t* YN = HB; bf16_t* PB = HB; \
    bf16_t* XB = (bf16_t*)(ws + WS_XB); bf16_t* OA0 = (bf16_t*)out; bf16_t* OA1 = (bf16_t*)((char*)out + OUT_OA1); bf16_t* OA2 = (bf16_t*)(ws + WS_OA2); bf16_t* OB = (bf16_t*)((char*)out + OUT_OB); float* ML = (float*)((char*)out + OUT_ML);
__global__ void __launch_bounds__(NWAVES * 64, 2) mk_fwd(Args args) {
    extern __shared__ __attribute__((aligned(16))) unsigned char lds_raw[];
    LAS unsigned char* lds = (LAS unsigned char*)lds_raw;
    const int tid = threadIdx.x, lane = tid & 63, wave = __builtin_amdgcn_readfirstlane(tid >> 6);
    const int G = gridDim.x, bx = blockIdx.x;
    const int vcu = (G % 8 == 0) ? (bx % 8) * (G / 8) + bx / 8 : bx;
    const int gw = vcu * NWAVES + wave, NGW = G * NWAVES;
    unsigned char* const ws0 = args.ws;
    volatile LAS unsigned* MISC = (volatile LAS unsigned*)(lds + LDS_MISC);
    if (tid < 32) MISC[tid] = 0u;
    __syncthreads();
    const int lo = args.ph_lo, hi = args.ph_hi;
    const bool use_bar = (hi - lo) > 1;
    XcdBarrier bar; bar.bar = (unsigned*)(ws0 + WS_CTL) + CW_BAR; bar.x = 0; bar.st = nullptr;
    if (use_bar) bar = xcd_barrier_post((unsigned*)(ws0 + WS_CTL) + CW_BAR, MISC + 8);
#define IN(k) (lo <= (k) && (k) < hi)
#define STAGGER() do { if (MK_STAGGER_TICKS > 0) { const unsigned long long t0_ = __builtin_amdgcn_s_memrealtime(), dl_ = (unsigned long long)((bx >> 3) & 3) * MK_STAGGER_TICKS; while (__builtin_amdgcn_s_memrealtime() - t0_ < dl_) __builtin_amdgcn_s_sleep(8); } } while (0)
#define SEAM(k) do { if (IN(k) && IN((k) + 1)) xcd_barrier(bar); } while (0)

    if (IN(0)) {
        MK_PTRS;
        LAS float* scr = (LAS float*)(lds + wave * 16384);
        constexpr int I_GU = (D / 64) * (2 * DFF / 32), I_DN = (DFF / 64) * (D / 32), I_IN = (D / 64) * (NQKV / 32), I_SQ = (D / 64) * (D / 32), I_KV = (D / 64) * (2 * D / 32);
        constexpr int NITEMS = 2 * I_GU + 2 * I_DN + I_IN + 2 * I_SQ + I_KV;
        for (int it = gw; it < NITEMS; it += NGW) {
            int r = it;
            if (r < 2 * I_GU) {
                const bool second = r >= I_GU; if (second) r -= I_GU;
                const int nblk = 2 * DFF / 32, kb = r / nblk, nb = r % nblk, n0 = nb * 32;
                const int drow = n0 < DFF ? (n0 / 128) * 256 + (n0 % 128) : ((n0 - DFF) / 128) * 256 + 128 + ((n0 - DFF) % 128);
                tr_item(args.in[second ? 17 : 3], 2 * DFF, kb * 64, n0, args.in[second ? 16 : 2], 1.0f, (second ? Wgu2 : Wgu1) + (size_t)drow * D, D, scr, lane); continue; }
            r -= 2 * I_GU;
            if (r < 2 * I_DN) { const bool second = r >= I_DN; if (second) r -= I_DN; const int nblk = D / 32, kb = r / nblk, nb = r % nblk;
                tr_item(args.in[second ? 18 : 4], D, kb * 64, nb * 32, nullptr, 1.0f, (second ? Wd2 : Wd1) + (size_t)(nb * 32) * DFF, DFF, scr, lane); continue; }
            r -= 2 * I_DN;
            if (r < I_IN) { const int nblk = NQKV / 32, kb = r / nblk, nb = r % nblk, n0 = nb * 32; const bool isq = (n0 < 768) || (n0 >= 2304 && n0 < 2560);
                tr_item(args.in[6], NQKV, kb * 64, n0, args.in[5], isq ? 0.125f : 1.0f, Win + (size_t)n0 * D, D, scr, lane); continue; }
            r -= I_IN;
            if (r < I_SQ) { const int nblk = D / 32, kb = r / nblk, nb = r % nblk, k0 = kb * 64; const float* gp = k0 < 768 ? args.in[8] : args.in[9] - 768;
                tr_item(args.in[10], D, k0, nb * 32, gp, 1.0f, Wout + (size_t)(nb * 32) * D, D, scr, lane); continue; }
            r -= I_SQ;
            if (r < I_SQ) { const int nblk = D / 32, kb = r / nblk, nb = r % nblk; tr_item(args.in[15], D, kb * 64, nb * 32, nullptr, 1.0f, Wco + (size_t)(nb * 32) * D, D, scr, lane); continue; }
            r -= I_SQ;
            { const int nblk = 2 * D / 32, kb = r / nblk, nb = r % nblk; tr_item(args.in[14], 2 * D, kb * 64, nb * 32, args.in[12], 1.0f, Wckv + (size_t)(nb * 32) * D, D, scr, lane); }
        }
        for (int c = gw; c < D; c += NGW) { const float g = args.in[11][c] * 0.0625f; const f32x4* src = (const f32x4*)(args.in[13] + (size_t)c * D) + lane; u32x2* dst = (u32x2*)(Wcqs + (size_t)c * D) + lane;
#pragma unroll
            for (int j = 0; j < 4; ++j) { const f32x4 v = src[64 * j] * g; u32x2 w; w[0] = cvt_pk_bf16(v[0], v[1]); w[1] = cvt_pk_bf16(v[2], v[3]); dst[64 * j] = w; } }
        for (int m = gw; m < M; m += 4 * NGW) cvt_rows<4>(x_in, XB, SS0, m, NGW, M, lane);
        for (int m = gw; m < MM; m += NGW) cvt_rows<1>(mem_in, MB, SSM, m, NGW, MM, lane);
        for (int i = gw * 64 + lane; i < NBAT * 16 * 256; i += NGW * 64) KM[i] = 0.f;
    }
    SEAM(0);

    if (IN(1)) {
        MK_PTRS;
        STAGGER();
        { SchedStd S; S.o.init(M, 2 * DFF, G, bx); S.A = (const char*)XB; S.B = (const char*)Wgu1; S.a_tile = (size_t)256 * D * 2; S.b_tile = (size_t)256 * D * 2; S.b_batch = 0; S.ocol_mul = 128;
          EpiGU E{HB, SS0}; pg8::gemm_phase<EpiGU, SchedStd, true>(lds, D, D, D / 64, S, E); }
        { SchedStd S; S.o.init(MM, 2 * D, G, (bx + G / 2) % G); S.A = (const char*)MB; S.B = (const char*)Wckv; S.a_tile = (size_t)256 * D * 2; S.b_tile = (size_t)256 * D * 2; S.b_batch = 0; S.ocol_mul = 256;
          EpiStore E{KVC, 2 * D, SSM, nullptr, false}; pg8::gemm_phase<EpiStore, SchedStd, true>(lds, D, D, D / 64, S, E); }
    }
    SEAM(1);

    if (IN(2)) {
        MK_PTRS;
        SchedStd S; S.o.init(M, D, G, bx); S.A = (const char*)HB; S.B = (const char*)Wd1; S.a_tile = (size_t)256 * DFF * 2; S.b_tile = (size_t)256 * DFF * 2; S.b_batch = 0; S.ocol_mul = 256;
        EpiRes E{XB, SS1, 0.5f}; pg8::gemm_phase<EpiRes, SchedStd, true>(lds, DFF, DFF, DFF / 64, S, E);
    }
    SEAM(2);

    if (IN(3)) {
        MK_PTRS;
        { SchedStd S; S.o.init(M, NQKV, G, bx); S.A = (const char*)XB; S.B = (const char*)Win; S.a_tile = (size_t)256 * D * 2; S.b_tile = (size_t)256 * D * 2; S.b_batch = 0; S.ocol_mul = 256;
          EpiStore E{QKV, 0, SS1, KM, false}; pg8::gemm_phase<EpiStore, SchedStd, true>(lds, D, D, D / 64, S, E); }
        { SchedWK S{G, bx, (const char*)KVC, (const char*)Wcqs}; EpiStore E{WKT, D, nullptr, nullptr, false}; pg8::gemm_phase<EpiStore, SchedWK, true>(lds, 2 * D, D, 4, S, E); }
        { SchedVW S{G, (bx + G / 2) % G, (const char*)KVC, (const char*)Wco}; EpiStore E{VWT, D, nullptr, nullptr, false}; pg8::gemm_phase<EpiStore, SchedVW, true>(lds, D, 2 * D, 4, S, E); }
    }
    SEAM(3);

    if (IN(4)) {
        MK_PTRS;
        LAS float* tab = (LAS float*)(lds + LDS_TAB);
        const int h2 = lane >> 5, q = lane & 31;
        const long rowb = 128;
        constexpr long HSTR = (long)SEQ * 128;
#define ATT_WAITV(n) asm volatile("s_waitcnt vmcnt(" #n ")" ::: "memory")
#define ATT_BAR() do { asm volatile("s_waitcnt lgkmcnt(0)" ::: "memory"); __builtin_amdgcn_s_barrier(); asm volatile("" ::: "memory"); } while (0)
        for (int i = tid; i < 4 * att::TABB_N; i += NWAVES * 64) { const int hb = i / att::TABB_N, e = i % att::TABB_N, dist = e - 32;
            tab[i] = dist >= 0 ? rel_bias[att::rel_bucket(dist) * 16 + 12 + hb] * LOG2E : -INFINITY; }
        __syncthreads();
        constexpr int NMOBA = NBAT * 4 * 16;
        for (int j = vcu; j < NMOBA / 2; j += G)
#pragma unroll 1
            for (int half = 0; half < 2; ++half) {
                const int bh = j >> 3, s8 = j & 7; const int qb = half ? s8 : 15 - s8, b = bh >> 2, hb = bh & 3;
                const int q0 = qb * 256 + wave * 32;
                const char* base = (const char*)QKV + (size_t)b * 48 * HSTR;
                const char* qbase = base + (36 + hb) * HSTR + (size_t)q0 * rowb;
                const char* kbase = base + (40 + hb) * HSTR;
                att::bf16x8 qf[4];
#pragma unroll
                for (int d0 = 0; d0 < 4; ++d0) qf[d0] = *(const att::bf16x8*)(qbase + (long)q * rowb + (16 * d0 + 8 * h2) * 2);
                const unsigned sel = att::moba_select(qbase, rowb, KM + (size_t)b * 16 * 256 + hb * 64, qb);
                const LAS float* tb = tab + hb * att::TABB_N;
                const int NT = 4 * (qb + 1);
                const int drow = wave * 8 + (lane >> 3);
                const char* ksrc = kbase + (long)drow * rowb;
                ATT_WAITV(0);
                constexpr int NS = 6;
                int st_t = 0;
#pragma unroll
                for (int k = 0; k < NS - 1; ++k) if (k < NT)
                    att::dma_rows8(ksrc + (long)k * 64 * rowb, (int)(4 * HSTR), drow, (LAS char*)(lds + k * 16384 + wave * 1024), (LAS char*)(lds + k * 16384 + 8192 + wave * 1024), lane);
                att::f32x16 o[2]; o[0] = att::f32x16{}; o[1] = att::f32x16{}; float mo = -1e30f, lo_ = 0.f;
#pragma unroll 1
                for (int t = 0; t < NT; ++t) {
                    const int newer = NT - 1 - t;
                    if (newer >= 4) ATT_WAITV(8); else if (newer == 3) ATT_WAITV(6); else if (newer == 2) ATT_WAITV(4); else if (newer == 1) ATT_WAITV(2); else ATT_WAITV(0);
                    ATT_BAR();
                    if (t + NS - 1 < NT) { const int s2 = st_t == 0 ? NS - 1 : st_t - 1;
                        att::dma_rows8(ksrc + (long)(t + NS - 1) * 64 * rowb, (int)(4 * HSTR), drow, (LAS char*)(lds + s2 * 16384 + wave * 1024), (LAS char*)(lds + s2 * 16384 + 8192 + wave * 1024), lane); }
                    const LAS char* kt = (const LAS char*)(lds + st_t * 16384);
#pragma unroll
                    for (int gg = 0; gg < 2; ++gg) {
                        const int g0 = 64 * t + 32 * gg;
                        if (g0 <= q0) {
                            int B = (q0 - g0 + 32) + q - 4 * h2; B = B < (att::TABB_N - 1) ? B : (att::TABB_N - 1);
                            const int n = g0 >> 8; const bool sl = (n == qb) || ((sel >> n) & 1u); B = sl ? B : 27;
                            att::attn_group(qf, o, mo, lo_, kt + gg * 4096, kt + 8192 + gg * 4096, tb + B, lane);
                        }
                    }
                    st_t = st_t == NS - 1 ? 0 : st_t + 1;
                }
                ATT_BAR();
                lo_ += __shfl_xor(lo_, 32);
                att::store_o<MK_NT_PART>(o, lo_, (char*)OB + ((size_t)(b * SEQ + q0 + q) * 256 + hb * 64) * 2, h2);
            }
        __syncthreads();
        for (int i = tid; i < 36 * att::TABA_N; i += NWAVES * 64) { const int t = i / att::TABA_N, e = i % att::TABA_N, p = t / 12, h = t % 12, delta = e - 32, d = p == 0 ? 1 : (p == 1 ? 4 : 16);
            tab[i] = (delta >= 0 && delta <= 128) ? rel_bias[att::rel_bucket(delta * d) * 16 + h] * LOG2E : -INFINITY; }
        __syncthreads();
        constexpr int NDIL = NBAT * 12 * 48;
        struct DilItem { int b, h, p, d, res, m0, mbase; };
        auto decode = [&](int it, DilItem& I) { const int bh = it / 48, j = it % 48; I.b = bh / 12; I.h = bh % 12; I.p = j >> 4; const int jj = j & 15;
            I.d = I.p == 0 ? 1 : (I.p == 1 ? 4 : 16); I.res = I.p == 0 ? 0 : (I.p == 1 ? (jj & 3) : jj); const int mblk = I.p == 0 ? jj : (I.p == 1 ? (jj >> 2) : 0);
            I.mbase = mblk * 256 - 128; I.m0 = mblk * 256 + wave * 32; };
        att::bf16x8 qf[4];
        auto issue_k = [&](const DilItem& I) {
            const char* kb = (const char*)QKV + ((size_t)I.b * 48 + 12 + I.h) * HSTR + (size_t)I.res * rowb; const long st = (long)I.d * rowb;
#pragma unroll 1
            for (int k = wave; k < 48; k += NWAVES) { if (I.mbase + 8 * k < 0) continue; const int row = 8 * k + (lane >> 3); att::dma_k_rows8(kb + (long)(I.mbase + row) * st, row, (LAS char*)(lds + k * 1024), lane); } };
        auto issue_v = [&](const DilItem& I) {
            const char* vb = (const char*)QKV + ((size_t)I.b * 48 + 24 + I.h) * HSTR + (size_t)I.res * rowb; const long st = (long)I.d * rowb;
#pragma unroll 1
            for (int k = wave; k < 48; k += NWAVES) { if (I.mbase + 8 * k < 0) continue; const int row = 8 * k + (lane >> 3); att::dma_v_rows8(vb + (long)(I.mbase + row) * st, row, (LAS char*)(lds + 49152 + k * 1024), lane); } };
        auto load_q = [&](const DilItem& I) {
            const char* qp = (const char*)QKV + ((size_t)I.b * 48 + I.h) * HSTR + (size_t)I.res * rowb + (long)I.m0 * I.d * rowb + (long)q * I.d * rowb + 16 * h2;
            asm volatile("global_load_dwordx4 %0, %4, off\n\tglobal_load_dwordx4 %1, %4, off offset:32\n\tglobal_load_dwordx4 %2, %4, off offset:64\n\tglobal_load_dwordx4 %3, %4, off offset:96"
                         : "=&v"(qf[0]), "=&v"(qf[1]), "=&v"(qf[2]), "=&v"(qf[3]) : "v"(qp) : "memory"); };
        DilItem cur; int it = vcu;
        if (it < NDIL) { decode(it, cur); ATT_WAITV(0); issue_k(cur); load_q(cur); issue_v(cur); }
#pragma unroll 1
        for (; it < NDIL; it += G) {
            if (cur.mbase < 0) ATT_WAITV(4); else ATT_WAITV(6);
            asm volatile("" : "+v"(qf[0]), "+v"(qf[1]), "+v"(qf[2]), "+v"(qf[3]));
            ATT_BAR();
            const int m0 = cur.m0, gend = (m0 - 128) > 0 ? (m0 - 128) : 0, ng = ((m0 - gend) >> 5) + 1;
            att::u32x4 pw[5][2]; float mo, lo_;
            { att::bf16x8 qc[4] = {qf[0], qf[1], qf[2], qf[3]};
              att::dil_pass1(qc, ng, (const LAS char*)(lds + (m0 - cur.mbase) * 128), tab + (cur.p * 12 + cur.h) * att::TABA_N + 32 + q - 4 * h2, pw, mo, lo_, lane); }
            ATT_WAITV(0); ATT_BAR();
            const DilItem done = cur; const bool has_next = it + G < NDIL;
            if (has_next) { decode(it + G, cur); issue_k(cur); }
            att::f32x16 o[2];
            att::dil_pass2(ng, (const LAS char*)(lds + 49152 + (m0 - done.mbase) * 128), pw, o, lane);
            ATT_BAR();
            const size_t tok = (size_t)done.b * SEQ + (size_t)(m0 + q) * done.d + done.res;
            att::store_o<MK_NT_PART>(o, lo_, (char*)(done.p == 0 ? OA0 : (done.p == 1 ? OA1 : OA2)) + (tok * 768 + done.h * 64) * 2, h2);
            if (h2 == 0) *(f32x2*)(ML + (((size_t)done.p * M + tok) * 12 + done.h) * 2) = (f32x2){mo, lo_};
            if (has_next) { load_q(cur); issue_v(cur); }
        }
#undef ATT_WAITV
#undef ATT_BAR
    }
    SEAM(4);

    if (IN(5)) {
        MK_PTRS;
        for (int row0 = gw; row0 < M; row0 += 2 * NGW) {
            f32x2 ml[2][3][3]; u32x2 oa[2][3][3]; u32x2 ob[2];
#pragma unroll
            for (int r = 0; r < 2; ++r) { const int row = (row0 + r * NGW) < M ? (row0 + r * NGW) : row0;
#pragma unroll
                for (int k = 0; k < 3; ++k) { const int col = 256 * k + 4 * lane, hd = col >> 6;
#pragma unroll
                    for (int p = 0; p < 3; ++p) ml[r][k][p] = __builtin_nontemporal_load((const f32x2*)(ML + (((size_t)p * M + row) * 12 + hd) * 2));
                    oa[r][k][0] = __builtin_nontemporal_load((const u32x2*)(OA0 + (size_t)row * 768 + col)); oa[r][k][1] = __builtin_nontemporal_load((const u32x2*)(OA1 + (size_t)row * 768 + col)); oa[r][k][2] = __builtin_nontemporal_load((const u32x2*)(OA2 + (size_t)row * 768 + col)); }
                ob[r] = __builtin_nontemporal_load((const u32x2*)(OB + (size_t)row * 256 + 4 * lane)); }
            float va[2][3][4], vb[2][4], ssa[2], ssb[2];
#pragma unroll
            for (int r = 0; r < 2; ++r) { ssa[r] = 0.f; ssb[r] = 0.f;
#pragma unroll
                for (int k = 0; k < 3; ++k) {
                    const float Mx = fmaxf(ml[r][k][0][0], fmaxf(ml[r][k][1][0], ml[r][k][2][0]));
                    const float w0 = ml[r][k][0][1] * __builtin_amdgcn_exp2f(ml[r][k][0][0] - Mx), w1 = ml[r][k][1][1] * __builtin_amdgcn_exp2f(ml[r][k][1][0] - Mx), w2 = ml[r][k][2][1] * __builtin_amdgcn_exp2f(ml[r][k][2][0] - Mx);
                    const float iw = 1.0f / (w0 + w1 + w2);
#pragma unroll
                    for (int e = 0; e < 4; ++e) { const unsigned s0 = oa[r][k][0][e >> 1], s1 = oa[r][k][1][e >> 1], s2 = oa[r][k][2][e >> 1];
                        const float f0 = __builtin_bit_cast(float, (e & 1) ? (s0 & 0xffff0000u) : (s0 << 16)), f1 = __builtin_bit_cast(float, (e & 1) ? (s1 & 0xffff0000u) : (s1 << 16)), f2 = __builtin_bit_cast(float, (e & 1) ? (s2 & 0xffff0000u) : (s2 << 16));
                        const float v = (w0 * f0 + w1 * f1 + w2 * f2) * iw; va[r][k][e] = v; ssa[r] += v * v; } }
#pragma unroll
                for (int e = 0; e < 4; ++e) { const unsigned s0 = ob[r][e >> 1]; vb[r][e] = __builtin_bit_cast(float, (e & 1) ? (s0 & 0xffff0000u) : (s0 << 16)); ssb[r] += vb[r][e] * vb[r][e]; } }
#pragma unroll
            for (int of = 1; of < 64; of <<= 1)
#pragma unroll
                for (int r = 0; r < 2; ++r) { ssa[r] += __shfl_xor(ssa[r], of); ssb[r] += __shfl_xor(ssb[r], of); }
#pragma unroll
            for (int r = 0; r < 2; ++r) { const int row = row0 + r * NGW; if (row < M) {
                const float ra = __builtin_amdgcn_rsqf(ssa[r] * (1.0f / 768.0f) + EPS), rb = __builtin_amdgcn_rsqf(ssb[r] * (1.0f / 256.0f) + EPS);
#pragma unroll
                for (int k = 0; k < 3; ++k) { u32x2 w; w[0] = cvt_pk_bf16(va[r][k][0] * ra, va[r][k][1] * ra); w[1] = cvt_pk_bf16(va[r][k][2] * ra, va[r][k][3] * ra); *(u32x2*)(YN + (size_t)row * D + 256 * k + 4 * lane) = w; }
                { u32x2 w; w[0] = cvt_pk_bf16(vb[r][0] * rb, vb[r][1] * rb); w[1] = cvt_pk_bf16(vb[r][2] * rb, vb[r][3] * rb); *(u32x2*)(YN + (size_t)row * D + 768 + 4 * lane) = w; } } }
        }
    }
    SEAM(5);

    if (IN(6)) {
        MK_PTRS;
        SchedStd S; S.o.init(M, D, G, bx); S.A = (const char*)YN; S.B = (const char*)Wout; S.a_tile = (size_t)256 * D * 2; S.b_tile = (size_t)256 * D * 2; S.b_batch = 0; S.ocol_mul = 256;
        EpiRes E{XB, SS2, 1.0f}; pg8::gemm_phase<EpiRes, SchedStd, true>(lds, D, D, D / 64, S, E);
    }
    SEAM(6);

    if (IN(7)) {
        MK_PTRS;
        SchedStd S; S.o.init(M, D, G, bx); S.A = (const char*)XB; S.B = (const char*)WKT; S.a_tile = (size_t)256 * D * 2; S.b_tile = (size_t)256 * D * 2; S.b_batch = (size_t)D * D * 2; S.ocol_mul = 256;
        EpiSoftmax E{PB, SS2}; pg8::gemm_phase<EpiSoftmax, SchedStd, true>(lds, D, D, D / 64, S, E);
    }
    SEAM(7);

    if (IN(8)) {
        MK_PTRS;
        SchedStd S; S.o.init(M, D, G, bx); S.A = (const char*)PB; S.B = (const char*)VWT; S.a_tile = (size_t)256 * D * 2; S.b_tile = (size_t)256 * D * 2; S.b_batch = (size_t)D * D * 2; S.ocol_mul = 256;
        EpiRes E{XB, SS3, 1.0f}; pg8::gemm_phase<EpiRes, SchedStd, true>(lds, D, D, D / 64, S, E);
    }
    SEAM(8);

    if (IN(9)) {
        MK_PTRS;
        STAGGER();
        SchedStd S; S.o.init(M, 2 * DFF, G, bx); S.A = (const char*)XB; S.B = (const char*)Wgu2; S.a_tile = (size_t)256 * D * 2; S.b_tile = (size_t)256 * D * 2; S.b_batch = 0; S.ocol_mul = 128;
        EpiGU E{HB, SS3}; pg8::gemm_phase<EpiGU, SchedStd, true>(lds, D, D, D / 64, S, E);
    }
    SEAM(9);

    if (IN(10)) {
        MK_PTRS;
        SchedStd S; S.o.init(M, D, G, bx); S.A = (const char*)HB; S.B = (const char*)Wd2; S.a_tile = (size_t)256 * DFF * 2; S.b_tile = (size_t)256 * DFF * 2; S.b_batch = 0; S.ocol_mul = 256;
        EpiRes E{XB, SS4, 0.5f}; pg8::gemm_phase<EpiRes, SchedStd, true>(lds, DFF, DFF, DFF / 64, S, E);
    }
    SEAM(10);

    if (IN(11)) {
        MK_PTRS;
        const float* gf = args.in[19];
        for (int row0 = gw; row0 < M; row0 += 4 * NGW) {
            u32x2 w[4][4]; float rs[4]; const f32x4* gr = (const f32x4*)gf + lane;
#pragma unroll
            for (int r = 0; r < 4; ++r) { const int row = (row0 + r * NGW) < M ? (row0 + r * NGW) : row0; const u32x2* xr = (const u32x2*)(XB + (size_t)row * D) + lane;
#pragma unroll
                for (int j = 0; j < 4; ++j) w[r][j] = __builtin_nontemporal_load(xr + 64 * j);
                rs[r] = row_rstd(SS4, row); }
#pragma unroll
            for (int r = 0; r < 4; ++r) { const int row = row0 + r * NGW; if (row < M) { f32x4* orow = (f32x4*)(out + (size_t)row * D) + lane;
#pragma unroll
                for (int j = 0; j < 4; ++j) { f32x4 v; v[0] = __builtin_bit_cast(float, w[r][j][0] << 16); v[1] = __builtin_bit_cast(float, w[r][j][0] & 0xffff0000u); v[2] = __builtin_bit_cast(float, w[r][j][1] << 16); v[3] = __builtin_bit_cast(float, w[r][j][1] & 0xffff0000u);
                    __builtin_nontemporal_store(v * rs[r] * gr[64 * j], orow + 64 * j); } } }
        }
    }
#undef IN
#undef SEAM
}
}


#if MK_DEBUG
namespace dbg {
__global__ void __launch_bounds__(256) cmp_f32(const float* a, const float* r, size_t n, float* acc) {
    float num = 0.f, den = 0.f;
    for (size_t i = (size_t)blockIdx.x * 256 + threadIdx.x; i < n; i += (size_t)gridDim.x * 256) { const float d = a[i] - r[i]; num += d * d; den += r[i] * r[i]; }
    for (int o = 32; o > 0; o >>= 1) { num += __shfl_xor(num, o); den += __shfl_xor(den, o); }
    if ((threadIdx.x & 63) == 0) { atomicAdd(acc, num); atomicAdd(acc + 1, den); }
}
__global__ void __launch_bounds__(256) cmp_bf16(const unsigned short* a, int lda, const float* colscale, const float* r, int ldr, int rows, int cols, float* acc) {
    float num = 0.f, den = 0.f; const size_t n = (size_t)rows * cols;
    for (size_t i = (size_t)blockIdx.x * 256 + threadIdx.x; i < n; i += (size_t)gridDim.x * 256) { const size_t row = i / cols; const int c = (int)(i % cols);
        const float av = __builtin_bit_cast(float, (unsigned)a[row * lda + c] << 16) * (colscale ? colscale[c] : 1.0f); const float rv = r[row * ldr + c]; const float d = av - rv; num += d * d; den += rv * rv; }
    for (int o = 32; o > 0; o >>= 1) { num += __shfl_xor(num, o); den += __shfl_xor(den, o); }
    if ((threadIdx.x & 63) == 0) { atomicAdd(acc, num); atomicAdd(acc + 1, den); }
}
__global__ void __launch_bounds__(256) cmp_p(const unsigned short* a, const float* r, float* acc) {
    float num = 0.f, den = 0.f; const size_t n = (size_t)4096 * 1024;
    for (size_t i = (size_t)blockIdx.x * 256 + threadIdx.x; i < n; i += (size_t)gridDim.x * 256) { const size_t row = i / 1024; const int c = (int)(i % 1024);
        const float av = __builtin_bit_cast(float, (unsigned)a[i] << 16); const float rv = r[(size_t)(c >> 8) * 4096 * 256 + row * 256 + (c & 255)]; const float d = av - rv; num += d * d; den += rv * rv; }
    for (int o = 32; o > 0; o >>= 1) { num += __shfl_xor(num, o); den += __shfl_xor(den, o); }
    if ((threadIdx.x & 63) == 0) { atomicAdd(acc, num); atomicAdd(acc + 1, den); }
}
__global__ void build_scales(float* qkvs, float* gcat, const float* goa, const float* gob) {
    const int i = blockIdx.x * 256 + threadIdx.x;
    if (i < 3072) qkvs[i] = ((i < 768) || (i >= 2304 && i < 2560)) ? 8.0f : 1.0f;
    if (i < 1024) gcat[i] = i < 768 ? goa[i] : gob[i - 768];
}
constexpr int NST = 8;
__global__ void __launch_bounds__(256) finalize(float* out, size_t n, const float* acc, int report) {
    const float tol[NST] = {0.03f, 0.03f, 1e9f  , 0.08f, 0.03f, 0.05f, 0.03f, 0.03f};
    float E = 0.f;
    if (report > 0) { const float e = sqrtf(acc[2 * (report - 1)] / acc[2 * (report - 1) + 1]); E = (e == e) ? fminf(e, 3.0f) : 3.0f; }
    else { for (int k = NST - 1; k >= 0; --k) { const float e = sqrtf(acc[2 * k] / acc[2 * k + 1]); if (!(e <= tol[k])) E = 0.1f * (k + 1); } }
    for (size_t i = (size_t)blockIdx.x * 256 + threadIdx.x; i < n; i += (size_t)gridDim.x * 256) out[i] *= (1.0f + E);
}
}
#endif

static void mk_launch(const mk::Args& a0, int lo, int hi, int grid, hipStream_t st) {
    mk::Args a = a0; a.ph_lo = lo; a.ph_hi = hi;
    hipLaunchKernelGGL(mk::mk_fwd, dim3(grid), dim3(mk::NWAVES * 64), mk::LDS_BYTES, st, a);
    const hipError_t le = hipPeekAtLastError();
    if (le != hipSuccess) fprintf(stderr, "kernel_launch: launch of phases [%d,%d) failed: %s\n", lo, hi, hipGetErrorName(le));
}

extern "C" void kernel_launch(void* const* d_in, const int* in_sizes, int n_in, void* d_out, int out_size, void* d_ws, size_t ws_size, hipStream_t stream) {
    static int grid = 0;
    if (grid == 0) {
        if (n_in != 20 || out_size != 8 * 4096 * 1024) { fprintf(stderr, "kernel_launch: unexpected shapes (n_in %d out %d)\n", n_in, out_size); grid = -1; return; }
        int dev = 0, cus = 0, per_cu = 0;
        if (hipGetDevice(&dev) != hipSuccess || hipDeviceGetAttribute(&cus, hipDeviceAttributeMultiprocessorCount, dev) != hipSuccess) { grid = -1; return; }
        if (hipFuncSetAttribute((const void*)mk::mk_fwd, hipFuncAttributeMaxDynamicSharedMemorySize, mk::LDS_BYTES) != hipSuccess) { fprintf(stderr, "kernel_launch: hipFuncSetAttribute failed\n"); grid = -1; return; }
        if (hipOccupancyMaxActiveBlocksPerMultiprocessor(&per_cu, (const void*)mk::mk_fwd, mk::NWAVES * 64, mk::LDS_BYTES) != hipSuccess || per_cu < 1) fprintf(stderr, "kernel_launch: occupancy query reports %d workgroups per CU\n", per_cu);
        (void)hipGetLastError();
        grid = cus;
    }
    if (grid < 0) return;
    unsigned char* ws = (unsigned char*)d_ws;
#if MK_DEBUG
    const size_t ref_off = (mk::WS_END + 4095) / 4096 * 4096;
    size_t off = ref_off + (size_t)290 * 1024 * 1024;
    auto take = [&](size_t bytes) { unsigned char* p = ws + off; off += (bytes + 255) / 256 * 256; return p; };
    float* sx1 = (float*)take((size_t)4096 * 1024 * 4); float* sx2 = (float*)take((size_t)4096 * 1024 * 4); float* sx3 = (float*)take((size_t)4096 * 1024 * 4);
    float* mkout = (float*)take((size_t)4096 * 1024 * 4); float* qkvs = (float*)take(3072 * 4); float* gcat = (float*)take(1024 * 4); float* acc = (float*)take(256);
    if (off > ws_size) { fprintf(stderr, "kernel_launch: debug build needs %zu bytes of workspace, got %zu\n", off, ws_size); return; }
    ref::Snap snap{sx1, sx2, sx3};
    ref::forward(d_in, (float*)d_out, ws + ref_off, stream, &snap);
    (void)hipMemsetAsync(ws + mk::WS_CTL, 0, mk::CTL_BYTES, stream);
    (void)hipMemsetAsync(acc, 0, 256, stream);
    dbg::build_scales<<<12, 256, 0, stream>>>(qkvs, gcat, (const float*)d_in[8], (const float*)d_in[9]);
    mk::Args a{};
    for (int i = 0; i < 20; ++i) a.in[i] = (const float*)d_in[i];
    a.in[0] = (const float*)d_in[0] + (size_t)7 * 4096 * 1024; a.in[1] = (const float*)d_in[1] + (size_t)7 * 256 * 1024;
    a.out = mkout; a.ws = ws;
    const ref::Bufs& rb = ref::g_bufs;
    for (int ph = 0; ph < mk::NPH; ++ph) {
        mk_launch(a, ph, ph + 1, grid, stream);
        if (ph == 1) dbg::cmp_bf16<<<512, 256, 0, stream>>>((const unsigned short*)(ws + mk::WS_KVC), 2048, nullptr, rb.kvc, 2048, 256, 2048, acc + 0);
        if (ph == 2) dbg::cmp_bf16<<<512, 256, 0, stream>>>((const unsigned short*)(ws + mk::WS_XB), 1024, nullptr, sx1, 1024, 4096, 1024, acc + 2);
        if (ph == 3) dbg::cmp_bf16<<<512, 256, 0, stream>>>((const unsigned short*)(ws + mk::WS_R1), 3072, qkvs, rb.proj, 3072, 4096, 3072, acc + 4);
        if (ph == 5) dbg::cmp_bf16<<<512, 256, 0, stream>>>((const unsigned short*)(ws + mk::WS_R1), 1024, gcat, rb.yn, 1024, 4096, 1024, acc + 6);
        if (ph == 6) dbg::cmp_bf16<<<512, 256, 0, stream>>>((const unsigned short*)(ws + mk::WS_XB), 1024, nullptr, sx2, 1024, 4096, 1024, acc + 8);
        if (ph == 7) dbg::cmp_p<<<512, 256, 0, stream>>>((const unsigned short*)(ws + mk::WS_R1), rb.sc, acc + 10);
        if (ph == 8) dbg::cmp_bf16<<<512, 256, 0, stream>>>((const unsigned short*)(ws + mk::WS_XB), 1024, nullptr, sx3, 1024, 4096, 1024, acc + 12);
        if (ph == 11) dbg::cmp_f32<<<512, 256, 0, stream>>>(mkout, (const float*)d_out + (size_t)7 * 4096 * 1024, (size_t)4096 * 1024, acc + 14);
    }
    dbg::finalize<<<1024, 256, 0, stream>>>((float*)d_out, (size_t)8 * 4096 * 1024, acc, MK_REPORT);
#else
    if (ws_size < mk::WS_END) { fprintf(stderr, "kernel_launch: needs %zu bytes of workspace, got %zu\n", (size_t)mk::WS_END, ws_size); return; }
    if (hipMemsetAsync(ws + mk::WS_CTL, 0, mk::CTL_BYTES, stream) != hipSuccess) return;
    mk::Args a{};
    for (int i = 0; i < 20; ++i) a.in[i] = (const float*)d_in[i];
    a.out = (float*)d_out; a.ws = ws;
#if MK_N_LAUNCHES == 1
    mk_launch(a, 0, mk::NPH, grid, stream);
#else
    for (int ph = 0; ph < mk::NPH; ++ph) {
        for (int r = 0; r < MK_REPEAT_N; ++r) if (ph == MK_REPEAT) { mk::Args a2 = a; a2.flags = MK_REPEAT_FLAGS; mk_launch(a2, ph, ph + 1, grid, stream); }
        mk_launch(a, ph, ph + 1, grid, stream); }
#endif
#endif
}
```

```cpp
#include <hip/hip_runtime.h>
#include <cstdio>
#include <cstdint>
#include <cmath>
#define MK_REPEAT -1
#define MK_REPEAT_N 1
#define MK_REPEAT_FLAGS 0
#define MK_STAGGER_TICKS 0
#define MK_NT_PART false
#define MK_TIMING 0
#define MK_TQ 0.02f
#define MK_DEBUG 0
#define MK_REPORT 0
#define MK_N_LAUNCHES 1
#define MK_NBAT 8

namespace pg8 {
#define PG8_LAS __attribute__((address_space(3)))
typedef unsigned short bf16_t;
typedef short bf16x8 __attribute__((ext_vector_type(8)));
typedef float f32x4 __attribute__((ext_vector_type(4)));
typedef float f32x2 __attribute__((ext_vector_type(2)));
typedef unsigned u32x4 __attribute__((ext_vector_type(4)));
typedef unsigned u32x2 __attribute__((ext_vector_type(2)));
constexpr int BM = 256, BK = 64, HALF = 128, HTB = HALF * BK * 2  , STAGE_BYTES = 8 * HTB, NXCD = 8, WGM = 8;

__host__ __device__ __forceinline__ int lds_byte(int r, int c) { const int st = (r >> 4) * 2 + (c >> 5), rr = r & 15, cc = c & 31, ob = rr * 64 + cc * 2; return st * 1024 + (ob ^ (((ob >> 9) & 1) << 5)); }
__host__ __device__ __forceinline__ void stage_rc(int b, int& R, int& C) { const int st = b / 1024, sb = b % 1024, swz = sb ^ (((sb >> 9) & 1) << 5); R = (st >> 1) * 16 + swz / 64; C = (st & 1) * 32 + (swz % 64) / 2; }
__host__ __device__ __forceinline__ int perm32(int rho) { const int n = rho >> 4, i = rho & 15; return 8 * (i >> 2) + 4 * n + (i & 3); }

struct Unit { const char* a; const char* b; int orow, ocol, aux; };

struct Order {
    int nM, nN, nwg, G, c;
    __device__ __forceinline__ void init(int M, int N, int G_, int c_) { nM = M / BM; nN = N / BM; nwg = nM * nN; G = G_; c = c_; }
    __device__ __forceinline__ bool tile(int i, int& pm, int& pn) const {
        const long L = (long)i * G + c; if (L >= nwg) return false;
        int wgid = (int)L; { const int q = nwg / NXCD, r = nwg % NXCD, xcd = wgid % NXCD, off = wgid / NXCD; wgid = (xcd < r ? xcd * (q + 1) : r * (q + 1) + (xcd - r) * q) + off; }
        const int nig = WGM * nN, gid = wgid / nig, fm = gid * WGM, gsz = (nM - fm) < WGM ? (nM - fm) : WGM;
        pm = fm + ((wgid % nig) % gsz); pn = (wgid % nig) / gsz; return true;
    }
};

__device__ __forceinline__ unsigned cvt_pk_bf16(float lo, float hi) { unsigned r; asm volatile("v_cvt_pk_bf16_f32 %0, %1, %2" : "=v"(r) : "v"(lo), "v"(hi)); return r; }

template <class Epi, class Sched, bool ALIGN_EPI>
__device__ __forceinline__ void gemm_phase(PG8_LAS unsigned char* lds, const int lda, const int ldb, const int nt, const Sched& S, const Epi& E) {
    int tid_ = threadIdx.x; asm volatile("" : "+v"(tid_));
    const int tid = tid_, wid = __builtin_amdgcn_readfirstlane(tid >> 6), lane = tid & 63, wr = wid >> 2, wc = wid & 3, fr = lane & 15, fq = lane >> 4;
    unsigned voffA[2], voffB[2];
#pragma unroll
    for (int i = 0; i < 2; ++i) { int R, C; stage_rc(tid * 16 + i * 8192, R, C); const int Rb = Epi::PERM ? ((R & ~31) + perm32(R & 31)) : R;
        voffA[i] = (unsigned)(R * lda + C) * 2u; voffB[i] = (unsigned)(Rb * ldb + C) * 2u; }
    const size_t kstep = (size_t)(BK * 2);
    const size_t hstepA = (size_t)HALF * lda * 2, hstepB = (size_t)HALF * ldb * 2;
    const unsigned ldsw = (unsigned)wid * 1024u;
    const int aoff = lds_byte(wr * 64 + fr, fq * 8), boff = lds_byte(wc * 32 + fr, fq * 8);
#define PG8_SA(b, h) (((b) * 2 + (h)) * HTB)
#define PG8_SB(b, h) ((4 + (b) * 2 + (h)) * HTB)
#define PG8_STAGE(bufoff, gbase, voff) do { _Pragma("unroll") for (int _i = 0; _i < 2; ++_i) \
        __builtin_amdgcn_global_load_lds((const unsigned*)((const char*)(gbase) + (voff)[_i]), (PG8_LAS unsigned*)(lds + (bufoff) + ldsw + _i * 8192), 16, 0, 0); } while (0)
#define PG8_LDA(dst, b, h) do { _Pragma("unroll") for (int m = 0; m < 4; ++m) _Pragma("unroll") for (int k = 0; k < 2; ++k) dst[m][k] = *(const PG8_LAS bf16x8*)(lds + PG8_SA(b, h) + aoff + m * 2048 + k * 1024); } while (0)
#define PG8_LDB(dst, b, h) do { _Pragma("unroll") for (int n = 0; n < 2; ++n) _Pragma("unroll") for (int k = 0; k < 2; ++k) dst[n][k] = *(const PG8_LAS bf16x8*)(lds + PG8_SB(b, h) + boff + n * 2048 + k * 1024); } while (0)
#define PG8_MMA(ai, bj, At, Bt) do { __builtin_amdgcn_s_setprio(1); _Pragma("unroll") for (int m = 0; m < 4; ++m) _Pragma("unroll") for (int n = 0; n < 2; ++n) _Pragma("unroll") for (int k = 0; k < 2; ++k) \
        acc[ai][bj][m][n] = __builtin_amdgcn_mfma_f32_16x16x32_bf16(Bt[n][k], At[m][k], acc[ai][bj][m][n], 0, 0, 0); __builtin_amdgcn_s_setprio(0); } while (0)
#define PG8_WAIT_V(n) asm volatile("s_waitcnt vmcnt(" #n ")" ::: "memory")
#define PG8_WAIT_L(n) asm volatile("s_waitcnt lgkmcnt(" #n ")" ::: "memory")
#define PG8_BAR __builtin_amdgcn_s_barrier()
#define PG8_SCHED __builtin_amdgcn_sched_barrier(0)
    Unit cur, nxt; int ui = 0;
    if (!S.next(0, cur)) return;
    f32x4 acc[2][2][4][2];
#pragma unroll
    for (int a = 0; a < 2; ++a)
#pragma unroll
        for (int b = 0; b < 2; ++b)
#pragma unroll
            for (int m = 0; m < 4; ++m)
#pragma unroll
                for (int n = 0; n < 2; ++n) acc[a][b][m][n] = (f32x4){0.f, 0.f, 0.f, 0.f};
    bf16x8 At[4][2], B0[2][2], B1[2][2];
    const char* cA = cur.a; const char* cB = cur.b;
    PG8_STAGE(PG8_SB(0, 0), cB, voffB); PG8_STAGE(PG8_SB(0, 1), cB + hstepB, voffB); PG8_STAGE(PG8_SA(0, 0), cA, voffA); PG8_STAGE(PG8_SA(0, 1), cA + hstepA, voffA);
    if (wr == 1) PG8_BAR;
    PG8_WAIT_V(2); PG8_BAR;
    PG8_STAGE(PG8_SB(1, 0), cB + kstep, voffB); PG8_STAGE(PG8_SA(1, 0), cA + kstep, voffA); PG8_STAGE(PG8_SB(1, 1), cB + hstepB + kstep, voffB);
    PG8_WAIT_V(6); PG8_BAR;
    for (;;) {
        const bool has_next = S.next(ui + 1, nxt);
        const char* nA = has_next ? nxt.a : cA; const char* nB = has_next ? nxt.b : cB;
#pragma unroll 1
        for (int t = 0; t < nt; t += 2) {
            const bool last = (t == nt - 2);
            const char* a1 = cA + (size_t)(t + 1) * kstep;
            const char* a2 = last ? nA : cA + (size_t)(t + 2) * kstep; const char* b2 = last ? nB : cB + (size_t)(t + 2) * kstep;
            const char* a3 = a2 + kstep; const char* b3 = b2 + kstep;
            PG8_LDB(B0, 0, 0); PG8_LDB(B1, 0, 1); PG8_SCHED; PG8_LDA(At, 0, 0); PG8_STAGE(PG8_SA(1, 1), a1 + hstepA, voffA);
            PG8_WAIT_V(8); PG8_WAIT_L(0); PG8_BAR; PG8_MMA(0, 0, At, B0); PG8_MMA(0, 1, At, B1); PG8_BAR; PG8_SCHED;
            PG8_LDA(At, 0, 1); PG8_STAGE(PG8_SB(0, 0), b2, voffB); PG8_STAGE(PG8_SB(0, 1), b2 + hstepB, voffB); PG8_STAGE(PG8_SA(0, 0), a2, voffA);
            PG8_WAIT_V(8); PG8_WAIT_L(0); PG8_BAR; PG8_MMA(1, 0, At, B0); PG8_MMA(1, 1, At, B1); PG8_BAR; PG8_SCHED;
            PG8_LDB(B0, 1, 0); PG8_LDB(B1, 1, 1); PG8_SCHED; PG8_LDA(At, 1, 0); PG8_STAGE(PG8_SA(0, 1), a2 + hstepA, voffA);
            PG8_WAIT_V(8); PG8_WAIT_L(0); PG8_BAR; PG8_MMA(0, 0, At, B0); PG8_MMA(0, 1, At, B1); PG8_BAR; PG8_SCHED;
            PG8_LDA(At, 1, 1); PG8_STAGE(PG8_SB(1, 0), b3, voffB); PG8_STAGE(PG8_SB(1, 1), b3 + hstepB, voffB); PG8_STAGE(PG8_SA(1, 0), a3, voffA);
            PG8_WAIT_V(8); PG8_WAIT_L(0); PG8_BAR; PG8_MMA(1, 0, At, B0); PG8_MMA(1, 1, At, B1); PG8_BAR; PG8_SCHED;
        }
        if constexpr (ALIGN_EPI) { if (wr == 0) PG8_BAR; }
        E(acc, cur, wr, wc, fr, fq, lds, wid, lane);
        if (!has_next) break;
#pragma unroll
        for (int a = 0; a < 2; ++a)
#pragma unroll
            for (int b = 0; b < 2; ++b)
#pragma unroll
                for (int m = 0; m < 4; ++m)
#pragma unroll
                    for (int n = 0; n < 2; ++n) acc[a][b][m][n] = (f32x4){0.f, 0.f, 0.f, 0.f};
        cur = nxt; cA = nA; cB = nB; ++ui;
        if constexpr (ALIGN_EPI) { if (wr == 1) PG8_BAR; }
    }
    PG8_WAIT_V(0);
    if constexpr (!ALIGN_EPI) { if (wr == 0) PG8_BAR; }
    PG8_BAR;
#undef PG8_SA
#undef PG8_SB
#undef PG8_STAGE
#undef PG8_LDA
#undef PG8_LDB
#undef PG8_MMA
#undef PG8_WAIT_V
#undef PG8_WAIT_L
#undef PG8_BAR
#undef PG8_SCHED
}
}

namespace att {
#define ATT_LAS __attribute__((address_space(3)))
typedef short bf16x8 __attribute__((ext_vector_type(8)));
typedef short v4i16 __attribute__((ext_vector_type(4)));
typedef float f32x16 __attribute__((ext_vector_type(16)));
typedef float f32x4 __attribute__((ext_vector_type(4)));
typedef unsigned u32x4 __attribute__((ext_vector_type(4)));
typedef unsigned u32x2 __attribute__((ext_vector_type(2)));
constexpr float LOG2E = 1.4426950408889634f;
constexpr int TABA_N = 192, TABB_N = 1600;

__device__ __forceinline__ int rel_bucket(int n) {
    if (n < 16) return n < 0 ? 0 : n;
    int b = 16;
    b += (n >= 22); b += (n >= 30); b += (n >= 40); b += (n >= 54); b += (n >= 73); b += (n >= 99); b += (n >= 134); b += (n >= 182);
    b += (n >= 246); b += (n >= 332); b += (n >= 450); b += (n >= 609); b += (n >= 825); b += (n >= 1117); b += (n >= 1513);
    return b;
}
__device__ __forceinline__ unsigned pk_bf16(float lo, float hi) { unsigned r; asm volatile("v_cvt_pk_bf16_f32 %0, %1, %2" : "=v"(r) : "v"(lo), "v"(hi)); return r; }
__device__ __forceinline__ float bf16_round(float x) { unsigned u = __builtin_bit_cast(unsigned, x); u = (u + 0x7fffu + ((u >> 16) & 1u)) & 0xffff0000u; return __builtin_bit_cast(float, u); }

__device__ __forceinline__ void glds16(const void* gsrc, unsigned lds_dst) { unsigned keep;
    asm volatile("s_mov_b32 %0, m0\n\ts_mov_b32 m0, %2\n\ts_nop 0\n\tglobal_load_lds_dwordx4 %1, off\n\ts_mov_b32 m0, %0" : "=&s"(keep) : "v"(gsrc), "s"(lds_dst) : "memory"); }
__device__ __forceinline__ void dma_rows8(const char* krow0  , const int voff, const int row  ,
                                          ATT_LAS char* kdst  , ATT_LAS char* vdst, const int lane) {
    const int pc = lane & 7;
    glds16(krow0 + 16 * (pc ^ ((row >> 1) & 7)), (unsigned)__builtin_amdgcn_readfirstlane((int)(unsigned)(uintptr_t)kdst));
    glds16(krow0 + voff + 16 * (pc ^ (((row >> 1) & 1) << 2)), (unsigned)__builtin_amdgcn_readfirstlane((int)(unsigned)(uintptr_t)vdst));
}

__device__ __forceinline__ void attn_group(const bf16x8 (&qf)[4], f32x16 (&o)[2], float& m, float& l, const ATT_LAS char* kg, const ATT_LAS char* vg, const ATT_LAS float* tp, const int lane) {
    const int q = lane & 31, h = lane >> 5;
    const ATT_LAS char* kr0 = kg + q * 128; const int kswz = (q >> 1) & 7;
    typedef float f32x2_ __attribute__((ext_vector_type(2)));
    f32x2_ t0, t1, t2, t3, t4, t5, t6, t7;
    { const unsigned ta = (unsigned)(uintptr_t)(tp - 27);
      asm volatile("ds_read2_b32 %0, %8 offset0:27 offset1:26\n\tds_read2_b32 %1, %8 offset0:25 offset1:24\n\tds_read2_b32 %2, %8 offset0:19 offset1:18\n\tds_read2_b32 %3, %8 offset0:17 offset1:16\n\t"
                   "ds_read2_b32 %4, %8 offset0:11 offset1:10\n\tds_read2_b32 %5, %8 offset0:9 offset1:8\n\tds_read2_b32 %6, %8 offset0:3 offset1:2\n\tds_read2_b32 %7, %8 offset0:1 offset1:0"
                   : "=&v"(t0), "=&v"(t1), "=&v"(t2), "=&v"(t3), "=&v"(t4), "=&v"(t5), "=&v"(t6), "=&v"(t7) : "v"(ta) : "memory"); }
    const int q4 = (lane & 15) >> 2, p4 = lane & 3, g1 = (lane >> 4) & 1, vsw = (q4 >> 1) & 1;
    const unsigned va0_ = (unsigned)(uintptr_t)(vg + (4 * h + q4) * 128 + 32 * g1 + 8 * p4 + 64 * vsw), va1_ = (unsigned)(uintptr_t)(vg + (4 * h + q4) * 128 + 32 * g1 + 8 * p4 + 64 * (1 ^ vsw));
    v4i16 a[2][4];
    asm volatile("ds_read_b64_tr_b16 %0, %8\n\tds_read_b64_tr_b16 %1, %8 offset:1024\n\tds_read_b64_tr_b16 %2, %8 offset:2048\n\tds_read_b64_tr_b16 %3, %8 offset:3072\n\t"
                 "ds_read_b64_tr_b16 %4, %9\n\tds_read_b64_tr_b16 %5, %9 offset:1024\n\tds_read_b64_tr_b16 %6, %9 offset:2048\n\tds_read_b64_tr_b16 %7, %9 offset:3072"
                 : "=&v"(a[0][0]), "=&v"(a[0][1]), "=&v"(a[0][2]), "=&v"(a[0][3]), "=&v"(a[1][0]), "=&v"(a[1][1]), "=&v"(a[1][2]), "=&v"(a[1][3]) : "v"(va0_), "v"(va1_) : "memory");
    f32x16 s = f32x16{};
#pragma unroll
    for (int d0 = 0; d0 < 4; ++d0) { const bf16x8 kf = *(const ATT_LAS bf16x8*)(kr0 + 16 * ((2 * d0 + h) ^ kswz)); s = __builtin_amdgcn_mfma_f32_32x32x16_bf16(kf, qf[d0], s, 0, 0, 0); }
    asm volatile("s_waitcnt lgkmcnt(0)" : "+v"(t0), "+v"(t1), "+v"(t2), "+v"(t3), "+v"(t4), "+v"(t5), "+v"(t6), "+v"(t7), "+v"(a[0][0]), "+v"(a[0][1]), "+v"(a[0][2]), "+v"(a[0][3]), "+v"(a[1][0]), "+v"(a[1][1]), "+v"(a[1][2]), "+v"(a[1][3]) :: "memory");
    float mx = -INFINITY;
    { const float tb_[16] = {t0[0], t0[1], t1[0], t1[1], t2[0], t2[1], t3[0], t3[1], t4[0], t4[1], t5[0], t5[1], t6[0], t6[1], t7[0], t7[1]};
#pragma unroll
      for (int r = 0; r < 16; ++r) s[r] = fmaf(s[r], LOG2E, tb_[r]); }
#pragma unroll
    for (int r = 0; r < 16; r += 2) mx = fmaxf(mx, fmaxf(s[r], s[r + 1]));
    mx = fmaxf(mx, __shfl_xor(mx, 32));
    if (__any(mx > m)) {
        const float mnew = fmaxf(m, mx), alpha = __builtin_amdgcn_exp2f(m - mnew);
        l *= alpha; m = mnew;
#pragma unroll
        for (int r = 0; r < 16; ++r) { o[0][r] *= alpha; o[1][r] *= alpha; }
    }
    float ps = 0.f;
#pragma unroll
    for (int r = 0; r < 16; ++r) { s[r] = __builtin_amdgcn_exp2f(s[r] - m); ps += s[r]; }
    l += ps;
    u32x4 pw0, pw1;
    pw0[0] = pk_bf16(s[0], s[1]); pw0[1] = pk_bf16(s[2], s[3]); pw0[2] = pk_bf16(s[4], s[5]); pw0[3] = pk_bf16(s[6], s[7]);
    pw1[0] = pk_bf16(s[8], s[9]); pw1[1] = pk_bf16(s[10], s[11]); pw1[2] = pk_bf16(s[12], s[13]); pw1[3] = pk_bf16(s[14], s[15]);
    const bf16x8 pb0 = __builtin_bit_cast(bf16x8, pw0), pb1 = __builtin_bit_cast(bf16x8, pw1);
#pragma unroll
    for (int dh = 0; dh < 2; ++dh) {
        const bf16x8 va0 = (bf16x8){a[dh][0][0], a[dh][0][1], a[dh][0][2], a[dh][0][3], a[dh][1][0], a[dh][1][1], a[dh][1][2], a[dh][1][3]};
        const bf16x8 va1 = (bf16x8){a[dh][2][0], a[dh][2][1], a[dh][2][2], a[dh][2][3], a[dh][3][0], a[dh][3][1], a[dh][3][2], a[dh][3][3]};
        o[dh] = __builtin_amdgcn_mfma_f32_32x32x16_bf16(va0, pb0, o[dh], 0, 0, 0);
        o[dh] = __builtin_amdgcn_mfma_f32_32x32x16_bf16(va1, pb1, o[dh], 0, 0, 0);
    }
}

__device__ __forceinline__ void dma_k_rows8(const char* krow, const int row, ATT_LAS char* kdst, const int lane) {
    glds16(krow + 16 * ((lane & 7) ^ ((row >> 1) & 7)), (unsigned)__builtin_amdgcn_readfirstlane((int)(unsigned)(uintptr_t)kdst)); }
__device__ __forceinline__ void dma_v_rows8(const char* vrow, const int row, ATT_LAS char* vdst, const int lane) {
    glds16(vrow + 16 * ((lane & 7) ^ (((row >> 1) & 1) << 2)), (unsigned)__builtin_amdgcn_readfirstlane((int)(unsigned)(uintptr_t)vdst)); }
__device__ __forceinline__ void dil_pass1(const bf16x8 (&qf)[4], const int ng, const ATT_LAS char* kimg0  , const ATT_LAS float* tp0  ,
                                          u32x4 (&pw)[5][2], float& m_out, float& l_out, const int lane) {
    const int q = lane & 31, h = lane >> 5, kswz = (q >> 1) & 7;
    typedef float f32x2_ __attribute__((ext_vector_type(2)));
    f32x16 s[5]; float mx = -INFINITY;
#pragma unroll
    for (int g = 0; g < 5; ++g) if (g < ng) {
        f32x2_ t0, t1, t2, t3, t4, t5, t6, t7;
        { const unsigned ta = (unsigned)(uintptr_t)(tp0 + 32 * g - 27);
          asm volatile("ds_read2_b32 %0, %8 offset0:27 offset1:26\n\tds_read2_b32 %1, %8 offset0:25 offset1:24\n\tds_read2_b32 %2, %8 offset0:19 offset1:18\n\tds_read2_b32 %3, %8 offset0:17 offset1:16\n\t"
                       "ds_read2_b32 %4, %8 offset0:11 offset1:10\n\tds_read2_b32 %5, %8 offset0:9 offset1:8\n\tds_read2_b32 %6, %8 offset0:3 offset1:2\n\tds_read2_b32 %7, %8 offset0:1 offset1:0"
                       : "=&v"(t0), "=&v"(t1), "=&v"(t2), "=&v"(t3), "=&v"(t4), "=&v"(t5), "=&v"(t6), "=&v"(t7) : "v"(ta) : "memory"); }
        const ATT_LAS char* kr0 = kimg0 - g * 4096 + q * 128;
        f32x16 sg = f32x16{};
#pragma unroll
        for (int d0 = 0; d0 < 4; ++d0) { const bf16x8 kf = *(const ATT_LAS bf16x8*)(kr0 + 16 * ((2 * d0 + h) ^ kswz)); sg = __builtin_amdgcn_mfma_f32_32x32x16_bf16(kf, qf[d0], sg, 0, 0, 0); }
        asm volatile("s_waitcnt lgkmcnt(0)" : "+v"(t0), "+v"(t1), "+v"(t2), "+v"(t3), "+v"(t4), "+v"(t5), "+v"(t6), "+v"(t7) :: "memory");
        const float tb_[16] = {t0[0], t0[1], t1[0], t1[1], t2[0], t2[1], t3[0], t3[1], t4[0], t4[1], t5[0], t5[1], t6[0], t6[1], t7[0], t7[1]};
#pragma unroll
        for (int r = 0; r < 16; ++r) sg[r] = fmaf(sg[r], LOG2E, tb_[r]);
#pragma unroll
        for (int r = 0; r < 16; r += 2) mx = fmaxf(mx, fmaxf(sg[r], sg[r + 1]));
        s[g] = sg;
    }
    mx = fmaxf(mx, __shfl_xor(mx, 32));
    float ps = 0.f;
#pragma unroll
    for (int g = 0; g < 5; ++g) if (g < ng) {
        f32x16 p = s[g];
#pragma unroll
        for (int r = 0; r < 16; ++r) { p[r] = __builtin_amdgcn_exp2f(p[r] - mx); ps += p[r]; }
        pw[g][0][0] = pk_bf16(p[0], p[1]); pw[g][0][1] = pk_bf16(p[2], p[3]); pw[g][0][2] = pk_bf16(p[4], p[5]); pw[g][0][3] = pk_bf16(p[6], p[7]);
        pw[g][1][0] = pk_bf16(p[8], p[9]); pw[g][1][1] = pk_bf16(p[10], p[11]); pw[g][1][2] = pk_bf16(p[12], p[13]); pw[g][1][3] = pk_bf16(p[14], p[15]);
    }
    ps += __shfl_xor(ps, 32);
    m_out = mx; l_out = ps;
}
__device__ __forceinline__ void dil_pass2(const int ng, const ATT_LAS char* vimg0  , const u32x4 (&pw)[5][2], f32x16 (&o)[2], const int lane) {
    const int h = lane >> 5, q4 = (lane & 15) >> 2, p4 = lane & 3, g1 = (lane >> 4) & 1, vsw = (q4 >> 1) & 1;
    o[0] = f32x16{}; o[1] = f32x16{};
#pragma unroll
    for (int g = 0; g < 5; ++g) if (g < ng) {
        const ATT_LAS char* vg = vimg0 - g * 4096;
        const unsigned va0_ = (unsigned)(uintptr_t)(vg + (4 * h + q4) * 128 + 32 * g1 + 8 * p4 + 64 * vsw), va1_ = (unsigned)(uintptr_t)(vg + (4 * h + q4) * 128 + 32 * g1 + 8 * p4 + 64 * (1 ^ vsw));
        v4i16 a[2][4];
        asm volatile("ds_read_b64_tr_b16 %0, %8\n\tds_read_b64_tr_b16 %1, %8 offset:1024\n\tds_read_b64_tr_b16 %2, %8 offset:2048\n\tds_read_b64_tr_b16 %3, %8 offset:3072\n\t"
                     "ds_read_b64_tr_b16 %4, %9\n\tds_read_b64_tr_b16 %5, %9 offset:1024\n\tds_read_b64_tr_b16 %6, %9 offset:2048\n\tds_read_b64_tr_b16 %7, %9 offset:3072\n\ts_waitcnt lgkmcnt(0)"
                     : "=&v"(a[0][0]), "=&v"(a[0][1]), "=&v"(a[0][2]), "=&v"(a[0][3]), "=&v"(a[1][0]), "=&v"(a[1][1]), "=&v"(a[1][2]), "=&v"(a[1][3]) : "v"(va0_), "v"(va1_) : "memory");
        const bf16x8 pb0 = __builtin_bit_cast(bf16x8, pw[g][0]), pb1 = __builtin_bit_cast(bf16x8, pw[g][1]);
#pragma unroll
        for (int dh = 0; dh < 2; ++dh) {
            const bf16x8 va0 = (bf16x8){a[dh][0][0], a[dh][0][1], a[dh][0][2], a[dh][0][3], a[dh][1][0], a[dh][1][1], a[dh][1][2], a[dh][1][3]};
            const bf16x8 va1 = (bf16x8){a[dh][2][0], a[dh][2][1], a[dh][2][2], a[dh][2][3], a[dh][3][0], a[dh][3][1], a[dh][3][2], a[dh][3][3]};
            o[dh] = __builtin_amdgcn_mfma_f32_32x32x16_bf16(va0, pb0, o[dh], 0, 0, 0);
            o[dh] = __builtin_amdgcn_mfma_f32_32x32x16_bf16(va1, pb1, o[dh], 0, 0, 0);
        }
    }
}

template <bool NT>
__device__ __forceinline__ void store_o(const f32x16 (&o)[2], const float l, char* orow_q, const int h, const bool valid = true) {
    const float il = 1.0f / l;
#pragma unroll
    for (int dh = 0; dh < 2; ++dh)
#pragma unroll
        for (int jj = 0; jj < 2; ++jj) {
            u32x2 we, wo;
            we[0] = pk_bf16(o[dh][8 * jj] * il, o[dh][8 * jj + 1] * il); we[1] = pk_bf16(o[dh][8 * jj + 2] * il, o[dh][8 * jj + 3] * il);
            wo[0] = pk_bf16(o[dh][8 * jj + 4] * il, o[dh][8 * jj + 5] * il); wo[1] = pk_bf16(o[dh][8 * jj + 6] * il, o[dh][8 * jj + 7] * il);
            const unsigned s0 = h ? we[0] : wo[0], s1 = h ? we[1] : wo[1];
            const unsigned r0 = (unsigned)__shfl_xor((int)s0, 32), r1 = (unsigned)__shfl_xor((int)s1, 32);
            u32x4 w; if (h == 0) { w[0] = we[0]; w[1] = we[1]; w[2] = r0; w[3] = r1; } else { w[0] = r0; w[1] = r1; w[2] = wo[0]; w[3] = wo[1]; }
            u32x4* dst = (u32x4*)(orow_q + (32 * dh + 16 * jj + 8 * h) * 2);
            if (valid) { if (NT) __builtin_nontemporal_store(w, dst); else *dst = w; }
        }
}

__device__ __forceinline__ unsigned moba_select(const char* qbase, const long qs, const float* km, const int qb) {
    const int lane = threadIdx.x & 63, q = lane & 31, h = lane >> 5;
    f32x16 g = f32x16{};
    const float* kmrow = km + (size_t)(q & 15) * 256;
    const bool lo_part = q >= 16;
#pragma unroll
    for (int d0 = 0; d0 < 4; ++d0) {
        const bf16x8 qf = *(const bf16x8*)(qbase + (long)q * qs + (16 * d0 + 8 * h) * 2);
        const f32x4 f0 = *(const f32x4*)(kmrow + 16 * d0 + 8 * h), f1 = *(const f32x4*)(kmrow + 16 * d0 + 8 * h + 4);
        float v[8] = {f0[0], f0[1], f0[2], f0[3], f1[0], f1[1], f1[2], f1[3]};
        u32x4 aw;
#pragma unroll
        for (int j = 0; j < 4; ++j) {
            const float h0 = bf16_round(v[2 * j]), h1 = bf16_round(v[2 * j + 1]);
            const float x0 = lo_part ? (v[2 * j] - h0) : h0, x1 = lo_part ? (v[2 * j + 1] - h1) : h1;
            aw[j] = pk_bf16(x0, x1);
        }
        g = __builtin_amdgcn_mfma_f32_32x32x16_bf16(__builtin_bit_cast(bf16x8, aw), qf, g, 0, 0, 0);
    }
    float gate[8], other[8];
#pragma unroll
    for (int r = 0; r < 8; ++r) { gate[r] = g[r] + g[r + 8]; }
#pragma unroll
    for (int r = 0; r < 8; ++r) { other[r] = __shfl_xor(gate[r], 32); }
    unsigned mymask = 0u;
#pragma unroll
    for (int r = 0; r < 8; ++r) {
        const int n = (r & 3) + 8 * (r >> 2) + 4 * h;
        int rank = 0;
#pragma unroll
        for (int r2 = 0; r2 < 8; ++r2) {
            const int n2 = (r2 & 3) + 8 * (r2 >> 2) + 4 * h, n3 = (r2 & 3) + 8 * (r2 >> 2) + 4 * (1 - h);
            if (r2 != r) rank += (n2 < qb && (gate[r2] > gate[r] || (gate[r2] == gate[r] && n2 < n))) ? 1 : 0;
            rank += (n3 < qb && (other[r2] > gate[r] || (other[r2] == gate[r] && n3 < n))) ? 1 : 0;
        }
        if (n < qb && rank < 3) mymask |= 1u << n;
    }
    return mymask | (unsigned)__shfl_xor((int)mymask, 32);
}
}


namespace mk {
using pg8::bf16_t; using pg8::bf16x8; using pg8::f32x4; using pg8::f32x2; using pg8::u32x4; using pg8::u32x2; using pg8::Unit; using pg8::cvt_pk_bf16;
#define LAS __attribute__((address_space(3)))
constexpr int NBAT = MK_NBAT, SEQ = 4096, D = 1024, DFF = 2816, NMEM = 256, M = NBAT * SEQ, MM = NBAT * NMEM, NQKV = 3072;
constexpr float EPS = 1e-6f, LOG2E = 1.4426950408889634f;
constexpr int NWAVES = 8, NPH = 13;

constexpr size_t al256(size_t x) { return (x + 255) / 256 * 256; }
constexpr size_t WS_CTL = 0, CTL_BYTES = 1u << 20;
constexpr size_t WS_WGU1 = WS_CTL + CTL_BYTES;
constexpr size_t WS_WD1 = WS_WGU1 + (size_t)2 * DFF * D * 2;
constexpr size_t WS_WIN = WS_WD1 + (size_t)D * DFF * 2;
constexpr size_t WS_WOUT = WS_WIN + (size_t)NQKV * D * 2;
constexpr size_t WS_WCQS = WS_WOUT + (size_t)D * D * 2;
constexpr size_t WS_WCKV = WS_WCQS + (size_t)D * D * 2;
constexpr size_t WS_WCO = WS_WCKV + (size_t)2 * D * D * 2;
constexpr size_t WS_WGU2 = WS_WCO + (size_t)D * D * 2;
constexpr size_t WS_WD2 = WS_WGU2 + (size_t)2 * DFF * D * 2;
constexpr size_t WS_MB = WS_WD2 + (size_t)D * DFF * 2;
constexpr size_t WS_KVC = WS_MB + (size_t)MM * D * 2;
constexpr size_t WS_WKT = WS_KVC + (size_t)MM * 2 * D * 2;
constexpr size_t WS_VWT = WS_WKT + (size_t)NBAT * D * D * 2;
constexpr size_t SS_BYTES = (size_t)M * 16 * 4;
constexpr size_t WS_SS = WS_VWT + (size_t)NBAT * D * D * 2;
constexpr size_t WS_SSM = WS_SS + 5 * SS_BYTES;
constexpr size_t WS_KM = WS_SSM + (size_t)MM * 16 * 4;
constexpr size_t WS_R1 = al256(WS_KM + (size_t)NBAT * 16 * 256 * 4);
constexpr size_t WS_XB = WS_R1 + (size_t)M * NQKV * 2;
constexpr size_t WS_OA2 = WS_XB + (size_t)M * D * 2;
constexpr size_t WS_SEL = WS_OA2 + (size_t)M * 768 * 2;
constexpr size_t WS_OBP = WS_SEL + (size_t)NBAT * 4 * SEQ * 4;
constexpr size_t WS_MLB = WS_OBP + (size_t)4 * M * 256 * 2;
constexpr size_t WS_END = WS_MLB + (size_t)4 * M * 4 * 2 * 4;
constexpr size_t OUT_OA1 = (size_t)M * 768 * 2, OUT_OB = 2 * OUT_OA1, OUT_ML = OUT_OB + (size_t)M * 256 * 2;
static_assert(OUT_ML + (size_t)3 * M * 12 * 8 <= (size_t)M * D * 4, "attention partials fit in d_out");
constexpr int CW_BAR = 4096, CW_QUEUE = 8192;

constexpr int LDS_XCH = 131072;
constexpr int LDS_MISC = 131072 + 8192;
constexpr int LDS_BYTES = 147456;
constexpr int LDS_TAB = 98304;
static_assert(LDS_TAB + 36 * att::TABA_N * 4 <= LDS_XCH && LDS_TAB + 4 * att::TABB_N * 4 <= LDS_XCH, "attention LDS map");

__device__ __forceinline__ float wave_sum(float v) {
#pragma unroll
    for (int o = 1; o < 64; o <<= 1) v += __shfl_xor(v, o);
    return v;
}
__device__ __forceinline__ float row_rstd(const float* ss, int row) {
    const f32x4* p = (const f32x4*)(ss + (size_t)row * 16);
    const f32x4 a = p[0], b = p[1], c = p[2], d = p[3];
    const float s = ((a[0] + a[1]) + (a[2] + a[3])) + ((b[0] + b[1]) + (b[2] + b[3])) + ((c[0] + c[1]) + (c[2] + c[3])) + ((d[0] + d[1]) + (d[2] + d[3]));
    return 1.0f / sqrtf(s * (1.0f / D) + EPS);
}

struct SchedStd {
    pg8::Order o; const char* A; const char* B; size_t a_tile, b_tile, b_batch; int ocol_mul;
    __device__ __forceinline__ bool next(int i, Unit& u) const { int pm, pn; if (!o.tile(i, pm, pn)) return false;
        u.a = A + (size_t)pm * a_tile; u.b = B + (size_t)pn * b_tile + (size_t)(pm >> 4) * b_batch; u.orow = pm * 256; u.ocol = pn * ocol_mul; u.aux = pn; return true; }
};
struct SchedWK {
    int G, c; const char* kvc; const char* wcqs;
    __device__ __forceinline__ bool next(int i, Unit& u) const { const int L = i * G + c; if (L >= NBAT * 16) return false; const int bh = L >> 2, pn = L & 3, b = bh >> 2, h = bh & 3;
        u.a = kvc + ((size_t)(b * 256) * 2048 + h * 256) * 2; u.b = wcqs + ((size_t)(pn * 256) * 1024 + h * 256) * 2; u.orow = b * 1024 + h * 256; u.ocol = pn * 256; u.aux = 0; return true; }
};
struct SchedVW {
    int G, c; const char* kvc; const char* wcot;
    __device__ __forceinline__ bool next(int i, Unit& u) const { const int L = i * G + c; if (L >= NBAT * 16) return false; const int bh = L >> 2, pm = L & 3, b = bh >> 2, h = bh & 3;
        u.a = wcot + ((size_t)(pm * 256) * 1024 + h * 256) * 2; u.b = kvc + ((size_t)(b * 256) * 2048 + 1024 + h * 256) * 2; u.orow = b * 1024 + pm * 256; u.ocol = h * 256; u.aux = 0; return true; }
};

struct EpiGU { static constexpr bool PERM = true;
    bf16_t* H; const float* ss;
    __device__ __forceinline__ void operator()(const f32x4 (&acc)[2][2][4][2], const Unit& u, int wr, int wc, int fr, int fq, LAS unsigned char*, int, int) const {
        float rsv[2][4];
#pragma unroll
        for (int ai = 0; ai < 2; ++ai)
#pragma unroll
            for (int m = 0; m < 4; ++m) rsv[ai][m] = row_rstd(ss, u.orow + ai * 128 + wr * 64 + m * 16 + fr);
#pragma unroll
        for (int ai = 0; ai < 2; ++ai)
#pragma unroll
            for (int m = 0; m < 4; ++m) { const int row = u.orow + ai * 128 + wr * 64 + m * 16 + fr; const float rs = rsv[ai][m];
                float hv[8];
#pragma unroll
                for (int n = 0; n < 2; ++n)
#pragma unroll
                    for (int j = 0; j < 4; ++j) { const float g = acc[ai][0][m][n][j] * rs, uu = acc[ai][1][m][n][j] * rs;
                        hv[4 * n + j] = g * __builtin_amdgcn_rcpf(1.0f + __builtin_amdgcn_exp2f(-g * LOG2E)) * uu; }
                u32x4 w; w[0] = cvt_pk_bf16(hv[0], hv[1]); w[1] = cvt_pk_bf16(hv[2], hv[3]); w[2] = cvt_pk_bf16(hv[4], hv[5]); w[3] = cvt_pk_bf16(hv[6], hv[7]);
                __builtin_nontemporal_store(w, (u32x4*)(H + (size_t)row * DFF + u.ocol + wc * 32 + 8 * fq)); }
    }
};
struct EpiRes { static constexpr bool PERM = true;
    bf16_t* xb; float* ssout; float alpha;
    __device__ __forceinline__ void operator()(const f32x4 (&acc)[2][2][4][2], const Unit& u, int wr, int wc, int fr, int fq, LAS unsigned char*, int, int) const {
        const size_t off0 = (size_t)(u.orow + wr * 64 + fr) * D + u.ocol + wc * 32 + 8 * fq;
        u32x4 cur[2], nxt[2];
#pragma unroll
        for (int bj = 0; bj < 2; ++bj) cur[bj] = *(const u32x4*)(xb + off0 + bj * 128);
#pragma unroll
        for (int idx = 0; idx < 8; ++idx) { const int ai = idx >> 2, m = idx & 3; const size_t off = off0 + (size_t)(ai * 128 + m * 16) * D; const int row = u.orow + ai * 128 + wr * 64 + m * 16 + fr;
            if (idx < 7) { const size_t offn = off0 + (size_t)(((idx + 1) >> 2) * 128 + ((idx + 1) & 3) * 16) * D;
#pragma unroll
                for (int bj = 0; bj < 2; ++bj) nxt[bj] = *(const u32x4*)(xb + offn + bj * 128); }
            float sq = 0.f;
#pragma unroll
            for (int bj = 0; bj < 2; ++bj) { float o[8];
#pragma unroll
                for (int n = 0; n < 2; ++n)
#pragma unroll
                    for (int j = 0; j < 4; ++j) { const unsigned wv = cur[bj][2 * n + (j >> 1)]; const float r = __builtin_bit_cast(float, (j & 1) ? (wv & 0xffff0000u) : (wv << 16));
                        const float v = r + acc[ai][bj][m][n][j] * alpha; o[4 * n + j] = v; sq += v * v; }
                u32x4 w; w[0] = cvt_pk_bf16(o[0], o[1]); w[1] = cvt_pk_bf16(o[2], o[3]); w[2] = cvt_pk_bf16(o[4], o[5]); w[3] = cvt_pk_bf16(o[6], o[7]);
                *(u32x4*)(xb + off + bj * 128) = w; }
            sq += __shfl_xor(sq, 16); sq += __shfl_xor(sq, 32);
            if (fq == 0) ssout[(size_t)row * 16 + (u.ocol >> 8) * 4 + wc] = sq;
#pragma unroll
            for (int bj = 0; bj < 2; ++bj) cur[bj] = nxt[bj]; }
    }
};
struct EpiStore { static constexpr bool PERM = true;
    bf16_t* O; int ldc; const float* ss; float* km; bool nt;
    __device__ __forceinline__ void operator()(const f32x4 (&acc)[2][2][4][2], const Unit& u, int wr, int wc, int fr, int fq, LAS unsigned char*, int, int) const {
        float rsv[2][4];
#pragma unroll
        for (int ai = 0; ai < 2; ++ai)
#pragma unroll
            for (int m = 0; m < 4; ++m) rsv[ai][m] = ss ? row_rstd(ss, u.orow + ai * 128 + wr * 64 + m * 16 + fr) : 1.0f;
#pragma unroll
        for (int ai = 0; ai < 2; ++ai)
#pragma unroll
            for (int m = 0; m < 4; ++m) { const int row = u.orow + ai * 128 + wr * 64 + m * 16 + fr; const float rs = rsv[ai][m];
                const int col0 = u.ocol + wc * 32 + 8 * fq;
                bf16_t* rowp = ldc ? O + (size_t)row * ldc + col0 : O + (((size_t)(row / SEQ) * (NQKV / 64) + (col0 >> 6)) * SEQ + (row % SEQ)) * 64 + (col0 & 63);
                const size_t bjstep = ldc ? 128 : (size_t)2 * SEQ * 64;
#pragma unroll
                for (int bj = 0; bj < 2; ++bj) { const f32x4 v0 = acc[ai][bj][m][0] * rs, v1 = acc[ai][bj][m][1] * rs;
                    u32x4 w; w[0] = cvt_pk_bf16(v0[0], v0[1]); w[1] = cvt_pk_bf16(v0[2], v0[3]); w[2] = cvt_pk_bf16(v1[0], v1[1]); w[3] = cvt_pk_bf16(v1[2], v1[3]);
                    if (nt) __builtin_nontemporal_store(w, (u32x4*)(rowp + bj * bjstep)); else *(u32x4*)(rowp + bj * bjstep) = w; } }
        if ((km != nullptr) && (u.aux == 10)) {
            float* kmb = km + (size_t)(u.orow >> 8) * 256 + wc * 32 + 8 * fq;
#pragma unroll
            for (int bj = 0; bj < 2; ++bj)
#pragma unroll
                for (int n = 0; n < 2; ++n) { f32x4 cs = (f32x4){0.f, 0.f, 0.f, 0.f};
#pragma unroll
                    for (int ai = 0; ai < 2; ++ai)
#pragma unroll
                        for (int m = 0; m < 4; ++m) cs += acc[ai][bj][m][n] * rsv[ai][m];
#pragma unroll
                    for (int j = 0; j < 4; ++j) { float v = cs[j]; v += __shfl_xor(v, 1); v += __shfl_xor(v, 2); v += __shfl_xor(v, 4); v += __shfl_xor(v, 8);
                        if (fr == 0) atomicAdd(kmb + bj * 128 + 4 * n + j, v); } }
        }
    }
};
struct EpiSoftmax { static constexpr bool PERM = true;
    bf16_t* P; const float* ss;
    __device__ __forceinline__ void operator()(const f32x4 (&acc)[2][2][4][2], const Unit& u, int wr, int wc, int fr, int fq, LAS unsigned char* lds, int, int) const {
        LAS f32x2* X = (LAS f32x2*)(lds + LDS_XCH);
        float rsl[2][4], mw[2][4];
#pragma unroll
        for (int ai = 0; ai < 2; ++ai)
#pragma unroll
            for (int m = 0; m < 4; ++m) { const int rl = ai * 128 + wr * 64 + m * 16 + fr; const float rs = row_rstd(ss, u.orow + rl) * LOG2E; rsl[ai][m] = rs;
                float mx = -INFINITY;
#pragma unroll
                for (int bj = 0; bj < 2; ++bj)
#pragma unroll
                    for (int n = 0; n < 2; ++n)
#pragma unroll
                        for (int j = 0; j < 4; ++j) mx = fmaxf(mx, acc[ai][bj][m][n][j] * rs);
                mx = fmaxf(mx, __shfl_xor(mx, 16)); mx = fmaxf(mx, __shfl_xor(mx, 32));
                float sm = 0.f;
#pragma unroll
                for (int bj = 0; bj < 2; ++bj)
#pragma unroll
                    for (int n = 0; n < 2; ++n)
#pragma unroll
                        for (int j = 0; j < 4; ++j) sm += __builtin_amdgcn_exp2f(acc[ai][bj][m][n][j] * rs - mx);
                sm += __shfl_xor(sm, 16); sm += __shfl_xor(sm, 32);
                mw[ai][m] = mx;
                if (fq == 0) X[rl * 4 + wc] = (f32x2){mx, sm}; }
        asm volatile("s_waitcnt lgkmcnt(0)" ::: "memory"); __builtin_amdgcn_s_barrier(); asm volatile("" ::: "memory");
#pragma unroll
        for (int ai = 0; ai < 2; ++ai)
#pragma unroll
            for (int m = 0; m < 4; ++m) { const int rl = ai * 128 + wr * 64 + m * 16 + fr; const float rs = rsl[ai][m];
                const f32x2 x0 = X[rl * 4 + 0], x1 = X[rl * 4 + 1], x2 = X[rl * 4 + 2], x3 = X[rl * 4 + 3];
                const float Mx = fmaxf(fmaxf(x0[0], x1[0]), fmaxf(x2[0], x3[0]));
                const float L = x0[1] * __builtin_amdgcn_exp2f(x0[0] - Mx) + x1[1] * __builtin_amdgcn_exp2f(x1[0] - Mx) + x2[1] * __builtin_amdgcn_exp2f(x2[0] - Mx) + x3[1] * __builtin_amdgcn_exp2f(x3[0] - Mx);
                const float il = 1.0f / L;
                bf16_t* rowp = P + (size_t)(u.orow + rl) * D + u.ocol + wc * 32 + 8 * fq;
#pragma unroll
                for (int bj = 0; bj < 2; ++bj) { float pv[8];
#pragma unroll
                    for (int n = 0; n < 2; ++n)
#pragma unroll
                        for (int j = 0; j < 4; ++j) pv[4 * n + j] = __builtin_amdgcn_exp2f(acc[ai][bj][m][n][j] * rs - Mx) * il;
                    u32x4 w; w[0] = cvt_pk_bf16(pv[0], pv[1]); w[1] = cvt_pk_bf16(pv[2], pv[3]); w[2] = cvt_pk_bf16(pv[4], pv[5]); w[3] = cvt_pk_bf16(pv[6], pv[7]);
                    *(u32x4*)(rowp + bj * 128) = w; } }
        (void)mw;
    }
};

#define XB_TMO      128
#define XB_XCNT(j)  (256  + 64 * (j))
#define XB_XSUB(j)  (1280 + 64 * (j))
#define XB_XGEN(j)  (2304 + 64 * (j))
#define XB_TOP      3328
#define XB_TOPGEN   3392
#define XCD_BAR_WORDS 3456
#define XB_SPIN_CAP (1u << 18)
__device__ __forceinline__ unsigned xb_ld(unsigned* p)              { return __hip_atomic_load(p, __ATOMIC_RELAXED, __HIP_MEMORY_SCOPE_AGENT); }
__device__ __forceinline__ unsigned xb_add(unsigned* p, unsigned v) { return __hip_atomic_fetch_add(p, v, __ATOMIC_RELAXED, __HIP_MEMORY_SCOPE_AGENT); }
__device__ __forceinline__ unsigned xb_xcc_id() { return (unsigned)__builtin_amdgcn_s_getreg((3 << 11) | 20) & 0xFu; }
#define XB_SPIN(cond, bar) do { unsigned _sp = 0; while (cond) { __builtin_amdgcn_s_sleep(1); \
    if ((++_sp & 255u) == 0u) { if (xb_ld(&(bar)[XB_TMO])) break; if (_sp > XB_SPIN_CAP) { atomicAdd(&(bar)[XB_TMO], 1u); break; } } } } while (0)
struct XcdBarrier { unsigned* bar; unsigned x; volatile LAS unsigned* st; };
__device__ __forceinline__ XcdBarrier xcd_barrier_post(unsigned* bar, volatile LAS unsigned* st) {
    XcdBarrier b; b.bar = bar; b.x = xb_xcc_id(); b.st = st;
    if (threadIdx.x == 0) (void)xb_add(&bar[XB_XCNT(b.x)], 1u);
    return b;
}
__device__ __forceinline__ void xcd_barrier_complete(unsigned* bar, unsigned x, unsigned& nloc, unsigned& nx) {
    const unsigned G = gridDim.x * gridDim.y * gridDim.z;
    unsigned sum, cnt, mine, sp = 0u;
    for (;;) {
        sum = 0u; cnt = 0u; mine = 0u;
#pragma unroll
        for (unsigned j = 0; j < 16; ++j) { const unsigned c = xb_ld(&bar[XB_XCNT(j)]); sum += c; cnt += (c > 0u) ? 1u : 0u; mine = (j == x) ? c : mine; }
        if (sum == G) break;
        __builtin_amdgcn_s_sleep(1);
        if ((++sp & 255u) == 0u) { if (xb_ld(&bar[XB_TMO])) break; if (sp > XB_SPIN_CAP) { atomicAdd(&bar[XB_TMO], 1u); break; } }
    }
    nloc = mine > 0u ? mine : 1u; nx = cnt > 0u ? cnt : 1u;
}
__device__ __forceinline__ void xcd_barrier(const XcdBarrier& b) {
    asm volatile("s_waitcnt vmcnt(0)" ::: "memory");
    __syncthreads();
    if (threadIdx.x == 0) {
        unsigned* bar = b.bar;
        __builtin_amdgcn_s_waitcnt(0);
        unsigned nloc = b.st[0], nx = b.st[1];
        if (nloc == 0u) { xcd_barrier_complete(bar, b.x, nloc, nx); b.st[0] = nloc; b.st[1] = nx; }
        const unsigned old = xb_add(&bar[XB_XSUB(b.x)], 1u);
        const unsigned gen = old / nloc;
        if (old + 1u == (gen + 1u) * nloc) {
            __builtin_amdgcn_fence(__ATOMIC_RELEASE, "agent");
            asm volatile("s_waitcnt vmcnt(0)" ::: "memory");
            const unsigned og = xb_add(&bar[XB_TOP], 1u);
            const unsigned tg = og / nx;
            if (og + 1u == (tg + 1u) * nx) xb_add(&bar[XB_TOPGEN], 1u);
            else XB_SPIN(xb_ld(&bar[XB_TOPGEN]) == tg, bar);
            __builtin_amdgcn_fence(__ATOMIC_ACQUIRE, "agent");
            xb_add(&bar[XB_XGEN(b.x)], 1u);
            asm volatile("s_waitcnt vmcnt(0)" ::: "memory");
        } else {
            XB_SPIN(xb_ld(&bar[XB_XGEN(b.x)]) == gen, bar);
            __builtin_amdgcn_fence(__ATOMIC_ACQUIRE, "agent");
            asm volatile("s_waitcnt vmcnt(0)" ::: "memory");
        }
    }
    __syncthreads();
}

__device__ __forceinline__ void tr_item(const float* W, int N, int k0, int n0, const float* gain, float cscale, bf16_t* dst  , int Kd, LAS float* scr, int lane) {
    f32x4 v[8]; float g[8];
#pragma unroll
    for (int i = 0; i < 8; ++i) { const int kk = 8 * i + (lane >> 3); v[i] = __builtin_nontemporal_load((const f32x4*)(W + (size_t)(k0 + kk) * N + n0 + 4 * (lane & 7))); g[i] = gain ? gain[k0 + kk] * cscale : cscale; }
#pragma unroll
    for (int i = 0; i < 8; ++i) { const int kk = 8 * i + (lane >> 3); LAS float* d = scr + kk * 33 + 4 * (lane & 7); d[0] = v[i][0] * g[i]; d[1] = v[i][1] * g[i]; d[2] = v[i][2] * g[i]; d[3] = v[i][3] * g[i]; }
    asm volatile("s_waitcnt lgkmcnt(0)" ::: "memory");
    const int c = lane & 7;
#pragma unroll
    for (int j = 0; j < 4; ++j) { const int n = (lane >> 3) + 8 * j; const LAS float* s = scr + (8 * c) * 33 + n;
        u32x4 o; o[0] = cvt_pk_bf16(s[0 * 33], s[1 * 33]); o[1] = cvt_pk_bf16(s[2 * 33], s[3 * 33]); o[2] = cvt_pk_bf16(s[4 * 33], s[5 * 33]); o[3] = cvt_pk_bf16(s[6 * 33], s[7 * 33]);
        *(u32x4*)(dst + (size_t)n * Kd + k0 + 8 * c) = o; }
    asm volatile("s_waitcnt lgkmcnt(0)" ::: "memory");
}
template <int NR>
__device__ __forceinline__ void cvt_rows(const float* x, bf16_t* o, float* ss, int row0, int stride, int nrows, int lane) {
    f32x4 v[NR][4]; float s[NR];
#pragma unroll
    for (int r = 0; r < NR; ++r) { const int row = row0 + r * stride; const f32x4* xr = (const f32x4*)(x + (size_t)(row < nrows ? row : row0) * D) + lane;
#pragma unroll
        for (int j = 0; j < 4; ++j) v[r][j] = __builtin_nontemporal_load(xr + 64 * j); }
#pragma unroll
    for (int r = 0; r < NR; ++r) { float a = 0.f;
#pragma unroll
        for (int j = 0; j < 4; ++j) a += (v[r][j][0] * v[r][j][0] + v[r][j][1] * v[r][j][1]) + (v[r][j][2] * v[r][j][2] + v[r][j][3] * v[r][j][3]);
        s[r] = a; }
#pragma unroll
    for (int of = 1; of < 64; of <<= 1)
#pragma unroll
        for (int r = 0; r < NR; ++r) s[r] += __shfl_xor(s[r], of);
#pragma unroll
    for (int r = 0; r < NR; ++r) { const int row = row0 + r * stride; if (row < nrows) { u32x2* o8 = (u32x2*)(o + (size_t)row * D) + lane;
#pragma unroll
            for (int j = 0; j < 4; ++j) { u32x2 w; w[0] = cvt_pk_bf16(v[r][j][0], v[r][j][1]); w[1] = cvt_pk_bf16(v[r][j][2], v[r][j][3]); o8[64 * j] = w; }
            if (lane < 16) ss[(size_t)row * 16 + lane] = lane == 0 ? s[r] : 0.f; } }
}

struct Args { const float* in[20]; float* out; unsigned char* ws; int ph_lo, ph_hi, flags, pad; };

#define MK_PTRS unsigned char* ws = args.ws; float* out = args.out; asm volatile("" : "+s"(ws), "+s"(out)); \
    const float* x_in = args.in[0]; const float* mem_in = args.in[1]; const float* rel_bias = args.in[7]; \
    bf16_t* Wgu1 = (bf16_t*)(ws + WS_WGU1); bf16_t* Wd1 = (bf16_t*)(ws + WS_WD1); bf16_t* Win = (bf16_t*)(ws + WS_WIN); bf16_t* Wout = (bf16_t*)(ws + WS_WOUT); \
    bf16_t* Wcqs = (bf16_t*)(ws + WS_WCQS); bf16_t* Wckv = (bf16_t*)(ws + WS_WCKV); bf16_t* Wco = (bf16_t*)(ws + WS_WCO); bf16_t* Wgu2 = (bf16_t*)(ws + WS_WGU2); bf16_t* Wd2 = (bf16_t*)(ws + WS_WD2); \
    bf16_t* MB = (bf16_t*)(ws + WS_MB); bf16_t* KVC = (bf16_t*)(ws + WS_KVC); bf16_t* WKT = (bf16_t*)(ws + WS_WKT); bf16_t* VWT = (bf16_t*)(ws + WS_VWT); \
    float* SS0 = (float*)(ws + WS_SS); float* SS1 = SS0 + (size_t)M * 16; float* SS2 = SS1 + (size_t)M * 16; float* SS3 = SS2 + (size_t)M * 16; float* SS4 = SS3 + (size_t)M * 16; \
    float* SSM = (float*)(ws + WS_SSM); float* KM = (float*)(ws + WS_KM); \
    bf16_t* HB = (bf16_t*)(ws + WS_R1); bf16_t* QKV = HB; bf16_t* YN = HB; bf16_t* PB = HB; \
    bf16_t* XB = (bf16_t*)(ws + WS_XB); bf16_t* OA0 = (bf16_t*)out; bf16_t* OA1 = (bf16_t*)((char*)out + OUT_OA1); bf16_t* OA2 = (bf16_t*)(ws + WS_OA2); bf16_t* OB = (bf16_t*)((char*)out + OUT_OB); float* ML = (float*)((char*)out + OUT_ML); unsigned* SEL = (unsigned*)(ws + WS_SEL); bf16_t* OBP = (bf16_t*)(ws + WS_OBP); float* MLB = (float*)(ws + WS_MLB); (void)OB;
__global__ void __launch_bounds__(NWAVES * 64, 2) mk_fwd(Args args) {
    extern __shared__ __attribute__((aligned(16))) unsigned char lds_raw[];
    LAS unsigned char* lds = (LAS unsigned char*)lds_raw;
    const int tid = threadIdx.x, lane = tid & 63, wave = __builtin_amdgcn_readfirstlane(tid >> 6);
    const int G = gridDim.x, bx = blockIdx.x;
    const int vcu = (G % 8 == 0) ? (bx % 8) * (G / 8) + bx / 8 : bx;
    const int gw = vcu * NWAVES + wave, NGW = G * NWAVES;
    unsigned char* const ws0 = args.ws;
    volatile LAS unsigned* MISC = (volatile LAS unsigned*)(lds + LDS_MISC);
    if (tid < 32) MISC[tid] = 0u;
    __syncthreads();
    const int lo = args.ph_lo, hi = args.ph_hi;
    const bool use_bar = (hi - lo) > 1;
    XcdBarrier bar; bar.bar = (unsigned*)(ws0 + WS_CTL) + CW_BAR; bar.x = 0; bar.st = nullptr;
    if (use_bar) bar = xcd_barrier_post((unsigned*)(ws0 + WS_CTL) + CW_BAR, MISC + 8);
#define IN(k) (lo <= (k) && (k) < hi)
#define STAGGER() do { if (MK_STAGGER_TICKS > 0) { const unsigned long long t0_ = __builtin_amdgcn_s_memrealtime(), dl_ = (unsigned long long)((bx >> 3) & 3) * MK_STAGGER_TICKS; while (__builtin_amdgcn_s_memrealtime() - t0_ < dl_) __builtin_amdgcn_s_sleep(8); } } while (0)
#define SEAM(k) do { if (IN(k) && IN((k) + 1)) xcd_barrier(bar); } while (0)

    if (IN(0)) {
        MK_PTRS;
        LAS float* scr = (LAS float*)(lds + wave * 16384);
        constexpr int I_GU = (D / 64) * (2 * DFF / 32), I_DN = (DFF / 64) * (D / 32), I_IN = (D / 64) * (NQKV / 32), I_SQ = (D / 64) * (D / 32), I_KV = (D / 64) * (2 * D / 32);
        constexpr int NITEMS = 2 * I_GU + 2 * I_DN + I_IN + 2 * I_SQ + I_KV;
        for (int it = gw; it < NITEMS; it += NGW) {
            int r = it;
            if (r < 2 * I_GU) {
                const bool second = r >= I_GU; if (second) r -= I_GU;
                const int nblk = 2 * DFF / 32, kb = r / nblk, nb = r % nblk, n0 = nb * 32;
                const int drow = n0 < DFF ? (n0 / 128) * 256 + (n0 % 128) : ((n0 - DFF) / 128) * 256 + 128 + ((n0 - DFF) % 128);
                tr_item(args.in[second ? 17 : 3], 2 * DFF, kb * 64, n0, args.in[second ? 16 : 2], 1.0f, (second ? Wgu2 : Wgu1) + (size_t)drow * D, D, scr, lane); continue; }
            r -= 2 * I_GU;
            if (r < 2 * I_DN) { const bool second = r >= I_DN; if (second) r -= I_DN; const int nblk = D / 32, kb = r / nblk, nb = r % nblk;
                tr_item(args.in[second ? 18 : 4], D, kb * 64, nb * 32, nullptr, 1.0f, (second ? Wd2 : Wd1) + (size_t)(nb * 32) * DFF, DFF, scr, lane); continue; }
            r -= 2 * I_DN;
            if (r < I_IN) { const int nblk = NQKV / 32, kb = r / nblk, nb = r % nblk, n0 = nb * 32; const bool isq = (n0 < 768) || (n0 >= 2304 && n0 < 2560);
                tr_item(args.in[6], NQKV, kb * 64, n0, args.in[5], isq ? 0.125f : 1.0f, Win + (size_t)n0 * D, D, scr, lane); continue; }
            r -= I_IN;
            if (r < I_SQ) { const int nblk = D / 32, kb = r / nblk, nb = r % nblk, k0 = kb * 64; const float* gp = k0 < 768 ? args.in[8] : args.in[9] - 768;
                tr_item(args.in[10], D, k0, nb * 32, gp, 1.0f, Wout + (size_t)(nb * 32) * D, D, scr, lane); continue; }
            r -= I_SQ;
            if (r < I_SQ) { const int nblk = D / 32, kb = r / nblk, nb = r % nblk; tr_item(args.in[15], D, kb * 64, nb * 32, nullptr, 1.0f, Wco + (size_t)(nb * 32) * D, D, scr, lane); continue; }
            r -= I_SQ;
            { const int nblk = 2 * D / 32, kb = r / nblk, nb = r % nblk; tr_item(args.in[14], 2 * D, kb * 64, nb * 32, args.in[12], 1.0f, Wckv + (size_t)(nb * 32) * D, D, scr, lane); }
        }
        for (int c = gw; c < D; c += NGW) { const float g = args.in[11][c] * 0.0625f; const f32x4* src = (const f32x4*)(args.in[13] + (size_t)c * D) + lane; u32x2* dst = (u32x2*)(Wcqs + (size_t)c * D) + lane;
#pragma unroll
            for (int j = 0; j < 4; ++j) { const f32x4 v = src[64 * j] * g; u32x2 w; w[0] = cvt_pk_bf16(v[0], v[1]); w[1] = cvt_pk_bf16(v[2], v[3]); dst[64 * j] = w; } }
        for (int m = gw; m < M; m += 4 * NGW) cvt_rows<4>(x_in, XB, SS0, m, NGW, M, lane);
        for (int m = gw; m < MM; m += NGW) cvt_rows<1>(mem_in, MB, SSM, m, NGW, MM, lane);
        for (int i = gw * 64 + lane; i < NBAT * 16 * 256; i += NGW * 64) KM[i] = 0.f;
    }
    SEAM(0);

    if (IN(1)) {
        MK_PTRS;
        STAGGER();
        { SchedStd S; S.o.init(M, 2 * DFF, G, bx); S.A = (const char*)XB; S.B = (const char*)Wgu1; S.a_tile = (size_t)256 * D * 2; S.b_tile = (size_t)256 * D * 2; S.b_batch = 0; S.ocol_mul = 128;
          EpiGU E{HB, SS0}; pg8::gemm_phase<EpiGU, SchedStd, true>(lds, D, D, D / 64, S, E); }
        { SchedStd S; S.o.init(MM, 2 * D, G, (bx + G / 2) % G); S.A = (const char*)MB; S.B = (const char*)Wckv; S.a_tile = (size_t)256 * D * 2; S.b_tile = (size_t)256 * D * 2; S.b_batch = 0; S.ocol_mul = 256;
          EpiStore E{KVC, 2 * D, SSM, nullptr, false}; pg8::gemm_phase<EpiStore, SchedStd, true>(lds, D, D, D / 64, S, E); }
    }
    SEAM(1);

    if (IN(2)) {
        MK_PTRS;
        SchedStd S; S.o.init(M, D, G, bx); S.A = (const char*)HB; S.B = (const char*)Wd1; S.a_tile = (size_t)256 * DFF * 2; S.b_tile = (size_t)256 * DFF * 2; S.b_batch = 0; S.ocol_mul = 256;
        EpiRes E{XB, SS1, 0.5f}; pg8::gemm_phase<EpiRes, SchedStd, true>(lds, DFF, DFF, DFF / 64, S, E);
    }
    SEAM(2);

    if (IN(3)) {
        MK_PTRS;
        { SchedStd S; S.o.init(M, NQKV, G, bx); S.A = (const char*)XB; S.B = (const char*)Win; S.a_tile = (size_t)256 * D * 2; S.b_tile = (size_t)256 * D * 2; S.b_batch = 0; S.ocol_mul = 256;
          EpiStore E{QKV, 0, SS1, KM, false}; pg8::gemm_phase<EpiStore, SchedStd, true>(lds, D, D, D / 64, S, E); }
        { SchedWK S{G, bx, (const char*)KVC, (const char*)Wcqs}; EpiStore E{WKT, D, nullptr, nullptr, false}; pg8::gemm_phase<EpiStore, SchedWK, true>(lds, 2 * D, D, 4, S, E); }
        { SchedVW S{G, (bx + G / 2) % G, (const char*)KVC, (const char*)Wco}; EpiStore E{VWT, D, nullptr, nullptr, false}; pg8::gemm_phase<EpiStore, SchedVW, true>(lds, D, 2 * D, 4, S, E); }
    }
    SEAM(3);

    if (IN(4)) {
        MK_PTRS;
        constexpr long HSTR4 = (long)SEQ * 128;
        for (int task = gw; task < NBAT * 4 * (SEQ / 32); task += NGW) { const int bh = task / (SEQ / 32), tl = task % (SEQ / 32), b = bh >> 2, hb = bh & 3, q0 = tl * 32, qb = q0 >> 8;
            const char* qbase = (const char*)QKV + ((size_t)b * 48 + 36 + hb) * HSTR4 + (size_t)q0 * 128;
            const unsigned msk = att::moba_select(qbase, 128, KM + (size_t)b * 16 * 256 + hb * 64, qb);
            if (lane < 32) SEL[(size_t)bh * SEQ + q0 + lane] = msk; }
    }
    SEAM(4);

    if (IN(5)) {
        MK_PTRS;
        LAS float* tab = (LAS float*)(lds + LDS_TAB);
        const int h2 = lane >> 5, q = lane & 31;
        const long rowb = 128;
        constexpr long HSTR = (long)SEQ * 128;
#define ATT_WAITV(n) asm volatile("s_waitcnt vmcnt(" #n ")" ::: "memory")
#define ATT_BAR() do { asm volatile("s_waitcnt lgkmcnt(0)" ::: "memory"); __builtin_amdgcn_s_barrier(); asm volatile("" ::: "memory"); } while (0)
        for (int i = tid; i < 4 * att::TABB_N; i += NWAVES * 64) { const int hb = i / att::TABB_N, e = i % att::TABB_N, dist = e - 32;
            tab[i] = dist >= 0 ? rel_bias[att::rel_bucket(dist) * 16 + 12 + hb] * LOG2E : -INFINITY; }
        __syncthreads();
        {
            constexpr int NBH = NBAT * 4, NUNITS = 16 * NBH;
            LAS unsigned* LQ = (LAS unsigned*)(lds + 65536);
            volatile LAS unsigned* UW = (volatile LAS unsigned*)(lds + 65536 + 16384);
            unsigned* qhead = (unsigned*)(ws + WS_CTL) + CW_QUEUE;
#pragma unroll 1
            for (;;) {
                if (tid == 0) UW[8] = __hip_atomic_fetch_add(qhead, 1u, __ATOMIC_RELAXED, __HIP_MEMORY_SCOPE_AGENT);
                ATT_BAR();
                const int u = (int)UW[8];
                if (u >= NUNITS) break;
                const int n = u / NBH, bh = u % NBH, b = bh >> 2, hb = bh & 3;
                const char* qh = (const char*)QKV + ((size_t)b * 48 + 36 + hb) * HSTR;
                const char* kh = (const char*)QKV + ((size_t)b * 48 + 40 + hb) * HSTR + (size_t)(256 * n) * rowb;
                const unsigned* selp = SEL + (size_t)bh * SEQ;
                ATT_WAITV(0);
#pragma unroll
                for (int k = wave; k < 32; k += NWAVES) { const int row = 8 * k + (lane >> 3); att::dma_rows8(kh + (long)row * rowb, (int)(4 * HSTR), row, (LAS char*)(lds + k * 1024), (LAS char*)(lds + 32768 + k * 1024), lane); }
                int total = 0;
                if (n < 15) {
                    const int lo = 256 * (n + 1) + wave * 32 * (15 - n), R = 32 * (15 - n);
                    int cnt = 0;
#pragma unroll 1
                    for (int i = 0; i < R; i += 64) { const bool pr = (i + lane < R) && ((selp[lo + i + lane] >> n) & 1u); cnt += __popcll(__ballot(pr)); }
                    if (lane == 0) UW[wave] = (unsigned)cnt;
                    ATT_BAR();
                    int basew = 0;
#pragma unroll
                    for (int w2 = 0; w2 < NWAVES; ++w2) { const int cw = (int)UW[w2]; basew += (w2 < wave) ? cw : 0; total += cw; }
#pragma unroll 1
                    for (int i = 0; i < R; i += 64) { const bool pr = (i + lane < R) && ((selp[lo + i + lane] >> n) & 1u); const unsigned long long bal = __ballot(pr);
                        if (pr) LQ[basew + __popcll(bal & ((1ull << lane) - 1ull))] = (unsigned)(lo + i + lane); basew += __popcll(bal); }
                }
                const int ntiles = (total + 31) >> 5;
                ATT_WAITV(0); ATT_BAR();
                const LAS float* tb = tab + hb * att::TABB_N;
#pragma unroll 1
                for (int tile = -1; tile < ntiles; tile = (tile < 0 ? wave : tile + NWAVES)) {
                    const bool own = tile < 0;
                    int tq; bool valid = true;
                    if (own) tq = 256 * n + 32 * wave + q; else { const int e = 32 * tile + q; valid = e < total; tq = (int)LQ[valid ? e : total - 1]; }
                    att::bf16x8 qf[4];
#pragma unroll
                    for (int d0 = 0; d0 < 4; ++d0) qf[d0] = *(const att::bf16x8*)(qh + (long)tq * rowb + (16 * d0 + 8 * h2) * 2);
                    const int slot = own ? 3 : __popc(selp[tq] & ((1u << n) - 1u));
                    att::f32x16 o[2]; o[0] = att::f32x16{}; o[1] = att::f32x16{}; float mo = -1e30f, lo_ = 0.f;
                    const int Bq = (tq - 256 * n + 32) - 4 * h2;
#pragma unroll 1
                    for (int g = own ? wave : 7; g >= 0; --g) { int B = Bq - 32 * g; B = B < (att::TABB_N - 1) ? B : (att::TABB_N - 1);
                        att::attn_group(qf, o, mo, lo_, (const LAS char*)(lds + g * 4096), (const LAS char*)(lds + 32768 + g * 4096), tb + B, lane); }
                    lo_ += __shfl_xor(lo_, 32);
                    const size_t prow = (size_t)slot * M + (size_t)b * SEQ + tq;
                    att::store_o<MK_NT_PART>(o, lo_, (char*)OBP + (prow * 256 + hb * 64) * 2, h2, valid);
                    if (h2 == 0 && valid) *(f32x2*)(MLB + (prow * 4 + hb) * 2) = (f32x2){mo, lo_};
                }
                ATT_BAR();
            }
        }
        __syncthreads();
        for (int i = tid; i < 36 * att::TABA_N; i += NWAVES * 64) { const int t = i / att::TABA_N, e = i % att::TABA_N, p = t / 12, h = t % 12, delta = e - 32, d = p == 0 ? 1 : (p == 1 ? 4 : 16);
            tab[i] = (delta >= 0 && delta <= 128) ? rel_bias[att::rel_bucket(delta * d) * 16 + h] * LOG2E : -INFINITY; }
        __syncthreads();
        constexpr int NDIL = NBAT * 12 * 48;
        struct DilItem { int b, h, p, d, res, m0, mbase; };
        auto decode = [&](int it, DilItem& I) { const int bh = it / 48, j = it % 48; I.b = bh / 12; I.h = bh % 12; I.p = j >> 4; const int jj = j & 15;
            I.d = I.p == 0 ? 1 : (I.p == 1 ? 4 : 16); I.res = I.p == 0 ? 0 : (I.p == 1 ? (jj & 3) : jj); const int mblk = I.p == 0 ? jj : (I.p == 1 ? (jj >> 2) : 0);
            I.mbase = mblk * 256 - 128; I.m0 = mblk * 256 + wave * 32; };
        att::bf16x8 qf[4];
        auto issue_k = [&](const DilItem& I) {
            const char* kb = (const char*)QKV + ((size_t)I.b * 48 + 12 + I.h) * HSTR + (size_t)I.res * rowb; const long st = (long)I.d * rowb;
#pragma unroll 1
            for (int k = wave; k < 48; k += NWAVES) { if (I.mbase + 8 * k < 0) continue; const int row = 8 * k + (lane >> 3); att::dma_k_rows8(kb + (long)(I.mbase + row) * st, row, (LAS char*)(lds + k * 1024), lane); } };
        auto issue_v = [&](const DilItem& I) {
            const char* vb = (const char*)QKV + ((size_t)I.b * 48 + 24 + I.h) * HSTR + (size_t)I.res * rowb; const long st = (long)I.d * rowb;
#pragma unroll 1
            for (int k = wave; k < 48; k += NWAVES) { if (I.mbase + 8 * k < 0) continue; const int row = 8 * k + (lane >> 3); att::dma_v_rows8(vb + (long)(I.mbase + row) * st, row, (LAS char*)(lds + 49152 + k * 1024), lane); } };
        auto load_q = [&](const DilItem& I) {
            const char* qp = (const char*)QKV + ((size_t)I.b * 48 + I.h) * HSTR + (size_t)I.res * rowb + (long)I.m0 * I.d * rowb + (long)q * I.d * rowb + 16 * h2;
            asm volatile("global_load_dwordx4 %0, %4, off\n\tglobal_load_dwordx4 %1, %4, off offset:32\n\tglobal_load_dwordx4 %2, %4, off offset:64\n\tglobal_load_dwordx4 %3, %4, off offset:96"
                         : "=&v"(qf[0]), "=&v"(qf[1]), "=&v"(qf[2]), "=&v"(qf[3]) : "v"(qp) : "memory"); };
        DilItem cur; int it = vcu;
        if (it < NDIL) { decode(it, cur); ATT_WAITV(0); issue_k(cur); load_q(cur); issue_v(cur); }
#pragma unroll 1
        for (; it < NDIL; it += G) {
            if (cur.mbase < 0) ATT_WAITV(4); else ATT_WAITV(6);
            asm volatile("" : "+v"(qf[0]), "+v"(qf[1]), "+v"(qf[2]), "+v"(qf[3]));
            ATT_BAR();
            const int m0 = cur.m0, gend = (m0 - 128) > 0 ? (m0 - 128) : 0, ng = ((m0 - gend) >> 5) + 1;
            att::u32x4 pw[5][2]; float mo, lo_;
            { att::bf16x8 qc[4] = {qf[0], qf[1], qf[2], qf[3]};
              att::dil_pass1(qc, ng, (const LAS char*)(lds + (m0 - cur.mbase) * 128), tab + (cur.p * 12 + cur.h) * att::TABA_N + 32 + q - 4 * h2, pw, mo, lo_, lane); }
            ATT_WAITV(0); ATT_BAR();
            const DilItem done = cur; const bool has_next = it + G < NDIL;
            if (has_next) { decode(it + G, cur); issue_k(cur); }
            att::f32x16 o[2];
            att::dil_pass2(ng, (const LAS char*)(lds + 49152 + (m0 - done.mbase) * 128), pw, o, lane);
            ATT_BAR();
            const size_t tok = (size_t)done.b * SEQ + (size_t)(m0 + q) * done.d + done.res;
            att::store_o<MK_NT_PART>(o, lo_, (char*)(done.p == 0 ? OA0 : (done.p == 1 ? OA1 : OA2)) + (tok * 768 + done.h * 64) * 2, h2);
            if (h2 == 0) *(f32x2*)(ML + (((size_t)done.p * M + tok) * 12 + done.h) * 2) = (f32x2){mo, lo_};
            if (has_next) { load_q(cur); issue_v(cur); }
        }
#undef ATT_WAITV
#undef ATT_BAR
    }
    SEAM(5);

    if (IN(6)) {
        MK_PTRS;
        for (int row0 = gw; row0 < M; row0 += 2 * NGW) {
            f32x2 ml[2][3][3]; u32x2 oa[2][3][3]; f32x2 mlb[2][4]; u32x2 obp[2][4];
#pragma unroll
            for (int r = 0; r < 2; ++r) { const int row = (row0 + r * NGW) < M ? (row0 + r * NGW) : row0;
#pragma unroll
                for (int k = 0; k < 3; ++k) { const int col = 256 * k + 4 * lane, hd = col >> 6;
#pragma unroll
                    for (int p = 0; p < 3; ++p) ml[r][k][p] = __builtin_nontemporal_load((const f32x2*)(ML + (((size_t)p * M + row) * 12 + hd) * 2));
                    oa[r][k][0] = __builtin_nontemporal_load((const u32x2*)(OA0 + (size_t)row * 768 + col)); oa[r][k][1] = __builtin_nontemporal_load((const u32x2*)(OA1 + (size_t)row * 768 + col)); oa[r][k][2] = __builtin_nontemporal_load((const u32x2*)(OA2 + (size_t)row * 768 + col)); }
#pragma unroll
                for (int s = 0; s < 4; ++s) { mlb[r][s] = __builtin_nontemporal_load((const f32x2*)(MLB + (((size_t)s * M + row) * 4 + (lane >> 4)) * 2)); obp[r][s] = __builtin_nontemporal_load((const u32x2*)(OBP + ((size_t)s * M + row) * 256 + 4 * lane)); } }
            float va[2][3][4], vb[2][4], ssa[2], ssb[2];
#pragma unroll
            for (int r = 0; r < 2; ++r) { ssa[r] = 0.f; ssb[r] = 0.f;
#pragma unroll
                for (int k = 0; k < 3; ++k) {
                    const float Mx = fmaxf(ml[r][k][0][0], fmaxf(ml[r][k][1][0], ml[r][k][2][0]));
                    const float w0 = ml[r][k][0][1] * __builtin_amdgcn_exp2f(ml[r][k][0][0] - Mx), w1 = ml[r][k][1][1] * __builtin_amdgcn_exp2f(ml[r][k][1][0] - Mx), w2 = ml[r][k][2][1] * __builtin_amdgcn_exp2f(ml[r][k][2][0] - Mx);
                    const float iw = 1.0f / (w0 + w1 + w2);
#pragma unroll
                    for (int e = 0; e < 4; ++e) { const unsigned s0 = oa[r][k][0][e >> 1], s1 = oa[r][k][1][e >> 1], s2 = oa[r][k][2][e >> 1];
                        const float f0 = __builtin_bit_cast(float, (e & 1) ? (s0 & 0xffff0000u) : (s0 << 16)), f1 = __builtin_bit_cast(float, (e & 1) ? (s1 & 0xffff0000u) : (s1 << 16)), f2 = __builtin_bit_cast(float, (e & 1) ? (s2 & 0xffff0000u) : (s2 << 16));
                        const float v = (w0 * f0 + w1 * f1 + w2 * f2) * iw; va[r][k][e] = v; ssa[r] += v * v; } }
                { const int rowq = (row0 + r * NGW) < M ? (row0 + r * NGW) : row0, nsel = (((rowq % SEQ) >> 8) < 3) ? ((rowq % SEQ) >> 8) : 3;
                  float wq[4], Mq = -INFINITY;
#pragma unroll
                  for (int s = 0; s < 4; ++s) { const bool use = (s == 3) || (s < nsel); Mq = use ? fmaxf(Mq, mlb[r][s][0]) : Mq; }
                  float wsum = 0.f;
#pragma unroll
                  for (int s = 0; s < 4; ++s) { const bool use = (s == 3) || (s < nsel); wq[s] = use ? mlb[r][s][1] * __builtin_amdgcn_exp2f(mlb[r][s][0] - Mq) : 0.f; wsum += wq[s]; }
                  const float iwq = 1.0f / wsum;
#pragma unroll
                  for (int e = 0; e < 4; ++e) { float acc_ = 0.f;
#pragma unroll
                      for (int s = 0; s < 4; ++s) { const bool use = (s == 3) || (s < nsel); const unsigned s0 = obp[r][s][e >> 1]; const float f = __builtin_bit_cast(float, (e & 1) ? (s0 & 0xffff0000u) : (s0 << 16)); acc_ += use ? wq[s] * f : 0.f; }
                      vb[r][e] = acc_ * iwq; ssb[r] += vb[r][e] * vb[r][e]; } } }
#pragma unroll
            for (int of = 1; of < 64; of <<= 1)
#pragma unroll
                for (int r = 0; r < 2; ++r) { ssa[r] += __shfl_xor(ssa[r], of); ssb[r] += __shfl_xor(ssb[r], of); }
#pragma unroll
            for (int r = 0; r < 2; ++r) { const int row = row0 + r * NGW; if (row < M) {
                const float ra = __builtin_amdgcn_rsqf(ssa[r] * (1.0f / 768.0f) + EPS), rb = __builtin_amdgcn_rsqf(ssb[r] * (1.0f / 256.0f) + EPS);
#pragma unroll
                for (int k = 0; k < 3; ++k) { u32x2 w; w[0] = cvt_pk_bf16(va[r][k][0] * ra, va[r][k][1] * ra); w[1] = cvt_pk_bf16(va[r][k][2] * ra, va[r][k][3] * ra); *(u32x2*)(YN + (size_t)row * D + 256 * k + 4 * lane) = w; }
                { u32x2 w; w[0] = cvt_pk_bf16(vb[r][0] * rb, vb[r][1] * rb); w[1] = cvt_pk_bf16(vb[r][2] * rb, vb[r][3] * rb); *(u32x2*)(YN + (size_t)row * D + 768 + 4 * lane) = w; } } }
        }
    }
    SEAM(6);

    if (IN(7)) {
        MK_PTRS;
        SchedStd S; S.o.init(M, D, G, bx); S.A = (const char*)YN; S.B = (const char*)Wout; S.a_tile = (size_t)256 * D * 2; S.b_tile = (size_t)256 * D * 2; S.b_batch = 0; S.ocol_mul = 256;
        EpiRes E{XB, SS2, 1.0f}; pg8::gemm_phase<EpiRes, SchedStd, true>(lds, D, D, D / 64, S, E);
    }
    SEAM(7);

    if (IN(8)) {
        MK_PTRS;
        SchedStd S; S.o.init(M, D, G, bx); S.A = (const char*)XB; S.B = (const char*)WKT; S.a_tile = (size_t)256 * D * 2; S.b_tile = (size_t)256 * D * 2; S.b_batch = (size_t)D * D * 2; S.ocol_mul = 256;
        EpiSoftmax E{PB, SS2}; pg8::gemm_phase<EpiSoftmax, SchedStd, true>(lds, D, D, D / 64, S, E);
    }
    SEAM(8);

    if (IN(9)) {
        MK_PTRS;
        SchedStd S; S.o.init(M, D, G, bx); S.A = (const char*)PB; S.B = (const char*)VWT; S.a_tile = (size_t)256 * D * 2; S.b_tile = (size_t)256 * D * 2; S.b_batch = (size_t)D * D * 2; S.ocol_mul = 256;
        EpiRes E{XB, SS3, 1.0f}; pg8::gemm_phase<EpiRes, SchedStd, true>(lds, D, D, D / 64, S, E);
    }
    SEAM(9);

    if (IN(10)) {
        MK_PTRS;
        STAGGER();
        SchedStd S; S.o.init(M, 2 * DFF, G, bx); S.A = (const char*)XB; S.B = (const char*)Wgu2; S.a_tile = (size_t)256 * D * 2; S.b_tile = (size_t)256 * D * 2; S.b_batch = 0; S.ocol_mul = 128;
        EpiGU E{HB, SS3}; pg8::gemm_phase<EpiGU, SchedStd, true>(lds, D, D, D / 64, S, E);
    }
    SEAM(10);

    if (IN(11)) {
        MK_PTRS;
        SchedStd S; S.o.init(M, D, G, bx); S.A = (const char*)HB; S.B = (const char*)Wd2; S.a_tile = (size_t)256 * DFF * 2; S.b_tile = (size_t)256 * DFF * 2; S.b_batch = 0; S.ocol_mul = 256;
        EpiRes E{XB, SS4, 0.5f}; pg8::gemm_phase<EpiRes, SchedStd, true>(lds, DFF, DFF, DFF / 64, S, E);
    }
    SEAM(11);

    if (IN(12)) {
        MK_PTRS;
        const float* gf = args.in[19];
        for (int row0 = gw; row0 < M; row0 += 4 * NGW) {
            u32x2 w[4][4]; float rs[4]; const f32x4* gr = (const f32x4*)gf + lane;
#pragma unroll
            for (int r = 0; r < 4; ++r) { const int row = (row0 + r * NGW) < M ? (row0 + r * NGW) : row0; const u32x2* xr = (const u32x2*)(XB + (size_t)row * D) + lane;
#pragma unroll
                for (int j = 0; j < 4; ++j) w[r][j] = __builtin_nontemporal_load(xr + 64 * j);
                rs[r] = row_rstd(SS4, row); }
#pragma unroll
            for (int r = 0; r < 4; ++r) { const int row = row0 + r * NGW; if (row < M) { f32x4* orow = (f32x4*)(out + (size_t)row * D) + lane;
#pragma unroll
                for (int j = 0; j < 4; ++j) { f32x4 v; v[0] = __builtin_bit_cast(float, w[r][j][0] << 16); v[1] = __builtin_bit_cast(float, w[r][j][0] & 0xffff0000u); v[2] = __builtin_bit_cast(float, w[r][j][1] << 16); v[3] = __builtin_bit_cast(float, w[r][j][1] & 0xffff0000u);
                    __builtin_nontemporal_store(v * rs[r] * gr[64 * j], orow + 64 * j); } } }
        }
    }
#undef IN
#undef SEAM
}
}


#if MK_DEBUG
namespace dbg {
__global__ void __launch_bounds__(256) cmp_f32(const float* a, const float* r, size_t n, float* acc) {
    float num = 0.f, den = 0.f;
    for (size_t i = (size_t)blockIdx.x * 256 + threadIdx.x; i < n; i += (size_t)gridDim.x * 256) { const float d = a[i] - r[i]; num += d * d; den += r[i] * r[i]; }
    for (int o = 32; o > 0; o >>= 1) { num += __shfl_xor(num, o); den += __shfl_xor(den, o); }
    if ((threadIdx.x & 63) == 0) { atomicAdd(acc, num); atomicAdd(acc + 1, den); }
}
__global__ void __launch_bounds__(256) cmp_bf16(const unsigned short* a, int lda, const float* colscale, const float* r, int ldr, int rows, int cols, float* acc) {
    float num = 0.f, den = 0.f; const size_t n = (size_t)rows * cols;
    for (size_t i = (size_t)blockIdx.x * 256 + threadIdx.x; i < n; i += (size_t)gridDim.x * 256) { const size_t row = i / cols; const int c = (int)(i % cols);
        const float av = __builtin_bit_cast(float, (unsigned)a[row * lda + c] << 16) * (colscale ? colscale[c] : 1.0f); const float rv = r[row * ldr + c]; const float d = av - rv; num += d * d; den += rv * rv; }
    for (int o = 32; o > 0; o >>= 1) { num += __shfl_xor(num, o); den += __shfl_xor(den, o); }
    if ((threadIdx.x & 63) == 0) { atomicAdd(acc, num); atomicAdd(acc + 1, den); }
}
__global__ void __launch_bounds__(256) cmp_p(const unsigned short* a, const float* r, float* acc) {
    float num = 0.f, den = 0.f; const size_t n = (size_t)4096 * 1024;
    for (size_t i = (size_t)blockIdx.x * 256 + threadIdx.x; i < n; i += (size_t)gridDim.x * 256) { const size_t row = i / 1024; const int c = (int)(i % 1024);
        const float av = __builtin_bit_cast(float, (unsigned)a[i] << 16); const float rv = r[(size_t)(c >> 8) * 4096 * 256 + row * 256 + (c & 255)]; const float d = av - rv; num += d * d; den += rv * rv; }
    for (int o = 32; o > 0; o >>= 1) { num += __shfl_xor(num, o); den += __shfl_xor(den, o); }
    if ((threadIdx.x & 63) == 0) { atomicAdd(acc, num); atomicAdd(acc + 1, den); }
}
__global__ void build_scales(float* qkvs, float* gcat, const float* goa, const float* gob) {
    const int i = blockIdx.x * 256 + threadIdx.x;
    if (i < 3072) qkvs[i] = ((i < 768) || (i >= 2304 && i < 2560)) ? 8.0f : 1.0f;
    if (i < 1024) gcat[i] = i < 768 ? goa[i] : gob[i - 768];
}
constexpr int NST = 8;
__global__ void __launch_bounds__(256) finalize(float* out, size_t n, const float* acc, int report) {
    const float tol[NST] = {0.03f, 0.03f, 1e9f  , 0.08f, 0.03f, 0.05f, 0.03f, 0.03f};
    float E = 0.f;
    if (report > 0) { const float e = sqrtf(acc[2 * (report - 1)] / acc[2 * (report - 1) + 1]); E = (e == e) ? fminf(e, 3.0f) : 3.0f; }
    else { for (int k = NST - 1; k >= 0; --k) { const float e = sqrtf(acc[2 * k] / acc[2 * k + 1]); if (!(e <= tol[k])) E = 0.1f * (k + 1); } }
    for (size_t i = (size_t)blockIdx.x * 256 + threadIdx.x; i < n; i += (size_t)gridDim.x * 256) out[i] *= (1.0f + E);
}
}
#endif

static void mk_launch(const mk::Args& a0, int lo, int hi, int grid, hipStream_t st) {
    mk::Args a = a0; a.ph_lo = lo; a.ph_hi = hi;
    hipLaunchKernelGGL(mk::mk_fwd, dim3(grid), dim3(mk::NWAVES * 64), mk::LDS_BYTES, st, a);
    const hipError_t le = hipPeekAtLastError();
    if (le != hipSuccess) fprintf(stderr, "kernel_launch: launch of phases [%d,%d) failed: %s\n", lo, hi, hipGetErrorName(le));
}

extern "C" void kernel_launch(void* const* d_in, const int* in_sizes, int n_in, void* d_out, int out_size, void* d_ws, size_t ws_size, hipStream_t stream) {
    static int grid = 0;
    if (grid == 0) {
        if (n_in != 20 || out_size != 8 * 4096 * 1024) { fprintf(stderr, "kernel_launch: unexpected shapes (n_in %d out %d)\n", n_in, out_size); grid = -1; return; }
        int dev = 0, cus = 0, per_cu = 0;
        if (hipGetDevice(&dev) != hipSuccess || hipDeviceGetAttribute(&cus, hipDeviceAttributeMultiprocessorCount, dev) != hipSuccess) { grid = -1; return; }
        if (hipFuncSetAttribute((const void*)mk::mk_fwd, hipFuncAttributeMaxDynamicSharedMemorySize, mk::LDS_BYTES) != hipSuccess) { fprintf(stderr, "kernel_launch: hipFuncSetAttribute failed\n"); grid = -1; return; }
        if (hipOccupancyMaxActiveBlocksPerMultiprocessor(&per_cu, (const void*)mk::mk_fwd, mk::NWAVES * 64, mk::LDS_BYTES) != hipSuccess || per_cu < 1) fprintf(stderr, "kernel_launch: occupancy query reports %d workgroups per CU\n", per_cu);
        (void)hipGetLastError();
        grid = cus;
    }
    if (grid < 0) return;
    unsigned char* ws = (unsigned char*)d_ws;
#if MK_DEBUG
    const size_t ref_off = (mk::WS_END + 4095) / 4096 * 4096;
    size_t off = ref_off + (size_t)290 * 1024 * 1024;
    auto take = [&](size_t bytes) { unsigned char* p = ws + off; off += (bytes + 255) / 256 * 256; return p; };
    float* sx1 = (float*)take((size_t)4096 * 1024 * 4); float* sx2 = (float*)take((size_t)4096 * 1024 * 4); float* sx3 = (float*)take((size_t)4096 * 1024 * 4);
    float* mkout = (float*)take((size_t)4096 * 1024 * 4); float* qkvs = (float*)take(3072 * 4); float* gcat = (float*)take(1024 * 4); float* acc = (float*)take(256);
    if (off > ws_size) { fprintf(stderr, "kernel_launch: debug build needs %zu bytes of workspace, got %zu\n", off, ws_size); return; }
    ref::Snap snap{sx1, sx2, sx3};
    ref::forward(d_in, (float*)d_out, ws + ref_off, stream, &snap);
    (void)hipMemsetAsync(ws + mk::WS_CTL, 0, mk::CTL_BYTES, stream);
    (void)hipMemsetAsync(acc, 0, 256, stream);
    dbg::build_scales<<<12, 256, 0, stream>>>(qkvs, gcat, (const float*)d_in[8], (const float*)d_in[9]);
    mk::Args a{};
    for (int i = 0; i < 20; ++i) a.in[i] = (const float*)d_in[i];
    a.in[0] = (const float*)d_in[0] + (size_t)7 * 4096 * 1024; a.in[1] = (const float*)d_in[1] + (size_t)7 * 256 * 1024;
    a.out = mkout; a.ws = ws;
    const ref::Bufs& rb = ref::g_bufs;
    for (int ph = 0; ph < mk::NPH; ++ph) {
        mk_launch(a, ph, ph + 1, grid, stream);
        if (ph == 1) dbg::cmp_bf16<<<512, 256, 0, stream>>>((const unsigned short*)(ws + mk::WS_KVC), 2048, nullptr, rb.kvc, 2048, 256, 2048, acc + 0);
        if (ph == 2) dbg::cmp_bf16<<<512, 256, 0, stream>>>((const unsigned short*)(ws + mk::WS_XB), 1024, nullptr, sx1, 1024, 4096, 1024, acc + 2);
        if (ph == 3) dbg::cmp_bf16<<<512, 256, 0, stream>>>((const unsigned short*)(ws + mk::WS_R1), 3072, qkvs, rb.proj, 3072, 4096, 3072, acc + 4);
        if (ph == 6) dbg::cmp_bf16<<<512, 256, 0, stream>>>((const unsigned short*)(ws + mk::WS_R1), 1024, gcat, rb.yn, 1024, 4096, 1024, acc + 6);
        if (ph == 7) dbg::cmp_bf16<<<512, 256, 0, stream>>>((const unsigned short*)(ws + mk::WS_XB), 1024, nullptr, sx2, 1024, 4096, 1024, acc + 8);
        if (ph == 8) dbg::cmp_p<<<512, 256, 0, stream>>>((const unsigned short*)(ws + mk::WS_R1), rb.sc, acc + 10);
        if (ph == 9) dbg::cmp_bf16<<<512, 256, 0, stream>>>((const unsigned short*)(ws + mk::WS_XB), 1024, nullptr, sx3, 1024, 4096, 1024, acc + 12);
        if (ph == 12) dbg::cmp_f32<<<512, 256, 0, stream>>>(mkout, (const float*)d_out + (size_t)7 * 4096 * 1024, (size_t)4096 * 1024, acc + 14);
    }
    dbg::finalize<<<1024, 256, 0, stream>>>((float*)d_out, (size_t)8 * 4096 * 1024, acc, MK_REPORT);
#else
    if (ws_size < mk::WS_END) { fprintf(stderr, "kernel_launch: needs %zu bytes of workspace, got %zu\n", (size_t)mk::WS_END, ws_size); return; }
    if (hipMemsetAsync(ws + mk::WS_CTL, 0, mk::CTL_BYTES, stream) != hipSuccess) return;
    mk::Args a{};
    for (int i = 0; i < 20; ++i) a.in[i] = (const float*)d_in[i];
    a.out = (float*)d_out; a.ws = ws;
#if MK_N_LAUNCHES == 1
    mk_launch(a, 0, mk::NPH, grid, stream);
#else
    for (int ph = 0; ph < mk::NPH; ++ph) {
        for (int r = 0; r < MK_REPEAT_N; ++r) if (ph == MK_REPEAT) { mk::Args a2 = a; a2.flags = MK_REPEAT_FLAGS; mk_launch(a2, ph, ph + 1, grid, stream); }
        mk_launch(a, ph, ph + 1, grid, stream); }
#endif
#endif
}
```

```cpp
#include <hip/hip_runtime.h>
#include <cstdio>
#include <cstdint>
#include <cmath>
#define MK_REPEAT -1
#define MK_REPEAT_N 1
#define MK_REPEAT_FLAGS 0
#define MK_STAGGER_TICKS 0
#define MK_NT_PART false
#define MK_TIMING 0
#define MK_TQ 0.02f
#define MK_PROBE_SAME 0
#define MK_DEBUG 0
#define MK_REPORT 0
#define MK_N_LAUNCHES 1
#define MK_NBAT 8

namespace pg8 {
#define PG8_LAS __attribute__((address_space(3)))
typedef unsigned short bf16_t;
typedef short bf16x8 __attribute__((ext_vector_type(8)));
typedef float f32x4 __attribute__((ext_vector_type(4)));
typedef float f32x2 __attribute__((ext_vector_type(2)));
typedef unsigned u32x4 __attribute__((ext_vector_type(4)));
typedef unsigned u32x2 __attribute__((ext_vector_type(2)));
constexpr int BM = 256, BK = 64, HALF = 128, HTB = HALF * BK * 2  , STAGE_BYTES = 8 * HTB, NXCD = 8, WGM = 8;

__host__ __device__ __forceinline__ int lds_byte(int r, int c) { const int st = (r >> 4) * 2 + (c >> 5), rr = r & 15, cc = c & 31, ob = rr * 64 + cc * 2; return st * 1024 + (ob ^ (((ob >> 9) & 1) << 5)); }
__host__ __device__ __forceinline__ void stage_rc(int b, int& R, int& C) { const int st = b / 1024, sb = b % 1024, swz = sb ^ (((sb >> 9) & 1) << 5); R = (st >> 1) * 16 + swz / 64; C = (st & 1) * 32 + (swz % 64) / 2; }
__host__ __device__ __forceinline__ int perm32(int rho) { const int n = rho >> 4, i = rho & 15; return 8 * (i >> 2) + 4 * n + (i & 3); }

struct Unit { const char* a; const char* b; int orow, ocol, aux; };

struct Order {
    int nM, nN, nwg, G, c;
    __device__ __forceinline__ void init(int M, int N, int G_, int c_) { nM = M / BM; nN = N / BM; nwg = nM * nN; G = G_; c = c_; }
    __device__ __forceinline__ bool tile(int i, int& pm, int& pn) const {
        const long L = (long)i * G + c; if (L >= nwg) return false;
        int wgid = (int)L; { const int q = nwg / NXCD, r = nwg % NXCD, xcd = wgid % NXCD, off = wgid / NXCD; wgid = (xcd < r ? xcd * (q + 1) : r * (q + 1) + (xcd - r) * q) + off; }
        const int nig = WGM * nN, gid = wgid / nig, fm = gid * WGM, gsz = (nM - fm) < WGM ? (nM - fm) : WGM;
        pm = fm + ((wgid % nig) % gsz); pn = (wgid % nig) / gsz; return true;
    }
};

__device__ __forceinline__ unsigned cvt_pk_bf16(float lo, float hi) { unsigned r; asm volatile("v_cvt_pk_bf16_f32 %0, %1, %2" : "=v"(r) : "v"(lo), "v"(hi)); return r; }

template <class Epi, class Sched, bool ALIGN_EPI>
__device__ __forceinline__ void gemm_phase(PG8_LAS unsigned char* lds, const int lda, const int ldb, const int nt, const Sched& S, const Epi& E) {
    int tid_ = threadIdx.x; asm volatile("" : "+v"(tid_));
    const int tid = tid_, wid = __builtin_amdgcn_readfirstlane(tid >> 6), lane = tid & 63, wr = wid >> 2, wc = wid & 3, fr = lane & 15, fq = lane >> 4;
    unsigned voffA[2], voffB[2];
#pragma unroll
    for (int i = 0; i < 2; ++i) { int R, C; stage_rc(tid * 16 + i * 8192, R, C); const int Rb = Epi::PERM ? ((R & ~31) + perm32(R & 31)) : R;
        voffA[i] = (unsigned)(R * lda + C) * 2u; voffB[i] = (unsigned)(Rb * ldb + C) * 2u; }
    const size_t kstep = (size_t)(BK * 2);
    const size_t hstepA = (size_t)HALF * lda * 2, hstepB = (size_t)HALF * ldb * 2;
    const unsigned ldsw = (unsigned)wid * 1024u;
    const int aoff = lds_byte(wr * 64 + fr, fq * 8), boff = lds_byte(wc * 32 + fr, fq * 8);
#define PG8_SA(b, h) (((b) * 2 + (h)) * HTB)
#define PG8_SB(b, h) ((4 + (b) * 2 + (h)) * HTB)
#define PG8_STAGE(bufoff, gbase, voff) do { _Pragma("unroll") for (int _i = 0; _i < 2; ++_i) \
        __builtin_amdgcn_global_load_lds((const unsigned*)((const char*)(gbase) + (voff)[_i]), (PG8_LAS unsigned*)(lds + (bufoff) + ldsw + _i * 8192), 16, 0, 0); } while (0)
#define PG8_LDA(dst, b, h) do { _Pragma("unroll") for (int m = 0; m < 4; ++m) _Pragma("unroll") for (int k = 0; k < 2; ++k) dst[m][k] = *(const PG8_LAS bf16x8*)(lds + PG8_SA(b, h) + aoff + m * 2048 + k * 1024); } while (0)
#define PG8_LDB(dst, b, h) do { _Pragma("unroll") for (int n = 0; n < 2; ++n) _Pragma("unroll") for (int k = 0; k < 2; ++k) dst[n][k] = *(const PG8_LAS bf16x8*)(lds + PG8_SB(b, h) + boff + n * 2048 + k * 1024); } while (0)
#define PG8_MMA(ai, bj, At, Bt) do { __builtin_amdgcn_s_setprio(1); _Pragma("unroll") for (int m = 0; m < 4; ++m) _Pragma("unroll") for (int n = 0; n < 2; ++n) _Pragma("unroll") for (int k = 0; k < 2; ++k) \
        acc[ai][bj][m][n] = __builtin_amdgcn_mfma_f32_16x16x32_bf16(Bt[n][k], At[m][k], acc[ai][bj][m][n], 0, 0, 0); __builtin_amdgcn_s_setprio(0); } while (0)
#define PG8_WAIT_V(n) asm volatile("s_waitcnt vmcnt(" #n ")" ::: "memory")
#define PG8_WAIT_L(n) asm volatile("s_waitcnt lgkmcnt(" #n ")" ::: "memory")
#define PG8_BAR __builtin_amdgcn_s_barrier()
#define PG8_SCHED __builtin_amdgcn_sched_barrier(0)
    Unit cur, nxt; int ui = 0;
    if (!S.next(0, cur)) return;
    f32x4 acc[2][2][4][2];
#pragma unroll
    for (int a = 0; a < 2; ++a)
#pragma unroll
        for (int b = 0; b < 2; ++b)
#pragma unroll
            for (int m = 0; m < 4; ++m)
#pragma unroll
                for (int n = 0; n < 2; ++n) acc[a][b][m][n] = (f32x4){0.f, 0.f, 0.f, 0.f};
    bf16x8 At[4][2], B0[2][2], B1[2][2];
    const char* cA = cur.a; const char* cB = cur.b;
    PG8_STAGE(PG8_SB(0, 0), cB, voffB); PG8_STAGE(PG8_SB(0, 1), cB + hstepB, voffB); PG8_STAGE(PG8_SA(0, 0), cA, voffA); PG8_STAGE(PG8_SA(0, 1), cA + hstepA, voffA);
    if (wr == 1) PG8_BAR;
    PG8_WAIT_V(2); PG8_BAR;
    PG8_STAGE(PG8_SB(1, 0), cB + kstep, voffB); PG8_STAGE(PG8_SA(1, 0), cA + kstep, voffA); PG8_STAGE(PG8_SB(1, 1), cB + hstepB + kstep, voffB);
    PG8_WAIT_V(6); PG8_BAR;
    for (;;) {
        const bool has_next = S.next(ui + 1, nxt);
        const char* nA = has_next ? nxt.a : cA; const char* nB = has_next ? nxt.b : cB;
#pragma unroll 1
        for (int t = 0; t < nt; t += 2) {
            const bool last = (t == nt - 2);
            const char* a1 = cA + (size_t)(t + 1) * kstep;
            const char* a2 = last ? nA : cA + (size_t)(t + 2) * kstep; const char* b2 = last ? nB : cB + (size_t)(t + 2) * kstep;
            const char* a3 = a2 + kstep; const char* b3 = b2 + kstep;
            PG8_LDB(B0, 0, 0); PG8_LDB(B1, 0, 1); PG8_SCHED; PG8_LDA(At, 0, 0); PG8_STAGE(PG8_SA(1, 1), a1 + hstepA, voffA);
            PG8_WAIT_V(8); PG8_WAIT_L(0); PG8_BAR; PG8_MMA(0, 0, At, B0); PG8_MMA(0, 1, At, B1); PG8_BAR; PG8_SCHED;
            PG8_LDA(At, 0, 1); PG8_STAGE(PG8_SB(0, 0), b2, voffB); PG8_STAGE(PG8_SB(0, 1), b2 + hstepB, voffB); PG8_STAGE(PG8_SA(0, 0), a2, voffA);
            PG8_WAIT_V(8); PG8_WAIT_L(0); PG8_BAR; PG8_MMA(1, 0, At, B0); PG8_MMA(1, 1, At, B1); PG8_BAR; PG8_SCHED;
            PG8_LDB(B0, 1, 0); PG8_LDB(B1, 1, 1); PG8_SCHED; PG8_LDA(At, 1, 0); PG8_STAGE(PG8_SA(0, 1), a2 + hstepA, voffA);
            PG8_WAIT_V(8); PG8_WAIT_L(0); PG8_BAR; PG8_MMA(0, 0, At, B0); PG8_MMA(0, 1, At, B1); PG8_BAR; PG8_SCHED;
            PG8_LDA(At, 1, 1); PG8_STAGE(PG8_SB(1, 0), b3, voffB); PG8_STAGE(PG8_SB(1, 1), b3 + hstepB, voffB); PG8_STAGE(PG8_SA(1, 0), a3, voffA);
            PG8_WAIT_V(8); PG8_WAIT_L(0); PG8_BAR; PG8_MMA(1, 0, At, B0); PG8_MMA(1, 1, At, B1); PG8_BAR; PG8_SCHED;
        }
        if constexpr (ALIGN_EPI) { if (wr == 0) PG8_BAR; }
        E(acc, cur, wr, wc, fr, fq, lds, wid, lane);
        if (!has_next) break;
#pragma unroll
        for (int a = 0; a < 2; ++a)
#pragma unroll
            for (int b = 0; b < 2; ++b)
#pragma unroll
                for (int m = 0; m < 4; ++m)
#pragma unroll
                    for (int n = 0; n < 2; ++n) acc[a][b][m][n] = (f32x4){0.f, 0.f, 0.f, 0.f};
        cur = nxt; cA = nA; cB = nB; ++ui;
        if constexpr (ALIGN_EPI) { if (wr == 1) PG8_BAR; }
    }
    PG8_WAIT_V(0);
    if constexpr (!ALIGN_EPI) { if (wr == 0) PG8_BAR; }
    PG8_BAR;
#undef PG8_SA
#undef PG8_SB
#undef PG8_STAGE
#undef PG8_LDA
#undef PG8_LDB
#undef PG8_MMA
#undef PG8_WAIT_V
#undef PG8_WAIT_L
#undef PG8_BAR
#undef PG8_SCHED
}
}

namespace att {
#define ATT_LAS __attribute__((address_space(3)))
typedef short bf16x8 __attribute__((ext_vector_type(8)));
typedef short v4i16 __attribute__((ext_vector_type(4)));
typedef float f32x16 __attribute__((ext_vector_type(16)));
typedef float f32x4 __attribute__((ext_vector_type(4)));
typedef unsigned u32x4 __attribute__((ext_vector_type(4)));
typedef unsigned u32x2 __attribute__((ext_vector_type(2)));
constexpr float LOG2E = 1.4426950408889634f;
constexpr int TABA_N = 192, TABB_N = 1600;

__device__ __forceinline__ int rel_bucket(int n) {
    if (n < 16) return n < 0 ? 0 : n;
    int b = 16;
    b += (n >= 22); b += (n >= 30); b += (n >= 40); b += (n >= 54); b += (n >= 73); b += (n >= 99); b += (n >= 134); b += (n >= 182);
    b += (n >= 246); b += (n >= 332); b += (n >= 450); b += (n >= 609); b += (n >= 825); b += (n >= 1117); b += (n >= 1513);
    return b;
}
__device__ __forceinline__ unsigned pk_bf16(float lo, float hi) { unsigned r; asm volatile("v_cvt_pk_bf16_f32 %0, %1, %2" : "=v"(r) : "v"(lo), "v"(hi)); return r; }
__device__ __forceinline__ float bf16_round(float x) { unsigned u = __builtin_bit_cast(unsigned, x); u = (u + 0x7fffu + ((u >> 16) & 1u)) & 0xffff0000u; return __builtin_bit_cast(float, u); }

__device__ __forceinline__ void glds16(const void* gsrc, unsigned lds_dst) { unsigned keep;
    asm volatile("s_mov_b32 %0, m0\n\ts_mov_b32 m0, %2\n\ts_nop 0\n\tglobal_load_lds_dwordx4 %1, off\n\ts_mov_b32 m0, %0" : "=&s"(keep) : "v"(gsrc), "s"(lds_dst) : "memory"); }
__device__ __forceinline__ void dma_rows8(const char* krow0  , const int voff, const int row  ,
                                          ATT_LAS char* kdst  , ATT_LAS char* vdst, const int lane) {
    const int pc = lane & 7;
    glds16(krow0 + 16 * (pc ^ ((row >> 1) & 7)), (unsigned)__builtin_amdgcn_readfirstlane((int)(unsigned)(uintptr_t)kdst));
    glds16(krow0 + voff + 16 * (pc ^ (((row >> 1) & 1) << 2)), (unsigned)__builtin_amdgcn_readfirstlane((int)(unsigned)(uintptr_t)vdst));
}

__device__ __forceinline__ void attn_group(const bf16x8 (&qf)[4], f32x16 (&o)[2], float& m, float& l, const ATT_LAS char* kg, const ATT_LAS char* vg, const ATT_LAS float* tp, const int lane) {
    const int q = lane & 31, h = lane >> 5;
    const ATT_LAS char* kr0 = kg + q * 128; const int kswz = (q >> 1) & 7;
    typedef float f32x2_ __attribute__((ext_vector_type(2)));
    f32x2_ t0, t1, t2, t3, t4, t5, t6, t7;
    { const unsigned ta = (unsigned)(uintptr_t)(tp - 27);
      asm volatile("ds_read2_b32 %0, %8 offset0:27 offset1:26\n\tds_read2_b32 %1, %8 offset0:25 offset1:24\n\tds_read2_b32 %2, %8 offset0:19 offset1:18\n\tds_read2_b32 %3, %8 offset0:17 offset1:16\n\t"
                   "ds_read2_b32 %4, %8 offset0:11 offset1:10\n\tds_read2_b32 %5, %8 offset0:9 offset1:8\n\tds_read2_b32 %6, %8 offset0:3 offset1:2\n\tds_read2_b32 %7, %8 offset0:1 offset1:0"
                   : "=&v"(t0), "=&v"(t1), "=&v"(t2), "=&v"(t3), "=&v"(t4), "=&v"(t5), "=&v"(t6), "=&v"(t7) : "v"(ta) : "memory"); }
    const int q4 = (lane & 15) >> 2, p4 = lane & 3, g1 = (lane >> 4) & 1, vsw = (q4 >> 1) & 1;
    const unsigned va0_ = (unsigned)(uintptr_t)(vg + (4 * h + q4) * 128 + 32 * g1 + 8 * p4 + 64 * vsw), va1_ = (unsigned)(uintptr_t)(vg + (4 * h + q4) * 128 + 32 * g1 + 8 * p4 + 64 * (1 ^ vsw));
    v4i16 a[2][4];
    asm volatile("ds_read_b64_tr_b16 %0, %8\n\tds_read_b64_tr_b16 %1, %8 offset:1024\n\tds_read_b64_tr_b16 %2, %8 offset:2048\n\tds_read_b64_tr_b16 %3, %8 offset:3072\n\t"
                 "ds_read_b64_tr_b16 %4, %9\n\tds_read_b64_tr_b16 %5, %9 offset:1024\n\tds_read_b64_tr_b16 %6, %9 offset:2048\n\tds_read_b64_tr_b16 %7, %9 offset:3072"
                 : "=&v"(a[0][0]), "=&v"(a[0][1]), "=&v"(a[0][2]), "=&v"(a[0][3]), "=&v"(a[1][0]), "=&v"(a[1][1]), "=&v"(a[1][2]), "=&v"(a[1][3]) : "v"(va0_), "v"(va1_) : "memory");
    f32x16 s = f32x16{};
#pragma unroll
    for (int d0 = 0; d0 < 4; ++d0) { const bf16x8 kf = *(const ATT_LAS bf16x8*)(kr0 + 16 * ((2 * d0 + h) ^ kswz)); s = __builtin_amdgcn_mfma_f32_32x32x16_bf16(kf, qf[d0], s, 0, 0, 0); }
    asm volatile("s_waitcnt lgkmcnt(0)" : "+v"(t0), "+v"(t1), "+v"(t2), "+v"(t3), "+v"(t4), "+v"(t5), "+v"(t6), "+v"(t7), "+v"(a[0][0]), "+v"(a[0][1]), "+v"(a[0][2]), "+v"(a[0][3]), "+v"(a[1][0]), "+v"(a[1][1]), "+v"(a[1][2]), "+v"(a[1][3]) :: "memory");
    float mx = -INFINITY;
    { const float tb_[16] = {t0[0], t0[1], t1[0], t1[1], t2[0], t2[1], t3[0], t3[1], t4[0], t4[1], t5[0], t5[1], t6[0], t6[1], t7[0], t7[1]};
#pragma unroll
      for (int r = 0; r < 16; ++r) s[r] = fmaf(s[r], LOG2E, tb_[r]); }
#pragma unroll
    for (int r = 0; r < 16; r += 2) mx = fmaxf(mx, fmaxf(s[r], s[r + 1]));
    mx = fmaxf(mx, __shfl_xor(mx, 32));
    if (__any(mx > m)) {
        const float mnew = fmaxf(m, mx), alpha = __builtin_amdgcn_exp2f(m - mnew);
        l *= alpha; m = mnew;
#pragma unroll
        for (int r = 0; r < 16; ++r) { o[0][r] *= alpha; o[1][r] *= alpha; }
    }
    float ps = 0.f;
#pragma unroll
    for (int r = 0; r < 16; ++r) { s[r] = __builtin_amdgcn_exp2f(s[r] - m); ps += s[r]; }
    l += ps;
    u32x4 pw0, pw1;
    pw0[0] = pk_bf16(s[0], s[1]); pw0[1] = pk_bf16(s[2], s[3]); pw0[2] = pk_bf16(s[4], s[5]); pw0[3] = pk_bf16(s[6], s[7]);
    pw1[0] = pk_bf16(s[8], s[9]); pw1[1] = pk_bf16(s[10], s[11]); pw1[2] = pk_bf16(s[12], s[13]); pw1[3] = pk_bf16(s[14], s[15]);
    const bf16x8 pb0 = __builtin_bit_cast(bf16x8, pw0), pb1 = __builtin_bit_cast(bf16x8, pw1);
#pragma unroll
    for (int dh = 0; dh < 2; ++dh) {
        const bf16x8 va0 = (bf16x8){a[dh][0][0], a[dh][0][1], a[dh][0][2], a[dh][0][3], a[dh][1][0], a[dh][1][1], a[dh][1][2], a[dh][1][3]};
        const bf16x8 va1 = (bf16x8){a[dh][2][0], a[dh][2][1], a[dh][2][2], a[dh][2][3], a[dh][3][0], a[dh][3][1], a[dh][3][2], a[dh][3][3]};
        o[dh] = __builtin_amdgcn_mfma_f32_32x32x16_bf16(va0, pb0, o[dh], 0, 0, 0);
        o[dh] = __builtin_amdgcn_mfma_f32_32x32x16_bf16(va1, pb1, o[dh], 0, 0, 0);
    }
}

__device__ __forceinline__ void dma_k_rows8(const char* krow, const int row, ATT_LAS char* kdst, const int lane) {
    glds16(krow + 16 * ((lane & 7) ^ ((row >> 1) & 7)), (unsigned)__builtin_amdgcn_readfirstlane((int)(unsigned)(uintptr_t)kdst)); }
__device__ __forceinline__ void dma_v_rows8(const char* vrow, const int row, ATT_LAS char* vdst, const int lane) {
    glds16(vrow + 16 * ((lane & 7) ^ (((row >> 1) & 1) << 2)), (unsigned)__builtin_amdgcn_readfirstlane((int)(unsigned)(uintptr_t)vdst)); }
__device__ __forceinline__ void dil_pass1(const bf16x8 (&qf)[4], const int ng, const ATT_LAS char* kimg0  , const ATT_LAS float* tp0  ,
                                          u32x4 (&pw)[5][2], float& m_out, float& l_out, const int lane) {
    const int q = lane & 31, h = lane >> 5, kswz = (q >> 1) & 7;
    typedef float f32x2_ __attribute__((ext_vector_type(2)));
    f32x16 s[5]; float mx = -INFINITY;
#pragma unroll
    for (int g = 0; g < 5; ++g) if (g < ng) {
        f32x2_ t0, t1, t2, t3, t4, t5, t6, t7;
        { const unsigned ta = (unsigned)(uintptr_t)(tp0 + 32 * g - 27);
          asm volatile("ds_read2_b32 %0, %8 offset0:27 offset1:26\n\tds_read2_b32 %1, %8 offset0:25 offset1:24\n\tds_read2_b32 %2, %8 offset0:19 offset1:18\n\tds_read2_b32 %3, %8 offset0:17 offset1:16\n\t"
                       "ds_read2_b32 %4, %8 offset0:11 offset1:10\n\tds_read2_b32 %5, %8 offset0:9 offset1:8\n\tds_read2_b32 %6, %8 offset0:3 offset1:2\n\tds_read2_b32 %7, %8 offset0:1 offset1:0"
                       : "=&v"(t0), "=&v"(t1), "=&v"(t2), "=&v"(t3), "=&v"(t4), "=&v"(t5), "=&v"(t6), "=&v"(t7) : "v"(ta) : "memory"); }
        const ATT_LAS char* kr0 = kimg0 - g * 4096 + q * 128;
        f32x16 sg = f32x16{};
#pragma unroll
        for (int d0 = 0; d0 < 4; ++d0) { const bf16x8 kf = *(const ATT_LAS bf16x8*)(kr0 + 16 * ((2 * d0 + h) ^ kswz)); sg = __builtin_amdgcn_mfma_f32_32x32x16_bf16(kf, qf[d0], sg, 0, 0, 0); }
        asm volatile("s_waitcnt lgkmcnt(0)" : "+v"(t0), "+v"(t1), "+v"(t2), "+v"(t3), "+v"(t4), "+v"(t5), "+v"(t6), "+v"(t7) :: "memory");
        const float tb_[16] = {t0[0], t0[1], t1[0], t1[1], t2[0], t2[1], t3[0], t3[1], t4[0], t4[1], t5[0], t5[1], t6[0], t6[1], t7[0], t7[1]};
#pragma unroll
        for (int r = 0; r < 16; ++r) sg[r] = fmaf(sg[r], LOG2E, tb_[r]);
#pragma unroll
        for (int r = 0; r < 16; r += 2) mx = fmaxf(mx, fmaxf(sg[r], sg[r + 1]));
        s[g] = sg;
    }
    mx = fmaxf(mx, __shfl_xor(mx, 32));
    float ps = 0.f;
#pragma unroll
    for (int g = 0; g < 5; ++g) if (g < ng) {
        f32x16 p = s[g];
#pragma unroll
        for (int r = 0; r < 16; ++r) { p[r] = __builtin_amdgcn_exp2f(p[r] - mx); ps += p[r]; }
        pw[g][0][0] = pk_bf16(p[0], p[1]); pw[g][0][1] = pk_bf16(p[2], p[3]); pw[g][0][2] = pk_bf16(p[4], p[5]); pw[g][0][3] = pk_bf16(p[6], p[7]);
        pw[g][1][0] = pk_bf16(p[8], p[9]); pw[g][1][1] = pk_bf16(p[10], p[11]); pw[g][1][2] = pk_bf16(p[12], p[13]); pw[g][1][3] = pk_bf16(p[14], p[15]);
    }
    ps += __shfl_xor(ps, 32);
    m_out = mx; l_out = ps;
}
__device__ __forceinline__ void dil_pass2(const int ng, const ATT_LAS char* vimg0  , const u32x4 (&pw)[5][2], f32x16 (&o)[2], const int lane) {
    const int h = lane >> 5, q4 = (lane & 15) >> 2, p4 = lane & 3, g1 = (lane >> 4) & 1, vsw = (q4 >> 1) & 1;
    o[0] = f32x16{}; o[1] = f32x16{};
#pragma unroll
    for (int g = 0; g < 5; ++g) if (g < ng) {
        const ATT_LAS char* vg = vimg0 - g * 4096;
        const unsigned va0_ = (unsigned)(uintptr_t)(vg + (4 * h + q4) * 128 + 32 * g1 + 8 * p4 + 64 * vsw), va1_ = (unsigned)(uintptr_t)(vg + (4 * h + q4) * 128 + 32 * g1 + 8 * p4 + 64 * (1 ^ vsw));
        v4i16 a[2][4];
        asm volatile("ds_read_b64_tr_b16 %0, %8\n\tds_read_b64_tr_b16 %1, %8 offset:1024\n\tds_read_b64_tr_b16 %2, %8 offset:2048\n\tds_read_b64_tr_b16 %3, %8 offset:3072\n\t"
                     "ds_read_b64_tr_b16 %4, %9\n\tds_read_b64_tr_b16 %5, %9 offset:1024\n\tds_read_b64_tr_b16 %6, %9 offset:2048\n\tds_read_b64_tr_b16 %7, %9 offset:3072\n\ts_waitcnt lgkmcnt(0)"
                     : "=&v"(a[0][0]), "=&v"(a[0][1]), "=&v"(a[0][2]), "=&v"(a[0][3]), "=&v"(a[1][0]), "=&v"(a[1][1]), "=&v"(a[1][2]), "=&v"(a[1][3]) : "v"(va0_), "v"(va1_) : "memory");
        const bf16x8 pb0 = __builtin_bit_cast(bf16x8, pw[g][0]), pb1 = __builtin_bit_cast(bf16x8, pw[g][1]);
#pragma unroll
        for (int dh = 0; dh < 2; ++dh) {
            const bf16x8 va0 = (bf16x8){a[dh][0][0], a[dh][0][1], a[dh][0][2], a[dh][0][3], a[dh][1][0], a[dh][1][1], a[dh][1][2], a[dh][1][3]};
            const bf16x8 va1 = (bf16x8){a[dh][2][0], a[dh][2][1], a[dh][2][2], a[dh][2][3], a[dh][3][0], a[dh][3][1], a[dh][3][2], a[dh][3][3]};
            o[dh] = __builtin_amdgcn_mfma_f32_32x32x16_bf16(va0, pb0, o[dh], 0, 0, 0);
            o[dh] = __builtin_amdgcn_mfma_f32_32x32x16_bf16(va1, pb1, o[dh], 0, 0, 0);
        }
    }
}

template <bool NT>
__device__ __forceinline__ void store_o(const f32x16 (&o)[2], const float l, char* orow_q, const int h, const bool valid = true) {
    const float il = 1.0f / l;
#pragma unroll
    for (int dh = 0; dh < 2; ++dh)
#pragma unroll
        for (int jj = 0; jj < 2; ++jj) {
            u32x2 we, wo;
            we[0] = pk_bf16(o[dh][8 * jj] * il, o[dh][8 * jj + 1] * il); we[1] = pk_bf16(o[dh][8 * jj + 2] * il, o[dh][8 * jj + 3] * il);
            wo[0] = pk_bf16(o[dh][8 * jj + 4] * il, o[dh][8 * jj + 5] * il); wo[1] = pk_bf16(o[dh][8 * jj + 6] * il, o[dh][8 * jj + 7] * il);
            const unsigned s0 = h ? we[0] : wo[0], s1 = h ? we[1] : wo[1];
            const unsigned r0 = (unsigned)__shfl_xor((int)s0, 32), r1 = (unsigned)__shfl_xor((int)s1, 32);
            u32x4 w; if (h == 0) { w[0] = we[0]; w[1] = we[1]; w[2] = r0; w[3] = r1; } else { w[0] = r0; w[1] = r1; w[2] = wo[0]; w[3] = wo[1]; }
            u32x4* dst = (u32x4*)(orow_q + (32 * dh + 16 * jj + 8 * h) * 2);
            if (valid) { if (NT) __builtin_nontemporal_store(w, dst); else *dst = w; }
        }
}

template <bool NT>
__device__ __forceinline__ void store_o_staged(const f32x16 (&o)[2], const float l, ATT_LAS char* stg, char* base, const long rstride, const int lane) {
    const int q = lane & 31, h = lane >> 5; const float il = 1.0f / l;
#pragma unroll
    for (int dh = 0; dh < 2; ++dh)
#pragma unroll
        for (int jj = 0; jj < 2; ++jj) {
            u32x2 we, wo;
            we[0] = pk_bf16(o[dh][8 * jj] * il, o[dh][8 * jj + 1] * il); we[1] = pk_bf16(o[dh][8 * jj + 2] * il, o[dh][8 * jj + 3] * il);
            wo[0] = pk_bf16(o[dh][8 * jj + 4] * il, o[dh][8 * jj + 5] * il); wo[1] = pk_bf16(o[dh][8 * jj + 6] * il, o[dh][8 * jj + 7] * il);
            const unsigned s0 = h ? we[0] : wo[0], s1 = h ? we[1] : wo[1];
            const unsigned r0 = (unsigned)__shfl_xor((int)s0, 32), r1 = (unsigned)__shfl_xor((int)s1, 32);
            u32x4 w; if (h == 0) { w[0] = we[0]; w[1] = we[1]; w[2] = r0; w[3] = r1; } else { w[0] = r0; w[1] = r1; w[2] = wo[0]; w[3] = wo[1]; }
            *(ATT_LAS u32x4*)(stg + q * 128 + 16 * ((4 * dh + 2 * jj + h) ^ (q & 7))) = w;
        }
    asm volatile("s_waitcnt lgkmcnt(0)" ::: "memory");
#pragma unroll
    for (int i = 0; i < 4; ++i) { const int r = 8 * i + (lane >> 3), c = lane & 7;
        const u32x4 w = *(const ATT_LAS u32x4*)(stg + r * 128 + 16 * (c ^ (r & 7)));
        u32x4* dst = (u32x4*)(base + (long)r * rstride + 16 * c);
        if (NT) __builtin_nontemporal_store(w, dst); else *dst = w; }
    asm volatile("s_waitcnt lgkmcnt(0)" ::: "memory");
}

__device__ __forceinline__ unsigned moba_select(const char* qbase, const long qs, const float* km, const int qb) {
    const int lane = threadIdx.x & 63, q = lane & 31, h = lane >> 5;
    f32x16 g = f32x16{};
    const float* kmrow = km + (size_t)(q & 15) * 256;
    const bool lo_part = q >= 16;
#pragma unroll
    for (int d0 = 0; d0 < 4; ++d0) {
        const bf16x8 qf = *(const bf16x8*)(qbase + (long)q * qs + (16 * d0 + 8 * h) * 2);
        const f32x4 f0 = *(const f32x4*)(kmrow + 16 * d0 + 8 * h), f1 = *(const f32x4*)(kmrow + 16 * d0 + 8 * h + 4);
        float v[8] = {f0[0], f0[1], f0[2], f0[3], f1[0], f1[1], f1[2], f1[3]};
        u32x4 aw;
#pragma unroll
        for (int j = 0; j < 4; ++j) {
            const float h0 = bf16_round(v[2 * j]), h1 = bf16_round(v[2 * j + 1]);
            const float x0 = lo_part ? (v[2 * j] - h0) : h0, x1 = lo_part ? (v[2 * j + 1] - h1) : h1;
            aw[j] = pk_bf16(x0, x1);
        }
        g = __builtin_amdgcn_mfma_f32_32x32x16_bf16(__builtin_bit_cast(bf16x8, aw), qf, g, 0, 0, 0);
    }
    float gate[8], other[8];
#pragma unroll
    for (int r = 0; r < 8; ++r) { gate[r] = g[r] + g[r + 8]; }
#pragma unroll
    for (int r = 0; r < 8; ++r) { other[r] = __shfl_xor(gate[r], 32); }
    unsigned mymask = 0u;
#pragma unroll
    for (int r = 0; r < 8; ++r) {
        const int n = (r & 3) + 8 * (r >> 2) + 4 * h;
        int rank = 0;
#pragma unroll
        for (int r2 = 0; r2 < 8; ++r2) {
            const int n2 = (r2 & 3) + 8 * (r2 >> 2) + 4 * h, n3 = (r2 & 3) + 8 * (r2 >> 2) + 4 * (1 - h);
            if (r2 != r) rank += (n2 < qb && (gate[r2] > gate[r] || (gate[r2] == gate[r] && n2 < n))) ? 1 : 0;
            rank += (n3 < qb && (other[r2] > gate[r] || (other[r2] == gate[r] && n3 < n))) ? 1 : 0;
        }
        if (n < qb && rank < 3) mymask |= 1u << n;
    }
    return mymask | (unsigned)__shfl_xor((int)mymask, 32);
}
}


namespace mk {
using pg8::bf16_t; using pg8::bf16x8; using pg8::f32x4; using pg8::f32x2; using pg8::u32x4; using pg8::u32x2; using pg8::Unit; using pg8::cvt_pk_bf16;
#define LAS __attribute__((address_space(3)))
constexpr int NBAT = MK_NBAT, SEQ = 4096, D = 1024, DFF = 2816, NMEM = 256, M = NBAT * SEQ, MM = NBAT * NMEM, NQKV = 3072;
constexpr float EPS = 1e-6f, LOG2E = 1.4426950408889634f;
constexpr int NWAVES = 8, NPH = 13;

constexpr size_t al256(size_t x) { return (x + 255) / 256 * 256; }
constexpr size_t WS_CTL = 0, CTL_BYTES = 1u << 20;
constexpr size_t WS_WGU1 = WS_CTL + CTL_BYTES;
constexpr size_t WS_WD1 = WS_WGU1 + (size_t)2 * DFF * D * 2;
constexpr size_t WS_WIN = WS_WD1 + (size_t)D * DFF * 2;
constexpr size_t WS_WOUT = WS_WIN + (size_t)NQKV * D * 2;
constexpr size_t WS_WCQS = WS_WOUT + (size_t)D * D * 2;
constexpr size_t WS_WCKV = WS_WCQS + (size_t)D * D * 2;
constexpr size_t WS_WCO = WS_WCKV + (size_t)2 * D * D * 2;
constexpr size_t WS_WGU2 = WS_WCO + (size_t)D * D * 2;
constexpr size_t WS_WD2 = WS_WGU2 + (size_t)2 * DFF * D * 2;
constexpr size_t WS_MB = WS_WD2 + (size_t)D * DFF * 2;
constexpr size_t WS_KVC = WS_MB + (size_t)MM * D * 2;
constexpr size_t WS_WKT = WS_KVC + (size_t)MM * 2 * D * 2;
constexpr size_t WS_VWT = WS_WKT + (size_t)NBAT * D * D * 2;
constexpr size_t SS_BYTES = (size_t)M * 16 * 4;
constexpr size_t WS_SS = WS_VWT + (size_t)NBAT * D * D * 2;
constexpr size_t WS_SSM = WS_SS + 5 * SS_BYTES;
constexpr size_t WS_KM = WS_SSM + (size_t)MM * 16 * 4;
constexpr size_t WS_R1 = al256(WS_KM + (size_t)NBAT * 16 * 256 * 4);
constexpr size_t WS_XB = WS_R1 + (size_t)M * NQKV * 2;
constexpr size_t WS_OA2 = WS_XB + (size_t)M * D * 2;
constexpr size_t WS_SEL = WS_OA2 + (size_t)M * 768 * 2;
constexpr size_t WS_OBP = WS_SEL + (size_t)NBAT * 4 * SEQ * 4;
constexpr size_t WS_MLB = WS_OBP + (size_t)4 * M * 256 * 2;
constexpr size_t WS_END = WS_MLB + (size_t)4 * M * 4 * 2 * 4;
constexpr size_t OUT_OA1 = (size_t)M * 768 * 2, OUT_OB = 2 * OUT_OA1, OUT_ML = OUT_OB + (size_t)M * 256 * 2;
static_assert(OUT_ML + (size_t)3 * M * 12 * 8 <= (size_t)M * D * 4, "attention partials fit in d_out");
constexpr int CW_BAR = 4096, CW_QUEUE = 8192;

constexpr int LDS_XCH = 131072;
constexpr int LDS_MISC = 131072 + 8192;
constexpr int LDS_BYTES = 147456;
constexpr int LDS_TAB = 98304;
static_assert(LDS_TAB + 4 * att::TABB_N * 4 <= LDS_XCH, "attention LDS map");

__device__ __forceinline__ float wave_sum(float v) {
#pragma unroll
    for (int o = 1; o < 64; o <<= 1) v += __shfl_xor(v, o);
    return v;
}
__device__ __forceinline__ float row_rstd(const float* ss, int row) {
    const f32x4* p = (const f32x4*)(ss + (size_t)row * 16);
    const f32x4 a = p[0], b = p[1], c = p[2], d = p[3];
    const float s = ((a[0] + a[1]) + (a[2] + a[3])) + ((b[0] + b[1]) + (b[2] + b[3])) + ((c[0] + c[1]) + (c[2] + c[3])) + ((d[0] + d[1]) + (d[2] + d[3]));
    return 1.0f / sqrtf(s * (1.0f / D) + EPS);
}

struct SchedStd {
    pg8::Order o; const char* A; const char* B; size_t a_tile, b_tile, b_batch; int ocol_mul;
    __device__ __forceinline__ bool next(int i, Unit& u) const { int pm, pn; if (!o.tile(i, pm, pn)) return false;
        u.a = A + (size_t)pm * a_tile; u.b = B + (size_t)pn * b_tile + (size_t)(pm >> 4) * b_batch; u.orow = pm * 256; u.ocol = pn * ocol_mul; u.aux = pn; return true; }
};
struct SchedWK {
    int G, c; const char* kvc; const char* wcqs;
    __device__ __forceinline__ bool next(int i, Unit& u) const { const int L = i * G + c; if (L >= NBAT * 16) return false; const int bh = L >> 2, pn = L & 3, b = bh >> 2, h = bh & 3;
        u.a = kvc + ((size_t)(b * 256) * 2048 + h * 256) * 2; u.b = wcqs + ((size_t)(pn * 256) * 1024 + h * 256) * 2; u.orow = b * 1024 + h * 256; u.ocol = pn * 256; u.aux = 0; return true; }
};
struct SchedVW {
    int G, c; const char* kvc; const char* wcot;
    __device__ __forceinline__ bool next(int i, Unit& u) const { const int L = i * G + c; if (L >= NBAT * 16) return false; const int bh = L >> 2, pm = L & 3, b = bh >> 2, h = bh & 3;
        u.a = wcot + ((size_t)(pm * 256) * 1024 + h * 256) * 2; u.b = kvc + ((size_t)(b * 256) * 2048 + 1024 + h * 256) * 2; u.orow = b * 1024 + pm * 256; u.ocol = h * 256; u.aux = 0; return true; }
};

struct EpiGU { static constexpr bool PERM = true;
    bf16_t* H; const float* ss;
    __device__ __forceinline__ void operator()(const f32x4 (&acc)[2][2][4][2], const Unit& u, int wr, int wc, int fr, int fq, LAS unsigned char*, int, int) const {
        float rsv[2][4];
#pragma unroll
        for (int ai = 0; ai < 2; ++ai)
#pragma unroll
            for (int m = 0; m < 4; ++m) rsv[ai][m] = row_rstd(ss, u.orow + ai * 128 + wr * 64 + m * 16 + fr);
#pragma unroll
        for (int ai = 0; ai < 2; ++ai)
#pragma unroll
            for (int m = 0; m < 4; ++m) { const int row = u.orow + ai * 128 + wr * 64 + m * 16 + fr; const float rs = rsv[ai][m];
                float hv[8];
#pragma unroll
                for (int n = 0; n < 2; ++n)
#pragma unroll
                    for (int j = 0; j < 4; ++j) { const float g = acc[ai][0][m][n][j] * rs, uu = acc[ai][1][m][n][j] * rs;
                        hv[4 * n + j] = g * __builtin_amdgcn_rcpf(1.0f + __builtin_amdgcn_exp2f(-g * LOG2E)) * uu; }
                u32x4 w; w[0] = cvt_pk_bf16(hv[0], hv[1]); w[1] = cvt_pk_bf16(hv[2], hv[3]); w[2] = cvt_pk_bf16(hv[4], hv[5]); w[3] = cvt_pk_bf16(hv[6], hv[7]);
                __builtin_nontemporal_store(w, (u32x4*)(H + (size_t)row * DFF + u.ocol + wc * 32 + 8 * fq)); }
    }
};
struct EpiRes { static constexpr bool PERM = true;
    bf16_t* xb; float* ssout; float alpha;
    __device__ __forceinline__ void operator()(const f32x4 (&acc)[2][2][4][2], const Unit& u, int wr, int wc, int fr, int fq, LAS unsigned char*, int, int) const {
        const size_t off0 = (size_t)(u.orow + wr * 64 + fr) * D + u.ocol + wc * 32 + 8 * fq;
        u32x4 cur[2], nxt[2];
#pragma unroll
        for (int bj = 0; bj < 2; ++bj) cur[bj] = *(const u32x4*)(xb + off0 + bj * 128);
#pragma unroll
        for (int idx = 0; idx < 8; ++idx) { const int ai = idx >> 2, m = idx & 3; const size_t off = off0 + (size_t)(ai * 128 + m * 16) * D; const int row = u.orow + ai * 128 + wr * 64 + m * 16 + fr;
            if (idx < 7) { const size_t offn = off0 + (size_t)(((idx + 1) >> 2) * 128 + ((idx + 1) & 3) * 16) * D;
#pragma unroll
                for (int bj = 0; bj < 2; ++bj) nxt[bj] = *(const u32x4*)(xb + offn + bj * 128); }
            float sq = 0.f;
#pragma unroll
            for (int bj = 0; bj < 2; ++bj) { float o[8];
#pragma unroll
                for (int n = 0; n < 2; ++n)
#pragma unroll
                    for (int j = 0; j < 4; ++j) { const unsigned wv = cur[bj][2 * n + (j >> 1)]; const float r = __builtin_bit_cast(float, (j & 1) ? (wv & 0xffff0000u) : (wv << 16));
                        const float v = r + acc[ai][bj][m][n][j] * alpha; o[4 * n + j] = v; sq += v * v; }
                u32x4 w; w[0] = cvt_pk_bf16(o[0], o[1]); w[1] = cvt_pk_bf16(o[2], o[3]); w[2] = cvt_pk_bf16(o[4], o[5]); w[3] = cvt_pk_bf16(o[6], o[7]);
                *(u32x4*)(xb + off + bj * 128) = w; }
            sq += __shfl_xor(sq, 16); sq += __shfl_xor(sq, 32);
            if (fq == 0) ssout[(size_t)row * 16 + (u.ocol >> 8) * 4 + wc] = sq;
#pragma unroll
            for (int bj = 0; bj < 2; ++bj) cur[bj] = nxt[bj]; }
    }
};
struct EpiStore { static constexpr bool PERM = true;
    bf16_t* O; int ldc; const float* ss; float* km; bool nt;
    __device__ __forceinline__ void operator()(const f32x4 (&acc)[2][2][4][2], const Unit& u, int wr, int wc, int fr, int fq, LAS unsigned char*, int, int) const {
        float rsv[2][4];
#pragma unroll
        for (int ai = 0; ai < 2; ++ai)
#pragma unroll
            for (int m = 0; m < 4; ++m) rsv[ai][m] = ss ? row_rstd(ss, u.orow + ai * 128 + wr * 64 + m * 16 + fr) : 1.0f;
#pragma unroll
        for (int ai = 0; ai < 2; ++ai)
#pragma unroll
            for (int m = 0; m < 4; ++m) { const int row = u.orow + ai * 128 + wr * 64 + m * 16 + fr; const float rs = rsv[ai][m];
                const int col0 = u.ocol + wc * 32 + 8 * fq;
                bf16_t* rowp = ldc ? O + (size_t)row * ldc + col0 : O + (((size_t)(row / SEQ) * (NQKV / 64) + (col0 >> 6)) * SEQ + (row % SEQ)) * 64 + (col0 & 63);
                const size_t bjstep = ldc ? 128 : (size_t)2 * SEQ * 64;
#pragma unroll
                for (int bj = 0; bj < 2; ++bj) { const f32x4 v0 = acc[ai][bj][m][0] * rs, v1 = acc[ai][bj][m][1] * rs;
                    u32x4 w; w[0] = cvt_pk_bf16(v0[0], v0[1]); w[1] = cvt_pk_bf16(v0[2], v0[3]); w[2] = cvt_pk_bf16(v1[0], v1[1]); w[3] = cvt_pk_bf16(v1[2], v1[3]);
                    if (nt) __builtin_nontemporal_store(w, (u32x4*)(rowp + bj * bjstep)); else *(u32x4*)(rowp + bj * bjstep) = w; } }
        if ((km != nullptr) && (u.aux == 10)) {
            float* kmb = km + (size_t)(u.orow >> 8) * 256 + wc * 32 + 8 * fq;
#pragma unroll
            for (int bj = 0; bj < 2; ++bj)
#pragma unroll
                for (int n = 0; n < 2; ++n) { f32x4 cs = (f32x4){0.f, 0.f, 0.f, 0.f};
#pragma unroll
                    for (int ai = 0; ai < 2; ++ai)
#pragma unroll
                        for (int m = 0; m < 4; ++m) cs += acc[ai][bj][m][n] * rsv[ai][m];
#pragma unroll
                    for (int j = 0; j < 4; ++j) { float v = cs[j]; v += __shfl_xor(v, 1); v += __shfl_xor(v, 2); v += __shfl_xor(v, 4); v += __shfl_xor(v, 8);
                        if (fr == 0) atomicAdd(kmb + bj * 128 + 4 * n + j, v); } }
        }
    }
};
struct EpiSoftmax { static constexpr bool PERM = true;
    bf16_t* P; const float* ss;
    __device__ __forceinline__ void operator()(const f32x4 (&acc)[2][2][4][2], const Unit& u, int wr, int wc, int fr, int fq, LAS unsigned char* lds, int, int) const {
        LAS f32x2* X = (LAS f32x2*)(lds + LDS_XCH);
        float rsl[2][4], mw[2][4];
#pragma unroll
        for (int ai = 0; ai < 2; ++ai)
#pragma unroll
            for (int m = 0; m < 4; ++m) { const int rl = ai * 128 + wr * 64 + m * 16 + fr; const float rs = row_rstd(ss, u.orow + rl) * LOG2E; rsl[ai][m] = rs;
                float mx = -INFINITY;
#pragma unroll
                for (int bj = 0; bj < 2; ++bj)
#pragma unroll
                    for (int n = 0; n < 2; ++n)
#pragma unroll
                        for (int j = 0; j < 4; ++j) mx = fmaxf(mx, acc[ai][bj][m][n][j] * rs);
                mx = fmaxf(mx, __shfl_xor(mx, 16)); mx = fmaxf(mx, __shfl_xor(mx, 32));
                float sm = 0.f;
#pragma unroll
                for (int bj = 0; bj < 2; ++bj)
#pragma unroll
                    for (int n = 0; n < 2; ++n)
#pragma unroll
                        for (int j = 0; j < 4; ++j) sm += __builtin_amdgcn_exp2f(acc[ai][bj][m][n][j] * rs - mx);
                sm += __shfl_xor(sm, 16); sm += __shfl_xor(sm, 32);
                mw[ai][m] = mx;
                if (fq == 0) X[rl * 4 + wc] = (f32x2){mx, sm}; }
        asm volatile("s_waitcnt lgkmcnt(0)" ::: "memory"); __builtin_amdgcn_s_barrier(); asm volatile("" ::: "memory");
#pragma unroll
        for (int ai = 0; ai < 2; ++ai)
#pragma unroll
            for (int m = 0; m < 4; ++m) { const int rl = ai * 128 + wr * 64 + m * 16 + fr; const float rs = rsl[ai][m];
                const f32x2 x0 = X[rl * 4 + 0], x1 = X[rl * 4 + 1], x2 = X[rl * 4 + 2], x3 = X[rl * 4 + 3];
                const float Mx = fmaxf(fmaxf(x0[0], x1[0]), fmaxf(x2[0], x3[0]));
                const float L = x0[1] * __builtin_amdgcn_exp2f(x0[0] - Mx) + x1[1] * __builtin_amdgcn_exp2f(x1[0] - Mx) + x2[1] * __builtin_amdgcn_exp2f(x2[0] - Mx) + x3[1] * __builtin_amdgcn_exp2f(x3[0] - Mx);
                const float il = 1.0f / L;
                bf16_t* rowp = P + (size_t)(u.orow + rl) * D + u.ocol + wc * 32 + 8 * fq;
#pragma unroll
                for (int bj = 0; bj < 2; ++bj) { float pv[8];
#pragma unroll
                    for (int n = 0; n < 2; ++n)
#pragma unroll
                        for (int j = 0; j < 4; ++j) pv[4 * n + j] = __builtin_amdgcn_exp2f(acc[ai][bj][m][n][j] * rs - Mx) * il;
                    u32x4 w; w[0] = cvt_pk_bf16(pv[0], pv[1]); w[1] = cvt_pk_bf16(pv[2], pv[3]); w[2] = cvt_pk_bf16(pv[4], pv[5]); w[3] = cvt_pk_bf16(pv[6], pv[7]);
                    *(u32x4*)(rowp + bj * 128) = w; } }
        (void)mw;
    }
};

#define XB_TMO      128
#define XB_XCNT(j)  (256  + 64 * (j))
#define XB_XSUB(j)  (1280 + 64 * (j))
#define XB_XGEN(j)  (2304 + 64 * (j))
#define XB_TOP      3328
#define XB_TOPGEN   3392
#define XCD_BAR_WORDS 3456
#define XB_SPIN_CAP (1u << 18)
__device__ __forceinline__ unsigned xb_ld(unsigned* p)              { return __hip_atomic_load(p, __ATOMIC_RELAXED, __HIP_MEMORY_SCOPE_AGENT); }
__device__ __forceinline__ unsigned xb_add(unsigned* p, unsigned v) { return __hip_atomic_fetch_add(p, v, __ATOMIC_RELAXED, __HIP_MEMORY_SCOPE_AGENT); }
__device__ __forceinline__ unsigned xb_xcc_id() { return (unsigned)__builtin_amdgcn_s_getreg((3 << 11) | 20) & 0xFu; }
#define XB_SPIN(cond, bar) do { unsigned _sp = 0; while (cond) { __builtin_amdgcn_s_sleep(1); \
    if ((++_sp & 255u) == 0u) { if (xb_ld(&(bar)[XB_TMO])) break; if (_sp > XB_SPIN_CAP) { atomicAdd(&(bar)[XB_TMO], 1u); break; } } } } while (0)
struct XcdBarrier { unsigned* bar; unsigned x; volatile LAS unsigned* st; };
__device__ __forceinline__ XcdBarrier xcd_barrier_post(unsigned* bar, volatile LAS unsigned* st) {
    XcdBarrier b; b.bar = bar; b.x = xb_xcc_id(); b.st = st;
    if (threadIdx.x == 0) (void)xb_add(&bar[XB_XCNT(b.x)], 1u);
    return b;
}
__device__ __forceinline__ void xcd_barrier_complete(unsigned* bar, unsigned x, unsigned& nloc, unsigned& nx) {
    const unsigned G = gridDim.x * gridDim.y * gridDim.z;
    unsigned sum, cnt, mine, sp = 0u;
    for (;;) {
        sum = 0u; cnt = 0u; mine = 0u;
#pragma unroll
        for (unsigned j = 0; j < 16; ++j) { const unsigned c = xb_ld(&bar[XB_XCNT(j)]); sum += c; cnt += (c > 0u) ? 1u : 0u; mine = (j == x) ? c : mine; }
        if (sum == G) break;
        __builtin_amdgcn_s_sleep(1);
        if ((++sp & 255u) == 0u) { if (xb_ld(&bar[XB_TMO])) break; if (sp > XB_SPIN_CAP) { atomicAdd(&bar[XB_TMO], 1u); break; } }
    }
    nloc = mine > 0u ? mine : 1u; nx = cnt > 0u ? cnt : 1u;
}
__device__ __forceinline__ void xcd_barrier(const XcdBarrier& b) {
    asm volatile("s_waitcnt vmcnt(0)" ::: "memory");
    __syncthreads();
    if (threadIdx.x == 0) {
        unsigned* bar = b.bar;
        __builtin_amdgcn_s_waitcnt(0);
        unsigned nloc = b.st[0], nx = b.st[1];
        if (nloc == 0u) { xcd_barrier_complete(bar, b.x, nloc, nx); b.st[0] = nloc; b.st[1] = nx; }
        const unsigned old = xb_add(&bar[XB_XSUB(b.x)], 1u);
        const unsigned gen = old / nloc;
        if (old + 1u == (gen + 1u) * nloc) {
            __builtin_amdgcn_fence(__ATOMIC_RELEASE, "agent");
            asm volatile("s_waitcnt vmcnt(0)" ::: "memory");
            const unsigned og = xb_add(&bar[XB_TOP], 1u);
            const unsigned tg = og / nx;
            if (og + 1u == (tg + 1u) * nx) xb_add(&bar[XB_TOPGEN], 1u);
            else XB_SPIN(xb_ld(&bar[XB_TOPGEN]) == tg, bar);
            __builtin_amdgcn_fence(__ATOMIC_ACQUIRE, "agent");
            xb_add(&bar[XB_XGEN(b.x)], 1u);
            asm volatile("s_waitcnt vmcnt(0)" ::: "memory");
        } else {
            XB_SPIN(xb_ld(&bar[XB_XGEN(b.x)]) == gen, bar);
            __builtin_amdgcn_fence(__ATOMIC_ACQUIRE, "agent");
            asm volatile("s_waitcnt vmcnt(0)" ::: "memory");
        }
    }
    __syncthreads();
}

__device__ __forceinline__ void tr_item(const float* W, int N, int k0, int n0, const float* gain, float cscale, bf16_t* dst  , int Kd, LAS float* scr, int lane) {
    f32x4 v[8]; float g[8];
#pragma unroll
    for (int i = 0; i < 8; ++i) { const int kk = 8 * i + (lane >> 3); v[i] = __builtin_nontemporal_load((const f32x4*)(W + (size_t)(k0 + kk) * N + n0 + 4 * (lane & 7))); g[i] = gain ? gain[k0 + kk] * cscale : cscale; }
#pragma unroll
    for (int i = 0; i < 8; ++i) { const int kk = 8 * i + (lane >> 3); LAS float* d = scr + kk * 33 + 4 * (lane & 7); d[0] = v[i][0] * g[i]; d[1] = v[i][1] * g[i]; d[2] = v[i][2] * g[i]; d[3] = v[i][3] * g[i]; }
    asm volatile("s_waitcnt lgkmcnt(0)" ::: "memory");
    const int c = lane & 7;
#pragma unroll
    for (int j = 0; j < 4; ++j) { const int n = (lane >> 3) + 8 * j; const LAS float* s = scr + (8 * c) * 33 + n;
        u32x4 o; o[0] = cvt_pk_bf16(s[0 * 33], s[1 * 33]); o[1] = cvt_pk_bf16(s[2 * 33], s[3 * 33]); o[2] = cvt_pk_bf16(s[4 * 33], s[5 * 33]); o[3] = cvt_pk_bf16(s[6 * 33], s[7 * 33]);
        *(u32x4*)(dst + (size_t)n * Kd + k0 + 8 * c) = o; }
    asm volatile("s_waitcnt lgkmcnt(0)" ::: "memory");
}
template <int NR>
__device__ __forceinline__ void cvt_rows(const float* x, bf16_t* o, float* ss, int row0, int stride, int nrows, int lane) {
    f32x4 v[NR][4]; float s[NR];
#pragma unroll
    for (int r = 0; r < NR; ++r) { const int row = row0 + r * stride; const f32x4* xr = (const f32x4*)(x + (size_t)(row < nrows ? row : row0) * D) + lane;
#pragma unroll
        for (int j = 0; j < 4; ++j) v[r][j] = __builtin_nontemporal_load(xr + 64 * j); }
#pragma unroll
    for (int r = 0; r < NR; ++r) { float a = 0.f;
#pragma unroll
        for (int j = 0; j < 4; ++j) a += (v[r][j][0] * v[r][j][0] + v[r][j][1] * v[r][j][1]) + (v[r][j][2] * v[r][j][2] + v[r][j][3] * v[r][j][3]);
        s[r] = a; }
#pragma unroll
    for (int of = 1; of < 64; of <<= 1)
#pragma unroll
        for (int r = 0; r < NR; ++r) s[r] += __shfl_xor(s[r], of);
#pragma unroll
    for (int r = 0; r < NR; ++r) { const int row = row0 + r * stride; if (row < nrows) { u32x2* o8 = (u32x2*)(o + (size_t)row * D) + lane;
#pragma unroll
            for (int j = 0; j < 4; ++j) { u32x2 w; w[0] = cvt_pk_bf16(v[r][j][0], v[r][j][1]); w[1] = cvt_pk_bf16(v[r][j][2], v[r][j][3]); o8[64 * j] = w; }
            if (lane < 16) ss[(size_t)row * 16 + lane] = lane == 0 ? s[r] : 0.f; } }
}

struct Args { const float* in[20]; float* out; unsigned char* ws; int ph_lo, ph_hi, flags, pad; };

#define MK_PTRS unsigned char* ws = args.ws; float* out = args.out; asm volatile("" : "+s"(ws), "+s"(out)); \
    const float* x_in = args.in[0]; const float* mem_in = args.in[1]; const float* rel_bias = args.in[7]; \
    bf16_t* Wgu1 = (bf16_t*)(ws + WS_WGU1); bf16_t* Wd1 = (bf16_t*)(ws + WS_WD1); bf16_t* Win = (bf16_t*)(ws + WS_WIN); bf16_t* Wout = (bf16_t*)(ws + WS_WOUT); \
    bf16_t* Wcqs = (bf16_t*)(ws + WS_WCQS); bf16_t* Wckv = (bf16_t*)(ws + WS_WCKV); bf16_t* Wco = (bf16_t*)(ws + WS_WCO); bf16_t* Wgu2 = (bf16_t*)(ws + WS_WGU2); bf16_t* Wd2 = (bf16_t*)(ws + WS_WD2); \
    bf16_t* MB = (bf16_t*)(ws + WS_MB); bf16_t* KVC = (bf16_t*)(ws + WS_KVC); bf16_t* WKT = (bf16_t*)(ws + WS_WKT); bf16_t* VWT = (bf16_t*)(ws + WS_VWT); \
    float* SS0 = (float*)(ws + WS_SS); float* SS1 = SS0 + (size_t)M * 16; float* SS2 = SS1 + (size_t)M * 16; float* SS3 = SS2 + (size_t)M * 16; float* SS4 = SS3 + (size_t)M * 16; \
    float* SSM = (float*)(ws + WS_SSM); float* KM = (float*)(ws + WS_KM); \
    bf16_t* HB = (bf16_t*)(ws + WS_R1); bf16_t* QKV = HB; bf16_t* YN = HB; bf16_t* PB = HB; \
    bf16_t* XB = (bf16_t*)(ws + WS_XB); bf16_t* OA0 = (bf16_t*)out; bf16_t* OA1 = (bf16_t*)((char*)out + OUT_OA1); bf16_t* OA2 = (bf16_t*)(ws + WS_OA2); bf16_t* OB = (bf16_t*)((char*)out + OUT_OB); float* ML = (float*)((char*)out + OUT_ML); unsigned* SEL = (unsigned*)(ws + WS_SEL); bf16_t* OBP = (bf16_t*)(ws + WS_OBP); float* MLB = (float*)(ws + WS_MLB); (void)OB;
__global__ void __launch_bounds__(NWAVES * 64, 2) mk_fwd(Args args) {
    extern __shared__ __attribute__((aligned(16))) unsigned char lds_raw[];
    LAS unsigned char* lds = (LAS unsigned char*)lds_raw;
    const int tid = threadIdx.x, lane = tid & 63, wave = __builtin_amdgcn_readfirstlane(tid >> 6);
    const int G = gridDim.x, bx = blockIdx.x;
    const int vcu = (G % 8 == 0) ? (bx % 8) * (G / 8) + bx / 8 : bx;
    const int gw = vcu * NWAVES + wave, NGW = G * NWAVES;
    unsigned char* const ws0 = args.ws;
    volatile LAS unsigned* MISC = (volatile LAS unsigned*)(lds + LDS_MISC);
    if (tid < 32) MISC[tid] = 0u;
    __syncthreads();
    const int lo = args.ph_lo, hi = args.ph_hi;
    const bool use_bar = (hi - lo) > 1;
    XcdBarrier bar; bar.bar = (unsigned*)(ws0 + WS_CTL) + CW_BAR; bar.x = 0; bar.st = nullptr;
    if (use_bar) bar = xcd_barrier_post((unsigned*)(ws0 + WS_CTL) + CW_BAR, MISC + 8);
#define IN(k) (lo <= (k) && (k) < hi)
#define STAGGER() do { if (MK_STAGGER_TICKS > 0) { const unsigned long long t0_ = __builtin_amdgcn_s_memrealtime(), dl_ = (unsigned long long)((bx >> 3) & 3) * MK_STAGGER_TICKS; while (__builtin_amdgcn_s_memrealtime() - t0_ < dl_) __builtin_amdgcn_s_sleep(8); } } while (0)
#define SEAM(k) do { if (IN(k) && IN((k) + 1)) xcd_barrier(bar); } while (0)

    if (IN(0)) {
        MK_PTRS;
        LAS float* scr = (LAS float*)(lds + wave * 16384);
        constexpr int I_GU = (D / 64) * (2 * DFF / 32), I_DN = (DFF / 64) * (D / 32), I_IN = (D / 64) * (NQKV / 32), I_SQ = (D / 64) * (D / 32), I_KV = (D / 64) * (2 * D / 32);
        constexpr int NITEMS = 2 * I_GU + 2 * I_DN + I_IN + 2 * I_SQ + I_KV;
        for (int it = gw; it < NITEMS; it += NGW) {
            int r = it;
            if (r < 2 * I_GU) {
                const bool second = r >= I_GU; if (second) r -= I_GU;
                const int nblk = 2 * DFF / 32, kb = r / nblk, nb = r % nblk, n0 = nb * 32;
                const int drow = n0 < DFF ? (n0 / 128) * 256 + (n0 % 128) : ((n0 - DFF) / 128) * 256 + 128 + ((n0 - DFF) % 128);
                tr_item(args.in[second ? 17 : 3], 2 * DFF, kb * 64, n0, args.in[second ? 16 : 2], 1.0f, (second ? Wgu2 : Wgu1) + (size_t)drow * D, D, scr, lane); continue; }
            r -= 2 * I_GU;
            if (r < 2 * I_DN) { const bool second = r >= I_DN; if (second) r -= I_DN; const int nblk = D / 32, kb = r / nblk, nb = r % nblk;
                tr_item(args.in[second ? 18 : 4], D, kb * 64, nb * 32, nullptr, 1.0f, (second ? Wd2 : Wd1) + (size_t)(nb * 32) * DFF, DFF, scr, lane); continue; }
            r -= 2 * I_DN;
            if (r < I_IN) { const int nblk = NQKV / 32, kb = r / nblk, nb = r % nblk, n0 = nb * 32; const bool isq = (n0 < 768) || (n0 >= 2304 && n0 < 2560);
                tr_item(args.in[6], NQKV, kb * 64, n0, args.in[5], isq ? 0.125f : 1.0f, Win + (size_t)n0 * D, D, scr, lane); continue; }
            r -= I_IN;
            if (r < I_SQ) { const int nblk = D / 32, kb = r / nblk, nb = r % nblk, k0 = kb * 64; const float* gp = k0 < 768 ? args.in[8] : args.in[9] - 768;
                tr_item(args.in[10], D, k0, nb * 32, gp, 1.0f, Wout + (size_t)(nb * 32) * D, D, scr, lane); continue; }
            r -= I_SQ;
            if (r < I_SQ) { const int nblk = D / 32, kb = r / nblk, nb = r % nblk; tr_item(args.in[15], D, kb * 64, nb * 32, nullptr, 1.0f, Wco + (size_t)(nb * 32) * D, D, scr, lane); continue; }
            r -= I_SQ;
            { const int nblk = 2 * D / 32, kb = r / nblk, nb = r % nblk; tr_item(args.in[14], 2 * D, kb * 64, nb * 32, args.in[12], 1.0f, Wckv + (size_t)(nb * 32) * D, D, scr, lane); }
        }
        for (int c = gw; c < D; c += NGW) { const float g = args.in[11][c] * 0.0625f; const f32x4* src = (const f32x4*)(args.in[13] + (size_t)c * D) + lane; u32x2* dst = (u32x2*)(Wcqs + (size_t)c * D) + lane;
#pragma unroll
            for (int j = 0; j < 4; ++j) { const f32x4 v = src[64 * j] * g; u32x2 w; w[0] = cvt_pk_bf16(v[0], v[1]); w[1] = cvt_pk_bf16(v[2], v[3]); dst[64 * j] = w; } }
        for (int m = gw; m < M; m += 4 * NGW) cvt_rows<4>(x_in, XB, SS0, m, NGW, M, lane);
        for (int m = gw; m < MM; m += NGW) cvt_rows<1>(mem_in, MB, SSM, m, NGW, MM, lane);
        for (int i = gw * 64 + lane; i < NBAT * 16 * 256; i += NGW * 64) KM[i] = 0.f;
    }
    SEAM(0);

    if (IN(1)) {
        MK_PTRS;
        STAGGER();
        { SchedStd S; S.o.init(M, 2 * DFF, G, bx); S.A = (const char*)XB; S.B = (const char*)Wgu1; S.a_tile = (size_t)256 * D * 2; S.b_tile = (size_t)256 * D * 2; S.b_batch = 0; S.ocol_mul = 128;
          EpiGU E{HB, SS0}; pg8::gemm_phase<EpiGU, SchedStd, true>(lds, D, D, D / 64, S, E); }
        { SchedStd S; S.o.init(MM, 2 * D, G, (bx + G / 2) % G); S.A = (const char*)MB; S.B = (const char*)Wckv; S.a_tile = (size_t)256 * D * 2; S.b_tile = (size_t)256 * D * 2; S.b_batch = 0; S.ocol_mul = 256;
          EpiStore E{KVC, 2 * D, SSM, nullptr, false}; pg8::gemm_phase<EpiStore, SchedStd, true>(lds, D, D, D / 64, S, E); }
    }
    SEAM(1);

    if (IN(2)) {
        MK_PTRS;
        SchedStd S; S.o.init(M, D, G, bx); S.A = (const char*)HB; S.B = (const char*)Wd1; S.a_tile = (size_t)256 * DFF * 2; S.b_tile = (size_t)256 * DFF * 2; S.b_batch = 0; S.ocol_mul = 256;
        EpiRes E{XB, SS1, 0.5f}; pg8::gemm_phase<EpiRes, SchedStd, true>(lds, DFF, DFF, DFF / 64, S, E);
    }
    SEAM(2);

    if (IN(3)) {
        MK_PTRS;
        { SchedStd S; S.o.init(M, NQKV, G, bx); S.A = (const char*)XB; S.B = (const char*)Win; S.a_tile = (size_t)256 * D * 2; S.b_tile = (size_t)256 * D * 2; S.b_batch = 0; S.ocol_mul = 256;
          EpiStore E{QKV, 0, SS1, KM, false}; pg8::gemm_phase<EpiStore, SchedStd, true>(lds, D, D, D / 64, S, E); }
        { SchedWK S{G, bx, (const char*)KVC, (const char*)Wcqs}; EpiStore E{WKT, D, nullptr, nullptr, false}; pg8::gemm_phase<EpiStore, SchedWK, true>(lds, 2 * D, D, 4, S, E); }
        { SchedVW S{G, (bx + G / 2) % G, (const char*)KVC, (const char*)Wco}; EpiStore E{VWT, D, nullptr, nullptr, false}; pg8::gemm_phase<EpiStore, SchedVW, true>(lds, D, 2 * D, 4, S, E); }
    }
    SEAM(3);

    if (IN(4)) {
        MK_PTRS;
        constexpr long HSTR4 = (long)SEQ * 128;
        for (int task = gw; task < NBAT * 4 * (SEQ / 32); task += NGW) { const int bh = task / (SEQ / 32), tl = task % (SEQ / 32), b = bh >> 2, hb = bh & 3, q0 = tl * 32, qb = q0 >> 8;
            const char* qbase = (const char*)QKV + ((size_t)b * 48 + 36 + hb) * HSTR4 + (size_t)q0 * 128;
            const unsigned msk = att::moba_select(qbase, 128, KM + (size_t)b * 16 * 256 + hb * 64, qb);
            if (lane < 32) SEL[(size_t)bh * SEQ + q0 + lane] = msk; }
    }
    SEAM(4);

    if (IN(5)) {
        MK_PTRS;
        LAS float* tab = (LAS float*)(lds + LDS_TAB);
        const int h2 = lane >> 5, q = lane & 31;
        const long rowb = 128;
        constexpr long HSTR = (long)SEQ * 128;
#define ATT_WAITV(n) asm volatile("s_waitcnt vmcnt(" #n ")" ::: "memory")
#define ATT_BAR() do { asm volatile("s_waitcnt lgkmcnt(0)" ::: "memory"); __builtin_amdgcn_s_barrier(); asm volatile("" ::: "memory"); } while (0)
        for (int i = tid; i < 4 * att::TABB_N; i += NWAVES * 64) { const int hb = i / att::TABB_N, e = i % att::TABB_N, dist = e - 32;
            tab[i] = dist >= 0 ? rel_bias[att::rel_bucket(dist) * 16 + 12 + hb] * LOG2E : -INFINITY; }
        __syncthreads();
        {
            constexpr int NBH = NBAT * 4, NUNITS = 16 * NBH;
            LAS unsigned* LQ = (LAS unsigned*)(lds + 65536);
            volatile LAS unsigned* UW = (volatile LAS unsigned*)(lds + 65536 + 16384);
            unsigned* qhead = (unsigned*)(ws + WS_CTL) + CW_QUEUE;
#pragma unroll 1
            for (;;) {
                if (tid == 0) UW[8] = __hip_atomic_fetch_add(qhead, 1u, __ATOMIC_RELAXED, __HIP_MEMORY_SCOPE_AGENT);
                ATT_BAR();
                const int u = (int)UW[8];
                if (u >= NUNITS) break;
                const int n = u / NBH, bh = u % NBH, b = bh >> 2, hb = bh & 3;
                const char* qh = (const char*)QKV + ((size_t)b * 48 + 36 + hb) * HSTR;
                const char* kh = (const char*)QKV + ((size_t)b * 48 + 40 + hb) * HSTR + (size_t)(256 * n) * rowb;
                const unsigned* selp = SEL + (size_t)bh * SEQ;
                ATT_WAITV(0);
#pragma unroll
                for (int k = wave; k < 32; k += NWAVES) { const int row = 8 * k + (lane >> 3); att::dma_rows8(kh + (long)row * rowb, (int)(4 * HSTR), row, (LAS char*)(lds + k * 1024), (LAS char*)(lds + 32768 + k * 1024), lane); }
                int total = 0;
                if (n < 15) {
                    const int lo = 256 * (n + 1) + wave * 32 * (15 - n), R = 32 * (15 - n);
                    int cnt = 0;
#pragma unroll 1
                    for (int i = 0; i < R; i += 64) { const bool pr = (i + lane < R) && ((selp[lo + i + lane] >> n) & 1u); cnt += __popcll(__ballot(pr)); }
                    if (lane == 0) UW[wave] = (unsigned)cnt;
                    ATT_BAR();
                    int basew = 0;
#pragma unroll
                    for (int w2 = 0; w2 < NWAVES; ++w2) { const int cw = (int)UW[w2]; basew += (w2 < wave) ? cw : 0; total += cw; }
#pragma unroll 1
                    for (int i = 0; i < R; i += 64) { const bool pr = (i + lane < R) && ((selp[lo + i + lane] >> n) & 1u); const unsigned long long bal = __ballot(pr);
                        if (pr) LQ[basew + __popcll(bal & ((1ull << lane) - 1ull))] = (unsigned)(lo + i + lane); basew += __popcll(bal); }
                }
                const int ntiles = (total + 31) >> 5;
                ATT_WAITV(0); ATT_BAR();
                const LAS float* tb = tab + hb * att::TABB_N;
#pragma unroll 1
                for (int tile = -1; tile < ntiles; tile = (tile < 0 ? wave : tile + NWAVES)) {
                    const bool own = tile < 0;
                    int tq; bool valid = true;
                    if (own) tq = 256 * n + 32 * wave + q; else { const int e = 32 * tile + q; valid = e < total; tq = (int)LQ[valid ? e : total - 1]; }
                    att::bf16x8 qf[4];
#pragma unroll
                    for (int d0 = 0; d0 < 4; ++d0) qf[d0] = *(const att::bf16x8*)(qh + (long)tq * rowb + (16 * d0 + 8 * h2) * 2);
                    const int slot = own ? 3 : __popc(selp[tq] & ((1u << n) - 1u));
                    att::f32x16 o[2]; o[0] = att::f32x16{}; o[1] = att::f32x16{}; float mo = -1e30f, lo_ = 0.f;
                    const int Bq = (tq - 256 * n + 32) - 4 * h2;
#pragma unroll 1
                    for (int g = own ? wave : 7; g >= 0; --g) { int B = Bq - 32 * g; B = B < (att::TABB_N - 1) ? B : (att::TABB_N - 1);
                        att::attn_group(qf, o, mo, lo_, (const LAS char*)(lds + g * 4096), (const LAS char*)(lds + 32768 + g * 4096), tb + B, lane); }
                    lo_ += __shfl_xor(lo_, 32);
                    const size_t prow = (size_t)slot * M + (size_t)b * SEQ + tq;
                    att::store_o<MK_NT_PART>(o, lo_, (char*)OBP + (prow * 256 + hb * 64) * 2, h2, valid);
                    if (h2 == 0 && valid) *(f32x2*)(MLB + (prow * 4 + hb) * 2) = (f32x2){mo, lo_};
                }
                ATT_BAR();
            }
        }
        __syncthreads();
        LAS float* rbl = (LAS float*)(lds + LDS_TAB); LAS float* tabI = (LAS float*)(lds + LDS_TAB + 2048);
        LAS char* ostg = (LAS char*)(lds + LDS_TAB + 3072 + wave * 4096);
        static_assert(LDS_TAB + 3072 + NWAVES * 4096 <= LDS_MISC, "dilated LDS map");
        for (int i = tid; i < 512; i += NWAVES * 64) rbl[i] = rel_bias[i] * LOG2E;
        __syncthreads();
        constexpr int NDIL = NBAT * 12 * 48;
        struct DilItem { int b, h, p, d, res, m0, mbase; };
        auto decode = [&](int it, DilItem& I) { const int bh = it / 48, j = it % 48; I.b = bh / 12; I.h = bh % 12; I.p = j >> 4; const int jj = j & 15;
            I.d = I.p == 0 ? 1 : (I.p == 1 ? 4 : 16); I.res = I.p == 0 ? 0 : (I.p == 1 ? (jj & 3) : jj); const int mblk = I.p == 0 ? jj : (I.p == 1 ? (jj >> 2) : 0);
            I.mbase = mblk * 256 - 128; I.m0 = mblk * 256 + wave * 32; };
        att::bf16x8 qf[4];
        auto issue_k = [&](const DilItem& I) {
            const char* kb = (const char*)QKV + ((size_t)I.b * 48 + 12 + I.h) * HSTR + (size_t)I.res * rowb; const long st = (long)I.d * rowb;
#pragma unroll 1
            for (int k = wave; k < 48; k += NWAVES) { if (I.mbase + 8 * k < 0) continue; const int row = 8 * k + (lane >> 3); att::dma_k_rows8(kb + (long)(I.mbase + row) * st, row, (LAS char*)(lds + k * 1024), lane); } };
        auto issue_v = [&](const DilItem& I) {
            const char* vb = (const char*)QKV + ((size_t)I.b * 48 + 24 + I.h) * HSTR + (size_t)I.res * rowb; const long st = (long)I.d * rowb;
#pragma unroll 1
            for (int k = wave; k < 48; k += NWAVES) { if (I.mbase + 8 * k < 0) continue; const int row = 8 * k + (lane >> 3); att::dma_v_rows8(vb + (long)(I.mbase + row) * st, row, (LAS char*)(lds + 49152 + k * 1024), lane); } };
        auto load_q = [&](const DilItem& I) {
            const char* qp = (const char*)QKV + ((size_t)I.b * 48 + I.h) * HSTR + (size_t)I.res * rowb + (long)I.m0 * I.d * rowb + (long)q * I.d * rowb + 16 * h2;
            asm volatile("global_load_dwordx4 %0, %4, off\n\tglobal_load_dwordx4 %1, %4, off offset:32\n\tglobal_load_dwordx4 %2, %4, off offset:64\n\tglobal_load_dwordx4 %3, %4, off offset:96"
                         : "=&v"(qf[0]), "=&v"(qf[1]), "=&v"(qf[2]), "=&v"(qf[3]) : "v"(qp) : "memory"); };
        auto build_tab = [&](const DilItem& I) { if (tid < att::TABA_N) { const int delta = tid - 32; tabI[tid] = (delta >= 0 && delta <= 128) ? rbl[att::rel_bucket(delta * I.d) * 16 + I.h] : -INFINITY; } };
        DilItem cur; int it = vcu;
        if (it < NDIL) { decode(it, cur); build_tab(cur); ATT_WAITV(0); issue_k(cur); load_q(cur); issue_v(cur); }
#pragma unroll 1
        for (; it < NDIL; it += G) {
            if (cur.mbase < 0) ATT_WAITV(4); else ATT_WAITV(6);
            asm volatile("" : "+v"(qf[0]), "+v"(qf[1]), "+v"(qf[2]), "+v"(qf[3]));
            ATT_BAR();
            const int m0 = cur.m0, gend = (m0 - 128) > 0 ? (m0 - 128) : 0, ng = ((m0 - gend) >> 5) + 1;
            att::u32x4 pw[5][2]; float mo, lo_;
            { att::bf16x8 qc[4] = {qf[0], qf[1], qf[2], qf[3]};
              att::dil_pass1(qc, ng, (const LAS char*)(lds + (m0 - cur.mbase) * 128), tabI + 32 + q - 4 * h2, pw, mo, lo_, lane); }
            ATT_WAITV(0); ATT_BAR();
            const DilItem done = cur; const bool has_next = it + G < NDIL;
            if (has_next) { decode(it + G, cur); issue_k(cur); build_tab(cur); }
            att::f32x16 o[2];
            att::dil_pass2(ng, (const LAS char*)(lds + 49152 + (m0 - done.mbase) * 128), pw, o, lane);
            ATT_BAR();
            const size_t tok = (size_t)done.b * SEQ + (size_t)(m0 + q) * done.d + done.res;
            att::store_o_staged<MK_NT_PART>(o, lo_, ostg, (char*)(done.p == 0 ? OA0 : (done.p == 1 ? OA1 : OA2)) + (((size_t)done.b * SEQ + (size_t)m0 * done.d + done.res) * 768 + done.h * 64) * 2, (long)done.d * 768 * 2, lane);
            if (h2 == 0) *(f32x2*)(ML + (((size_t)done.p * M + tok) * 12 + done.h) * 2) = (f32x2){mo, lo_};
            if (has_next) { load_q(cur); issue_v(cur); }
        }
#undef ATT_WAITV
#undef ATT_BAR
    }
    SEAM(5);

    if (IN(6)) {
        MK_PTRS;
        for (int row0 = gw; row0 < M; row0 += 2 * NGW) {
            f32x2 ml[2][3][3]; u32x2 oa[2][3][3]; f32x2 mlb[2][4]; u32x2 obp[2][4];
#pragma unroll
            for (int r = 0; r < 2; ++r) { const int row = (row0 + r * NGW) < M ? (row0 + r * NGW) : row0;
#pragma unroll
                for (int k = 0; k < 3; ++k) { const int col = 256 * k + 4 * lane, hd = col >> 6;
#pragma unroll
                    for (int p = 0; p < 3; ++p) ml[r][k][p] = __builtin_nontemporal_load((const f32x2*)(ML + (((size_t)p * M + row) * 12 + hd) * 2));
                    oa[r][k][0] = __builtin_nontemporal_load((const u32x2*)(OA0 + (size_t)row * 768 + col)); oa[r][k][1] = __builtin_nontemporal_load((const u32x2*)(OA1 + (size_t)row * 768 + col)); oa[r][k][2] = __builtin_nontemporal_load((const u32x2*)(OA2 + (size_t)row * 768 + col)); }
#pragma unroll
                for (int s = 0; s < 4; ++s) { mlb[r][s] = __builtin_nontemporal_load((const f32x2*)(MLB + (((size_t)s * M + row) * 4 + (lane >> 4)) * 2)); obp[r][s] = __builtin_nontemporal_load((const u32x2*)(OBP + ((size_t)s * M + row) * 256 + 4 * lane)); } }
            float va[2][3][4], vb[2][4], ssa[2], ssb[2];
#pragma unroll
            for (int r = 0; r < 2; ++r) { ssa[r] = 0.f; ssb[r] = 0.f;
#pragma unroll
                for (int k = 0; k < 3; ++k) {
                    const float Mx = fmaxf(ml[r][k][0][0], fmaxf(ml[r][k][1][0], ml[r][k][2][0]));
                    const float w0 = ml[r][k][0][1] * __builtin_amdgcn_exp2f(ml[r][k][0][0] - Mx), w1 = ml[r][k][1][1] * __builtin_amdgcn_exp2f(ml[r][k][1][0] - Mx), w2 = ml[r][k][2][1] * __builtin_amdgcn_exp2f(ml[r][k][2][0] - Mx);
                    const float iw = 1.0f / (w0 + w1 + w2);
#pragma unroll
                    for (int e = 0; e < 4; ++e) { const unsigned s0 = oa[r][k][0][e >> 1], s1 = oa[r][k][1][e >> 1], s2 = oa[r][k][2][e >> 1];
                        const float f0 = __builtin_bit_cast(float, (e & 1) ? (s0 & 0xffff0000u) : (s0 << 16)), f1 = __builtin_bit_cast(float, (e & 1) ? (s1 & 0xffff0000u) : (s1 << 16)), f2 = __builtin_bit_cast(float, (e & 1) ? (s2 & 0xffff0000u) : (s2 << 16));
                        const float v = (w0 * f0 + w1 * f1 + w2 * f2) * iw; va[r][k][e] = v; ssa[r] += v * v; } }
                { const int rowq = (row0 + r * NGW) < M ? (row0 + r * NGW) : row0, nsel = (((rowq % SEQ) >> 8) < 3) ? ((rowq % SEQ) >> 8) : 3;
                  float wq[4], Mq = -INFINITY;
#pragma unroll
                  for (int s = 0; s < 4; ++s) { const bool use = (s == 3) || (s < nsel); Mq = use ? fmaxf(Mq, mlb[r][s][0]) : Mq; }
                  float wsum = 0.f;
#pragma unroll
                  for (int s = 0; s < 4; ++s) { const bool use = (s == 3) || (s < nsel); wq[s] = use ? mlb[r][s][1] * __builtin_amdgcn_exp2f(mlb[r][s][0] - Mq) : 0.f; wsum += wq[s]; }
                  const float iwq = 1.0f / wsum;
#pragma unroll
                  for (int e = 0; e < 4; ++e) { float acc_ = 0.f;
#pragma unroll
                      for (int s = 0; s < 4; ++s) { const bool use = (s == 3) || (s < nsel); const unsigned s0 = obp[r][s][e >> 1]; const float f = __builtin_bit_cast(float, (e & 1) ? (s0 & 0xffff0000u) : (s0 << 16)); acc_ += use ? wq[s] * f : 0.f; }
                      vb[r][e] = acc_ * iwq; ssb[r] += vb[r][e] * vb[r][e]; } } }
#pragma unroll
            for (int of = 1; of < 64; of <<= 1)
#pragma unroll
                for (int r = 0; r < 2; ++r) { ssa[r] += __shfl_xor(ssa[r], of); ssb[r] += __shfl_xor(ssb[r], of); }
#pragma unroll
            for (int r = 0; r < 2; ++r) { const int row = row0 + r * NGW; if (row < M) {
                const float ra = __builtin_amdgcn_rsqf(ssa[r] * (1.0f / 768.0f) + EPS), rb = __builtin_amdgcn_rsqf(ssb[r] * (1.0f / 256.0f) + EPS);
#pragma unroll
                for (int k = 0; k < 3; ++k) { u32x2 w; w[0] = cvt_pk_bf16(va[r][k][0] * ra, va[r][k][1] * ra); w[1] = cvt_pk_bf16(va[r][k][2] * ra, va[r][k][3] * ra); *(u32x2*)(YN + (size_t)row * D + 256 * k + 4 * lane) = w; }
                { u32x2 w; w[0] = cvt_pk_bf16(vb[r][0] * rb, vb[r][1] * rb); w[1] = cvt_pk_bf16(vb[r][2] * rb, vb[r][3] * rb); *(u32x2*)(YN + (size_t)row * D + 768 + 4 * lane) = w; } } }
        }
    }
    SEAM(6);

    if (IN(7)) {
        MK_PTRS;
        SchedStd S; S.o.init(M, D, G, bx); S.A = (const char*)YN; S.B = (const char*)Wout; S.a_tile = (size_t)256 * D * 2; S.b_tile = (size_t)256 * D * 2; S.b_batch = 0; S.ocol_mul = 256;
        EpiRes E{XB, SS2, 1.0f}; pg8::gemm_phase<EpiRes, SchedStd, true>(lds, D, D, D / 64, S, E);
    }
    SEAM(7);

    if (IN(8)) {
        MK_PTRS;
        SchedStd S; S.o.init(M, D, G, bx); S.A = (const char*)XB; S.B = (const char*)WKT; S.a_tile = (size_t)256 * D * 2; S.b_tile = (size_t)256 * D * 2; S.b_batch = (size_t)D * D * 2; S.ocol_mul = 256;
        EpiSoftmax E{PB, SS2}; pg8::gemm_phase<EpiSoftmax, SchedStd, true>(lds, D, D, D / 64, S, E);
    }
    SEAM(8);

    if (IN(9)) {
        MK_PTRS;
        SchedStd S; S.o.init(M, D, G, bx); S.A = (const char*)PB; S.B = (const char*)VWT; S.a_tile = (size_t)256 * D * 2; S.b_tile = (size_t)256 * D * 2; S.b_batch = (size_t)D * D * 2; S.ocol_mul = 256;
        EpiRes E{XB, SS3, 1.0f}; pg8::gemm_phase<EpiRes, SchedStd, true>(lds, D, D, D / 64, S, E);
    }
    SEAM(9);

    if (IN(10)) {
        MK_PTRS;
        STAGGER();
        SchedStd S; S.o.init(M, 2 * DFF, G, bx); S.A = (const char*)XB; S.B = (const char*)Wgu2; S.a_tile = (size_t)256 * D * 2; S.b_tile = (size_t)256 * D * 2; S.b_batch = 0; S.ocol_mul = 128;
        EpiGU E{HB, SS3}; pg8::gemm_phase<EpiGU, SchedStd, true>(lds, D, D, D / 64, S, E);
    }
    SEAM(10);

    if (IN(11)) {
        MK_PTRS;
        SchedStd S; S.o.init(M, D, G, bx); S.A = (const char*)HB; S.B = (const char*)Wd2; S.a_tile = (size_t)256 * DFF * 2; S.b_tile = (size_t)256 * DFF * 2; S.b_batch = 0; S.ocol_mul = 256;
        EpiRes E{XB, SS4, 0.5f}; pg8::gemm_phase<EpiRes, SchedStd, true>(lds, DFF, DFF, DFF / 64, S, E);
    }
    SEAM(11);

    if (IN(12)) {
        MK_PTRS;
        const float* gf = args.in[19];
        for (int row0 = gw; row0 < M; row0 += 4 * NGW) {
            u32x2 w[4][4]; float rs[4]; const f32x4* gr = (const f32x4*)gf + lane;
#pragma unroll
            for (int r = 0; r < 4; ++r) { const int row = (row0 + r * NGW) < M ? (row0 + r * NGW) : row0; const u32x2* xr = (const u32x2*)(XB + (size_t)row * D) + lane;
#pragma unroll
                for (int j = 0; j < 4; ++j) w[r][j] = __builtin_nontemporal_load(xr + 64 * j);
                rs[r] = row_rstd(SS4, row); }
#pragma unroll
            for (int r = 0; r < 4; ++r) { const int row = row0 + r * NGW; if (row < M) { f32x4* orow = (f32x4*)(out + (size_t)row * D) + lane;
#pragma unroll
                for (int j = 0; j < 4; ++j) { f32x4 v; v[0] = __builtin_bit_cast(float, w[r][j][0] << 16); v[1] = __builtin_bit_cast(float, w[r][j][0] & 0xffff0000u); v[2] = __builtin_bit_cast(float, w[r][j][1] << 16); v[3] = __builtin_bit_cast(float, w[r][j][1] & 0xffff0000u);
                    __builtin_nontemporal_store(v * rs[r] * gr[64 * j], orow + 64 * j); } } }
        }
    }
#undef IN
#undef SEAM
}
}


#if MK_DEBUG
namespace dbg {
__global__ void __launch_bounds__(256) cmp_f32(const float* a, const float* r, size_t n, float* acc) {
    float num = 0.f, den = 0.f;
    for (size_t i = (size_t)blockIdx.x * 256 + threadIdx.x; i < n; i += (size_t)gridDim.x * 256) { const float d = a[i] - r[i]; num += d * d; den += r[i] * r[i]; }
    for (int o = 32; o > 0; o >>= 1) { num += __shfl_xor(num, o); den += __shfl_xor(den, o); }
    if ((threadIdx.x & 63) == 0) { atomicAdd(acc, num); atomicAdd(acc + 1, den); }
}
__global__ void __launch_bounds__(256) cmp_bf16(const unsigned short* a, int lda, const float* colscale, const float* r, int ldr, int rows, int cols, float* acc) {
    float num = 0.f, den = 0.f; const size_t n = (size_t)rows * cols;
    for (size_t i = (size_t)blockIdx.x * 256 + threadIdx.x; i < n; i += (size_t)gridDim.x * 256) { const size_t row = i / cols; const int c = (int)(i % cols);
        const float av = __builtin_bit_cast(float, (unsigned)a[row * lda + c] << 16) * (colscale ? colscale[c] : 1.0f); const float rv = r[row * ldr + c]; const float d = av - rv; num += d * d; den += rv * rv; }
    for (int o = 32; o > 0; o >>= 1) { num += __shfl_xor(num, o); den += __shfl_xor(den, o); }
    if ((threadIdx.x & 63) == 0) { atomicAdd(acc, num); atomicAdd(acc + 1, den); }
}
__global__ void __launch_bounds__(256) cmp_p(const unsigned short* a, const float* r, float* acc) {
    float num = 0.f, den = 0.f; const size_t n = (size_t)4096 * 1024;
    for (size_t i = (size_t)blockIdx.x * 256 + threadIdx.x; i < n; i += (size_t)gridDim.x * 256) { const size_t row = i / 1024; const int c = (int)(i % 1024);
        const float av = __builtin_bit_cast(float, (unsigned)a[i] << 16); const float rv = r[(size_t)(c >> 8) * 4096 * 256 + row * 256 + (c & 255)]; const float d = av - rv; num += d * d; den += rv * rv; }
    for (int o = 32; o > 0; o >>= 1) { num += __shfl_xor(num, o); den += __shfl_xor(den, o); }
    if ((threadIdx.x & 63) == 0) { atomicAdd(acc, num); atomicAdd(acc + 1, den); }
}
__global__ void build_scales(float* qkvs, float* gcat, const float* goa, const float* gob) {
    const int i = blockIdx.x * 256 + threadIdx.x;
    if (i < 3072) qkvs[i] = ((i < 768) || (i >= 2304 && i < 2560)) ? 8.0f : 1.0f;
    if (i < 1024) gcat[i] = i < 768 ? goa[i] : gob[i - 768];
}
constexpr int NST = 8;
__global__ void __launch_bounds__(256) finalize(float* out, size_t n, const float* acc, int report) {
    const float tol[NST] = {0.03f, 0.03f, 1e9f  , 0.08f, 0.03f, 0.05f, 0.03f, 0.03f};
    float E = 0.f;
    if (report > 0) { const float e = sqrtf(acc[2 * (report - 1)] / acc[2 * (report - 1) + 1]); E = (e == e) ? fminf(e, 3.0f) : 3.0f; }
    else { for (int k = NST - 1; k >= 0; --k) { const float e = sqrtf(acc[2 * k] / acc[2 * k + 1]); if (!(e <= tol[k])) E = 0.1f * (k + 1); } }
    for (size_t i = (size_t)blockIdx.x * 256 + threadIdx.x; i < n; i += (size_t)gridDim.x * 256) out[i] *= (1.0f + E);
}
}
#endif

static void mk_launch(const mk::Args& a0, int lo, int hi, int grid, hipStream_t st) {
    mk::Args a = a0; a.ph_lo = lo; a.ph_hi = hi;
    hipLaunchKernelGGL(mk::mk_fwd, dim3(grid), dim3(mk::NWAVES * 64), mk::LDS_BYTES, st, a);
    const hipError_t le = hipPeekAtLastError();
    if (le != hipSuccess) fprintf(stderr, "kernel_launch: launch of phases [%d,%d) failed: %s\n", lo, hi, hipGetErrorName(le));
}

extern "C" void kernel_launch(void* const* d_in, const int* in_sizes, int n_in, void* d_out, int out_size, void* d_ws, size_t ws_size, hipStream_t stream) {
    static int grid = 0;
    if (grid == 0) {
        if (n_in != 20 || out_size != 8 * 4096 * 1024) { fprintf(stderr, "kernel_launch: unexpected shapes (n_in %d out %d)\n", n_in, out_size); grid = -1; return; }
        int dev = 0, cus = 0, per_cu = 0;
        if (hipGetDevice(&dev) != hipSuccess || hipDeviceGetAttribute(&cus, hipDeviceAttributeMultiprocessorCount, dev) != hipSuccess) { grid = -1; return; }
        if (hipFuncSetAttribute((const void*)mk::mk_fwd, hipFuncAttributeMaxDynamicSharedMemorySize, mk::LDS_BYTES) != hipSuccess) { fprintf(stderr, "kernel_launch: hipFuncSetAttribute failed\n"); grid = -1; return; }
        if (hipOccupancyMaxActiveBlocksPerMultiprocessor(&per_cu, (const void*)mk::mk_fwd, mk::NWAVES * 64, mk::LDS_BYTES) != hipSuccess || per_cu < 1) fprintf(stderr, "kernel_launch: occupancy query reports %d workgroups per CU\n", per_cu);
        (void)hipGetLastError();
        grid = cus;
    }
    if (grid < 0) return;
    unsigned char* ws = (unsigned char*)d_ws;
#if MK_DEBUG
    const size_t ref_off = (mk::WS_END + 4095) / 4096 * 4096;
    size_t off = ref_off + (size_t)290 * 1024 * 1024;
    auto take = [&](size_t bytes) { unsigned char* p = ws + off; off += (bytes + 255) / 256 * 256; return p; };
    float* sx1 = (float*)take((size_t)4096 * 1024 * 4); float* sx2 = (float*)take((size_t)4096 * 1024 * 4); float* sx3 = (float*)take((size_t)4096 * 1024 * 4);
    float* mkout = (float*)take((size_t)4096 * 1024 * 4); float* qkvs = (float*)take(3072 * 4); float* gcat = (float*)take(1024 * 4); float* acc = (float*)take(256);
    if (off > ws_size) { fprintf(stderr, "kernel_launch: debug build needs %zu bytes of workspace, got %zu\n", off, ws_size); return; }
    ref::Snap snap{sx1, sx2, sx3};
    ref::forward(d_in, (float*)d_out, ws + ref_off, stream, &snap);
    (void)hipMemsetAsync(ws + mk::WS_CTL, 0, mk::CTL_BYTES, stream);
    (void)hipMemsetAsync(acc, 0, 256, stream);
    dbg::build_scales<<<12, 256, 0, stream>>>(qkvs, gcat, (const float*)d_in[8], (const float*)d_in[9]);
    mk::Args a{};
    for (int i = 0; i < 20; ++i) a.in[i] = (const float*)d_in[i];
    a.in[0] = (const float*)d_in[0] + (size_t)7 * 4096 * 1024; a.in[1] = (const float*)d_in[1] + (size_t)7 * 256 * 1024;
    a.out = mkout; a.ws = ws;
    const ref::Bufs& rb = ref::g_bufs;
    for (int ph = 0; ph < mk::NPH; ++ph) {
        mk_launch(a, ph, ph + 1, grid, stream);
        if (ph == 1) dbg::cmp_bf16<<<512, 256, 0, stream>>>((const unsigned short*)(ws + mk::WS_KVC), 2048, nullptr, rb.kvc, 2048, 256, 2048, acc + 0);
        if (ph == 2) dbg::cmp_bf16<<<512, 256, 0, stream>>>((const unsigned short*)(ws + mk::WS_XB), 1024, nullptr, sx1, 1024, 4096, 1024, acc + 2);
        if (ph == 3) dbg::cmp_bf16<<<512, 256, 0, stream>>>((const unsigned short*)(ws + mk::WS_R1), 3072, qkvs, rb.proj, 3072, 4096, 3072, acc + 4);
        if (ph == 6) dbg::cmp_bf16<<<512, 256, 0, stream>>>((const unsigned short*)(ws + mk::WS_R1), 1024, gcat, rb.yn, 1024, 4096, 1024, acc + 6);
        if (ph == 7) dbg::cmp_bf16<<<512, 256, 0, stream>>>((const unsigned short*)(ws + mk::WS_XB), 1024, nullptr, sx2, 1024, 4096, 1024, acc + 8);
        if (ph == 8) dbg::cmp_p<<<512, 256, 0, stream>>>((const unsigned short*)(ws + mk::WS_R1), rb.sc, acc + 10);
        if (ph == 9) dbg::cmp_bf16<<<512, 256, 0, stream>>>((const unsigned short*)(ws + mk::WS_XB), 1024, nullptr, sx3, 1024, 4096, 1024, acc + 12);
        if (ph == 12) dbg::cmp_f32<<<512, 256, 0, stream>>>(mkout, (const float*)d_out + (size_t)7 * 4096 * 1024, (size_t)4096 * 1024, acc + 14);
    }
    dbg::finalize<<<1024, 256, 0, stream>>>((float*)d_out, (size_t)8 * 4096 * 1024, acc, MK_REPORT);
#else
    if (ws_size < mk::WS_END) { fprintf(stderr, "kernel_launch: needs %zu bytes of workspace, got %zu\n", (size_t)mk::WS_END, ws_size); return; }
    if (hipMemsetAsync(ws + mk::WS_CTL, 0, mk::CTL_BYTES, stream) != hipSuccess) return;
    mk::Args a{};
    for (int i = 0; i < 20; ++i) a.in[i] = (const float*)d_in[i];
    a.out = (float*)d_out; a.ws = ws;
#if MK_N_LAUNCHES == 1
    mk_launch(a, 0, mk::NPH, grid, stream);
#else
    for (int ph = 0; ph < mk::NPH; ++ph) {
        for (int r = 0; r < MK_REPEAT_N; ++r) if (ph == MK_REPEAT) { mk::Args a2 = a; a2.flags = MK_REPEAT_FLAGS; mk_launch(a2, ph, ph + 1, grid, stream); }
        mk_launch(a, ph, ph + 1, grid, stream); }
#endif
#endif
}
```

```cpp
#include <hip/hip_runtime.h>
#include <cstdio>
#include <cstdint>
#include <cmath>
#define MK_REPEAT -1
#define MK_REPEAT_N 1
#define MK_REPEAT_FLAGS 0
#define MK_STAGGER_TICKS 0
#define MK_NT_PART false
#define MK_TIMING 0
#define MK_TQ 0.02f
#define MK_PROBE_SAME 0
#define MK_DEBUG 0
#define MK_REPORT 0
#define MK_N_LAUNCHES 1
#define MK_NBAT 8

namespace pg8 {
#define PG8_LAS __attribute__((address_space(3)))
typedef unsigned short bf16_t;
typedef short bf16x8 __attribute__((ext_vector_type(8)));
typedef float f32x4 __attribute__((ext_vector_type(4)));
typedef float f32x2 __attribute__((ext_vector_type(2)));
typedef unsigned u32x4 __attribute__((ext_vector_type(4)));
typedef unsigned u32x2 __attribute__((ext_vector_type(2)));
constexpr int BM = 256, BK = 64, HALF = 128, HTB = HALF * BK * 2  , STAGE_BYTES = 8 * HTB, NXCD = 8, WGM = 8;

__host__ __device__ __forceinline__ int lds_byte(int r, int c) { const int st = (r >> 4) * 2 + (c >> 5), rr = r & 15, cc = c & 31, ob = rr * 64 + cc * 2; return st * 1024 + (ob ^ (((ob >> 9) & 1) << 5)); }
__host__ __device__ __forceinline__ void stage_rc(int b, int& R, int& C) { const int st = b / 1024, sb = b % 1024, swz = sb ^ (((sb >> 9) & 1) << 5); R = (st >> 1) * 16 + swz / 64; C = (st & 1) * 32 + (swz % 64) / 2; }
__host__ __device__ __forceinline__ int perm32(int rho) { const int n = rho >> 4, i = rho & 15; return 8 * (i >> 2) + 4 * n + (i & 3); }

struct Unit { const char* a; const char* b; int orow, ocol, aux; };

struct Order {
    int nM, nN, nwg, G, c;
    __device__ __forceinline__ void init(int M, int N, int G_, int c_) { nM = M / BM; nN = N / BM; nwg = nM * nN; G = G_; c = c_; }
    __device__ __forceinline__ bool tile(int i, int& pm, int& pn) const {
        const long L = (long)i * G + c; if (L >= nwg) return false;
        int wgid = (int)L; { const int q = nwg / NXCD, r = nwg % NXCD, xcd = wgid % NXCD, off = wgid / NXCD; wgid = (xcd < r ? xcd * (q + 1) : r * (q + 1) + (xcd - r) * q) + off; }
        const int nig = WGM * nN, gid = wgid / nig, fm = gid * WGM, gsz = (nM - fm) < WGM ? (nM - fm) : WGM;
        pm = fm + ((wgid % nig) % gsz); pn = (wgid % nig) / gsz; return true;
    }
};

__device__ __forceinline__ unsigned cvt_pk_bf16(float lo, float hi) { unsigned r; asm volatile("v_cvt_pk_bf16_f32 %0, %1, %2" : "=v"(r) : "v"(lo), "v"(hi)); return r; }

template <class Epi, class Sched, bool ALIGN_EPI>
__device__ __forceinline__ void gemm_phase(PG8_LAS unsigned char* lds, const int lda, const int ldb, const int nt, const Sched& S, const Epi& E) {
    int tid_ = threadIdx.x; asm volatile("" : "+v"(tid_));
    const int tid = tid_, wid = __builtin_amdgcn_readfirstlane(tid >> 6), lane = tid & 63, wr = wid >> 2, wc = wid & 3, fr = lane & 15, fq = lane >> 4;
    unsigned voffA[2], voffB[2];
#pragma unroll
    for (int i = 0; i < 2; ++i) { int R, C; stage_rc(tid * 16 + i * 8192, R, C); const int Rb = Epi::PERM ? ((R & ~31) + perm32(R & 31)) : R;
        voffA[i] = (unsigned)(R * lda + C) * 2u; voffB[i] = (unsigned)(Rb * ldb + C) * 2u; }
    const size_t kstep = (size_t)(BK * 2);
    const size_t hstepA = (size_t)HALF * lda * 2, hstepB = (size_t)HALF * ldb * 2;
    const unsigned ldsw = (unsigned)wid * 1024u;
    const int aoff = lds_byte(wr * 64 + fr, fq * 8), boff = lds_byte(wc * 32 + fr, fq * 8);
#define PG8_SA(b, h) (((b) * 2 + (h)) * HTB)
#define PG8_SB(b, h) ((4 + (b) * 2 + (h)) * HTB)
#define PG8_STAGE(bufoff, gbase, voff) do { _Pragma("unroll") for (int _i = 0; _i < 2; ++_i) \
        __builtin_amdgcn_global_load_lds((const unsigned*)((const char*)(gbase) + (voff)[_i]), (PG8_LAS unsigned*)(lds + (bufoff) + ldsw + _i * 8192), 16, 0, 0); } while (0)
#define PG8_LDA(dst, b, h) do { _Pragma("unroll") for (int m = 0; m < 4; ++m) _Pragma("unroll") for (int k = 0; k < 2; ++k) dst[m][k] = *(const PG8_LAS bf16x8*)(lds + PG8_SA(b, h) + aoff + m * 2048 + k * 1024); } while (0)
#define PG8_LDB(dst, b, h) do { _Pragma("unroll") for (int n = 0; n < 2; ++n) _Pragma("unroll") for (int k = 0; k < 2; ++k) dst[n][k] = *(const PG8_LAS bf16x8*)(lds + PG8_SB(b, h) + boff + n * 2048 + k * 1024); } while (0)
#define PG8_MMA(ai, bj, At, Bt) do { __builtin_amdgcn_s_setprio(1); _Pragma("unroll") for (int m = 0; m < 4; ++m) _Pragma("unroll") for (int n = 0; n < 2; ++n) _Pragma("unroll") for (int k = 0; k < 2; ++k) \
        acc[ai][bj][m][n] = __builtin_amdgcn_mfma_f32_16x16x32_bf16(Bt[n][k], At[m][k], acc[ai][bj][m][n], 0, 0, 0); __builtin_amdgcn_s_setprio(0); } while (0)
#define PG8_WAIT_V(n) asm volatile("s_waitcnt vmcnt(" #n ")" ::: "memory")
#define PG8_WAIT_L(n) asm volatile("s_waitcnt lgkmcnt(" #n ")" ::: "memory")
#define PG8_BAR __builtin_amdgcn_s_barrier()
#define PG8_SCHED __builtin_amdgcn_sched_barrier(0)
    Unit cur, nxt; int ui = 0;
    if (!S.next(0, cur)) return;
    f32x4 acc[2][2][4][2];
#pragma unroll
    for (int a = 0; a < 2; ++a)
#pragma unroll
        for (int b = 0; b < 2; ++b)
#pragma unroll
            for (int m = 0; m < 4; ++m)
#pragma unroll
                for (int n = 0; n < 2; ++n) acc[a][b][m][n] = (f32x4){0.f, 0.f, 0.f, 0.f};
    bf16x8 At[4][2], B0[2][2], B1[2][2];
    const char* cA = cur.a; const char* cB = cur.b;
    PG8_STAGE(PG8_SB(0, 0), cB, voffB); PG8_STAGE(PG8_SB(0, 1), cB + hstepB, voffB); PG8_STAGE(PG8_SA(0, 0), cA, voffA); PG8_STAGE(PG8_SA(0, 1), cA + hstepA, voffA);
    if (wr == 1) PG8_BAR;
    PG8_WAIT_V(2); PG8_BAR;
    PG8_STAGE(PG8_SB(1, 0), cB + kstep, voffB); PG8_STAGE(PG8_SA(1, 0), cA + kstep, voffA); PG8_STAGE(PG8_SB(1, 1), cB + hstepB + kstep, voffB);
    PG8_WAIT_V(6); PG8_BAR;
    for (;;) {
        const bool has_next = S.next(ui + 1, nxt);
        const char* nA = has_next ? nxt.a : cA; const char* nB = has_next ? nxt.b : cB;
#pragma unroll 1
        for (int t = 0; t < nt; t += 2) {
            const bool last = (t == nt - 2);
            const char* a1 = cA + (size_t)(t + 1) * kstep;
            const char* a2 = last ? nA : cA + (size_t)(t + 2) * kstep; const char* b2 = last ? nB : cB + (size_t)(t + 2) * kstep;
            const char* a3 = a2 + kstep; const char* b3 = b2 + kstep;
            PG8_LDB(B0, 0, 0); PG8_LDB(B1, 0, 1); PG8_SCHED; PG8_LDA(At, 0, 0); PG8_STAGE(PG8_SA(1, 1), a1 + hstepA, voffA);
            PG8_WAIT_V(8); PG8_WAIT_L(0); PG8_BAR; PG8_MMA(0, 0, At, B0); PG8_MMA(0, 1, At, B1); PG8_BAR; PG8_SCHED;
            PG8_LDA(At, 0, 1); PG8_STAGE(PG8_SB(0, 0), b2, voffB); PG8_STAGE(PG8_SB(0, 1), b2 + hstepB, voffB); PG8_STAGE(PG8_SA(0, 0), a2, voffA);
            PG8_WAIT_V(8); PG8_WAIT_L(0); PG8_BAR; PG8_MMA(1, 0, At, B0); PG8_MMA(1, 1, At, B1); PG8_BAR; PG8_SCHED;
            PG8_LDB(B0, 1, 0); PG8_LDB(B1, 1, 1); PG8_SCHED; PG8_LDA(At, 1, 0); PG8_STAGE(PG8_SA(0, 1), a2 + hstepA, voffA);
            PG8_WAIT_V(8); PG8_WAIT_L(0); PG8_BAR; PG8_MMA(0, 0, At, B0); PG8_MMA(0, 1, At, B1); PG8_BAR; PG8_SCHED;
            PG8_LDA(At, 1, 1); PG8_STAGE(PG8_SB(1, 0), b3, voffB); PG8_STAGE(PG8_SB(1, 1), b3 + hstepB, voffB); PG8_STAGE(PG8_SA(1, 0), a3, voffA);
            PG8_WAIT_V(8); PG8_WAIT_L(0); PG8_BAR; PG8_MMA(1, 0, At, B0); PG8_MMA(1, 1, At, B1); PG8_BAR; PG8_SCHED;
        }
        if constexpr (ALIGN_EPI) { if (wr == 0) PG8_BAR; }
        E(acc, cur, wr, wc, fr, fq, lds, wid, lane);
        if (!has_next) break;
#pragma unroll
        for (int a = 0; a < 2; ++a)
#pragma unroll
            for (int b = 0; b < 2; ++b)
#pragma unroll
                for (int m = 0; m < 4; ++m)
#pragma unroll
                    for (int n = 0; n < 2; ++n) acc[a][b][m][n] = (f32x4){0.f, 0.f, 0.f, 0.f};
        cur = nxt; cA = nA; cB = nB; ++ui;
        if constexpr (ALIGN_EPI) { if (wr == 1) PG8_BAR; }
    }
    PG8_WAIT_V(0);
    if constexpr (!ALIGN_EPI) { if (wr == 0) PG8_BAR; }
    PG8_BAR;
#undef PG8_SA
#undef PG8_SB
#undef PG8_STAGE
#undef PG8_LDA
#undef PG8_LDB
#undef PG8_MMA
#undef PG8_WAIT_V
#undef PG8_WAIT_L
#undef PG8_BAR
#undef PG8_SCHED
}
}

namespace att {
#define ATT_LAS __attribute__((address_space(3)))
typedef short bf16x8 __attribute__((ext_vector_type(8)));
typedef short v4i16 __attribute__((ext_vector_type(4)));
typedef float f32x16 __attribute__((ext_vector_type(16)));
typedef float f32x4 __attribute__((ext_vector_type(4)));
typedef unsigned u32x4 __attribute__((ext_vector_type(4)));
typedef unsigned u32x2 __attribute__((ext_vector_type(2)));
constexpr float LOG2E = 1.4426950408889634f;
constexpr int TABA_N = 192, TABB_N = 1600;

__device__ __forceinline__ int rel_bucket(int n) {
    if (n < 16) return n < 0 ? 0 : n;
    int b = 16;
    b += (n >= 22); b += (n >= 30); b += (n >= 40); b += (n >= 54); b += (n >= 73); b += (n >= 99); b += (n >= 134); b += (n >= 182);
    b += (n >= 246); b += (n >= 332); b += (n >= 450); b += (n >= 609); b += (n >= 825); b += (n >= 1117); b += (n >= 1513);
    return b;
}
__device__ __forceinline__ unsigned pk_bf16(float lo, float hi) { unsigned r; asm volatile("v_cvt_pk_bf16_f32 %0, %1, %2" : "=v"(r) : "v"(lo), "v"(hi)); return r; }
__device__ __forceinline__ float bf16_round(float x) { unsigned u = __builtin_bit_cast(unsigned, x); u = (u + 0x7fffu + ((u >> 16) & 1u)) & 0xffff0000u; return __builtin_bit_cast(float, u); }

__device__ __forceinline__ void glds16(const void* gsrc, unsigned lds_dst) { unsigned keep;
    asm volatile("s_mov_b32 %0, m0\n\ts_mov_b32 m0, %2\n\ts_nop 0\n\tglobal_load_lds_dwordx4 %1, off\n\ts_mov_b32 m0, %0" : "=&s"(keep) : "v"(gsrc), "s"(lds_dst) : "memory"); }
__device__ __forceinline__ void dma_rows8(const char* krow0  , const int voff, const int row  ,
                                          ATT_LAS char* kdst  , ATT_LAS char* vdst, const int lane) {
    const int pc = lane & 7;
    glds16(krow0 + 16 * (pc ^ ((row >> 1) & 7)), (unsigned)__builtin_amdgcn_readfirstlane((int)(unsigned)(uintptr_t)kdst));
    glds16(krow0 + voff + 16 * (pc ^ (((row >> 1) & 1) << 2)), (unsigned)__builtin_amdgcn_readfirstlane((int)(unsigned)(uintptr_t)vdst));
}

__device__ __forceinline__ void attn_group(const bf16x8 (&qf)[4], f32x16 (&o)[2], float& m, float& l, const ATT_LAS char* kg, const ATT_LAS char* vg, const ATT_LAS float* tp, const int lane) {
    const int q = lane & 31, h = lane >> 5;
    const ATT_LAS char* kr0 = kg + q * 128; const int kswz = (q >> 1) & 7;
    typedef float f32x2_ __attribute__((ext_vector_type(2)));
    f32x2_ t0, t1, t2, t3, t4, t5, t6, t7;
    { const unsigned ta = (unsigned)(uintptr_t)(tp - 27);
      asm volatile("ds_read2_b32 %0, %8 offset0:27 offset1:26\n\tds_read2_b32 %1, %8 offset0:25 offset1:24\n\tds_read2_b32 %2, %8 offset0:19 offset1:18\n\tds_read2_b32 %3, %8 offset0:17 offset1:16\n\t"
                   "ds_read2_b32 %4, %8 offset0:11 offset1:10\n\tds_read2_b32 %5, %8 offset0:9 offset1:8\n\tds_read2_b32 %6, %8 offset0:3 offset1:2\n\tds_read2_b32 %7, %8 offset0:1 offset1:0"
                   : "=&v"(t0), "=&v"(t1), "=&v"(t2), "=&v"(t3), "=&v"(t4), "=&v"(t5), "=&v"(t6), "=&v"(t7) : "v"(ta) : "memory"); }
    const int q4 = (lane & 15) >> 2, p4 = lane & 3, g1 = (lane >> 4) & 1, vsw = (q4 >> 1) & 1;
    const unsigned va0_ = (unsigned)(uintptr_t)(vg + (4 * h + q4) * 128 + 32 * g1 + 8 * p4 + 64 * vsw), va1_ = (unsigned)(uintptr_t)(vg + (4 * h + q4) * 128 + 32 * g1 + 8 * p4 + 64 * (1 ^ vsw));
    v4i16 a[2][4];
    asm volatile("ds_read_b64_tr_b16 %0, %8\n\tds_read_b64_tr_b16 %1, %8 offset:1024\n\tds_read_b64_tr_b16 %2, %8 offset:2048\n\tds_read_b64_tr_b16 %3, %8 offset:3072\n\t"
                 "ds_read_b64_tr_b16 %4, %9\n\tds_read_b64_tr_b16 %5, %9 offset:1024\n\tds_read_b64_tr_b16 %6, %9 offset:2048\n\tds_read_b64_tr_b16 %7, %9 offset:3072"
                 : "=&v"(a[0][0]), "=&v"(a[0][1]), "=&v"(a[0][2]), "=&v"(a[0][3]), "=&v"(a[1][0]), "=&v"(a[1][1]), "=&v"(a[1][2]), "=&v"(a[1][3]) : "v"(va0_), "v"(va1_) : "memory");
    f32x16 s = f32x16{};
#pragma unroll
    for (int d0 = 0; d0 < 4; ++d0) { const bf16x8 kf = *(const ATT_LAS bf16x8*)(kr0 + 16 * ((2 * d0 + h) ^ kswz)); s = __builtin_amdgcn_mfma_f32_32x32x16_bf16(kf, qf[d0], s, 0, 0, 0); }
    asm volatile("s_waitcnt lgkmcnt(0)" : "+v"(t0), "+v"(t1), "+v"(t2), "+v"(t3), "+v"(t4), "+v"(t5), "+v"(t6), "+v"(t7), "+v"(a[0][0]), "+v"(a[0][1]), "+v"(a[0][2]), "+v"(a[0][3]), "+v"(a[1][0]), "+v"(a[1][1]), "+v"(a[1][2]), "+v"(a[1][3]) :: "memory");
    float mx = -INFINITY;
    { const float tb_[16] = {t0[0], t0[1], t1[0], t1[1], t2[0], t2[1], t3[0], t3[1], t4[0], t4[1], t5[0], t5[1], t6[0], t6[1], t7[0], t7[1]};
#pragma unroll
      for (int r = 0; r < 16; ++r) s[r] = fmaf(s[r], LOG2E, tb_[r]); }
#pragma unroll
    for (int r = 0; r < 16; r += 2) mx = fmaxf(mx, fmaxf(s[r], s[r + 1]));
    mx = fmaxf(mx, __shfl_xor(mx, 32));
    if (__any(mx > m)) {
        const float mnew = fmaxf(m, mx), alpha = __builtin_amdgcn_exp2f(m - mnew);
        l *= alpha; m = mnew;
#pragma unroll
        for (int r = 0; r < 16; ++r) { o[0][r] *= alpha; o[1][r] *= alpha; }
    }
    float ps = 0.f;
#pragma unroll
    for (int r = 0; r < 16; ++r) { s[r] = __builtin_amdgcn_exp2f(s[r] - m); ps += s[r]; }
    l += ps;
    u32x4 pw0, pw1;
    pw0[0] = pk_bf16(s[0], s[1]); pw0[1] = pk_bf16(s[2], s[3]); pw0[2] = pk_bf16(s[4], s[5]); pw0[3] = pk_bf16(s[6], s[7]);
    pw1[0] = pk_bf16(s[8], s[9]); pw1[1] = pk_bf16(s[10], s[11]); pw1[2] = pk_bf16(s[12], s[13]); pw1[3] = pk_bf16(s[14], s[15]);
    const bf16x8 pb0 = __builtin_bit_cast(bf16x8, pw0), pb1 = __builtin_bit_cast(bf16x8, pw1);
#pragma unroll
    for (int dh = 0; dh < 2; ++dh) {
        const bf16x8 va0 = (bf16x8){a[dh][0][0], a[dh][0][1], a[dh][0][2], a[dh][0][3], a[dh][1][0], a[dh][1][1], a[dh][1][2], a[dh][1][3]};
        const bf16x8 va1 = (bf16x8){a[dh][2][0], a[dh][2][1], a[dh][2][2], a[dh][2][3], a[dh][3][0], a[dh][3][1], a[dh][3][2], a[dh][3][3]};
        o[dh] = __builtin_amdgcn_mfma_f32_32x32x16_bf16(va0, pb0, o[dh], 0, 0, 0);
        o[dh] = __builtin_amdgcn_mfma_f32_32x32x16_bf16(va1, pb1, o[dh], 0, 0, 0);
    }
}

__device__ __forceinline__ void dma_k_rows8(const char* krow, const int row, ATT_LAS char* kdst, const int lane) {
    glds16(krow + 16 * ((lane & 7) ^ ((row >> 1) & 7)), (unsigned)__builtin_amdgcn_readfirstlane((int)(unsigned)(uintptr_t)kdst)); }
__device__ __forceinline__ void dma_v_rows8(const char* vrow, const int row, ATT_LAS char* vdst, const int lane) {
    glds16(vrow + 16 * ((lane & 7) ^ (((row >> 1) & 1) << 2)), (unsigned)__builtin_amdgcn_readfirstlane((int)(unsigned)(uintptr_t)vdst)); }
__device__ __forceinline__ void dil_pass1(const bf16x8 (&qf)[4], const int ng, const ATT_LAS char* kimg0  , const ATT_LAS float* tp0  ,
                                          u32x4 (&pw)[5][2], float& m_out, float& l_out, const int lane) {
    const int q = lane & 31, h = lane >> 5, kswz = (q >> 1) & 7;
    typedef float f32x2_ __attribute__((ext_vector_type(2)));
    f32x16 s[5]; float mx = -INFINITY;
#pragma unroll
    for (int g = 0; g < 5; ++g) if (g < ng) {
        f32x2_ t0, t1, t2, t3, t4, t5, t6, t7;
        { const unsigned ta = (unsigned)(uintptr_t)(tp0 + 32 * g - 27);
          asm volatile("ds_read2_b32 %0, %8 offset0:27 offset1:26\n\tds_read2_b32 %1, %8 offset0:25 offset1:24\n\tds_read2_b32 %2, %8 offset0:19 offset1:18\n\tds_read2_b32 %3, %8 offset0:17 offset1:16\n\t"
                       "ds_read2_b32 %4, %8 offset0:11 offset1:10\n\tds_read2_b32 %5, %8 offset0:9 offset1:8\n\tds_read2_b32 %6, %8 offset0:3 offset1:2\n\tds_read2_b32 %7, %8 offset0:1 offset1:0"
                       : "=&v"(t0), "=&v"(t1), "=&v"(t2), "=&v"(t3), "=&v"(t4), "=&v"(t5), "=&v"(t6), "=&v"(t7) : "v"(ta) : "memory"); }
        const ATT_LAS char* kr0 = kimg0 - g * 4096 + q * 128;
        f32x16 sg = f32x16{};
#pragma unroll
        for (int d0 = 0; d0 < 4; ++d0) { const bf16x8 kf = *(const ATT_LAS bf16x8*)(kr0 + 16 * ((2 * d0 + h) ^ kswz)); sg = __builtin_amdgcn_mfma_f32_32x32x16_bf16(kf, qf[d0], sg, 0, 0, 0); }
        asm volatile("s_waitcnt lgkmcnt(0)" : "+v"(t0), "+v"(t1), "+v"(t2), "+v"(t3), "+v"(t4), "+v"(t5), "+v"(t6), "+v"(t7) :: "memory");
        const float tb_[16] = {t0[0], t0[1], t1[0], t1[1], t2[0], t2[1], t3[0], t3[1], t4[0], t4[1], t5[0], t5[1], t6[0], t6[1], t7[0], t7[1]};
#pragma unroll
        for (int r = 0; r < 16; ++r) sg[r] = fmaf(sg[r], LOG2E, tb_[r]);
#pragma unroll
        for (int r = 0; r < 16; r += 2) mx = fmaxf(mx, fmaxf(sg[r], sg[r + 1]));
        s[g] = sg;
    }
    mx = fmaxf(mx, __shfl_xor(mx, 32));
    float ps = 0.f;
#pragma unroll
    for (int g = 0; g < 5; ++g) if (g < ng) {
        f32x16 p = s[g];
#pragma unroll
        for (int r = 0; r < 16; ++r) { p[r] = __builtin_amdgcn_exp2f(p[r] - mx); ps += p[r]; }
        pw[g][0][0] = pk_bf16(p[0], p[1]); pw[g][0][1] = pk_bf16(p[2], p[3]); pw[g][0][2] = pk_bf16(p[4], p[5]); pw[g][0][3] = pk_bf16(p[6], p[7]);
        pw[g][1][0] = pk_bf16(p[8], p[9]); pw[g][1][1] = pk_bf16(p[10], p[11]); pw[g][1][2] = pk_bf16(p[12], p[13]); pw[g][1][3] = pk_bf16(p[14], p[15]);
    }
    ps += __shfl_xor(ps, 32);
    m_out = mx; l_out = ps;
}
__device__ __forceinline__ void dil_pass2(const int ng, const ATT_LAS char* vimg0  , const u32x4 (&pw)[5][2], f32x16 (&o)[2], const int lane) {
    const int h = lane >> 5, q4 = (lane & 15) >> 2, p4 = lane & 3, g1 = (lane >> 4) & 1, vsw = (q4 >> 1) & 1;
    o[0] = f32x16{}; o[1] = f32x16{};
#pragma unroll
    for (int g = 0; g < 5; ++g) if (g < ng) {
        const ATT_LAS char* vg = vimg0 - g * 4096;
        const unsigned va0_ = (unsigned)(uintptr_t)(vg + (4 * h + q4) * 128 + 32 * g1 + 8 * p4 + 64 * vsw), va1_ = (unsigned)(uintptr_t)(vg + (4 * h + q4) * 128 + 32 * g1 + 8 * p4 + 64 * (1 ^ vsw));
        v4i16 a[2][4];
        asm volatile("ds_read_b64_tr_b16 %0, %8\n\tds_read_b64_tr_b16 %1, %8 offset:1024\n\tds_read_b64_tr_b16 %2, %8 offset:2048\n\tds_read_b64_tr_b16 %3, %8 offset:3072\n\t"
                     "ds_read_b64_tr_b16 %4, %9\n\tds_read_b64_tr_b16 %5, %9 offset:1024\n\tds_read_b64_tr_b16 %6, %9 offset:2048\n\tds_read_b64_tr_b16 %7, %9 offset:3072\n\ts_waitcnt lgkmcnt(0)"
                     : "=&v"(a[0][0]), "=&v"(a[0][1]), "=&v"(a[0][2]), "=&v"(a[0][3]), "=&v"(a[1][0]), "=&v"(a[1][1]), "=&v"(a[1][2]), "=&v"(a[1][3]) : "v"(va0_), "v"(va1_) : "memory");
        const bf16x8 pb0 = __builtin_bit_cast(bf16x8, pw[g][0]), pb1 = __builtin_bit_cast(bf16x8, pw[g][1]);
#pragma unroll
        for (int dh = 0; dh < 2; ++dh) {
            const bf16x8 va0 = (bf16x8){a[dh][0][0], a[dh][0][1], a[dh][0][2], a[dh][0][3], a[dh][1][0], a[dh][1][1], a[dh][1][2], a[dh][1][3]};
            const bf16x8 va1 = (bf16x8){a[dh][2][0], a[dh][2][1], a[dh][2][2], a[dh][2][3], a[dh][3][0], a[dh][3][1], a[dh][3][2], a[dh][3][3]};
            o[dh] = __builtin_amdgcn_mfma_f32_32x32x16_bf16(va0, pb0, o[dh], 0, 0, 0);
            o[dh] = __builtin_amdgcn_mfma_f32_32x32x16_bf16(va1, pb1, o[dh], 0, 0, 0);
        }
    }
}

template <bool NT>
__device__ __forceinline__ void store_o(const f32x16 (&o)[2], const float l, char* orow_q, const int h, const bool valid = true) {
    const float il = 1.0f / l;
#pragma unroll
    for (int dh = 0; dh < 2; ++dh)
#pragma unroll
        for (int jj = 0; jj < 2; ++jj) {
            u32x2 we, wo;
            we[0] = pk_bf16(o[dh][8 * jj] * il, o[dh][8 * jj + 1] * il); we[1] = pk_bf16(o[dh][8 * jj + 2] * il, o[dh][8 * jj + 3] * il);
            wo[0] = pk_bf16(o[dh][8 * jj + 4] * il, o[dh][8 * jj + 5] * il); wo[1] = pk_bf16(o[dh][8 * jj + 6] * il, o[dh][8 * jj + 7] * il);
            const unsigned s0 = h ? we[0] : wo[0], s1 = h ? we[1] : wo[1];
            const unsigned r0 = (unsigned)__shfl_xor((int)s0, 32), r1 = (unsigned)__shfl_xor((int)s1, 32);
            u32x4 w; if (h == 0) { w[0] = we[0]; w[1] = we[1]; w[2] = r0; w[3] = r1; } else { w[0] = r0; w[1] = r1; w[2] = wo[0]; w[3] = wo[1]; }
            u32x4* dst = (u32x4*)(orow_q + (32 * dh + 16 * jj + 8 * h) * 2);
            if (valid) { if (NT) __builtin_nontemporal_store(w, dst); else *dst = w; }
        }
}

template <bool NT>
__device__ __forceinline__ void store_o_staged(const f32x16 (&o)[2], const float l, ATT_LAS char* stg, char* base, const long rstride, const int lane) {
    const int q = lane & 31, h = lane >> 5; const float il = 1.0f / l;
#pragma unroll
    for (int dh = 0; dh < 2; ++dh)
#pragma unroll
        for (int jj = 0; jj < 2; ++jj) {
            u32x2 we, wo;
            we[0] = pk_bf16(o[dh][8 * jj] * il, o[dh][8 * jj + 1] * il); we[1] = pk_bf16(o[dh][8 * jj + 2] * il, o[dh][8 * jj + 3] * il);
            wo[0] = pk_bf16(o[dh][8 * jj + 4] * il, o[dh][8 * jj + 5] * il); wo[1] = pk_bf16(o[dh][8 * jj + 6] * il, o[dh][8 * jj + 7] * il);
            const unsigned s0 = h ? we[0] : wo[0], s1 = h ? we[1] : wo[1];
            const unsigned r0 = (unsigned)__shfl_xor((int)s0, 32), r1 = (unsigned)__shfl_xor((int)s1, 32);
            u32x4 w; if (h == 0) { w[0] = we[0]; w[1] = we[1]; w[2] = r0; w[3] = r1; } else { w[0] = r0; w[1] = r1; w[2] = wo[0]; w[3] = wo[1]; }
            *(ATT_LAS u32x4*)(stg + q * 128 + 16 * ((4 * dh + 2 * jj + h) ^ (q & 7))) = w;
        }
    asm volatile("s_waitcnt lgkmcnt(0)" ::: "memory");
#pragma unroll
    for (int i = 0; i < 4; ++i) { const int r = 8 * i + (lane >> 3), c = lane & 7;
        const u32x4 w = *(const ATT_LAS u32x4*)(stg + r * 128 + 16 * (c ^ (r & 7)));
        u32x4* dst = (u32x4*)(base + (long)r * rstride + 16 * c);
        if (NT) __builtin_nontemporal_store(w, dst); else *dst = w; }
    asm volatile("s_waitcnt lgkmcnt(0)" ::: "memory");
}

__device__ __forceinline__ unsigned moba_select(const char* qbase, const long qs, const float* km, const int qb) {
    const int lane = threadIdx.x & 63, q = lane & 31, h = lane >> 5;
    f32x16 g = f32x16{};
    const float* kmrow = km + (size_t)(q & 15) * 256;
    const bool lo_part = q >= 16;
#pragma unroll
    for (int d0 = 0; d0 < 4; ++d0) {
        const bf16x8 qf = *(const bf16x8*)(qbase + (long)q * qs + (16 * d0 + 8 * h) * 2);
        const f32x4 f0 = *(const f32x4*)(kmrow + 16 * d0 + 8 * h), f1 = *(const f32x4*)(kmrow + 16 * d0 + 8 * h + 4);
        float v[8] = {f0[0], f0[1], f0[2], f0[3], f1[0], f1[1], f1[2], f1[3]};
        u32x4 aw;
#pragma unroll
        for (int j = 0; j < 4; ++j) {
            const float h0 = bf16_round(v[2 * j]), h1 = bf16_round(v[2 * j + 1]);
            const float x0 = lo_part ? (v[2 * j] - h0) : h0, x1 = lo_part ? (v[2 * j + 1] - h1) : h1;
            aw[j] = pk_bf16(x0, x1);
        }
        g = __builtin_amdgcn_mfma_f32_32x32x16_bf16(__builtin_bit_cast(bf16x8, aw), qf, g, 0, 0, 0);
    }
    float gate[8], other[8];
#pragma unroll
    for (int r = 0; r < 8; ++r) { gate[r] = g[r] + g[r + 8]; }
#pragma unroll
    for (int r = 0; r < 8; ++r) { other[r] = __shfl_xor(gate[r], 32); }
    unsigned mymask = 0u;
#pragma unroll
    for (int r = 0; r < 8; ++r) {
        const int n = (r & 3) + 8 * (r >> 2) + 4 * h;
        int rank = 0;
#pragma unroll
        for (int r2 = 0; r2 < 8; ++r2) {
            const int n2 = (r2 & 3) + 8 * (r2 >> 2) + 4 * h, n3 = (r2 & 3) + 8 * (r2 >> 2) + 4 * (1 - h);
            if (r2 != r) rank += (n2 < qb && (gate[r2] > gate[r] || (gate[r2] == gate[r] && n2 < n))) ? 1 : 0;
            rank += (n3 < qb && (other[r2] > gate[r] || (other[r2] == gate[r] && n3 < n))) ? 1 : 0;
        }
        if (n < qb && rank < 3) mymask |= 1u << n;
    }
    return mymask | (unsigned)__shfl_xor((int)mymask, 32);
}
}


namespace mk {
using pg8::bf16_t; using pg8::bf16x8; using pg8::f32x4; using pg8::f32x2; using pg8::u32x4; using pg8::u32x2; using pg8::Unit; using pg8::cvt_pk_bf16;
#define LAS __attribute__((address_space(3)))
constexpr int NBAT = MK_NBAT, SEQ = 4096, D = 1024, DFF = 2816, NMEM = 256, M = NBAT * SEQ, MM = NBAT * NMEM, NQKV = 3072;
constexpr float EPS = 1e-6f, LOG2E = 1.4426950408889634f;
constexpr int NWAVES = 8, NPH = 13;

constexpr size_t al256(size_t x) { return (x + 255) / 256 * 256; }
constexpr size_t WS_CTL = 0, CTL_BYTES = 1u << 20;
constexpr size_t WS_WGU1 = WS_CTL + CTL_BYTES;
constexpr size_t WS_WD1 = WS_WGU1 + (size_t)2 * DFF * D * 2;
constexpr size_t WS_WIN = WS_WD1 + (size_t)D * DFF * 2;
constexpr size_t WS_WOUT = WS_WIN + (size_t)NQKV * D * 2;
constexpr size_t WS_WCQS = WS_WOUT + (size_t)D * D * 2;
constexpr size_t WS_WCKV = WS_WCQS + (size_t)D * D * 2;
constexpr size_t WS_WCO = WS_WCKV + (size_t)2 * D * D * 2;
constexpr size_t WS_WGU2 = WS_WCO + (size_t)D * D * 2;
constexpr size_t WS_WD2 = WS_WGU2 + (size_t)2 * DFF * D * 2;
constexpr size_t WS_MB = WS_WD2 + (size_t)D * DFF * 2;
constexpr size_t WS_KVC = WS_MB + (size_t)MM * D * 2;
constexpr size_t WS_WKT = WS_KVC + (size_t)MM * 2 * D * 2;
constexpr size_t WS_VWT = WS_WKT + (size_t)NBAT * D * D * 2;
constexpr size_t SS_BYTES = (size_t)M * 16 * 4;
constexpr size_t WS_SS = WS_VWT + (size_t)NBAT * D * D * 2;
constexpr size_t WS_SSM = WS_SS + 5 * SS_BYTES;
constexpr size_t WS_KM = WS_SSM + (size_t)MM * 16 * 4;
constexpr size_t WS_R1 = al256(WS_KM + (size_t)NBAT * 16 * 256 * 4);
constexpr size_t WS_XB = WS_R1 + (size_t)M * NQKV * 2;
constexpr size_t WS_OA2 = WS_XB + (size_t)M * D * 2;
constexpr size_t WS_SEL = WS_OA2 + (size_t)M * 768 * 2;
constexpr size_t WS_OBP = WS_SEL + (size_t)NBAT * 4 * SEQ * 4;
constexpr size_t WS_MLB = WS_OBP + (size_t)4 * M * 256 * 2;
constexpr size_t WS_END = WS_MLB + (size_t)4 * M * 4 * 2 * 4;
constexpr size_t OUT_OA1 = (size_t)M * 768 * 2, OUT_OB = 2 * OUT_OA1, OUT_ML = OUT_OB + (size_t)M * 256 * 2;
static_assert(OUT_ML + (size_t)3 * M * 12 * 8 <= (size_t)M * D * 4, "attention partials fit in d_out");
constexpr int CW_BAR = 4096, CW_QUEUE = 8192;

constexpr int LDS_XCH = 131072;
constexpr int LDS_MISC = 131072 + 8192;
constexpr int LDS_BYTES = 147456;
constexpr int LDS_TAB = 98304;
static_assert(LDS_TAB + 4 * att::TABB_N * 4 <= LDS_XCH, "attention LDS map");

__device__ __forceinline__ float wave_sum(float v) {
#pragma unroll
    for (int o = 1; o < 64; o <<= 1) v += __shfl_xor(v, o);
    return v;
}
__device__ __forceinline__ float row_rstd(const float* ss, int row) {
    const f32x4* p = (const f32x4*)(ss + (size_t)row * 16);
    const f32x4 a = p[0], b = p[1], c = p[2], d = p[3];
    const float s = ((a[0] + a[1]) + (a[2] + a[3])) + ((b[0] + b[1]) + (b[2] + b[3])) + ((c[0] + c[1]) + (c[2] + c[3])) + ((d[0] + d[1]) + (d[2] + d[3]));
    return 1.0f / sqrtf(s * (1.0f / D) + EPS);
}

struct SchedStd {
    pg8::Order o; const char* A; const char* B; size_t a_tile, b_tile, b_batch; int ocol_mul;
    __device__ __forceinline__ bool next(int i, Unit& u) const { int pm, pn; if (!o.tile(i, pm, pn)) return false;
        u.a = A + (size_t)pm * a_tile; u.b = B + (size_t)pn * b_tile + (size_t)(pm >> 4) * b_batch; u.orow = pm * 256; u.ocol = pn * ocol_mul; u.aux = pn; return true; }
};
struct SchedWK {
    int G, c; const char* kvc; const char* wcqs;
    __device__ __forceinline__ bool next(int i, Unit& u) const { const int L = i * G + c; if (L >= NBAT * 16) return false; const int bh = L >> 2, pn = L & 3, b = bh >> 2, h = bh & 3;
        u.a = kvc + ((size_t)(b * 256) * 2048 + h * 256) * 2; u.b = wcqs + ((size_t)(pn * 256) * 1024 + h * 256) * 2; u.orow = b * 1024 + h * 256; u.ocol = pn * 256; u.aux = 0; return true; }
};
struct SchedVW {
    int G, c; const char* kvc; const char* wcot;
    __device__ __forceinline__ bool next(int i, Unit& u) const { const int L = i * G + c; if (L >= NBAT * 16) return false; const int bh = L >> 2, pm = L & 3, b = bh >> 2, h = bh & 3;
        u.a = wcot + ((size_t)(pm * 256) * 1024 + h * 256) * 2; u.b = kvc + ((size_t)(b * 256) * 2048 + 1024 + h * 256) * 2; u.orow = b * 1024 + pm * 256; u.ocol = h * 256; u.aux = 0; return true; }
};

struct EpiGU { static constexpr bool PERM = true;
    bf16_t* H; const float* ss;
    __device__ __forceinline__ void operator()(const f32x4 (&acc)[2][2][4][2], const Unit& u, int wr, int wc, int fr, int fq, LAS unsigned char*, int, int) const {
        float rsv[2][4];
#pragma unroll
        for (int ai = 0; ai < 2; ++ai)
#pragma unroll
            for (int m = 0; m < 4; ++m) rsv[ai][m] = row_rstd(ss, u.orow + ai * 128 + wr * 64 + m * 16 + fr);
#pragma unroll
        for (int ai = 0; ai < 2; ++ai)
#pragma unroll
            for (int m = 0; m < 4; ++m) { const int row = u.orow + ai * 128 + wr * 64 + m * 16 + fr; const float rs = rsv[ai][m];
                float hv[8];
#pragma unroll
                for (int n = 0; n < 2; ++n)
#pragma unroll
                    for (int j = 0; j < 4; ++j) { const float g = acc[ai][0][m][n][j] * rs, uu = acc[ai][1][m][n][j] * rs;
                        hv[4 * n + j] = g * __builtin_amdgcn_rcpf(1.0f + __builtin_amdgcn_exp2f(-g * LOG2E)) * uu; }
                u32x4 w; w[0] = cvt_pk_bf16(hv[0], hv[1]); w[1] = cvt_pk_bf16(hv[2], hv[3]); w[2] = cvt_pk_bf16(hv[4], hv[5]); w[3] = cvt_pk_bf16(hv[6], hv[7]);
                __builtin_nontemporal_store(w, (u32x4*)(H + (size_t)row * DFF + u.ocol + wc * 32 + 8 * fq)); }
    }
};
struct EpiRes { static constexpr bool PERM = true;
    bf16_t* xb; float* ssout; float alpha;
    __device__ __forceinline__ void operator()(const f32x4 (&acc)[2][2][4][2], const Unit& u, int wr, int wc, int fr, int fq, LAS unsigned char*, int, int) const {
        const size_t off0 = (size_t)(u.orow + wr * 64 + fr) * D + u.ocol + wc * 32 + 8 * fq;
        u32x4 cur[2], nxt[2];
#pragma unroll
        for (int bj = 0; bj < 2; ++bj) cur[bj] = *(const u32x4*)(xb + off0 + bj * 128);
#pragma unroll
        for (int idx = 0; idx < 8; ++idx) { const int ai = idx >> 2, m = idx & 3; const size_t off = off0 + (size_t)(ai * 128 + m * 16) * D; const int row = u.orow + ai * 128 + wr * 64 + m * 16 + fr;
            if (idx < 7) { const size_t offn = off0 + (size_t)(((idx + 1) >> 2) * 128 + ((idx + 1) & 3) * 16) * D;
#pragma unroll
                for (int bj = 0; bj < 2; ++bj) nxt[bj] = *(const u32x4*)(xb + offn + bj * 128); }
            float sq = 0.f;
#pragma unroll
            for (int bj = 0; bj < 2; ++bj) { float o[8];
#pragma unroll
                for (int n = 0; n < 2; ++n)
#pragma unroll
                    for (int j = 0; j < 4; ++j) { const unsigned wv = cur[bj][2 * n + (j >> 1)]; const float r = __builtin_bit_cast(float, (j & 1) ? (wv & 0xffff0000u) : (wv << 16));
                        const float v = r + acc[ai][bj][m][n][j] * alpha; o[4 * n + j] = v; sq += v * v; }
                u32x4 w; w[0] = cvt_pk_bf16(o[0], o[1]); w[1] = cvt_pk_bf16(o[2], o[3]); w[2] = cvt_pk_bf16(o[4], o[5]); w[3] = cvt_pk_bf16(o[6], o[7]);
                *(u32x4*)(xb + off + bj * 128) = w; }
            sq += __shfl_xor(sq, 16); sq += __shfl_xor(sq, 32);
            if (fq == 0) ssout[(size_t)row * 16 + (u.ocol >> 8) * 4 + wc] = sq;
#pragma unroll
            for (int bj = 0; bj < 2; ++bj) cur[bj] = nxt[bj]; }
    }
};
struct EpiStore { static constexpr bool PERM = true;
    bf16_t* O; int ldc; const float* ss; float* km; bool nt;
    __device__ __forceinline__ void operator()(const f32x4 (&acc)[2][2][4][2], const Unit& u, int wr, int wc, int fr, int fq, LAS unsigned char*, int, int) const {
        float rsv[2][4];
#pragma unroll
        for (int ai = 0; ai < 2; ++ai)
#pragma unroll
            for (int m = 0; m < 4; ++m) rsv[ai][m] = ss ? row_rstd(ss, u.orow + ai * 128 + wr * 64 + m * 16 + fr) : 1.0f;
#pragma unroll
        for (int ai = 0; ai < 2; ++ai)
#pragma unroll
            for (int m = 0; m < 4; ++m) { const int row = u.orow + ai * 128 + wr * 64 + m * 16 + fr; const float rs = rsv[ai][m];
                const int col0 = u.ocol + wc * 32 + 8 * fq;
                bf16_t* rowp = ldc ? O + (size_t)row * ldc + col0 : O + (((size_t)(row / SEQ) * (NQKV / 64) + (col0 >> 6)) * SEQ + (row % SEQ)) * 64 + (col0 & 63);
                const size_t bjstep = ldc ? 128 : (size_t)2 * SEQ * 64;
#pragma unroll
                for (int bj = 0; bj < 2; ++bj) { const f32x4 v0 = acc[ai][bj][m][0] * rs, v1 = acc[ai][bj][m][1] * rs;
                    u32x4 w; w[0] = cvt_pk_bf16(v0[0], v0[1]); w[1] = cvt_pk_bf16(v0[2], v0[3]); w[2] = cvt_pk_bf16(v1[0], v1[1]); w[3] = cvt_pk_bf16(v1[2], v1[3]);
                    if (nt) __builtin_nontemporal_store(w, (u32x4*)(rowp + bj * bjstep)); else *(u32x4*)(rowp + bj * bjstep) = w; } }
        if ((km != nullptr) && (u.aux == 10)) {
            float* kmb = km + (size_t)(u.orow >> 8) * 256 + wc * 32 + 8 * fq;
#pragma unroll
            for (int bj = 0; bj < 2; ++bj)
#pragma unroll
                for (int n = 0; n < 2; ++n) { f32x4 cs = (f32x4){0.f, 0.f, 0.f, 0.f};
#pragma unroll
                    for (int ai = 0; ai < 2; ++ai)
#pragma unroll
                        for (int m = 0; m < 4; ++m) cs += acc[ai][bj][m][n] * rsv[ai][m];
#pragma unroll
                    for (int j = 0; j < 4; ++j) { float v = cs[j]; v += __shfl_xor(v, 1); v += __shfl_xor(v, 2); v += __shfl_xor(v, 4); v += __shfl_xor(v, 8);
                        if (fr == 0) atomicAdd(kmb + bj * 128 + 4 * n + j, v); } }
        }
    }
};
struct EpiSoftmax { static constexpr bool PERM = true;
    bf16_t* P; const float* ss;
    __device__ __forceinline__ void operator()(const f32x4 (&acc)[2][2][4][2], const Unit& u, int wr, int wc, int fr, int fq, LAS unsigned char* lds, int, int) const {
        LAS f32x2* X = (LAS f32x2*)(lds + LDS_XCH);
        float rsl[2][4], mw[2][4];
#pragma unroll
        for (int ai = 0; ai < 2; ++ai)
#pragma unroll
            for (int m = 0; m < 4; ++m) { const int rl = ai * 128 + wr * 64 + m * 16 + fr; const float rs = row_rstd(ss, u.orow + rl) * LOG2E; rsl[ai][m] = rs;
                float mx = -INFINITY;
#pragma unroll
                for (int bj = 0; bj < 2; ++bj)
#pragma unroll
                    for (int n = 0; n < 2; ++n)
#pragma unroll
                        for (int j = 0; j < 4; ++j) mx = fmaxf(mx, acc[ai][bj][m][n][j] * rs);
                mx = fmaxf(mx, __shfl_xor(mx, 16)); mx = fmaxf(mx, __shfl_xor(mx, 32));
                float sm = 0.f;
#pragma unroll
                for (int bj = 0; bj < 2; ++bj)
#pragma unroll
                    for (int n = 0; n < 2; ++n)
#pragma unroll
                        for (int j = 0; j < 4; ++j) sm += __builtin_amdgcn_exp2f(acc[ai][bj][m][n][j] * rs - mx);
                sm += __shfl_xor(sm, 16); sm += __shfl_xor(sm, 32);
                mw[ai][m] = mx;
                if (fq == 0) X[rl * 4 + wc] = (f32x2){mx, sm}; }
        asm volatile("s_waitcnt lgkmcnt(0)" ::: "memory"); __builtin_amdgcn_s_barrier(); asm volatile("" ::: "memory");
#pragma unroll
        for (int ai = 0; ai < 2; ++ai)
#pragma unroll
            for (int m = 0; m < 4; ++m) { const int rl = ai * 128 + wr * 64 + m * 16 + fr; const float rs = rsl[ai][m];
                const f32x2 x0 = X[rl * 4 + 0], x1 = X[rl * 4 + 1], x2 = X[rl * 4 + 2], x3 = X[rl * 4 + 3];
                const float Mx = fmaxf(fmaxf(x0[0], x1[0]), fmaxf(x2[0], x3[0]));
                const float L = x0[1] * __builtin_amdgcn_exp2f(x0[0] - Mx) + x1[1] * __builtin_amdgcn_exp2f(x1[0] - Mx) + x2[1] * __builtin_amdgcn_exp2f(x2[0] - Mx) + x3[1] * __builtin_amdgcn_exp2f(x3[0] - Mx);
                const float il = 1.0f / L;
                bf16_t* rowp = P + (size_t)(u.orow + rl) * D + u.ocol + wc * 32 + 8 * fq;
#pragma unroll
                for (int bj = 0; bj < 2; ++bj) { float pv[8];
#pragma unroll
                    for (int n = 0; n < 2; ++n)
#pragma unroll
                        for (int j = 0; j < 4; ++j) pv[4 * n + j] = __builtin_amdgcn_exp2f(acc[ai][bj][m][n][j] * rs - Mx) * il;
                    u32x4 w; w[0] = cvt_pk_bf16(pv[0], pv[1]); w[1] = cvt_pk_bf16(pv[2], pv[3]); w[2] = cvt_pk_bf16(pv[4], pv[5]); w[3] = cvt_pk_bf16(pv[6], pv[7]);
                    *(u32x4*)(rowp + bj * 128) = w; } }
        (void)mw;
    }
};

#define XB_TMO      128
#define XB_XCNT(j)  (256  + 64 * (j))
#define XB_XSUB(j)  (1280 + 64 * (j))
#define XB_XGEN(j)  (2304 + 64 * (j))
#define XB_TOP      3328
#define XB_TOPGEN   3392
#define XCD_BAR_WORDS 3456
#define XB_SPIN_CAP (1u << 18)
__device__ __forceinline__ unsigned xb_ld(unsigned* p)              { return __hip_atomic_load(p, __ATOMIC_RELAXED, __HIP_MEMORY_SCOPE_AGENT); }
__device__ __forceinline__ unsigned xb_add(unsigned* p, unsigned v) { return __hip_atomic_fetch_add(p, v, __ATOMIC_RELAXED, __HIP_MEMORY_SCOPE_AGENT); }
__device__ __forceinline__ unsigned xb_xcc_id() { return (unsigned)__builtin_amdgcn_s_getreg((3 << 11) | 20) & 0xFu; }
#define XB_SPIN(cond, bar) do { unsigned _sp = 0; while (cond) { __builtin_amdgcn_s_sleep(1); \
    if ((++_sp & 255u) == 0u) { if (xb_ld(&(bar)[XB_TMO])) break; if (_sp > XB_SPIN_CAP) { atomicAdd(&(bar)[XB_TMO], 1u); break; } } } } while (0)
struct XcdBarrier { unsigned* bar; unsigned x; volatile LAS unsigned* st; };
__device__ __forceinline__ XcdBarrier xcd_barrier_post(unsigned* bar, volatile LAS unsigned* st) {
    XcdBarrier b; b.bar = bar; b.x = xb_xcc_id(); b.st = st;
    if (threadIdx.x == 0) (void)xb_add(&bar[XB_XCNT(b.x)], 1u);
    return b;
}
__device__ __forceinline__ void xcd_barrier_complete(unsigned* bar, unsigned x, unsigned& nloc, unsigned& nx) {
    const unsigned G = gridDim.x * gridDim.y * gridDim.z;
    unsigned sum, cnt, mine, sp = 0u;
    for (;;) {
        sum = 0u; cnt = 0u; mine = 0u;
#pragma unroll
        for (unsigned j = 0; j < 16; ++j) { const unsigned c = xb_ld(&bar[XB_XCNT(j)]); sum += c; cnt += (c > 0u) ? 1u : 0u; mine = (j == x) ? c : mine; }
        if (sum == G) break;
        __builtin_amdgcn_s_sleep(1);
        if ((++sp & 255u) == 0u) { if (xb_ld(&bar[XB_TMO])) break; if (sp > XB_SPIN_CAP) { atomicAdd(&bar[XB_TMO], 1u); break; } }
    }
    nloc = mine > 0u ? mine : 1u; nx = cnt > 0u ? cnt : 1u;
}
__device__ __forceinline__ void xcd_barrier(const XcdBarrier& b) {
    asm volatile("s_waitcnt vmcnt(0)" ::: "memory");
    __syncthreads();
    if (threadIdx.x == 0) {
        unsigned* bar = b.bar;
        __builtin_amdgcn_s_waitcnt(0);
        unsigned nloc = b.st[0], nx = b.st[1];
        if (nloc == 0u) { xcd_barrier_complete(bar, b.x, nloc, nx); b.st[0] = nloc; b.st[1] = nx; }
        const unsigned old = xb_add(&bar[XB_XSUB(b.x)], 1u);
        const unsigned gen = old / nloc;
        if (old + 1u == (gen + 1u) * nloc) {
            __builtin_amdgcn_fence(__ATOMIC_RELEASE, "agent");
            asm volatile("s_waitcnt vmcnt(0)" ::: "memory");
            const unsigned og = xb_add(&bar[XB_TOP], 1u);
            const unsigned tg = og / nx;
            if (og + 1u == (tg + 1u) * nx) xb_add(&bar[XB_TOPGEN], 1u);
            else XB_SPIN(xb_ld(&bar[XB_TOPGEN]) == tg, bar);
            __builtin_amdgcn_fence(__ATOMIC_ACQUIRE, "agent");
            xb_add(&bar[XB_XGEN(b.x)], 1u);
            asm volatile("s_waitcnt vmcnt(0)" ::: "memory");
        } else {
            XB_SPIN(xb_ld(&bar[XB_XGEN(b.x)]) == gen, bar);
            __builtin_amdgcn_fence(__ATOMIC_ACQUIRE, "agent");
            asm volatile("s_waitcnt vmcnt(0)" ::: "memory");
        }
    }
    __syncthreads();
}

__device__ __forceinline__ void tr_item(const float* W, int N, int k0, int n0, const float* gain, float cscale, bf16_t* dst  , int Kd, LAS float* scr, int lane) {
    f32x4 v[8]; float g[8];
#pragma unroll
    for (int i = 0; i < 8; ++i) { const int kk = 8 * i + (lane >> 3); v[i] = __builtin_nontemporal_load((const f32x4*)(W + (size_t)(k0 + kk) * N + n0 + 4 * (lane & 7))); g[i] = gain ? gain[k0 + kk] * cscale : cscale; }
#pragma unroll
    for (int i = 0; i < 8; ++i) { const int kk = 8 * i + (lane >> 3); LAS float* d = scr + kk * 33 + 4 * (lane & 7); d[0] = v[i][0] * g[i]; d[1] = v[i][1] * g[i]; d[2] = v[i][2] * g[i]; d[3] = v[i][3] * g[i]; }
    asm volatile("s_waitcnt lgkmcnt(0)" ::: "memory");
    const int c = lane & 7;
#pragma unroll
    for (int j = 0; j < 4; ++j) { const int n = (lane >> 3) + 8 * j; const LAS float* s = scr + (8 * c) * 33 + n;
        u32x4 o; o[0] = cvt_pk_bf16(s[0 * 33], s[1 * 33]); o[1] = cvt_pk_bf16(s[2 * 33], s[3 * 33]); o[2] = cvt_pk_bf16(s[4 * 33], s[5 * 33]); o[3] = cvt_pk_bf16(s[6 * 33], s[7 * 33]);
        *(u32x4*)(dst + (size_t)n * Kd + k0 + 8 * c) = o; }
    asm volatile("s_waitcnt lgkmcnt(0)" ::: "memory");
}
template <int NR>
__device__ __forceinline__ void cvt_rows(const float* x, bf16_t* o, float* ss, int row0, int stride, int nrows, int lane) {
    f32x4 v[NR][4]; float s[NR];
#pragma unroll
    for (int r = 0; r < NR; ++r) { const int row = row0 + r * stride; const f32x4* xr = (const f32x4*)(x + (size_t)(row < nrows ? row : row0) * D) + lane;
#pragma unroll
        for (int j = 0; j < 4; ++j) v[r][j] = __builtin_nontemporal_load(xr + 64 * j); }
#pragma unroll
    for (int r = 0; r < NR; ++r) { float a = 0.f;
#pragma unroll
        for (int j = 0; j < 4; ++j) a += (v[r][j][0] * v[r][j][0] + v[r][j][1] * v[r][j][1]) + (v[r][j][2] * v[r][j][2] + v[r][j][3] * v[r][j][3]);
        s[r] = a; }
#pragma unroll
    for (int of = 1; of < 64; of <<= 1)
#pragma unroll
        for (int r = 0; r < NR; ++r) s[r] += __shfl_xor(s[r], of);
#pragma unroll
    for (int r = 0; r < NR; ++r) { const int row = row0 + r * stride; if (row < nrows) { u32x2* o8 = (u32x2*)(o + (size_t)row * D) + lane;
#pragma unroll
            for (int j = 0; j < 4; ++j) { u32x2 w; w[0] = cvt_pk_bf16(v[r][j][0], v[r][j][1]); w[1] = cvt_pk_bf16(v[r][j][2], v[r][j][3]); o8[64 * j] = w; }
            if (lane < 16) ss[(size_t)row * 16 + lane] = lane == 0 ? s[r] : 0.f; } }
}

struct Args { const float* in[20]; float* out; unsigned char* ws; int ph_lo, ph_hi, flags, pad; };

#define MK_PTRS unsigned char* ws = args.ws; float* out = args.out; asm volatile("" : "+s"(ws), "+s"(out)); \
    const float* x_in = args.in[0]; const float* mem_in = args.in[1]; const float* rel_bias = args.in[7]; \
    bf16_t* Wgu1 = (bf16_t*)(ws + WS_WGU1); bf16_t* Wd1 = (bf16_t*)(ws + WS_WD1); bf16_t* Win = (bf16_t*)(ws + WS_WIN); bf16_t* Wout = (bf16_t*)(ws + WS_WOUT); \
    bf16_t* Wcqs = (bf16_t*)(ws + WS_WCQS); bf16_t* Wckv = (bf16_t*)(ws + WS_WCKV); bf16_t* Wco = (bf16_t*)(ws + WS_WCO); bf16_t* Wgu2 = (bf16_t*)(ws + WS_WGU2); bf16_t* Wd2 = (bf16_t*)(ws + WS_WD2); \
    bf16_t* MB = (bf16_t*)(ws + WS_MB); bf16_t* KVC = (bf16_t*)(ws + WS_KVC); bf16_t* WKT = (bf16_t*)(ws + WS_WKT); bf16_t* VWT = (bf16_t*)(ws + WS_VWT); \
    float* SS0 = (float*)(ws + WS_SS); float* SS1 = SS0 + (size_t)M * 16; float* SS2 = SS1 + (size_t)M * 16; float* SS3 = SS2 + (size_t)M * 16; float* SS4 = SS3 + (size_t)M * 16; \
    float* SSM = (float*)(ws + WS_SSM); float* KM = (float*)(ws + WS_KM); \
    bf16_t* HB = (bf16_t*)(ws + WS_R1); bf16_t* QKV = HB; bf16_t* YN = HB; bf16_t* PB = HB; \
    bf16_t* XB = (bf16_t*)(ws + WS_XB); bf16_t* OA0 = (bf16_t*)out; bf16_t* OA1 = (bf16_t*)((char*)out + OUT_OA1); bf16_t* OA2 = (bf16_t*)(ws + WS_OA2); bf16_t* OB = (bf16_t*)((char*)out + OUT_OB); float* ML = (float*)((char*)out + OUT_ML); unsigned* SEL = (unsigned*)(ws + WS_SEL); bf16_t* OBP = (bf16_t*)(ws + WS_OBP); float* MLB = (float*)(ws + WS_MLB); (void)OB;
__global__ void __launch_bounds__(NWAVES * 64, 2) mk_fwd(Args args) {
    extern __shared__ __attribute__((aligned(16))) unsigned char lds_raw[];
    LAS unsigned char* lds = (LAS unsigned char*)lds_raw;
    const int tid = threadIdx.x, lane = tid & 63, wave = __builtin_amdgcn_readfirstlane(tid >> 6);
    const int G = gridDim.x, bx = blockIdx.x;
    const int vcu = (G % 8 == 0) ? (bx % 8) * (G / 8) + bx / 8 : bx;
    const int gw = vcu * NWAVES + wave, NGW = G * NWAVES;
    unsigned char* const ws0 = args.ws;
    volatile LAS unsigned* MISC = (volatile LAS unsigned*)(lds + LDS_MISC);
    if (tid < 32) MISC[tid] = 0u;
    __syncthreads();
    const int lo = args.ph_lo, hi = args.ph_hi;
    const bool use_bar = (hi - lo) > 1;
    XcdBarrier bar; bar.bar = (unsigned*)(ws0 + WS_CTL) + CW_BAR; bar.x = 0; bar.st = nullptr;
    if (use_bar) bar = xcd_barrier_post((unsigned*)(ws0 + WS_CTL) + CW_BAR, MISC + 8);
#define IN(k) (lo <= (k) && (k) < hi)
#define STAGGER() do { if (MK_STAGGER_TICKS > 0) { const unsigned long long t0_ = __builtin_amdgcn_s_memrealtime(), dl_ = (unsigned long long)((bx >> 3) & 3) * MK_STAGGER_TICKS; while (__builtin_amdgcn_s_memrealtime() - t0_ < dl_) __builtin_amdgcn_s_sleep(8); } } while (0)
#define SEAM(k) do { if (IN(k) && IN((k) + 1)) xcd_barrier(bar); } while (0)

    if (IN(0)) {
        MK_PTRS;
        LAS float* scr = (LAS float*)(lds + wave * 16384);
        constexpr int I_GU = (D / 64) * (2 * DFF / 32), I_DN = (DFF / 64) * (D / 32), I_IN = (D / 64) * (NQKV / 32), I_SQ = (D / 64) * (D / 32), I_KV = (D / 64) * (2 * D / 32);
        constexpr int NITEMS = 2 * I_GU + 2 * I_DN + I_IN + 2 * I_SQ + I_KV;
        for (int it = gw; it < NITEMS; it += NGW) {
            int r = it;
            if (r < 2 * I_GU) {
                const bool second = r >= I_GU; if (second) r -= I_GU;
                const int nblk = 2 * DFF / 32, kb = r / nblk, nb = r % nblk, n0 = nb * 32;
                const int drow = n0 < DFF ? (n0 / 128) * 256 + (n0 % 128) : ((n0 - DFF) / 128) * 256 + 128 + ((n0 - DFF) % 128);
                tr_item(args.in[second ? 17 : 3], 2 * DFF, kb * 64, n0, args.in[second ? 16 : 2], 1.0f, (second ? Wgu2 : Wgu1) + (size_t)drow * D, D, scr, lane); continue; }
            r -= 2 * I_GU;
            if (r < 2 * I_DN) { const bool second = r >= I_DN; if (second) r -= I_DN; const int nblk = D / 32, kb = r / nblk, nb = r % nblk;
                tr_item(args.in[second ? 18 : 4], D, kb * 64, nb * 32, nullptr, 1.0f, (second ? Wd2 : Wd1) + (size_t)(nb * 32) * DFF, DFF, scr, lane); continue; }
            r -= 2 * I_DN;
            if (r < I_IN) { const int nblk = NQKV / 32, kb = r / nblk, nb = r % nblk, n0 = nb * 32; const bool isq = (n0 < 768) || (n0 >= 2304 && n0 < 2560);
                tr_item(args.in[6], NQKV, kb * 64, n0, args.in[5], isq ? 0.125f : 1.0f, Win + (size_t)n0 * D, D, scr, lane); continue; }
            r -= I_IN;
            if (r < I_SQ) { const int nblk = D / 32, kb = r / nblk, nb = r % nblk, k0 = kb * 64; const float* gp = k0 < 768 ? args.in[8] : args.in[9] - 768;
                tr_item(args.in[10], D, k0, nb * 32, gp, 1.0f, Wout + (size_t)(nb * 32) * D, D, scr, lane); continue; }
            r -= I_SQ;
            if (r < I_SQ) { const int nblk = D / 32, kb = r / nblk, nb = r % nblk; tr_item(args.in[15], D, kb * 64, nb * 32, nullptr, 1.0f, Wco + (size_t)(nb * 32) * D, D, scr, lane); continue; }
            r -= I_SQ;
            { const int nblk = 2 * D / 32, kb = r / nblk, nb = r % nblk; tr_item(args.in[14], 2 * D, kb * 64, nb * 32, args.in[12], 1.0f, Wckv + (size_t)(nb * 32) * D, D, scr, lane); }
        }
        for (int c = gw; c < D; c += NGW) { const float g = args.in[11][c] * 0.0625f; const f32x4* src = (const f32x4*)(args.in[13] + (size_t)c * D) + lane; u32x2* dst = (u32x2*)(Wcqs + (size_t)c * D) + lane;
#pragma unroll
            for (int j = 0; j < 4; ++j) { const f32x4 v = src[64 * j] * g; u32x2 w; w[0] = cvt_pk_bf16(v[0], v[1]); w[1] = cvt_pk_bf16(v[2], v[3]); dst[64 * j] = w; } }
        for (int m = gw; m < M; m += 4 * NGW) cvt_rows<4>(x_in, XB, SS0, m, NGW, M, lane);
        for (int m = gw; m < MM; m += NGW) cvt_rows<1>(mem_in, MB, SSM, m, NGW, MM, lane);
        for (int i = gw * 64 + lane; i < NBAT * 16 * 256; i += NGW * 64) KM[i] = 0.f;
    }
    SEAM(0);

    if (IN(1)) {
        MK_PTRS;
        STAGGER();
        { SchedStd S; S.o.init(M, 2 * DFF, G, bx); S.A = (const char*)XB; S.B = (const char*)Wgu1; S.a_tile = (size_t)256 * D * 2; S.b_tile = (size_t)256 * D * 2; S.b_batch = 0; S.ocol_mul = 128;
          EpiGU E{HB, SS0}; pg8::gemm_phase<EpiGU, SchedStd, true>(lds, D, D, D / 64, S, E); }
    }
    SEAM(1);

    if (IN(2)) {
        MK_PTRS;
        SchedStd S; S.o.init(M, D, G, bx); S.A = (const char*)HB; S.B = (const char*)Wd1; S.a_tile = (size_t)256 * DFF * 2; S.b_tile = (size_t)256 * DFF * 2; S.b_batch = 0; S.ocol_mul = 256;
        EpiRes E{XB, SS1, 0.5f}; pg8::gemm_phase<EpiRes, SchedStd, true>(lds, DFF, DFF, DFF / 64, S, E);
    }
    SEAM(2);

    if (IN(3)) {
        MK_PTRS;
        { SchedStd S; S.o.init(M, NQKV, G, bx); S.A = (const char*)XB; S.B = (const char*)Win; S.a_tile = (size_t)256 * D * 2; S.b_tile = (size_t)256 * D * 2; S.b_batch = 0; S.ocol_mul = 256;
          EpiStore E{QKV, 0, SS1, KM, false}; pg8::gemm_phase<EpiStore, SchedStd, true>(lds, D, D, D / 64, S, E); }
    }
    SEAM(3);

    if (IN(4)) {
        MK_PTRS;
        constexpr long HSTR4 = (long)SEQ * 128;
        for (int task = gw; task < NBAT * 4 * (SEQ / 32); task += NGW) { const int bh = task / (SEQ / 32), tl = task % (SEQ / 32), b = bh >> 2, hb = bh & 3, q0 = tl * 32, qb = q0 >> 8;
            const char* qbase = (const char*)QKV + ((size_t)b * 48 + 36 + hb) * HSTR4 + (size_t)q0 * 128;
            const unsigned msk = att::moba_select(qbase, 128, KM + (size_t)b * 16 * 256 + hb * 64, qb);
            if (lane < 32) SEL[(size_t)bh * SEQ + q0 + lane] = msk; }
    }
    SEAM(4);

    if (IN(5)) {
        MK_PTRS;
        LAS float* tab = (LAS float*)(lds + LDS_TAB);
        const int h2 = lane >> 5, q = lane & 31;
        const long rowb = 128;
        constexpr long HSTR = (long)SEQ * 128;
#define ATT_WAITV(n) asm volatile("s_waitcnt vmcnt(" #n ")" ::: "memory")
#define ATT_BAR() do { asm volatile("s_waitcnt lgkmcnt(0)" ::: "memory"); __builtin_amdgcn_s_barrier(); asm volatile("" ::: "memory"); } while (0)
        { constexpr int NKV = NBAT * 8;
          struct SchedOne { const char* A; const char* B; int G_, c_; __device__ __forceinline__ bool next(int i, Unit& uu) const { const int idx = i * G_ + c_; if (idx >= NKV) return false; const int pm = idx >> 3, pn = idx & 7;
              uu.a = A + (size_t)pm * 256 * D * 2; uu.b = B + (size_t)pn * 256 * D * 2; uu.orow = pm * 256; uu.ocol = pn * 256; uu.aux = pn; return true; } };
          SchedOne S1{(const char*)MB, (const char*)Wckv, G, vcu};
          EpiStore Ekv{KVC, 2 * D, SSM, nullptr, false}; pg8::gemm_phase<EpiStore, SchedOne, true>(lds, D, D, D / 64, S1, Ekv);
          __syncthreads(); }
        for (int i = tid; i < 4 * att::TABB_N; i += NWAVES * 64) { const int hb = i / att::TABB_N, e = i % att::TABB_N, dist = e - 32;
            tab[i] = dist >= 0 ? rel_bias[att::rel_bucket(dist) * 16 + 12 + hb] * LOG2E : -INFINITY; }
        __syncthreads();
        {
            constexpr int NBH = NBAT * 4, NUNITS = 16 * NBH;
            LAS unsigned* LQ = (LAS unsigned*)(lds + 65536);
            volatile LAS unsigned* UW = (volatile LAS unsigned*)(lds + 65536 + 16384);
            unsigned* qhead = (unsigned*)(ws + WS_CTL) + CW_QUEUE;
#pragma unroll 1
            for (;;) {
                if (tid == 0) UW[8] = __hip_atomic_fetch_add(qhead, 1u, __ATOMIC_RELAXED, __HIP_MEMORY_SCOPE_AGENT);
                ATT_BAR();
                const int u = (int)UW[8];
                if (u >= NUNITS) break;
                const int n = u / NBH, bh = u % NBH, b = bh >> 2, hb = bh & 3;
                const char* qh = (const char*)QKV + ((size_t)b * 48 + 36 + hb) * HSTR;
                const char* kh = (const char*)QKV + ((size_t)b * 48 + 40 + hb) * HSTR + (size_t)(256 * n) * rowb;
                const unsigned* selp = SEL + (size_t)bh * SEQ;
                ATT_WAITV(0);
#pragma unroll
                for (int k = wave; k < 32; k += NWAVES) { const int row = 8 * k + (lane >> 3); att::dma_rows8(kh + (long)row * rowb, (int)(4 * HSTR), row, (LAS char*)(lds + k * 1024), (LAS char*)(lds + 32768 + k * 1024), lane); }
                int total = 0;
                if (n < 15) {
                    const int lo = 256 * (n + 1) + wave * 32 * (15 - n), R = 32 * (15 - n);
                    int cnt = 0;
#pragma unroll 1
                    for (int i = 0; i < R; i += 64) { const bool pr = (i + lane < R) && ((selp[lo + i + lane] >> n) & 1u); cnt += __popcll(__ballot(pr)); }
                    if (lane == 0) UW[wave] = (unsigned)cnt;
                    ATT_BAR();
                    int basew = 0;
#pragma unroll
                    for (int w2 = 0; w2 < NWAVES; ++w2) { const int cw = (int)UW[w2]; basew += (w2 < wave) ? cw : 0; total += cw; }
#pragma unroll 1
                    for (int i = 0; i < R; i += 64) { const bool pr = (i + lane < R) && ((selp[lo + i + lane] >> n) & 1u); const unsigned long long bal = __ballot(pr);
                        if (pr) LQ[basew + __popcll(bal & ((1ull << lane) - 1ull))] = (unsigned)(lo + i + lane); basew += __popcll(bal); }
                }
                const int ntiles = (total + 31) >> 5;
                ATT_WAITV(0); ATT_BAR();
                const LAS float* tb = tab + hb * att::TABB_N;
#pragma unroll 1
                for (int tile = -1; tile < ntiles; tile = (tile < 0 ? wave : tile + NWAVES)) {
                    const bool own = tile < 0;
                    int tq; bool valid = true;
                    if (own) tq = 256 * n + 32 * wave + q; else { const int e = 32 * tile + q; valid = e < total; tq = (int)LQ[valid ? e : total - 1]; }
                    att::bf16x8 qf[4];
#pragma unroll
                    for (int d0 = 0; d0 < 4; ++d0) qf[d0] = *(const att::bf16x8*)(qh + (long)tq * rowb + (16 * d0 + 8 * h2) * 2);
                    const int slot = own ? 3 : __popc(selp[tq] & ((1u << n) - 1u));
                    att::f32x16 o[2]; o[0] = att::f32x16{}; o[1] = att::f32x16{}; float mo = -1e30f, lo_ = 0.f;
                    const int Bq = (tq - 256 * n + 32) - 4 * h2;
#pragma unroll 1
                    for (int g = own ? wave : 7; g >= 0; --g) { int B = Bq - 32 * g; B = B < (att::TABB_N - 1) ? B : (att::TABB_N - 1);
                        att::attn_group(qf, o, mo, lo_, (const LAS char*)(lds + g * 4096), (const LAS char*)(lds + 32768 + g * 4096), tb + B, lane); }
                    lo_ += __shfl_xor(lo_, 32);
                    const size_t prow = (size_t)slot * M + (size_t)b * SEQ + tq;
                    att::store_o<MK_NT_PART>(o, lo_, (char*)OBP + (prow * 256 + hb * 64) * 2, h2, valid);
                    if (h2 == 0 && valid) *(f32x2*)(MLB + (prow * 4 + hb) * 2) = (f32x2){mo, lo_};
                }
                ATT_BAR();
            }
        }
        __syncthreads();
        LAS float* rbl = (LAS float*)(lds + LDS_TAB); LAS float* tabI = (LAS float*)(lds + LDS_TAB + 2048);
        LAS char* ostg = (LAS char*)(lds + LDS_TAB + 3072 + wave * 4096);
        static_assert(LDS_TAB + 3072 + NWAVES * 4096 <= LDS_MISC, "dilated LDS map");
        for (int i = tid; i < 512; i += NWAVES * 64) rbl[i] = rel_bias[i] * LOG2E;
        __syncthreads();
        constexpr int NDIL = NBAT * 12 * 48;
        struct DilItem { int b, h, p, d, res, m0, mbase; };
        auto decode = [&](int it, DilItem& I) { const int bh = it / 48, j = it % 48; I.b = bh / 12; I.h = bh % 12; I.p = j >> 4; const int jj = j & 15;
            I.d = I.p == 0 ? 1 : (I.p == 1 ? 4 : 16); I.res = I.p == 0 ? 0 : (I.p == 1 ? (jj & 3) : jj); const int mblk = I.p == 0 ? jj : (I.p == 1 ? (jj >> 2) : 0);
            I.mbase = mblk * 256 - 128; I.m0 = mblk * 256 + wave * 32; };
        att::bf16x8 qf[4];
        auto issue_k = [&](const DilItem& I) {
            const char* kb = (const char*)QKV + ((size_t)I.b * 48 + 12 + I.h) * HSTR + (size_t)I.res * rowb; const long st = (long)I.d * rowb;
#pragma unroll 1
            for (int k = wave; k < 48; k += NWAVES) { if (I.mbase + 8 * k < 0) continue; const int row = 8 * k + (lane >> 3); att::dma_k_rows8(kb + (long)(I.mbase + row) * st, row, (LAS char*)(lds + k * 1024), lane); } };
        auto issue_v = [&](const DilItem& I) {
            const char* vb = (const char*)QKV + ((size_t)I.b * 48 + 24 + I.h) * HSTR + (size_t)I.res * rowb; const long st = (long)I.d * rowb;
#pragma unroll 1
            for (int k = wave; k < 48; k += NWAVES) { if (I.mbase + 8 * k < 0) continue; const int row = 8 * k + (lane >> 3); att::dma_v_rows8(vb + (long)(I.mbase + row) * st, row, (LAS char*)(lds + 49152 + k * 1024), lane); } };
        auto load_q = [&](const DilItem& I) {
            const char* qp = (const char*)QKV + ((size_t)I.b * 48 + I.h) * HSTR + (size_t)I.res * rowb + (long)I.m0 * I.d * rowb + (long)q * I.d * rowb + 16 * h2;
            asm volatile("global_load_dwordx4 %0, %4, off\n\tglobal_load_dwordx4 %1, %4, off offset:32\n\tglobal_load_dwordx4 %2, %4, off offset:64\n\tglobal_load_dwordx4 %3, %4, off offset:96"
                         : "=&v"(qf[0]), "=&v"(qf[1]), "=&v"(qf[2]), "=&v"(qf[3]) : "v"(qp) : "memory"); };
        auto build_tab = [&](const DilItem& I) { if (tid < att::TABA_N) { const int delta = tid - 32; tabI[tid] = (delta >= 0 && delta <= 128) ? rbl[att::rel_bucket(delta * I.d) * 16 + I.h] : -INFINITY; } };
        DilItem cur; int it = vcu;
        if (it < NDIL) { decode(it, cur); build_tab(cur); ATT_WAITV(0); issue_k(cur); load_q(cur); issue_v(cur); }
#pragma unroll 1
        for (; it < NDIL; it += G) {
            if (cur.mbase < 0) ATT_WAITV(4); else ATT_WAITV(6);
            asm volatile("" : "+v"(qf[0]), "+v"(qf[1]), "+v"(qf[2]), "+v"(qf[3]));
            ATT_BAR();
            const int m0 = cur.m0, gend = (m0 - 128) > 0 ? (m0 - 128) : 0, ng = ((m0 - gend) >> 5) + 1;
            att::u32x4 pw[5][2]; float mo, lo_;
            { att::bf16x8 qc[4] = {qf[0], qf[1], qf[2], qf[3]};
              att::dil_pass1(qc, ng, (const LAS char*)(lds + (m0 - cur.mbase) * 128), tabI + 32 + q - 4 * h2, pw, mo, lo_, lane); }
            ATT_WAITV(0); ATT_BAR();
            const DilItem done = cur; const bool has_next = it + G < NDIL;
            if (has_next) { decode(it + G, cur); issue_k(cur); build_tab(cur); }
            att::f32x16 o[2];
            att::dil_pass2(ng, (const LAS char*)(lds + 49152 + (m0 - done.mbase) * 128), pw, o, lane);
            ATT_BAR();
            const size_t tok = (size_t)done.b * SEQ + (size_t)(m0 + q) * done.d + done.res;
            att::store_o_staged<MK_NT_PART>(o, lo_, ostg, (char*)(done.p == 0 ? OA0 : (done.p == 1 ? OA1 : OA2)) + (((size_t)done.b * SEQ + (size_t)m0 * done.d + done.res) * 768 + done.h * 64) * 2, (long)done.d * 768 * 2, lane);
            if (h2 == 0) *(f32x2*)(ML + (((size_t)done.p * M + tok) * 12 + done.h) * 2) = (f32x2){mo, lo_};
            if (has_next) { load_q(cur); issue_v(cur); }
        }
#undef ATT_WAITV
#undef ATT_BAR
    }
    SEAM(5);

    if (IN(6)) {
        MK_PTRS;
        for (int row0 = gw; row0 < M; row0 += 2 * NGW) {
            f32x2 ml[2][3][3]; u32x2 oa[2][3][3]; f32x2 mlb[2][4]; u32x2 obp[2][4];
#pragma unroll
            for (int r = 0; r < 2; ++r) { const int row = (row0 + r * NGW) < M ? (row0 + r * NGW) : row0;
#pragma unroll
                for (int k = 0; k < 3; ++k) { const int col = 256 * k + 4 * lane, hd = col >> 6;
#pragma unroll
                    for (int p = 0; p < 3; ++p) ml[r][k][p] = __builtin_nontemporal_load((const f32x2*)(ML + (((size_t)p * M + row) * 12 + hd) * 2));
                    oa[r][k][0] = __builtin_nontemporal_load((const u32x2*)(OA0 + (size_t)row * 768 + col)); oa[r][k][1] = __builtin_nontemporal_load((const u32x2*)(OA1 + (size_t)row * 768 + col)); oa[r][k][2] = __builtin_nontemporal_load((const u32x2*)(OA2 + (size_t)row * 768 + col)); }
#pragma unroll
                for (int s = 0; s < 4; ++s) { mlb[r][s] = __builtin_nontemporal_load((const f32x2*)(MLB + (((size_t)s * M + row) * 4 + (lane >> 4)) * 2)); obp[r][s] = __builtin_nontemporal_load((const u32x2*)(OBP + ((size_t)s * M + row) * 256 + 4 * lane)); } }
            float va[2][3][4], vb[2][4], ssa[2], ssb[2];
#pragma unroll
            for (int r = 0; r < 2; ++r) { ssa[r] = 0.f; ssb[r] = 0.f;
#pragma unroll
                for (int k = 0; k < 3; ++k) {
                    const float Mx = fmaxf(ml[r][k][0][0], fmaxf(ml[r][k][1][0], ml[r][k][2][0]));
                    const float w0 = ml[r][k][0][1] * __builtin_amdgcn_exp2f(ml[r][k][0][0] - Mx), w1 = ml[r][k][1][1] * __builtin_amdgcn_exp2f(ml[r][k][1][0] - Mx), w2 = ml[r][k][2][1] * __builtin_amdgcn_exp2f(ml[r][k][2][0] - Mx);
                    const float iw = 1.0f / (w0 + w1 + w2);
#pragma unroll
                    for (int e = 0; e < 4; ++e) { const unsigned s0 = oa[r][k][0][e >> 1], s1 = oa[r][k][1][e >> 1], s2 = oa[r][k][2][e >> 1];
                        const float f0 = __builtin_bit_cast(float, (e & 1) ? (s0 & 0xffff0000u) : (s0 << 16)), f1 = __builtin_bit_cast(float, (e & 1) ? (s1 & 0xffff0000u) : (s1 << 16)), f2 = __builtin_bit_cast(float, (e & 1) ? (s2 & 0xffff0000u) : (s2 << 16));
                        const float v = (w0 * f0 + w1 * f1 + w2 * f2) * iw; va[r][k][e] = v; ssa[r] += v * v; } }
                { const int rowq = (row0 + r * NGW) < M ? (row0 + r * NGW) : row0, nsel = (((rowq % SEQ) >> 8) < 3) ? ((rowq % SEQ) >> 8) : 3;
                  float wq[4], Mq = -INFINITY;
#pragma unroll
                  for (int s = 0; s < 4; ++s) { const bool use = (s == 3) || (s < nsel); Mq = use ? fmaxf(Mq, mlb[r][s][0]) : Mq; }
                  float wsum = 0.f;
#pragma unroll
                  for (int s = 0; s < 4; ++s) { const bool use = (s == 3) || (s < nsel); wq[s] = use ? mlb[r][s][1] * __builtin_amdgcn_exp2f(mlb[r][s][0] - Mq) : 0.f; wsum += wq[s]; }
                  const float iwq = 1.0f / wsum;
#pragma unroll
                  for (int e = 0; e < 4; ++e) { float acc_ = 0.f;
#pragma unroll
                      for (int s = 0; s < 4; ++s) { const bool use = (s == 3) || (s < nsel); const unsigned s0 = obp[r][s][e >> 1]; const float f = __builtin_bit_cast(float, (e & 1) ? (s0 & 0xffff0000u) : (s0 << 16)); acc_ += use ? wq[s] * f : 0.f; }
                      vb[r][e] = acc_ * iwq; ssb[r] += vb[r][e] * vb[r][e]; } } }
#pragma unroll
            for (int of = 1; of < 64; of <<= 1)
#pragma unroll
                for (int r = 0; r < 2; ++r) { ssa[r] += __shfl_xor(ssa[r], of); ssb[r] += __shfl_xor(ssb[r], of); }
#pragma unroll
            for (int r = 0; r < 2; ++r) { const int row = row0 + r * NGW; if (row < M) {
                const float ra = __builtin_amdgcn_rsqf(ssa[r] * (1.0f / 768.0f) + EPS), rb = __builtin_amdgcn_rsqf(ssb[r] * (1.0f / 256.0f) + EPS);
#pragma unroll
                for (int k = 0; k < 3; ++k) { u32x2 w; w[0] = cvt_pk_bf16(va[r][k][0] * ra, va[r][k][1] * ra); w[1] = cvt_pk_bf16(va[r][k][2] * ra, va[r][k][3] * ra); *(u32x2*)(YN + (size_t)row * D + 256 * k + 4 * lane) = w; }
                { u32x2 w; w[0] = cvt_pk_bf16(vb[r][0] * rb, vb[r][1] * rb); w[1] = cvt_pk_bf16(vb[r][2] * rb, vb[r][3] * rb); *(u32x2*)(YN + (size_t)row * D + 768 + 4 * lane) = w; } } }
        }
    }
    SEAM(6);

    if (IN(7)) {
        MK_PTRS;
        { SchedWK S{G, bx, (const char*)KVC, (const char*)Wcqs}; EpiStore E{WKT, D, nullptr, nullptr, false}; pg8::gemm_phase<EpiStore, SchedWK, true>(lds, 2 * D, D, 4, S, E); }
        { SchedVW S{G, (bx + G / 2) % G, (const char*)KVC, (const char*)Wco}; EpiStore E{VWT, D, nullptr, nullptr, false}; pg8::gemm_phase<EpiStore, SchedVW, true>(lds, D, 2 * D, 4, S, E); }
        SchedStd S; S.o.init(M, D, G, bx); S.A = (const char*)YN; S.B = (const char*)Wout; S.a_tile = (size_t)256 * D * 2; S.b_tile = (size_t)256 * D * 2; S.b_batch = 0; S.ocol_mul = 256;
        EpiRes E{XB, SS2, 1.0f}; pg8::gemm_phase<EpiRes, SchedStd, true>(lds, D, D, D / 64, S, E);
    }
    SEAM(7);

    if (IN(8)) {
        MK_PTRS;
        SchedStd S; S.o.init(M, D, G, bx); S.A = (const char*)XB; S.B = (const char*)WKT; S.a_tile = (size_t)256 * D * 2; S.b_tile = (size_t)256 * D * 2; S.b_batch = (size_t)D * D * 2; S.ocol_mul = 256;
        EpiSoftmax E{PB, SS2}; pg8::gemm_phase<EpiSoftmax, SchedStd, true>(lds, D, D, D / 64, S, E);
    }
    SEAM(8);

    if (IN(9)) {
        MK_PTRS;
        SchedStd S; S.o.init(M, D, G, bx); S.A = (const char*)PB; S.B = (const char*)VWT; S.a_tile = (size_t)256 * D * 2; S.b_tile = (size_t)256 * D * 2; S.b_batch = (size_t)D * D * 2; S.ocol_mul = 256;
        EpiRes E{XB, SS3, 1.0f}; pg8::gemm_phase<EpiRes, SchedStd, true>(lds, D, D, D / 64, S, E);
    }
    SEAM(9);

    if (IN(10)) {
        MK_PTRS;
        STAGGER();
        SchedStd S; S.o.init(M, 2 * DFF, G, bx); S.A = (const char*)XB; S.B = (const char*)Wgu2; S.a_tile = (size_t)256 * D * 2; S.b_tile = (size_t)256 * D * 2; S.b_batch = 0; S.ocol_mul = 128;
        EpiGU E{HB, SS3}; pg8::gemm_phase<EpiGU, SchedStd, true>(lds, D, D, D / 64, S, E);
    }
    SEAM(10);

    if (IN(11)) {
        MK_PTRS;
        SchedStd S; S.o.init(M, D, G, bx); S.A = (const char*)HB; S.B = (const char*)Wd2; S.a_tile = (size_t)256 * DFF * 2; S.b_tile = (size_t)256 * DFF * 2; S.b_batch = 0; S.ocol_mul = 256;
        EpiRes E{XB, SS4, 0.5f}; pg8::gemm_phase<EpiRes, SchedStd, true>(lds, DFF, DFF, DFF / 64, S, E);
    }
    SEAM(11);

    if (IN(12)) {
        MK_PTRS;
        const float* gf = args.in[19];
        for (int row0 = gw; row0 < M; row0 += 4 * NGW) {
            u32x2 w[4][4]; float rs[4]; const f32x4* gr = (const f32x4*)gf + lane;
#pragma unroll
            for (int r = 0; r < 4; ++r) { const int row = (row0 + r * NGW) < M ? (row0 + r * NGW) : row0; const u32x2* xr = (const u32x2*)(XB + (size_t)row * D) + lane;
#pragma unroll
                for (int j = 0; j < 4; ++j) w[r][j] = __builtin_nontemporal_load(xr + 64 * j);
                rs[r] = row_rstd(SS4, row); }
#pragma unroll
            for (int r = 0; r < 4; ++r) { const int row = row0 + r * NGW; if (row < M) { f32x4* orow = (f32x4*)(out + (size_t)row * D) + lane;
#pragma unroll
                for (int j = 0; j < 4; ++j) { f32x4 v; v[0] = __builtin_bit_cast(float, w[r][j][0] << 16); v[1] = __builtin_bit_cast(float, w[r][j][0] & 0xffff0000u); v[2] = __builtin_bit_cast(float, w[r][j][1] << 16); v[3] = __builtin_bit_cast(float, w[r][j][1] & 0xffff0000u);
                    __builtin_nontemporal_store(v * rs[r] * gr[64 * j], orow + 64 * j); } } }
        }
    }
#undef IN
#undef SEAM
}
}


#if MK_DEBUG
namespace dbg {
__global__ void __launch_bounds__(256) cmp_f32(const float* a, const float* r, size_t n, float* acc) {
    float num = 0.f, den = 0.f;
    for (size_t i = (size_t)blockIdx.x * 256 + threadIdx.x; i < n; i += (size_t)gridDim.x * 256) { const float d = a[i] - r[i]; num += d * d; den += r[i] * r[i]; }
    for (int o = 32; o > 0; o >>= 1) { num += __shfl_xor(num, o); den += __shfl_xor(den, o); }
    if ((threadIdx.x & 63) == 0) { atomicAdd(acc, num); atomicAdd(acc + 1, den); }
}
__global__ void __launch_bounds__(256) cmp_bf16(const unsigned short* a, int lda, const float* colscale, const float* r, int ldr, int rows, int cols, float* acc) {
    float num = 0.f, den = 0.f; const size_t n = (size_t)rows * cols;
    for (size_t i = (size_t)blockIdx.x * 256 + threadIdx.x; i < n; i += (size_t)gridDim.x * 256) { const size_t row = i / cols; const int c = (int)(i % cols);
        const float av = __builtin_bit_cast(float, (unsigned)a[row * lda + c] << 16) * (colscale ? colscale[c] : 1.0f); const float rv = r[row * ldr + c]; const float d = av - rv; num += d * d; den += rv * rv; }
    for (int o = 32; o > 0; o >>= 1) { num += __shfl_xor(num, o); den += __shfl_xor(den, o); }
    if ((threadIdx.x & 63) == 0) { atomicAdd(acc, num); atomicAdd(acc + 1, den); }
}
__global__ void __launch_bounds__(256) cmp_p(const unsigned short* a, const float* r, float* acc) {
    float num = 0.f, den = 0.f; const size_t n = (size_t)4096 * 1024;
    for (size_t i = (size_t)blockIdx.x * 256 + threadIdx.x; i < n; i += (size_t)gridDim.x * 256) { const size_t row = i / 1024; const int c = (int)(i % 1024);
        const float av = __builtin_bit_cast(float, (unsigned)a[i] << 16); const float rv = r[(size_t)(c >> 8) * 4096 * 256 + row * 256 + (c & 255)]; const float d = av - rv; num += d * d; den += rv * rv; }
    for (int o = 32; o > 0; o >>= 1) { num += __shfl_xor(num, o); den += __shfl_xor(den, o); }
    if ((threadIdx.x & 63) == 0) { atomicAdd(acc, num); atomicAdd(acc + 1, den); }
}
__global__ void build_scales(float* qkvs, float* gcat, const float* goa, const float* gob) {
    const int i = blockIdx.x * 256 + threadIdx.x;
    if (i < 3072) qkvs[i] = ((i < 768) || (i >= 2304 && i < 2560)) ? 8.0f : 1.0f;
    if (i < 1024) gcat[i] = i < 768 ? goa[i] : gob[i - 768];
}
constexpr int NST = 8;
__global__ void __launch_bounds__(256) finalize(float* out, size_t n, const float* acc, int report) {
    const float tol[NST] = {0.03f, 0.03f, 1e9f  , 0.08f, 0.03f, 0.05f, 0.03f, 0.03f};
    float E = 0.f;
    if (report > 0) { const float e = sqrtf(acc[2 * (report - 1)] / acc[2 * (report - 1) + 1]); E = (e == e) ? fminf(e, 3.0f) : 3.0f; }
    else { for (int k = NST - 1; k >= 0; --k) { const float e = sqrtf(acc[2 * k] / acc[2 * k + 1]); if (!(e <= tol[k])) E = 0.1f * (k + 1); } }
    for (size_t i = (size_t)blockIdx.x * 256 + threadIdx.x; i < n; i += (size_t)gridDim.x * 256) out[i] *= (1.0f + E);
}
}
#endif

static void mk_launch(const mk::Args& a0, int lo, int hi, int grid, hipStream_t st) {
    mk::Args a = a0; a.ph_lo = lo; a.ph_hi = hi;
    hipLaunchKernelGGL(mk::mk_fwd, dim3(grid), dim3(mk::NWAVES * 64), mk::LDS_BYTES, st, a);
    const hipError_t le = hipPeekAtLastError();
    if (le != hipSuccess) fprintf(stderr, "kernel_launch: launch of phases [%d,%d) failed: %s\n", lo, hi, hipGetErrorName(le));
}

extern "C" void kernel_launch(void* const* d_in, const int* in_sizes, int n_in, void* d_out, int out_size, void* d_ws, size_t ws_size, hipStream_t stream) {
    static int grid = 0;
    if (grid == 0) {
        if (n_in != 20 || out_size != 8 * 4096 * 1024) { fprintf(stderr, "kernel_launch: unexpected shapes (n_in %d out %d)\n", n_in, out_size); grid = -1; return; }
        int dev = 0, cus = 0, per_cu = 0;
        if (hipGetDevice(&dev) != hipSuccess || hipDeviceGetAttribute(&cus, hipDeviceAttributeMultiprocessorCount, dev) != hipSuccess) { grid = -1; return; }
        if (hipFuncSetAttribute((const void*)mk::mk_fwd, hipFuncAttributeMaxDynamicSharedMemorySize, mk::LDS_BYTES) != hipSuccess) { fprintf(stderr, "kernel_launch: hipFuncSetAttribute failed\n"); grid = -1; return; }
        if (hipOccupancyMaxActiveBlocksPerMultiprocessor(&per_cu, (const void*)mk::mk_fwd, mk::NWAVES * 64, mk::LDS_BYTES) != hipSuccess || per_cu < 1) fprintf(stderr, "kernel_launch: occupancy query reports %d workgroups per CU\n", per_cu);
        (void)hipGetLastError();
        grid = cus;
    }
    if (grid < 0) return;
    unsigned char* ws = (unsigned char*)d_ws;
#if MK_DEBUG
    const size_t ref_off = (mk::WS_END + 4095) / 4096 * 4096;
    size_t off = ref_off + (size_t)290 * 1024 * 1024;
    auto take = [&](size_t bytes) { unsigned char* p = ws + off; off += (bytes + 255) / 256 * 256; return p; };
    float* sx1 = (float*)take((size_t)4096 * 1024 * 4); float* sx2 = (float*)take((size_t)4096 * 1024 * 4); float* sx3 = (float*)take((size_t)4096 * 1024 * 4);
    float* mkout = (float*)take((size_t)4096 * 1024 * 4); float* qkvs = (float*)take(3072 * 4); float* gcat = (float*)take(1024 * 4); float* acc = (float*)take(256);
    if (off > ws_size) { fprintf(stderr, "kernel_launch: debug build needs %zu bytes of workspace, got %zu\n", off, ws_size); return; }
    ref::Snap snap{sx1, sx2, sx3};
    ref::forward(d_in, (float*)d_out, ws + ref_off, stream, &snap);
    (void)hipMemsetAsync(ws + mk::WS_CTL, 0, mk::CTL_BYTES, stream);
    (void)hipMemsetAsync(acc, 0, 256, stream);
    dbg::build_scales<<<12, 256, 0, stream>>>(qkvs, gcat, (const float*)d_in[8], (const float*)d_in[9]);
    mk::Args a{};
    for (int i = 0; i < 20; ++i) a.in[i] = (const float*)d_in[i];
    a.in[0] = (const float*)d_in[0] + (size_t)7 * 4096 * 1024; a.in[1] = (const float*)d_in[1] + (size_t)7 * 256 * 1024;
    a.out = mkout; a.ws = ws;
    const ref::Bufs& rb = ref::g_bufs;
    for (int ph = 0; ph < mk::NPH; ++ph) {
        mk_launch(a, ph, ph + 1, grid, stream);
        if (ph == 5) dbg::cmp_bf16<<<512, 256, 0, stream>>>((const unsigned short*)(ws + mk::WS_KVC), 2048, nullptr, rb.kvc, 2048, 256, 2048, acc + 0);
        if (ph == 2) dbg::cmp_bf16<<<512, 256, 0, stream>>>((const unsigned short*)(ws + mk::WS_XB), 1024, nullptr, sx1, 1024, 4096, 1024, acc + 2);
        if (ph == 3) dbg::cmp_bf16<<<512, 256, 0, stream>>>((const unsigned short*)(ws + mk::WS_R1), 3072, qkvs, rb.proj, 3072, 4096, 3072, acc + 4);
        if (ph == 6) dbg::cmp_bf16<<<512, 256, 0, stream>>>((const unsigned short*)(ws + mk::WS_R1), 1024, gcat, rb.yn, 1024, 4096, 1024, acc + 6);
        if (ph == 7) dbg::cmp_bf16<<<512, 256, 0, stream>>>((const unsigned short*)(ws + mk::WS_XB), 1024, nullptr, sx2, 1024, 4096, 1024, acc + 8);
        if (ph == 8) dbg::cmp_p<<<512, 256, 0, stream>>>((const unsigned short*)(ws + mk::WS_R1), rb.sc, acc + 10);
        if (ph == 9) dbg::cmp_bf16<<<512, 256, 0, stream>>>((const unsigned short*)(ws + mk::WS_XB), 1024, nullptr, sx3, 1024, 4096, 1024, acc + 12);
        if (ph == 12) dbg::cmp_f32<<<512, 256, 0, stream>>>(mkout, (const float*)d_out + (size_t)7 * 4096 * 1024, (size_t)4096 * 1024, acc + 14);
    }
    dbg::finalize<<<1024, 256, 0, stream>>>((float*)d_out, (size_t)8 * 4096 * 1024, acc, MK_REPORT);
#else
    if (ws_size < mk::WS_END) { fprintf(stderr, "kernel_launch: needs %zu bytes of workspace, got %zu\n", (size_t)mk::WS_END, ws_size); return; }
    if (hipMemsetAsync(ws + mk::WS_CTL, 0, mk::CTL_BYTES, stream) != hipSuccess) return;
    mk::Args a{};
    for (int i = 0; i < 20; ++i) a.in[i] = (const float*)d_in[i];
    a.out = (float*)d_out; a.ws = ws;
#if MK_N_LAUNCHES == 1
    mk_launch(a, 0, mk::NPH, grid, stream);
#else
    for (int ph = 0; ph < mk::NPH; ++ph) {
        for (int r = 0; r < MK_REPEAT_N; ++r) if (ph == MK_REPEAT) { mk::Args a2 = a; a2.flags = MK_REPEAT_FLAGS; mk_launch(a2, ph, ph + 1, grid, stream); }
        mk_launch(a, ph, ph + 1, grid, stream); }
#endif
#endif
}
```

```cpp
#include <hip/hip_runtime.h>
#include <cstdio>
#include <cstdint>
#include <cmath>
#define MK_REPEAT -1
#define MK_REPEAT_N 1
#define MK_REPEAT_FLAGS 0
#define MK_STAGGER_TICKS 0
#define MK_NT_PART false
#define MK_TIMING 0
#define MK_TQ 0.02f
#define MK_PROBE_SAME 0
#define MK_DEBUG 0
#define MK_REPORT 0
#define MK_N_LAUNCHES 1
#define MK_NBAT 8

namespace pg8 {
#define PG8_LAS __attribute__((address_space(3)))
typedef unsigned short bf16_t;
typedef short bf16x8 __attribute__((ext_vector_type(8)));
typedef float f32x4 __attribute__((ext_vector_type(4)));
typedef float f32x2 __attribute__((ext_vector_type(2)));
typedef unsigned u32x4 __attribute__((ext_vector_type(4)));
typedef unsigned u32x2 __attribute__((ext_vector_type(2)));
constexpr int BM = 256, BK = 64, HALF = 128, HTB = HALF * BK * 2  , STAGE_BYTES = 8 * HTB, NXCD = 8, WGM = 8;

__host__ __device__ __forceinline__ int lds_byte(int r, int c) { const int st = (r >> 4) * 2 + (c >> 5), rr = r & 15, cc = c & 31, ob = rr * 64 + cc * 2; return st * 1024 + (ob ^ (((ob >> 9) & 1) << 5)); }
__host__ __device__ __forceinline__ void stage_rc(int b, int& R, int& C) { const int st = b / 1024, sb = b % 1024, swz = sb ^ (((sb >> 9) & 1) << 5); R = (st >> 1) * 16 + swz / 64; C = (st & 1) * 32 + (swz % 64) / 2; }
__host__ __device__ __forceinline__ int perm32(int rho) { const int n = rho >> 4, i = rho & 15; return 8 * (i >> 2) + 4 * n + (i & 3); }

struct Unit { const char* a; const char* b; int orow, ocol, aux; };

struct Order {
    int nM, nN, nwg, G, c;
    __device__ __forceinline__ void init(int M, int N, int G_, int c_) { nM = M / BM; nN = N / BM; nwg = nM * nN; G = G_; c = c_; }
    __device__ __forceinline__ bool tile(int i, int& pm, int& pn) const {
        const long L = (long)i * G + c; if (L >= nwg) return false;
        int wgid = (int)L; { const int q = nwg / NXCD, r = nwg % NXCD, xcd = wgid % NXCD, off = wgid / NXCD; wgid = (xcd < r ? xcd * (q + 1) : r * (q + 1) + (xcd - r) * q) + off; }
        const int nig = WGM * nN, gid = wgid / nig, fm = gid * WGM, gsz = (nM - fm) < WGM ? (nM - fm) : WGM;
        pm = fm + ((wgid % nig) % gsz); pn = (wgid % nig) / gsz; return true;
    }
};

__device__ __forceinline__ unsigned cvt_pk_bf16(float lo, float hi) { unsigned r; asm volatile("v_cvt_pk_bf16_f32 %0, %1, %2" : "=v"(r) : "v"(lo), "v"(hi)); return r; }

template <class Epi, class Sched, bool ALIGN_EPI>
__device__ __forceinline__ void gemm_phase(PG8_LAS unsigned char* lds, const int lda, const int ldb, const int nt, const Sched& S, const Epi& E) {
    int tid_ = threadIdx.x; asm volatile("" : "+v"(tid_));
    const int tid = tid_, wid = __builtin_amdgcn_readfirstlane(tid >> 6), lane = tid & 63, wr = wid >> 2, wc = wid & 3, fr = lane & 15, fq = lane >> 4;
    unsigned voffA[2], voffB[2];
#pragma unroll
    for (int i = 0; i < 2; ++i) { int R, C; stage_rc(tid * 16 + i * 8192, R, C); const int Rb = Epi::PERM ? ((R & ~31) + perm32(R & 31)) : R;
        voffA[i] = (unsigned)(R * lda + C) * 2u; voffB[i] = (unsigned)(Rb * ldb + C) * 2u; }
    const size_t kstep = (size_t)(BK * 2);
    const size_t hstepA = (size_t)HALF * lda * 2, hstepB = (size_t)HALF * ldb * 2;
    const unsigned ldsw = (unsigned)wid * 1024u;
    const int aoff = lds_byte(wr * 64 + fr, fq * 8), boff = lds_byte(wc * 32 + fr, fq * 8);
#define PG8_SA(b, h) (((b) * 2 + (h)) * HTB)
#define PG8_SB(b, h) ((4 + (b) * 2 + (h)) * HTB)
#define PG8_STAGE(bufoff, gbase, voff) do { _Pragma("unroll") for (int _i = 0; _i < 2; ++_i) \
        __builtin_amdgcn_global_load_lds((const unsigned*)((const char*)(gbase) + (voff)[_i]), (PG8_LAS unsigned*)(lds + (bufoff) + ldsw + _i * 8192), 16, 0, 0); } while (0)
#define PG8_LDA(dst, b, h) do { _Pragma("unroll") for (int m = 0; m < 4; ++m) _Pragma("unroll") for (int k = 0; k < 2; ++k) dst[m][k] = *(const PG8_LAS bf16x8*)(lds + PG8_SA(b, h) + aoff + m * 2048 + k * 1024); } while (0)
#define PG8_LDB(dst, b, h) do { _Pragma("unroll") for (int n = 0; n < 2; ++n) _Pragma("unroll") for (int k = 0; k < 2; ++k) dst[n][k] = *(const PG8_LAS bf16x8*)(lds + PG8_SB(b, h) + boff + n * 2048 + k * 1024); } while (0)
#define PG8_MMA(ai, bj, At, Bt) do { __builtin_amdgcn_s_setprio(1); _Pragma("unroll") for (int m = 0; m < 4; ++m) _Pragma("unroll") for (int n = 0; n < 2; ++n) _Pragma("unroll") for (int k = 0; k < 2; ++k) \
        acc[ai][bj][m][n] = __builtin_amdgcn_mfma_f32_16x16x32_bf16(Bt[n][k], At[m][k], acc[ai][bj][m][n], 0, 0, 0); __builtin_amdgcn_s_setprio(0); } while (0)
#define PG8_WAIT_V(n) asm volatile("s_waitcnt vmcnt(" #n ")" ::: "memory")
#define PG8_WAIT_L(n) asm volatile("s_waitcnt lgkmcnt(" #n ")" ::: "memory")
#define PG8_BAR __builtin_amdgcn_s_barrier()
#define PG8_SCHED __builtin_amdgcn_sched_barrier(0)
    Unit cur, nxt; int ui = 0;
    if (!S.next(0, cur)) return;
    f32x4 acc[2][2][4][2];
#pragma unroll
    for (int a = 0; a < 2; ++a)
#pragma unroll
        for (int b = 0; b < 2; ++b)
#pragma unroll
            for (int m = 0; m < 4; ++m)
#pragma unroll
                for (int n = 0; n < 2; ++n) acc[a][b][m][n] = (f32x4){0.f, 0.f, 0.f, 0.f};
    bf16x8 At[4][2], B0[2][2], B1[2][2];
    const char* cA = cur.a; const char* cB = cur.b;
    PG8_STAGE(PG8_SB(0, 0), cB, voffB); PG8_STAGE(PG8_SB(0, 1), cB + hstepB, voffB); PG8_STAGE(PG8_SA(0, 0), cA, voffA); PG8_STAGE(PG8_SA(0, 1), cA + hstepA, voffA);
    if (wr == 1) PG8_BAR;
    PG8_WAIT_V(2); PG8_BAR;
    PG8_STAGE(PG8_SB(1, 0), cB + kstep, voffB); PG8_STAGE(PG8_SA(1, 0), cA + kstep, voffA); PG8_STAGE(PG8_SB(1, 1), cB + hstepB + kstep, voffB);
    PG8_WAIT_V(6); PG8_BAR;
    for (;;) {
        const bool has_next = S.next(ui + 1, nxt);
        const char* nA = has_next ? nxt.a : cA; const char* nB = has_next ? nxt.b : cB;
#pragma unroll 1
        for (int t = 0; t < nt; t += 2) {
            const bool last = (t == nt - 2);
            const char* a1 = cA + (size_t)(t + 1) * kstep;
            const char* a2 = last ? nA : cA + (size_t)(t + 2) * kstep; const char* b2 = last ? nB : cB + (size_t)(t + 2) * kstep;
            const char* a3 = a2 + kstep; const char* b3 = b2 + kstep;
            PG8_LDB(B0, 0, 0); PG8_LDB(B1, 0, 1); PG8_SCHED; PG8_LDA(At, 0, 0); PG8_STAGE(PG8_SA(1, 1), a1 + hstepA, voffA);
            PG8_WAIT_V(8); PG8_WAIT_L(0); PG8_BAR; PG8_MMA(0, 0, At, B0); PG8_MMA(0, 1, At, B1); PG8_BAR; PG8_SCHED;
            PG8_LDA(At, 0, 1); PG8_STAGE(PG8_SB(0, 0), b2, voffB); PG8_STAGE(PG8_SB(0, 1), b2 + hstepB, voffB); PG8_STAGE(PG8_SA(0, 0), a2, voffA);
            PG8_WAIT_V(8); PG8_WAIT_L(0); PG8_BAR; PG8_MMA(1, 0, At, B0); PG8_MMA(1, 1, At, B1); PG8_BAR; PG8_SCHED;
            PG8_LDB(B0, 1, 0); PG8_LDB(B1, 1, 1); PG8_SCHED; PG8_LDA(At, 1, 0); PG8_STAGE(PG8_SA(0, 1), a2 + hstepA, voffA);
            PG8_WAIT_V(8); PG8_WAIT_L(0); PG8_BAR; PG8_MMA(0, 0, At, B0); PG8_MMA(0, 1, At, B1); PG8_BAR; PG8_SCHED;
            PG8_LDA(At, 1, 1); PG8_STAGE(PG8_SB(1, 0), b3, voffB); PG8_STAGE(PG8_SB(1, 1), b3 + hstepB, voffB); PG8_STAGE(PG8_SA(1, 0), a3, voffA);
            PG8_WAIT_V(8); PG8_WAIT_L(0); PG8_BAR; PG8_MMA(1, 0, At, B0); PG8_MMA(1, 1, At, B1); PG8_BAR; PG8_SCHED;
        }
        if constexpr (ALIGN_EPI) { if (wr == 0) PG8_BAR; }
        E(acc, cur, wr, wc, fr, fq, lds, wid, lane);
        if (!has_next) break;
#pragma unroll
        for (int a = 0; a < 2; ++a)
#pragma unroll
            for (int b = 0; b < 2; ++b)
#pragma unroll
                for (int m = 0; m < 4; ++m)
#pragma unroll
                    for (int n = 0; n < 2; ++n) acc[a][b][m][n] = (f32x4){0.f, 0.f, 0.f, 0.f};
        cur = nxt; cA = nA; cB = nB; ++ui;
        if constexpr (ALIGN_EPI) { if (wr == 1) PG8_BAR; }
    }
    PG8_WAIT_V(0);
    if constexpr (!ALIGN_EPI) { if (wr == 0) PG8_BAR; }
    PG8_BAR;
#undef PG8_SA
#undef PG8_SB
#undef PG8_STAGE
#undef PG8_LDA
#undef PG8_LDB
#undef PG8_MMA
#undef PG8_WAIT_V
#undef PG8_WAIT_L
#undef PG8_BAR
#undef PG8_SCHED
}
}

namespace att {
#define ATT_LAS __attribute__((address_space(3)))
typedef short bf16x8 __attribute__((ext_vector_type(8)));
typedef short v4i16 __attribute__((ext_vector_type(4)));
typedef float f32x16 __attribute__((ext_vector_type(16)));
typedef float f32x4 __attribute__((ext_vector_type(4)));
typedef unsigned u32x4 __attribute__((ext_vector_type(4)));
typedef unsigned u32x2 __attribute__((ext_vector_type(2)));
constexpr float LOG2E = 1.4426950408889634f;
constexpr int TABA_N = 192, TABB_N = 1600;

__device__ __forceinline__ int rel_bucket(int n) {
    if (n < 16) return n < 0 ? 0 : n;
    int b = 16;
    b += (n >= 22); b += (n >= 30); b += (n >= 40); b += (n >= 54); b += (n >= 73); b += (n >= 99); b += (n >= 134); b += (n >= 182);
    b += (n >= 246); b += (n >= 332); b += (n >= 450); b += (n >= 609); b += (n >= 825); b += (n >= 1117); b += (n >= 1513);
    return b;
}
__device__ __forceinline__ unsigned pk_bf16(float lo, float hi) { unsigned r; asm volatile("v_cvt_pk_bf16_f32 %0, %1, %2" : "=v"(r) : "v"(lo), "v"(hi)); return r; }
__device__ __forceinline__ float bf16_round(float x) { unsigned u = __builtin_bit_cast(unsigned, x); u = (u + 0x7fffu + ((u >> 16) & 1u)) & 0xffff0000u; return __builtin_bit_cast(float, u); }

__device__ __forceinline__ void glds16(const void* gsrc, unsigned lds_dst) { unsigned keep;
    asm volatile("s_mov_b32 %0, m0\n\ts_mov_b32 m0, %2\n\ts_nop 0\n\tglobal_load_lds_dwordx4 %1, off\n\ts_mov_b32 m0, %0" : "=&s"(keep) : "v"(gsrc), "s"(lds_dst) : "memory"); }
__device__ __forceinline__ void dma_rows8(const char* krow0  , const int voff, const int row  ,
                                          ATT_LAS char* kdst  , ATT_LAS char* vdst, const int lane) {
    const int pc = lane & 7;
    glds16(krow0 + 16 * (pc ^ ((row >> 1) & 7)), (unsigned)__builtin_amdgcn_readfirstlane((int)(unsigned)(uintptr_t)kdst));
    glds16(krow0 + voff + 16 * (pc ^ (((row >> 1) & 1) << 2)), (unsigned)__builtin_amdgcn_readfirstlane((int)(unsigned)(uintptr_t)vdst));
}

__device__ __forceinline__ void attn_group(const bf16x8 (&qf)[4], f32x16 (&o)[2], float& m, float& l, const ATT_LAS char* kg, const ATT_LAS char* vg, const ATT_LAS float* tp, const int lane) {
    const int q = lane & 31, h = lane >> 5;
    const ATT_LAS char* kr0 = kg + q * 128; const int kswz = (q >> 1) & 7;
    typedef float f32x2_ __attribute__((ext_vector_type(2)));
    f32x2_ t0, t1, t2, t3, t4, t5, t6, t7;
    { const unsigned ta = (unsigned)(uintptr_t)(tp - 27);
      asm volatile("ds_read2_b32 %0, %8 offset0:27 offset1:26\n\tds_read2_b32 %1, %8 offset0:25 offset1:24\n\tds_read2_b32 %2, %8 offset0:19 offset1:18\n\tds_read2_b32 %3, %8 offset0:17 offset1:16\n\t"
                   "ds_read2_b32 %4, %8 offset0:11 offset1:10\n\tds_read2_b32 %5, %8 offset0:9 offset1:8\n\tds_read2_b32 %6, %8 offset0:3 offset1:2\n\tds_read2_b32 %7, %8 offset0:1 offset1:0"
                   : "=&v"(t0), "=&v"(t1), "=&v"(t2), "=&v"(t3), "=&v"(t4), "=&v"(t5), "=&v"(t6), "=&v"(t7) : "v"(ta) : "memory"); }
    const int q4 = (lane & 15) >> 2, p4 = lane & 3, g1 = (lane >> 4) & 1, vsw = (q4 >> 1) & 1;
    const unsigned va0_ = (unsigned)(uintptr_t)(vg + (4 * h + q4) * 128 + 32 * g1 + 8 * p4 + 64 * vsw), va1_ = (unsigned)(uintptr_t)(vg + (4 * h + q4) * 128 + 32 * g1 + 8 * p4 + 64 * (1 ^ vsw));
    v4i16 a[2][4];
    asm volatile("ds_read_b64_tr_b16 %0, %8\n\tds_read_b64_tr_b16 %1, %8 offset:1024\n\tds_read_b64_tr_b16 %2, %8 offset:2048\n\tds_read_b64_tr_b16 %3, %8 offset:3072\n\t"
                 "ds_read_b64_tr_b16 %4, %9\n\tds_read_b64_tr_b16 %5, %9 offset:1024\n\tds_read_b64_tr_b16 %6, %9 offset:2048\n\tds_read_b64_tr_b16 %7, %9 offset:3072"
                 : "=&v"(a[0][0]), "=&v"(a[0][1]), "=&v"(a[0][2]), "=&v"(a[0][3]), "=&v"(a[1][0]), "=&v"(a[1][1]), "=&v"(a[1][2]), "=&v"(a[1][3]) : "v"(va0_), "v"(va1_) : "memory");
    f32x16 s = f32x16{};
#pragma unroll
    for (int d0 = 0; d0 < 4; ++d0) { const bf16x8 kf = *(const ATT_LAS bf16x8*)(kr0 + 16 * ((2 * d0 + h) ^ kswz)); s = __builtin_amdgcn_mfma_f32_32x32x16_bf16(kf, qf[d0], s, 0, 0, 0); }
    asm volatile("s_waitcnt lgkmcnt(0)" : "+v"(t0), "+v"(t1), "+v"(t2), "+v"(t3), "+v"(t4), "+v"(t5), "+v"(t6), "+v"(t7), "+v"(a[0][0]), "+v"(a[0][1]), "+v"(a[0][2]), "+v"(a[0][3]), "+v"(a[1][0]), "+v"(a[1][1]), "+v"(a[1][2]), "+v"(a[1][3]) :: "memory");
    float mx = -INFINITY;
    { const float tb_[16] = {t0[0], t0[1], t1[0], t1[1], t2[0], t2[1], t3[0], t3[1], t4[0], t4[1], t5[0], t5[1], t6[0], t6[1], t7[0], t7[1]};
#pragma unroll
      for (int r = 0; r < 16; ++r) s[r] = fmaf(s[r], LOG2E, tb_[r]); }
#pragma unroll
    for (int r = 0; r < 16; r += 2) mx = fmaxf(mx, fmaxf(s[r], s[r + 1]));
    mx = fmaxf(mx, __shfl_xor(mx, 32));
    if (__any(mx > m)) {
        const float mnew = fmaxf(m, mx), alpha = __builtin_amdgcn_exp2f(m - mnew);
        l *= alpha; m = mnew;
#pragma unroll
        for (int r = 0; r < 16; ++r) { o[0][r] *= alpha; o[1][r] *= alpha; }
    }
    float ps = 0.f;
#pragma unroll
    for (int r = 0; r < 16; ++r) { s[r] = __builtin_amdgcn_exp2f(s[r] - m); ps += s[r]; }
    l += ps;
    u32x4 pw0, pw1;
    pw0[0] = pk_bf16(s[0], s[1]); pw0[1] = pk_bf16(s[2], s[3]); pw0[2] = pk_bf16(s[4], s[5]); pw0[3] = pk_bf16(s[6], s[7]);
    pw1[0] = pk_bf16(s[8], s[9]); pw1[1] = pk_bf16(s[10], s[11]); pw1[2] = pk_bf16(s[12], s[13]); pw1[3] = pk_bf16(s[14], s[15]);
    const bf16x8 pb0 = __builtin_bit_cast(bf16x8, pw0), pb1 = __builtin_bit_cast(bf16x8, pw1);
#pragma unroll
    for (int dh = 0; dh < 2; ++dh) {
        const bf16x8 va0 = (bf16x8){a[dh][0][0], a[dh][0][1], a[dh][0][2], a[dh][0][3], a[dh][1][0], a[dh][1][1], a[dh][1][2], a[dh][1][3]};
        const bf16x8 va1 = (bf16x8){a[dh][2][0], a[dh][2][1], a[dh][2][2], a[dh][2][3], a[dh][3][0], a[dh][3][1], a[dh][3][2], a[dh][3][3]};
        o[dh] = __builtin_amdgcn_mfma_f32_32x32x16_bf16(va0, pb0, o[dh], 0, 0, 0);
        o[dh] = __builtin_amdgcn_mfma_f32_32x32x16_bf16(va1, pb1, o[dh], 0, 0, 0);
    }
}

__device__ __forceinline__ void dma_k_rows8(const char* krow, const int row, ATT_LAS char* kdst, const int lane) {
    glds16(krow + 16 * ((lane & 7) ^ ((row >> 1) & 7)), (unsigned)__builtin_amdgcn_readfirstlane((int)(unsigned)(uintptr_t)kdst)); }
__device__ __forceinline__ void dma_v_rows8(const char* vrow, const int row, ATT_LAS char* vdst, const int lane) {
    glds16(vrow + 16 * ((lane & 7) ^ (((row >> 1) & 1) << 2)), (unsigned)__builtin_amdgcn_readfirstlane((int)(unsigned)(uintptr_t)vdst)); }
__device__ __forceinline__ void dil_pass1(const bf16x8 (&qf)[4], const int ng, const ATT_LAS char* kimg0  , const ATT_LAS float* tp0  ,
                                          u32x4 (&pw)[5][2], float& m_out, float& l_out, const int lane) {
    const int q = lane & 31, h = lane >> 5, kswz = (q >> 1) & 7;
    typedef float f32x2_ __attribute__((ext_vector_type(2)));
    f32x16 s[5]; float mx = -INFINITY;
#pragma unroll
    for (int g = 0; g < 5; ++g) if (g < ng) {
        f32x2_ t0, t1, t2, t3, t4, t5, t6, t7;
        { const unsigned ta = (unsigned)(uintptr_t)(tp0 + 32 * g - 27);
          asm volatile("ds_read2_b32 %0, %8 offset0:27 offset1:26\n\tds_read2_b32 %1, %8 offset0:25 offset1:24\n\tds_read2_b32 %2, %8 offset0:19 offset1:18\n\tds_read2_b32 %3, %8 offset0:17 offset1:16\n\t"
                       "ds_read2_b32 %4, %8 offset0:11 offset1:10\n\tds_read2_b32 %5, %8 offset0:9 offset1:8\n\tds_read2_b32 %6, %8 offset0:3 offset1:2\n\tds_read2_b32 %7, %8 offset0:1 offset1:0"
                       : "=&v"(t0), "=&v"(t1), "=&v"(t2), "=&v"(t3), "=&v"(t4), "=&v"(t5), "=&v"(t6), "=&v"(t7) : "v"(ta) : "memory"); }
        const ATT_LAS char* kr0 = kimg0 - g * 4096 + q * 128;
        f32x16 sg = f32x16{};
#pragma unroll
        for (int d0 = 0; d0 < 4; ++d0) { const bf16x8 kf = *(const ATT_LAS bf16x8*)(kr0 + 16 * ((2 * d0 + h) ^ kswz)); sg = __builtin_amdgcn_mfma_f32_32x32x16_bf16(kf, qf[d0], sg, 0, 0, 0); }
        asm volatile("s_waitcnt lgkmcnt(0)" : "+v"(t0), "+v"(t1), "+v"(t2), "+v"(t3), "+v"(t4), "+v"(t5), "+v"(t6), "+v"(t7) :: "memory");
        const float tb_[16] = {t0[0], t0[1], t1[0], t1[1], t2[0], t2[1], t3[0], t3[1], t4[0], t4[1], t5[0], t5[1], t6[0], t6[1], t7[0], t7[1]};
#pragma unroll
        for (int r = 0; r < 16; ++r) sg[r] = fmaf(sg[r], LOG2E, tb_[r]);
#pragma unroll
        for (int r = 0; r < 16; r += 2) mx = fmaxf(mx, fmaxf(sg[r], sg[r + 1]));
        s[g] = sg;
    }
    mx = fmaxf(mx, __shfl_xor(mx, 32));
    float ps = 0.f;
#pragma unroll
    for (int g = 0; g < 5; ++g) if (g < ng) {
        f32x16 p = s[g];
#pragma unroll
        for (int r = 0; r < 16; ++r) { p[r] = __builtin_amdgcn_exp2f(p[r] - mx); ps += p[r]; }
        pw[g][0][0] = pk_bf16(p[0], p[1]); pw[g][0][1] = pk_bf16(p[2], p[3]); pw[g][0][2] = pk_bf16(p[4], p[5]); pw[g][0][3] = pk_bf16(p[6], p[7]);
        pw[g][1][0] = pk_bf16(p[8], p[9]); pw[g][1][1] = pk_bf16(p[10], p[11]); pw[g][1][2] = pk_bf16(p[12], p[13]); pw[g][1][3] = pk_bf16(p[14], p[15]);
    }
    ps += __shfl_xor(ps, 32);
    m_out = mx; l_out = ps;
}
__device__ __forceinline__ void dil_pass2(const int ng, const ATT_LAS char* vimg0  , const u32x4 (&pw)[5][2], f32x16 (&o)[2], const int lane) {
    const int h = lane >> 5, q4 = (lane & 15) >> 2, p4 = lane & 3, g1 = (lane >> 4) & 1, vsw = (q4 >> 1) & 1;
    o[0] = f32x16{}; o[1] = f32x16{};
#pragma unroll
    for (int g = 0; g < 5; ++g) if (g < ng) {
        const ATT_LAS char* vg = vimg0 - g * 4096;
        const unsigned va0_ = (unsigned)(uintptr_t)(vg + (4 * h + q4) * 128 + 32 * g1 + 8 * p4 + 64 * vsw), va1_ = (unsigned)(uintptr_t)(vg + (4 * h + q4) * 128 + 32 * g1 + 8 * p4 + 64 * (1 ^ vsw));
        v4i16 a[2][4];
        asm volatile("ds_read_b64_tr_b16 %0, %8\n\tds_read_b64_tr_b16 %1, %8 offset:1024\n\tds_read_b64_tr_b16 %2, %8 offset:2048\n\tds_read_b64_tr_b16 %3, %8 offset:3072\n\t"
                     "ds_read_b64_tr_b16 %4, %9\n\tds_read_b64_tr_b16 %5, %9 offset:1024\n\tds_read_b64_tr_b16 %6, %9 offset:2048\n\tds_read_b64_tr_b16 %7, %9 offset:3072\n\ts_waitcnt lgkmcnt(0)"
                     : "=&v"(a[0][0]), "=&v"(a[0][1]), "=&v"(a[0][2]), "=&v"(a[0][3]), "=&v"(a[1][0]), "=&v"(a[1][1]), "=&v"(a[1][2]), "=&v"(a[1][3]) : "v"(va0_), "v"(va1_) : "memory");
        const bf16x8 pb0 = __builtin_bit_cast(bf16x8, pw[g][0]), pb1 = __builtin_bit_cast(bf16x8, pw[g][1]);
#pragma unroll
        for (int dh = 0; dh < 2; ++dh) {
            const bf16x8 va0 = (bf16x8){a[dh][0][0], a[dh][0][1], a[dh][0][2], a[dh][0][3], a[dh][1][0], a[dh][1][1], a[dh][1][2], a[dh][1][3]};
            const bf16x8 va1 = (bf16x8){a[dh][2][0], a[dh][2][1], a[dh][2][2], a[dh][2][3], a[dh][3][0], a[dh][3][1], a[dh][3][2], a[dh][3][3]};
            o[dh] = __builtin_amdgcn_mfma_f32_32x32x16_bf16(va0, pb0, o[dh], 0, 0, 0);
            o[dh] = __builtin_amdgcn_mfma_f32_32x32x16_bf16(va1, pb1, o[dh], 0, 0, 0);
        }
    }
}

template <bool NT>
__device__ __forceinline__ void store_o(const f32x16 (&o)[2], const float l, char* orow_q, const int h, const bool valid = true) {
    const float il = 1.0f / l;
#pragma unroll
    for (int dh = 0; dh < 2; ++dh)
#pragma unroll
        for (int jj = 0; jj < 2; ++jj) {
            u32x2 we, wo;
            we[0] = pk_bf16(o[dh][8 * jj] * il, o[dh][8 * jj + 1] * il); we[1] = pk_bf16(o[dh][8 * jj + 2] * il, o[dh][8 * jj + 3] * il);
            wo[0] = pk_bf16(o[dh][8 * jj + 4] * il, o[dh][8 * jj + 5] * il); wo[1] = pk_bf16(o[dh][8 * jj + 6] * il, o[dh][8 * jj + 7] * il);
            const unsigned s0 = h ? we[0] : wo[0], s1 = h ? we[1] : wo[1];
            const unsigned r0 = (unsigned)__shfl_xor((int)s0, 32), r1 = (unsigned)__shfl_xor((int)s1, 32);
            u32x4 w; if (h == 0) { w[0] = we[0]; w[1] = we[1]; w[2] = r0; w[3] = r1; } else { w[0] = r0; w[1] = r1; w[2] = wo[0]; w[3] = wo[1]; }
            u32x4* dst = (u32x4*)(orow_q + (32 * dh + 16 * jj + 8 * h) * 2);
            if (valid) { if (NT) __builtin_nontemporal_store(w, dst); else *dst = w; }
        }
}

template <bool NT>
__device__ __forceinline__ void store_o_staged(const f32x16 (&o)[2], const float l, ATT_LAS char* stg, char* base, const long rstride, const int lane) {
    const int q = lane & 31, h = lane >> 5; const float il = 1.0f / l;
#pragma unroll
    for (int dh = 0; dh < 2; ++dh)
#pragma unroll
        for (int jj = 0; jj < 2; ++jj) {
            u32x2 we, wo;
            we[0] = pk_bf16(o[dh][8 * jj] * il, o[dh][8 * jj + 1] * il); we[1] = pk_bf16(o[dh][8 * jj + 2] * il, o[dh][8 * jj + 3] * il);
            wo[0] = pk_bf16(o[dh][8 * jj + 4] * il, o[dh][8 * jj + 5] * il); wo[1] = pk_bf16(o[dh][8 * jj + 6] * il, o[dh][8 * jj + 7] * il);
            const unsigned s0 = h ? we[0] : wo[0], s1 = h ? we[1] : wo[1];
            const unsigned r0 = (unsigned)__shfl_xor((int)s0, 32), r1 = (unsigned)__shfl_xor((int)s1, 32);
            u32x4 w; if (h == 0) { w[0] = we[0]; w[1] = we[1]; w[2] = r0; w[3] = r1; } else { w[0] = r0; w[1] = r1; w[2] = wo[0]; w[3] = wo[1]; }
            *(ATT_LAS u32x4*)(stg + q * 128 + 16 * ((4 * dh + 2 * jj + h) ^ (q & 7))) = w;
        }
    asm volatile("s_waitcnt lgkmcnt(0)" ::: "memory");
#pragma unroll
    for (int i = 0; i < 4; ++i) { const int r = 8 * i + (lane >> 3), c = lane & 7;
        const u32x4 w = *(const ATT_LAS u32x4*)(stg + r * 128 + 16 * (c ^ (r & 7)));
        u32x4* dst = (u32x4*)(base + (long)r * rstride + 16 * c);
        if (NT) __builtin_nontemporal_store(w, dst); else *dst = w; }
    asm volatile("s_waitcnt lgkmcnt(0)" ::: "memory");
}

__device__ __forceinline__ unsigned moba_select(const char* qbase, const long qs, const float* km, const int qb) {
    const int lane = threadIdx.x & 63, q = lane & 31, h = lane >> 5;
    f32x16 g = f32x16{};
    const float* kmrow = km + (size_t)(q & 15) * 256;
    const bool lo_part = q >= 16;
#pragma unroll
    for (int d0 = 0; d0 < 4; ++d0) {
        const bf16x8 qf = *(const bf16x8*)(qbase + (long)q * qs + (16 * d0 + 8 * h) * 2);
        const f32x4 f0 = *(const f32x4*)(kmrow + 16 * d0 + 8 * h), f1 = *(const f32x4*)(kmrow + 16 * d0 + 8 * h + 4);
        float v[8] = {f0[0], f0[1], f0[2], f0[3], f1[0], f1[1], f1[2], f1[3]};
        u32x4 aw;
#pragma unroll
        for (int j = 0; j < 4; ++j) {
            const float h0 = bf16_round(v[2 * j]), h1 = bf16_round(v[2 * j + 1]);
            const float x0 = lo_part ? (v[2 * j] - h0) : h0, x1 = lo_part ? (v[2 * j + 1] - h1) : h1;
            aw[j] = pk_bf16(x0, x1);
        }
        g = __builtin_amdgcn_mfma_f32_32x32x16_bf16(__builtin_bit_cast(bf16x8, aw), qf, g, 0, 0, 0);
    }
    float gate[8], other[8];
#pragma unroll
    for (int r = 0; r < 8; ++r) { gate[r] = g[r] + g[r + 8]; }
#pragma unroll
    for (int r = 0; r < 8; ++r) { other[r] = __shfl_xor(gate[r], 32); }
    unsigned mymask = 0u;
#pragma unroll
    for (int r = 0; r < 8; ++r) {
        const int n = (r & 3) + 8 * (r >> 2) + 4 * h;
        int rank = 0;
#pragma unroll
        for (int r2 = 0; r2 < 8; ++r2) {
            const int n2 = (r2 & 3) + 8 * (r2 >> 2) + 4 * h, n3 = (r2 & 3) + 8 * (r2 >> 2) + 4 * (1 - h);
            if (r2 != r) rank += (n2 < qb && (gate[r2] > gate[r] || (gate[r2] == gate[r] && n2 < n))) ? 1 : 0;
            rank += (n3 < qb && (other[r2] > gate[r] || (other[r2] == gate[r] && n3 < n))) ? 1 : 0;
        }
        if (n < qb && rank < 3) mymask |= 1u << n;
    }
    return mymask | (unsigned)__shfl_xor((int)mymask, 32);
}
}


namespace mk {
using pg8::bf16_t; using pg8::bf16x8; using pg8::f32x4; using pg8::f32x2; using pg8::u32x4; using pg8::u32x2; using pg8::Unit; using pg8::cvt_pk_bf16;
#define LAS __attribute__((address_space(3)))
constexpr int NBAT = MK_NBAT, SEQ = 4096, D = 1024, DFF = 2816, NMEM = 256, M = NBAT * SEQ, MM = NBAT * NMEM, NQKV = 3072;
constexpr float EPS = 1e-6f, LOG2E = 1.4426950408889634f;
constexpr int NWAVES = 8, NPH = 13;

constexpr size_t al256(size_t x) { return (x + 255) / 256 * 256; }
constexpr size_t WS_CTL = 0, CTL_BYTES = 1u << 20;
constexpr size_t WS_WGU1 = WS_CTL + CTL_BYTES;
constexpr size_t WS_WD1 = WS_WGU1 + (size_t)2 * DFF * D * 2;
constexpr size_t WS_WIN = WS_WD1 + (size_t)D * DFF * 2;
constexpr size_t WS_WOUT = WS_WIN + (size_t)NQKV * D * 2;
constexpr size_t WS_WCQS = WS_WOUT + (size_t)D * D * 2;
constexpr size_t WS_WCKV = WS_WCQS + (size_t)D * D * 2;
constexpr size_t WS_WCO = WS_WCKV + (size_t)2 * D * D * 2;
constexpr size_t WS_WGU2 = WS_WCO + (size_t)D * D * 2;
constexpr size_t WS_WD2 = WS_WGU2 + (size_t)2 * DFF * D * 2;
constexpr size_t WS_MB = WS_WD2 + (size_t)D * DFF * 2;
constexpr size_t WS_KVC = WS_MB + (size_t)MM * D * 2;
constexpr size_t WS_WKT = WS_KVC + (size_t)MM * 2 * D * 2;
constexpr size_t WS_VWT = WS_WKT + (size_t)NBAT * D * D * 2;
constexpr size_t SS_BYTES = (size_t)M * 16 * 4;
constexpr size_t WS_SS = WS_VWT + (size_t)NBAT * D * D * 2;
constexpr size_t WS_SSM = WS_SS + 5 * SS_BYTES;
constexpr size_t WS_KM = WS_SSM + (size_t)MM * 16 * 4;
constexpr size_t WS_R1 = al256(WS_KM + (size_t)NBAT * 16 * 256 * 4);
constexpr size_t WS_XB = WS_R1 + (size_t)M * NQKV * 2;
constexpr size_t WS_OA2 = WS_XB + (size_t)M * D * 2;
constexpr size_t WS_SEL = WS_OA2 + (size_t)M * 768 * 2;
constexpr size_t WS_OBP = WS_SEL + (size_t)NBAT * 4 * SEQ * 4;
constexpr size_t WS_MLB = WS_OBP + (size_t)4 * M * 256 * 2;
constexpr size_t WS_END = WS_MLB + (size_t)4 * M * 4 * 2 * 4;
constexpr size_t OUT_OA1 = (size_t)M * 768 * 2, OUT_OB = 2 * OUT_OA1, OUT_ML = OUT_OB + (size_t)M * 256 * 2;
static_assert(OUT_ML + (size_t)3 * M * 12 * 8 <= (size_t)M * D * 4, "attention partials fit in d_out");
constexpr int CW_BAR = 4096, CW_QUEUE = 8192;

constexpr int LDS_XCH = 131072;
constexpr int LDS_MISC = 131072 + 8192;
constexpr int LDS_BYTES = 147456;
constexpr int LDS_TAB = 98304;
static_assert(LDS_TAB + 4 * att::TABB_N * 4 <= LDS_XCH, "attention LDS map");

__device__ __forceinline__ float wave_sum(float v) {
#pragma unroll
    for (int o = 1; o < 64; o <<= 1) v += __shfl_xor(v, o);
    return v;
}
__device__ __forceinline__ float row_rstd(const float* ss, int row) {
    const f32x4* p = (const f32x4*)(ss + (size_t)row * 16);
    const f32x4 a = p[0], b = p[1], c = p[2], d = p[3];
    const float s = ((a[0] + a[1]) + (a[2] + a[3])) + ((b[0] + b[1]) + (b[2] + b[3])) + ((c[0] + c[1]) + (c[2] + c[3])) + ((d[0] + d[1]) + (d[2] + d[3]));
    return 1.0f / sqrtf(s * (1.0f / D) + EPS);
}

struct SchedStd {
    pg8::Order o; const char* A; const char* B; size_t a_tile, b_tile, b_batch; int ocol_mul;
    __device__ __forceinline__ bool next(int i, Unit& u) const { int pm, pn; if (!o.tile(i, pm, pn)) return false;
        u.a = A + (size_t)pm * a_tile; u.b = B + (size_t)pn * b_tile + (size_t)(pm >> 4) * b_batch; u.orow = pm * 256; u.ocol = pn * ocol_mul; u.aux = pn; return true; }
};
struct SchedWK {
    int G, c; const char* kvc; const char* wcqs;
    __device__ __forceinline__ bool next(int i, Unit& u) const { const int L = i * G + c; if (L >= NBAT * 16) return false; const int bh = L >> 2, pn = L & 3, b = bh >> 2, h = bh & 3;
        u.a = kvc + ((size_t)(b * 256) * 2048 + h * 256) * 2; u.b = wcqs + ((size_t)(pn * 256) * 1024 + h * 256) * 2; u.orow = b * 1024 + h * 256; u.ocol = pn * 256; u.aux = 0; return true; }
};
struct SchedVW {
    int G, c; const char* kvc; const char* wcot;
    __device__ __forceinline__ bool next(int i, Unit& u) const { const int L = i * G + c; if (L >= NBAT * 16) return false; const int bh = L >> 2, pm = L & 3, b = bh >> 2, h = bh & 3;
        u.a = wcot + ((size_t)(pm * 256) * 1024 + h * 256) * 2; u.b = kvc + ((size_t)(b * 256) * 2048 + 1024 + h * 256) * 2; u.orow = b * 1024 + pm * 256; u.ocol = h * 256; u.aux = 0; return true; }
};

struct EpiGU { static constexpr bool PERM = true;
    bf16_t* H; const float* ss;
    __device__ __forceinline__ void operator()(const f32x4 (&acc)[2][2][4][2], const Unit& u, int wr, int wc, int fr, int fq, LAS unsigned char*, int, int) const {
        float rsv[2][4];
#pragma unroll
        for (int ai = 0; ai < 2; ++ai)
#pragma unroll
            for (int m = 0; m < 4; ++m) rsv[ai][m] = row_rstd(ss, u.orow + ai * 128 + wr * 64 + m * 16 + fr);
#pragma unroll
        for (int ai = 0; ai < 2; ++ai)
#pragma unroll
            for (int m = 0; m < 4; ++m) { const int row = u.orow + ai * 128 + wr * 64 + m * 16 + fr; const float rs = rsv[ai][m];
                float hv[8];
#pragma unroll
                for (int n = 0; n < 2; ++n)
#pragma unroll
                    for (int j = 0; j < 4; ++j) { const float g = acc[ai][0][m][n][j] * rs, uu = acc[ai][1][m][n][j] * rs;
                        hv[4 * n + j] = g * __builtin_amdgcn_rcpf(1.0f + __builtin_amdgcn_exp2f(-g * LOG2E)) * uu; }
                u32x4 w; w[0] = cvt_pk_bf16(hv[0], hv[1]); w[1] = cvt_pk_bf16(hv[2], hv[3]); w[2] = cvt_pk_bf16(hv[4], hv[5]); w[3] = cvt_pk_bf16(hv[6], hv[7]);
                __builtin_nontemporal_store(w, (u32x4*)(H + (size_t)row * DFF + u.ocol + wc * 32 + 8 * fq)); }
    }
};
struct EpiRes { static constexpr bool PERM = true;
    bf16_t* xb; float* ssout; float alpha;
    __device__ __forceinline__ void operator()(const f32x4 (&acc)[2][2][4][2], const Unit& u, int wr, int wc, int fr, int fq, LAS unsigned char*, int, int) const {
        const size_t off0 = (size_t)(u.orow + wr * 64 + fr) * D + u.ocol + wc * 32 + 8 * fq;
        u32x4 cur[2], nxt[2];
#pragma unroll
        for (int bj = 0; bj < 2; ++bj) cur[bj] = *(const u32x4*)(xb + off0 + bj * 128);
#pragma unroll
        for (int idx = 0; idx < 8; ++idx) { const int ai = idx >> 2, m = idx & 3; const size_t off = off0 + (size_t)(ai * 128 + m * 16) * D; const int row = u.orow + ai * 128 + wr * 64 + m * 16 + fr;
            if (idx < 7) { const size_t offn = off0 + (size_t)(((idx + 1) >> 2) * 128 + ((idx + 1) & 3) * 16) * D;
#pragma unroll
                for (int bj = 0; bj < 2; ++bj) nxt[bj] = *(const u32x4*)(xb + offn + bj * 128); }
            float sq = 0.f;
#pragma unroll
            for (int bj = 0; bj < 2; ++bj) { float o[8];
#pragma unroll
                for (int n = 0; n < 2; ++n)
#pragma unroll
                    for (int j = 0; j < 4; ++j) { const unsigned wv = cur[bj][2 * n + (j >> 1)]; const float r = __builtin_bit_cast(float, (j & 1) ? (wv & 0xffff0000u) : (wv << 16));
                        const float v = r + acc[ai][bj][m][n][j] * alpha; o[4 * n + j] = v; sq += v * v; }
                u32x4 w; w[0] = cvt_pk_bf16(o[0], o[1]); w[1] = cvt_pk_bf16(o[2], o[3]); w[2] = cvt_pk_bf16(o[4], o[5]); w[3] = cvt_pk_bf16(o[6], o[7]);
                *(u32x4*)(xb + off + bj * 128) = w; }
            sq += __shfl_xor(sq, 16); sq += __shfl_xor(sq, 32);
            if (fq == 0) ssout[(size_t)row * 16 + (u.ocol >> 8) * 4 + wc] = sq;
#pragma unroll
            for (int bj = 0; bj < 2; ++bj) cur[bj] = nxt[bj]; }
    }
};
struct EpiStore { static constexpr bool PERM = true;
    bf16_t* O; int ldc; const float* ss; float* km; bool nt;
    __device__ __forceinline__ void operator()(const f32x4 (&acc)[2][2][4][2], const Unit& u, int wr, int wc, int fr, int fq, LAS unsigned char*, int, int) const {
        float rsv[2][4];
#pragma unroll
        for (int ai = 0; ai < 2; ++ai)
#pragma unroll
            for (int m = 0; m < 4; ++m) rsv[ai][m] = ss ? row_rstd(ss, u.orow + ai * 128 + wr * 64 + m * 16 + fr) : 1.0f;
#pragma unroll
        for (int ai = 0; ai < 2; ++ai)
#pragma unroll
            for (int m = 0; m < 4; ++m) { const int row = u.orow + ai * 128 + wr * 64 + m * 16 + fr; const float rs = rsv[ai][m];
                const int col0 = u.ocol + wc * 32 + 8 * fq;
                bf16_t* rowp = ldc ? O + (size_t)row * ldc + col0 : O + (((size_t)(row / SEQ) * (NQKV / 64) + (col0 >> 6)) * SEQ + (row % SEQ)) * 64 + (col0 & 63);
                const size_t bjstep = ldc ? 128 : (size_t)2 * SEQ * 64;
#pragma unroll
                for (int bj = 0; bj < 2; ++bj) { const f32x4 v0 = acc[ai][bj][m][0] * rs, v1 = acc[ai][bj][m][1] * rs;
                    u32x4 w; w[0] = cvt_pk_bf16(v0[0], v0[1]); w[1] = cvt_pk_bf16(v0[2], v0[3]); w[2] = cvt_pk_bf16(v1[0], v1[1]); w[3] = cvt_pk_bf16(v1[2], v1[3]);
                    if (nt) __builtin_nontemporal_store(w, (u32x4*)(rowp + bj * bjstep)); else *(u32x4*)(rowp + bj * bjstep) = w; } }
        if ((km != nullptr) && (u.aux == 10)) {
            float* kmb = km + (size_t)(u.orow >> 8) * 256 + wc * 32 + 8 * fq;
#pragma unroll
            for (int bj = 0; bj < 2; ++bj)
#pragma unroll
                for (int n = 0; n < 2; ++n) { f32x4 cs = (f32x4){0.f, 0.f, 0.f, 0.f};
#pragma unroll
                    for (int ai = 0; ai < 2; ++ai)
#pragma unroll
                        for (int m = 0; m < 4; ++m) cs += acc[ai][bj][m][n] * rsv[ai][m];
#pragma unroll
                    for (int j = 0; j < 4; ++j) { float v = cs[j]; v += __shfl_xor(v, 1); v += __shfl_xor(v, 2); v += __shfl_xor(v, 4); v += __shfl_xor(v, 8);
                        if (fr == 0) atomicAdd(kmb + bj * 128 + 4 * n + j, v); } }
        }
    }
};
struct EpiSoftmax { static constexpr bool PERM = true;
    bf16_t* P; const float* ss;
    __device__ __forceinline__ void operator()(const f32x4 (&acc)[2][2][4][2], const Unit& u, int wr, int wc, int fr, int fq, LAS unsigned char* lds, int, int) const {
        LAS f32x2* X = (LAS f32x2*)(lds + LDS_XCH);
        float rsl[2][4], mw[2][4];
#pragma unroll
        for (int ai = 0; ai < 2; ++ai)
#pragma unroll
            for (int m = 0; m < 4; ++m) { const int rl = ai * 128 + wr * 64 + m * 16 + fr; const float rs = row_rstd(ss, u.orow + rl) * LOG2E; rsl[ai][m] = rs;
                float mx = -INFINITY;
#pragma unroll
                for (int bj = 0; bj < 2; ++bj)
#pragma unroll
                    for (int n = 0; n < 2; ++n)
#pragma unroll
                        for (int j = 0; j < 4; ++j) mx = fmaxf(mx, acc[ai][bj][m][n][j] * rs);
                mx = fmaxf(mx, __shfl_xor(mx, 16)); mx = fmaxf(mx, __shfl_xor(mx, 32));
                float sm = 0.f;
#pragma unroll
                for (int bj = 0; bj < 2; ++bj)
#pragma unroll
                    for (int n = 0; n < 2; ++n)
#pragma unroll
                        for (int j = 0; j < 4; ++j) sm += __builtin_amdgcn_exp2f(acc[ai][bj][m][n][j] * rs - mx);
                sm += __shfl_xor(sm, 16); sm += __shfl_xor(sm, 32);
                mw[ai][m] = mx;
                if (fq == 0) X[rl * 4 + wc] = (f32x2){mx, sm}; }
        asm volatile("s_waitcnt lgkmcnt(0)" ::: "memory"); __builtin_amdgcn_s_barrier(); asm volatile("" ::: "memory");
#pragma unroll
        for (int ai = 0; ai < 2; ++ai)
#pragma unroll
            for (int m = 0; m < 4; ++m) { const int rl = ai * 128 + wr * 64 + m * 16 + fr; const float rs = rsl[ai][m];
                const f32x2 x0 = X[rl * 4 + 0], x1 = X[rl * 4 + 1], x2 = X[rl * 4 + 2], x3 = X[rl * 4 + 3];
                const float Mx = fmaxf(fmaxf(x0[0], x1[0]), fmaxf(x2[0], x3[0]));
                const float L = x0[1] * __builtin_amdgcn_exp2f(x0[0] - Mx) + x1[1] * __builtin_amdgcn_exp2f(x1[0] - Mx) + x2[1] * __builtin_amdgcn_exp2f(x2[0] - Mx) + x3[1] * __builtin_amdgcn_exp2f(x3[0] - Mx);
                const float il = 1.0f / L;
                bf16_t* rowp = P + (size_t)(u.orow + rl) * D + u.ocol + wc * 32 + 8 * fq;
#pragma unroll
                for (int bj = 0; bj < 2; ++bj) { float pv[8];
#pragma unroll
                    for (int n = 0; n < 2; ++n)
#pragma unroll
                        for (int j = 0; j < 4; ++j) pv[4 * n + j] = __builtin_amdgcn_exp2f(acc[ai][bj][m][n][j] * rs - Mx) * il;
                    u32x4 w; w[0] = cvt_pk_bf16(pv[0], pv[1]); w[1] = cvt_pk_bf16(pv[2], pv[3]); w[2] = cvt_pk_bf16(pv[4], pv[5]); w[3] = cvt_pk_bf16(pv[6], pv[7]);
                    *(u32x4*)(rowp + bj * 128) = w; } }
        (void)mw;
    }
};

#define XB_TMO      128
#define XB_XCNT(j)  (256  + 64 * (j))
#define XB_XSUB(j)  (1280 + 64 * (j))
#define XB_XGEN(j)  (2304 + 64 * (j))
#define XB_TOP      3328
#define XB_TOPGEN   3392
#define XCD_BAR_WORDS 3456
#define XB_SPIN_CAP (1u << 18)
__device__ __forceinline__ unsigned xb_ld(unsigned* p)              { return __hip_atomic_load(p, __ATOMIC_RELAXED, __HIP_MEMORY_SCOPE_AGENT); }
__device__ __forceinline__ unsigned xb_add(unsigned* p, unsigned v) { return __hip_atomic_fetch_add(p, v, __ATOMIC_RELAXED, __HIP_MEMORY_SCOPE_AGENT); }
__device__ __forceinline__ unsigned xb_xcc_id() { return (unsigned)__builtin_amdgcn_s_getreg((3 << 11) | 20) & 0xFu; }
#define XB_SPIN(cond, bar) do { unsigned _sp = 0; while (cond) { __builtin_amdgcn_s_sleep(1); \
    if ((++_sp & 255u) == 0u) { if (xb_ld(&(bar)[XB_TMO])) break; if (_sp > XB_SPIN_CAP) { atomicAdd(&(bar)[XB_TMO], 1u); break; } } } } while (0)
struct XcdBarrier { unsigned* bar; unsigned x; volatile LAS unsigned* st; };
__device__ __forceinline__ XcdBarrier xcd_barrier_post(unsigned* bar, volatile LAS unsigned* st) {
    XcdBarrier b; b.bar = bar; b.x = xb_xcc_id(); b.st = st;
    if (threadIdx.x == 0) (void)xb_add(&bar[XB_XCNT(b.x)], 1u);
    return b;
}
__device__ __forceinline__ void xcd_barrier_complete(unsigned* bar, unsigned x, unsigned& nloc, unsigned& nx) {
    const unsigned G = gridDim.x * gridDim.y * gridDim.z;
    unsigned sum, cnt, mine, sp = 0u;
    for (;;) {
        sum = 0u; cnt = 0u; mine = 0u;
#pragma unroll
        for (unsigned j = 0; j < 16; ++j) { const unsigned c = xb_ld(&bar[XB_XCNT(j)]); sum += c; cnt += (c > 0u) ? 1u : 0u; mine = (j == x) ? c : mine; }
        if (sum == G) break;
        __builtin_amdgcn_s_sleep(1);
        if ((++sp & 255u) == 0u) { if (xb_ld(&bar[XB_TMO])) break; if (sp > XB_SPIN_CAP) { atomicAdd(&bar[XB_TMO], 1u); break; } }
    }
    nloc = mine > 0u ? mine : 1u; nx = cnt > 0u ? cnt : 1u;
}
__device__ __forceinline__ void xcd_barrier(const XcdBarrier& b) {
    asm volatile("s_waitcnt vmcnt(0)" ::: "memory");
    __syncthreads();
    if (threadIdx.x == 0) {
        unsigned* bar = b.bar;
        __builtin_amdgcn_s_waitcnt(0);
        unsigned nloc = b.st[0], nx = b.st[1];
        if (nloc == 0u) { xcd_barrier_complete(bar, b.x, nloc, nx); b.st[0] = nloc; b.st[1] = nx; }
        const unsigned old = xb_add(&bar[XB_XSUB(b.x)], 1u);
        const unsigned gen = old / nloc;
        if (old + 1u == (gen + 1u) * nloc) {
            __builtin_amdgcn_fence(__ATOMIC_RELEASE, "agent");
            asm volatile("s_waitcnt vmcnt(0)" ::: "memory");
            const unsigned og = xb_add(&bar[XB_TOP], 1u);
            const unsigned tg = og / nx;
            if (og + 1u == (tg + 1u) * nx) xb_add(&bar[XB_TOPGEN], 1u);
            else XB_SPIN(xb_ld(&bar[XB_TOPGEN]) == tg, bar);
            __builtin_amdgcn_fence(__ATOMIC_ACQUIRE, "agent");
            xb_add(&bar[XB_XGEN(b.x)], 1u);
            asm volatile("s_waitcnt vmcnt(0)" ::: "memory");
        } else {
            XB_SPIN(xb_ld(&bar[XB_XGEN(b.x)]) == gen, bar);
            __builtin_amdgcn_fence(__ATOMIC_ACQUIRE, "agent");
            asm volatile("s_waitcnt vmcnt(0)" ::: "memory");
        }
    }
    __syncthreads();
}

__device__ __forceinline__ void tr_item(const float* W, int N, int k0, int n0, const float* gain, float cscale, bf16_t* dst  , int Kd, LAS float* scr, int lane) {
    f32x4 v[8]; float g[8];
#pragma unroll
    for (int i = 0; i < 8; ++i) { const int kk = 8 * i + (lane >> 3); v[i] = __builtin_nontemporal_load((const f32x4*)(W + (size_t)(k0 + kk) * N + n0 + 4 * (lane & 7))); g[i] = gain ? gain[k0 + kk] * cscale : cscale; }
#pragma unroll
    for (int i = 0; i < 8; ++i) { const int kk = 8 * i + (lane >> 3); LAS float* d = scr + kk * 33 + 4 * (lane & 7); d[0] = v[i][0] * g[i]; d[1] = v[i][1] * g[i]; d[2] = v[i][2] * g[i]; d[3] = v[i][3] * g[i]; }
    asm volatile("s_waitcnt lgkmcnt(0)" ::: "memory");
    const int c = lane & 7;
#pragma unroll
    for (int j = 0; j < 4; ++j) { const int n = (lane >> 3) + 8 * j; const LAS float* s = scr + (8 * c) * 33 + n;
        u32x4 o; o[0] = cvt_pk_bf16(s[0 * 33], s[1 * 33]); o[1] = cvt_pk_bf16(s[2 * 33], s[3 * 33]); o[2] = cvt_pk_bf16(s[4 * 33], s[5 * 33]); o[3] = cvt_pk_bf16(s[6 * 33], s[7 * 33]);
        *(u32x4*)(dst + (size_t)n * Kd + k0 + 8 * c) = o; }
    asm volatile("s_waitcnt lgkmcnt(0)" ::: "memory");
}
template <int NR>
__device__ __forceinline__ void cvt_rows(const float* x, bf16_t* o, float* ss, int row0, int stride, int nrows, int lane) {
    f32x4 v[NR][4]; float s[NR];
#pragma unroll
    for (int r = 0; r < NR; ++r) { const int row = row0 + r * stride; const f32x4* xr = (const f32x4*)(x + (size_t)(row < nrows ? row : row0) * D) + lane;
#pragma unroll
        for (int j = 0; j < 4; ++j) v[r][j] = __builtin_nontemporal_load(xr + 64 * j); }
#pragma unroll
    for (int r = 0; r < NR; ++r) { float a = 0.f;
#pragma unroll
        for (int j = 0; j < 4; ++j) a += (v[r][j][0] * v[r][j][0] + v[r][j][1] * v[r][j][1]) + (v[r][j][2] * v[r][j][2] + v[r][j][3] * v[r][j][3]);
        s[r] = a; }
#pragma unroll
    for (int of = 1; of < 64; of <<= 1)
#pragma unroll
        for (int r = 0; r < NR; ++r) s[r] += __shfl_xor(s[r], of);
#pragma unroll
    for (int r = 0; r < NR; ++r) { const int row = row0 + r * stride; if (row < nrows) { u32x2* o8 = (u32x2*)(o + (size_t)row * D) + lane;
#pragma unroll
            for (int j = 0; j < 4; ++j) { u32x2 w; w[0] = cvt_pk_bf16(v[r][j][0], v[r][j][1]); w[1] = cvt_pk_bf16(v[r][j][2], v[r][j][3]); o8[64 * j] = w; }
            if (lane < 16) ss[(size_t)row * 16 + lane] = lane == 0 ? s[r] : 0.f; } }
}

struct Args { const float* in[20]; float* out; unsigned char* ws; int ph_lo, ph_hi, flags, pad; };

#define MK_PTRS unsigned char* ws = args.ws; float* out = args.out; asm volatile("" : "+s"(ws), "+s"(out)); \
    const float* x_in = args.in[0]; const float* mem_in = args.in[1]; const float* rel_bias = args.in[7]; \
    bf16_t* Wgu1 = (bf16_t*)(ws + WS_WGU1); bf16_t* Wd1 = (bf16_t*)(ws + WS_WD1); bf16_t* Win = (bf16_t*)(ws + WS_WIN); bf16_t* Wout = (bf16_t*)(ws + WS_WOUT); \
    bf16_t* Wcqs = (bf16_t*)(ws + WS_WCQS); bf16_t* Wckv = (bf16_t*)(ws + WS_WCKV); bf16_t* Wco = (bf16_t*)(ws + WS_WCO); bf16_t* Wgu2 = (bf16_t*)(ws + WS_WGU2); bf16_t* Wd2 = (bf16_t*)(ws + WS_WD2); \
    bf16_t* MB = (bf16_t*)(ws + WS_MB); bf16_t* KVC = (bf16_t*)(ws + WS_KVC); bf16_t* WKT = (bf16_t*)(ws + WS_WKT); bf16_t* VWT = (bf16_t*)(ws + WS_VWT); \
    float* SS0 = (float*)(ws + WS_SS); float* SS1 = SS0 + (size_t)M * 16; float* SS2 = SS1 + (size_t)M * 16; float* SS3 = SS2 + (size_t)M * 16; float* SS4 = SS3 + (size_t)M * 16; \
    float* SSM = (float*)(ws + WS_SSM); float* KM = (float*)(ws + WS_KM); \
    bf16_t* HB = (bf16_t*)(ws + WS_R1); bf16_t* QKV = HB; bf16_t* YN = HB; bf16_t* PB = HB; \
    bf16_t* XB = (bf16_t*)(ws + WS_XB); bf16_t* OA0 = (bf16_t*)out; bf16_t* OA1 = (bf16_t*)((char*)out + OUT_OA1); bf16_t* OA2 = (bf16_t*)(ws + WS_OA2); bf16_t* OB = (bf16_t*)((char*)out + OUT_OB); float* ML = (float*)((char*)out + OUT_ML); unsigned* SEL = (unsigned*)(ws + WS_SEL); bf16_t* OBP = (bf16_t*)(ws + WS_OBP); float* MLB = (float*)(ws + WS_MLB); (void)OB;
__global__ void __launch_bounds__(NWAVES * 64, 2) mk_fwd(Args args) {
    extern __shared__ __attribute__((aligned(16))) unsigned char lds_raw[];
    LAS unsigned char* lds = (LAS unsigned char*)lds_raw;
    const int tid = threadIdx.x, lane = tid & 63, wave = __builtin_amdgcn_readfirstlane(tid >> 6);
    const int G = gridDim.x, bx = blockIdx.x;
    const int vcu = (G % 8 == 0) ? (bx % 8) * (G / 8) + bx / 8 : bx;
    const int gw = vcu * NWAVES + wave, NGW = G * NWAVES;
    unsigned char* const ws0 = args.ws;
    volatile LAS unsigned* MISC = (volatile LAS unsigned*)(lds + LDS_MISC);
    if (tid < 32) MISC[tid] = 0u;
    __syncthreads();
    const int lo = args.ph_lo, hi = args.ph_hi;
    const bool use_bar = (hi - lo) > 1;
    XcdBarrier bar; bar.bar = (unsigned*)(ws0 + WS_CTL) + CW_BAR; bar.x = 0; bar.st = nullptr;
    if (use_bar) bar = xcd_barrier_post((unsigned*)(ws0 + WS_CTL) + CW_BAR, MISC + 8);
#define IN(k) (lo <= (k) && (k) < hi)
#define STAGGER() do { if (MK_STAGGER_TICKS > 0) { const unsigned long long t0_ = __builtin_amdgcn_s_memrealtime(), dl_ = (unsigned long long)((bx >> 3) & 3) * MK_STAGGER_TICKS; while (__builtin_amdgcn_s_memrealtime() - t0_ < dl_) __builtin_amdgcn_s_sleep(8); } } while (0)
#define SEAM(k) do { if (IN(k) && IN((k) + 1)) xcd_barrier(bar); } while (0)

    if (IN(0)) {
        MK_PTRS;
        LAS float* scr = (LAS float*)(lds + wave * 16384);
        constexpr int I_GU = (D / 64) * (2 * DFF / 32), I_DN = (DFF / 64) * (D / 32), I_IN = (D / 64) * (NQKV / 32), I_SQ = (D / 64) * (D / 32), I_KV = (D / 64) * (2 * D / 32);
        constexpr int NITEMS = 2 * I_GU + 2 * I_DN + I_IN + 2 * I_SQ + I_KV;
        for (int it = gw; it < NITEMS; it += NGW) {
            int r = it;
            if (r < 2 * I_GU) {
                const bool second = r >= I_GU; if (second) r -= I_GU;
                const int nblk = 2 * DFF / 32, kb = r / nblk, nb = r % nblk, n0 = nb * 32;
                const int drow = n0 < DFF ? (n0 / 128) * 256 + (n0 % 128) : ((n0 - DFF) / 128) * 256 + 128 + ((n0 - DFF) % 128);
                tr_item(args.in[second ? 17 : 3], 2 * DFF, kb * 64, n0, args.in[second ? 16 : 2], 1.0f, (second ? Wgu2 : Wgu1) + (size_t)drow * D, D, scr, lane); continue; }
            r -= 2 * I_GU;
            if (r < 2 * I_DN) { const bool second = r >= I_DN; if (second) r -= I_DN; const int nblk = D / 32, kb = r / nblk, nb = r % nblk;
                tr_item(args.in[second ? 18 : 4], D, kb * 64, nb * 32, nullptr, 1.0f, (second ? Wd2 : Wd1) + (size_t)(nb * 32) * DFF, DFF, scr, lane); continue; }
            r -= 2 * I_DN;
            if (r < I_IN) { const int nblk = NQKV / 32, kb = r / nblk, nb = r % nblk, n0 = nb * 32; const bool isq = (n0 < 768) || (n0 >= 2304 && n0 < 2560);
                tr_item(args.in[6], NQKV, kb * 64, n0, args.in[5], isq ? 0.125f : 1.0f, Win + (size_t)n0 * D, D, scr, lane); continue; }
            r -= I_IN;
            if (r < I_SQ) { const int nblk = D / 32, kb = r / nblk, nb = r % nblk, k0 = kb * 64; const float* gp = k0 < 768 ? args.in[8] : args.in[9] - 768;
                tr_item(args.in[10], D, k0, nb * 32, gp, 1.0f, Wout + (size_t)(nb * 32) * D, D, scr, lane); continue; }
            r -= I_SQ;
            if (r < I_SQ) { const int nblk = D / 32, kb = r / nblk, nb = r % nblk; tr_item(args.in[15], D, kb * 64, nb * 32, nullptr, 1.0f, Wco + (size_t)(nb * 32) * D, D, scr, lane); continue; }
            r -= I_SQ;
            { const int nblk = 2 * D / 32, kb = r / nblk, nb = r % nblk; tr_item(args.in[14], 2 * D, kb * 64, nb * 32, args.in[12], 1.0f, Wckv + (size_t)(nb * 32) * D, D, scr, lane); }
        }
        for (int c = gw; c < D; c += NGW) { const float g = args.in[11][c] * 0.0625f; const f32x4* src = (const f32x4*)(args.in[13] + (size_t)c * D) + lane; u32x2* dst = (u32x2*)(Wcqs + (size_t)c * D) + lane;
#pragma unroll
            for (int j = 0; j < 4; ++j) { const f32x4 v = src[64 * j] * g; u32x2 w; w[0] = cvt_pk_bf16(v[0], v[1]); w[1] = cvt_pk_bf16(v[2], v[3]); dst[64 * j] = w; } }
        for (int m = gw; m < M; m += 4 * NGW) cvt_rows<4>(x_in, XB, SS0, m, NGW, M, lane);
        for (int m = gw; m < MM; m += NGW) cvt_rows<1>(mem_in, MB, SSM, m, NGW, MM, lane);
        for (int i = gw * 64 + lane; i < NBAT * 16 * 256; i += NGW * 64) KM[i] = 0.f;
    }
    SEAM(0);

    if (IN(1)) {
        MK_PTRS;
        STAGGER();
        { SchedStd S; S.o.init(M, 2 * DFF, G, bx); S.A = (const char*)XB; S.B = (const char*)Wgu1; S.a_tile = (size_t)256 * D * 2; S.b_tile = (size_t)256 * D * 2; S.b_batch = 0; S.ocol_mul = 128;
          EpiGU E{HB, SS0}; pg8::gemm_phase<EpiGU, SchedStd, true>(lds, D, D, D / 64, S, E); }
    }
    SEAM(1);

    if (IN(2)) {
        MK_PTRS;
        SchedStd S; S.o.init(M, D, G, bx); S.A = (const char*)HB; S.B = (const char*)Wd1; S.a_tile = (size_t)256 * DFF * 2; S.b_tile = (size_t)256 * DFF * 2; S.b_batch = 0; S.ocol_mul = 256;
        EpiRes E{XB, SS1, 0.5f}; pg8::gemm_phase<EpiRes, SchedStd, true>(lds, DFF, DFF, DFF / 64, S, E);
    }
    SEAM(2);

    if (IN(3)) {
        MK_PTRS;
        { SchedStd S; S.o.init(M, NQKV, G, bx); S.A = (const char*)XB; S.B = (const char*)Win; S.a_tile = (size_t)256 * D * 2; S.b_tile = (size_t)256 * D * 2; S.b_batch = 0; S.ocol_mul = 256;
          EpiStore E{QKV, 0, SS1, KM, false}; pg8::gemm_phase<EpiStore, SchedStd, true>(lds, D, D, D / 64, S, E); }
    }
    SEAM(3);

    if (IN(4)) {
        MK_PTRS;
        constexpr long HSTR4 = (long)SEQ * 128;
        for (int task = gw; task < NBAT * 4 * (SEQ / 32); task += NGW) { const int bh = task / (SEQ / 32), tl = task % (SEQ / 32), b = bh >> 2, hb = bh & 3, q0 = tl * 32, qb = q0 >> 8;
            const char* qbase = (const char*)QKV + ((size_t)b * 48 + 36 + hb) * HSTR4 + (size_t)q0 * 128;
            const unsigned msk = att::moba_select(qbase, 128, KM + (size_t)b * 16 * 256 + hb * 64, qb);
            if (lane < 32) SEL[(size_t)bh * SEQ + q0 + lane] = msk; }
    }
    SEAM(4);

    if (IN(5)) {
        MK_PTRS;
        LAS float* tab = (LAS float*)(lds + LDS_TAB);
        const int h2 = lane >> 5, q = lane & 31;
        const long rowb = 128;
        constexpr long HSTR = (long)SEQ * 128;
#define ATT_WAITV(n) asm volatile("s_waitcnt vmcnt(" #n ")" ::: "memory")
#define ATT_BAR() do { asm volatile("s_waitcnt lgkmcnt(0)" ::: "memory"); __builtin_amdgcn_s_barrier(); asm volatile("" ::: "memory"); } while (0)
        { constexpr int NKV = NBAT * 8;
          struct SchedOne { const char* A; const char* B; int G_, c_; __device__ __forceinline__ bool next(int i, Unit& uu) const { const int idx = i * G_ + c_; if (idx >= NKV) return false; const int pm = idx >> 3, pn = idx & 7;
              uu.a = A + (size_t)pm * 256 * D * 2; uu.b = B + (size_t)pn * 256 * D * 2; uu.orow = pm * 256; uu.ocol = pn * 256; uu.aux = pn; return true; } };
          SchedOne S1{(const char*)MB, (const char*)Wckv, G, vcu};
          EpiStore Ekv{KVC, 2 * D, SSM, nullptr, false}; pg8::gemm_phase<EpiStore, SchedOne, true>(lds, D, D, D / 64, S1, Ekv);
          __syncthreads(); }
        for (int i = tid; i < 4 * att::TABB_N; i += NWAVES * 64) { const int hb = i / att::TABB_N, e = i % att::TABB_N, dist = e - 32;
            tab[i] = dist >= 0 ? rel_bias[att::rel_bucket(dist) * 16 + 12 + hb] * LOG2E : -INFINITY; }
        __syncthreads();
        {
            constexpr int NBH = NBAT * 4, NUNITS = 16 * NBH;
            LAS unsigned* LQ = (LAS unsigned*)(lds + 65536);
            volatile LAS unsigned* UW = (volatile LAS unsigned*)(lds + 65536 + 16384);
            unsigned* qhead = (unsigned*)(ws + WS_CTL) + CW_QUEUE;
#pragma unroll 1
            for (;;) {
                if (tid == 0) UW[8] = __hip_atomic_fetch_add(qhead, 1u, __ATOMIC_RELAXED, __HIP_MEMORY_SCOPE_AGENT);
                ATT_BAR();
                const int u = (int)UW[8];
                if (u >= NUNITS) break;
                const int n = u / NBH, bh = u % NBH, b = bh >> 2, hb = bh & 3;
                const char* qh = (const char*)QKV + ((size_t)b * 48 + 36 + hb) * HSTR;
                const char* kh = (const char*)QKV + ((size_t)b * 48 + 40 + hb) * HSTR + (size_t)(256 * n) * rowb;
                const unsigned* selp = SEL + (size_t)bh * SEQ;
                ATT_WAITV(0);
#pragma unroll
                for (int k = wave; k < 32; k += NWAVES) { const int row = 8 * k + (lane >> 3); att::dma_rows8(kh + (long)row * rowb, (int)(4 * HSTR), row, (LAS char*)(lds + k * 1024), (LAS char*)(lds + 32768 + k * 1024), lane); }
                int total = 0;
                if (n < 15) {
                    const int lo = 256 * (n + 1) + wave * 32 * (15 - n), R = 32 * (15 - n);
                    int cnt = 0;
#pragma unroll 1
                    for (int i = 0; i < R; i += 64) { const bool pr = (i + lane < R) && ((selp[lo + i + lane] >> n) & 1u); cnt += __popcll(__ballot(pr)); }
                    if (lane == 0) UW[wave] = (unsigned)cnt;
                    ATT_BAR();
                    int basew = 0;
#pragma unroll
                    for (int w2 = 0; w2 < NWAVES; ++w2) { const int cw = (int)UW[w2]; basew += (w2 < wave) ? cw : 0; total += cw; }
#pragma unroll 1
                    for (int i = 0; i < R; i += 64) { const bool pr = (i + lane < R) && ((selp[lo + i + lane] >> n) & 1u); const unsigned long long bal = __ballot(pr);
                        if (pr) LQ[basew + __popcll(bal & ((1ull << lane) - 1ull))] = (unsigned)(lo + i + lane); basew += __popcll(bal); }
                }
                const int ntiles = (total + 31) >> 5;
                ATT_WAITV(0); ATT_BAR();
                const LAS float* tb = tab + hb * att::TABB_N;
#pragma unroll 1
                for (int tile = -1; tile < ntiles; tile = (tile < 0 ? wave : tile + NWAVES)) {
                    const bool own = tile < 0;
                    int tq; bool valid = true;
                    if (own) tq = 256 * n + 32 * wave + q; else { const int e = 32 * tile + q; valid = e < total; tq = (int)LQ[valid ? e : total - 1]; }
                    att::bf16x8 qf[4];
#pragma unroll
                    for (int d0 = 0; d0 < 4; ++d0) qf[d0] = *(const att::bf16x8*)(qh + (long)tq * rowb + (16 * d0 + 8 * h2) * 2);
                    const int slot = own ? 3 : __popc(selp[tq] & ((1u << n) - 1u));
                    att::f32x16 o[2]; o[0] = att::f32x16{}; o[1] = att::f32x16{}; float mo = -1e30f, lo_ = 0.f;
                    const int Bq = (tq - 256 * n + 32) - 4 * h2;
#pragma unroll 1
                    for (int g = own ? wave : 7; g >= 0; --g) { int B = Bq - 32 * g; B = B < (att::TABB_N - 1) ? B : (att::TABB_N - 1);
                        att::attn_group(qf, o, mo, lo_, (const LAS char*)(lds + g * 4096), (const LAS char*)(lds + 32768 + g * 4096), tb + B, lane); }
                    lo_ += __shfl_xor(lo_, 32);
                    const size_t prow = (size_t)slot * M + (size_t)b * SEQ + tq;
                    att::store_o<MK_NT_PART>(o, lo_, (char*)OBP + (prow * 256 + hb * 64) * 2, h2, valid);
                    if (h2 == 0 && valid) *(f32x2*)(MLB + (prow * 4 + hb) * 2) = (f32x2){mo, lo_};
                }
                ATT_BAR();
            }
        }
        __syncthreads();
        LAS float* rbl = (LAS float*)(lds + LDS_TAB); LAS float* tabI = (LAS float*)(lds + LDS_TAB + 2048);
        LAS char* ostg = (LAS char*)(lds + LDS_TAB + 3072 + wave * 4096);
        static_assert(LDS_TAB + 3072 + NWAVES * 4096 <= LDS_MISC, "dilated LDS map");
        for (int i = tid; i < 512; i += NWAVES * 64) rbl[i] = rel_bias[i] * LOG2E;
        __syncthreads();
        constexpr int NDIL = NBAT * 12 * 48;
        struct DilItem { int b, h, p, d, res, m0, mbase; };
        auto decode = [&](int it, DilItem& I) { const int bh = it / 48, j = it % 48; I.b = bh / 12; I.h = bh % 12; I.p = j >> 4; const int jj = j & 15;
            I.d = I.p == 0 ? 1 : (I.p == 1 ? 4 : 16); I.res = I.p == 0 ? 0 : (I.p == 1 ? (jj & 3) : jj); const int mblk = I.p == 0 ? jj : (I.p == 1 ? (jj >> 2) : 0);
            I.mbase = mblk * 256 - 128; I.m0 = mblk * 256 + wave * 32; };
        att::bf16x8 qf[4];
        auto issue_k = [&](const DilItem& I) {
            const char* kb = (const char*)QKV + ((size_t)I.b * 48 + 12 + I.h) * HSTR + (size_t)I.res * rowb; const long st = (long)I.d * rowb;
#pragma unroll 1
            for (int k = wave; k < 48; k += NWAVES) { if (I.mbase + 8 * k < 0) continue; const int row = 8 * k + (lane >> 3); att::dma_k_rows8(kb + (long)(I.mbase + row) * st, row, (LAS char*)(lds + k * 1024), lane); } };
        auto issue_v = [&](const DilItem& I) {
            const char* vb = (const char*)QKV + ((size_t)I.b * 48 + 24 + I.h) * HSTR + (size_t)I.res * rowb; const long st = (long)I.d * rowb;
#pragma unroll 1
            for (int k = wave; k < 48; k += NWAVES) { if (I.mbase + 8 * k < 0) continue; const int row = 8 * k + (lane >> 3); att::dma_v_rows8(vb + (long)(I.mbase + row) * st, row, (LAS char*)(lds + 49152 + k * 1024), lane); } };
        auto load_q = [&](const DilItem& I) {
            const char* qp = (const char*)QKV + ((size_t)I.b * 48 + I.h) * HSTR + (size_t)I.res * rowb + (long)I.m0 * I.d * rowb + (long)q * I.d * rowb + 16 * h2;
            asm volatile("global_load_dwordx4 %0, %4, off\n\tglobal_load_dwordx4 %1, %4, off offset:32\n\tglobal_load_dwordx4 %2, %4, off offset:64\n\tglobal_load_dwordx4 %3, %4, off offset:96"
                         : "=&v"(qf[0]), "=&v"(qf[1]), "=&v"(qf[2]), "=&v"(qf[3]) : "v"(qp) : "memory"); };
        auto build_tab = [&](const DilItem& I) { if (tid < att::TABA_N) { const int delta = tid - 32; tabI[tid] = (delta >= 0 && delta <= 128) ? rbl[att::rel_bucket(delta * I.d) * 16 + I.h] : -INFINITY; } };
        att::u32x4 vr[6];
        auto load_v = [&](const DilItem& I) {
            const char* vb = (const char*)QKV + ((size_t)I.b * 48 + 24 + I.h) * HSTR + (size_t)I.res * rowb; const long st = (long)I.d * rowb;
#pragma unroll
            for (int j = 0; j < 6; ++j) { const int k = wave + NWAVES * j; if (I.mbase + 8 * k < 0) continue; const int row = 8 * k + (lane >> 3);
                const char* src = vb + (long)(I.mbase + row) * st + 16 * ((lane & 7) ^ (((row >> 1) & 1) << 2));
                asm volatile("global_load_dwordx4 %0, %1, off" : "=&v"(vr[j]) : "v"(src) : "memory"); } };
        DilItem cur; int it = vcu;
        if (it < NDIL) { decode(it, cur); build_tab(cur); ATT_WAITV(0); issue_k(cur); load_q(cur); issue_v(cur); }
        att::f32x16 po[2]; po[0] = att::f32x16{}; po[1] = att::f32x16{}; float pmo = 0.f, plo = 1.f; DilItem pdone = cur; int pm0 = 0; bool pvalid = false;
#define FLUSH_PREV() do { const size_t tok_ = (size_t)pdone.b * SEQ + (size_t)(pm0 + q) * pdone.d + pdone.res; \
            att::store_o_staged<MK_NT_PART>(po, plo, ostg, (char*)(pdone.p == 0 ? OA0 : (pdone.p == 1 ? OA1 : OA2)) + (((size_t)pdone.b * SEQ + (size_t)pm0 * pdone.d + pdone.res) * 768 + pdone.h * 64) * 2, (long)pdone.d * 768 * 2, lane); \
            if (h2 == 0) *(f32x2*)(ML + (((size_t)pdone.p * M + tok_) * 12 + pdone.h) * 2) = (f32x2){pmo, plo}; } while (0)
#pragma unroll 1
        for (; it < NDIL; it += G) {
            ATT_WAITV(0);
            asm volatile("" : "+v"(qf[0]), "+v"(qf[1]), "+v"(qf[2]), "+v"(qf[3]));
            ATT_BAR();
            const bool has_next = it + G < NDIL; DilItem nxt = cur; if (has_next) decode(it + G, nxt);
            if (pvalid) FLUSH_PREV();
            if (has_next) load_v(nxt);
            const int m0 = cur.m0, gend = (m0 - 128) > 0 ? (m0 - 128) : 0, ng = ((m0 - gend) >> 5) + 1;
            att::u32x4 pw[5][2]; float mo, lo_;
            { att::bf16x8 qc[4] = {qf[0], qf[1], qf[2], qf[3]};
              att::dil_pass1(qc, ng, (const LAS char*)(lds + (m0 - cur.mbase) * 128), tabI + 32 + q - 4 * h2, pw, mo, lo_, lane); }
            ATT_BAR();
            const DilItem done = cur;
            if (has_next) { cur = nxt; issue_k(cur); build_tab(cur); load_q(cur); }
            att::f32x16 o[2];
            att::dil_pass2(ng, (const LAS char*)(lds + 49152 + (m0 - done.mbase) * 128), pw, o, lane);
            ATT_BAR();
            po[0] = o[0]; po[1] = o[1]; pmo = mo; plo = lo_; pdone = done; pm0 = m0; pvalid = true;
            if (has_next) {
                if (cur.mbase < 0) ATT_WAITV(8); else ATT_WAITV(10);
                asm volatile("" : "+v"(vr[0]), "+v"(vr[1]), "+v"(vr[2]), "+v"(vr[3]), "+v"(vr[4]), "+v"(vr[5]));
#pragma unroll
                for (int j = 0; j < 6; ++j) { const int k = wave + NWAVES * j; if (cur.mbase + 8 * k < 0) continue; *(LAS att::u32x4*)(lds + 49152 + k * 1024 + lane * 16) = vr[j]; }
            }
        }
        if (pvalid) FLUSH_PREV();
#undef FLUSH_PREV
#undef ATT_WAITV
#undef ATT_BAR
    }
    SEAM(5);

    if (IN(6)) {
        MK_PTRS;
        for (int row0 = gw; row0 < M; row0 += 2 * NGW) {
            f32x2 ml[2][3][3]; u32x2 oa[2][3][3]; f32x2 mlb[2][4]; u32x2 obp[2][4];
#pragma unroll
            for (int r = 0; r < 2; ++r) { const int row = (row0 + r * NGW) < M ? (row0 + r * NGW) : row0;
#pragma unroll
                for (int k = 0; k < 3; ++k) { const int col = 256 * k + 4 * lane, hd = col >> 6;
#pragma unroll
                    for (int p = 0; p < 3; ++p) ml[r][k][p] = __builtin_nontemporal_load((const f32x2*)(ML + (((size_t)p * M + row) * 12 + hd) * 2));
                    oa[r][k][0] = __builtin_nontemporal_load((const u32x2*)(OA0 + (size_t)row * 768 + col)); oa[r][k][1] = __builtin_nontemporal_load((const u32x2*)(OA1 + (size_t)row * 768 + col)); oa[r][k][2] = __builtin_nontemporal_load((const u32x2*)(OA2 + (size_t)row * 768 + col)); }
#pragma unroll
                for (int s = 0; s < 4; ++s) { mlb[r][s] = __builtin_nontemporal_load((const f32x2*)(MLB + (((size_t)s * M + row) * 4 + (lane >> 4)) * 2)); obp[r][s] = __builtin_nontemporal_load((const u32x2*)(OBP + ((size_t)s * M + row) * 256 + 4 * lane)); } }
            float va[2][3][4], vb[2][4], ssa[2], ssb[2];
#pragma unroll
            for (int r = 0; r < 2; ++r) { ssa[r] = 0.f; ssb[r] = 0.f;
#pragma unroll
                for (int k = 0; k < 3; ++k) {
                    const float Mx = fmaxf(ml[r][k][0][0], fmaxf(ml[r][k][1][0], ml[r][k][2][0]));
                    const float w0 = ml[r][k][0][1] * __builtin_amdgcn_exp2f(ml[r][k][0][0] - Mx), w1 = ml[r][k][1][1] * __builtin_amdgcn_exp2f(ml[r][k][1][0] - Mx), w2 = ml[r][k][2][1] * __builtin_amdgcn_exp2f(ml[r][k][2][0] - Mx);
                    const float iw = 1.0f / (w0 + w1 + w2);
#pragma unroll
                    for (int e = 0; e < 4; ++e) { const unsigned s0 = oa[r][k][0][e >> 1], s1 = oa[r][k][1][e >> 1], s2 = oa[r][k][2][e >> 1];
                        const float f0 = __builtin_bit_cast(float, (e & 1) ? (s0 & 0xffff0000u) : (s0 << 16)), f1 = __builtin_bit_cast(float, (e & 1) ? (s1 & 0xffff0000u) : (s1 << 16)), f2 = __builtin_bit_cast(float, (e & 1) ? (s2 & 0xffff0000u) : (s2 << 16));
                        const float v = (w0 * f0 + w1 * f1 + w2 * f2) * iw; va[r][k][e] = v; ssa[r] += v * v; } }
                { const int rowq = (row0 + r * NGW) < M ? (row0 + r * NGW) : row0, nsel = (((rowq % SEQ) >> 8) < 3) ? ((rowq % SEQ) >> 8) : 3;
                  float wq[4], Mq = -INFINITY;
#pragma unroll
                  for (int s = 0; s < 4; ++s) { const bool use = (s == 3) || (s < nsel); Mq = use ? fmaxf(Mq, mlb[r][s][0]) : Mq; }
                  float wsum = 0.f;
#pragma unroll
                  for (int s = 0; s < 4; ++s) { const bool use = (s == 3) || (s < nsel); wq[s] = use ? mlb[r][s][1] * __builtin_amdgcn_exp2f(mlb[r][s][0] - Mq) : 0.f; wsum += wq[s]; }
                  const float iwq = 1.0f / wsum;
#pragma unroll
                  for (int e = 0; e < 4; ++e) { float acc_ = 0.f;
#pragma unroll
                      for (int s = 0; s < 4; ++s) { const bool use = (s == 3) || (s < nsel); const unsigned s0 = obp[r][s][e >> 1]; const float f = __builtin_bit_cast(float, (e & 1) ? (s0 & 0xffff0000u) : (s0 << 16)); acc_ += use ? wq[s] * f : 0.f; }
                      vb[r][e] = acc_ * iwq; ssb[r] += vb[r][e] * vb[r][e]; } } }
#pragma unroll
            for (int of = 1; of < 64; of <<= 1)
#pragma unroll
                for (int r = 0; r < 2; ++r) { ssa[r] += __shfl_xor(ssa[r], of); ssb[r] += __shfl_xor(ssb[r], of); }
#pragma unroll
            for (int r = 0; r < 2; ++r) { const int row = row0 + r * NGW; if (row < M) {
                const float ra = __builtin_amdgcn_rsqf(ssa[r] * (1.0f / 768.0f) + EPS), rb = __builtin_amdgcn_rsqf(ssb[r] * (1.0f / 256.0f) + EPS);
#pragma unroll
                for (int k = 0; k < 3; ++k) { u32x2 w; w[0] = cvt_pk_bf16(va[r][k][0] * ra, va[r][k][1] * ra); w[1] = cvt_pk_bf16(va[r][k][2] * ra, va[r][k][3] * ra); *(u32x2*)(YN + (size_t)row * D + 256 * k + 4 * lane) = w; }
                { u32x2 w; w[0] = cvt_pk_bf16(vb[r][0] * rb, vb[r][1] * rb); w[1] = cvt_pk_bf16(vb[r][2] * rb, vb[r][3] * rb); *(u32x2*)(YN + (size_t)row * D + 768 + 4 * lane) = w; } } }
        }
    }
    SEAM(6);

    if (IN(7)) {
        MK_PTRS;
        { SchedWK S{G, bx, (const char*)KVC, (const char*)Wcqs}; EpiStore E{WKT, D, nullptr, nullptr, false}; pg8::gemm_phase<EpiStore, SchedWK, true>(lds, 2 * D, D, 4, S, E); }
        { SchedVW S{G, (bx + G / 2) % G, (const char*)KVC, (const char*)Wco}; EpiStore E{VWT, D, nullptr, nullptr, false}; pg8::gemm_phase<EpiStore, SchedVW, true>(lds, D, 2 * D, 4, S, E); }
        SchedStd S; S.o.init(M, D, G, bx); S.A = (const char*)YN; S.B = (const char*)Wout; S.a_tile = (size_t)256 * D * 2; S.b_tile = (size_t)256 * D * 2; S.b_batch = 0; S.ocol_mul = 256;
        EpiRes E{XB, SS2, 1.0f}; pg8::gemm_phase<EpiRes, SchedStd, true>(lds, D, D, D / 64, S, E);
    }
    SEAM(7);

    if (IN(8)) {
        MK_PTRS;
        SchedStd S; S.o.init(M, D, G, bx); S.A = (const char*)XB; S.B = (const char*)WKT; S.a_tile = (size_t)256 * D * 2; S.b_tile = (size_t)256 * D * 2; S.b_batch = (size_t)D * D * 2; S.ocol_mul = 256;
        EpiSoftmax E{PB, SS2}; pg8::gemm_phase<EpiSoftmax, SchedStd, true>(lds, D, D, D / 64, S, E);
    }
    SEAM(8);

    if (IN(9)) {
        MK_PTRS;
        SchedStd S; S.o.init(M, D, G, bx); S.A = (const char*)PB; S.B = (const char*)VWT; S.a_tile = (size_t)256 * D * 2; S.b_tile = (size_t)256 * D * 2; S.b_batch = (size_t)D * D * 2; S.ocol_mul = 256;
        EpiRes E{XB, SS3, 1.0f}; pg8::gemm_phase<EpiRes, SchedStd, true>(lds, D, D, D / 64, S, E);
    }
    SEAM(9);

    if (IN(10)) {
        MK_PTRS;
        STAGGER();
        SchedStd S; S.o.init(M, 2 * DFF, G, bx); S.A = (const char*)XB; S.B = (const char*)Wgu2; S.a_tile = (size_t)256 * D * 2; S.b_tile = (size_t)256 * D * 2; S.b_batch = 0; S.ocol_mul = 128;
        EpiGU E{HB, SS3}; pg8::gemm_phase<EpiGU, SchedStd, true>(lds, D, D, D / 64, S, E);
    }
    SEAM(10);

    if (IN(11)) {
        MK_PTRS;
        SchedStd S; S.o.init(M, D, G, bx); S.A = (const char*)HB; S.B = (const char*)Wd2; S.a_tile = (size_t)256 * DFF * 2; S.b_tile = (size_t)256 * DFF * 2; S.b_batch = 0; S.ocol_mul = 256;
        EpiRes E{XB, SS4, 0.5f}; pg8::gemm_phase<EpiRes, SchedStd, true>(lds, DFF, DFF, DFF / 64, S, E);
    }
    SEAM(11);

    if (IN(12)) {
        MK_PTRS;
        const float* gf = args.in[19];
        for (int row0 = gw; row0 < M; row0 += 4 * NGW) {
            u32x2 w[4][4]; float rs[4]; const f32x4* gr = (const f32x4*)gf + lane;
#pragma unroll
            for (int r = 0; r < 4; ++r) { const int row = (row0 + r * NGW) < M ? (row0 + r * NGW) : row0; const u32x2* xr = (const u32x2*)(XB + (size_t)row * D) + lane;
#pragma unroll
                for (int j = 0; j < 4; ++j) w[r][j] = __builtin_nontemporal_load(xr + 64 * j);
                rs[r] = row_rstd(SS4, row); }
#pragma unroll
            for (int r = 0; r < 4; ++r) { const int row = row0 + r * NGW; if (row < M) { f32x4* orow = (f32x4*)(out + (size_t)row * D) + lane;
#pragma unroll
                for (int j = 0; j < 4; ++j) { f32x4 v; v[0] = __builtin_bit_cast(float, w[r][j][0] << 16); v[1] = __builtin_bit_cast(float, w[r][j][0] & 0xffff0000u); v[2] = __builtin_bit_cast(float, w[r][j][1] << 16); v[3] = __builtin_bit_cast(float, w[r][j][1] & 0xffff0000u);
                    __builtin_nontemporal_store(v * rs[r] * gr[64 * j], orow + 64 * j); } } }
        }
    }
#undef IN
#undef SEAM
}
}


#if MK_DEBUG
namespace dbg {
__global__ void __launch_bounds__(256) cmp_f32(const float* a, const float* r, size_t n, float* acc) {
    float num = 0.f, den = 0.f;
    for (size_t i = (size_t)blockIdx.x * 256 + threadIdx.x; i < n; i += (size_t)gridDim.x * 256) { const float d = a[i] - r[i]; num += d * d; den += r[i] * r[i]; }
    for (int o = 32; o > 0; o >>= 1) { num += __shfl_xor(num, o); den += __shfl_xor(den, o); }
    if ((threadIdx.x & 63) == 0) { atomicAdd(acc, num); atomicAdd(acc + 1, den); }
}
__global__ void __launch_bounds__(256) cmp_bf16(const unsigned short* a, int lda, const float* colscale, const float* r, int ldr, int rows, int cols, float* acc) {
    float num = 0.f, den = 0.f; const size_t n = (size_t)rows * cols;
    for (size_t i = (size_t)blockIdx.x * 256 + threadIdx.x; i < n; i += (size_t)gridDim.x * 256) { const size_t row = i / cols; const int c = (int)(i % cols);
        const float av = __builtin_bit_cast(float, (unsigned)a[row * lda + c] << 16) * (colscale ? colscale[c] : 1.0f); const float rv = r[row * ldr + c]; const float d = av - rv; num += d * d; den += rv * rv; }
    for (int o = 32; o > 0; o >>= 1) { num += __shfl_xor(num, o); den += __shfl_xor(den, o); }
    if ((threadIdx.x & 63) == 0) { atomicAdd(acc, num); atomicAdd(acc + 1, den); }
}
__global__ void __launch_bounds__(256) cmp_p(const unsigned short* a, const float* r, float* acc) {
    float num = 0.f, den = 0.f; const size_t n = (size_t)4096 * 1024;
    for (size_t i = (size_t)blockIdx.x * 256 + threadIdx.x; i < n; i += (size_t)gridDim.x * 256) { const size_t row = i / 1024; const int c = (int)(i % 1024);
        const float av = __builtin_bit_cast(float, (unsigned)a[i] << 16); const float rv = r[(size_t)(c >> 8) * 4096 * 256 + row * 256 + (c & 255)]; const float d = av - rv; num += d * d; den += rv * rv; }
    for (int o = 32; o > 0; o >>= 1) { num += __shfl_xor(num, o); den += __shfl_xor(den, o); }
    if ((threadIdx.x & 63) == 0) { atomicAdd(acc, num); atomicAdd(acc + 1, den); }
}
__global__ void build_scales(float* qkvs, float* gcat, const float* goa, const float* gob) {
    const int i = blockIdx.x * 256 + threadIdx.x;
    if (i < 3072) qkvs[i] = ((i < 768) || (i >= 2304 && i < 2560)) ? 8.0f : 1.0f;
    if (i < 1024) gcat[i] = i < 768 ? goa[i] : gob[i - 768];
}
constexpr int NST = 8;
__global__ void __launch_bounds__(256) finalize(float* out, size_t n, const float* acc, int report) {
    const float tol[NST] = {0.03f, 0.03f, 1e9f  , 0.08f, 0.03f, 0.05f, 0.03f, 0.03f};
    float E = 0.f;
    if (report > 0) { const float e = sqrtf(acc[2 * (report - 1)] / acc[2 * (report - 1) + 1]); E = (e == e) ? fminf(e, 3.0f) : 3.0f; }
    else { for (int k = NST - 1; k >= 0; --k) { const float e = sqrtf(acc[2 * k] / acc[2 * k + 1]); if (!(e <= tol[k])) E = 0.1f * (k + 1); } }
    for (size_t i = (size_t)blockIdx.x * 256 + threadIdx.x; i < n; i += (size_t)gridDim.x * 256) out[i] *= (1.0f + E);
}
}
#endif

static void mk_launch(const mk::Args& a0, int lo, int hi, int grid, hipStream_t st) {
    mk::Args a = a0; a.ph_lo = lo; a.ph_hi = hi;
    hipLaunchKernelGGL(mk::mk_fwd, dim3(grid), dim3(mk::NWAVES * 64), mk::LDS_BYTES, st, a);
    const hipError_t le = hipPeekAtLastError();
    if (le != hipSuccess) fprintf(stderr, "kernel_launch: launch of phases [%d,%d) failed: %s\n", lo, hi, hipGetErrorName(le));
}

extern "C" void kernel_launch(void* const* d_in, const int* in_sizes, int n_in, void* d_out, int out_size, void* d_ws, size_t ws_size, hipStream_t stream) {
    static int grid = 0;
    if (grid == 0) {
        if (n_in != 20 || out_size != 8 * 4096 * 1024) { fprintf(stderr, "kernel_launch: unexpected shapes (n_in %d out %d)\n", n_in, out_size); grid = -1; return; }
        int dev = 0, cus = 0, per_cu = 0;
        if (hipGetDevice(&dev) != hipSuccess || hipDeviceGetAttribute(&cus, hipDeviceAttributeMultiprocessorCount, dev) != hipSuccess) { grid = -1; return; }
        if (hipFuncSetAttribute((const void*)mk::mk_fwd, hipFuncAttributeMaxDynamicSharedMemorySize, mk::LDS_BYTES) != hipSuccess) { fprintf(stderr, "kernel_launch: hipFuncSetAttribute failed\n"); grid = -1; return; }
        if (hipOccupancyMaxActiveBlocksPerMultiprocessor(&per_cu, (const void*)mk::mk_fwd, mk::NWAVES * 64, mk::LDS_BYTES) != hipSuccess || per_cu < 1) fprintf(stderr, "kernel_launch: occupancy query reports %d workgroups per CU\n", per_cu);
        (void)hipGetLastError();
        grid = cus;
    }
    if (grid < 0) return;
    unsigned char* ws = (unsigned char*)d_ws;
#if MK_DEBUG
    const size_t ref_off = (mk::WS_END + 4095) / 4096 * 4096;
    size_t off = ref_off + (size_t)290 * 1024 * 1024;
    auto take = [&](size_t bytes) { unsigned char* p = ws + off; off += (bytes + 255) / 256 * 256; return p; };
    float* sx1 = (float*)take((size_t)4096 * 1024 * 4); float* sx2 = (float*)take((size_t)4096 * 1024 * 4); float* sx3 = (float*)take((size_t)4096 * 1024 * 4);
    float* mkout = (float*)take((size_t)4096 * 1024 * 4); float* qkvs = (float*)take(3072 * 4); float* gcat = (float*)take(1024 * 4); float* acc = (float*)take(256);
    if (off > ws_size) { fprintf(stderr, "kernel_launch: debug build needs %zu bytes of workspace, got %zu\n", off, ws_size); return; }
    ref::Snap snap{sx1, sx2, sx3};
    ref::forward(d_in, (float*)d_out, ws + ref_off, stream, &snap);
    (void)hipMemsetAsync(ws + mk::WS_CTL, 0, mk::CTL_BYTES, stream);
    (void)hipMemsetAsync(acc, 0, 256, stream);
    dbg::build_scales<<<12, 256, 0, stream>>>(qkvs, gcat, (const float*)d_in[8], (const float*)d_in[9]);
    mk::Args a{};
    for (int i = 0; i < 20; ++i) a.in[i] = (const float*)d_in[i];
    a.in[0] = (const float*)d_in[0] + (size_t)7 * 4096 * 1024; a.in[1] = (const float*)d_in[1] + (size_t)7 * 256 * 1024;
    a.out = mkout; a.ws = ws;
    const ref::Bufs& rb = ref::g_bufs;
    for (int ph = 0; ph < mk::NPH; ++ph) {
        mk_launch(a, ph, ph + 1, grid, stream);
        if (ph == 5) dbg::cmp_bf16<<<512, 256, 0, stream>>>((const unsigned short*)(ws + mk::WS_KVC), 2048, nullptr, rb.kvc, 2048, 256, 2048, acc + 0);
        if (ph == 2) dbg::cmp_bf16<<<512, 256, 0, stream>>>((const unsigned short*)(ws + mk::WS_XB), 1024, nullptr, sx1, 1024, 4096, 1024, acc + 2);
        if (ph == 3) dbg::cmp_bf16<<<512, 256, 0, stream>>>((const unsigned short*)(ws + mk::WS_R1), 3072, qkvs, rb.proj, 3072, 4096, 3072, acc + 4);
        if (ph == 6) dbg::cmp_bf16<<<512, 256, 0, stream>>>((const unsigned short*)(ws + mk::WS_R1), 1024, gcat, rb.yn, 1024, 4096, 1024, acc + 6);
        if (ph == 7) dbg::cmp_bf16<<<512, 256, 0, stream>>>((const unsigned short*)(ws + mk::WS_XB), 1024, nullptr, sx2, 1024, 4096, 1024, acc + 8);
        if (ph == 8) dbg::cmp_p<<<512, 256, 0, stream>>>((const unsigned short*)(ws + mk::WS_R1), rb.sc, acc + 10);
        if (ph == 9) dbg::cmp_bf16<<<512, 256, 0, stream>>>((const unsigned short*)(ws + mk::WS_XB), 1024, nullptr, sx3, 1024, 4096, 1024, acc + 12);
        if (ph == 12) dbg::cmp_f32<<<512, 256, 0, stream>>>(mkout, (const float*)d_out + (size_t)7 * 4096 * 1024, (size_t)4096 * 1024, acc + 14);
    }
    dbg::finalize<<<1024, 256, 0, stream>>>((float*)d_out, (size_t)8 * 4096 * 1024, acc, MK_REPORT);
#else
    if (ws_size < mk::WS_END) { fprintf(stderr, "kernel_launch: needs %zu bytes of workspace, got %zu\n", (size_t)mk::WS_END, ws_size); return; }
    if (hipMemsetAsync(ws + mk::WS_CTL, 0, mk::CTL_BYTES, stream) != hipSuccess) return;
    mk::Args a{};
    for (int i = 0; i < 20; ++i) a.in[i] = (const float*)d_in[i];
    a.out = (float*)d_out; a.ws = ws;
#if MK_N_LAUNCHES == 1
    mk_launch(a, 0, mk::NPH, grid, stream);
#else
    for (int ph = 0; ph < mk::NPH; ++ph) {
        for (int r = 0; r < MK_REPEAT_N; ++r) if (ph == MK_REPEAT) { mk::Args a2 = a; a2.flags = MK_REPEAT_FLAGS; mk_launch(a2, ph, ph + 1, grid, stream); }
        mk_launch(a, ph, ph + 1, grid, stream); }
#endif
#endif
}
```

```cpp
#include <hip/hip_runtime.h>
#include <cstdio>
#include <cstdint>
#include <cmath>
#define MK_REPEAT -1
#define MK_REPEAT_N 1
#define MK_REPEAT_FLAGS 0
#define MK_STAGGER_TICKS 0
#define MK_NT_PART false
#define MK_TIMING 0
#define MK_TQ 0.02f
#define MK_PROBE_SAME 0
#define MK_FP8_FFN1 0
#define MK_FP8_FFN2 1
#define MK_DEBUG 0
#define MK_REPORT 0
#define MK_N_LAUNCHES 1
#define MK_NBAT 8

namespace pg8 {
#define PG8_LAS __attribute__((address_space(3)))
typedef unsigned short bf16_t;
typedef short bf16x8 __attribute__((ext_vector_type(8)));
typedef float f32x4 __attribute__((ext_vector_type(4)));
typedef float f32x2 __attribute__((ext_vector_type(2)));
typedef unsigned u32x4 __attribute__((ext_vector_type(4)));
typedef unsigned u32x2 __attribute__((ext_vector_type(2)));
typedef int i32x4 __attribute__((ext_vector_type(4)));
typedef int i32x8 __attribute__((ext_vector_type(8)));
constexpr int BM = 256, BK = 64, HALF = 128, HTB = HALF * BK * 2  , STAGE_BYTES = 8 * HTB, NXCD = 8, WGM = 8;

__host__ __device__ __forceinline__ int lds_byte(int r, int c) { const int st = (r >> 4) * 2 + (c >> 5), rr = r & 15, cc = c & 31, ob = rr * 64 + cc * 2; return st * 1024 + (ob ^ (((ob >> 9) & 1) << 5)); }
__host__ __device__ __forceinline__ void stage_rc(int b, int& R, int& C) { const int st = b / 1024, sb = b % 1024, swz = sb ^ (((sb >> 9) & 1) << 5); R = (st >> 1) * 16 + swz / 64; C = (st & 1) * 32 + (swz % 64) / 2; }
__host__ __device__ __forceinline__ int perm32(int rho) { const int n = rho >> 4, i = rho & 15; return 8 * (i >> 2) + 4 * n + (i & 3); }

struct Unit { const char* a; const char* b; int orow, ocol, aux; };

struct Order {
    int nM, nN, nwg, G, c;
    __device__ __forceinline__ void init(int M, int N, int G_, int c_) { nM = M / BM; nN = N / BM; nwg = nM * nN; G = G_; c = c_; }
    __device__ __forceinline__ bool tile(int i, int& pm, int& pn) const {
        const long L = (long)i * G + c; if (L >= nwg) return false;
        int wgid = (int)L; { const int q = nwg / NXCD, r = nwg % NXCD, xcd = wgid % NXCD, off = wgid / NXCD; wgid = (xcd < r ? xcd * (q + 1) : r * (q + 1) + (xcd - r) * q) + off; }
        const int nig = WGM * nN, gid = wgid / nig, fm = gid * WGM, gsz = (nM - fm) < WGM ? (nM - fm) : WGM;
        pm = fm + ((wgid % nig) % gsz); pn = (wgid % nig) / gsz; return true;
    }
};

__device__ __forceinline__ unsigned cvt_pk_bf16(float lo, float hi) { unsigned r; asm volatile("v_cvt_pk_bf16_f32 %0, %1, %2" : "=v"(r) : "v"(lo), "v"(hi)); return r; }

template <class Epi, class Sched, bool ALIGN_EPI, bool FP8 = false>
__device__ __forceinline__ void gemm_phase(PG8_LAS unsigned char* lds, const int lda, const int ldb, const int nt, const Sched& S, const Epi& E) {
    int tid_ = threadIdx.x; asm volatile("" : "+v"(tid_));
    const int tid = tid_, wid = __builtin_amdgcn_readfirstlane(tid >> 6), lane = tid & 63, wr = wid >> 2, wc = wid & 3, fr = lane & 15, fq = lane >> 4;
    unsigned voffA[2], voffB[2];
#pragma unroll
    for (int i = 0; i < 2; ++i) { int R, C; stage_rc(tid * 16 + i * 8192, R, C); const int Rb = Epi::PERM ? ((R & ~31) + perm32(R & 31)) : R;
        voffA[i] = (unsigned)(R * lda + C) * 2u; voffB[i] = (unsigned)(Rb * ldb + C) * 2u; }
    const size_t kstep = (size_t)(BK * 2);
    const size_t hstepA = (size_t)HALF * lda * 2, hstepB = (size_t)HALF * ldb * 2;
    const unsigned ldsw = (unsigned)wid * 1024u;
    const int aoff = lds_byte(wr * 64 + fr, fq * 8), boff = lds_byte(wc * 32 + fr, fq * 8);
#define PG8_SA(b, h) (((b) * 2 + (h)) * HTB)
#define PG8_SB(b, h) ((4 + (b) * 2 + (h)) * HTB)
#define PG8_STAGE(bufoff, gbase, voff) do { _Pragma("unroll") for (int _i = 0; _i < 2; ++_i) \
        __builtin_amdgcn_global_load_lds((const unsigned*)((const char*)(gbase) + (voff)[_i]), (PG8_LAS unsigned*)(lds + (bufoff) + ldsw + _i * 8192), 16, 0, 0); } while (0)
#define PG8_LDA(dst, b, h) do { _Pragma("unroll") for (int m = 0; m < 4; ++m) _Pragma("unroll") for (int k = 0; k < 2; ++k) dst[m][k] = *(const PG8_LAS bf16x8*)(lds + PG8_SA(b, h) + aoff + m * 2048 + k * 1024); } while (0)
#define PG8_LDB(dst, b, h) do { _Pragma("unroll") for (int n = 0; n < 2; ++n) _Pragma("unroll") for (int k = 0; k < 2; ++k) dst[n][k] = *(const PG8_LAS bf16x8*)(lds + PG8_SB(b, h) + boff + n * 2048 + k * 1024); } while (0)
#define PG8_MMA(ai, bj, At, Bt) do { __builtin_amdgcn_s_setprio(1); _Pragma("unroll") for (int m = 0; m < 4; ++m) _Pragma("unroll") for (int n = 0; n < 2; ++n) { \
        if constexpr (FP8) { const i32x8 bb_ = __builtin_shufflevector(__builtin_bit_cast(i32x4, Bt[n][0]), __builtin_bit_cast(i32x4, Bt[n][1]), 0, 1, 2, 3, 4, 5, 6, 7); \
            const i32x8 aa_ = __builtin_shufflevector(__builtin_bit_cast(i32x4, At[m][0]), __builtin_bit_cast(i32x4, At[m][1]), 0, 1, 2, 3, 4, 5, 6, 7); \
            asm volatile("v_mfma_scale_f32_16x16x128_f8f6f4 %0, %1, %2, %0, %3, %3 op_sel_hi:[0,0,0]" : "+v"(acc[ai][bj][m][n]) : "v"(bb_), "v"(aa_), "v"(sc1)); } \
        else { _Pragma("unroll") for (int k = 0; k < 2; ++k) acc[ai][bj][m][n] = __builtin_amdgcn_mfma_f32_16x16x32_bf16(Bt[n][k], At[m][k], acc[ai][bj][m][n], 0, 0, 0); } } \
        __builtin_amdgcn_s_setprio(0); } while (0)
#define PG8_WAIT_V(n) asm volatile("s_waitcnt vmcnt(" #n ")" ::: "memory")
#define PG8_WAIT_L(n) asm volatile("s_waitcnt lgkmcnt(" #n ")" ::: "memory")
#define PG8_BAR __builtin_amdgcn_s_barrier()
#define PG8_SCHED __builtin_amdgcn_sched_barrier(0)
    int sc1 = 0x7F7F7F7F; asm volatile("" : "+v"(sc1)); (void)sc1;
    Unit cur, nxt; int ui = 0;
    if (!S.next(0, cur)) return;
    f32x4 acc[2][2][4][2];
#pragma unroll
    for (int a = 0; a < 2; ++a)
#pragma unroll
        for (int b = 0; b < 2; ++b)
#pragma unroll
            for (int m = 0; m < 4; ++m)
#pragma unroll
                for (int n = 0; n < 2; ++n) acc[a][b][m][n] = (f32x4){0.f, 0.f, 0.f, 0.f};
    bf16x8 At[4][2], B0[2][2], B1[2][2];
    const char* cA = cur.a; const char* cB = cur.b;
    PG8_STAGE(PG8_SB(0, 0), cB, voffB); PG8_STAGE(PG8_SB(0, 1), cB + hstepB, voffB); PG8_STAGE(PG8_SA(0, 0), cA, voffA); PG8_STAGE(PG8_SA(0, 1), cA + hstepA, voffA);
    if (wr == 1) PG8_BAR;
    PG8_WAIT_V(2); PG8_BAR;
    PG8_STAGE(PG8_SB(1, 0), cB + kstep, voffB); PG8_STAGE(PG8_SA(1, 0), cA + kstep, voffA); PG8_STAGE(PG8_SB(1, 1), cB + hstepB + kstep, voffB);
    PG8_WAIT_V(6); PG8_BAR;
    for (;;) {
        const bool has_next = S.next(ui + 1, nxt);
        const char* nA = has_next ? nxt.a : cA; const char* nB = has_next ? nxt.b : cB;
#pragma unroll 1
        for (int t = 0; t < nt; t += 2) {
            const bool last = (t == nt - 2);
            const char* a1 = cA + (size_t)(t + 1) * kstep;
            const char* a2 = last ? nA : cA + (size_t)(t + 2) * kstep; const char* b2 = last ? nB : cB + (size_t)(t + 2) * kstep;
            const char* a3 = a2 + kstep; const char* b3 = b2 + kstep;
            PG8_LDB(B0, 0, 0); PG8_LDB(B1, 0, 1); PG8_SCHED; PG8_LDA(At, 0, 0); PG8_STAGE(PG8_SA(1, 1), a1 + hstepA, voffA);
            PG8_WAIT_V(8); PG8_WAIT_L(0); PG8_BAR; PG8_MMA(0, 0, At, B0); PG8_MMA(0, 1, At, B1); PG8_BAR; PG8_SCHED;
            PG8_LDA(At, 0, 1); PG8_STAGE(PG8_SB(0, 0), b2, voffB); PG8_STAGE(PG8_SB(0, 1), b2 + hstepB, voffB); PG8_STAGE(PG8_SA(0, 0), a2, voffA);
            PG8_WAIT_V(8); PG8_WAIT_L(0); PG8_BAR; PG8_MMA(1, 0, At, B0); PG8_MMA(1, 1, At, B1); PG8_BAR; PG8_SCHED;
            PG8_LDB(B0, 1, 0); PG8_LDB(B1, 1, 1); PG8_SCHED; PG8_LDA(At, 1, 0); PG8_STAGE(PG8_SA(0, 1), a2 + hstepA, voffA);
            PG8_WAIT_V(8); PG8_WAIT_L(0); PG8_BAR; PG8_MMA(0, 0, At, B0); PG8_MMA(0, 1, At, B1); PG8_BAR; PG8_SCHED;
            PG8_LDA(At, 1, 1); PG8_STAGE(PG8_SB(1, 0), b3, voffB); PG8_STAGE(PG8_SB(1, 1), b3 + hstepB, voffB); PG8_STAGE(PG8_SA(1, 0), a3, voffA);
            PG8_WAIT_V(8); PG8_WAIT_L(0); PG8_BAR; PG8_MMA(1, 0, At, B0); PG8_MMA(1, 1, At, B1); PG8_BAR; PG8_SCHED;
        }
        if constexpr (ALIGN_EPI) { if (wr == 0) PG8_BAR; }
        if constexpr (FP8) asm volatile("s_nop 15\n\ts_nop 7" ::: "memory");
        E(acc, cur, wr, wc, fr, fq, lds, wid, lane);
        if (!has_next) break;
#pragma unroll
        for (int a = 0; a < 2; ++a)
#pragma unroll
            for (int b = 0; b < 2; ++b)
#pragma unroll
                for (int m = 0; m < 4; ++m)
#pragma unroll
                    for (int n = 0; n < 2; ++n) acc[a][b][m][n] = (f32x4){0.f, 0.f, 0.f, 0.f};
        cur = nxt; cA = nA; cB = nB; ++ui;
        if constexpr (ALIGN_EPI) { if (wr == 1) PG8_BAR; }
    }
    PG8_WAIT_V(0);
    if constexpr (!ALIGN_EPI) { if (wr == 0) PG8_BAR; }
    PG8_BAR;
#undef PG8_SA
#undef PG8_SB
#undef PG8_STAGE
#undef PG8_LDA
#undef PG8_LDB
#undef PG8_MMA
#undef PG8_WAIT_V
#undef PG8_WAIT_L
#undef PG8_BAR
#undef PG8_SCHED
}
}

namespace att {
#define ATT_LAS __attribute__((address_space(3)))
typedef short bf16x8 __attribute__((ext_vector_type(8)));
typedef short v4i16 __attribute__((ext_vector_type(4)));
typedef float f32x16 __attribute__((ext_vector_type(16)));
typedef float f32x4 __attribute__((ext_vector_type(4)));
typedef unsigned u32x4 __attribute__((ext_vector_type(4)));
typedef unsigned u32x2 __attribute__((ext_vector_type(2)));
constexpr float LOG2E = 1.4426950408889634f;
constexpr int TABA_N = 192, TABB_N = 1600;

__device__ __forceinline__ int rel_bucket(int n) {
    if (n < 16) return n < 0 ? 0 : n;
    int b = 16;
    b += (n >= 22); b += (n >= 30); b += (n >= 40); b += (n >= 54); b += (n >= 73); b += (n >= 99); b += (n >= 134); b += (n >= 182);
    b += (n >= 246); b += (n >= 332); b += (n >= 450); b += (n >= 609); b += (n >= 825); b += (n >= 1117); b += (n >= 1513);
    return b;
}
__device__ __forceinline__ unsigned pk_bf16(float lo, float hi) { unsigned r; asm volatile("v_cvt_pk_bf16_f32 %0, %1, %2" : "=v"(r) : "v"(lo), "v"(hi)); return r; }
__device__ __forceinline__ float bf16_round(float x) { unsigned u = __builtin_bit_cast(unsigned, x); u = (u + 0x7fffu + ((u >> 16) & 1u)) & 0xffff0000u; return __builtin_bit_cast(float, u); }

__device__ __forceinline__ void glds16(const void* gsrc, unsigned lds_dst) { unsigned keep;
    asm volatile("s_mov_b32 %0, m0\n\ts_mov_b32 m0, %2\n\ts_nop 0\n\tglobal_load_lds_dwordx4 %1, off\n\ts_mov_b32 m0, %0" : "=&s"(keep) : "v"(gsrc), "s"(lds_dst) : "memory"); }
__device__ __forceinline__ void dma_rows8(const char* krow0  , const int voff, const int row  ,
                                          ATT_LAS char* kdst  , ATT_LAS char* vdst, const int lane) {
    const int pc = lane & 7;
    glds16(krow0 + 16 * (pc ^ ((row >> 1) & 7)), (unsigned)__builtin_amdgcn_readfirstlane((int)(unsigned)(uintptr_t)kdst));
    glds16(krow0 + voff + 16 * (pc ^ (((row >> 1) & 1) << 2)), (unsigned)__builtin_amdgcn_readfirstlane((int)(unsigned)(uintptr_t)vdst));
}

__device__ __forceinline__ void attn_group(const bf16x8 (&qf)[4], f32x16 (&o)[2], float& m, float& l, const ATT_LAS char* kg, const ATT_LAS char* vg, const ATT_LAS float* tp, const int lane) {
    const int q = lane & 31, h = lane >> 5;
    const ATT_LAS char* kr0 = kg + q * 128; const int kswz = (q >> 1) & 7;
    typedef float f32x2_ __attribute__((ext_vector_type(2)));
    f32x2_ t0, t1, t2, t3, t4, t5, t6, t7;
    { const unsigned ta = (unsigned)(uintptr_t)(tp - 27);
      asm volatile("ds_read2_b32 %0, %8 offset0:27 offset1:26\n\tds_read2_b32 %1, %8 offset0:25 offset1:24\n\tds_read2_b32 %2, %8 offset0:19 offset1:18\n\tds_read2_b32 %3, %8 offset0:17 offset1:16\n\t"
                   "ds_read2_b32 %4, %8 offset0:11 offset1:10\n\tds_read2_b32 %5, %8 offset0:9 offset1:8\n\tds_read2_b32 %6, %8 offset0:3 offset1:2\n\tds_read2_b32 %7, %8 offset0:1 offset1:0"
                   : "=&v"(t0), "=&v"(t1), "=&v"(t2), "=&v"(t3), "=&v"(t4), "=&v"(t5), "=&v"(t6), "=&v"(t7) : "v"(ta) : "memory"); }
    const int q4 = (lane & 15) >> 2, p4 = lane & 3, g1 = (lane >> 4) & 1, vsw = (q4 >> 1) & 1;
    const unsigned va0_ = (unsigned)(uintptr_t)(vg + (4 * h + q4) * 128 + 32 * g1 + 8 * p4 + 64 * vsw), va1_ = (unsigned)(uintptr_t)(vg + (4 * h + q4) * 128 + 32 * g1 + 8 * p4 + 64 * (1 ^ vsw));
    v4i16 a[2][4];
    asm volatile("ds_read_b64_tr_b16 %0, %8\n\tds_read_b64_tr_b16 %1, %8 offset:1024\n\tds_read_b64_tr_b16 %2, %8 offset:2048\n\tds_read_b64_tr_b16 %3, %8 offset:3072\n\t"
                 "ds_read_b64_tr_b16 %4, %9\n\tds_read_b64_tr_b16 %5, %9 offset:1024\n\tds_read_b64_tr_b16 %6, %9 offset:2048\n\tds_read_b64_tr_b16 %7, %9 offset:3072"
                 : "=&v"(a[0][0]), "=&v"(a[0][1]), "=&v"(a[0][2]), "=&v"(a[0][3]), "=&v"(a[1][0]), "=&v"(a[1][1]), "=&v"(a[1][2]), "=&v"(a[1][3]) : "v"(va0_), "v"(va1_) : "memory");
    f32x16 s = f32x16{};
#pragma unroll
    for (int d0 = 0; d0 < 4; ++d0) { const bf16x8 kf = *(const ATT_LAS bf16x8*)(kr0 + 16 * ((2 * d0 + h) ^ kswz)); s = __builtin_amdgcn_mfma_f32_32x32x16_bf16(kf, qf[d0], s, 0, 0, 0); }
    asm volatile("s_waitcnt lgkmcnt(0)" : "+v"(t0), "+v"(t1), "+v"(t2), "+v"(t3), "+v"(t4), "+v"(t5), "+v"(t6), "+v"(t7), "+v"(a[0][0]), "+v"(a[0][1]), "+v"(a[0][2]), "+v"(a[0][3]), "+v"(a[1][0]), "+v"(a[1][1]), "+v"(a[1][2]), "+v"(a[1][3]) :: "memory");
    float mx = -INFINITY;
    { const float tb_[16] = {t0[0], t0[1], t1[0], t1[1], t2[0], t2[1], t3[0], t3[1], t4[0], t4[1], t5[0], t5[1], t6[0], t6[1], t7[0], t7[1]};
#pragma unroll
      for (int r = 0; r < 16; ++r) s[r] = fmaf(s[r], LOG2E, tb_[r]); }
#pragma unroll
    for (int r = 0; r < 16; r += 2) mx = fmaxf(mx, fmaxf(s[r], s[r + 1]));
    mx = fmaxf(mx, __shfl_xor(mx, 32));
    if (__any(mx > m)) {
        const float mnew = fmaxf(m, mx), alpha = __builtin_amdgcn_exp2f(m - mnew);
        l *= alpha; m = mnew;
#pragma unroll
        for (int r = 0; r < 16; ++r) { o[0][r] *= alpha; o[1][r] *= alpha; }
    }
    float ps = 0.f;
#pragma unroll
    for (int r = 0; r < 16; ++r) { s[r] = __builtin_amdgcn_exp2f(s[r] - m); ps += s[r]; }
    l += ps;
    u32x4 pw0, pw1;
    pw0[0] = pk_bf16(s[0], s[1]); pw0[1] = pk_bf16(s[2], s[3]); pw0[2] = pk_bf16(s[4], s[5]); pw0[3] = pk_bf16(s[6], s[7]);
    pw1[0] = pk_bf16(s[8], s[9]); pw1[1] = pk_bf16(s[10], s[11]); pw1[2] = pk_bf16(s[12], s[13]); pw1[3] = pk_bf16(s[14], s[15]);
    const bf16x8 pb0 = __builtin_bit_cast(bf16x8, pw0), pb1 = __builtin_bit_cast(bf16x8, pw1);
#pragma unroll
    for (int dh = 0; dh < 2; ++dh) {
        const bf16x8 va0 = (bf16x8){a[dh][0][0], a[dh][0][1], a[dh][0][2], a[dh][0][3], a[dh][1][0], a[dh][1][1], a[dh][1][2], a[dh][1][3]};
        const bf16x8 va1 = (bf16x8){a[dh][2][0], a[dh][2][1], a[dh][2][2], a[dh][2][3], a[dh][3][0], a[dh][3][1], a[dh][3][2], a[dh][3][3]};
        o[dh] = __builtin_amdgcn_mfma_f32_32x32x16_bf16(va0, pb0, o[dh], 0, 0, 0);
        o[dh] = __builtin_amdgcn_mfma_f32_32x32x16_bf16(va1, pb1, o[dh], 0, 0, 0);
    }
}

__device__ __forceinline__ void dma_k_rows8(const char* krow, const int row, ATT_LAS char* kdst, const int lane) {
    glds16(krow + 16 * ((lane & 7) ^ ((row >> 1) & 7)), (unsigned)__builtin_amdgcn_readfirstlane((int)(unsigned)(uintptr_t)kdst)); }
__device__ __forceinline__ void dma_v_rows8(const char* vrow, const int row, ATT_LAS char* vdst, const int lane) {
    glds16(vrow + 16 * ((lane & 7) ^ (((row >> 1) & 1) << 2)), (unsigned)__builtin_amdgcn_readfirstlane((int)(unsigned)(uintptr_t)vdst)); }
__device__ __forceinline__ void dil_pass1(const bf16x8 (&qf)[4], const int ng, const ATT_LAS char* kimg0  , const ATT_LAS float* tp0  ,
                                          u32x4 (&pw)[5][2], float& m_out, float& l_out, const int lane) {
    const int q = lane & 31, h = lane >> 5, kswz = (q >> 1) & 7;
    typedef float f32x2_ __attribute__((ext_vector_type(2)));
    f32x16 s[5]; float mx = -INFINITY;
#pragma unroll
    for (int g = 0; g < 5; ++g) if (g < ng) {
        f32x2_ t0, t1, t2, t3, t4, t5, t6, t7;
        { const unsigned ta = (unsigned)(uintptr_t)(tp0 + 32 * g - 27);
          asm volatile("ds_read2_b32 %0, %8 offset0:27 offset1:26\n\tds_read2_b32 %1, %8 offset0:25 offset1:24\n\tds_read2_b32 %2, %8 offset0:19 offset1:18\n\tds_read2_b32 %3, %8 offset0:17 offset1:16\n\t"
                       "ds_read2_b32 %4, %8 offset0:11 offset1:10\n\tds_read2_b32 %5, %8 offset0:9 offset1:8\n\tds_read2_b32 %6, %8 offset0:3 offset1:2\n\tds_read2_b32 %7, %8 offset0:1 offset1:0"
                       : "=&v"(t0), "=&v"(t1), "=&v"(t2), "=&v"(t3), "=&v"(t4), "=&v"(t5), "=&v"(t6), "=&v"(t7) : "v"(ta) : "memory"); }
        const ATT_LAS char* kr0 = kimg0 - g * 4096 + q * 128;
        f32x16 sg = f32x16{};
#pragma unroll
        for (int d0 = 0; d0 < 4; ++d0) { const bf16x8 kf = *(const ATT_LAS bf16x8*)(kr0 + 16 * ((2 * d0 + h) ^ kswz)); sg = __builtin_amdgcn_mfma_f32_32x32x16_bf16(kf, qf[d0], sg, 0, 0, 0); }
        asm volatile("s_waitcnt lgkmcnt(0)" : "+v"(t0), "+v"(t1), "+v"(t2), "+v"(t3), "+v"(t4), "+v"(t5), "+v"(t6), "+v"(t7) :: "memory");
        const float tb_[16] = {t0[0], t0[1], t1[0], t1[1], t2[0], t2[1], t3[0], t3[1], t4[0], t4[1], t5[0], t5[1], t6[0], t6[1], t7[0], t7[1]};
#pragma unroll
        for (int r = 0; r < 16; ++r) sg[r] = fmaf(sg[r], LOG2E, tb_[r]);
#pragma unroll
        for (int r = 0; r < 16; r += 2) mx = fmaxf(mx, fmaxf(sg[r], sg[r + 1]));
        s[g] = sg;
    }
    mx = fmaxf(mx, __shfl_xor(mx, 32));
    float ps = 0.f;
#pragma unroll
    for (int g = 0; g < 5; ++g) if (g < ng) {
        f32x16 p = s[g];
#pragma unroll
        for (int r = 0; r < 16; ++r) { p[r] = __builtin_amdgcn_exp2f(p[r] - mx); ps += p[r]; }
        pw[g][0][0] = pk_bf16(p[0], p[1]); pw[g][0][1] = pk_bf16(p[2], p[3]); pw[g][0][2] = pk_bf16(p[4], p[5]); pw[g][0][3] = pk_bf16(p[6], p[7]);
        pw[g][1][0] = pk_bf16(p[8], p[9]); pw[g][1][1] = pk_bf16(p[10], p[11]); pw[g][1][2] = pk_bf16(p[12], p[13]); pw[g][1][3] = pk_bf16(p[14], p[15]);
    }
    ps += __shfl_xor(ps, 32);
    m_out = mx; l_out = ps;
}
__device__ __forceinline__ void dil_pass2(const int ng, const ATT_LAS char* vimg0  , const u32x4 (&pw)[5][2], f32x16 (&o)[2], const int lane) {
    const int h = lane >> 5, q4 = (lane & 15) >> 2, p4 = lane & 3, g1 = (lane >> 4) & 1, vsw = (q4 >> 1) & 1;
    o[0] = f32x16{}; o[1] = f32x16{};
#pragma unroll
    for (int g = 0; g < 5; ++g) if (g < ng) {
        const ATT_LAS char* vg = vimg0 - g * 4096;
        const unsigned va0_ = (unsigned)(uintptr_t)(vg + (4 * h + q4) * 128 + 32 * g1 + 8 * p4 + 64 * vsw), va1_ = (unsigned)(uintptr_t)(vg + (4 * h + q4) * 128 + 32 * g1 + 8 * p4 + 64 * (1 ^ vsw));
        v4i16 a[2][4];
        asm volatile("ds_read_b64_tr_b16 %0, %8\n\tds_read_b64_tr_b16 %1, %8 offset:1024\n\tds_read_b64_tr_b16 %2, %8 offset:2048\n\tds_read_b64_tr_b16 %3, %8 offset:3072\n\t"
                     "ds_read_b64_tr_b16 %4, %9\n\tds_read_b64_tr_b16 %5, %9 offset:1024\n\tds_read_b64_tr_b16 %6, %9 offset:2048\n\tds_read_b64_tr_b16 %7, %9 offset:3072\n\ts_waitcnt lgkmcnt(0)"
                     : "=&v"(a[0][0]), "=&v"(a[0][1]), "=&v"(a[0][2]), "=&v"(a[0][3]), "=&v"(a[1][0]), "=&v"(a[1][1]), "=&v"(a[1][2]), "=&v"(a[1][3]) : "v"(va0_), "v"(va1_) : "memory");
        const bf16x8 pb0 = __builtin_bit_cast(bf16x8, pw[g][0]), pb1 = __builtin_bit_cast(bf16x8, pw[g][1]);
#pragma unroll
        for (int dh = 0; dh < 2; ++dh) {
            const bf16x8 va0 = (bf16x8){a[dh][0][0], a[dh][0][1], a[dh][0][2], a[dh][0][3], a[dh][1][0], a[dh][1][1], a[dh][1][2], a[dh][1][3]};
            const bf16x8 va1 = (bf16x8){a[dh][2][0], a[dh][2][1], a[dh][2][2], a[dh][2][3], a[dh][3][0], a[dh][3][1], a[dh][3][2], a[dh][3][3]};
            o[dh] = __builtin_amdgcn_mfma_f32_32x32x16_bf16(va0, pb0, o[dh], 0, 0, 0);
            o[dh] = __builtin_amdgcn_mfma_f32_32x32x16_bf16(va1, pb1, o[dh], 0, 0, 0);
        }
    }
}

template <bool NT>
__device__ __forceinline__ void store_o(const f32x16 (&o)[2], const float l, char* orow_q, const int h, const bool valid = true) {
    const float il = 1.0f / l;
#pragma unroll
    for (int dh = 0; dh < 2; ++dh)
#pragma unroll
        for (int jj = 0; jj < 2; ++jj) {
            u32x2 we, wo;
            we[0] = pk_bf16(o[dh][8 * jj] * il, o[dh][8 * jj + 1] * il); we[1] = pk_bf16(o[dh][8 * jj + 2] * il, o[dh][8 * jj + 3] * il);
            wo[0] = pk_bf16(o[dh][8 * jj + 4] * il, o[dh][8 * jj + 5] * il); wo[1] = pk_bf16(o[dh][8 * jj + 6] * il, o[dh][8 * jj + 7] * il);
            const unsigned s0 = h ? we[0] : wo[0], s1 = h ? we[1] : wo[1];
            const unsigned r0 = (unsigned)__shfl_xor((int)s0, 32), r1 = (unsigned)__shfl_xor((int)s1, 32);
            u32x4 w; if (h == 0) { w[0] = we[0]; w[1] = we[1]; w[2] = r0; w[3] = r1; } else { w[0] = r0; w[1] = r1; w[2] = wo[0]; w[3] = wo[1]; }
            u32x4* dst = (u32x4*)(orow_q + (32 * dh + 16 * jj + 8 * h) * 2);
            if (valid) { if (NT) __builtin_nontemporal_store(w, dst); else *dst = w; }
        }
}

template <bool NT>
__device__ __forceinline__ void store_o_staged(const f32x16 (&o)[2], const float l, ATT_LAS char* stg, char* base, const long rstride, const int lane) {
    const int q = lane & 31, h = lane >> 5; const float il = 1.0f / l;
#pragma unroll
    for (int dh = 0; dh < 2; ++dh)
#pragma unroll
        for (int jj = 0; jj < 2; ++jj) {
            u32x2 we, wo;
            we[0] = pk_bf16(o[dh][8 * jj] * il, o[dh][8 * jj + 1] * il); we[1] = pk_bf16(o[dh][8 * jj + 2] * il, o[dh][8 * jj + 3] * il);
            wo[0] = pk_bf16(o[dh][8 * jj + 4] * il, o[dh][8 * jj + 5] * il); wo[1] = pk_bf16(o[dh][8 * jj + 6] * il, o[dh][8 * jj + 7] * il);
            const unsigned s0 = h ? we[0] : wo[0], s1 = h ? we[1] : wo[1];
            const unsigned r0 = (unsigned)__shfl_xor((int)s0, 32), r1 = (unsigned)__shfl_xor((int)s1, 32);
            u32x4 w; if (h == 0) { w[0] = we[0]; w[1] = we[1]; w[2] = r0; w[3] = r1; } else { w[0] = r0; w[1] = r1; w[2] = wo[0]; w[3] = wo[1]; }
            *(ATT_LAS u32x4*)(stg + q * 128 + 16 * ((4 * dh + 2 * jj + h) ^ (q & 7))) = w;
        }
    asm volatile("s_waitcnt lgkmcnt(0)" ::: "memory");
#pragma unroll
    for (int i = 0; i < 4; ++i) { const int r = 8 * i + (lane >> 3), c = lane & 7;
        const u32x4 w = *(const ATT_LAS u32x4*)(stg + r * 128 + 16 * (c ^ (r & 7)));
        u32x4* dst = (u32x4*)(base + (long)r * rstride + 16 * c);
        if (NT) __builtin_nontemporal_store(w, dst); else *dst = w; }
    asm volatile("s_waitcnt lgkmcnt(0)" ::: "memory");
}

__device__ __forceinline__ unsigned moba_select(const char* qbase, const long qs, const float* km, const int qb) {
    const int lane = threadIdx.x & 63, q = lane & 31, h = lane >> 5;
    f32x16 g = f32x16{};
    const float* kmrow = km + (size_t)(q & 15) * 256;
    const bool lo_part = q >= 16;
#pragma unroll
    for (int d0 = 0; d0 < 4; ++d0) {
        const bf16x8 qf = *(const bf16x8*)(qbase + (long)q * qs + (16 * d0 + 8 * h) * 2);
        const f32x4 f0 = *(const f32x4*)(kmrow + 16 * d0 + 8 * h), f1 = *(const f32x4*)(kmrow + 16 * d0 + 8 * h + 4);
        float v[8] = {f0[0], f0[1], f0[2], f0[3], f1[0], f1[1], f1[2], f1[3]};
        u32x4 aw;
#pragma unroll
        for (int j = 0; j < 4; ++j) {
            const float h0 = bf16_round(v[2 * j]), h1 = bf16_round(v[2 * j + 1]);
            const float x0 = lo_part ? (v[2 * j] - h0) : h0, x1 = lo_part ? (v[2 * j + 1] - h1) : h1;
            aw[j] = pk_bf16(x0, x1);
        }
        g = __builtin_amdgcn_mfma_f32_32x32x16_bf16(__builtin_bit_cast(bf16x8, aw), qf, g, 0, 0, 0);
    }
    float gate[8], other[8];
#pragma unroll
    for (int r = 0; r < 8; ++r) { gate[r] = g[r] + g[r + 8]; }
#pragma unroll
    for (int r = 0; r < 8; ++r) { other[r] = __shfl_xor(gate[r], 32); }
    unsigned mymask = 0u;
#pragma unroll
    for (int r = 0; r < 8; ++r) {
        const int n = (r & 3) + 8 * (r >> 2) + 4 * h;
        int rank = 0;
#pragma unroll
        for (int r2 = 0; r2 < 8; ++r2) {
            const int n2 = (r2 & 3) + 8 * (r2 >> 2) + 4 * h, n3 = (r2 & 3) + 8 * (r2 >> 2) + 4 * (1 - h);
            if (r2 != r) rank += (n2 < qb && (gate[r2] > gate[r] || (gate[r2] == gate[r] && n2 < n))) ? 1 : 0;
            rank += (n3 < qb && (other[r2] > gate[r] || (other[r2] == gate[r] && n3 < n))) ? 1 : 0;
        }
        if (n < qb && rank < 3) mymask |= 1u << n;
    }
    return mymask | (unsigned)__shfl_xor((int)mymask, 32);
}
}


namespace mk {
using pg8::bf16_t; using pg8::bf16x8; using pg8::f32x4; using pg8::f32x2; using pg8::u32x4; using pg8::u32x2; using pg8::Unit; using pg8::cvt_pk_bf16;
#define LAS __attribute__((address_space(3)))
constexpr int NBAT = MK_NBAT, SEQ = 4096, D = 1024, DFF = 2816, NMEM = 256, M = NBAT * SEQ, MM = NBAT * NMEM, NQKV = 3072;
constexpr float EPS = 1e-6f, LOG2E = 1.4426950408889634f;
constexpr int NWAVES = 8, NPH = 13;
constexpr bool F8_1 = MK_FP8_FFN1 != 0, F8_2 = MK_FP8_FFN2 != 0;
constexpr float F8_WGU = 64.f, F8_H = 4.f, F8_WD = 128.f;

constexpr size_t al256(size_t x) { return (x + 255) / 256 * 256; }
constexpr size_t WS_CTL = 0, CTL_BYTES = 1u << 20;
constexpr size_t WS_WGU1 = WS_CTL + CTL_BYTES;
constexpr size_t WS_WD1 = WS_WGU1 + (size_t)2 * DFF * D * 2;
constexpr size_t WS_WIN = WS_WD1 + (size_t)D * DFF * 2;
constexpr size_t WS_WOUT = WS_WIN + (size_t)NQKV * D * 2;
constexpr size_t WS_WCQS = WS_WOUT + (size_t)D * D * 2;
constexpr size_t WS_WCKV = WS_WCQS + (size_t)D * D * 2;
constexpr size_t WS_WCO = WS_WCKV + (size_t)2 * D * D * 2;
constexpr size_t WS_WGU2 = WS_WCO + (size_t)D * D * 2;
constexpr size_t WS_WD2 = WS_WGU2 + (size_t)2 * DFF * D * 2;
constexpr size_t WS_MB = WS_WD2 + (size_t)D * DFF * 2;
constexpr size_t WS_KVC = WS_MB + (size_t)MM * D * 2;
constexpr size_t WS_WKT = WS_KVC + (size_t)MM * 2 * D * 2;
constexpr size_t WS_VWT = WS_WKT + (size_t)NBAT * D * D * 2;
constexpr size_t SS_BYTES = (size_t)M * 16 * 4;
constexpr size_t WS_SS = WS_VWT + (size_t)NBAT * D * D * 2;
constexpr size_t WS_SSM = WS_SS + 5 * SS_BYTES;
constexpr size_t WS_KM = WS_SSM + (size_t)MM * 16 * 4;
constexpr size_t WS_R1 = al256(WS_KM + (size_t)NBAT * 16 * 256 * 4);
constexpr size_t WS_X8 = WS_R1 + al256((size_t)M * DFF);
static_assert(WS_X8 >= WS_R1 + (size_t)M * D * 2 && WS_X8 + (size_t)M * D <= WS_R1 + (size_t)M * NQKV * 2, "X8 inside R1");
constexpr size_t WS_XB = WS_R1 + (size_t)M * NQKV * 2;
constexpr size_t WS_OA2 = WS_XB + (size_t)M * D * 2;
constexpr size_t WS_SEL = WS_OA2 + (size_t)M * 768 * 2;
constexpr size_t WS_OBP = WS_SEL + (size_t)NBAT * 4 * SEQ * 4;
constexpr size_t WS_MLB = WS_OBP + (size_t)4 * M * 256 * 2;
constexpr size_t WS_END = WS_MLB + (size_t)4 * M * 4 * 2 * 4;
constexpr size_t OUT_OA1 = (size_t)M * 768 * 2, OUT_OB = 2 * OUT_OA1, OUT_ML = OUT_OB + (size_t)M * 256 * 2;
static_assert(OUT_ML + (size_t)3 * M * 12 * 8 <= (size_t)M * D * 4, "attention partials fit in d_out");
constexpr int CW_BAR = 4096, CW_QUEUE = 8192;

constexpr int LDS_XCH = 131072;
constexpr int LDS_MISC = 131072 + 8192;
constexpr int LDS_BYTES = 147456;
constexpr int LDS_TAB = 98304;
static_assert(LDS_TAB + 4 * att::TABB_N * 4 <= LDS_XCH, "attention LDS map");

__device__ __forceinline__ float wave_sum(float v) {
#pragma unroll
    for (int o = 1; o < 64; o <<= 1) v += __shfl_xor(v, o);
    return v;
}
__device__ __forceinline__ unsigned pk_fp8x4(float a, float b, float c, float d) { int r = __builtin_amdgcn_cvt_pk_fp8_f32(a, b, 0, false); r = __builtin_amdgcn_cvt_pk_fp8_f32(c, d, r, true); return (unsigned)r; }
__device__ __forceinline__ float row_rstd(const float* ss, int row) {
    const f32x4* p = (const f32x4*)(ss + (size_t)row * 16);
    const f32x4 a = p[0], b = p[1], c = p[2], d = p[3];
    const float s = ((a[0] + a[1]) + (a[2] + a[3])) + ((b[0] + b[1]) + (b[2] + b[3])) + ((c[0] + c[1]) + (c[2] + c[3])) + ((d[0] + d[1]) + (d[2] + d[3]));
    return 1.0f / sqrtf(s * (1.0f / D) + EPS);
}

struct SchedStd {
    pg8::Order o; const char* A; const char* B; size_t a_tile, b_tile, b_batch; int ocol_mul;
    __device__ __forceinline__ bool next(int i, Unit& u) const { int pm, pn; if (!o.tile(i, pm, pn)) return false;
        u.a = A + (size_t)pm * a_tile; u.b = B + (size_t)pn * b_tile + (size_t)(pm >> 4) * b_batch; u.orow = pm * 256; u.ocol = pn * ocol_mul; u.aux = pn; return true; }
};
struct SchedWK {
    int G, c; const char* kvc; const char* wcqs;
    __device__ __forceinline__ bool next(int i, Unit& u) const { const int L = i * G + c; if (L >= NBAT * 16) return false; const int bh = L >> 2, pn = L & 3, b = bh >> 2, h = bh & 3;
        u.a = kvc + ((size_t)(b * 256) * 2048 + h * 256) * 2; u.b = wcqs + ((size_t)(pn * 256) * 1024 + h * 256) * 2; u.orow = b * 1024 + h * 256; u.ocol = pn * 256; u.aux = 0; return true; }
};
struct SchedVW {
    int G, c; const char* kvc; const char* wcot;
    __device__ __forceinline__ bool next(int i, Unit& u) const { const int L = i * G + c; if (L >= NBAT * 16) return false; const int bh = L >> 2, pm = L & 3, b = bh >> 2, h = bh & 3;
        u.a = wcot + ((size_t)(pm * 256) * 1024 + h * 256) * 2; u.b = kvc + ((size_t)(b * 256) * 2048 + 1024 + h * 256) * 2; u.orow = b * 1024 + pm * 256; u.ocol = h * 256; u.aux = 0; return true; }
};

template <bool F8> struct EpiGU { static constexpr bool PERM = true;
    void* H; const float* ss;
    __device__ __forceinline__ void operator()(const f32x4 (&acc)[2][2][4][2], const Unit& u, int wr, int wc, int fr, int fq, LAS unsigned char*, int, int) const {
        float rsv[2][4];
#pragma unroll
        for (int ai = 0; ai < 2; ++ai)
#pragma unroll
            for (int m = 0; m < 4; ++m) rsv[ai][m] = row_rstd(ss, u.orow + ai * 128 + wr * 64 + m * 16 + fr) * (F8 ? 1.0f / F8_WGU : 1.0f);
#pragma unroll
        for (int ai = 0; ai < 2; ++ai)
#pragma unroll
            for (int m = 0; m < 4; ++m) { const int row = u.orow + ai * 128 + wr * 64 + m * 16 + fr; const float rs = rsv[ai][m];
                float hv[8];
#pragma unroll
                for (int n = 0; n < 2; ++n)
#pragma unroll
                    for (int j = 0; j < 4; ++j) { const float g = acc[ai][0][m][n][j] * rs, uu = acc[ai][1][m][n][j] * rs;
                        hv[4 * n + j] = g * __builtin_amdgcn_rcpf(1.0f + __builtin_amdgcn_exp2f(-g * LOG2E)) * uu; }
                if constexpr (F8) { u32x2 w; w[0] = pk_fp8x4(hv[0] * F8_H, hv[1] * F8_H, hv[2] * F8_H, hv[3] * F8_H); w[1] = pk_fp8x4(hv[4] * F8_H, hv[5] * F8_H, hv[6] * F8_H, hv[7] * F8_H);
                    __builtin_nontemporal_store(w, (u32x2*)((unsigned char*)H + (size_t)row * DFF + u.ocol + wc * 32 + 8 * fq)); }
                else { u32x4 w; w[0] = cvt_pk_bf16(hv[0], hv[1]); w[1] = cvt_pk_bf16(hv[2], hv[3]); w[2] = cvt_pk_bf16(hv[4], hv[5]); w[3] = cvt_pk_bf16(hv[6], hv[7]);
                    __builtin_nontemporal_store(w, (u32x4*)((bf16_t*)H + (size_t)row * DFF + u.ocol + wc * 32 + 8 * fq)); } }
    }
};
template <bool X8> struct EpiRes { static constexpr bool PERM = true;
    bf16_t* xb; float* ssout; float alpha; unsigned char* x8;
    __device__ __forceinline__ void operator()(const f32x4 (&acc)[2][2][4][2], const Unit& u, int wr, int wc, int fr, int fq, LAS unsigned char*, int, int) const {
        const size_t off0 = (size_t)(u.orow + wr * 64 + fr) * D + u.ocol + wc * 32 + 8 * fq;
        u32x4 cur[2], nxt[2];
#pragma unroll
        for (int bj = 0; bj < 2; ++bj) cur[bj] = *(const u32x4*)(xb + off0 + bj * 128);
#pragma unroll
        for (int idx = 0; idx < 8; ++idx) { const int ai = idx >> 2, m = idx & 3; const size_t off = off0 + (size_t)(ai * 128 + m * 16) * D; const int row = u.orow + ai * 128 + wr * 64 + m * 16 + fr;
            if (idx < 7) { const size_t offn = off0 + (size_t)(((idx + 1) >> 2) * 128 + ((idx + 1) & 3) * 16) * D;
#pragma unroll
                for (int bj = 0; bj < 2; ++bj) nxt[bj] = *(const u32x4*)(xb + offn + bj * 128); }
            float sq = 0.f;
#pragma unroll
            for (int bj = 0; bj < 2; ++bj) { float o[8];
#pragma unroll
                for (int n = 0; n < 2; ++n)
#pragma unroll
                    for (int j = 0; j < 4; ++j) { const unsigned wv = cur[bj][2 * n + (j >> 1)]; const float r = __builtin_bit_cast(float, (j & 1) ? (wv & 0xffff0000u) : (wv << 16));
                        const float v = r + acc[ai][bj][m][n][j] * alpha; o[4 * n + j] = v; sq += v * v; }
                u32x4 w; w[0] = cvt_pk_bf16(o[0], o[1]); w[1] = cvt_pk_bf16(o[2], o[3]); w[2] = cvt_pk_bf16(o[4], o[5]); w[3] = cvt_pk_bf16(o[6], o[7]);
                *(u32x4*)(xb + off + bj * 128) = w;
                if constexpr (X8) { u32x2 w8; w8[0] = pk_fp8x4(o[0], o[1], o[2], o[3]); w8[1] = pk_fp8x4(o[4], o[5], o[6], o[7]); *(u32x2*)(x8 + off + bj * 128) = w8; } }
            sq += __shfl_xor(sq, 16); sq += __shfl_xor(sq, 32);
            if (fq == 0) ssout[(size_t)row * 16 + (u.ocol >> 8) * 4 + wc] = sq;
#pragma unroll
            for (int bj = 0; bj < 2; ++bj) cur[bj] = nxt[bj]; }
    }
};
struct EpiStore { static constexpr bool PERM = true;
    bf16_t* O; int ldc; const float* ss; float* km; bool nt;
    __device__ __forceinline__ void operator()(const f32x4 (&acc)[2][2][4][2], const Unit& u, int wr, int wc, int fr, int fq, LAS unsigned char*, int, int) const {
        float rsv[2][4];
#pragma unroll
        for (int ai = 0; ai < 2; ++ai)
#pragma unroll
            for (int m = 0; m < 4; ++m) rsv[ai][m] = ss ? row_rstd(ss, u.orow + ai * 128 + wr * 64 + m * 16 + fr) : 1.0f;
#pragma unroll
        for (int ai = 0; ai < 2; ++ai)
#pragma unroll
            for (int m = 0; m < 4; ++m) { const int row = u.orow + ai * 128 + wr * 64 + m * 16 + fr; const float rs = rsv[ai][m];
                const int col0 = u.ocol + wc * 32 + 8 * fq;
                bf16_t* rowp = ldc ? O + (size_t)row * ldc + col0 : O + (((size_t)(row / SEQ) * (NQKV / 64) + (col0 >> 6)) * SEQ + (row % SEQ)) * 64 + (col0 & 63);
                const size_t bjstep = ldc ? 128 : (size_t)2 * SEQ * 64;
#pragma unroll
                for (int bj = 0; bj < 2; ++bj) { const f32x4 v0 = acc[ai][bj][m][0] * rs, v1 = acc[ai][bj][m][1] * rs;
                    u32x4 w; w[0] = cvt_pk_bf16(v0[0], v0[1]); w[1] = cvt_pk_bf16(v0[2], v0[3]); w[2] = cvt_pk_bf16(v1[0], v1[1]); w[3] = cvt_pk_bf16(v1[2], v1[3]);
                    if (nt) __builtin_nontemporal_store(w, (u32x4*)(rowp + bj * bjstep)); else *(u32x4*)(rowp + bj * bjstep) = w; } }
        if ((km != nullptr) && (u.aux == 10)) {
            float* kmb = km + (size_t)(u.orow >> 8) * 256 + wc * 32 + 8 * fq;
#pragma unroll
            for (int bj = 0; bj < 2; ++bj)
#pragma unroll
                for (int n = 0; n < 2; ++n) { f32x4 cs = (f32x4){0.f, 0.f, 0.f, 0.f};
#pragma unroll
                    for (int ai = 0; ai < 2; ++ai)
#pragma unroll
                        for (int m = 0; m < 4; ++m) cs += acc[ai][bj][m][n] * rsv[ai][m];
#pragma unroll
                    for (int j = 0; j < 4; ++j) { float v = cs[j]; v += __shfl_xor(v, 1); v += __shfl_xor(v, 2); v += __shfl_xor(v, 4); v += __shfl_xor(v, 8);
                        if (fr == 0) atomicAdd(kmb + bj * 128 + 4 * n + j, v); } }
        }
    }
};
struct EpiSoftmax { static constexpr bool PERM = true;
    bf16_t* P; const float* ss;
    __device__ __forceinline__ void operator()(const f32x4 (&acc)[2][2][4][2], const Unit& u, int wr, int wc, int fr, int fq, LAS unsigned char* lds, int, int) const {
        LAS f32x2* X = (LAS f32x2*)(lds + LDS_XCH);
        float rsl[2][4], mw[2][4];
#pragma unroll
        for (int ai = 0; ai < 2; ++ai)
#pragma unroll
            for (int m = 0; m < 4; ++m) { const int rl = ai * 128 + wr * 64 + m * 16 + fr; const float rs = row_rstd(ss, u.orow + rl) * LOG2E; rsl[ai][m] = rs;
                float mx = -INFINITY;
#pragma unroll
                for (int bj = 0; bj < 2; ++bj)
#pragma unroll
                    for (int n = 0; n < 2; ++n)
#pragma unroll
                        for (int j = 0; j < 4; ++j) mx = fmaxf(mx, acc[ai][bj][m][n][j] * rs);
                mx = fmaxf(mx, __shfl_xor(mx, 16)); mx = fmaxf(mx, __shfl_xor(mx, 32));
                float sm = 0.f;
#pragma unroll
                for (int bj = 0; bj < 2; ++bj)
#pragma unroll
                    for (int n = 0; n < 2; ++n)
#pragma unroll
                        for (int j = 0; j < 4; ++j) sm += __builtin_amdgcn_exp2f(acc[ai][bj][m][n][j] * rs - mx);
                sm += __shfl_xor(sm, 16); sm += __shfl_xor(sm, 32);
                mw[ai][m] = mx;
                if (fq == 0) X[rl * 4 + wc] = (f32x2){mx, sm}; }
        asm volatile("s_waitcnt lgkmcnt(0)" ::: "memory"); __builtin_amdgcn_s_barrier(); asm volatile("" ::: "memory");
#pragma unroll
        for (int ai = 0; ai < 2; ++ai)
#pragma unroll
            for (int m = 0; m < 4; ++m) { const int rl = ai * 128 + wr * 64 + m * 16 + fr; const float rs = rsl[ai][m];
                const f32x2 x0 = X[rl * 4 + 0], x1 = X[rl * 4 + 1], x2 = X[rl * 4 + 2], x3 = X[rl * 4 + 3];
                const float Mx = fmaxf(fmaxf(x0[0], x1[0]), fmaxf(x2[0], x3[0]));
                const float L = x0[1] * __builtin_amdgcn_exp2f(x0[0] - Mx) + x1[1] * __builtin_amdgcn_exp2f(x1[0] - Mx) + x2[1] * __builtin_amdgcn_exp2f(x2[0] - Mx) + x3[1] * __builtin_amdgcn_exp2f(x3[0] - Mx);
                const float il = 1.0f / L;
                bf16_t* rowp = P + (size_t)(u.orow + rl) * D + u.ocol + wc * 32 + 8 * fq;
#pragma unroll
                for (int bj = 0; bj < 2; ++bj) { float pv[8];
#pragma unroll
                    for (int n = 0; n < 2; ++n)
#pragma unroll
                        for (int j = 0; j < 4; ++j) pv[4 * n + j] = __builtin_amdgcn_exp2f(acc[ai][bj][m][n][j] * rs - Mx) * il;
                    u32x4 w; w[0] = cvt_pk_bf16(pv[0], pv[1]); w[1] = cvt_pk_bf16(pv[2], pv[3]); w[2] = cvt_pk_bf16(pv[4], pv[5]); w[3] = cvt_pk_bf16(pv[6], pv[7]);
                    *(u32x4*)(rowp + bj * 128) = w; } }
        (void)mw;
    }
};

#define XB_TMO      128
#define XB_XCNT(j)  (256  + 64 * (j))
#define XB_XSUB(j)  (1280 + 64 * (j))
#define XB_XGEN(j)  (2304 + 64 * (j))
#define XB_TOP      3328
#define XB_TOPGEN   3392
#define XCD_BAR_WORDS 3456
#define XB_SPIN_CAP (1u << 18)
__device__ __forceinline__ unsigned xb_ld(unsigned* p)              { return __hip_atomic_load(p, __ATOMIC_RELAXED, __HIP_MEMORY_SCOPE_AGENT); }
__device__ __forceinline__ unsigned xb_add(unsigned* p, unsigned v) { return __hip_atomic_fetch_add(p, v, __ATOMIC_RELAXED, __HIP_MEMORY_SCOPE_AGENT); }
__device__ __forceinline__ unsigned xb_xcc_id() { return (unsigned)__builtin_amdgcn_s_getreg((3 << 11) | 20) & 0xFu; }
#define XB_SPIN(cond, bar) do { unsigned _sp = 0; while (cond) { __builtin_amdgcn_s_sleep(1); \
    if ((++_sp & 255u) == 0u) { if (xb_ld(&(bar)[XB_TMO])) break; if (_sp > XB_SPIN_CAP) { atomicAdd(&(bar)[XB_TMO], 1u); break; } } } } while (0)
struct XcdBarrier { unsigned* bar; unsigned x; volatile LAS unsigned* st; };
__device__ __forceinline__ XcdBarrier xcd_barrier_post(unsigned* bar, volatile LAS unsigned* st) {
    XcdBarrier b; b.bar = bar; b.x = xb_xcc_id(); b.st = st;
    if (threadIdx.x == 0) (void)xb_add(&bar[XB_XCNT(b.x)], 1u);
    return b;
}
__device__ __forceinline__ void xcd_barrier_complete(unsigned* bar, unsigned x, unsigned& nloc, unsigned& nx) {
    const unsigned G = gridDim.x * gridDim.y * gridDim.z;
    unsigned sum, cnt, mine, sp = 0u;
    for (;;) {
        sum = 0u; cnt = 0u; mine = 0u;
#pragma unroll
        for (unsigned j = 0; j < 16; ++j) { const unsigned c = xb_ld(&bar[XB_XCNT(j)]); sum += c; cnt += (c > 0u) ? 1u : 0u; mine = (j == x) ? c : mine; }
        if (sum == G) break;
        __builtin_amdgcn_s_sleep(1);
        if ((++sp & 255u) == 0u) { if (xb_ld(&bar[XB_TMO])) break; if (sp > XB_SPIN_CAP) { atomicAdd(&bar[XB_TMO], 1u); break; } }
    }
    nloc = mine > 0u ? mine : 1u; nx = cnt > 0u ? cnt : 1u;
}
__device__ __forceinline__ void xcd_barrier(const XcdBarrier& b) {
    asm volatile("s_waitcnt vmcnt(0)" ::: "memory");
    __syncthreads();
    if (threadIdx.x == 0) {
        unsigned* bar = b.bar;
        __builtin_amdgcn_s_waitcnt(0);
        unsigned nloc = b.st[0], nx = b.st[1];
        if (nloc == 0u) { xcd_barrier_complete(bar, b.x, nloc, nx); b.st[0] = nloc; b.st[1] = nx; }
        const unsigned old = xb_add(&bar[XB_XSUB(b.x)], 1u);
        const unsigned gen = old / nloc;
        if (old + 1u == (gen + 1u) * nloc) {
            __builtin_amdgcn_fence(__ATOMIC_RELEASE, "agent");
            asm volatile("s_waitcnt vmcnt(0)" ::: "memory");
            const unsigned og = xb_add(&bar[XB_TOP], 1u);
            const unsigned tg = og / nx;
            if (og + 1u == (tg + 1u) * nx) xb_add(&bar[XB_TOPGEN], 1u);
            else XB_SPIN(xb_ld(&bar[XB_TOPGEN]) == tg, bar);
            __builtin_amdgcn_fence(__ATOMIC_ACQUIRE, "agent");
            xb_add(&bar[XB_XGEN(b.x)], 1u);
            asm volatile("s_waitcnt vmcnt(0)" ::: "memory");
        } else {
            XB_SPIN(xb_ld(&bar[XB_XGEN(b.x)]) == gen, bar);
            __builtin_amdgcn_fence(__ATOMIC_ACQUIRE, "agent");
            asm volatile("s_waitcnt vmcnt(0)" ::: "memory");
        }
    }
    __syncthreads();
}

template <bool F8>
__device__ __forceinline__ void tr_item(const float* W, int N, int k0, int n0, const float* gain, float cscale, void* dst  , int Kd, LAS float* scr, int lane) {
    f32x4 v[8]; float g[8];
#pragma unroll
    for (int i = 0; i < 8; ++i) { const int kk = 8 * i + (lane >> 3); v[i] = __builtin_nontemporal_load((const f32x4*)(W + (size_t)(k0 + kk) * N + n0 + 4 * (lane & 7))); g[i] = gain ? gain[k0 + kk] * cscale : cscale; }
#pragma unroll
    for (int i = 0; i < 8; ++i) { const int kk = 8 * i + (lane >> 3); LAS float* d = scr + kk * 33 + 4 * (lane & 7); d[0] = v[i][0] * g[i]; d[1] = v[i][1] * g[i]; d[2] = v[i][2] * g[i]; d[3] = v[i][3] * g[i]; }
    asm volatile("s_waitcnt lgkmcnt(0)" ::: "memory");
    const int c = lane & 7;
#pragma unroll
    for (int j = 0; j < 4; ++j) { const int n = (lane >> 3) + 8 * j; const LAS float* s = scr + (8 * c) * 33 + n;
        if constexpr (F8) { u32x2 o; o[0] = pk_fp8x4(s[0 * 33], s[1 * 33], s[2 * 33], s[3 * 33]); o[1] = pk_fp8x4(s[4 * 33], s[5 * 33], s[6 * 33], s[7 * 33]); *(u32x2*)((unsigned char*)dst + (size_t)n * Kd + k0 + 8 * c) = o; }
        else { u32x4 o; o[0] = cvt_pk_bf16(s[0 * 33], s[1 * 33]); o[1] = cvt_pk_bf16(s[2 * 33], s[3 * 33]); o[2] = cvt_pk_bf16(s[4 * 33], s[5 * 33]); o[3] = cvt_pk_bf16(s[6 * 33], s[7 * 33]);
            *(u32x4*)((bf16_t*)dst + (size_t)n * Kd + k0 + 8 * c) = o; } }
    asm volatile("s_waitcnt lgkmcnt(0)" ::: "memory");
}
template <int NR>
__device__ __forceinline__ void cvt_rows(const float* x, bf16_t* o, unsigned char* o8  , float* ss, int row0, int stride, int nrows, int lane) {
    f32x4 v[NR][4]; float s[NR];
#pragma unroll
    for (int r = 0; r < NR; ++r) { const int row = row0 + r * stride; const f32x4* xr = (const f32x4*)(x + (size_t)(row < nrows ? row : row0) * D) + lane;
#pragma unroll
        for (int j = 0; j < 4; ++j) v[r][j] = __builtin_nontemporal_load(xr + 64 * j); }
#pragma unroll
    for (int r = 0; r < NR; ++r) { float a = 0.f;
#pragma unroll
        for (int j = 0; j < 4; ++j) a += (v[r][j][0] * v[r][j][0] + v[r][j][1] * v[r][j][1]) + (v[r][j][2] * v[r][j][2] + v[r][j][3] * v[r][j][3]);
        s[r] = a; }
#pragma unroll
    for (int of = 1; of < 64; of <<= 1)
#pragma unroll
        for (int r = 0; r < NR; ++r) s[r] += __shfl_xor(s[r], of);
#pragma unroll
    for (int r = 0; r < NR; ++r) { const int row = row0 + r * stride; if (row < nrows) { u32x2* ob = (u32x2*)(o + (size_t)row * D) + lane;
#pragma unroll
            for (int j = 0; j < 4; ++j) { u32x2 w; w[0] = cvt_pk_bf16(v[r][j][0], v[r][j][1]); w[1] = cvt_pk_bf16(v[r][j][2], v[r][j][3]); ob[64 * j] = w; }
            if (o8) { unsigned* oq = (unsigned*)(o8 + (size_t)row * D) + lane;
#pragma unroll
                for (int j = 0; j < 4; ++j) oq[64 * j] = pk_fp8x4(v[r][j][0], v[r][j][1], v[r][j][2], v[r][j][3]); }
            if (lane < 16) ss[(size_t)row * 16 + lane] = lane == 0 ? s[r] : 0.f; } }
}

struct Args { const float* in[20]; float* out; unsigned char* ws; int ph_lo, ph_hi, flags, pad; };

#define MK_PTRS unsigned char* ws = args.ws; float* out = args.out; asm volatile("" : "+s"(ws), "+s"(out)); \
    const float* x_in = args.in[0]; const float* mem_in = args.in[1]; const float* rel_bias = args.in[7]; \
    bf16_t* Wgu1 = (bf16_t*)(ws + WS_WGU1); bf16_t* Wd1 = (bf16_t*)(ws + WS_WD1); bf16_t* Win = (bf16_t*)(ws + WS_WIN); bf16_t* Wout = (bf16_t*)(ws + WS_WOUT); \
    bf16_t* Wcqs = (bf16_t*)(ws + WS_WCQS); bf16_t* Wckv = (bf16_t*)(ws + WS_WCKV); bf16_t* Wco = (bf16_t*)(ws + WS_WCO); bf16_t* Wgu2 = (bf16_t*)(ws + WS_WGU2); bf16_t* Wd2 = (bf16_t*)(ws + WS_WD2); \
    bf16_t* MB = (bf16_t*)(ws + WS_MB); bf16_t* KVC = (bf16_t*)(ws + WS_KVC); bf16_t* WKT = (bf16_t*)(ws + WS_WKT); bf16_t* VWT = (bf16_t*)(ws + WS_VWT); \
    float* SS0 = (float*)(ws + WS_SS); float* SS1 = SS0 + (size_t)M * 16; float* SS2 = SS1 + (size_t)M * 16; float* SS3 = SS2 + (size_t)M * 16; float* SS4 = SS3 + (size_t)M * 16; \
    float* SSM = (float*)(ws + WS_SSM); float* KM = (float*)(ws + WS_KM); \
    bf16_t* HB = (bf16_t*)(ws + WS_R1); bf16_t* QKV = HB; bf16_t* YN = HB; bf16_t* PB = HB; \
    bf16_t* XB = (bf16_t*)(ws + WS_XB); unsigned char* X8 = ws + WS_X8; (void)X8; bf16_t* OA0 = (bf16_t*)out; bf16_t* OA1 = (bf16_t*)((char*)out + OUT_OA1); bf16_t* OA2 = (bf16_t*)(ws + WS_OA2); bf16_t* OB = (bf16_t*)((char*)out + OUT_OB); float* ML = (float*)((char*)out + OUT_ML); unsigned* SEL = (unsigned*)(ws + WS_SEL); bf16_t* OBP = (bf16_t*)(ws + WS_OBP); float* MLB = (float*)(ws + WS_MLB); (void)OB;
__global__ void __launch_bounds__(NWAVES * 64, 2) mk_fwd(Args args) {
    extern __shared__ __attribute__((aligned(16))) unsigned char lds_raw[];
    LAS unsigned char* lds = (LAS unsigned char*)lds_raw;
    const int tid = threadIdx.x, lane = tid & 63, wave = __builtin_amdgcn_readfirstlane(tid >> 6);
    const int G = gridDim.x, bx = blockIdx.x;
    const int vcu = (G % 8 == 0) ? (bx % 8) * (G / 8) + bx / 8 : bx;
    const int gw = vcu * NWAVES + wave, NGW = G * NWAVES;
    unsigned char* const ws0 = args.ws;
    volatile LAS unsigned* MISC = (volatile LAS unsigned*)(lds + LDS_MISC);
    if (tid < 32) MISC[tid] = 0u;
    __syncthreads();
    const int lo = args.ph_lo, hi = args.ph_hi;
    const bool use_bar = (hi - lo) > 1;
    XcdBarrier bar; bar.bar = (unsigned*)(ws0 + WS_CTL) + CW_BAR; bar.x = 0; bar.st = nullptr;
    if (use_bar) bar = xcd_barrier_post((unsigned*)(ws0 + WS_CTL) + CW_BAR, MISC + 8);
#define IN(k) (lo <= (k) && (k) < hi)
#define STAGGER() do { if (MK_STAGGER_TICKS > 0) { const unsigned long long t0_ = __builtin_amdgcn_s_memrealtime(), dl_ = (unsigned long long)((bx >> 3) & 3) * MK_STAGGER_TICKS; while (__builtin_amdgcn_s_memrealtime() - t0_ < dl_) __builtin_amdgcn_s_sleep(8); } } while (0)
#define SEAM(k) do { if (IN(k) && IN((k) + 1)) xcd_barrier(bar); } while (0)

    if (IN(0)) {
        MK_PTRS;
        LAS float* scr = (LAS float*)(lds + wave * 16384);
        constexpr int I_GU = (D / 64) * (2 * DFF / 32), I_DN = (DFF / 64) * (D / 32), I_IN = (D / 64) * (NQKV / 32), I_SQ = (D / 64) * (D / 32), I_KV = (D / 64) * (2 * D / 32);
        constexpr int NITEMS = 2 * I_GU + 2 * I_DN + I_IN + 2 * I_SQ + I_KV;
        for (int it = gw; it < NITEMS; it += NGW) {
            int r = it;
            if (r < 2 * I_GU) {
                const bool second = r >= I_GU; if (second) r -= I_GU;
                const int nblk = 2 * DFF / 32, kb = r / nblk, nb = r % nblk, n0 = nb * 32;
                const int drow = n0 < DFF ? (n0 / 128) * 256 + (n0 % 128) : ((n0 - DFF) / 128) * 256 + 128 + ((n0 - DFF) % 128);
                if (second ? F8_2 : F8_1) tr_item<true>(args.in[second ? 17 : 3], 2 * DFF, kb * 64, n0, args.in[second ? 16 : 2], F8_WGU, (unsigned char*)(second ? Wgu2 : Wgu1) + (size_t)drow * D, D, scr, lane);
                else tr_item<false>(args.in[second ? 17 : 3], 2 * DFF, kb * 64, n0, args.in[second ? 16 : 2], 1.0f, (second ? Wgu2 : Wgu1) + (size_t)drow * D, D, scr, lane);
                continue; }
            r -= 2 * I_GU;
            if (r < 2 * I_DN) { const bool second = r >= I_DN; if (second) r -= I_DN; const int nblk = D / 32, kb = r / nblk, nb = r % nblk;
                if (second ? F8_2 : F8_1) tr_item<true>(args.in[second ? 18 : 4], D, kb * 64, nb * 32, nullptr, F8_WD, (unsigned char*)(second ? Wd2 : Wd1) + (size_t)(nb * 32) * DFF, DFF, scr, lane);
                else tr_item<false>(args.in[second ? 18 : 4], D, kb * 64, nb * 32, nullptr, 1.0f, (second ? Wd2 : Wd1) + (size_t)(nb * 32) * DFF, DFF, scr, lane);
                continue; }
            r -= 2 * I_DN;
            if (r < I_IN) { const int nblk = NQKV / 32, kb = r / nblk, nb = r % nblk, n0 = nb * 32; const bool isq = (n0 < 768) || (n0 >= 2304 && n0 < 2560);
                tr_item<false>(args.in[6], NQKV, kb * 64, n0, args.in[5], isq ? 0.125f : 1.0f, Win + (size_t)n0 * D, D, scr, lane); continue; }
            r -= I_IN;
            if (r < I_SQ) { const int nblk = D / 32, kb = r / nblk, nb = r % nblk, k0 = kb * 64; const float* gp = k0 < 768 ? args.in[8] : args.in[9] - 768;
                tr_item<false>(args.in[10], D, k0, nb * 32, gp, 1.0f, Wout + (size_t)(nb * 32) * D, D, scr, lane); continue; }
            r -= I_SQ;
            if (r < I_SQ) { const int nblk = D / 32, kb = r / nblk, nb = r % nblk; tr_item<false>(args.in[15], D, kb * 64, nb * 32, nullptr, 1.0f, Wco + (size_t)(nb * 32) * D, D, scr, lane); continue; }
            r -= I_SQ;
            { const int nblk = 2 * D / 32, kb = r / nblk, nb = r % nblk; tr_item<false>(args.in[14], 2 * D, kb * 64, nb * 32, args.in[12], 1.0f, Wckv + (size_t)(nb * 32) * D, D, scr, lane); }
        }
        for (int c = gw; c < D; c += NGW) { const float g = args.in[11][c] * 0.0625f; const f32x4* src = (const f32x4*)(args.in[13] + (size_t)c * D) + lane; u32x2* dst = (u32x2*)(Wcqs + (size_t)c * D) + lane;
#pragma unroll
            for (int j = 0; j < 4; ++j) { const f32x4 v = src[64 * j] * g; u32x2 w; w[0] = cvt_pk_bf16(v[0], v[1]); w[1] = cvt_pk_bf16(v[2], v[3]); dst[64 * j] = w; } }
        for (int m = gw; m < M; m += 4 * NGW) cvt_rows<4>(x_in, XB, F8_1 ? X8 : nullptr, SS0, m, NGW, M, lane);
        for (int m = gw; m < MM; m += NGW) cvt_rows<1>(mem_in, MB, nullptr, SSM, m, NGW, MM, lane);
        for (int i = gw * 64 + lane; i < NBAT * 16 * 256; i += NGW * 64) KM[i] = 0.f;
    }
    SEAM(0);

    if (IN(1)) {
        MK_PTRS;
        STAGGER();
        { constexpr int EB = F8_1 ? 1 : 2;
          SchedStd S; S.o.init(M, 2 * DFF, G, bx); S.A = F8_1 ? (const char*)X8 : (const char*)XB; S.B = (const char*)Wgu1; S.a_tile = (size_t)256 * D * EB; S.b_tile = (size_t)256 * D * EB; S.b_batch = 0; S.ocol_mul = 128;
          EpiGU<F8_1> E{HB, SS0}; pg8::gemm_phase<EpiGU<F8_1>, SchedStd, true, F8_1>(lds, D * EB / 2, D * EB / 2, D * EB / 128, S, E); }
    }
    SEAM(1);

    if (IN(2)) {
        MK_PTRS;
        constexpr int EB = F8_1 ? 1 : 2;
        SchedStd S; S.o.init(M, D, G, bx); S.A = (const char*)HB; S.B = (const char*)Wd1; S.a_tile = (size_t)256 * DFF * EB; S.b_tile = (size_t)256 * DFF * EB; S.b_batch = 0; S.ocol_mul = 256;
        EpiRes<false> E{XB, SS1, F8_1 ? 0.5f / (F8_H * F8_WD) : 0.5f, nullptr}; pg8::gemm_phase<EpiRes<false>, SchedStd, true, F8_1>(lds, DFF * EB / 2, DFF * EB / 2, DFF * EB / 128, S, E);
    }
    SEAM(2);

    if (IN(3)) {
        MK_PTRS;
        { SchedStd S; S.o.init(M, NQKV, G, bx); S.A = (const char*)XB; S.B = (const char*)Win; S.a_tile = (size_t)256 * D * 2; S.b_tile = (size_t)256 * D * 2; S.b_batch = 0; S.ocol_mul = 256;
          EpiStore E{QKV, 0, SS1, KM, false}; pg8::gemm_phase<EpiStore, SchedStd, true>(lds, D, D, D / 64, S, E); }
    }
    SEAM(3);

    if (IN(4)) {
        MK_PTRS;
        constexpr long HSTR4 = (long)SEQ * 128;
        for (int task = gw; task < NBAT * 4 * (SEQ / 32); task += NGW) { const int bh = task / (SEQ / 32), tl = task % (SEQ / 32), b = bh >> 2, hb = bh & 3, q0 = tl * 32, qb = q0 >> 8;
            const char* qbase = (const char*)QKV + ((size_t)b * 48 + 36 + hb) * HSTR4 + (size_t)q0 * 128;
            const unsigned msk = att::moba_select(qbase, 128, KM + (size_t)b * 16 * 256 + hb * 64, qb);
            if (lane < 32) SEL[(size_t)bh * SEQ + q0 + lane] = msk; }
    }
    SEAM(4);

    if (IN(5)) {
        MK_PTRS;
        LAS float* tab = (LAS float*)(lds + LDS_TAB);
        const int h2 = lane >> 5, q = lane & 31;
        const long rowb = 128;
        constexpr long HSTR = (long)SEQ * 128;
#define ATT_WAITV(n) asm volatile("s_waitcnt vmcnt(" #n ")" ::: "memory")
#define ATT_BAR() do { asm volatile("s_waitcnt lgkmcnt(0)" ::: "memory"); __builtin_amdgcn_s_barrier(); asm volatile("" ::: "memory"); } while (0)
        { constexpr int NKV = NBAT * 8;
          struct SchedOne { const char* A; const char* B; int G_, c_; __device__ __forceinline__ bool next(int i, Unit& uu) const { const int idx = i * G_ + c_; if (idx >= NKV) return false; const int pm = idx >> 3, pn = idx & 7;
              uu.a = A + (size_t)pm * 256 * D * 2; uu.b = B + (size_t)pn * 256 * D * 2; uu.orow = pm * 256; uu.ocol = pn * 256; uu.aux = pn; return true; } };
          SchedOne S1{(const char*)MB, (const char*)Wckv, G, vcu};
          EpiStore Ekv{KVC, 2 * D, SSM, nullptr, false}; pg8::gemm_phase<EpiStore, SchedOne, true>(lds, D, D, D / 64, S1, Ekv);
          __syncthreads(); }
        for (int i = tid; i < 4 * att::TABB_N; i += NWAVES * 64) { const int hb = i / att::TABB_N, e = i % att::TABB_N, dist = e - 32;
            tab[i] = dist >= 0 ? rel_bias[att::rel_bucket(dist) * 16 + 12 + hb] * LOG2E : -INFINITY; }
        __syncthreads();
        {
            constexpr int NBH = NBAT * 4, NUNITS = 16 * NBH;
            LAS unsigned* LQ = (LAS unsigned*)(lds + 65536);
            volatile LAS unsigned* UW = (volatile LAS unsigned*)(lds + 65536 + 16384);
            unsigned* qhead = (unsigned*)(ws + WS_CTL) + CW_QUEUE;
#pragma unroll 1
            for (;;) {
                if (tid == 0) UW[8] = __hip_atomic_fetch_add(qhead, 1u, __ATOMIC_RELAXED, __HIP_MEMORY_SCOPE_AGENT);
                ATT_BAR();
                const int u = (int)UW[8];
                if (u >= NUNITS) break;
                const int n = u / NBH, bh = u % NBH, b = bh >> 2, hb = bh & 3;
                const char* qh = (const char*)QKV + ((size_t)b * 48 + 36 + hb) * HSTR;
                const char* kh = (const char*)QKV + ((size_t)b * 48 + 40 + hb) * HSTR + (size_t)(256 * n) * rowb;
                const unsigned* selp = SEL + (size_t)bh * SEQ;
                ATT_WAITV(0);
#pragma unroll
                for (int k = wave; k < 32; k += NWAVES) { const int row = 8 * k + (lane >> 3); att::dma_rows8(kh + (long)row * rowb, (int)(4 * HSTR), row, (LAS char*)(lds + k * 1024), (LAS char*)(lds + 32768 + k * 1024), lane); }
                int total = 0;
                if (n < 15) {
                    const int lo = 256 * (n + 1) + wave * 32 * (15 - n), R = 32 * (15 - n);
                    int cnt = 0;
#pragma unroll 1
                    for (int i = 0; i < R; i += 64) { const bool pr = (i + lane < R) && ((selp[lo + i + lane] >> n) & 1u); cnt += __popcll(__ballot(pr)); }
                    if (lane == 0) UW[wave] = (unsigned)cnt;
                    ATT_BAR();
                    int basew = 0;
#pragma unroll
                    for (int w2 = 0; w2 < NWAVES; ++w2) { const int cw = (int)UW[w2]; basew += (w2 < wave) ? cw : 0; total += cw; }
#pragma unroll 1
                    for (int i = 0; i < R; i += 64) { const bool pr = (i + lane < R) && ((selp[lo + i + lane] >> n) & 1u); const unsigned long long bal = __ballot(pr);
                        if (pr) LQ[basew + __popcll(bal & ((1ull << lane) - 1ull))] = (unsigned)(lo + i + lane); basew += __popcll(bal); }
                }
                const int ntiles = (total + 31) >> 5;
                ATT_WAITV(0); ATT_BAR();
                const LAS float* tb = tab + hb * att::TABB_N;
#pragma unroll 1
                for (int tile = -1; tile < ntiles; tile = (tile < 0 ? wave : tile + NWAVES)) {
                    const bool own = tile < 0;
                    int tq; bool valid = true;
                    if (own) tq = 256 * n + 32 * wave + q; else { const int e = 32 * tile + q; valid = e < total; tq = (int)LQ[valid ? e : total - 1]; }
                    att::bf16x8 qf[4];
#pragma unroll
                    for (int d0 = 0; d0 < 4; ++d0) qf[d0] = *(const att::bf16x8*)(qh + (long)tq * rowb + (16 * d0 + 8 * h2) * 2);
                    const int slot = own ? 3 : __popc(selp[tq] & ((1u << n) - 1u));
                    att::f32x16 o[2]; o[0] = att::f32x16{}; o[1] = att::f32x16{}; float mo = -1e30f, lo_ = 0.f;
                    const int Bq = (tq - 256 * n + 32) - 4 * h2;
#pragma unroll 1
                    for (int g = own ? wave : 7; g >= 0; --g) { int B = Bq - 32 * g; B = B < (att::TABB_N - 1) ? B : (att::TABB_N - 1);
                        att::attn_group(qf, o, mo, lo_, (const LAS char*)(lds + g * 4096), (const LAS char*)(lds + 32768 + g * 4096), tb + B, lane); }
                    lo_ += __shfl_xor(lo_, 32);
                    const size_t prow = (size_t)slot * M + (size_t)b * SEQ + tq;
                    att::store_o<MK_NT_PART>(o, lo_, (char*)OBP + (prow * 256 + hb * 64) * 2, h2, valid);
                    if (h2 == 0 && valid) *(f32x2*)(MLB + (prow * 4 + hb) * 2) = (f32x2){mo, lo_};
                }
                ATT_BAR();
            }
        }
        __syncthreads();
        LAS float* rbl = (LAS float*)(lds + LDS_TAB); LAS float* tabI = (LAS float*)(lds + LDS_TAB + 2048);
        LAS char* ostg = (LAS char*)(lds + LDS_TAB + 3072 + wave * 4096);
        static_assert(LDS_TAB + 3072 + NWAVES * 4096 <= LDS_MISC, "dilated LDS map");
        for (int i = tid; i < 512; i += NWAVES * 64) rbl[i] = rel_bias[i] * LOG2E;
        __syncthreads();
        constexpr int NDIL = NBAT * 12 * 48;
        struct DilItem { int b, h, p, d, res, m0, mbase; };
        auto decode = [&](int it, DilItem& I) { const int bh = it / 48, j = it % 48; I.b = bh / 12; I.h = bh % 12; I.p = j >> 4; const int jj = j & 15;
            I.d = I.p == 0 ? 1 : (I.p == 1 ? 4 : 16); I.res = I.p == 0 ? 0 : (I.p == 1 ? (jj & 3) : jj); const int mblk = I.p == 0 ? jj : (I.p == 1 ? (jj >> 2) : 0);
            I.mbase = mblk * 256 - 128; I.m0 = mblk * 256 + wave * 32; };
        att::bf16x8 qf[4];
        auto issue_k = [&](const DilItem& I) {
            const char* kb = (const char*)QKV + ((size_t)I.b * 48 + 12 + I.h) * HSTR + (size_t)I.res * rowb; const long st = (long)I.d * rowb;
#pragma unroll 1
            for (int k = wave; k < 48; k += NWAVES) { if (I.mbase + 8 * k < 0) continue; const int row = 8 * k + (lane >> 3); att::dma_k_rows8(kb + (long)(I.mbase + row) * st, row, (LAS char*)(lds + k * 1024), lane); } };
        auto issue_v = [&](const DilItem& I) {
            const char* vb = (const char*)QKV + ((size_t)I.b * 48 + 24 + I.h) * HSTR + (size_t)I.res * rowb; const long st = (long)I.d * rowb;
#pragma unroll 1
            for (int k = wave; k < 48; k += NWAVES) { if (I.mbase + 8 * k < 0) continue; const int row = 8 * k + (lane >> 3); att::dma_v_rows8(vb + (long)(I.mbase + row) * st, row, (LAS char*)(lds + 49152 + k * 1024), lane); } };
        auto load_q = [&](const DilItem& I) {
            const char* qp = (const char*)QKV + ((size_t)I.b * 48 + I.h) * HSTR + (size_t)I.res * rowb + (long)I.m0 * I.d * rowb + (long)q * I.d * rowb + 16 * h2;
            asm volatile("global_load_dwordx4 %0, %4, off\n\tglobal_load_dwordx4 %1, %4, off offset:32\n\tglobal_load_dwordx4 %2, %4, off offset:64\n\tglobal_load_dwordx4 %3, %4, off offset:96"
                         : "=&v"(qf[0]), "=&v"(qf[1]), "=&v"(qf[2]), "=&v"(qf[3]) : "v"(qp) : "memory"); };
        auto build_tab = [&](const DilItem& I) { if (tid < att::TABA_N) { const int delta = tid - 32; tabI[tid] = (delta >= 0 && delta <= 128) ? rbl[att::rel_bucket(delta * I.d) * 16 + I.h] : -INFINITY; } };
        att::u32x4 vr[6];
        auto load_v = [&](const DilItem& I) {
            const char* vb = (const char*)QKV + ((size_t)I.b * 48 + 24 + I.h) * HSTR + (size_t)I.res * rowb; const long st = (long)I.d * rowb;
#pragma unroll
            for (int j = 0; j < 6; ++j) { const int k = wave + NWAVES * j; if (I.mbase + 8 * k < 0) continue; const int row = 8 * k + (lane >> 3);
                const char* src = vb + (long)(I.mbase + row) * st + 16 * ((lane & 7) ^ (((row >> 1) & 1) << 2));
                asm volatile("global_load_dwordx4 %0, %1, off" : "=&v"(vr[j]) : "v"(src) : "memory"); } };
        DilItem cur; int it = vcu;
        if (it < NDIL) { decode(it, cur); build_tab(cur); ATT_WAITV(0); issue_k(cur); load_q(cur); issue_v(cur); }
        att::f32x16 po[2]; po[0] = att::f32x16{}; po[1] = att::f32x16{}; float pmo = 0.f, plo = 1.f; DilItem pdone = cur; int pm0 = 0; bool pvalid = false;
#define FLUSH_PREV() do { const size_t tok_ = (size_t)pdone.b * SEQ + (size_t)(pm0 + q) * pdone.d + pdone.res; \
            att::store_o_staged<MK_NT_PART>(po, plo, ostg, (char*)(pdone.p == 0 ? OA0 : (pdone.p == 1 ? OA1 : OA2)) + (((size_t)pdone.b * SEQ + (size_t)pm0 * pdone.d + pdone.res) * 768 + pdone.h * 64) * 2, (long)pdone.d * 768 * 2, lane); \
            if (h2 == 0) *(f32x2*)(ML + (((size_t)pdone.p * M + tok_) * 12 + pdone.h) * 2) = (f32x2){pmo, plo}; } while (0)
#pragma unroll 1
        for (; it < NDIL; it += G) {
            ATT_WAITV(0);
            asm volatile("" : "+v"(qf[0]), "+v"(qf[1]), "+v"(qf[2]), "+v"(qf[3]));
            ATT_BAR();
            const bool has_next = it + G < NDIL; DilItem nxt = cur; if (has_next) decode(it + G, nxt);
            if (pvalid) FLUSH_PREV();
            if (has_next) load_v(nxt);
            const int m0 = cur.m0, gend = (m0 - 128) > 0 ? (m0 - 128) : 0, ng = ((m0 - gend) >> 5) + 1;
            att::u32x4 pw[5][2]; float mo, lo_;
            { att::bf16x8 qc[4] = {qf[0], qf[1], qf[2], qf[3]};
              att::dil_pass1(qc, ng, (const LAS char*)(lds + (m0 - cur.mbase) * 128), tabI + 32 + q - 4 * h2, pw, mo, lo_, lane); }
            ATT_BAR();
            const DilItem done = cur;
            if (has_next) { cur = nxt; issue_k(cur); build_tab(cur); load_q(cur); }
            att::f32x16 o[2];
            att::dil_pass2(ng, (const LAS char*)(lds + 49152 + (m0 - done.mbase) * 128), pw, o, lane);
            ATT_BAR();
            po[0] = o[0]; po[1] = o[1]; pmo = mo; plo = lo_; pdone = done; pm0 = m0; pvalid = true;
            if (has_next) {
                if (cur.mbase < 0) ATT_WAITV(8); else ATT_WAITV(10);
                asm volatile("" : "+v"(vr[0]), "+v"(vr[1]), "+v"(vr[2]), "+v"(vr[3]), "+v"(vr[4]), "+v"(vr[5]));
#pragma unroll
                for (int j = 0; j < 6; ++j) { const int k = wave + NWAVES * j; if (cur.mbase + 8 * k < 0) continue; *(LAS att::u32x4*)(lds + 49152 + k * 1024 + lane * 16) = vr[j]; }
            }
        }
        if (pvalid) FLUSH_PREV();
#undef FLUSH_PREV
#undef ATT_WAITV
#undef ATT_BAR
    }
    SEAM(5);

    if (IN(6)) {
        MK_PTRS;
        for (int row0 = gw; row0 < M; row0 += 2 * NGW) {
            f32x2 ml[2][3][3]; u32x2 oa[2][3][3]; f32x2 mlb[2][4]; u32x2 obp[2][4];
#pragma unroll
            for (int r = 0; r < 2; ++r) { const int row = (row0 + r * NGW) < M ? (row0 + r * NGW) : row0;
#pragma unroll
                for (int k = 0; k < 3; ++k) { const int col = 256 * k + 4 * lane, hd = col >> 6;
#pragma unroll
                    for (int p = 0; p < 3; ++p) ml[r][k][p] = __builtin_nontemporal_load((const f32x2*)(ML + (((size_t)p * M + row) * 12 + hd) * 2));
                    oa[r][k][0] = __builtin_nontemporal_load((const u32x2*)(OA0 + (size_t)row * 768 + col)); oa[r][k][1] = __builtin_nontemporal_load((const u32x2*)(OA1 + (size_t)row * 768 + col)); oa[r][k][2] = __builtin_nontemporal_load((const u32x2*)(OA2 + (size_t)row * 768 + col)); }
#pragma unroll
                for (int s = 0; s < 4; ++s) { mlb[r][s] = __builtin_nontemporal_load((const f32x2*)(MLB + (((size_t)s * M + row) * 4 + (lane >> 4)) * 2)); obp[r][s] = __builtin_nontemporal_load((const u32x2*)(OBP + ((size_t)s * M + row) * 256 + 4 * lane)); } }
            float va[2][3][4], vb[2][4], ssa[2], ssb[2];
#pragma unroll
            for (int r = 0; r < 2; ++r) { ssa[r] = 0.f; ssb[r] = 0.f;
#pragma unroll
                for (int k = 0; k < 3; ++k) {
                    const float Mx = fmaxf(ml[r][k][0][0], fmaxf(ml[r][k][1][0], ml[r][k][2][0]));
                    const float w0 = ml[r][k][0][1] * __builtin_amdgcn_exp2f(ml[r][k][0][0] - Mx), w1 = ml[r][k][1][1] * __builtin_amdgcn_exp2f(ml[r][k][1][0] - Mx), w2 = ml[r][k][2][1] * __builtin_amdgcn_exp2f(ml[r][k][2][0] - Mx);
                    const float iw = 1.0f / (w0 + w1 + w2);
#pragma unroll
                    for (int e = 0; e < 4; ++e) { const unsigned s0 = oa[r][k][0][e >> 1], s1 = oa[r][k][1][e >> 1], s2 = oa[r][k][2][e >> 1];
                        const float f0 = __builtin_bit_cast(float, (e & 1) ? (s0 & 0xffff0000u) : (s0 << 16)), f1 = __builtin_bit_cast(float, (e & 1) ? (s1 & 0xffff0000u) : (s1 << 16)), f2 = __builtin_bit_cast(float, (e & 1) ? (s2 & 0xffff0000u) : (s2 << 16));
                        const float v = (w0 * f0 + w1 * f1 + w2 * f2) * iw; va[r][k][e] = v; ssa[r] += v * v; } }
                { const int rowq = (row0 + r * NGW) < M ? (row0 + r * NGW) : row0, nsel = (((rowq % SEQ) >> 8) < 3) ? ((rowq % SEQ) >> 8) : 3;
                  float wq[4], Mq = -INFINITY;
#pragma unroll
                  for (int s = 0; s < 4; ++s) { const bool use = (s == 3) || (s < nsel); Mq = use ? fmaxf(Mq, mlb[r][s][0]) : Mq; }
                  float wsum = 0.f;
#pragma unroll
                  for (int s = 0; s < 4; ++s) { const bool use = (s == 3) || (s < nsel); wq[s] = use ? mlb[r][s][1] * __builtin_amdgcn_exp2f(mlb[r][s][0] - Mq) : 0.f; wsum += wq[s]; }
                  const float iwq = 1.0f / wsum;
#pragma unroll
                  for (int e = 0; e < 4; ++e) { float acc_ = 0.f;
#pragma unroll
                      for (int s = 0; s < 4; ++s) { const bool use = (s == 3) || (s < nsel); const unsigned s0 = obp[r][s][e >> 1]; const float f = __builtin_bit_cast(float, (e & 1) ? (s0 & 0xffff0000u) : (s0 << 16)); acc_ += use ? wq[s] * f : 0.f; }
                      vb[r][e] = acc_ * iwq; ssb[r] += vb[r][e] * vb[r][e]; } } }
#pragma unroll
            for (int of = 1; of < 64; of <<= 1)
#pragma unroll
                for (int r = 0; r < 2; ++r) { ssa[r] += __shfl_xor(ssa[r], of); ssb[r] += __shfl_xor(ssb[r], of); }
#pragma unroll
            for (int r = 0; r < 2; ++r) { const int row = row0 + r * NGW; if (row < M) {
                const float ra = __builtin_amdgcn_rsqf(ssa[r] * (1.0f / 768.0f) + EPS), rb = __builtin_amdgcn_rsqf(ssb[r] * (1.0f / 256.0f) + EPS);
#pragma unroll
                for (int k = 0; k < 3; ++k) { u32x2 w; w[0] = cvt_pk_bf16(va[r][k][0] * ra, va[r][k][1] * ra); w[1] = cvt_pk_bf16(va[r][k][2] * ra, va[r][k][3] * ra); *(u32x2*)(YN + (size_t)row * D + 256 * k + 4 * lane) = w; }
                { u32x2 w; w[0] = cvt_pk_bf16(vb[r][0] * rb, vb[r][1] * rb); w[1] = cvt_pk_bf16(vb[r][2] * rb, vb[r][3] * rb); *(u32x2*)(YN + (size_t)row * D + 768 + 4 * lane) = w; } } }
        }
    }
    SEAM(6);

    if (IN(7)) {
        MK_PTRS;
        { SchedWK S{G, bx, (const char*)KVC, (const char*)Wcqs}; EpiStore E{WKT, D, nullptr, nullptr, false}; pg8::gemm_phase<EpiStore, SchedWK, true>(lds, 2 * D, D, 4, S, E); }
        { SchedVW S{G, (bx + G / 2) % G, (const char*)KVC, (const char*)Wco}; EpiStore E{VWT, D, nullptr, nullptr, false}; pg8::gemm_phase<EpiStore, SchedVW, true>(lds, D, 2 * D, 4, S, E); }
        SchedStd S; S.o.init(M, D, G, bx); S.A = (const char*)YN; S.B = (const char*)Wout; S.a_tile = (size_t)256 * D * 2; S.b_tile = (size_t)256 * D * 2; S.b_batch = 0; S.ocol_mul = 256;
        EpiRes<false> E{XB, SS2, 1.0f, nullptr}; pg8::gemm_phase<EpiRes<false>, SchedStd, true>(lds, D, D, D / 64, S, E);
    }
    SEAM(7);

    if (IN(8)) {
        MK_PTRS;
        SchedStd S; S.o.init(M, D, G, bx); S.A = (const char*)XB; S.B = (const char*)WKT; S.a_tile = (size_t)256 * D * 2; S.b_tile = (size_t)256 * D * 2; S.b_batch = (size_t)D * D * 2; S.ocol_mul = 256;
        EpiSoftmax E{PB, SS2}; pg8::gemm_phase<EpiSoftmax, SchedStd, true>(lds, D, D, D / 64, S, E);
    }
    SEAM(8);

    if (IN(9)) {
        MK_PTRS;
        SchedStd S; S.o.init(M, D, G, bx); S.A = (const char*)PB; S.B = (const char*)VWT; S.a_tile = (size_t)256 * D * 2; S.b_tile = (size_t)256 * D * 2; S.b_batch = (size_t)D * D * 2; S.ocol_mul = 256;
        EpiRes<F8_2> E{XB, SS3, 1.0f, X8}; pg8::gemm_phase<EpiRes<F8_2>, SchedStd, true>(lds, D, D, D / 64, S, E);
    }
    SEAM(9);

    if (IN(10)) {
        MK_PTRS;
        STAGGER();
        constexpr int EB = F8_2 ? 1 : 2;
        SchedStd S; S.o.init(M, 2 * DFF, G, bx); S.A = F8_2 ? (const char*)X8 : (const char*)XB; S.B = (const char*)Wgu2; S.a_tile = (size_t)256 * D * EB; S.b_tile = (size_t)256 * D * EB; S.b_batch = 0; S.ocol_mul = 128;
        EpiGU<F8_2> E{HB, SS3}; pg8::gemm_phase<EpiGU<F8_2>, SchedStd, true, F8_2>(lds, D * EB / 2, D * EB / 2, D * EB / 128, S, E);
    }
    SEAM(10);

    if (IN(11)) {
        MK_PTRS;
        constexpr int EB = F8_2 ? 1 : 2;
        SchedStd S; S.o.init(M, D, G, bx); S.A = (const char*)HB; S.B = (const char*)Wd2; S.a_tile = (size_t)256 * DFF * EB; S.b_tile = (size_t)256 * DFF * EB; S.b_batch = 0; S.ocol_mul = 256;
        EpiRes<false> E{XB, SS4, F8_2 ? 0.5f / (F8_H * F8_WD) : 0.5f, nullptr}; pg8::gemm_phase<EpiRes<false>, SchedStd, true, F8_2>(lds, DFF * EB / 2, DFF * EB / 2, DFF * EB / 128, S, E);
    }
    SEAM(11);

    if (IN(12)) {
        MK_PTRS;
        const float* gf = args.in[19];
        for (int row0 = gw; row0 < M; row0 += 4 * NGW) {
            u32x2 w[4][4]; float rs[4]; const f32x4* gr = (const f32x4*)gf + lane;
#pragma unroll
            for (int r = 0; r < 4; ++r) { const int row = (row0 + r * NGW) < M ? (row0 + r * NGW) : row0; const u32x2* xr = (const u32x2*)(XB + (size_t)row * D) + lane;
#pragma unroll
                for (int j = 0; j < 4; ++j) w[r][j] = __builtin_nontemporal_load(xr + 64 * j);
                rs[r] = row_rstd(SS4, row); }
#pragma unroll
            for (int r = 0; r < 4; ++r) { const int row = row0 + r * NGW; if (row < M) { f32x4* orow = (f32x4*)(out + (size_t)row * D) + lane;
#pragma unroll
                for (int j = 0; j < 4; ++j) { f32x4 v; v[0] = __builtin_bit_cast(float, w[r][j][0] << 16); v[1] = __builtin_bit_cast(float, w[r][j][0] & 0xffff0000u); v[2] = __builtin_bit_cast(float, w[r][j][1] << 16); v[3] = __builtin_bit_cast(float, w[r][j][1] & 0xffff0000u);
                    __builtin_nontemporal_store(v * rs[r] * gr[64 * j], orow + 64 * j); } } }
        }
    }
#undef IN
#undef SEAM
}
}


#if MK_DEBUG
namespace dbg {
__global__ void __launch_bounds__(256) cmp_f32(const float* a, const float* r, size_t n, float* acc) {
    float num = 0.f, den = 0.f;
    for (size_t i = (size_t)blockIdx.x * 256 + threadIdx.x; i < n; i += (size_t)gridDim.x * 256) { const float d = a[i] - r[i]; num += d * d; den += r[i] * r[i]; }
    for (int o = 32; o > 0; o >>= 1) { num += __shfl_xor(num, o); den += __shfl_xor(den, o); }
    if ((threadIdx.x & 63) == 0) { atomicAdd(acc, num); atomicAdd(acc + 1, den); }
}
__global__ void __launch_bounds__(256) cmp_bf16(const unsigned short* a, int lda, const float* colscale, const float* r, int ldr, int rows, int cols, float* acc) {
    float num = 0.f, den = 0.f; const size_t n = (size_t)rows * cols;
    for (size_t i = (size_t)blockIdx.x * 256 + threadIdx.x; i < n; i += (size_t)gridDim.x * 256) { const size_t row = i / cols; const int c = (int)(i % cols);
        const float av = __builtin_bit_cast(float, (unsigned)a[row * lda + c] << 16) * (colscale ? colscale[c] : 1.0f); const float rv = r[row * ldr + c]; const float d = av - rv; num += d * d; den += rv * rv; }
    for (int o = 32; o > 0; o >>= 1) { num += __shfl_xor(num, o); den += __shfl_xor(den, o); }
    if ((threadIdx.x & 63) == 0) { atomicAdd(acc, num); atomicAdd(acc + 1, den); }
}
__global__ void __launch_bounds__(256) cmp_p(const unsigned short* a, const float* r, float* acc) {
    float num = 0.f, den = 0.f; const size_t n = (size_t)4096 * 1024;
    for (size_t i = (size_t)blockIdx.x * 256 + threadIdx.x; i < n; i += (size_t)gridDim.x * 256) { const size_t row = i / 1024; const int c = (int)(i % 1024);
        const float av = __builtin_bit_cast(float, (unsigned)a[i] << 16); const float rv = r[(size_t)(c >> 8) * 4096 * 256 + row * 256 + (c & 255)]; const float d = av - rv; num += d * d; den += rv * rv; }
    for (int o = 32; o > 0; o >>= 1) { num += __shfl_xor(num, o); den += __shfl_xor(den, o); }
    if ((threadIdx.x & 63) == 0) { atomicAdd(acc, num); atomicAdd(acc + 1, den); }
}
__global__ void build_scales(float* qkvs, float* gcat, const float* goa, const float* gob) {
    const int i = blockIdx.x * 256 + threadIdx.x;
    if (i < 3072) qkvs[i] = ((i < 768) || (i >= 2304 && i < 2560)) ? 8.0f : 1.0f;
    if (i < 1024) gcat[i] = i < 768 ? goa[i] : gob[i - 768];
}
constexpr int NST = 8;
__global__ void __launch_bounds__(256) finalize(float* out, size_t n, const float* acc, int report) {
    const float tol[NST] = {0.03f, 0.03f, 1e9f  , 0.08f, 0.03f, 0.05f, 0.03f, 0.03f};
    float E = 0.f;
    if (report > 0) { const float e = sqrtf(acc[2 * (report - 1)] / acc[2 * (report - 1) + 1]); E = (e == e) ? fminf(e, 3.0f) : 3.0f; }
    else { for (int k = NST - 1; k >= 0; --k) { const float e = sqrtf(acc[2 * k] / acc[2 * k + 1]); if (!(e <= tol[k])) E = 0.1f * (k + 1); } }
    for (size_t i = (size_t)blockIdx.x * 256 + threadIdx.x; i < n; i += (size_t)gridDim.x * 256) out[i] *= (1.0f + E);
}
}
#endif

static void mk_launch(const mk::Args& a0, int lo, int hi, int grid, hipStream_t st) {
    mk::Args a = a0; a.ph_lo = lo; a.ph_hi = hi;
    hipLaunchKernelGGL(mk::mk_fwd, dim3(grid), dim3(mk::NWAVES * 64), mk::LDS_BYTES, st, a);
    const hipError_t le = hipPeekAtLastError();
    if (le != hipSuccess) fprintf(stderr, "kernel_launch: launch of phases [%d,%d) failed: %s\n", lo, hi, hipGetErrorName(le));
}

extern "C" void kernel_launch(void* const* d_in, const int* in_sizes, int n_in, void* d_out, int out_size, void* d_ws, size_t ws_size, hipStream_t stream) {
    static int grid = 0;
    if (grid == 0) {
        if (n_in != 20 || out_size != 8 * 4096 * 1024) { fprintf(stderr, "kernel_launch: unexpected shapes (n_in %d out %d)\n", n_in, out_size); grid = -1; return; }
        int dev = 0, cus = 0, per_cu = 0;
        if (hipGetDevice(&dev) != hipSuccess || hipDeviceGetAttribute(&cus, hipDeviceAttributeMultiprocessorCount, dev) != hipSuccess) { grid = -1; return; }
        if (hipFuncSetAttribute((const void*)mk::mk_fwd, hipFuncAttributeMaxDynamicSharedMemorySize, mk::LDS_BYTES) != hipSuccess) { fprintf(stderr, "kernel_launch: hipFuncSetAttribute failed\n"); grid = -1; return; }
        if (hipOccupancyMaxActiveBlocksPerMultiprocessor(&per_cu, (const void*)mk::mk_fwd, mk::NWAVES * 64, mk::LDS_BYTES) != hipSuccess || per_cu < 1) fprintf(stderr, "kernel_launch: occupancy query reports %d workgroups per CU\n", per_cu);
        (void)hipGetLastError();
        grid = cus;
    }
    if (grid < 0) return;
    unsigned char* ws = (unsigned char*)d_ws;
#if MK_DEBUG
    const size_t ref_off = (mk::WS_END + 4095) / 4096 * 4096;
    size_t off = ref_off + (size_t)290 * 1024 * 1024;
    auto take = [&](size_t bytes) { unsigned char* p = ws + off; off += (bytes + 255) / 256 * 256; return p; };
    float* sx1 = (float*)take((size_t)4096 * 1024 * 4); float* sx2 = (float*)take((size_t)4096 * 1024 * 4); float* sx3 = (float*)take((size_t)4096 * 1024 * 4);
    float* mkout = (float*)take((size_t)4096 * 1024 * 4); float* qkvs = (float*)take(3072 * 4); float* gcat = (float*)take(1024 * 4); float* acc = (float*)take(256);
    if (off > ws_size) { fprintf(stderr, "kernel_launch: debug build needs %zu bytes of workspace, got %zu\n", off, ws_size); return; }
    ref::Snap snap{sx1, sx2, sx3};
    ref::forward(d_in, (float*)d_out, ws + ref_off, stream, &snap);
    (void)hipMemsetAsync(ws + mk::WS_CTL, 0, mk::CTL_BYTES, stream);
    (void)hipMemsetAsync(acc, 0, 256, stream);
    dbg::build_scales<<<12, 256, 0, stream>>>(qkvs, gcat, (const float*)d_in[8], (const float*)d_in[9]);
    mk::Args a{};
    for (int i = 0; i < 20; ++i) a.in[i] = (const float*)d_in[i];
    a.in[0] = (const float*)d_in[0] + (size_t)7 * 4096 * 1024; a.in[1] = (const float*)d_in[1] + (size_t)7 * 256 * 1024;
    a.out = mkout; a.ws = ws;
    const ref::Bufs& rb = ref::g_bufs;
    for (int ph = 0; ph < mk::NPH; ++ph) {
        mk_launch(a, ph, ph + 1, grid, stream);
        if (ph == 5) dbg::cmp_bf16<<<512, 256, 0, stream>>>((const unsigned short*)(ws + mk::WS_KVC), 2048, nullptr, rb.kvc, 2048, 256, 2048, acc + 0);
        if (ph == 2) dbg::cmp_bf16<<<512, 256, 0, stream>>>((const unsigned short*)(ws + mk::WS_XB), 1024, nullptr, sx1, 1024, 4096, 1024, acc + 2);
        if (ph == 3) dbg::cmp_bf16<<<512, 256, 0, stream>>>((const unsigned short*)(ws + mk::WS_R1), 3072, qkvs, rb.proj, 3072, 4096, 3072, acc + 4);
        if (ph == 6) dbg::cmp_bf16<<<512, 256, 0, stream>>>((const unsigned short*)(ws + mk::WS_R1), 1024, gcat, rb.yn, 1024, 4096, 1024, acc + 6);
        if (ph == 7) dbg::cmp_bf16<<<512, 256, 0, stream>>>((const unsigned short*)(ws + mk::WS_XB), 1024, nullptr, sx2, 1024, 4096, 1024, acc + 8);
        if (ph == 8) dbg::cmp_p<<<512, 256, 0, stream>>>((const unsigned short*)(ws + mk::WS_R1), rb.sc, acc + 10);
        if (ph == 9) dbg::cmp_bf16<<<512, 256, 0, stream>>>((const unsigned short*)(ws + mk::WS_XB), 1024, nullptr, sx3, 1024, 4096, 1024, acc + 12);
        if (ph == 12) dbg::cmp_f32<<<512, 256, 0, stream>>>(mkout, (const float*)d_out + (size_t)7 * 4096 * 1024, (size_t)4096 * 1024, acc + 14);
    }
    dbg::finalize<<<1024, 256, 0, stream>>>((float*)d_out, (size_t)8 * 4096 * 1024, acc, MK_REPORT);
#else
    if (ws_size < mk::WS_END) { fprintf(stderr, "kernel_launch: needs %zu bytes of workspace, got %zu\n", (size_t)mk::WS_END, ws_size); return; }
    if (hipMemsetAsync(ws + mk::WS_CTL, 0, mk::CTL_BYTES, stream) != hipSuccess) return;
    mk::Args a{};
    for (int i = 0; i < 20; ++i) a.in[i] = (const float*)d_in[i];
    a.out = (float*)d_out; a.ws = ws;
#if MK_N_LAUNCHES == 1
    mk_launch(a, 0, mk::NPH, grid, stream);
#else
    for (int ph = 0; ph < mk::NPH; ++ph) {
        for (int r = 0; r < MK_REPEAT_N; ++r) if (ph == MK_REPEAT) { mk::Args a2 = a; a2.flags = MK_REPEAT_FLAGS; mk_launch(a2, ph, ph + 1, grid, stream); }
        mk_launch(a, ph, ph + 1, grid, stream); }
#endif
#endif
}
```

```cpp
#include <hip/hip_runtime.h>
#include <cstdio>
#include <cstdint>
#include <cmath>
#define MK_REPEAT -1
#define MK_REPEAT_N 1
#define MK_REPEAT_FLAGS 0
#define MK_STAGGER_TICKS 0
#define MK_NT_PART false
#define MK_TIMING 0
#define MK_TQ 0.02f
#define MK_PROBE_SAME 0
#define MK_FP8_FFN1 4
#define MK_FP8_FFN2 3
#define MK_DEBUG 0
#define MK_REPORT 0
#define MK_N_LAUNCHES 1
#define MK_NBAT 8

namespace pg8 {
#define PG8_LAS __attribute__((address_space(3)))
typedef unsigned short bf16_t;
typedef short bf16x8 __attribute__((ext_vector_type(8)));
typedef float f32x4 __attribute__((ext_vector_type(4)));
typedef float f32x2 __attribute__((ext_vector_type(2)));
typedef unsigned u32x4 __attribute__((ext_vector_type(4)));
typedef unsigned u32x2 __attribute__((ext_vector_type(2)));
typedef int i32x4 __attribute__((ext_vector_type(4)));
typedef int i32x8 __attribute__((ext_vector_type(8)));
constexpr int BM = 256, BK = 64, HALF = 128, HTB = HALF * BK * 2  , STAGE_BYTES = 8 * HTB, NXCD = 8, WGM = 8;

__host__ __device__ __forceinline__ int lds_byte(int r, int c) { const int st = (r >> 4) * 2 + (c >> 5), rr = r & 15, cc = c & 31, ob = rr * 64 + cc * 2; return st * 1024 + (ob ^ (((ob >> 9) & 1) << 5)); }
__host__ __device__ __forceinline__ void stage_rc(int b, int& R, int& C) { const int st = b / 1024, sb = b % 1024, swz = sb ^ (((sb >> 9) & 1) << 5); R = (st >> 1) * 16 + swz / 64; C = (st & 1) * 32 + (swz % 64) / 2; }
__host__ __device__ __forceinline__ int perm32(int rho) { const int n = rho >> 4, i = rho & 15; return 8 * (i >> 2) + 4 * n + (i & 3); }

struct Unit { const char* a; const char* b; int orow, ocol, aux; };

struct Order {
    int nM, nN, nwg, G, c;
    __device__ __forceinline__ void init(int M, int N, int G_, int c_) { nM = M / BM; nN = N / BM; nwg = nM * nN; G = G_; c = c_; }
    __device__ __forceinline__ bool tile(int i, int& pm, int& pn) const {
        const long L = (long)i * G + c; if (L >= nwg) return false;
        int wgid = (int)L; { const int q = nwg / NXCD, r = nwg % NXCD, xcd = wgid % NXCD, off = wgid / NXCD; wgid = (xcd < r ? xcd * (q + 1) : r * (q + 1) + (xcd - r) * q) + off; }
        const int nig = WGM * nN, gid = wgid / nig, fm = gid * WGM, gsz = (nM - fm) < WGM ? (nM - fm) : WGM;
        pm = fm + ((wgid % nig) % gsz); pn = (wgid % nig) / gsz; return true;
    }
};

__device__ __forceinline__ unsigned cvt_pk_bf16(float lo, float hi) { unsigned r; asm volatile("v_cvt_pk_bf16_f32 %0, %1, %2" : "=v"(r) : "v"(lo), "v"(hi)); return r; }

template <class Epi, class Sched, bool ALIGN_EPI, int MODE = 0>
__device__ __forceinline__ void gemm_phase(PG8_LAS unsigned char* lds, const int lda, const int ldb, const int nt, const Sched& S, const Epi& E) {
    int tid_ = threadIdx.x; asm volatile("" : "+v"(tid_));
    const int tid = tid_, wid = __builtin_amdgcn_readfirstlane(tid >> 6), lane = tid & 63, wr = wid >> 2, wc = wid & 3, fr = lane & 15, fq = lane >> 4;
    unsigned voffA[2], voffB[2];
#pragma unroll
    for (int i = 0; i < 2; ++i) { int R, C; stage_rc(tid * 16 + i * 8192, R, C); const int Rb = Epi::PERM ? ((R & ~31) + perm32(R & 31)) : R;
        voffA[i] = (unsigned)(R * lda + C) * 2u; voffB[i] = (unsigned)(Rb * ldb + C) * 2u; }
    const size_t kstep = (size_t)(BK * 2);
    const size_t hstepA = (size_t)HALF * lda * 2, hstepB = (size_t)HALF * ldb * 2;
    const unsigned ldsw = (unsigned)wid * 1024u;
    const int aoff = lds_byte(wr * 64 + fr, fq * 8), boff = lds_byte(wc * 32 + fr, fq * 8);
#define PG8_SA(b, h) (((b) * 2 + (h)) * HTB)
#define PG8_SB(b, h) ((4 + (b) * 2 + (h)) * HTB)
#define PG8_STAGE(bufoff, gbase, voff) do { _Pragma("unroll") for (int _i = 0; _i < 2; ++_i) \
        __builtin_amdgcn_global_load_lds((const unsigned*)((const char*)(gbase) + (voff)[_i]), (PG8_LAS unsigned*)(lds + (bufoff) + ldsw + _i * 8192), 16, 0, 0); } while (0)
#define PG8_LDA(dst, b, h) do { _Pragma("unroll") for (int m = 0; m < 4; ++m) _Pragma("unroll") for (int k = 0; k < 2; ++k) dst[m][k] = *(const PG8_LAS bf16x8*)(lds + PG8_SA(b, h) + aoff + m * 2048 + k * 1024); } while (0)
#define PG8_LDB(dst, b, h) do { _Pragma("unroll") for (int n = 0; n < 2; ++n) _Pragma("unroll") for (int k = 0; k < 2; ++k) dst[n][k] = *(const PG8_LAS bf16x8*)(lds + PG8_SB(b, h) + boff + n * 2048 + k * 1024); } while (0)
#define PG8_MMA(ai, bj, At, Bt) do { __builtin_amdgcn_s_setprio(1); _Pragma("unroll") for (int m = 0; m < 4; ++m) _Pragma("unroll") for (int n = 0; n < 2; ++n) { \
        if constexpr (FP8) { const i32x8 bb_ = __builtin_shufflevector(__builtin_bit_cast(i32x4, Bt[n][0]), __builtin_bit_cast(i32x4, Bt[n][1]), 0, 1, 2, 3, 4, 5, 6, 7); \
            const i32x8 aa_ = __builtin_shufflevector(__builtin_bit_cast(i32x4, At[m][0]), __builtin_bit_cast(i32x4, At[m][1]), 0, 1, 2, 3, 4, 5, 6, 7); \
            asm volatile("v_mfma_scale_f32_16x16x128_f8f6f4 %0, %1, %2, %0, %3, %3 op_sel_hi:[0,0,0]" : "+v"(acc[ai][bj][m][n]) : "v"(bb_), "v"(aa_), "v"(sc1)); } \
        else if constexpr (I8) { _Pragma("unroll") for (int k = 0; k < 2; ++k) acc[ai][bj][m][n] = __builtin_bit_cast(f32x4, __builtin_amdgcn_mfma_i32_16x16x64_i8(__builtin_bit_cast(i32x4, Bt[n][k]), __builtin_bit_cast(i32x4, At[m][k]), __builtin_bit_cast(i32x4, acc[ai][bj][m][n]), 0, 0, 0)); } \
        else { _Pragma("unroll") for (int k = 0; k < 2; ++k) acc[ai][bj][m][n] = __builtin_amdgcn_mfma_f32_16x16x32_bf16(Bt[n][k], At[m][k], acc[ai][bj][m][n], 0, 0, 0); } } \
        __builtin_amdgcn_s_setprio(0); } while (0)
#define PG8_WAIT_V(n) asm volatile("s_waitcnt vmcnt(" #n ")" ::: "memory")
#define PG8_WAIT_L(n) asm volatile("s_waitcnt lgkmcnt(" #n ")" ::: "memory")
#define PG8_BAR __builtin_amdgcn_s_barrier()
#define PG8_SCHED __builtin_amdgcn_sched_barrier(0)
    constexpr bool FP8 = MODE == 1, I8 = MODE == 2;
    int sc1 = 0x7F7F7F7F; asm volatile("" : "+v"(sc1)); (void)sc1;
    Unit cur, nxt; int ui = 0;
    if (!S.next(0, cur)) return;
    f32x4 acc[2][2][4][2];
#pragma unroll
    for (int a = 0; a < 2; ++a)
#pragma unroll
        for (int b = 0; b < 2; ++b)
#pragma unroll
            for (int m = 0; m < 4; ++m)
#pragma unroll
                for (int n = 0; n < 2; ++n) acc[a][b][m][n] = (f32x4){0.f, 0.f, 0.f, 0.f};
    bf16x8 At[4][2], B0[2][2], B1[2][2];
    const char* cA = cur.a; const char* cB = cur.b;
    PG8_STAGE(PG8_SB(0, 0), cB, voffB); PG8_STAGE(PG8_SB(0, 1), cB + hstepB, voffB); PG8_STAGE(PG8_SA(0, 0), cA, voffA); PG8_STAGE(PG8_SA(0, 1), cA + hstepA, voffA);
    if (wr == 1) PG8_BAR;
    PG8_WAIT_V(2); PG8_BAR;
    PG8_STAGE(PG8_SB(1, 0), cB + kstep, voffB); PG8_STAGE(PG8_SA(1, 0), cA + kstep, voffA); PG8_STAGE(PG8_SB(1, 1), cB + hstepB + kstep, voffB);
    PG8_WAIT_V(6); PG8_BAR;
    for (;;) {
        const bool has_next = S.next(ui + 1, nxt);
        const char* nA = has_next ? nxt.a : cA; const char* nB = has_next ? nxt.b : cB;
#pragma unroll 1
        for (int t = 0; t < nt; t += 2) {
            const bool last = (t == nt - 2);
            const char* a1 = cA + (size_t)(t + 1) * kstep;
            const char* a2 = last ? nA : cA + (size_t)(t + 2) * kstep; const char* b2 = last ? nB : cB + (size_t)(t + 2) * kstep;
            const char* a3 = a2 + kstep; const char* b3 = b2 + kstep;
            PG8_LDB(B0, 0, 0); PG8_LDB(B1, 0, 1); PG8_SCHED; PG8_LDA(At, 0, 0); PG8_STAGE(PG8_SA(1, 1), a1 + hstepA, voffA);
            PG8_WAIT_V(8); PG8_WAIT_L(0); PG8_BAR; PG8_MMA(0, 0, At, B0); PG8_MMA(0, 1, At, B1); PG8_BAR; PG8_SCHED;
            PG8_LDA(At, 0, 1); PG8_STAGE(PG8_SB(0, 0), b2, voffB); PG8_STAGE(PG8_SB(0, 1), b2 + hstepB, voffB); PG8_STAGE(PG8_SA(0, 0), a2, voffA);
            PG8_WAIT_V(8); PG8_WAIT_L(0); PG8_BAR; PG8_MMA(1, 0, At, B0); PG8_MMA(1, 1, At, B1); PG8_BAR; PG8_SCHED;
            PG8_LDB(B0, 1, 0); PG8_LDB(B1, 1, 1); PG8_SCHED; PG8_LDA(At, 1, 0); PG8_STAGE(PG8_SA(0, 1), a2 + hstepA, voffA);
            PG8_WAIT_V(8); PG8_WAIT_L(0); PG8_BAR; PG8_MMA(0, 0, At, B0); PG8_MMA(0, 1, At, B1); PG8_BAR; PG8_SCHED;
            PG8_LDA(At, 1, 1); PG8_STAGE(PG8_SB(1, 0), b3, voffB); PG8_STAGE(PG8_SB(1, 1), b3 + hstepB, voffB); PG8_STAGE(PG8_SA(1, 0), a3, voffA);
            PG8_WAIT_V(8); PG8_WAIT_L(0); PG8_BAR; PG8_MMA(1, 0, At, B0); PG8_MMA(1, 1, At, B1); PG8_BAR; PG8_SCHED;
        }
        if constexpr (ALIGN_EPI) { if (wr == 0) PG8_BAR; }
        if constexpr (FP8) asm volatile("s_nop 15\n\ts_nop 7" ::: "memory");
        E(acc, cur, wr, wc, fr, fq, lds, wid, lane);
        if (!has_next) break;
#pragma unroll
        for (int a = 0; a < 2; ++a)
#pragma unroll
            for (int b = 0; b < 2; ++b)
#pragma unroll
                for (int m = 0; m < 4; ++m)
#pragma unroll
                    for (int n = 0; n < 2; ++n) acc[a][b][m][n] = (f32x4){0.f, 0.f, 0.f, 0.f};
        cur = nxt; cA = nA; cB = nB; ++ui;
        if constexpr (ALIGN_EPI) { if (wr == 1) PG8_BAR; }
    }
    PG8_WAIT_V(0);
    if constexpr (!ALIGN_EPI) { if (wr == 0) PG8_BAR; }
    PG8_BAR;
#undef PG8_SA
#undef PG8_SB
#undef PG8_STAGE
#undef PG8_LDA
#undef PG8_LDB
#undef PG8_MMA
#undef PG8_WAIT_V
#undef PG8_WAIT_L
#undef PG8_BAR
#undef PG8_SCHED
}
}

namespace att {
#define ATT_LAS __attribute__((address_space(3)))
typedef short bf16x8 __attribute__((ext_vector_type(8)));
typedef short v4i16 __attribute__((ext_vector_type(4)));
typedef float f32x16 __attribute__((ext_vector_type(16)));
typedef float f32x4 __attribute__((ext_vector_type(4)));
typedef unsigned u32x4 __attribute__((ext_vector_type(4)));
typedef unsigned u32x2 __attribute__((ext_vector_type(2)));
constexpr float LOG2E = 1.4426950408889634f;
constexpr int TABA_N = 192, TABB_N = 1600;

__device__ __forceinline__ int rel_bucket(int n) {
    if (n < 16) return n < 0 ? 0 : n;
    int b = 16;
    b += (n >= 22); b += (n >= 30); b += (n >= 40); b += (n >= 54); b += (n >= 73); b += (n >= 99); b += (n >= 134); b += (n >= 182);
    b += (n >= 246); b += (n >= 332); b += (n >= 450); b += (n >= 609); b += (n >= 825); b += (n >= 1117); b += (n >= 1513);
    return b;
}
__device__ __forceinline__ unsigned pk_bf16(float lo, float hi) { unsigned r; asm volatile("v_cvt_pk_bf16_f32 %0, %1, %2" : "=v"(r) : "v"(lo), "v"(hi)); return r; }
__device__ __forceinline__ float bf16_round(float x) { unsigned u = __builtin_bit_cast(unsigned, x); u = (u + 0x7fffu + ((u >> 16) & 1u)) & 0xffff0000u; return __builtin_bit_cast(float, u); }

__device__ __forceinline__ void glds16(const void* gsrc, unsigned lds_dst) { unsigned keep;
    asm volatile("s_mov_b32 %0, m0\n\ts_mov_b32 m0, %2\n\ts_nop 0\n\tglobal_load_lds_dwordx4 %1, off\n\ts_mov_b32 m0, %0" : "=&s"(keep) : "v"(gsrc), "s"(lds_dst) : "memory"); }
__device__ __forceinline__ void dma_rows8(const char* krow0  , const int voff, const int row  ,
                                          ATT_LAS char* kdst  , ATT_LAS char* vdst, const int lane) {
    const int pc = lane & 7;
    glds16(krow0 + 16 * (pc ^ ((row >> 1) & 7)), (unsigned)__builtin_amdgcn_readfirstlane((int)(unsigned)(uintptr_t)kdst));
    glds16(krow0 + voff + 16 * (pc ^ (((row >> 1) & 1) << 2)), (unsigned)__builtin_amdgcn_readfirstlane((int)(unsigned)(uintptr_t)vdst));
}

__device__ __forceinline__ void attn_group(const bf16x8 (&qf)[4], f32x16 (&o)[2], float& m, float& l, const ATT_LAS char* kg, const ATT_LAS char* vg, const ATT_LAS float* tp, const int lane) {
    const int q = lane & 31, h = lane >> 5;
    const ATT_LAS char* kr0 = kg + q * 128; const int kswz = (q >> 1) & 7;
    typedef float f32x2_ __attribute__((ext_vector_type(2)));
    f32x2_ t0, t1, t2, t3, t4, t5, t6, t7;
    { const unsigned ta = (unsigned)(uintptr_t)(tp - 27);
      asm volatile("ds_read2_b32 %0, %8 offset0:27 offset1:26\n\tds_read2_b32 %1, %8 offset0:25 offset1:24\n\tds_read2_b32 %2, %8 offset0:19 offset1:18\n\tds_read2_b32 %3, %8 offset0:17 offset1:16\n\t"
                   "ds_read2_b32 %4, %8 offset0:11 offset1:10\n\tds_read2_b32 %5, %8 offset0:9 offset1:8\n\tds_read2_b32 %6, %8 offset0:3 offset1:2\n\tds_read2_b32 %7, %8 offset0:1 offset1:0"
                   : "=&v"(t0), "=&v"(t1), "=&v"(t2), "=&v"(t3), "=&v"(t4), "=&v"(t5), "=&v"(t6), "=&v"(t7) : "v"(ta) : "memory"); }
    const int q4 = (lane & 15) >> 2, p4 = lane & 3, g1 = (lane >> 4) & 1, vsw = (q4 >> 1) & 1;
    const unsigned va0_ = (unsigned)(uintptr_t)(vg + (4 * h + q4) * 128 + 32 * g1 + 8 * p4 + 64 * vsw), va1_ = (unsigned)(uintptr_t)(vg + (4 * h + q4) * 128 + 32 * g1 + 8 * p4 + 64 * (1 ^ vsw));
    v4i16 a[2][4];
    asm volatile("ds_read_b64_tr_b16 %0, %8\n\tds_read_b64_tr_b16 %1, %8 offset:1024\n\tds_read_b64_tr_b16 %2, %8 offset:2048\n\tds_read_b64_tr_b16 %3, %8 offset:3072\n\t"
                 "ds_read_b64_tr_b16 %4, %9\n\tds_read_b64_tr_b16 %5, %9 offset:1024\n\tds_read_b64_tr_b16 %6, %9 offset:2048\n\tds_read_b64_tr_b16 %7, %9 offset:3072"
                 : "=&v"(a[0][0]), "=&v"(a[0][1]), "=&v"(a[0][2]), "=&v"(a[0][3]), "=&v"(a[1][0]), "=&v"(a[1][1]), "=&v"(a[1][2]), "=&v"(a[1][3]) : "v"(va0_), "v"(va1_) : "memory");
    f32x16 s = f32x16{};
#pragma unroll
    for (int d0 = 0; d0 < 4; ++d0) { const bf16x8 kf = *(const ATT_LAS bf16x8*)(kr0 + 16 * ((2 * d0 + h) ^ kswz)); s = __builtin_amdgcn_mfma_f32_32x32x16_bf16(kf, qf[d0], s, 0, 0, 0); }
    asm volatile("s_waitcnt lgkmcnt(0)" : "+v"(t0), "+v"(t1), "+v"(t2), "+v"(t3), "+v"(t4), "+v"(t5), "+v"(t6), "+v"(t7), "+v"(a[0][0]), "+v"(a[0][1]), "+v"(a[0][2]), "+v"(a[0][3]), "+v"(a[1][0]), "+v"(a[1][1]), "+v"(a[1][2]), "+v"(a[1][3]) :: "memory");
    float mx = -INFINITY;
    { const float tb_[16] = {t0[0], t0[1], t1[0], t1[1], t2[0], t2[1], t3[0], t3[1], t4[0], t4[1], t5[0], t5[1], t6[0], t6[1], t7[0], t7[1]};
#pragma unroll
      for (int r = 0; r < 16; ++r) s[r] = fmaf(s[r], LOG2E, tb_[r]); }
#pragma unroll
    for (int r = 0; r < 16; r += 2) mx = fmaxf(mx, fmaxf(s[r], s[r + 1]));
    mx = fmaxf(mx, __shfl_xor(mx, 32));
    if (__any(mx > m)) {
        const float mnew = fmaxf(m, mx), alpha = __builtin_amdgcn_exp2f(m - mnew);
        l *= alpha; m = mnew;
#pragma unroll
        for (int r = 0; r < 16; ++r) { o[0][r] *= alpha; o[1][r] *= alpha; }
    }
    float ps = 0.f;
#pragma unroll
    for (int r = 0; r < 16; ++r) { s[r] = __builtin_amdgcn_exp2f(s[r] - m); ps += s[r]; }
    l += ps;
    u32x4 pw0, pw1;
    pw0[0] = pk_bf16(s[0], s[1]); pw0[1] = pk_bf16(s[2], s[3]); pw0[2] = pk_bf16(s[4], s[5]); pw0[3] = pk_bf16(s[6], s[7]);
    pw1[0] = pk_bf16(s[8], s[9]); pw1[1] = pk_bf16(s[10], s[11]); pw1[2] = pk_bf16(s[12], s[13]); pw1[3] = pk_bf16(s[14], s[15]);
    const bf16x8 pb0 = __builtin_bit_cast(bf16x8, pw0), pb1 = __builtin_bit_cast(bf16x8, pw1);
#pragma unroll
    for (int dh = 0; dh < 2; ++dh) {
        const bf16x8 va0 = (bf16x8){a[dh][0][0], a[dh][0][1], a[dh][0][2], a[dh][0][3], a[dh][1][0], a[dh][1][1], a[dh][1][2], a[dh][1][3]};
        const bf16x8 va1 = (bf16x8){a[dh][2][0], a[dh][2][1], a[dh][2][2], a[dh][2][3], a[dh][3][0], a[dh][3][1], a[dh][3][2], a[dh][3][3]};
        o[dh] = __builtin_amdgcn_mfma_f32_32x32x16_bf16(va0, pb0, o[dh], 0, 0, 0);
        o[dh] = __builtin_amdgcn_mfma_f32_32x32x16_bf16(va1, pb1, o[dh], 0, 0, 0);
    }
}

__device__ __forceinline__ void dma_k_rows8(const char* krow, const int row, ATT_LAS char* kdst, const int lane) {
    glds16(krow + 16 * ((lane & 7) ^ ((row >> 1) & 7)), (unsigned)__builtin_amdgcn_readfirstlane((int)(unsigned)(uintptr_t)kdst)); }
__device__ __forceinline__ void dma_v_rows8(const char* vrow, const int row, ATT_LAS char* vdst, const int lane) {
    glds16(vrow + 16 * ((lane & 7) ^ (((row >> 1) & 1) << 2)), (unsigned)__builtin_amdgcn_readfirstlane((int)(unsigned)(uintptr_t)vdst)); }
__device__ __forceinline__ void dil_pass1(const bf16x8 (&qf)[4], const int ng, const ATT_LAS char* kimg0  , const ATT_LAS float* tp0  ,
                                          u32x4 (&pw)[5][2], float& m_out, float& l_out, const int lane) {
    const int q = lane & 31, h = lane >> 5, kswz = (q >> 1) & 7;
    typedef float f32x2_ __attribute__((ext_vector_type(2)));
    f32x16 s[5]; float mx = -INFINITY;
#pragma unroll
    for (int g = 0; g < 5; ++g) if (g < ng) {
        f32x2_ t0, t1, t2, t3, t4, t5, t6, t7;
        { const unsigned ta = (unsigned)(uintptr_t)(tp0 + 32 * g - 27);
          asm volatile("ds_read2_b32 %0, %8 offset0:27 offset1:26\n\tds_read2_b32 %1, %8 offset0:25 offset1:24\n\tds_read2_b32 %2, %8 offset0:19 offset1:18\n\tds_read2_b32 %3, %8 offset0:17 offset1:16\n\t"
                       "ds_read2_b32 %4, %8 offset0:11 offset1:10\n\tds_read2_b32 %5, %8 offset0:9 offset1:8\n\tds_read2_b32 %6, %8 offset0:3 offset1:2\n\tds_read2_b32 %7, %8 offset0:1 offset1:0"
                       : "=&v"(t0), "=&v"(t1), "=&v"(t2), "=&v"(t3), "=&v"(t4), "=&v"(t5), "=&v"(t6), "=&v"(t7) : "v"(ta) : "memory"); }
        const ATT_LAS char* kr0 = kimg0 - g * 4096 + q * 128;
        f32x16 sg = f32x16{};
#pragma unroll
        for (int d0 = 0; d0 < 4; ++d0) { const bf16x8 kf = *(const ATT_LAS bf16x8*)(kr0 + 16 * ((2 * d0 + h) ^ kswz)); sg = __builtin_amdgcn_mfma_f32_32x32x16_bf16(kf, qf[d0], sg, 0, 0, 0); }
        asm volatile("s_waitcnt lgkmcnt(0)" : "+v"(t0), "+v"(t1), "+v"(t2), "+v"(t3), "+v"(t4), "+v"(t5), "+v"(t6), "+v"(t7) :: "memory");
        const float tb_[16] = {t0[0], t0[1], t1[0], t1[1], t2[0], t2[1], t3[0], t3[1], t4[0], t4[1], t5[0], t5[1], t6[0], t6[1], t7[0], t7[1]};
#pragma unroll
        for (int r = 0; r < 16; ++r) sg[r] = fmaf(sg[r], LOG2E, tb_[r]);
#pragma unroll
        for (int r = 0; r < 16; r += 2) mx = fmaxf(mx, fmaxf(sg[r], sg[r + 1]));
        s[g] = sg;
    }
    mx = fmaxf(mx, __shfl_xor(mx, 32));
    float ps = 0.f;
#pragma unroll
    for (int g = 0; g < 5; ++g) if (g < ng) {
        f32x16 p = s[g];
#pragma unroll
        for (int r = 0; r < 16; ++r) { p[r] = __builtin_amdgcn_exp2f(p[r] - mx); ps += p[r]; }
        pw[g][0][0] = pk_bf16(p[0], p[1]); pw[g][0][1] = pk_bf16(p[2], p[3]); pw[g][0][2] = pk_bf16(p[4], p[5]); pw[g][0][3] = pk_bf16(p[6], p[7]);
        pw[g][1][0] = pk_bf16(p[8], p[9]); pw[g][1][1] = pk_bf16(p[10], p[11]); pw[g][1][2] = pk_bf16(p[12], p[13]); pw[g][1][3] = pk_bf16(p[14], p[15]);
    }
    ps += __shfl_xor(ps, 32);
    m_out = mx; l_out = ps;
}
__device__ __forceinline__ void dil_pass2(const int ng, const ATT_LAS char* vimg0  , const u32x4 (&pw)[5][2], f32x16 (&o)[2], const int lane) {
    const int h = lane >> 5, q4 = (lane & 15) >> 2, p4 = lane & 3, g1 = (lane >> 4) & 1, vsw = (q4 >> 1) & 1;
    o[0] = f32x16{}; o[1] = f32x16{};
#pragma unroll
    for (int g = 0; g < 5; ++g) if (g < ng) {
        const ATT_LAS char* vg = vimg0 - g * 4096;
        const unsigned va0_ = (unsigned)(uintptr_t)(vg + (4 * h + q4) * 128 + 32 * g1 + 8 * p4 + 64 * vsw), va1_ = (unsigned)(uintptr_t)(vg + (4 * h + q4) * 128 + 32 * g1 + 8 * p4 + 64 * (1 ^ vsw));
        v4i16 a[2][4];
        asm volatile("ds_read_b64_tr_b16 %0, %8\n\tds_read_b64_tr_b16 %1, %8 offset:1024\n\tds_read_b64_tr_b16 %2, %8 offset:2048\n\tds_read_b64_tr_b16 %3, %8 offset:3072\n\t"
                     "ds_read_b64_tr_b16 %4, %9\n\tds_read_b64_tr_b16 %5, %9 offset:1024\n\tds_read_b64_tr_b16 %6, %9 offset:2048\n\tds_read_b64_tr_b16 %7, %9 offset:3072\n\ts_waitcnt lgkmcnt(0)"
                     : "=&v"(a[0][0]), "=&v"(a[0][1]), "=&v"(a[0][2]), "=&v"(a[0][3]), "=&v"(a[1][0]), "=&v"(a[1][1]), "=&v"(a[1][2]), "=&v"(a[1][3]) : "v"(va0_), "v"(va1_) : "memory");
        const bf16x8 pb0 = __builtin_bit_cast(bf16x8, pw[g][0]), pb1 = __builtin_bit_cast(bf16x8, pw[g][1]);
#pragma unroll
        for (int dh = 0; dh < 2; ++dh) {
            const bf16x8 va0 = (bf16x8){a[dh][0][0], a[dh][0][1], a[dh][0][2], a[dh][0][3], a[dh][1][0], a[dh][1][1], a[dh][1][2], a[dh][1][3]};
            const bf16x8 va1 = (bf16x8){a[dh][2][0], a[dh][2][1], a[dh][2][2], a[dh][2][3], a[dh][3][0], a[dh][3][1], a[dh][3][2], a[dh][3][3]};
            o[dh] = __builtin_amdgcn_mfma_f32_32x32x16_bf16(va0, pb0, o[dh], 0, 0, 0);
            o[dh] = __builtin_amdgcn_mfma_f32_32x32x16_bf16(va1, pb1, o[dh], 0, 0, 0);
        }
    }
}

template <bool NT>
__device__ __forceinline__ void store_o(const f32x16 (&o)[2], const float l, char* orow_q, const int h, const bool valid = true) {
    const float il = 1.0f / l;
#pragma unroll
    for (int dh = 0; dh < 2; ++dh)
#pragma unroll
        for (int jj = 0; jj < 2; ++jj) {
            u32x2 we, wo;
            we[0] = pk_bf16(o[dh][8 * jj] * il, o[dh][8 * jj + 1] * il); we[1] = pk_bf16(o[dh][8 * jj + 2] * il, o[dh][8 * jj + 3] * il);
            wo[0] = pk_bf16(o[dh][8 * jj + 4] * il, o[dh][8 * jj + 5] * il); wo[1] = pk_bf16(o[dh][8 * jj + 6] * il, o[dh][8 * jj + 7] * il);
            const unsigned s0 = h ? we[0] : wo[0], s1 = h ? we[1] : wo[1];
            const unsigned r0 = (unsigned)__shfl_xor((int)s0, 32), r1 = (unsigned)__shfl_xor((int)s1, 32);
            u32x4 w; if (h == 0) { w[0] = we[0]; w[1] = we[1]; w[2] = r0; w[3] = r1; } else { w[0] = r0; w[1] = r1; w[2] = wo[0]; w[3] = wo[1]; }
            u32x4* dst = (u32x4*)(orow_q + (32 * dh + 16 * jj + 8 * h) * 2);
            if (valid) { if (NT) __builtin_nontemporal_store(w, dst); else *dst = w; }
        }
}

template <bool NT>
__device__ __forceinline__ void store_o_staged(const f32x16 (&o)[2], const float l, ATT_LAS char* stg, char* base, const long rstride, const int lane) {
    const int q = lane & 31, h = lane >> 5; const float il = 1.0f / l;
#pragma unroll
    for (int dh = 0; dh < 2; ++dh)
#pragma unroll
        for (int jj = 0; jj < 2; ++jj) {
            u32x2 we, wo;
            we[0] = pk_bf16(o[dh][8 * jj] * il, o[dh][8 * jj + 1] * il); we[1] = pk_bf16(o[dh][8 * jj + 2] * il, o[dh][8 * jj + 3] * il);
            wo[0] = pk_bf16(o[dh][8 * jj + 4] * il, o[dh][8 * jj + 5] * il); wo[1] = pk_bf16(o[dh][8 * jj + 6] * il, o[dh][8 * jj + 7] * il);
            const unsigned s0 = h ? we[0] : wo[0], s1 = h ? we[1] : wo[1];
            const unsigned r0 = (unsigned)__shfl_xor((int)s0, 32), r1 = (unsigned)__shfl_xor((int)s1, 32);
            u32x4 w; if (h == 0) { w[0] = we[0]; w[1] = we[1]; w[2] = r0; w[3] = r1; } else { w[0] = r0; w[1] = r1; w[2] = wo[0]; w[3] = wo[1]; }
            *(ATT_LAS u32x4*)(stg + q * 128 + 16 * ((4 * dh + 2 * jj + h) ^ (q & 7))) = w;
        }
    asm volatile("s_waitcnt lgkmcnt(0)" ::: "memory");
#pragma unroll
    for (int i = 0; i < 4; ++i) { const int r = 8 * i + (lane >> 3), c = lane & 7;
        const u32x4 w = *(const ATT_LAS u32x4*)(stg + r * 128 + 16 * (c ^ (r & 7)));
        u32x4* dst = (u32x4*)(base + (long)r * rstride + 16 * c);
        if (NT) __builtin_nontemporal_store(w, dst); else *dst = w; }
    asm volatile("s_waitcnt lgkmcnt(0)" ::: "memory");
}

__device__ __forceinline__ unsigned moba_select(const char* qbase, const long qs, const float* km, const int qb) {
    const int lane = threadIdx.x & 63, q = lane & 31, h = lane >> 5;
    f32x16 g = f32x16{};
    const float* kmrow = km + (size_t)(q & 15) * 256;
    const bool lo_part = q >= 16;
#pragma unroll
    for (int d0 = 0; d0 < 4; ++d0) {
        const bf16x8 qf = *(const bf16x8*)(qbase + (long)q * qs + (16 * d0 + 8 * h) * 2);
        const f32x4 f0 = *(const f32x4*)(kmrow + 16 * d0 + 8 * h), f1 = *(const f32x4*)(kmrow + 16 * d0 + 8 * h + 4);
        float v[8] = {f0[0], f0[1], f0[2], f0[3], f1[0], f1[1], f1[2], f1[3]};
        u32x4 aw;
#pragma unroll
        for (int j = 0; j < 4; ++j) {
            const float h0 = bf16_round(v[2 * j]), h1 = bf16_round(v[2 * j + 1]);
            const float x0 = lo_part ? (v[2 * j] - h0) : h0, x1 = lo_part ? (v[2 * j + 1] - h1) : h1;
            aw[j] = pk_bf16(x0, x1);
        }
        g = __builtin_amdgcn_mfma_f32_32x32x16_bf16(__builtin_bit_cast(bf16x8, aw), qf, g, 0, 0, 0);
    }
    float gate[8], other[8];
#pragma unroll
    for (int r = 0; r < 8; ++r) { gate[r] = g[r] + g[r + 8]; }
#pragma unroll
    for (int r = 0; r < 8; ++r) { other[r] = __shfl_xor(gate[r], 32); }
    unsigned mymask = 0u;
#pragma unroll
    for (int r = 0; r < 8; ++r) {
        const int n = (r & 3) + 8 * (r >> 2) + 4 * h;
        int rank = 0;
#pragma unroll
        for (int r2 = 0; r2 < 8; ++r2) {
            const int n2 = (r2 & 3) + 8 * (r2 >> 2) + 4 * h, n3 = (r2 & 3) + 8 * (r2 >> 2) + 4 * (1 - h);
            if (r2 != r) rank += (n2 < qb && (gate[r2] > gate[r] || (gate[r2] == gate[r] && n2 < n))) ? 1 : 0;
            rank += (n3 < qb && (other[r2] > gate[r] || (other[r2] == gate[r] && n3 < n))) ? 1 : 0;
        }
        if (n < qb && rank < 3) mymask |= 1u << n;
    }
    return mymask | (unsigned)__shfl_xor((int)mymask, 32);
}
}


namespace mk {
using pg8::bf16_t; using pg8::bf16x8; using pg8::f32x4; using pg8::f32x2; using pg8::u32x4; using pg8::u32x2; using pg8::Unit; using pg8::cvt_pk_bf16;
#define LAS __attribute__((address_space(3)))
constexpr int NBAT = MK_NBAT, SEQ = 4096, D = 1024, DFF = 2816, NMEM = 256, M = NBAT * SEQ, MM = NBAT * NMEM, NQKV = 3072;
constexpr float EPS = 1e-6f, LOG2E = 1.4426950408889634f;
constexpr int NWAVES = 8, NPH = 13;
constexpr bool F8_1G = (MK_FP8_FFN1 & 1) != 0, F8_1D = (MK_FP8_FFN1 & 2) != 0, F8_2G = (MK_FP8_FFN2 & 1) != 0, F8_2D = (MK_FP8_FFN2 & 2) != 0;
constexpr bool I8_1G = (MK_FP8_FFN1 & 4) != 0;
static_assert(!(I8_1G && F8_1G), "one operand type per GEMM");
constexpr float F8_WGU = 64.f, F8_H = 4.f, F8_WD = 128.f;

constexpr size_t al256(size_t x) { return (x + 255) / 256 * 256; }
constexpr size_t WS_CTL = 0, CTL_BYTES = 1u << 20;
constexpr size_t WS_WGU1 = WS_CTL + CTL_BYTES;
constexpr size_t WS_WD1 = WS_WGU1 + (size_t)2 * DFF * D * 2;
constexpr size_t WS_WIN = WS_WD1 + (size_t)D * DFF * 2;
constexpr size_t WS_WOUT = WS_WIN + (size_t)NQKV * D * 2;
constexpr size_t WS_WCQS = WS_WOUT + (size_t)D * D * 2;
constexpr size_t WS_WCKV = WS_WCQS + (size_t)D * D * 2;
constexpr size_t WS_WCO = WS_WCKV + (size_t)2 * D * D * 2;
constexpr size_t WS_WGU2 = WS_WCO + (size_t)D * D * 2;
constexpr size_t WS_WD2 = WS_WGU2 + (size_t)2 * DFF * D * 2;
constexpr size_t WS_MB = WS_WD2 + (size_t)D * DFF * 2;
constexpr size_t WS_KVC = WS_MB + (size_t)MM * D * 2;
constexpr size_t WS_WKT = WS_KVC + (size_t)MM * 2 * D * 2;
constexpr size_t WS_VWT = WS_WKT + (size_t)NBAT * D * D * 2;
constexpr size_t SS_BYTES = (size_t)M * 16 * 4;
constexpr size_t WS_SS = WS_VWT + (size_t)NBAT * D * D * 2;
constexpr size_t WS_SSM = WS_SS + 5 * SS_BYTES;
constexpr size_t WS_KM = WS_SSM + (size_t)MM * 16 * 4;
constexpr size_t WS_SX = WS_KM + (size_t)NBAT * 16 * 256 * 4;
constexpr size_t WS_SW = WS_SX + (size_t)M * 4;
constexpr size_t WS_R1 = al256(WS_SW + (size_t)2 * DFF * 4);
constexpr size_t WS_XB = WS_R1 + (size_t)M * NQKV * 2;
constexpr size_t WS_OA2 = WS_XB + (size_t)M * D * 2;
constexpr size_t WS_SEL = WS_OA2 + (size_t)M * 768 * 2;
constexpr size_t WS_OBP = WS_SEL + (size_t)NBAT * 4 * SEQ * 4;
constexpr size_t WS_X8 = WS_OBP;
constexpr size_t WS_MLB = WS_OBP + (size_t)4 * M * 256 * 2;
constexpr size_t WS_END = WS_MLB + (size_t)4 * M * 4 * 2 * 4;
constexpr size_t OUT_OA1 = (size_t)M * 768 * 2, OUT_OB = 2 * OUT_OA1, OUT_ML = OUT_OB + (size_t)M * 256 * 2;
static_assert(OUT_ML + (size_t)3 * M * 12 * 8 <= (size_t)M * D * 4, "attention partials fit in d_out");
constexpr int CW_BAR = 4096, CW_QUEUE = 8192;

constexpr int LDS_XCH = 131072;
constexpr int LDS_MISC = 131072 + 8192;
constexpr int LDS_BYTES = 147456;
constexpr int LDS_TAB = 98304;
static_assert(LDS_TAB + 4 * att::TABB_N * 4 <= LDS_XCH, "attention LDS map");

__device__ __forceinline__ float wave_sum(float v) {
#pragma unroll
    for (int o = 1; o < 64; o <<= 1) v += __shfl_xor(v, o);
    return v;
}
__device__ __forceinline__ unsigned pk_fp8x4(float a, float b, float c, float d) { int r = __builtin_amdgcn_cvt_pk_fp8_f32(a, b, 0, false); r = __builtin_amdgcn_cvt_pk_fp8_f32(c, d, r, true); return (unsigned)r; }
__device__ __forceinline__ unsigned pk_i8x4(float a, float b, float c, float d) { const int ia = (int)__builtin_rintf(a), ib = (int)__builtin_rintf(b), ic = (int)__builtin_rintf(c), id = (int)__builtin_rintf(d);
    return ((unsigned)ia & 255u) | (((unsigned)ib & 255u) << 8) | (((unsigned)ic & 255u) << 16) | ((unsigned)id << 24); }
__device__ __forceinline__ float row_rstd(const float* ss, int row) {
    const f32x4* p = (const f32x4*)(ss + (size_t)row * 16);
    const f32x4 a = p[0], b = p[1], c = p[2], d = p[3];
    const float s = ((a[0] + a[1]) + (a[2] + a[3])) + ((b[0] + b[1]) + (b[2] + b[3])) + ((c[0] + c[1]) + (c[2] + c[3])) + ((d[0] + d[1]) + (d[2] + d[3]));
    return 1.0f / sqrtf(s * (1.0f / D) + EPS);
}

struct SchedStd {
    pg8::Order o; const char* A; const char* B; size_t a_tile, b_tile, b_batch; int ocol_mul;
    __device__ __forceinline__ bool next(int i, Unit& u) const { int pm, pn; if (!o.tile(i, pm, pn)) return false;
        u.a = A + (size_t)pm * a_tile; u.b = B + (size_t)pn * b_tile + (size_t)(pm >> 4) * b_batch; u.orow = pm * 256; u.ocol = pn * ocol_mul; u.aux = pn; return true; }
};
struct SchedWK {
    int G, c; const char* kvc; const char* wcqs;
    __device__ __forceinline__ bool next(int i, Unit& u) const { const int L = i * G + c; if (L >= NBAT * 16) return false; const int bh = L >> 2, pn = L & 3, b = bh >> 2, h = bh & 3;
        u.a = kvc + ((size_t)(b * 256) * 2048 + h * 256) * 2; u.b = wcqs + ((size_t)(pn * 256) * 1024 + h * 256) * 2; u.orow = b * 1024 + h * 256; u.ocol = pn * 256; u.aux = 0; return true; }
};
struct SchedVW {
    int G, c; const char* kvc; const char* wcot;
    __device__ __forceinline__ bool next(int i, Unit& u) const { const int L = i * G + c; if (L >= NBAT * 16) return false; const int bh = L >> 2, pm = L & 3, b = bh >> 2, h = bh & 3;
        u.a = wcot + ((size_t)(pm * 256) * 1024 + h * 256) * 2; u.b = kvc + ((size_t)(b * 256) * 2048 + 1024 + h * 256) * 2; u.orow = b * 1024 + pm * 256; u.ocol = h * 256; u.aux = 0; return true; }
};

template <bool F8, bool H8, bool I8> struct EpiGU { static constexpr bool PERM = true;
    void* H; const float* ss; const float* sx; const float* sw;
    __device__ __forceinline__ void operator()(const f32x4 (&acc)[2][2][4][2], const Unit& u, int wr, int wc, int fr, int fq, LAS unsigned char*, int, int) const {
        float rsv[2][4];
#pragma unroll
        for (int ai = 0; ai < 2; ++ai)
#pragma unroll
            for (int m = 0; m < 4; ++m) { const int row_ = u.orow + ai * 128 + wr * 64 + m * 16 + fr; rsv[ai][m] = row_rstd(ss, row_) * (F8 ? 1.0f / F8_WGU : 1.0f); if constexpr (I8) rsv[ai][m] *= sx[row_]; }
        f32x4 swg[2], swu[2];
        if constexpr (I8) { const f32x4* pg = (const f32x4*)(sw + u.ocol + wc * 32 + 8 * fq); const f32x4* pu = (const f32x4*)(sw + DFF + u.ocol + wc * 32 + 8 * fq); swg[0] = pg[0]; swg[1] = pg[1]; swu[0] = pu[0]; swu[1] = pu[1]; }
#pragma unroll
        for (int ai = 0; ai < 2; ++ai)
#pragma unroll
            for (int m = 0; m < 4; ++m) { const int row = u.orow + ai * 128 + wr * 64 + m * 16 + fr; const float rs = rsv[ai][m];
                float hv[8];
#pragma unroll
                for (int n = 0; n < 2; ++n)
#pragma unroll
                    for (int j = 0; j < 4; ++j) { float g, uu;
                        if constexpr (I8) { const float ga = acc[ai][0][m][n][j], ua = acc[ai][1][m][n][j];
                            g = (float)__builtin_bit_cast(int, ga) * (rs * swg[n][j]); uu = (float)__builtin_bit_cast(int, ua) * (rs * swu[n][j]); }
                        else { g = acc[ai][0][m][n][j] * rs; uu = acc[ai][1][m][n][j] * rs; }
                        hv[4 * n + j] = g * __builtin_amdgcn_rcpf(1.0f + __builtin_amdgcn_exp2f(-g * LOG2E)) * uu; }
                if constexpr (H8) { u32x2 w; w[0] = pk_fp8x4(hv[0] * F8_H, hv[1] * F8_H, hv[2] * F8_H, hv[3] * F8_H); w[1] = pk_fp8x4(hv[4] * F8_H, hv[5] * F8_H, hv[6] * F8_H, hv[7] * F8_H);
                    __builtin_nontemporal_store(w, (u32x2*)((unsigned char*)H + (size_t)row * DFF + u.ocol + wc * 32 + 8 * fq)); }
                else { u32x4 w; w[0] = cvt_pk_bf16(hv[0], hv[1]); w[1] = cvt_pk_bf16(hv[2], hv[3]); w[2] = cvt_pk_bf16(hv[4], hv[5]); w[3] = cvt_pk_bf16(hv[6], hv[7]);
                    __builtin_nontemporal_store(w, (u32x4*)((bf16_t*)H + (size_t)row * DFF + u.ocol + wc * 32 + 8 * fq)); } }
    }
};
template <bool X8> struct EpiRes { static constexpr bool PERM = true;
    bf16_t* xb; float* ssout; float alpha; unsigned char* x8;
    __device__ __forceinline__ void operator()(const f32x4 (&acc)[2][2][4][2], const Unit& u, int wr, int wc, int fr, int fq, LAS unsigned char*, int, int) const {
        const size_t off0 = (size_t)(u.orow + wr * 64 + fr) * D + u.ocol + wc * 32 + 8 * fq;
        u32x4 cur[2], nxt[2];
#pragma unroll
        for (int bj = 0; bj < 2; ++bj) cur[bj] = *(const u32x4*)(xb + off0 + bj * 128);
#pragma unroll
        for (int idx = 0; idx < 8; ++idx) { const int ai = idx >> 2, m = idx & 3; const size_t off = off0 + (size_t)(ai * 128 + m * 16) * D; const int row = u.orow + ai * 128 + wr * 64 + m * 16 + fr;
            if (idx < 7) { const size_t offn = off0 + (size_t)(((idx + 1) >> 2) * 128 + ((idx + 1) & 3) * 16) * D;
#pragma unroll
                for (int bj = 0; bj < 2; ++bj) nxt[bj] = *(const u32x4*)(xb + offn + bj * 128); }
            float sq = 0.f;
#pragma unroll
            for (int bj = 0; bj < 2; ++bj) { float o[8];
#pragma unroll
                for (int n = 0; n < 2; ++n)
#pragma unroll
                    for (int j = 0; j < 4; ++j) { const unsigned wv = cur[bj][2 * n + (j >> 1)]; const float r = __builtin_bit_cast(float, (j & 1) ? (wv & 0xffff0000u) : (wv << 16));
                        const float v = r + acc[ai][bj][m][n][j] * alpha; o[4 * n + j] = v; sq += v * v; }
                u32x4 w; w[0] = cvt_pk_bf16(o[0], o[1]); w[1] = cvt_pk_bf16(o[2], o[3]); w[2] = cvt_pk_bf16(o[4], o[5]); w[3] = cvt_pk_bf16(o[6], o[7]);
                *(u32x4*)(xb + off + bj * 128) = w;
                if constexpr (X8) { u32x2 w8; w8[0] = pk_fp8x4(o[0], o[1], o[2], o[3]); w8[1] = pk_fp8x4(o[4], o[5], o[6], o[7]); *(u32x2*)(x8 + off + bj * 128) = w8; } }
            sq += __shfl_xor(sq, 16); sq += __shfl_xor(sq, 32);
            if (fq == 0) ssout[(size_t)row * 16 + (u.ocol >> 8) * 4 + wc] = sq;
#pragma unroll
            for (int bj = 0; bj < 2; ++bj) cur[bj] = nxt[bj]; }
    }
};
struct EpiStore { static constexpr bool PERM = true;
    bf16_t* O; int ldc; const float* ss; float* km; bool nt;
    __device__ __forceinline__ void operator()(const f32x4 (&acc)[2][2][4][2], const Unit& u, int wr, int wc, int fr, int fq, LAS unsigned char*, int, int) const {
        float rsv[2][4];
#pragma unroll
        for (int ai = 0; ai < 2; ++ai)
#pragma unroll
            for (int m = 0; m < 4; ++m) rsv[ai][m] = ss ? row_rstd(ss, u.orow + ai * 128 + wr * 64 + m * 16 + fr) : 1.0f;
#pragma unroll
        for (int ai = 0; ai < 2; ++ai)
#pragma unroll
            for (int m = 0; m < 4; ++m) { const int row = u.orow + ai * 128 + wr * 64 + m * 16 + fr; const float rs = rsv[ai][m];
                const int col0 = u.ocol + wc * 32 + 8 * fq;
                bf16_t* rowp = ldc ? O + (size_t)row * ldc + col0 : O + (((size_t)(row / SEQ) * (NQKV / 64) + (col0 >> 6)) * SEQ + (row % SEQ)) * 64 + (col0 & 63);
                const size_t bjstep = ldc ? 128 : (size_t)2 * SEQ * 64;
#pragma unroll
                for (int bj = 0; bj < 2; ++bj) { const f32x4 v0 = acc[ai][bj][m][0] * rs, v1 = acc[ai][bj][m][1] * rs;
                    u32x4 w; w[0] = cvt_pk_bf16(v0[0], v0[1]); w[1] = cvt_pk_bf16(v0[2], v0[3]); w[2] = cvt_pk_bf16(v1[0], v1[1]); w[3] = cvt_pk_bf16(v1[2], v1[3]);
                    if (nt) __builtin_nontemporal_store(w, (u32x4*)(rowp + bj * bjstep)); else *(u32x4*)(rowp + bj * bjstep) = w; } }
        if ((km != nullptr) && (u.aux == 10)) {
            float* kmb = km + (size_t)(u.orow >> 8) * 256 + wc * 32 + 8 * fq;
#pragma unroll
            for (int bj = 0; bj < 2; ++bj)
#pragma unroll
                for (int n = 0; n < 2; ++n) { f32x4 cs = (f32x4){0.f, 0.f, 0.f, 0.f};
#pragma unroll
                    for (int ai = 0; ai < 2; ++ai)
#pragma unroll
                        for (int m = 0; m < 4; ++m) cs += acc[ai][bj][m][n] * rsv[ai][m];
#pragma unroll
                    for (int j = 0; j < 4; ++j) { float v = cs[j]; v += __shfl_xor(v, 1); v += __shfl_xor(v, 2); v += __shfl_xor(v, 4); v += __shfl_xor(v, 8);
                        if (fr == 0) atomicAdd(kmb + bj * 128 + 4 * n + j, v); } }
        }
    }
};
struct EpiSoftmax { static constexpr bool PERM = true;
    bf16_t* P; const float* ss;
    __device__ __forceinline__ void operator()(const f32x4 (&acc)[2][2][4][2], const Unit& u, int wr, int wc, int fr, int fq, LAS unsigned char* lds, int, int) const {
        LAS f32x2* X = (LAS f32x2*)(lds + LDS_XCH);
        float rsl[2][4], mw[2][4];
#pragma unroll
        for (int ai = 0; ai < 2; ++ai)
#pragma unroll
            for (int m = 0; m < 4; ++m) { const int rl = ai * 128 + wr * 64 + m * 16 + fr; const float rs = row_rstd(ss, u.orow + rl) * LOG2E; rsl[ai][m] = rs;
                float mx = -INFINITY;
#pragma unroll
                for (int bj = 0; bj < 2; ++bj)
#pragma unroll
                    for (int n = 0; n < 2; ++n)
#pragma unroll
                        for (int j = 0; j < 4; ++j) mx = fmaxf(mx, acc[ai][bj][m][n][j] * rs);
                mx = fmaxf(mx, __shfl_xor(mx, 16)); mx = fmaxf(mx, __shfl_xor(mx, 32));
                float sm = 0.f;
#pragma unroll
                for (int bj = 0; bj < 2; ++bj)
#pragma unroll
                    for (int n = 0; n < 2; ++n)
#pragma unroll
                        for (int j = 0; j < 4; ++j) sm += __builtin_amdgcn_exp2f(acc[ai][bj][m][n][j] * rs - mx);
                sm += __shfl_xor(sm, 16); sm += __shfl_xor(sm, 32);
                mw[ai][m] = mx;
                if (fq == 0) X[rl * 4 + wc] = (f32x2){mx, sm}; }
        asm volatile("s_waitcnt lgkmcnt(0)" ::: "memory"); __builtin_amdgcn_s_barrier(); asm volatile("" ::: "memory");
#pragma unroll
        for (int ai = 0; ai < 2; ++ai)
#pragma unroll
            for (int m = 0; m < 4; ++m) { const int rl = ai * 128 + wr * 64 + m * 16 + fr; const float rs = rsl[ai][m];
                const f32x2 x0 = X[rl * 4 + 0], x1 = X[rl * 4 + 1], x2 = X[rl * 4 + 2], x3 = X[rl * 4 + 3];
                const float Mx = fmaxf(fmaxf(x0[0], x1[0]), fmaxf(x2[0], x3[0]));
                const float L = x0[1] * __builtin_amdgcn_exp2f(x0[0] - Mx) + x1[1] * __builtin_amdgcn_exp2f(x1[0] - Mx) + x2[1] * __builtin_amdgcn_exp2f(x2[0] - Mx) + x3[1] * __builtin_amdgcn_exp2f(x3[0] - Mx);
                const float il = 1.0f / L;
                bf16_t* rowp = P + (size_t)(u.orow + rl) * D + u.ocol + wc * 32 + 8 * fq;
#pragma unroll
                for (int bj = 0; bj < 2; ++bj) { float pv[8];
#pragma unroll
                    for (int n = 0; n < 2; ++n)
#pragma unroll
                        for (int j = 0; j < 4; ++j) pv[4 * n + j] = __builtin_amdgcn_exp2f(acc[ai][bj][m][n][j] * rs - Mx) * il;
                    u32x4 w; w[0] = cvt_pk_bf16(pv[0], pv[1]); w[1] = cvt_pk_bf16(pv[2], pv[3]); w[2] = cvt_pk_bf16(pv[4], pv[5]); w[3] = cvt_pk_bf16(pv[6], pv[7]);
                    *(u32x4*)(rowp + bj * 128) = w; } }
        (void)mw;
    }
};

#define XB_TMO      128
#define XB_XCNT(j)  (256  + 64 * (j))
#define XB_XSUB(j)  (1280 + 64 * (j))
#define XB_XGEN(j)  (2304 + 64 * (j))
#define XB_TOP      3328
#define XB_TOPGEN   3392
#define XCD_BAR_WORDS 3456
#define XB_SPIN_CAP (1u << 18)
__device__ __forceinline__ unsigned xb_ld(unsigned* p)              { return __hip_atomic_load(p, __ATOMIC_RELAXED, __HIP_MEMORY_SCOPE_AGENT); }
__device__ __forceinline__ unsigned xb_add(unsigned* p, unsigned v) { return __hip_atomic_fetch_add(p, v, __ATOMIC_RELAXED, __HIP_MEMORY_SCOPE_AGENT); }
__device__ __forceinline__ unsigned xb_xcc_id() { return (unsigned)__builtin_amdgcn_s_getreg((3 << 11) | 20) & 0xFu; }
#define XB_SPIN(cond, bar) do { unsigned _sp = 0; while (cond) { __builtin_amdgcn_s_sleep(1); \
    if ((++_sp & 255u) == 0u) { if (xb_ld(&(bar)[XB_TMO])) break; if (_sp > XB_SPIN_CAP) { atomicAdd(&(bar)[XB_TMO], 1u); break; } } } } while (0)
struct XcdBarrier { unsigned* bar; unsigned x; volatile LAS unsigned* st; };
__device__ __forceinline__ XcdBarrier xcd_barrier_post(unsigned* bar, volatile LAS unsigned* st) {
    XcdBarrier b; b.bar = bar; b.x = xb_xcc_id(); b.st = st;
    if (threadIdx.x == 0) (void)xb_add(&bar[XB_XCNT(b.x)], 1u);
    return b;
}
__device__ __forceinline__ void xcd_barrier_complete(unsigned* bar, unsigned x, unsigned& nloc, unsigned& nx) {
    const unsigned G = gridDim.x * gridDim.y * gridDim.z;
    unsigned sum, cnt, mine, sp = 0u;
    for (;;) {
        sum = 0u; cnt = 0u; mine = 0u;
#pragma unroll
        for (unsigned j = 0; j < 16; ++j) { const unsigned c = xb_ld(&bar[XB_XCNT(j)]); sum += c; cnt += (c > 0u) ? 1u : 0u; mine = (j == x) ? c : mine; }
        if (sum == G) break;
        __builtin_amdgcn_s_sleep(1);
        if ((++sp & 255u) == 0u) { if (xb_ld(&bar[XB_TMO])) break; if (sp > XB_SPIN_CAP) { atomicAdd(&bar[XB_TMO], 1u); break; } }
    }
    nloc = mine > 0u ? mine : 1u; nx = cnt > 0u ? cnt : 1u;
}
__device__ __forceinline__ void xcd_barrier(const XcdBarrier& b) {
    asm volatile("s_waitcnt vmcnt(0)" ::: "memory");
    __syncthreads();
    if (threadIdx.x == 0) {
        unsigned* bar = b.bar;
        __builtin_amdgcn_s_waitcnt(0);
        unsigned nloc = b.st[0], nx = b.st[1];
        if (nloc == 0u) { xcd_barrier_complete(bar, b.x, nloc, nx); b.st[0] = nloc; b.st[1] = nx; }
        const unsigned old = xb_add(&bar[XB_XSUB(b.x)], 1u);
        const unsigned gen = old / nloc;
        if (old + 1u == (gen + 1u) * nloc) {
            __builtin_amdgcn_fence(__ATOMIC_RELEASE, "agent");
            asm volatile("s_waitcnt vmcnt(0)" ::: "memory");
            const unsigned og = xb_add(&bar[XB_TOP], 1u);
            const unsigned tg = og / nx;
            if (og + 1u == (tg + 1u) * nx) xb_add(&bar[XB_TOPGEN], 1u);
            else XB_SPIN(xb_ld(&bar[XB_TOPGEN]) == tg, bar);
            __builtin_amdgcn_fence(__ATOMIC_ACQUIRE, "agent");
            xb_add(&bar[XB_XGEN(b.x)], 1u);
            asm volatile("s_waitcnt vmcnt(0)" ::: "memory");
        } else {
            XB_SPIN(xb_ld(&bar[XB_XGEN(b.x)]) == gen, bar);
            __builtin_amdgcn_fence(__ATOMIC_ACQUIRE, "agent");
            asm volatile("s_waitcnt vmcnt(0)" ::: "memory");
        }
    }
    __syncthreads();
}

template <bool F8>
__device__ __forceinline__ void tr_item(const float* W, int N, int k0, int n0, const float* gain, float cscale, void* dst  , int Kd, LAS float* scr, int lane) {
    f32x4 v[8]; float g[8];
#pragma unroll
    for (int i = 0; i < 8; ++i) { const int kk = 8 * i + (lane >> 3); v[i] = __builtin_nontemporal_load((const f32x4*)(W + (size_t)(k0 + kk) * N + n0 + 4 * (lane & 7))); g[i] = gain ? gain[k0 + kk] * cscale : cscale; }
#pragma unroll
    for (int i = 0; i < 8; ++i) { const int kk = 8 * i + (lane >> 3); LAS float* d = scr + kk * 33 + 4 * (lane & 7); d[0] = v[i][0] * g[i]; d[1] = v[i][1] * g[i]; d[2] = v[i][2] * g[i]; d[3] = v[i][3] * g[i]; }
    asm volatile("s_waitcnt lgkmcnt(0)" ::: "memory");
    const int c = lane & 7;
#pragma unroll
    for (int j = 0; j < 4; ++j) { const int n = (lane >> 3) + 8 * j; const LAS float* s = scr + (8 * c) * 33 + n;
        if constexpr (F8) { u32x2 o; o[0] = pk_fp8x4(s[0 * 33], s[1 * 33], s[2 * 33], s[3 * 33]); o[1] = pk_fp8x4(s[4 * 33], s[5 * 33], s[6 * 33], s[7 * 33]); *(u32x2*)((unsigned char*)dst + (size_t)n * Kd + k0 + 8 * c) = o; }
        else { u32x4 o; o[0] = cvt_pk_bf16(s[0 * 33], s[1 * 33]); o[1] = cvt_pk_bf16(s[2 * 33], s[3 * 33]); o[2] = cvt_pk_bf16(s[4 * 33], s[5 * 33]); o[3] = cvt_pk_bf16(s[6 * 33], s[7 * 33]);
            *(u32x4*)((bf16_t*)dst + (size_t)n * Kd + k0 + 8 * c) = o; } }
    asm volatile("s_waitcnt lgkmcnt(0)" ::: "memory");
}
template <int NR, int Q8>
__device__ __forceinline__ void cvt_rows(const float* x, bf16_t* o, unsigned char* o8, float* sx, float* ss, int row0, int stride, int nrows, int lane) {
    f32x4 v[NR][4]; float s[NR];
#pragma unroll
    for (int r = 0; r < NR; ++r) { const int row = row0 + r * stride; const f32x4* xr = (const f32x4*)(x + (size_t)(row < nrows ? row : row0) * D) + lane;
#pragma unroll
        for (int j = 0; j < 4; ++j) v[r][j] = __builtin_nontemporal_load(xr + 64 * j); }
#pragma unroll
    for (int r = 0; r < NR; ++r) { float a = 0.f;
#pragma unroll
        for (int j = 0; j < 4; ++j) a += (v[r][j][0] * v[r][j][0] + v[r][j][1] * v[r][j][1]) + (v[r][j][2] * v[r][j][2] + v[r][j][3] * v[r][j][3]);
        s[r] = a; }
#pragma unroll
    for (int of = 1; of < 64; of <<= 1)
#pragma unroll
        for (int r = 0; r < NR; ++r) s[r] += __shfl_xor(s[r], of);
#pragma unroll
    for (int r = 0; r < NR; ++r) { const int row = row0 + r * stride; if (row < nrows) { u32x2* ob = (u32x2*)(o + (size_t)row * D) + lane;
#pragma unroll
            for (int j = 0; j < 4; ++j) { u32x2 w; w[0] = cvt_pk_bf16(v[r][j][0], v[r][j][1]); w[1] = cvt_pk_bf16(v[r][j][2], v[r][j][3]); ob[64 * j] = w; }
            if constexpr (Q8 == 1) { unsigned* oq = (unsigned*)(o8 + (size_t)row * D) + lane;
#pragma unroll
                for (int j = 0; j < 4; ++j) oq[64 * j] = pk_fp8x4(v[r][j][0], v[r][j][1], v[r][j][2], v[r][j][3]); }
            if constexpr (Q8 == 2) { float mx = 0.f;
#pragma unroll
                for (int j = 0; j < 4; ++j) mx = fmaxf(fmaxf(mx, fmaxf(fabsf(v[r][j][0]), fabsf(v[r][j][1]))), fmaxf(fabsf(v[r][j][2]), fabsf(v[r][j][3])));
#pragma unroll
                for (int of = 1; of < 64; of <<= 1) mx = fmaxf(mx, __shfl_xor(mx, of));
                mx = fmaxf(mx, 1e-30f); const float inv = 127.0f / mx; unsigned* oq = (unsigned*)(o8 + (size_t)row * D) + lane;
#pragma unroll
                for (int j = 0; j < 4; ++j) oq[64 * j] = pk_i8x4(v[r][j][0] * inv, v[r][j][1] * inv, v[r][j][2] * inv, v[r][j][3] * inv);
                if (lane == 0) sx[row] = mx * (1.0f / 127.0f); }
            if (lane < 16) ss[(size_t)row * 16 + lane] = lane == 0 ? s[r] : 0.f; } }
}

struct Args { const float* in[20]; float* out; unsigned char* ws; int ph_lo, ph_hi, flags, pad; };

#define MK_PTRS unsigned char* ws = args.ws; float* out = args.out; asm volatile("" : "+s"(ws), "+s"(out)); \
    const float* x_in = args.in[0]; const float* mem_in = args.in[1]; const float* rel_bias = args.in[7]; \
    bf16_t* Wgu1 = (bf16_t*)(ws + WS_WGU1); bf16_t* Wd1 = (bf16_t*)(ws + WS_WD1); bf16_t* Win = (bf16_t*)(ws + WS_WIN); bf16_t* Wout = (bf16_t*)(ws + WS_WOUT); \
    bf16_t* Wcqs = (bf16_t*)(ws + WS_WCQS); bf16_t* Wckv = (bf16_t*)(ws + WS_WCKV); bf16_t* Wco = (bf16_t*)(ws + WS_WCO); bf16_t* Wgu2 = (bf16_t*)(ws + WS_WGU2); bf16_t* Wd2 = (bf16_t*)(ws + WS_WD2); \
    bf16_t* MB = (bf16_t*)(ws + WS_MB); bf16_t* KVC = (bf16_t*)(ws + WS_KVC); bf16_t* WKT = (bf16_t*)(ws + WS_WKT); bf16_t* VWT = (bf16_t*)(ws + WS_VWT); \
    float* SS0 = (float*)(ws + WS_SS); float* SS1 = SS0 + (size_t)M * 16; float* SS2 = SS1 + (size_t)M * 16; float* SS3 = SS2 + (size_t)M * 16; float* SS4 = SS3 + (size_t)M * 16; \
    float* SSM = (float*)(ws + WS_SSM); float* KM = (float*)(ws + WS_KM); float* SX = (float*)(ws + WS_SX); float* SW = (float*)(ws + WS_SW); (void)SX; (void)SW; \
    bf16_t* HB = (bf16_t*)(ws + WS_R1); bf16_t* QKV = HB; bf16_t* YN = HB; bf16_t* PB = HB; \
    bf16_t* XB = (bf16_t*)(ws + WS_XB); unsigned char* X8 = ws + WS_X8; (void)X8; bf16_t* OA0 = (bf16_t*)out; bf16_t* OA1 = (bf16_t*)((char*)out + OUT_OA1); bf16_t* OA2 = (bf16_t*)(ws + WS_OA2); bf16_t* OB = (bf16_t*)((char*)out + OUT_OB); float* ML = (float*)((char*)out + OUT_ML); unsigned* SEL = (unsigned*)(ws + WS_SEL); bf16_t* OBP = (bf16_t*)(ws + WS_OBP); float* MLB = (float*)(ws + WS_MLB); (void)OB;
__global__ void __launch_bounds__(NWAVES * 64, 2) mk_fwd(Args args) {
    extern __shared__ __attribute__((aligned(16))) unsigned char lds_raw[];
    LAS unsigned char* lds = (LAS unsigned char*)lds_raw;
    const int tid = threadIdx.x, lane = tid & 63, wave = __builtin_amdgcn_readfirstlane(tid >> 6);
    const int G = gridDim.x, bx = blockIdx.x;
    const int vcu = (G % 8 == 0) ? (bx % 8) * (G / 8) + bx / 8 : bx;
    const int gw = vcu * NWAVES + wave, NGW = G * NWAVES;
    unsigned char* const ws0 = args.ws;
    volatile LAS unsigned* MISC = (volatile LAS unsigned*)(lds + LDS_MISC);
    if (tid < 32) MISC[tid] = 0u;
    __syncthreads();
    const int lo = args.ph_lo, hi = args.ph_hi;
    const bool use_bar = (hi - lo) > 1;
    XcdBarrier bar; bar.bar = (unsigned*)(ws0 + WS_CTL) + CW_BAR; bar.x = 0; bar.st = nullptr;
    if (use_bar) bar = xcd_barrier_post((unsigned*)(ws0 + WS_CTL) + CW_BAR, MISC + 8);
#define IN(k) (lo <= (k) && (k) < hi)
#define STAGGER() do { if (MK_STAGGER_TICKS > 0) { const unsigned long long t0_ = __builtin_amdgcn_s_memrealtime(), dl_ = (unsigned long long)((bx >> 3) & 3) * MK_STAGGER_TICKS; while (__builtin_amdgcn_s_memrealtime() - t0_ < dl_) __builtin_amdgcn_s_sleep(8); } } while (0)
#define SEAM(k) do { if (IN(k) && IN((k) + 1)) xcd_barrier(bar); } while (0)

    if (IN(0)) {
        MK_PTRS;
        LAS float* scr = (LAS float*)(lds + wave * 16384);
        constexpr int I_GU = (D / 64) * (2 * DFF / 32), I_DN = (DFF / 64) * (D / 32), I_IN = (D / 64) * (NQKV / 32), I_SQ = (D / 64) * (D / 32), I_KV = (D / 64) * (2 * D / 32);
        constexpr int NITEMS = 2 * I_GU + 2 * I_DN + I_IN + 2 * I_SQ + I_KV;
        for (int it = gw; it < NITEMS; it += NGW) {
            int r = it;
            if (r < 2 * I_GU) {
                const bool second = r >= I_GU; if (second) r -= I_GU;
                if (I8_1G && !second) continue;
                const int nblk = 2 * DFF / 32, kb = r / nblk, nb = r % nblk, n0 = nb * 32;
                const int drow = n0 < DFF ? (n0 / 128) * 256 + (n0 % 128) : ((n0 - DFF) / 128) * 256 + 128 + ((n0 - DFF) % 128);
                if (second ? F8_2G : F8_1G) tr_item<true>(args.in[second ? 17 : 3], 2 * DFF, kb * 64, n0, args.in[second ? 16 : 2], F8_WGU, (unsigned char*)(second ? Wgu2 : Wgu1) + (size_t)drow * D, D, scr, lane);
                else tr_item<false>(args.in[second ? 17 : 3], 2 * DFF, kb * 64, n0, args.in[second ? 16 : 2], 1.0f, (second ? Wgu2 : Wgu1) + (size_t)drow * D, D, scr, lane);
                continue; }
            r -= 2 * I_GU;
            if (r < 2 * I_DN) { const bool second = r >= I_DN; if (second) r -= I_DN; const int nblk = D / 32, kb = r / nblk, nb = r % nblk;
                if (second ? F8_2D : F8_1D) tr_item<true>(args.in[second ? 18 : 4], D, kb * 64, nb * 32, nullptr, F8_WD, (unsigned char*)(second ? Wd2 : Wd1) + (size_t)(nb * 32) * DFF, DFF, scr, lane);
                else tr_item<false>(args.in[second ? 18 : 4], D, kb * 64, nb * 32, nullptr, 1.0f, (second ? Wd2 : Wd1) + (size_t)(nb * 32) * DFF, DFF, scr, lane);
                continue; }
            r -= 2 * I_DN;
            if (r < I_IN) { const int nblk = NQKV / 32, kb = r / nblk, nb = r % nblk, n0 = nb * 32; const bool isq = (n0 < 768) || (n0 >= 2304 && n0 < 2560);
                tr_item<false>(args.in[6], NQKV, kb * 64, n0, args.in[5], isq ? 0.125f : 1.0f, Win + (size_t)n0 * D, D, scr, lane); continue; }
            r -= I_IN;
            if (r < I_SQ) { const int nblk = D / 32, kb = r / nblk, nb = r % nblk, k0 = kb * 64; const float* gp = k0 < 768 ? args.in[8] : args.in[9] - 768;
                tr_item<false>(args.in[10], D, k0, nb * 32, gp, 1.0f, Wout + (size_t)(nb * 32) * D, D, scr, lane); continue; }
            r -= I_SQ;
            if (r < I_SQ) { const int nblk = D / 32, kb = r / nblk, nb = r % nblk; tr_item<false>(args.in[15], D, kb * 64, nb * 32, nullptr, 1.0f, Wco + (size_t)(nb * 32) * D, D, scr, lane); continue; }
            r -= I_SQ;
            { const int nblk = 2 * D / 32, kb = r / nblk, nb = r % nblk; tr_item<false>(args.in[14], 2 * D, kb * 64, nb * 32, args.in[12], 1.0f, Wckv + (size_t)(nb * 32) * D, D, scr, lane); }
        }
        if constexpr (I8_1G) {
            for (int cg = vcu; cg < 2 * DFF / 32; cg += G) {
                const int n0 = cg * 32, drow = n0 < DFF ? (n0 / 128) * 256 + (n0 % 128) : ((n0 - DFF) / 128) * 256 + 128 + ((n0 - DFF) % 128);
                const float* W = args.in[3]; const float* gain = args.in[2];
                f32x4 v[2][8]; f32x4 mx = (f32x4){0.f, 0.f, 0.f, 0.f};
#pragma unroll
                for (int t = 0; t < 2; ++t)
#pragma unroll
                    for (int i = 0; i < 8; ++i) { const int kk = (2 * wave + t) * 64 + 8 * i + (lane >> 3); v[t][i] = __builtin_nontemporal_load((const f32x4*)(W + (size_t)kk * (2 * DFF) + n0 + 4 * (lane & 7))) * gain[kk]; }
#pragma unroll
                for (int t = 0; t < 2; ++t)
#pragma unroll
                    for (int i = 0; i < 8; ++i)
#pragma unroll
                        for (int c = 0; c < 4; ++c) mx[c] = fmaxf(mx[c], fabsf(v[t][i][c]));
#pragma unroll
                for (int c = 0; c < 4; ++c) { float a = mx[c]; a = fmaxf(a, __shfl_xor(a, 8)); a = fmaxf(a, __shfl_xor(a, 16)); a = fmaxf(a, __shfl_xor(a, 32)); mx[c] = a; }
                LAS float* XM = (LAS float*)(lds + LDS_XCH);
                if (lane < 8) { XM[wave * 32 + 4 * lane + 0] = mx[0]; XM[wave * 32 + 4 * lane + 1] = mx[1]; XM[wave * 32 + 4 * lane + 2] = mx[2]; XM[wave * 32 + 4 * lane + 3] = mx[3]; }
                asm volatile("s_waitcnt lgkmcnt(0)" ::: "memory"); __syncthreads();
                float mul[4];
#pragma unroll
                for (int c = 0; c < 4; ++c) { float a = 0.f;
#pragma unroll
                    for (int w2 = 0; w2 < NWAVES; ++w2) a = fmaxf(a, XM[w2 * 32 + 4 * (lane & 7) + c]);
                    a = fmaxf(a, 1e-30f); mul[c] = 127.0f / a; if (wave == 0 && lane < 8) SW[n0 + 4 * lane + c] = a * (1.0f / 127.0f); }
#pragma unroll
                for (int t = 0; t < 2; ++t) { const int k0 = (2 * wave + t) * 64;
#pragma unroll
                    for (int i = 0; i < 8; ++i) { const int kk = 8 * i + (lane >> 3); LAS float* d = scr + kk * 33 + 4 * (lane & 7); d[0] = v[t][i][0] * mul[0]; d[1] = v[t][i][1] * mul[1]; d[2] = v[t][i][2] * mul[2]; d[3] = v[t][i][3] * mul[3]; }
                    asm volatile("s_waitcnt lgkmcnt(0)" ::: "memory");
                    const int c8 = lane & 7;
#pragma unroll
                    for (int j = 0; j < 4; ++j) { const int n = (lane >> 3) + 8 * j; const LAS float* s = scr + (8 * c8) * 33 + n;
                        u32x2 o; o[0] = pk_i8x4(s[0 * 33], s[1 * 33], s[2 * 33], s[3 * 33]); o[1] = pk_i8x4(s[4 * 33], s[5 * 33], s[6 * 33], s[7 * 33]);
                        *(u32x2*)((unsigned char*)Wgu1 + (size_t)(drow + n) * D + k0 + 8 * c8) = o; }
                    asm volatile("s_waitcnt lgkmcnt(0)" ::: "memory"); }
                __syncthreads();
            }
        }
        for (int c = gw; c < D; c += NGW) { const float g = args.in[11][c] * 0.0625f; const f32x4* src = (const f32x4*)(args.in[13] + (size_t)c * D) + lane; u32x2* dst = (u32x2*)(Wcqs + (size_t)c * D) + lane;
#pragma unroll
            for (int j = 0; j < 4; ++j) { const f32x4 v = src[64 * j] * g; u32x2 w; w[0] = cvt_pk_bf16(v[0], v[1]); w[1] = cvt_pk_bf16(v[2], v[3]); dst[64 * j] = w; } }
        for (int m = gw; m < M; m += 4 * NGW) cvt_rows<4, I8_1G ? 2 : (F8_1G ? 1 : 0)>(x_in, XB, X8, SX, SS0, m, NGW, M, lane);
        for (int m = gw; m < MM; m += NGW) cvt_rows<1, 0>(mem_in, MB, nullptr, nullptr, SSM, m, NGW, MM, lane);
        for (int i = gw * 64 + lane; i < NBAT * 16 * 256; i += NGW * 64) KM[i] = 0.f;
    }
    SEAM(0);

    if (IN(1)) {
        MK_PTRS;
        STAGGER();
        { constexpr int EB = (F8_1G || I8_1G) ? 1 : 2;
          SchedStd S; S.o.init(M, 2 * DFF, G, bx); S.A = (F8_1G || I8_1G) ? (const char*)X8 : (const char*)XB; S.B = (const char*)Wgu1; S.a_tile = (size_t)256 * D * EB; S.b_tile = (size_t)256 * D * EB; S.b_batch = 0; S.ocol_mul = 128;
          EpiGU<F8_1G, F8_1D, I8_1G> E{HB, SS0, SX, SW}; pg8::gemm_phase<EpiGU<F8_1G, F8_1D, I8_1G>, SchedStd, true, I8_1G ? 2 : (F8_1G ? 1 : 0)>(lds, D * EB / 2, D * EB / 2, D * EB / 128, S, E); }
    }
    SEAM(1);

    if (IN(2)) {
        MK_PTRS;
        constexpr int EB = F8_1D ? 1 : 2;
        SchedStd S; S.o.init(M, D, G, bx); S.A = (const char*)HB; S.B = (const char*)Wd1; S.a_tile = (size_t)256 * DFF * EB; S.b_tile = (size_t)256 * DFF * EB; S.b_batch = 0; S.ocol_mul = 256;
        EpiRes<false> E{XB, SS1, F8_1D ? 0.5f / (F8_H * F8_WD) : 0.5f, nullptr}; pg8::gemm_phase<EpiRes<false>, SchedStd, true, F8_1D>(lds, DFF * EB / 2, DFF * EB / 2, DFF * EB / 128, S, E);
    }
    SEAM(2);

    if (IN(3)) {
        MK_PTRS;
        { SchedStd S; S.o.init(M, NQKV, G, bx); S.A = (const char*)XB; S.B = (const char*)Win; S.a_tile = (size_t)256 * D * 2; S.b_tile = (size_t)256 * D * 2; S.b_batch = 0; S.ocol_mul = 256;
          EpiStore E{QKV, 0, SS1, KM, false}; pg8::gemm_phase<EpiStore, SchedStd, true>(lds, D, D, D / 64, S, E); }
    }
    SEAM(3);

    if (IN(4)) {
        MK_PTRS;
        constexpr long HSTR4 = (long)SEQ * 128;
        for (int task = gw; task < NBAT * 4 * (SEQ / 32); task += NGW) { const int bh = task / (SEQ / 32), tl = task % (SEQ / 32), b = bh >> 2, hb = bh & 3, q0 = tl * 32, qb = q0 >> 8;
            const char* qbase = (const char*)QKV + ((size_t)b * 48 + 36 + hb) * HSTR4 + (size_t)q0 * 128;
            const unsigned msk = att::moba_select(qbase, 128, KM + (size_t)b * 16 * 256 + hb * 64, qb);
            if (lane < 32) SEL[(size_t)bh * SEQ + q0 + lane] = msk; }
    }
    SEAM(4);

    if (IN(5)) {
        MK_PTRS;
        LAS float* tab = (LAS float*)(lds + LDS_TAB);
        const int h2 = lane >> 5, q = lane & 31;
        const long rowb = 128;
        constexpr long HSTR = (long)SEQ * 128;
#define ATT_WAITV(n) asm volatile("s_waitcnt vmcnt(" #n ")" ::: "memory")
#define ATT_BAR() do { asm volatile("s_waitcnt lgkmcnt(0)" ::: "memory"); __builtin_amdgcn_s_barrier(); asm volatile("" ::: "memory"); } while (0)
        { constexpr int NKV = NBAT * 8;
          struct SchedOne { const char* A; const char* B; int G_, c_; __device__ __forceinline__ bool next(int i, Unit& uu) const { const int idx = i * G_ + c_; if (idx >= NKV) return false; const int pm = idx >> 3, pn = idx & 7;
              uu.a = A + (size_t)pm * 256 * D * 2; uu.b = B + (size_t)pn * 256 * D * 2; uu.orow = pm * 256; uu.ocol = pn * 256; uu.aux = pn; return true; } };
          SchedOne S1{(const char*)MB, (const char*)Wckv, G, vcu};
          EpiStore Ekv{KVC, 2 * D, SSM, nullptr, false}; pg8::gemm_phase<EpiStore, SchedOne, true>(lds, D, D, D / 64, S1, Ekv);
          __syncthreads(); }
        for (int i = tid; i < 4 * att::TABB_N; i += NWAVES * 64) { const int hb = i / att::TABB_N, e = i % att::TABB_N, dist = e - 32;
            tab[i] = dist >= 0 ? rel_bias[att::rel_bucket(dist) * 16 + 12 + hb] * LOG2E : -INFINITY; }
        __syncthreads();
        {
            constexpr int NBH = NBAT * 4, NUNITS = 16 * NBH;
            LAS unsigned* LQ = (LAS unsigned*)(lds + 65536);
            volatile LAS unsigned* UW = (volatile LAS unsigned*)(lds + 65536 + 16384);
            unsigned* qhead = (unsigned*)(ws + WS_CTL) + CW_QUEUE;
#pragma unroll 1
            for (;;) {
                if (tid == 0) UW[8] = __hip_atomic_fetch_add(qhead, 1u, __ATOMIC_RELAXED, __HIP_MEMORY_SCOPE_AGENT);
                ATT_BAR();
                const int u = (int)UW[8];
                if (u >= NUNITS) break;
                const int n = u / NBH, bh = u % NBH, b = bh >> 2, hb = bh & 3;
                const char* qh = (const char*)QKV + ((size_t)b * 48 + 36 + hb) * HSTR;
                const char* kh = (const char*)QKV + ((size_t)b * 48 + 40 + hb) * HSTR + (size_t)(256 * n) * rowb;
                const unsigned* selp = SEL + (size_t)bh * SEQ;
                ATT_WAITV(0);
#pragma unroll
                for (int k = wave; k < 32; k += NWAVES) { const int row = 8 * k + (lane >> 3); att::dma_rows8(kh + (long)row * rowb, (int)(4 * HSTR), row, (LAS char*)(lds + k * 1024), (LAS char*)(lds + 32768 + k * 1024), lane); }
                int total = 0;
                if (n < 15) {
                    const int lo = 256 * (n + 1) + wave * 32 * (15 - n), R = 32 * (15 - n);
                    int cnt = 0;
#pragma unroll 1
                    for (int i = 0; i < R; i += 64) { const bool pr = (i + lane < R) && ((selp[lo + i + lane] >> n) & 1u); cnt += __popcll(__ballot(pr)); }
                    if (lane == 0) UW[wave] = (unsigned)cnt;
                    ATT_BAR();
                    int basew = 0;
#pragma unroll
                    for (int w2 = 0; w2 < NWAVES; ++w2) { const int cw = (int)UW[w2]; basew += (w2 < wave) ? cw : 0; total += cw; }
#pragma unroll 1
                    for (int i = 0; i < R; i += 64) { const bool pr = (i + lane < R) && ((selp[lo + i + lane] >> n) & 1u); const unsigned long long bal = __ballot(pr);
                        if (pr) LQ[basew + __popcll(bal & ((1ull << lane) - 1ull))] = (unsigned)(lo + i + lane); basew += __popcll(bal); }
                }
                const int ntiles = (total + 31) >> 5;
                ATT_WAITV(0); ATT_BAR();
                const LAS float* tb = tab + hb * att::TABB_N;
#pragma unroll 1
                for (int tile = -1; tile < ntiles; tile = (tile < 0 ? wave : tile + NWAVES)) {
                    const bool own = tile < 0;
                    int tq; bool valid = true;
                    if (own) tq = 256 * n + 32 * wave + q; else { const int e = 32 * tile + q; valid = e < total; tq = (int)LQ[valid ? e : total - 1]; }
                    att::bf16x8 qf[4];
#pragma unroll
                    for (int d0 = 0; d0 < 4; ++d0) qf[d0] = *(const att::bf16x8*)(qh + (long)tq * rowb + (16 * d0 + 8 * h2) * 2);
                    const int slot = own ? 3 : __popc(selp[tq] & ((1u << n) - 1u));
                    att::f32x16 o[2]; o[0] = att::f32x16{}; o[1] = att::f32x16{}; float mo = -1e30f, lo_ = 0.f;
                    const int Bq = (tq - 256 * n + 32) - 4 * h2;
#pragma unroll 1
                    for (int g = own ? wave : 7; g >= 0; --g) { int B = Bq - 32 * g; B = B < (att::TABB_N - 1) ? B : (att::TABB_N - 1);
                        att::attn_group(qf, o, mo, lo_, (const LAS char*)(lds + g * 4096), (const LAS char*)(lds + 32768 + g * 4096), tb + B, lane); }
                    lo_ += __shfl_xor(lo_, 32);
                    const size_t prow = (size_t)slot * M + (size_t)b * SEQ + tq;
                    att::store_o<MK_NT_PART>(o, lo_, (char*)OBP + (prow * 256 + hb * 64) * 2, h2, valid);
                    if (h2 == 0 && valid) *(f32x2*)(MLB + (prow * 4 + hb) * 2) = (f32x2){mo, lo_};
                }
                ATT_BAR();
            }
        }
        __syncthreads();
        LAS float* rbl = (LAS float*)(lds + LDS_TAB); LAS float* tabI = (LAS float*)(lds + LDS_TAB + 2048);
        LAS char* ostg = (LAS char*)(lds + LDS_TAB + 3072 + wave * 4096);
        static_assert(LDS_TAB + 3072 + NWAVES * 4096 <= LDS_MISC, "dilated LDS map");
        for (int i = tid; i < 512; i += NWAVES * 64) rbl[i] = rel_bias[i] * LOG2E;
        __syncthreads();
        constexpr int NDIL = NBAT * 12 * 48;
        struct DilItem { int b, h, p, d, res, m0, mbase; };
        auto decode = [&](int it, DilItem& I) { const int bh = it / 48, j = it % 48; I.b = bh / 12; I.h = bh % 12; I.p = j >> 4; const int jj = j & 15;
            I.d = I.p == 0 ? 1 : (I.p == 1 ? 4 : 16); I.res = I.p == 0 ? 0 : (I.p == 1 ? (jj & 3) : jj); const int mblk = I.p == 0 ? jj : (I.p == 1 ? (jj >> 2) : 0);
            I.mbase = mblk * 256 - 128; I.m0 = mblk * 256 + wave * 32; };
        att::bf16x8 qf[4];
        auto issue_k = [&](const DilItem& I) {
            const char* kb = (const char*)QKV + ((size_t)I.b * 48 + 12 + I.h) * HSTR + (size_t)I.res * rowb; const long st = (long)I.d * rowb;
#pragma unroll 1
            for (int k = wave; k < 48; k += NWAVES) { if (I.mbase + 8 * k < 0) continue; const int row = 8 * k + (lane >> 3); att::dma_k_rows8(kb + (long)(I.mbase + row) * st, row, (LAS char*)(lds + k * 1024), lane); } };
        auto issue_v = [&](const DilItem& I) {
            const char* vb = (const char*)QKV + ((size_t)I.b * 48 + 24 + I.h) * HSTR + (size_t)I.res * rowb; const long st = (long)I.d * rowb;
#pragma unroll 1
            for (int k = wave; k < 48; k += NWAVES) { if (I.mbase + 8 * k < 0) continue; const int row = 8 * k + (lane >> 3); att::dma_v_rows8(vb + (long)(I.mbase + row) * st, row, (LAS char*)(lds + 49152 + k * 1024), lane); } };
        auto load_q = [&](const DilItem& I) {
            const char* qp = (const char*)QKV + ((size_t)I.b * 48 + I.h) * HSTR + (size_t)I.res * rowb + (long)I.m0 * I.d * rowb + (long)q * I.d * rowb + 16 * h2;
            asm volatile("global_load_dwordx4 %0, %4, off\n\tglobal_load_dwordx4 %1, %4, off offset:32\n\tglobal_load_dwordx4 %2, %4, off offset:64\n\tglobal_load_dwordx4 %3, %4, off offset:96"
                         : "=&v"(qf[0]), "=&v"(qf[1]), "=&v"(qf[2]), "=&v"(qf[3]) : "v"(qp) : "memory"); };
        auto build_tab = [&](const DilItem& I) { if (tid < att::TABA_N) { const int delta = tid - 32; tabI[tid] = (delta >= 0 && delta <= 128) ? rbl[att::rel_bucket(delta * I.d) * 16 + I.h] : -INFINITY; } };
        att::u32x4 vr[6];
        auto load_v = [&](const DilItem& I) {
            const char* vb = (const char*)QKV + ((size_t)I.b * 48 + 24 + I.h) * HSTR + (size_t)I.res * rowb; const long st = (long)I.d * rowb;
#pragma unroll
            for (int j = 0; j < 6; ++j) { const int k = wave + NWAVES * j; if (I.mbase + 8 * k < 0) continue; const int row = 8 * k + (lane >> 3);
                const char* src = vb + (long)(I.mbase + row) * st + 16 * ((lane & 7) ^ (((row >> 1) & 1) << 2));
                asm volatile("global_load_dwordx4 %0, %1, off" : "=&v"(vr[j]) : "v"(src) : "memory"); } };
        DilItem cur; int it = vcu;
        if (it < NDIL) { decode(it, cur); build_tab(cur); ATT_WAITV(0); issue_k(cur); load_q(cur); issue_v(cur); }
        att::f32x16 po[2]; po[0] = att::f32x16{}; po[1] = att::f32x16{}; float pmo = 0.f, plo = 1.f; DilItem pdone = cur; int pm0 = 0; bool pvalid = false;
#define FLUSH_PREV() do { const size_t tok_ = (size_t)pdone.b * SEQ + (size_t)(pm0 + q) * pdone.d + pdone.res; \
            att::store_o_staged<MK_NT_PART>(po, plo, ostg, (char*)(pdone.p == 0 ? OA0 : (pdone.p == 1 ? OA1 : OA2)) + (((size_t)pdone.b * SEQ + (size_t)pm0 * pdone.d + pdone.res) * 768 + pdone.h * 64) * 2, (long)pdone.d * 768 * 2, lane); \
            if (h2 == 0) *(f32x2*)(ML + (((size_t)pdone.p * M + tok_) * 12 + pdone.h) * 2) = (f32x2){pmo, plo}; } while (0)
#pragma unroll 1
        for (; it < NDIL; it += G) {
            ATT_WAITV(0);
            asm volatile("" : "+v"(qf[0]), "+v"(qf[1]), "+v"(qf[2]), "+v"(qf[3]));
            ATT_BAR();
            const bool has_next = it + G < NDIL; DilItem nxt = cur; if (has_next) decode(it + G, nxt);
            if (pvalid) FLUSH_PREV();
            if (has_next) load_v(nxt);
            const int m0 = cur.m0, gend = (m0 - 128) > 0 ? (m0 - 128) : 0, ng = ((m0 - gend) >> 5) + 1;
            att::u32x4 pw[5][2]; float mo, lo_;
            { att::bf16x8 qc[4] = {qf[0], qf[1], qf[2], qf[3]};
              att::dil_pass1(qc, ng, (const LAS char*)(lds + (m0 - cur.mbase) * 128), tabI + 32 + q - 4 * h2, pw, mo, lo_, lane); }
            ATT_BAR();
            const DilItem done = cur;
            if (has_next) { cur = nxt; issue_k(cur); build_tab(cur); load_q(cur); }
            att::f32x16 o[2];
            att::dil_pass2(ng, (const LAS char*)(lds + 49152 + (m0 - done.mbase) * 128), pw, o, lane);
            ATT_BAR();
            po[0] = o[0]; po[1] = o[1]; pmo = mo; plo = lo_; pdone = done; pm0 = m0; pvalid = true;
            if (has_next) {
                if (cur.mbase < 0) ATT_WAITV(8); else ATT_WAITV(10);
                asm volatile("" : "+v"(vr[0]), "+v"(vr[1]), "+v"(vr[2]), "+v"(vr[3]), "+v"(vr[4]), "+v"(vr[5]));
#pragma unroll
                for (int j = 0; j < 6; ++j) { const int k = wave + NWAVES * j; if (cur.mbase + 8 * k < 0) continue; *(LAS att::u32x4*)(lds + 49152 + k * 1024 + lane * 16) = vr[j]; }
            }
        }
        if (pvalid) FLUSH_PREV();
#undef FLUSH_PREV
#undef ATT_WAITV
#undef ATT_BAR
    }
    SEAM(5);

    if (IN(6)) {
        MK_PTRS;
        for (int row0 = gw; row0 < M; row0 += 2 * NGW) {
            f32x2 ml[2][3][3]; u32x2 oa[2][3][3]; f32x2 mlb[2][4]; u32x2 obp[2][4];
#pragma unroll
            for (int r = 0; r < 2; ++r) { const int row = (row0 + r * NGW) < M ? (row0 + r * NGW) : row0;
#pragma unroll
                for (int k = 0; k < 3; ++k) { const int col = 256 * k + 4 * lane, hd = col >> 6;
#pragma unroll
                    for (int p = 0; p < 3; ++p) ml[r][k][p] = __builtin_nontemporal_load((const f32x2*)(ML + (((size_t)p * M + row) * 12 + hd) * 2));
                    oa[r][k][0] = __builtin_nontemporal_load((const u32x2*)(OA0 + (size_t)row * 768 + col)); oa[r][k][1] = __builtin_nontemporal_load((const u32x2*)(OA1 + (size_t)row * 768 + col)); oa[r][k][2] = __builtin_nontemporal_load((const u32x2*)(OA2 + (size_t)row * 768 + col)); }
#pragma unroll
                for (int s = 0; s < 4; ++s) { mlb[r][s] = __builtin_nontemporal_load((const f32x2*)(MLB + (((size_t)s * M + row) * 4 + (lane >> 4)) * 2)); obp[r][s] = __builtin_nontemporal_load((const u32x2*)(OBP + ((size_t)s * M + row) * 256 + 4 * lane)); } }
            float va[2][3][4], vb[2][4], ssa[2], ssb[2];
#pragma unroll
            for (int r = 0; r < 2; ++r) { ssa[r] = 0.f; ssb[r] = 0.f;
#pragma unroll
                for (int k = 0; k < 3; ++k) {
                    const float Mx = fmaxf(ml[r][k][0][0], fmaxf(ml[r][k][1][0], ml[r][k][2][0]));
                    const float w0 = ml[r][k][0][1] * __builtin_amdgcn_exp2f(ml[r][k][0][0] - Mx), w1 = ml[r][k][1][1] * __builtin_amdgcn_exp2f(ml[r][k][1][0] - Mx), w2 = ml[r][k][2][1] * __builtin_amdgcn_exp2f(ml[r][k][2][0] - Mx);
                    const float iw = 1.0f / (w0 + w1 + w2);
#pragma unroll
                    for (int e = 0; e < 4; ++e) { const unsigned s0 = oa[r][k][0][e >> 1], s1 = oa[r][k][1][e >> 1], s2 = oa[r][k][2][e >> 1];
                        const float f0 = __builtin_bit_cast(float, (e & 1) ? (s0 & 0xffff0000u) : (s0 << 16)), f1 = __builtin_bit_cast(float, (e & 1) ? (s1 & 0xffff0000u) : (s1 << 16)), f2 = __builtin_bit_cast(float, (e & 1) ? (s2 & 0xffff0000u) : (s2 << 16));
                        const float v = (w0 * f0 + w1 * f1 + w2 * f2) * iw; va[r][k][e] = v; ssa[r] += v * v; } }
                { const int rowq = (row0 + r * NGW) < M ? (row0 + r * NGW) : row0, nsel = (((rowq % SEQ) >> 8) < 3) ? ((rowq % SEQ) >> 8) : 3;
                  float wq[4], Mq = -INFINITY;
#pragma unroll
                  for (int s = 0; s < 4; ++s) { const bool use = (s == 3) || (s < nsel); Mq = use ? fmaxf(Mq, mlb[r][s][0]) : Mq; }
                  float wsum = 0.f;
#pragma unroll
                  for (int s = 0; s < 4; ++s) { const bool use = (s == 3) || (s < nsel); wq[s] = use ? mlb[r][s][1] * __builtin_amdgcn_exp2f(mlb[r][s][0] - Mq) : 0.f; wsum += wq[s]; }
                  const float iwq = 1.0f / wsum;
#pragma unroll
                  for (int e = 0; e < 4; ++e) { float acc_ = 0.f;
#pragma unroll
                      for (int s = 0; s < 4; ++s) { const bool use = (s == 3) || (s < nsel); const unsigned s0 = obp[r][s][e >> 1]; const float f = __builtin_bit_cast(float, (e & 1) ? (s0 & 0xffff0000u) : (s0 << 16)); acc_ += use ? wq[s] * f : 0.f; }
                      vb[r][e] = acc_ * iwq; ssb[r] += vb[r][e] * vb[r][e]; } } }
#pragma unroll
            for (int of = 1; of < 64; of <<= 1)
#pragma unroll
                for (int r = 0; r < 2; ++r) { ssa[r] += __shfl_xor(ssa[r], of); ssb[r] += __shfl_xor(ssb[r], of); }
#pragma unroll
            for (int r = 0; r < 2; ++r) { const int row = row0 + r * NGW; if (row < M) {
                const float ra = __builtin_amdgcn_rsqf(ssa[r] * (1.0f / 768.0f) + EPS), rb = __builtin_amdgcn_rsqf(ssb[r] * (1.0f / 256.0f) + EPS);
#pragma unroll
                for (int k = 0; k < 3; ++k) { u32x2 w; w[0] = cvt_pk_bf16(va[r][k][0] * ra, va[r][k][1] * ra); w[1] = cvt_pk_bf16(va[r][k][2] * ra, va[r][k][3] * ra); *(u32x2*)(YN + (size_t)row * D + 256 * k + 4 * lane) = w; }
                { u32x2 w; w[0] = cvt_pk_bf16(vb[r][0] * rb, vb[r][1] * rb); w[1] = cvt_pk_bf16(vb[r][2] * rb, vb[r][3] * rb); *(u32x2*)(YN + (size_t)row * D + 768 + 4 * lane) = w; } } }
        }
    }
    SEAM(6);

    if (IN(7)) {
        MK_PTRS;
        { SchedWK S{G, bx, (const char*)KVC, (const char*)Wcqs}; EpiStore E{WKT, D, nullptr, nullptr, false}; pg8::gemm_phase<EpiStore, SchedWK, true>(lds, 2 * D, D, 4, S, E); }
        { SchedVW S{G, (bx + G / 2) % G, (const char*)KVC, (const char*)Wco}; EpiStore E{VWT, D, nullptr, nullptr, false}; pg8::gemm_phase<EpiStore, SchedVW, true>(lds, D, 2 * D, 4, S, E); }
        SchedStd S; S.o.init(M, D, G, bx); S.A = (const char*)YN; S.B = (const char*)Wout; S.a_tile = (size_t)256 * D * 2; S.b_tile = (size_t)256 * D * 2; S.b_batch = 0; S.ocol_mul = 256;
        EpiRes<false> E{XB, SS2, 1.0f, nullptr}; pg8::gemm_phase<EpiRes<false>, SchedStd, true>(lds, D, D, D / 64, S, E);
    }
    SEAM(7);

    if (IN(8)) {
        MK_PTRS;
        SchedStd S; S.o.init(M, D, G, bx); S.A = (const char*)XB; S.B = (const char*)WKT; S.a_tile = (size_t)256 * D * 2; S.b_tile = (size_t)256 * D * 2; S.b_batch = (size_t)D * D * 2; S.ocol_mul = 256;
        EpiSoftmax E{PB, SS2}; pg8::gemm_phase<EpiSoftmax, SchedStd, true>(lds, D, D, D / 64, S, E);
    }
    SEAM(8);

    if (IN(9)) {
        MK_PTRS;
        SchedStd S; S.o.init(M, D, G, bx); S.A = (const char*)PB; S.B = (const char*)VWT; S.a_tile = (size_t)256 * D * 2; S.b_tile = (size_t)256 * D * 2; S.b_batch = (size_t)D * D * 2; S.ocol_mul = 256;
        EpiRes<F8_2G> E{XB, SS3, 1.0f, X8}; pg8::gemm_phase<EpiRes<F8_2G>, SchedStd, true>(lds, D, D, D / 64, S, E);
    }
    SEAM(9);

    if (IN(10)) {
        MK_PTRS;
        STAGGER();
        constexpr int EB = F8_2G ? 1 : 2;
        SchedStd S; S.o.init(M, 2 * DFF, G, bx); S.A = F8_2G ? (const char*)X8 : (const char*)XB; S.B = (const char*)Wgu2; S.a_tile = (size_t)256 * D * EB; S.b_tile = (size_t)256 * D * EB; S.b_batch = 0; S.ocol_mul = 128;
        EpiGU<F8_2G, F8_2D, false> E{HB, SS3, nullptr, nullptr}; pg8::gemm_phase<EpiGU<F8_2G, F8_2D, false>, SchedStd, true, F8_2G ? 1 : 0>(lds, D * EB / 2, D * EB / 2, D * EB / 128, S, E);
    }
    SEAM(10);

    if (IN(11)) {
        MK_PTRS;
        constexpr int EB = F8_2D ? 1 : 2;
        SchedStd S; S.o.init(M, D, G, bx); S.A = (const char*)HB; S.B = (const char*)Wd2; S.a_tile = (size_t)256 * DFF * EB; S.b_tile = (size_t)256 * DFF * EB; S.b_batch = 0; S.ocol_mul = 256;
        EpiRes<false> E{XB, SS4, F8_2D ? 0.5f / (F8_H * F8_WD) : 0.5f, nullptr}; pg8::gemm_phase<EpiRes<false>, SchedStd, true, F8_2D>(lds, DFF * EB / 2, DFF * EB / 2, DFF * EB / 128, S, E);
    }
    SEAM(11);

    if (IN(12)) {
        MK_PTRS;
        const float* gf = args.in[19];
        for (int row0 = gw; row0 < M; row0 += 4 * NGW) {
            u32x2 w[4][4]; float rs[4]; const f32x4* gr = (const f32x4*)gf + lane;
#pragma unroll
            for (int r = 0; r < 4; ++r) { const int row = (row0 + r * NGW) < M ? (row0 + r * NGW) : row0; const u32x2* xr = (const u32x2*)(XB + (size_t)row * D) + lane;
#pragma unroll
                for (int j = 0; j < 4; ++j) w[r][j] = __builtin_nontemporal_load(xr + 64 * j);
                rs[r] = row_rstd(SS4, row); }
#pragma unroll
            for (int r = 0; r < 4; ++r) { const int row = row0 + r * NGW; if (row < M) { f32x4* orow = (f32x4*)(out + (size_t)row * D) + lane;
#pragma unroll
                for (int j = 0; j < 4; ++j) { f32x4 v; v[0] = __builtin_bit_cast(float, w[r][j][0] << 16); v[1] = __builtin_bit_cast(float, w[r][j][0] & 0xffff0000u); v[2] = __builtin_bit_cast(float, w[r][j][1] << 16); v[3] = __builtin_bit_cast(float, w[r][j][1] & 0xffff0000u);
                    __builtin_nontemporal_store(v * rs[r] * gr[64 * j], orow + 64 * j); } } }
        }
    }
#undef IN
#undef SEAM
}
}


#if MK_DEBUG
namespace dbg {
__global__ void __launch_bounds__(256) cmp_f32(const float* a, const float* r, size_t n, float* acc) {
    float num = 0.f, den = 0.f;
    for (size_t i = (size_t)blockIdx.x * 256 + threadIdx.x; i < n; i += (size_t)gridDim.x * 256) { const float d = a[i] - r[i]; num += d * d; den += r[i] * r[i]; }
    for (int o = 32; o > 0; o >>= 1) { num += __shfl_xor(num, o); den += __shfl_xor(den, o); }
    if ((threadIdx.x & 63) == 0) { atomicAdd(acc, num); atomicAdd(acc + 1, den); }
}
__global__ void __launch_bounds__(256) cmp_bf16(const unsigned short* a, int lda, const float* colscale, const float* r, int ldr, int rows, int cols, float* acc) {
    float num = 0.f, den = 0.f; const size_t n = (size_t)rows * cols;
    for (size_t i = (size_t)blockIdx.x * 256 + threadIdx.x; i < n; i += (size_t)gridDim.x * 256) { const size_t row = i / cols; const int c = (int)(i % cols);
        const float av = __builtin_bit_cast(float, (unsigned)a[row * lda + c] << 16) * (colscale ? colscale[c] : 1.0f); const float rv = r[row * ldr + c]; const float d = av - rv; num += d * d; den += rv * rv; }
    for (int o = 32; o > 0; o >>= 1) { num += __shfl_xor(num, o); den += __shfl_xor(den, o); }
    if ((threadIdx.x & 63) == 0) { atomicAdd(acc, num); atomicAdd(acc + 1, den); }
}
__global__ void __launch_bounds__(256) cmp_p(const unsigned short* a, const float* r, float* acc) {
    float num = 0.f, den = 0.f; const size_t n = (size_t)4096 * 1024;
    for (size_t i = (size_t)blockIdx.x * 256 + threadIdx.x; i < n; i += (size_t)gridDim.x * 256) { const size_t row = i / 1024; const int c = (int)(i % 1024);
        const float av = __builtin_bit_cast(float, (unsigned)a[i] << 16); const float rv = r[(size_t)(c >> 8) * 4096 * 256 + row * 256 + (c & 255)]; const float d = av - rv; num += d * d; den += rv * rv; }
    for (int o = 32; o > 0; o >>= 1) { num += __shfl_xor(num, o); den += __shfl_xor(den, o); }
    if ((threadIdx.x & 63) == 0) { atomicAdd(acc, num); atomicAdd(acc + 1, den); }
}
__global__ void build_scales(float* qkvs, float* gcat, const float* goa, const float* gob) {
    const int i = blockIdx.x * 256 + threadIdx.x;
    if (i < 3072) qkvs[i] = ((i < 768) || (i >= 2304 && i < 2560)) ? 8.0f : 1.0f;
    if (i < 1024) gcat[i] = i < 768 ? goa[i] : gob[i - 768];
}
constexpr int NST = 8;
__global__ void __launch_bounds__(256) finalize(float* out, size_t n, const float* acc, int report) {
    const float tol[NST] = {0.03f, 0.03f, 1e9f  , 0.08f, 0.03f, 0.05f, 0.03f, 0.03f};
    float E = 0.f;
    if (report > 0) { const float e = sqrtf(acc[2 * (report - 1)] / acc[2 * (report - 1) + 1]); E = (e == e) ? fminf(e, 3.0f) : 3.0f; }
    else { for (int k = NST - 1; k >= 0; --k) { const float e = sqrtf(acc[2 * k] / acc[2 * k + 1]); if (!(e <= tol[k])) E = 0.1f * (k + 1); } }
    for (size_t i = (size_t)blockIdx.x * 256 + threadIdx.x; i < n; i += (size_t)gridDim.x * 256) out[i] *= (1.0f + E);
}
}
#endif

static void mk_launch(const mk::Args& a0, int lo, int hi, int grid, hipStream_t st) {
    mk::Args a = a0; a.ph_lo = lo; a.ph_hi = hi;
    hipLaunchKernelGGL(mk::mk_fwd, dim3(grid), dim3(mk::NWAVES * 64), mk::LDS_BYTES, st, a);
    const hipError_t le = hipPeekAtLastError();
    if (le != hipSuccess) fprintf(stderr, "kernel_launch: launch of phases [%d,%d) failed: %s\n", lo, hi, hipGetErrorName(le));
}

extern "C" void kernel_launch(void* const* d_in, const int* in_sizes, int n_in, void* d_out, int out_size, void* d_ws, size_t ws_size, hipStream_t stream) {
    static int grid = 0;
    if (grid == 0) {
        if (n_in != 20 || out_size != 8 * 4096 * 1024) { fprintf(stderr, "kernel_launch: unexpected shapes (n_in %d out %d)\n", n_in, out_size); grid = -1; return; }
        int dev = 0, cus = 0, per_cu = 0;
        if (hipGetDevice(&dev) != hipSuccess || hipDeviceGetAttribute(&cus, hipDeviceAttributeMultiprocessorCount, dev) != hipSuccess) { grid = -1; return; }
        if (hipFuncSetAttribute((const void*)mk::mk_fwd, hipFuncAttributeMaxDynamicSharedMemorySize, mk::LDS_BYTES) != hipSuccess) { fprintf(stderr, "kernel_launch: hipFuncSetAttribute failed\n"); grid = -1; return; }
        if (hipOccupancyMaxActiveBlocksPerMultiprocessor(&per_cu, (const void*)mk::mk_fwd, mk::NWAVES * 64, mk::LDS_BYTES) != hipSuccess || per_cu < 1) fprintf(stderr, "kernel_launch: occupancy query reports %d workgroups per CU\n", per_cu);
        (void)hipGetLastError();
        grid = cus;
    }
    if (grid < 0) return;
    unsigned char* ws = (unsigned char*)d_ws;
#if MK_DEBUG
    const size_t ref_off = (mk::WS_END + 4095) / 4096 * 4096;
    size_t off = ref_off + (size_t)290 * 1024 * 1024;
    auto take = [&](size_t bytes) { unsigned char* p = ws + off; off += (bytes + 255) / 256 * 256; return p; };
    float* sx1 = (float*)take((size_t)4096 * 1024 * 4); float* sx2 = (float*)take((size_t)4096 * 1024 * 4); float* sx3 = (float*)take((size_t)4096 * 1024 * 4);
    float* mkout = (float*)take((size_t)4096 * 1024 * 4); float* qkvs = (float*)take(3072 * 4); float* gcat = (float*)take(1024 * 4); float* acc = (float*)take(256);
    if (off > ws_size) { fprintf(stderr, "kernel_launch: debug build needs %zu bytes of workspace, got %zu\n", off, ws_size); return; }
    ref::Snap snap{sx1, sx2, sx3};
    ref::forward(d_in, (float*)d_out, ws + ref_off, stream, &snap);
    (void)hipMemsetAsync(ws + mk::WS_CTL, 0, mk::CTL_BYTES, stream);
    (void)hipMemsetAsync(acc, 0, 256, stream);
    dbg::build_scales<<<12, 256, 0, stream>>>(qkvs, gcat, (const float*)d_in[8], (const float*)d_in[9]);
    mk::Args a{};
    for (int i = 0; i < 20; ++i) a.in[i] = (const float*)d_in[i];
    a.in[0] = (const float*)d_in[0] + (size_t)7 * 4096 * 1024; a.in[1] = (const float*)d_in[1] + (size_t)7 * 256 * 1024;
    a.out = mkout; a.ws = ws;
    const ref::Bufs& rb = ref::g_bufs;
    for (int ph = 0; ph < mk::NPH; ++ph) {
        mk_launch(a, ph, ph + 1, grid, stream);
        if (ph == 5) dbg::cmp_bf16<<<512, 256, 0, stream>>>((const unsigned short*)(ws + mk::WS_KVC), 2048, nullptr, rb.kvc, 2048, 256, 2048, acc + 0);
        if (ph == 2) dbg::cmp_bf16<<<512, 256, 0, stream>>>((const unsigned short*)(ws + mk::WS_XB), 1024, nullptr, sx1, 1024, 4096, 1024, acc + 2);
        if (ph == 3) dbg::cmp_bf16<<<512, 256, 0, stream>>>((const unsigned short*)(ws + mk::WS_R1), 3072, qkvs, rb.proj, 3072, 4096, 3072, acc + 4);
        if (ph == 6) dbg::cmp_bf16<<<512, 256, 0, stream>>>((const unsigned short*)(ws + mk::WS_R1), 1024, gcat, rb.yn, 1024, 4096, 1024, acc + 6);
        if (ph == 7) dbg::cmp_bf16<<<512, 256, 0, stream>>>((const unsigned short*)(ws + mk::WS_XB), 1024, nullptr, sx2, 1024, 4096, 1024, acc + 8);
        if (ph == 8) dbg::cmp_p<<<512, 256, 0, stream>>>((const unsigned short*)(ws + mk::WS_R1), rb.sc, acc + 10);
        if (ph == 9) dbg::cmp_bf16<<<512, 256, 0, stream>>>((const unsigned short*)(ws + mk::WS_XB), 1024, nullptr, sx3, 1024, 4096, 1024, acc + 12);
        if (ph == 12) dbg::cmp_f32<<<512, 256, 0, stream>>>(mkout, (const float*)d_out + (size_t)7 * 4096 * 1024, (size_t)4096 * 1024, acc + 14);
    }
    dbg::finalize<<<1024, 256, 0, stream>>>((float*)d_out, (size_t)8 * 4096 * 1024, acc, MK_REPORT);
#else
    if (ws_size < mk::WS_END) { fprintf(stderr, "kernel_launch: needs %zu bytes of workspace, got %zu\n", (size_t)mk::WS_END, ws_size); return; }
    if (hipMemsetAsync(ws + mk::WS_CTL, 0, mk::CTL_BYTES, stream) != hipSuccess) return;
    mk::Args a{};
    for (int i = 0; i < 20; ++i) a.in[i] = (const float*)d_in[i];
    a.out = (float*)d_out; a.ws = ws;
#if MK_N_LAUNCHES == 1
    mk_launch(a, 0, mk::NPH, grid, stream);
#else
    for (int ph = 0; ph < mk::NPH; ++ph) {
        for (int r = 0; r < MK_REPEAT_N; ++r) if (ph == MK_REPEAT) { mk::Args a2 = a; a2.flags = MK_REPEAT_FLAGS; mk_launch(a2, ph, ph + 1, grid, stream); }
        mk_launch(a, ph, ph + 1, grid, stream); }
#endif
#endif
}
```

```cpp
#include <hip/hip_runtime.h>
#include <cstdio>
#include <cstdint>
#include <cmath>
#define MK_REPEAT -1
#define MK_REPEAT_N 1
#define MK_REPEAT_FLAGS 0
#define MK_STAGGER_TICKS 0
#define MK_NT_PART false
#define MK_TIMING 0
#define MK_TQ 0.02f
#define MK_PROBE_SAME 0
#define MK_FP8_FFN1 6
#define MK_FP8_FFN2 3
#define MK_DEBUG 0
#define MK_REPORT 0
#define MK_N_LAUNCHES 1
#define MK_NBAT 8

namespace pg8 {
#define PG8_LAS __attribute__((address_space(3)))
typedef unsigned short bf16_t;
typedef short bf16x8 __attribute__((ext_vector_type(8)));
typedef float f32x4 __attribute__((ext_vector_type(4)));
typedef float f32x2 __attribute__((ext_vector_type(2)));
typedef unsigned u32x4 __attribute__((ext_vector_type(4)));
typedef unsigned u32x2 __attribute__((ext_vector_type(2)));
typedef int i32x4 __attribute__((ext_vector_type(4)));
typedef int i32x8 __attribute__((ext_vector_type(8)));
constexpr int BM = 256, BK = 64, HALF = 128, HTB = HALF * BK * 2  , STAGE_BYTES = 8 * HTB, NXCD = 8, WGM = 8;

__host__ __device__ __forceinline__ int lds_byte(int r, int c) { const int st = (r >> 4) * 2 + (c >> 5), rr = r & 15, cc = c & 31, ob = rr * 64 + cc * 2; return st * 1024 + (ob ^ (((ob >> 9) & 1) << 5)); }
__host__ __device__ __forceinline__ void stage_rc(int b, int& R, int& C) { const int st = b / 1024, sb = b % 1024, swz = sb ^ (((sb >> 9) & 1) << 5); R = (st >> 1) * 16 + swz / 64; C = (st & 1) * 32 + (swz % 64) / 2; }
__host__ __device__ __forceinline__ int perm32(int rho) { const int n = rho >> 4, i = rho & 15; return 8 * (i >> 2) + 4 * n + (i & 3); }

struct Unit { const char* a; const char* b; int orow, ocol, aux; };

struct Order {
    int nM, nN, nwg, G, c;
    __device__ __forceinline__ void init(int M, int N, int G_, int c_) { nM = M / BM; nN = N / BM; nwg = nM * nN; G = G_; c = c_; }
    __device__ __forceinline__ bool tile(int i, int& pm, int& pn) const {
        const long L = (long)i * G + c; if (L >= nwg) return false;
        int wgid = (int)L; { const int q = nwg / NXCD, r = nwg % NXCD, xcd = wgid % NXCD, off = wgid / NXCD; wgid = (xcd < r ? xcd * (q + 1) : r * (q + 1) + (xcd - r) * q) + off; }
        const int nig = WGM * nN, gid = wgid / nig, fm = gid * WGM, gsz = (nM - fm) < WGM ? (nM - fm) : WGM;
        pm = fm + ((wgid % nig) % gsz); pn = (wgid % nig) / gsz; return true;
    }
};

__device__ __forceinline__ unsigned cvt_pk_bf16(float lo, float hi) { unsigned r; asm volatile("v_cvt_pk_bf16_f32 %0, %1, %2" : "=v"(r) : "v"(lo), "v"(hi)); return r; }

template <class Epi, class Sched, bool ALIGN_EPI, int MODE = 0>
__device__ __forceinline__ void gemm_phase(PG8_LAS unsigned char* lds, const int lda, const int ldb, const int nt, const Sched& S, const Epi& E) {
    int tid_ = threadIdx.x; asm volatile("" : "+v"(tid_));
    const int tid = tid_, wid = __builtin_amdgcn_readfirstlane(tid >> 6), lane = tid & 63, wr = wid >> 2, wc = wid & 3, fr = lane & 15, fq = lane >> 4;
    unsigned voffA[2], voffB[2];
#pragma unroll
    for (int i = 0; i < 2; ++i) { int R, C; stage_rc(tid * 16 + i * 8192, R, C); const int Rb = Epi::PERM ? ((R & ~31) + perm32(R & 31)) : R;
        voffA[i] = (unsigned)(R * lda + C) * 2u; voffB[i] = (unsigned)(Rb * ldb + C) * 2u; }
    const size_t kstep = (size_t)(BK * 2);
    const size_t hstepA = (size_t)HALF * lda * 2, hstepB = (size_t)HALF * ldb * 2;
    const unsigned ldsw = (unsigned)wid * 1024u;
    const int aoff = lds_byte(wr * 64 + fr, fq * 8), boff = lds_byte(wc * 32 + fr, fq * 8);
#define PG8_SA(b, h) (((b) * 2 + (h)) * HTB)
#define PG8_SB(b, h) ((4 + (b) * 2 + (h)) * HTB)
#define PG8_STAGE(bufoff, gbase, voff) do { _Pragma("unroll") for (int _i = 0; _i < 2; ++_i) \
        __builtin_amdgcn_global_load_lds((const unsigned*)((const char*)(gbase) + (voff)[_i]), (PG8_LAS unsigned*)(lds + (bufoff) + ldsw + _i * 8192), 16, 0, 0); } while (0)
#define PG8_LDA(dst, b, h) do { _Pragma("unroll") for (int m = 0; m < 4; ++m) _Pragma("unroll") for (int k = 0; k < 2; ++k) dst[m][k] = *(const PG8_LAS bf16x8*)(lds + PG8_SA(b, h) + aoff + m * 2048 + k * 1024); } while (0)
#define PG8_LDB(dst, b, h) do { _Pragma("unroll") for (int n = 0; n < 2; ++n) _Pragma("unroll") for (int k = 0; k < 2; ++k) dst[n][k] = *(const PG8_LAS bf16x8*)(lds + PG8_SB(b, h) + boff + n * 2048 + k * 1024); } while (0)
#define PG8_MMA(ai, bj, At, Bt) do { __builtin_amdgcn_s_setprio(1); _Pragma("unroll") for (int m = 0; m < 4; ++m) _Pragma("unroll") for (int n = 0; n < 2; ++n) { \
        if constexpr (FP8) { const i32x8 bb_ = __builtin_shufflevector(__builtin_bit_cast(i32x4, Bt[n][0]), __builtin_bit_cast(i32x4, Bt[n][1]), 0, 1, 2, 3, 4, 5, 6, 7); \
            const i32x8 aa_ = __builtin_shufflevector(__builtin_bit_cast(i32x4, At[m][0]), __builtin_bit_cast(i32x4, At[m][1]), 0, 1, 2, 3, 4, 5, 6, 7); \
            asm volatile("v_mfma_scale_f32_16x16x128_f8f6f4 %0, %1, %2, %0, %3, %3 op_sel_hi:[0,0,0]" : "+v"(acc[ai][bj][m][n]) : "v"(bb_), "v"(aa_), "v"(sc1)); } \
        else if constexpr (I8) { _Pragma("unroll") for (int k = 0; k < 2; ++k) acc[ai][bj][m][n] = __builtin_bit_cast(f32x4, __builtin_amdgcn_mfma_i32_16x16x64_i8(__builtin_bit_cast(i32x4, Bt[n][k]), __builtin_bit_cast(i32x4, At[m][k]), __builtin_bit_cast(i32x4, acc[ai][bj][m][n]), 0, 0, 0)); } \
        else { _Pragma("unroll") for (int k = 0; k < 2; ++k) acc[ai][bj][m][n] = __builtin_amdgcn_mfma_f32_16x16x32_bf16(Bt[n][k], At[m][k], acc[ai][bj][m][n], 0, 0, 0); } } \
        __builtin_amdgcn_s_setprio(0); } while (0)
#define PG8_WAIT_V(n) asm volatile("s_waitcnt vmcnt(" #n ")" ::: "memory")
#define PG8_WAIT_L(n) asm volatile("s_waitcnt lgkmcnt(" #n ")" ::: "memory")
#define PG8_BAR __builtin_amdgcn_s_barrier()
#define PG8_SCHED __builtin_amdgcn_sched_barrier(0)
    constexpr bool FP8 = MODE == 1, I8 = MODE == 2;
    int sc1 = 0x7F7F7F7F; asm volatile("" : "+v"(sc1)); (void)sc1;
    Unit cur, nxt; int ui = 0;
    if (!S.next(0, cur)) return;
    f32x4 acc[2][2][4][2];
#pragma unroll
    for (int a = 0; a < 2; ++a)
#pragma unroll
        for (int b = 0; b < 2; ++b)
#pragma unroll
            for (int m = 0; m < 4; ++m)
#pragma unroll
                for (int n = 0; n < 2; ++n) acc[a][b][m][n] = (f32x4){0.f, 0.f, 0.f, 0.f};
    bf16x8 At[4][2], B0[2][2], B1[2][2];
    const char* cA = cur.a; const char* cB = cur.b;
    PG8_STAGE(PG8_SB(0, 0), cB, voffB); PG8_STAGE(PG8_SB(0, 1), cB + hstepB, voffB); PG8_STAGE(PG8_SA(0, 0), cA, voffA); PG8_STAGE(PG8_SA(0, 1), cA + hstepA, voffA);
    if (wr == 1) PG8_BAR;
    PG8_WAIT_V(2); PG8_BAR;
    PG8_STAGE(PG8_SB(1, 0), cB + kstep, voffB); PG8_STAGE(PG8_SA(1, 0), cA + kstep, voffA); PG8_STAGE(PG8_SB(1, 1), cB + hstepB + kstep, voffB);
    PG8_WAIT_V(6); PG8_BAR;
    for (;;) {
        const bool has_next = S.next(ui + 1, nxt);
        const char* nA = has_next ? nxt.a : cA; const char* nB = has_next ? nxt.b : cB;
#pragma unroll 1
        for (int t = 0; t < nt; t += 2) {
            const bool last = (t == nt - 2);
            const char* a1 = cA + (size_t)(t + 1) * kstep;
            const char* a2 = last ? nA : cA + (size_t)(t + 2) * kstep; const char* b2 = last ? nB : cB + (size_t)(t + 2) * kstep;
            const char* a3 = a2 + kstep; const char* b3 = b2 + kstep;
            PG8_LDB(B0, 0, 0); PG8_LDB(B1, 0, 1); PG8_SCHED; PG8_LDA(At, 0, 0); PG8_STAGE(PG8_SA(1, 1), a1 + hstepA, voffA);
            PG8_WAIT_V(8); PG8_WAIT_L(0); PG8_BAR; PG8_MMA(0, 0, At, B0); PG8_MMA(0, 1, At, B1); PG8_BAR; PG8_SCHED;
            PG8_LDA(At, 0, 1); PG8_STAGE(PG8_SB(0, 0), b2, voffB); PG8_STAGE(PG8_SB(0, 1), b2 + hstepB, voffB); PG8_STAGE(PG8_SA(0, 0), a2, voffA);
            PG8_WAIT_V(8); PG8_WAIT_L(0); PG8_BAR; PG8_MMA(1, 0, At, B0); PG8_MMA(1, 1, At, B1); PG8_BAR; PG8_SCHED;
            PG8_LDB(B0, 1, 0); PG8_LDB(B1, 1, 1); PG8_SCHED; PG8_LDA(At, 1, 0); PG8_STAGE(PG8_SA(0, 1), a2 + hstepA, voffA);
            PG8_WAIT_V(8); PG8_WAIT_L(0); PG8_BAR; PG8_MMA(0, 0, At, B0); PG8_MMA(0, 1, At, B1); PG8_BAR; PG8_SCHED;
            PG8_LDA(At, 1, 1); PG8_STAGE(PG8_SB(1, 0), b3, voffB); PG8_STAGE(PG8_SB(1, 1), b3 + hstepB, voffB); PG8_STAGE(PG8_SA(1, 0), a3, voffA);
            PG8_WAIT_V(8); PG8_WAIT_L(0); PG8_BAR; PG8_MMA(1, 0, At, B0); PG8_MMA(1, 1, At, B1); PG8_BAR; PG8_SCHED;
        }
        if constexpr (ALIGN_EPI) { if (wr == 0) PG8_BAR; }
        if constexpr (FP8) asm volatile("s_nop 15\n\ts_nop 7" ::: "memory");
        E(acc, cur, wr, wc, fr, fq, lds, wid, lane);
        if (!has_next) break;
#pragma unroll
        for (int a = 0; a < 2; ++a)
#pragma unroll
            for (int b = 0; b < 2; ++b)
#pragma unroll
                for (int m = 0; m < 4; ++m)
#pragma unroll
                    for (int n = 0; n < 2; ++n) acc[a][b][m][n] = (f32x4){0.f, 0.f, 0.f, 0.f};
        cur = nxt; cA = nA; cB = nB; ++ui;
        if constexpr (ALIGN_EPI) { if (wr == 1) PG8_BAR; }
    }
    PG8_WAIT_V(0);
    if constexpr (!ALIGN_EPI) { if (wr == 0) PG8_BAR; }
    PG8_BAR;
#undef PG8_SA
#undef PG8_SB
#undef PG8_STAGE
#undef PG8_LDA
#undef PG8_LDB
#undef PG8_MMA
#undef PG8_WAIT_V
#undef PG8_WAIT_L
#undef PG8_BAR
#undef PG8_SCHED
}
}

namespace att {
#define ATT_LAS __attribute__((address_space(3)))
typedef short bf16x8 __attribute__((ext_vector_type(8)));
typedef short v4i16 __attribute__((ext_vector_type(4)));
typedef float f32x16 __attribute__((ext_vector_type(16)));
typedef float f32x4 __attribute__((ext_vector_type(4)));
typedef unsigned u32x4 __attribute__((ext_vector_type(4)));
typedef unsigned u32x2 __attribute__((ext_vector_type(2)));
constexpr float LOG2E = 1.4426950408889634f;
constexpr int TABA_N = 192, TABB_N = 1600;

__device__ __forceinline__ int rel_bucket(int n) {
    if (n < 16) return n < 0 ? 0 : n;
    int b = 16;
    b += (n >= 22); b += (n >= 30); b += (n >= 40); b += (n >= 54); b += (n >= 73); b += (n >= 99); b += (n >= 134); b += (n >= 182);
    b += (n >= 246); b += (n >= 332); b += (n >= 450); b += (n >= 609); b += (n >= 825); b += (n >= 1117); b += (n >= 1513);
    return b;
}
__device__ __forceinline__ unsigned pk_bf16(float lo, float hi) { unsigned r; asm volatile("v_cvt_pk_bf16_f32 %0, %1, %2" : "=v"(r) : "v"(lo), "v"(hi)); return r; }
__device__ __forceinline__ float bf16_round(float x) { unsigned u = __builtin_bit_cast(unsigned, x); u = (u + 0x7fffu + ((u >> 16) & 1u)) & 0xffff0000u; return __builtin_bit_cast(float, u); }

__device__ __forceinline__ void glds16(const void* gsrc, unsigned lds_dst) { unsigned keep;
    asm volatile("s_mov_b32 %0, m0\n\ts_mov_b32 m0, %2\n\ts_nop 0\n\tglobal_load_lds_dwordx4 %1, off\n\ts_mov_b32 m0, %0" : "=&s"(keep) : "v"(gsrc), "s"(lds_dst) : "memory"); }
__device__ __forceinline__ void dma_rows8(const char* krow0  , const int voff, const int row  ,
                                          ATT_LAS char* kdst  , ATT_LAS char* vdst, const int lane) {
    const int pc = lane & 7;
    glds16(krow0 + 16 * (pc ^ ((row >> 1) & 7)), (unsigned)__builtin_amdgcn_readfirstlane((int)(unsigned)(uintptr_t)kdst));
    glds16(krow0 + voff + 16 * (pc ^ (((row >> 1) & 1) << 2)), (unsigned)__builtin_amdgcn_readfirstlane((int)(unsigned)(uintptr_t)vdst));
}

__device__ __forceinline__ void attn_group(const bf16x8 (&qf)[4], f32x16 (&o)[2], float& m, float& l, const ATT_LAS char* kg, const ATT_LAS char* vg, const ATT_LAS float* tp, const int lane) {
    const int q = lane & 31, h = lane >> 5;
    const ATT_LAS char* kr0 = kg + q * 128; const int kswz = (q >> 1) & 7;
    typedef float f32x2_ __attribute__((ext_vector_type(2)));
    f32x2_ t0, t1, t2, t3, t4, t5, t6, t7;
    { const unsigned ta = (unsigned)(uintptr_t)(tp - 27);
      asm volatile("ds_read2_b32 %0, %8 offset0:27 offset1:26\n\tds_read2_b32 %1, %8 offset0:25 offset1:24\n\tds_read2_b32 %2, %8 offset0:19 offset1:18\n\tds_read2_b32 %3, %8 offset0:17 offset1:16\n\t"
                   "ds_read2_b32 %4, %8 offset0:11 offset1:10\n\tds_read2_b32 %5, %8 offset0:9 offset1:8\n\tds_read2_b32 %6, %8 offset0:3 offset1:2\n\tds_read2_b32 %7, %8 offset0:1 offset1:0"
                   : "=&v"(t0), "=&v"(t1), "=&v"(t2), "=&v"(t3), "=&v"(t4), "=&v"(t5), "=&v"(t6), "=&v"(t7) : "v"(ta) : "memory"); }
    const int q4 = (lane & 15) >> 2, p4 = lane & 3, g1 = (lane >> 4) & 1, vsw = (q4 >> 1) & 1;
    const unsigned va0_ = (unsigned)(uintptr_t)(vg + (4 * h + q4) * 128 + 32 * g1 + 8 * p4 + 64 * vsw), va1_ = (unsigned)(uintptr_t)(vg + (4 * h + q4) * 128 + 32 * g1 + 8 * p4 + 64 * (1 ^ vsw));
    v4i16 a[2][4];
    asm volatile("ds_read_b64_tr_b16 %0, %8\n\tds_read_b64_tr_b16 %1, %8 offset:1024\n\tds_read_b64_tr_b16 %2, %8 offset:2048\n\tds_read_b64_tr_b16 %3, %8 offset:3072\n\t"
                 "ds_read_b64_tr_b16 %4, %9\n\tds_read_b64_tr_b16 %5, %9 offset:1024\n\tds_read_b64_tr_b16 %6, %9 offset:2048\n\tds_read_b64_tr_b16 %7, %9 offset:3072"
                 : "=&v"(a[0][0]), "=&v"(a[0][1]), "=&v"(a[0][2]), "=&v"(a[0][3]), "=&v"(a[1][0]), "=&v"(a[1][1]), "=&v"(a[1][2]), "=&v"(a[1][3]) : "v"(va0_), "v"(va1_) : "memory");
    f32x16 s = f32x16{};
#pragma unroll
    for (int d0 = 0; d0 < 4; ++d0) { const bf16x8 kf = *(const ATT_LAS bf16x8*)(kr0 + 16 * ((2 * d0 + h) ^ kswz)); s = __builtin_amdgcn_mfma_f32_32x32x16_bf16(kf, qf[d0], s, 0, 0, 0); }
    asm volatile("s_waitcnt lgkmcnt(0)" : "+v"(t0), "+v"(t1), "+v"(t2), "+v"(t3), "+v"(t4), "+v"(t5), "+v"(t6), "+v"(t7), "+v"(a[0][0]), "+v"(a[0][1]), "+v"(a[0][2]), "+v"(a[0][3]), "+v"(a[1][0]), "+v"(a[1][1]), "+v"(a[1][2]), "+v"(a[1][3]) :: "memory");
    float mx = -INFINITY;
    { const float tb_[16] = {t0[0], t0[1], t1[0], t1[1], t2[0], t2[1], t3[0], t3[1], t4[0], t4[1], t5[0], t5[1], t6[0], t6[1], t7[0], t7[1]};
#pragma unroll
      for (int r = 0; r < 16; ++r) s[r] = fmaf(s[r], LOG2E, tb_[r]); }
#pragma unroll
    for (int r = 0; r < 16; r += 2) mx = fmaxf(mx, fmaxf(s[r], s[r + 1]));
    mx = fmaxf(mx, __shfl_xor(mx, 32));
    if (__any(mx > m)) {
        const float mnew = fmaxf(m, mx), alpha = __builtin_amdgcn_exp2f(m - mnew);
        l *= alpha; m = mnew;
#pragma unroll
        for (int r = 0; r < 16; ++r) { o[0][r] *= alpha; o[1][r] *= alpha; }
    }
    float ps = 0.f;
#pragma unroll
    for (int r = 0; r < 16; ++r) { s[r] = __builtin_amdgcn_exp2f(s[r] - m); ps += s[r]; }
    l += ps;
    u32x4 pw0, pw1;
    pw0[0] = pk_bf16(s[0], s[1]); pw0[1] = pk_bf16(s[2], s[3]); pw0[2] = pk_bf16(s[4], s[5]); pw0[3] = pk_bf16(s[6], s[7]);
    pw1[0] = pk_bf16(s[8], s[9]); pw1[1] = pk_bf16(s[10], s[11]); pw1[2] = pk_bf16(s[12], s[13]); pw1[3] = pk_bf16(s[14], s[15]);
    const bf16x8 pb0 = __builtin_bit_cast(bf16x8, pw0), pb1 = __builtin_bit_cast(bf16x8, pw1);
#pragma unroll
    for (int dh = 0; dh < 2; ++dh) {
        const bf16x8 va0 = (bf16x8){a[dh][0][0], a[dh][0][1], a[dh][0][2], a[dh][0][3], a[dh][1][0], a[dh][1][1], a[dh][1][2], a[dh][1][3]};
        const bf16x8 va1 = (bf16x8){a[dh][2][0], a[dh][2][1], a[dh][2][2], a[dh][2][3], a[dh][3][0], a[dh][3][1], a[dh][3][2], a[dh][3][3]};
        o[dh] = __builtin_amdgcn_mfma_f32_32x32x16_bf16(va0, pb0, o[dh], 0, 0, 0);
        o[dh] = __builtin_amdgcn_mfma_f32_32x32x16_bf16(va1, pb1, o[dh], 0, 0, 0);
    }
}

__device__ __forceinline__ void dma_k_rows8(const char* krow, const int row, ATT_LAS char* kdst, const int lane) {
    glds16(krow + 16 * ((lane & 7) ^ ((row >> 1) & 7)), (unsigned)__builtin_amdgcn_readfirstlane((int)(unsigned)(uintptr_t)kdst)); }
__device__ __forceinline__ void dma_v_rows8(const char* vrow, const int row, ATT_LAS char* vdst, const int lane) {
    glds16(vrow + 16 * ((lane & 7) ^ (((row >> 1) & 1) << 2)), (unsigned)__builtin_amdgcn_readfirstlane((int)(unsigned)(uintptr_t)vdst)); }
__device__ __forceinline__ void dil_pass1(const bf16x8 (&qf)[4], const int ng, const ATT_LAS char* kimg0  , const ATT_LAS float* tp0  ,
                                          u32x4 (&pw)[5][2], float& m_out, float& l_out, const int lane) {
    const int q = lane & 31, h = lane >> 5, kswz = (q >> 1) & 7;
    typedef float f32x2_ __attribute__((ext_vector_type(2)));
    f32x16 s[5]; float mx = -INFINITY;
#pragma unroll
    for (int g = 0; g < 5; ++g) if (g < ng) {
        f32x2_ t0, t1, t2, t3, t4, t5, t6, t7;
        { const unsigned ta = (unsigned)(uintptr_t)(tp0 + 32 * g - 27);
          asm volatile("ds_read2_b32 %0, %8 offset0:27 offset1:26\n\tds_read2_b32 %1, %8 offset0:25 offset1:24\n\tds_read2_b32 %2, %8 offset0:19 offset1:18\n\tds_read2_b32 %3, %8 offset0:17 offset1:16\n\t"
                       "ds_read2_b32 %4, %8 offset0:11 offset1:10\n\tds_read2_b32 %5, %8 offset0:9 offset1:8\n\tds_read2_b32 %6, %8 offset0:3 offset1:2\n\tds_read2_b32 %7, %8 offset0:1 offset1:0"
                       : "=&v"(t0), "=&v"(t1), "=&v"(t2), "=&v"(t3), "=&v"(t4), "=&v"(t5), "=&v"(t6), "=&v"(t7) : "v"(ta) : "memory"); }
        const ATT_LAS char* kr0 = kimg0 - g * 4096 + q * 128;
        f32x16 sg = f32x16{};
#pragma unroll
        for (int d0 = 0; d0 < 4; ++d0) { const bf16x8 kf = *(const ATT_LAS bf16x8*)(kr0 + 16 * ((2 * d0 + h) ^ kswz)); sg = __builtin_amdgcn_mfma_f32_32x32x16_bf16(kf, qf[d0], sg, 0, 0, 0); }
        asm volatile("s_waitcnt lgkmcnt(0)" : "+v"(t0), "+v"(t1), "+v"(t2), "+v"(t3), "+v"(t4), "+v"(t5), "+v"(t6), "+v"(t7) :: "memory");
        const float tb_[16] = {t0[0], t0[1], t1[0], t1[1], t2[0], t2[1], t3[0], t3[1], t4[0], t4[1], t5[0], t5[1], t6[0], t6[1], t7[0], t7[1]};
#pragma unroll
        for (int r = 0; r < 16; ++r) sg[r] = fmaf(sg[r], LOG2E, tb_[r]);
#pragma unroll
        for (int r = 0; r < 16; r += 2) mx = fmaxf(mx, fmaxf(sg[r], sg[r + 1]));
        s[g] = sg;
    }
    mx = fmaxf(mx, __shfl_xor(mx, 32));
    float ps = 0.f;
#pragma unroll
    for (int g = 0; g < 5; ++g) if (g < ng) {
        f32x16 p = s[g];
#pragma unroll
        for (int r = 0; r < 16; ++r) { p[r] = __builtin_amdgcn_exp2f(p[r] - mx); ps += p[r]; }
        pw[g][0][0] = pk_bf16(p[0], p[1]); pw[g][0][1] = pk_bf16(p[2], p[3]); pw[g][0][2] = pk_bf16(p[4], p[5]); pw[g][0][3] = pk_bf16(p[6], p[7]);
        pw[g][1][0] = pk_bf16(p[8], p[9]); pw[g][1][1] = pk_bf16(p[10], p[11]); pw[g][1][2] = pk_bf16(p[12], p[13]); pw[g][1][3] = pk_bf16(p[14], p[15]);
    }
    ps += __shfl_xor(ps, 32);
    m_out = mx; l_out = ps;
}
__device__ __forceinline__ void dil_pass2(const int ng, const ATT_LAS char* vimg0  , const u32x4 (&pw)[5][2], f32x16 (&o)[2], const int lane) {
    const int h = lane >> 5, q4 = (lane & 15) >> 2, p4 = lane & 3, g1 = (lane >> 4) & 1, vsw = (q4 >> 1) & 1;
    o[0] = f32x16{}; o[1] = f32x16{};
#pragma unroll
    for (int g = 0; g < 5; ++g) if (g < ng) {
        const ATT_LAS char* vg = vimg0 - g * 4096;
        const unsigned va0_ = (unsigned)(uintptr_t)(vg + (4 * h + q4) * 128 + 32 * g1 + 8 * p4 + 64 * vsw), va1_ = (unsigned)(uintptr_t)(vg + (4 * h + q4) * 128 + 32 * g1 + 8 * p4 + 64 * (1 ^ vsw));
        v4i16 a[2][4];
        asm volatile("ds_read_b64_tr_b16 %0, %8\n\tds_read_b64_tr_b16 %1, %8 offset:1024\n\tds_read_b64_tr_b16 %2, %8 offset:2048\n\tds_read_b64_tr_b16 %3, %8 offset:3072\n\t"
                     "ds_read_b64_tr_b16 %4, %9\n\tds_read_b64_tr_b16 %5, %9 offset:1024\n\tds_read_b64_tr_b16 %6, %9 offset:2048\n\tds_read_b64_tr_b16 %7, %9 offset:3072\n\ts_waitcnt lgkmcnt(0)"
                     : "=&v"(a[0][0]), "=&v"(a[0][1]), "=&v"(a[0][2]), "=&v"(a[0][3]), "=&v"(a[1][0]), "=&v"(a[1][1]), "=&v"(a[1][2]), "=&v"(a[1][3]) : "v"(va0_), "v"(va1_) : "memory");
        const bf16x8 pb0 = __builtin_bit_cast(bf16x8, pw[g][0]), pb1 = __builtin_bit_cast(bf16x8, pw[g][1]);
#pragma unroll
        for (int dh = 0; dh < 2; ++dh) {
            const bf16x8 va0 = (bf16x8){a[dh][0][0], a[dh][0][1], a[dh][0][2], a[dh][0][3], a[dh][1][0], a[dh][1][1], a[dh][1][2], a[dh][1][3]};
            const bf16x8 va1 = (bf16x8){a[dh][2][0], a[dh][2][1], a[dh][2][2], a[dh][2][3], a[dh][3][0], a[dh][3][1], a[dh][3][2], a[dh][3][3]};
            o[dh] = __builtin_amdgcn_mfma_f32_32x32x16_bf16(va0, pb0, o[dh], 0, 0, 0);
            o[dh] = __builtin_amdgcn_mfma_f32_32x32x16_bf16(va1, pb1, o[dh], 0, 0, 0);
        }
    }
}

template <bool NT>
__device__ __forceinline__ void store_o(const f32x16 (&o)[2], const float l, char* orow_q, const int h, const bool valid = true) {
    const float il = 1.0f / l;
#pragma unroll
    for (int dh = 0; dh < 2; ++dh)
#pragma unroll
        for (int jj = 0; jj < 2; ++jj) {
            u32x2 we, wo;
            we[0] = pk_bf16(o[dh][8 * jj] * il, o[dh][8 * jj + 1] * il); we[1] = pk_bf16(o[dh][8 * jj + 2] * il, o[dh][8 * jj + 3] * il);
            wo[0] = pk_bf16(o[dh][8 * jj + 4] * il, o[dh][8 * jj + 5] * il); wo[1] = pk_bf16(o[dh][8 * jj + 6] * il, o[dh][8 * jj + 7] * il);
            const unsigned s0 = h ? we[0] : wo[0], s1 = h ? we[1] : wo[1];
            const unsigned r0 = (unsigned)__shfl_xor((int)s0, 32), r1 = (unsigned)__shfl_xor((int)s1, 32);
            u32x4 w; if (h == 0) { w[0] = we[0]; w[1] = we[1]; w[2] = r0; w[3] = r1; } else { w[0] = r0; w[1] = r1; w[2] = wo[0]; w[3] = wo[1]; }
            u32x4* dst = (u32x4*)(orow_q + (32 * dh + 16 * jj + 8 * h) * 2);
            if (valid) { if (NT) __builtin_nontemporal_store(w, dst); else *dst = w; }
        }
}

template <bool NT>
__device__ __forceinline__ void store_o_staged(const f32x16 (&o)[2], const float l, ATT_LAS char* stg, char* base, const long rstride, const int lane) {
    const int q = lane & 31, h = lane >> 5; const float il = 1.0f / l;
#pragma unroll
    for (int dh = 0; dh < 2; ++dh)
#pragma unroll
        for (int jj = 0; jj < 2; ++jj) {
            u32x2 we, wo;
            we[0] = pk_bf16(o[dh][8 * jj] * il, o[dh][8 * jj + 1] * il); we[1] = pk_bf16(o[dh][8 * jj + 2] * il, o[dh][8 * jj + 3] * il);
            wo[0] = pk_bf16(o[dh][8 * jj + 4] * il, o[dh][8 * jj + 5] * il); wo[1] = pk_bf16(o[dh][8 * jj + 6] * il, o[dh][8 * jj + 7] * il);
            const unsigned s0 = h ? we[0] : wo[0], s1 = h ? we[1] : wo[1];
            const unsigned r0 = (unsigned)__shfl_xor((int)s0, 32), r1 = (unsigned)__shfl_xor((int)s1, 32);
            u32x4 w; if (h == 0) { w[0] = we[0]; w[1] = we[1]; w[2] = r0; w[3] = r1; } else { w[0] = r0; w[1] = r1; w[2] = wo[0]; w[3] = wo[1]; }
            *(ATT_LAS u32x4*)(stg + q * 128 + 16 * ((4 * dh + 2 * jj + h) ^ (q & 7))) = w;
        }
    asm volatile("s_waitcnt lgkmcnt(0)" ::: "memory");
#pragma unroll
    for (int i = 0; i < 4; ++i) { const int r = 8 * i + (lane >> 3), c = lane & 7;
        const u32x4 w = *(const ATT_LAS u32x4*)(stg + r * 128 + 16 * (c ^ (r & 7)));
        u32x4* dst = (u32x4*)(base + (long)r * rstride + 16 * c);
        if (NT) __builtin_nontemporal_store(w, dst); else *dst = w; }
    asm volatile("s_waitcnt lgkmcnt(0)" ::: "memory");
}

__device__ __forceinline__ unsigned moba_select(const char* qbase, const long qs, const float* km, const int qb) {
    const int lane = threadIdx.x & 63, q = lane & 31, h = lane >> 5;
    f32x16 g = f32x16{};
    const float* kmrow = km + (size_t)(q & 15) * 256;
    const bool lo_part = q >= 16;
#pragma unroll
    for (int d0 = 0; d0 < 4; ++d0) {
        const bf16x8 qf = *(const bf16x8*)(qbase + (long)q * qs + (16 * d0 + 8 * h) * 2);
        const f32x4 f0 = *(const f32x4*)(kmrow + 16 * d0 + 8 * h), f1 = *(const f32x4*)(kmrow + 16 * d0 + 8 * h + 4);
        float v[8] = {f0[0], f0[1], f0[2], f0[3], f1[0], f1[1], f1[2], f1[3]};
        u32x4 aw;
#pragma unroll
        for (int j = 0; j < 4; ++j) {
            const float h0 = bf16_round(v[2 * j]), h1 = bf16_round(v[2 * j + 1]);
            const float x0 = lo_part ? (v[2 * j] - h0) : h0, x1 = lo_part ? (v[2 * j + 1] - h1) : h1;
            aw[j] = pk_bf16(x0, x1);
        }
        g = __builtin_amdgcn_mfma_f32_32x32x16_bf16(__builtin_bit_cast(bf16x8, aw), qf, g, 0, 0, 0);
    }
    float gate[8], other[8];
#pragma unroll
    for (int r = 0; r < 8; ++r) { gate[r] = g[r] + g[r + 8]; }
#pragma unroll
    for (int r = 0; r < 8; ++r) { other[r] = __shfl_xor(gate[r], 32); }
    unsigned mymask = 0u;
#pragma unroll
    for (int r = 0; r < 8; ++r) {
        const int n = (r & 3) + 8 * (r >> 2) + 4 * h;
        int rank = 0;
#pragma unroll
        for (int r2 = 0; r2 < 8; ++r2) {
            const int n2 = (r2 & 3) + 8 * (r2 >> 2) + 4 * h, n3 = (r2 & 3) + 8 * (r2 >> 2) + 4 * (1 - h);
            if (r2 != r) rank += (n2 < qb && (gate[r2] > gate[r] || (gate[r2] == gate[r] && n2 < n))) ? 1 : 0;
            rank += (n3 < qb && (other[r2] > gate[r] || (other[r2] == gate[r] && n3 < n))) ? 1 : 0;
        }
        if (n < qb && rank < 3) mymask |= 1u << n;
    }
    return mymask | (unsigned)__shfl_xor((int)mymask, 32);
}
}


namespace mk {
using pg8::bf16_t; using pg8::bf16x8; using pg8::f32x4; using pg8::f32x2; using pg8::u32x4; using pg8::u32x2; using pg8::Unit; using pg8::cvt_pk_bf16;
#define LAS __attribute__((address_space(3)))
constexpr int NBAT = MK_NBAT, SEQ = 4096, D = 1024, DFF = 2816, NMEM = 256, M = NBAT * SEQ, MM = NBAT * NMEM, NQKV = 3072;
constexpr float EPS = 1e-6f, LOG2E = 1.4426950408889634f;
constexpr int NWAVES = 8, NPH = 13;
constexpr bool F8_1G = (MK_FP8_FFN1 & 1) != 0, F8_1D = (MK_FP8_FFN1 & 2) != 0, F8_2G = (MK_FP8_FFN2 & 1) != 0, F8_2D = (MK_FP8_FFN2 & 2) != 0;
constexpr bool I8_1G = (MK_FP8_FFN1 & 4) != 0;
static_assert(!(I8_1G && F8_1G), "one operand type per GEMM");
constexpr float F8_WGU = 64.f, F8_H = 4.f, F8_WD = 128.f;

constexpr size_t al256(size_t x) { return (x + 255) / 256 * 256; }
constexpr size_t WS_CTL = 0, CTL_BYTES = 1u << 20;
constexpr size_t WS_WGU1 = WS_CTL + CTL_BYTES;
constexpr size_t WS_WD1 = WS_WGU1 + (size_t)2 * DFF * D * 2;
constexpr size_t WS_WIN = WS_WD1 + (size_t)D * DFF * 2;
constexpr size_t WS_WOUT = WS_WIN + (size_t)NQKV * D * 2;
constexpr size_t WS_WCQS = WS_WOUT + (size_t)D * D * 2;
constexpr size_t WS_WCKV = WS_WCQS + (size_t)D * D * 2;
constexpr size_t WS_WCO = WS_WCKV + (size_t)2 * D * D * 2;
constexpr size_t WS_WGU2 = WS_WCO + (size_t)D * D * 2;
constexpr size_t WS_WD2 = WS_WGU2 + (size_t)2 * DFF * D * 2;
constexpr size_t WS_MB = WS_WD2 + (size_t)D * DFF * 2;
constexpr size_t WS_KVC = WS_MB + (size_t)MM * D * 2;
constexpr size_t WS_WKT = WS_KVC + (size_t)MM * 2 * D * 2;
constexpr size_t WS_VWT = WS_WKT + (size_t)NBAT * D * D * 2;
constexpr size_t SS_BYTES = (size_t)M * 16 * 4;
constexpr size_t WS_SS = WS_VWT + (size_t)NBAT * D * D * 2;
constexpr size_t WS_SSM = WS_SS + 5 * SS_BYTES;
constexpr size_t WS_KM = WS_SSM + (size_t)MM * 16 * 4;
constexpr size_t WS_SX = WS_KM + (size_t)NBAT * 16 * 256 * 4;
constexpr size_t WS_SW = WS_SX + (size_t)M * 4;
constexpr size_t WS_R1 = al256(WS_SW + (size_t)2 * DFF * 4);
constexpr size_t WS_XB = WS_R1 + (size_t)M * NQKV * 2;
constexpr size_t WS_OA2 = WS_XB + (size_t)M * D * 2;
constexpr size_t WS_SEL = WS_OA2 + (size_t)M * 768 * 2;
constexpr size_t WS_OBP = WS_SEL + (size_t)NBAT * 4 * SEQ * 4;
constexpr size_t WS_X8 = WS_OBP;
constexpr size_t WS_MLB = WS_OBP + (size_t)4 * M * 256 * 2;
constexpr size_t WS_END = WS_MLB + (size_t)4 * M * 4 * 2 * 4;
constexpr size_t OUT_OA1 = (size_t)M * 768 * 2, OUT_OB = 2 * OUT_OA1, OUT_ML = OUT_OB + (size_t)M * 256 * 2;
static_assert(OUT_ML + (size_t)3 * M * 12 * 8 <= (size_t)M * D * 4, "attention partials fit in d_out");
constexpr int CW_BAR = 4096, CW_QUEUE = 8192;

constexpr int LDS_XCH = 131072;
constexpr int LDS_MISC = 131072 + 8192;
constexpr int LDS_BYTES = 147456;
constexpr int LDS_TAB = 98304;
static_assert(LDS_TAB + 4 * att::TABB_N * 4 <= LDS_XCH, "attention LDS map");

__device__ __forceinline__ float wave_sum(float v) {
#pragma unroll
    for (int o = 1; o < 64; o <<= 1) v += __shfl_xor(v, o);
    return v;
}
__device__ __forceinline__ unsigned pk_fp8x4(float a, float b, float c, float d) { int r = __builtin_amdgcn_cvt_pk_fp8_f32(a, b, 0, false); r = __builtin_amdgcn_cvt_pk_fp8_f32(c, d, r, true); return (unsigned)r; }
__device__ __forceinline__ unsigned pk_i8x4(float a, float b, float c, float d) { const int ia = (int)__builtin_rintf(a), ib = (int)__builtin_rintf(b), ic = (int)__builtin_rintf(c), id = (int)__builtin_rintf(d);
    return ((unsigned)ia & 255u) | (((unsigned)ib & 255u) << 8) | (((unsigned)ic & 255u) << 16) | ((unsigned)id << 24); }
__device__ __forceinline__ float row_rstd(const float* ss, int row) {
    const f32x4* p = (const f32x4*)(ss + (size_t)row * 16);
    const f32x4 a = p[0], b = p[1], c = p[2], d = p[3];
    const float s = ((a[0] + a[1]) + (a[2] + a[3])) + ((b[0] + b[1]) + (b[2] + b[3])) + ((c[0] + c[1]) + (c[2] + c[3])) + ((d[0] + d[1]) + (d[2] + d[3]));
    return 1.0f / sqrtf(s * (1.0f / D) + EPS);
}

struct SchedStd {
    pg8::Order o; const char* A; const char* B; size_t a_tile, b_tile, b_batch; int ocol_mul;
    __device__ __forceinline__ bool next(int i, Unit& u) const { int pm, pn; if (!o.tile(i, pm, pn)) return false;
        u.a = A + (size_t)pm * a_tile; u.b = B + (size_t)pn * b_tile + (size_t)(pm >> 4) * b_batch; u.orow = pm * 256; u.ocol = pn * ocol_mul; u.aux = pn; return true; }
};
struct SchedWK {
    int G, c; const char* kvc; const char* wcqs;
    __device__ __forceinline__ bool next(int i, Unit& u) const { const int L = i * G + c; if (L >= NBAT * 16) return false; const int bh = L >> 2, pn = L & 3, b = bh >> 2, h = bh & 3;
        u.a = kvc + ((size_t)(b * 256) * 2048 + h * 256) * 2; u.b = wcqs + ((size_t)(pn * 256) * 1024 + h * 256) * 2; u.orow = b * 1024 + h * 256; u.ocol = pn * 256; u.aux = 0; return true; }
};
struct SchedVW {
    int G, c; const char* kvc; const char* wcot;
    __device__ __forceinline__ bool next(int i, Unit& u) const { const int L = i * G + c; if (L >= NBAT * 16) return false; const int bh = L >> 2, pm = L & 3, b = bh >> 2, h = bh & 3;
        u.a = wcot + ((size_t)(pm * 256) * 1024 + h * 256) * 2; u.b = kvc + ((size_t)(b * 256) * 2048 + 1024 + h * 256) * 2; u.orow = b * 1024 + pm * 256; u.ocol = h * 256; u.aux = 0; return true; }
};

template <bool F8, bool H8, bool I8> struct EpiGU { static constexpr bool PERM = true;
    void* H; const float* ss; const float* sx; const float* sw;
    __device__ __forceinline__ void operator()(const f32x4 (&acc)[2][2][4][2], const Unit& u, int wr, int wc, int fr, int fq, LAS unsigned char*, int, int) const {
        float rsv[2][4];
#pragma unroll
        for (int ai = 0; ai < 2; ++ai)
#pragma unroll
            for (int m = 0; m < 4; ++m) { const int row_ = u.orow + ai * 128 + wr * 64 + m * 16 + fr; rsv[ai][m] = row_rstd(ss, row_) * (F8 ? 1.0f / F8_WGU : 1.0f); if constexpr (I8) rsv[ai][m] *= sx[row_]; }
        f32x4 swg[2], swu[2];
        if constexpr (I8) { const f32x4* pg = (const f32x4*)(sw + u.ocol + wc * 32 + 8 * fq); const f32x4* pu = (const f32x4*)(sw + DFF + u.ocol + wc * 32 + 8 * fq); swg[0] = pg[0]; swg[1] = pg[1]; swu[0] = pu[0]; swu[1] = pu[1]; }
#pragma unroll
        for (int ai = 0; ai < 2; ++ai)
#pragma unroll
            for (int m = 0; m < 4; ++m) { const int row = u.orow + ai * 128 + wr * 64 + m * 16 + fr; const float rs = rsv[ai][m];
                float hv[8];
#pragma unroll
                for (int n = 0; n < 2; ++n)
#pragma unroll
                    for (int j = 0; j < 4; ++j) { float g, uu;
                        if constexpr (I8) { const float ga = acc[ai][0][m][n][j], ua = acc[ai][1][m][n][j];
                            g = (float)__builtin_bit_cast(int, ga) * (rs * swg[n][j]); uu = (float)__builtin_bit_cast(int, ua) * (rs * swu[n][j]); }
                        else { g = acc[ai][0][m][n][j] * rs; uu = acc[ai][1][m][n][j] * rs; }
                        hv[4 * n + j] = g * __builtin_amdgcn_rcpf(1.0f + __builtin_amdgcn_exp2f(-g * LOG2E)) * uu; }
                if constexpr (H8) { u32x2 w; w[0] = pk_fp8x4(hv[0] * F8_H, hv[1] * F8_H, hv[2] * F8_H, hv[3] * F8_H); w[1] = pk_fp8x4(hv[4] * F8_H, hv[5] * F8_H, hv[6] * F8_H, hv[7] * F8_H);
                    __builtin_nontemporal_store(w, (u32x2*)((unsigned char*)H + (size_t)row * DFF + u.ocol + wc * 32 + 8 * fq)); }
                else { u32x4 w; w[0] = cvt_pk_bf16(hv[0], hv[1]); w[1] = cvt_pk_bf16(hv[2], hv[3]); w[2] = cvt_pk_bf16(hv[4], hv[5]); w[3] = cvt_pk_bf16(hv[6], hv[7]);
                    __builtin_nontemporal_store(w, (u32x4*)((bf16_t*)H + (size_t)row * DFF + u.ocol + wc * 32 + 8 * fq)); } }
    }
};
template <bool X8> struct EpiRes { static constexpr bool PERM = true;
    bf16_t* xb; float* ssout; float alpha; unsigned char* x8;
    __device__ __forceinline__ void operator()(const f32x4 (&acc)[2][2][4][2], const Unit& u, int wr, int wc, int fr, int fq, LAS unsigned char*, int, int) const {
        const size_t off0 = (size_t)(u.orow + wr * 64 + fr) * D + u.ocol + wc * 32 + 8 * fq;
        u32x4 cur[2], nxt[2];
#pragma unroll
        for (int bj = 0; bj < 2; ++bj) cur[bj] = *(const u32x4*)(xb + off0 + bj * 128);
#pragma unroll
        for (int idx = 0; idx < 8; ++idx) { const int ai = idx >> 2, m = idx & 3; const size_t off = off0 + (size_t)(ai * 128 + m * 16) * D; const int row = u.orow + ai * 128 + wr * 64 + m * 16 + fr;
            if (idx < 7) { const size_t offn = off0 + (size_t)(((idx + 1) >> 2) * 128 + ((idx + 1) & 3) * 16) * D;
#pragma unroll
                for (int bj = 0; bj < 2; ++bj) nxt[bj] = *(const u32x4*)(xb + offn + bj * 128); }
            float sq = 0.f;
#pragma unroll
            for (int bj = 0; bj < 2; ++bj) { float o[8];
#pragma unroll
                for (int n = 0; n < 2; ++n)
#pragma unroll
                    for (int j = 0; j < 4; ++j) { const unsigned wv = cur[bj][2 * n + (j >> 1)]; const float r = __builtin_bit_cast(float, (j & 1) ? (wv & 0xffff0000u) : (wv << 16));
                        const float v = r + acc[ai][bj][m][n][j] * alpha; o[4 * n + j] = v; sq += v * v; }
                u32x4 w; w[0] = cvt_pk_bf16(o[0], o[1]); w[1] = cvt_pk_bf16(o[2], o[3]); w[2] = cvt_pk_bf16(o[4], o[5]); w[3] = cvt_pk_bf16(o[6], o[7]);
                *(u32x4*)(xb + off + bj * 128) = w;
                if constexpr (X8) { u32x2 w8; w8[0] = pk_fp8x4(o[0], o[1], o[2], o[3]); w8[1] = pk_fp8x4(o[4], o[5], o[6], o[7]); *(u32x2*)(x8 + off + bj * 128) = w8; } }
            sq += __shfl_xor(sq, 16); sq += __shfl_xor(sq, 32);
            if (fq == 0) ssout[(size_t)row * 16 + (u.ocol >> 8) * 4 + wc] = sq;
#pragma unroll
            for (int bj = 0; bj < 2; ++bj) cur[bj] = nxt[bj]; }
    }
};
struct EpiStore { static constexpr bool PERM = true;
    bf16_t* O; int ldc; const float* ss; float* km; bool nt;
    __device__ __forceinline__ void operator()(const f32x4 (&acc)[2][2][4][2], const Unit& u, int wr, int wc, int fr, int fq, LAS unsigned char*, int, int) const {
        float rsv[2][4];
#pragma unroll
        for (int ai = 0; ai < 2; ++ai)
#pragma unroll
            for (int m = 0; m < 4; ++m) rsv[ai][m] = ss ? row_rstd(ss, u.orow + ai * 128 + wr * 64 + m * 16 + fr) : 1.0f;
#pragma unroll
        for (int ai = 0; ai < 2; ++ai)
#pragma unroll
            for (int m = 0; m < 4; ++m) { const int row = u.orow + ai * 128 + wr * 64 + m * 16 + fr; const float rs = rsv[ai][m];
                const int col0 = u.ocol + wc * 32 + 8 * fq;
                bf16_t* rowp = ldc ? O + (size_t)row * ldc + col0 : O + (((size_t)(row / SEQ) * (NQKV / 64) + (col0 >> 6)) * SEQ + (row % SEQ)) * 64 + (col0 & 63);
                const size_t bjstep = ldc ? 128 : (size_t)2 * SEQ * 64;
#pragma unroll
                for (int bj = 0; bj < 2; ++bj) { const f32x4 v0 = acc[ai][bj][m][0] * rs, v1 = acc[ai][bj][m][1] * rs;
                    u32x4 w; w[0] = cvt_pk_bf16(v0[0], v0[1]); w[1] = cvt_pk_bf16(v0[2], v0[3]); w[2] = cvt_pk_bf16(v1[0], v1[1]); w[3] = cvt_pk_bf16(v1[2], v1[3]);
                    if (nt) __builtin_nontemporal_store(w, (u32x4*)(rowp + bj * bjstep)); else *(u32x4*)(rowp + bj * bjstep) = w; } }
        if ((km != nullptr) && (u.aux == 10)) {
            float* kmb = km + (size_t)(u.orow >> 8) * 256 + wc * 32 + 8 * fq;
#pragma unroll
            for (int bj = 0; bj < 2; ++bj)
#pragma unroll
                for (int n = 0; n < 2; ++n) { f32x4 cs = (f32x4){0.f, 0.f, 0.f, 0.f};
#pragma unroll
                    for (int ai = 0; ai < 2; ++ai)
#pragma unroll
                        for (int m = 0; m < 4; ++m) cs += acc[ai][bj][m][n] * rsv[ai][m];
#pragma unroll
                    for (int j = 0; j < 4; ++j) { float v = cs[j]; v += __shfl_xor(v, 1); v += __shfl_xor(v, 2); v += __shfl_xor(v, 4); v += __shfl_xor(v, 8);
                        if (fr == 0) atomicAdd(kmb + bj * 128 + 4 * n + j, v); } }
        }
    }
};
struct EpiSoftmax { static constexpr bool PERM = true;
    bf16_t* P; const float* ss;
    __device__ __forceinline__ void operator()(const f32x4 (&acc)[2][2][4][2], const Unit& u, int wr, int wc, int fr, int fq, LAS unsigned char* lds, int, int) const {
        LAS f32x2* X = (LAS f32x2*)(lds + LDS_XCH);
        float rsl[2][4], mw[2][4];
#pragma unroll
        for (int ai = 0; ai < 2; ++ai)
#pragma unroll
            for (int m = 0; m < 4; ++m) { const int rl = ai * 128 + wr * 64 + m * 16 + fr; const float rs = row_rstd(ss, u.orow + rl) * LOG2E; rsl[ai][m] = rs;
                float mx = -INFINITY;
#pragma unroll
                for (int bj = 0; bj < 2; ++bj)
#pragma unroll
                    for (int n = 0; n < 2; ++n)
#pragma unroll
                        for (int j = 0; j < 4; ++j) mx = fmaxf(mx, acc[ai][bj][m][n][j] * rs);
                mx = fmaxf(mx, __shfl_xor(mx, 16)); mx = fmaxf(mx, __shfl_xor(mx, 32));
                float sm = 0.f;
#pragma unroll
                for (int bj = 0; bj < 2; ++bj)
#pragma unroll
                    for (int n = 0; n < 2; ++n)
#pragma unroll
                        for (int j = 0; j < 4; ++j) sm += __builtin_amdgcn_exp2f(acc[ai][bj][m][n][j] * rs - mx);
                sm += __shfl_xor(sm, 16); sm += __shfl_xor(sm, 32);
                mw[ai][m] = mx;
                if (fq == 0) X[rl * 4 + wc] = (f32x2){mx, sm}; }
        asm volatile("s_waitcnt lgkmcnt(0)" ::: "memory"); __builtin_amdgcn_s_barrier(); asm volatile("" ::: "memory");
#pragma unroll
        for (int ai = 0; ai < 2; ++ai)
#pragma unroll
            for (int m = 0; m < 4; ++m) { const int rl = ai * 128 + wr * 64 + m * 16 + fr; const float rs = rsl[ai][m];
                const f32x2 x0 = X[rl * 4 + 0], x1 = X[rl * 4 + 1], x2 = X[rl * 4 + 2], x3 = X[rl * 4 + 3];
                const float Mx = fmaxf(fmaxf(x0[0], x1[0]), fmaxf(x2[0], x3[0]));
                const float L = x0[1] * __builtin_amdgcn_exp2f(x0[0] - Mx) + x1[1] * __builtin_amdgcn_exp2f(x1[0] - Mx) + x2[1] * __builtin_amdgcn_exp2f(x2[0] - Mx) + x3[1] * __builtin_amdgcn_exp2f(x3[0] - Mx);
                const float il = 1.0f / L;
                bf16_t* rowp = P + (size_t)(u.orow + rl) * D + u.ocol + wc * 32 + 8 * fq;
#pragma unroll
                for (int bj = 0; bj < 2; ++bj) { float pv[8];
#pragma unroll
                    for (int n = 0; n < 2; ++n)
#pragma unroll
                        for (int j = 0; j < 4; ++j) pv[4 * n + j] = __builtin_amdgcn_exp2f(acc[ai][bj][m][n][j] * rs - Mx) * il;
                    u32x4 w; w[0] = cvt_pk_bf16(pv[0], pv[1]); w[1] = cvt_pk_bf16(pv[2], pv[3]); w[2] = cvt_pk_bf16(pv[4], pv[5]); w[3] = cvt_pk_bf16(pv[6], pv[7]);
                    *(u32x4*)(rowp + bj * 128) = w; } }
        (void)mw;
    }
};

#define XB_TMO      128
#define XB_XCNT(j)  (256  + 64 * (j))
#define XB_XSUB(j)  (1280 + 64 * (j))
#define XB_XGEN(j)  (2304 + 64 * (j))
#define XB_TOP      3328
#define XB_TOPGEN   3392
#define XCD_BAR_WORDS 3456
#define XB_SPIN_CAP (1u << 18)
__device__ __forceinline__ unsigned xb_ld(unsigned* p)              { return __hip_atomic_load(p, __ATOMIC_RELAXED, __HIP_MEMORY_SCOPE_AGENT); }
__device__ __forceinline__ unsigned xb_add(unsigned* p, unsigned v) { return __hip_atomic_fetch_add(p, v, __ATOMIC_RELAXED, __HIP_MEMORY_SCOPE_AGENT); }
__device__ __forceinline__ unsigned xb_xcc_id() { return (unsigned)__builtin_amdgcn_s_getreg((3 << 11) | 20) & 0xFu; }
#define XB_SPIN(cond, bar) do { unsigned _sp = 0; while (cond) { __builtin_amdgcn_s_sleep(1); \
    if ((++_sp & 255u) == 0u) { if (xb_ld(&(bar)[XB_TMO])) break; if (_sp > XB_SPIN_CAP) { atomicAdd(&(bar)[XB_TMO], 1u); break; } } } } while (0)
struct XcdBarrier { unsigned* bar; unsigned x; volatile LAS unsigned* st; };
__device__ __forceinline__ XcdBarrier xcd_barrier_post(unsigned* bar, volatile LAS unsigned* st) {
    XcdBarrier b; b.bar = bar; b.x = xb_xcc_id(); b.st = st;
    if (threadIdx.x == 0) (void)xb_add(&bar[XB_XCNT(b.x)], 1u);
    return b;
}
__device__ __forceinline__ void xcd_barrier_complete(unsigned* bar, unsigned x, unsigned& nloc, unsigned& nx) {
    const unsigned G = gridDim.x * gridDim.y * gridDim.z;
    unsigned sum, cnt, mine, sp = 0u;
    for (;;) {
        sum = 0u; cnt = 0u; mine = 0u;
#pragma unroll
        for (unsigned j = 0; j < 16; ++j) { const unsigned c = xb_ld(&bar[XB_XCNT(j)]); sum += c; cnt += (c > 0u) ? 1u : 0u; mine = (j == x) ? c : mine; }
        if (sum == G) break;
        __builtin_amdgcn_s_sleep(1);
        if ((++sp & 255u) == 0u) { if (xb_ld(&bar[XB_TMO])) break; if (sp > XB_SPIN_CAP) { atomicAdd(&bar[XB_TMO], 1u); break; } }
    }
    nloc = mine > 0u ? mine : 1u; nx = cnt > 0u ? cnt : 1u;
}
__device__ __forceinline__ void xcd_barrier(const XcdBarrier& b) {
    asm volatile("s_waitcnt vmcnt(0)" ::: "memory");
    __syncthreads();
    if (threadIdx.x == 0) {
        unsigned* bar = b.bar;
        __builtin_amdgcn_s_waitcnt(0);
        unsigned nloc = b.st[0], nx = b.st[1];
        if (nloc == 0u) { xcd_barrier_complete(bar, b.x, nloc, nx); b.st[0] = nloc; b.st[1] = nx; }
        const unsigned old = xb_add(&bar[XB_XSUB(b.x)], 1u);
        const unsigned gen = old / nloc;
        if (old + 1u == (gen + 1u) * nloc) {
            __builtin_amdgcn_fence(__ATOMIC_RELEASE, "agent");
            asm volatile("s_waitcnt vmcnt(0)" ::: "memory");
            const unsigned og = xb_add(&bar[XB_TOP], 1u);
            const unsigned tg = og / nx;
            if (og + 1u == (tg + 1u) * nx) xb_add(&bar[XB_TOPGEN], 1u);
            else XB_SPIN(xb_ld(&bar[XB_TOPGEN]) == tg, bar);
            __builtin_amdgcn_fence(__ATOMIC_ACQUIRE, "agent");
            xb_add(&bar[XB_XGEN(b.x)], 1u);
            asm volatile("s_waitcnt vmcnt(0)" ::: "memory");
        } else {
            XB_SPIN(xb_ld(&bar[XB_XGEN(b.x)]) == gen, bar);
            __builtin_amdgcn_fence(__ATOMIC_ACQUIRE, "agent");
            asm volatile("s_waitcnt vmcnt(0)" ::: "memory");
        }
    }
    __syncthreads();
}

template <bool F8>
__device__ __forceinline__ void tr_item(const float* W, int N, int k0, int n0, const float* gain, float cscale, void* dst  , int Kd, LAS float* scr, int lane) {
    f32x4 v[8]; float g[8];
#pragma unroll
    for (int i = 0; i < 8; ++i) { const int kk = 8 * i + (lane >> 3); v[i] = __builtin_nontemporal_load((const f32x4*)(W + (size_t)(k0 + kk) * N + n0 + 4 * (lane & 7))); g[i] = gain ? gain[k0 + kk] * cscale : cscale; }
#pragma unroll
    for (int i = 0; i < 8; ++i) { const int kk = 8 * i + (lane >> 3); LAS float* d = scr + kk * 33 + 4 * (lane & 7); d[0] = v[i][0] * g[i]; d[1] = v[i][1] * g[i]; d[2] = v[i][2] * g[i]; d[3] = v[i][3] * g[i]; }
    asm volatile("s_waitcnt lgkmcnt(0)" ::: "memory");
    const int c = lane & 7;
#pragma unroll
    for (int j = 0; j < 4; ++j) { const int n = (lane >> 3) + 8 * j; const LAS float* s = scr + (8 * c) * 33 + n;
        if constexpr (F8) { u32x2 o; o[0] = pk_fp8x4(s[0 * 33], s[1 * 33], s[2 * 33], s[3 * 33]); o[1] = pk_fp8x4(s[4 * 33], s[5 * 33], s[6 * 33], s[7 * 33]); *(u32x2*)((unsigned char*)dst + (size_t)n * Kd + k0 + 8 * c) = o; }
        else { u32x4 o; o[0] = cvt_pk_bf16(s[0 * 33], s[1 * 33]); o[1] = cvt_pk_bf16(s[2 * 33], s[3 * 33]); o[2] = cvt_pk_bf16(s[4 * 33], s[5 * 33]); o[3] = cvt_pk_bf16(s[6 * 33], s[7 * 33]);
            *(u32x4*)((bf16_t*)dst + (size_t)n * Kd + k0 + 8 * c) = o; } }
    asm volatile("s_waitcnt lgkmcnt(0)" ::: "memory");
}
template <int NR, int Q8>
__device__ __forceinline__ void cvt_rows(const float* x, bf16_t* o, unsigned char* o8, float* sx, float* ss, int row0, int stride, int nrows, int lane) {
    f32x4 v[NR][4]; float s[NR];
#pragma unroll
    for (int r = 0; r < NR; ++r) { const int row = row0 + r * stride; const f32x4* xr = (const f32x4*)(x + (size_t)(row < nrows ? row : row0) * D) + lane;
#pragma unroll
        for (int j = 0; j < 4; ++j) v[r][j] = __builtin_nontemporal_load(xr + 64 * j); }
#pragma unroll
    for (int r = 0; r < NR; ++r) { float a = 0.f;
#pragma unroll
        for (int j = 0; j < 4; ++j) a += (v[r][j][0] * v[r][j][0] + v[r][j][1] * v[r][j][1]) + (v[r][j][2] * v[r][j][2] + v[r][j][3] * v[r][j][3]);
        s[r] = a; }
#pragma unroll
    for (int of = 1; of < 64; of <<= 1)
#pragma unroll
        for (int r = 0; r < NR; ++r) s[r] += __shfl_xor(s[r], of);
#pragma unroll
    for (int r = 0; r < NR; ++r) { const int row = row0 + r * stride; if (row < nrows) { u32x2* ob = (u32x2*)(o + (size_t)row * D) + lane;
#pragma unroll
            for (int j = 0; j < 4; ++j) { u32x2 w; w[0] = cvt_pk_bf16(v[r][j][0], v[r][j][1]); w[1] = cvt_pk_bf16(v[r][j][2], v[r][j][3]); ob[64 * j] = w; }
            if constexpr (Q8 == 1) { unsigned* oq = (unsigned*)(o8 + (size_t)row * D) + lane;
#pragma unroll
                for (int j = 0; j < 4; ++j) oq[64 * j] = pk_fp8x4(v[r][j][0], v[r][j][1], v[r][j][2], v[r][j][3]); }
            if constexpr (Q8 == 2) { float mx = 0.f;
#pragma unroll
                for (int j = 0; j < 4; ++j) mx = fmaxf(fmaxf(mx, fmaxf(fabsf(v[r][j][0]), fabsf(v[r][j][1]))), fmaxf(fabsf(v[r][j][2]), fabsf(v[r][j][3])));
#pragma unroll
                for (int of = 1; of < 64; of <<= 1) mx = fmaxf(mx, __shfl_xor(mx, of));
                mx = fmaxf(mx, 1e-30f); const float inv = 127.0f / mx; unsigned* oq = (unsigned*)(o8 + (size_t)row * D) + lane;
#pragma unroll
                for (int j = 0; j < 4; ++j) oq[64 * j] = pk_i8x4(v[r][j][0] * inv, v[r][j][1] * inv, v[r][j][2] * inv, v[r][j][3] * inv);
                if (lane == 0) sx[row] = mx * (1.0f / 127.0f); }
            if (lane < 16) ss[(size_t)row * 16 + lane] = lane == 0 ? s[r] : 0.f; } }
}

struct Args { const float* in[20]; float* out; unsigned char* ws; int ph_lo, ph_hi, flags, pad; };

#define MK_PTRS unsigned char* ws = args.ws; float* out = args.out; asm volatile("" : "+s"(ws), "+s"(out)); \
    const float* x_in = args.in[0]; const float* mem_in = args.in[1]; const float* rel_bias = args.in[7]; \
    bf16_t* Wgu1 = (bf16_t*)(ws + WS_WGU1); bf16_t* Wd1 = (bf16_t*)(ws + WS_WD1); bf16_t* Win = (bf16_t*)(ws + WS_WIN); bf16_t* Wout = (bf16_t*)(ws + WS_WOUT); \
    bf16_t* Wcqs = (bf16_t*)(ws + WS_WCQS); bf16_t* Wckv = (bf16_t*)(ws + WS_WCKV); bf16_t* Wco = (bf16_t*)(ws + WS_WCO); bf16_t* Wgu2 = (bf16_t*)(ws + WS_WGU2); bf16_t* Wd2 = (bf16_t*)(ws + WS_WD2); \
    bf16_t* MB = (bf16_t*)(ws + WS_MB); bf16_t* KVC = (bf16_t*)(ws + WS_KVC); bf16_t* WKT = (bf16_t*)(ws + WS_WKT); bf16_t* VWT = (bf16_t*)(ws + WS_VWT); \
    float* SS0 = (float*)(ws + WS_SS); float* SS1 = SS0 + (size_t)M * 16; float* SS2 = SS1 + (size_t)M * 16; float* SS3 = SS2 + (size_t)M * 16; float* SS4 = SS3 + (size_t)M * 16; \
    float* SSM = (float*)(ws + WS_SSM); float* KM = (float*)(ws + WS_KM); float* SX = (float*)(ws + WS_SX); float* SW = (float*)(ws + WS_SW); (void)SX; (void)SW; \
    bf16_t* HB = (bf16_t*)(ws + WS_R1); bf16_t* QKV = HB; bf16_t* YN = HB; bf16_t* PB = HB; \
    bf16_t* XB = (bf16_t*)(ws + WS_XB); unsigned char* X8 = ws + WS_X8; (void)X8; bf16_t* OA0 = (bf16_t*)out; bf16_t* OA1 = (bf16_t*)((char*)out + OUT_OA1); bf16_t* OA2 = (bf16_t*)(ws + WS_OA2); bf16_t* OB = (bf16_t*)((char*)out + OUT_OB); float* ML = (float*)((char*)out + OUT_ML); unsigned* SEL = (unsigned*)(ws + WS_SEL); bf16_t* OBP = (bf16_t*)(ws + WS_OBP); float* MLB = (float*)(ws + WS_MLB); (void)OB;
__global__ void __launch_bounds__(NWAVES * 64, 2) mk_fwd(Args args) {
    extern __shared__ __attribute__((aligned(16))) unsigned char lds_raw[];
    LAS unsigned char* lds = (LAS unsigned char*)lds_raw;
    const int tid = threadIdx.x, lane = tid & 63, wave = __builtin_amdgcn_readfirstlane(tid >> 6);
    const int G = gridDim.x, bx = blockIdx.x;
    const int vcu = (G % 8 == 0) ? (bx % 8) * (G / 8) + bx / 8 : bx;
    const int gw = vcu * NWAVES + wave, NGW = G * NWAVES;
    unsigned char* const ws0 = args.ws;
    volatile LAS unsigned* MISC = (volatile LAS unsigned*)(lds + LDS_MISC);
    if (tid < 32) MISC[tid] = 0u;
    __syncthreads();
    const int lo = args.ph_lo, hi = args.ph_hi;
    const bool use_bar = (hi - lo) > 1;
    XcdBarrier bar; bar.bar = (unsigned*)(ws0 + WS_CTL) + CW_BAR; bar.x = 0; bar.st = nullptr;
    if (use_bar) bar = xcd_barrier_post((unsigned*)(ws0 + WS_CTL) + CW_BAR, MISC + 8);
#define IN(k) (lo <= (k) && (k) < hi)
#define STAGGER() do { if (MK_STAGGER_TICKS > 0) { const unsigned long long t0_ = __builtin_amdgcn_s_memrealtime(), dl_ = (unsigned long long)((bx >> 3) & 3) * MK_STAGGER_TICKS; while (__builtin_amdgcn_s_memrealtime() - t0_ < dl_) __builtin_amdgcn_s_sleep(8); } } while (0)
#define SEAM(k) do { if (IN(k) && IN((k) + 1)) xcd_barrier(bar); } while (0)

    if (IN(0)) {
        MK_PTRS;
        LAS float* scr = (LAS float*)(lds + wave * 16384);
        constexpr int I_GU = (D / 64) * (2 * DFF / 32), I_DN = (DFF / 64) * (D / 32), I_IN = (D / 64) * (NQKV / 32), I_SQ = (D / 64) * (D / 32), I_KV = (D / 64) * (2 * D / 32);
        constexpr int NITEMS = 2 * I_GU + 2 * I_DN + I_IN + 2 * I_SQ + I_KV;
        for (int it = gw; it < NITEMS; it += NGW) {
            int r = it;
            if (r < 2 * I_GU) {
                const bool second = r >= I_GU; if (second) r -= I_GU;
                if (I8_1G && !second) continue;
                const int nblk = 2 * DFF / 32, kb = r / nblk, nb = r % nblk, n0 = nb * 32;
                const int drow = n0 < DFF ? (n0 / 128) * 256 + (n0 % 128) : ((n0 - DFF) / 128) * 256 + 128 + ((n0 - DFF) % 128);
                if (second ? F8_2G : F8_1G) tr_item<true>(args.in[second ? 17 : 3], 2 * DFF, kb * 64, n0, args.in[second ? 16 : 2], F8_WGU, (unsigned char*)(second ? Wgu2 : Wgu1) + (size_t)drow * D, D, scr, lane);
                else tr_item<false>(args.in[second ? 17 : 3], 2 * DFF, kb * 64, n0, args.in[second ? 16 : 2], 1.0f, (second ? Wgu2 : Wgu1) + (size_t)drow * D, D, scr, lane);
                continue; }
            r -= 2 * I_GU;
            if (r < 2 * I_DN) { const bool second = r >= I_DN; if (second) r -= I_DN; const int nblk = D / 32, kb = r / nblk, nb = r % nblk;
                if (second ? F8_2D : F8_1D) tr_item<true>(args.in[second ? 18 : 4], D, kb * 64, nb * 32, nullptr, F8_WD, (unsigned char*)(second ? Wd2 : Wd1) + (size_t)(nb * 32) * DFF, DFF, scr, lane);
                else tr_item<false>(args.in[second ? 18 : 4], D, kb * 64, nb * 32, nullptr, 1.0f, (second ? Wd2 : Wd1) + (size_t)(nb * 32) * DFF, DFF, scr, lane);
                continue; }
            r -= 2 * I_DN;
            if (r < I_IN) { const int nblk = NQKV / 32, kb = r / nblk, nb = r % nblk, n0 = nb * 32; const bool isq = (n0 < 768) || (n0 >= 2304 && n0 < 2560);
                tr_item<false>(args.in[6], NQKV, kb * 64, n0, args.in[5], isq ? 0.125f : 1.0f, Win + (size_t)n0 * D, D, scr, lane); continue; }
            r -= I_IN;
            if (r < I_SQ) { const int nblk = D / 32, kb = r / nblk, nb = r % nblk, k0 = kb * 64; const float* gp = k0 < 768 ? args.in[8] : args.in[9] - 768;
                tr_item<false>(args.in[10], D, k0, nb * 32, gp, 1.0f, Wout + (size_t)(nb * 32) * D, D, scr, lane); continue; }
            r -= I_SQ;
            if (r < I_SQ) { const int nblk = D / 32, kb = r / nblk, nb = r % nblk; tr_item<false>(args.in[15], D, kb * 64, nb * 32, nullptr, 1.0f, Wco + (size_t)(nb * 32) * D, D, scr, lane); continue; }
            r -= I_SQ;
            { const int nblk = 2 * D / 32, kb = r / nblk, nb = r % nblk; tr_item<false>(args.in[14], 2 * D, kb * 64, nb * 32, args.in[12], 1.0f, Wckv + (size_t)(nb * 32) * D, D, scr, lane); }
        }
        if constexpr (I8_1G) {
            for (int cg = vcu; cg < 2 * DFF / 32; cg += G) {
                const int n0 = cg * 32, drow = n0 < DFF ? (n0 / 128) * 256 + (n0 % 128) : ((n0 - DFF) / 128) * 256 + 128 + ((n0 - DFF) % 128);
                const float* W = args.in[3]; const float* gain = args.in[2];
                f32x4 v[2][8]; f32x4 mx = (f32x4){0.f, 0.f, 0.f, 0.f};
#pragma unroll
                for (int t = 0; t < 2; ++t)
#pragma unroll
                    for (int i = 0; i < 8; ++i) { const int kk = (2 * wave + t) * 64 + 8 * i + (lane >> 3); v[t][i] = __builtin_nontemporal_load((const f32x4*)(W + (size_t)kk * (2 * DFF) + n0 + 4 * (lane & 7))) * gain[kk]; }
#pragma unroll
                for (int t = 0; t < 2; ++t)
#pragma unroll
                    for (int i = 0; i < 8; ++i)
#pragma unroll
                        for (int c = 0; c < 4; ++c) mx[c] = fmaxf(mx[c], fabsf(v[t][i][c]));
#pragma unroll
                for (int c = 0; c < 4; ++c) { float a = mx[c]; a = fmaxf(a, __shfl_xor(a, 8)); a = fmaxf(a, __shfl_xor(a, 16)); a = fmaxf(a, __shfl_xor(a, 32)); mx[c] = a; }
                LAS float* XM = (LAS float*)(lds + LDS_XCH);
                if (lane < 8) { XM[wave * 32 + 4 * lane + 0] = mx[0]; XM[wave * 32 + 4 * lane + 1] = mx[1]; XM[wave * 32 + 4 * lane + 2] = mx[2]; XM[wave * 32 + 4 * lane + 3] = mx[3]; }
                asm volatile("s_waitcnt lgkmcnt(0)" ::: "memory"); __syncthreads();
                float mul[4];
#pragma unroll
                for (int c = 0; c < 4; ++c) { float a = 0.f;
#pragma unroll
                    for (int w2 = 0; w2 < NWAVES; ++w2) a = fmaxf(a, XM[w2 * 32 + 4 * (lane & 7) + c]);
                    a = fmaxf(a, 1e-30f); mul[c] = 127.0f / a; if (wave == 0 && lane < 8) SW[n0 + 4 * lane + c] = a * (1.0f / 127.0f); }
#pragma unroll
                for (int t = 0; t < 2; ++t) { const int k0 = (2 * wave + t) * 64;
#pragma unroll
                    for (int i = 0; i < 8; ++i) { const int kk = 8 * i + (lane >> 3); LAS float* d = scr + kk * 33 + 4 * (lane & 7); d[0] = v[t][i][0] * mul[0]; d[1] = v[t][i][1] * mul[1]; d[2] = v[t][i][2] * mul[2]; d[3] = v[t][i][3] * mul[3]; }
                    asm volatile("s_waitcnt lgkmcnt(0)" ::: "memory");
                    const int c8 = lane & 7;
#pragma unroll
                    for (int j = 0; j < 4; ++j) { const int n = (lane >> 3) + 8 * j; const LAS float* s = scr + (8 * c8) * 33 + n;
                        u32x2 o; o[0] = pk_i8x4(s[0 * 33], s[1 * 33], s[2 * 33], s[3 * 33]); o[1] = pk_i8x4(s[4 * 33], s[5 * 33], s[6 * 33], s[7 * 33]);
                        *(u32x2*)((unsigned char*)Wgu1 + (size_t)(drow + n) * D + k0 + 8 * c8) = o; }
                    asm volatile("s_waitcnt lgkmcnt(0)" ::: "memory"); }
                __syncthreads();
            }
        }
        for (int c = gw; c < D; c += NGW) { const float g = args.in[11][c] * 0.0625f; const f32x4* src = (const f32x4*)(args.in[13] + (size_t)c * D) + lane; u32x2* dst = (u32x2*)(Wcqs + (size_t)c * D) + lane;
#pragma unroll
            for (int j = 0; j < 4; ++j) { const f32x4 v = src[64 * j] * g; u32x2 w; w[0] = cvt_pk_bf16(v[0], v[1]); w[1] = cvt_pk_bf16(v[2], v[3]); dst[64 * j] = w; } }
        for (int m = gw; m < M; m += 4 * NGW) cvt_rows<4, I8_1G ? 2 : (F8_1G ? 1 : 0)>(x_in, XB, X8, SX, SS0, m, NGW, M, lane);
        for (int m = gw; m < MM; m += NGW) cvt_rows<1, 0>(mem_in, MB, nullptr, nullptr, SSM, m, NGW, MM, lane);
        for (int i = gw * 64 + lane; i < NBAT * 16 * 256; i += NGW * 64) KM[i] = 0.f;
    }
    SEAM(0);

    if (IN(1)) {
        MK_PTRS;
        STAGGER();
        { constexpr int EB = (F8_1G || I8_1G) ? 1 : 2;
          SchedStd S; S.o.init(M, 2 * DFF, G, bx); S.A = (F8_1G || I8_1G) ? (const char*)X8 : (const char*)XB; S.B = (const char*)Wgu1; S.a_tile = (size_t)256 * D * EB; S.b_tile = (size_t)256 * D * EB; S.b_batch = 0; S.ocol_mul = 128;
          EpiGU<F8_1G, F8_1D, I8_1G> E{HB, SS0, SX, SW}; pg8::gemm_phase<EpiGU<F8_1G, F8_1D, I8_1G>, SchedStd, true, I8_1G ? 2 : (F8_1G ? 1 : 0)>(lds, D * EB / 2, D * EB / 2, D * EB / 128, S, E); }
    }
    SEAM(1);

    if (IN(2)) {
        MK_PTRS;
        constexpr int EB = F8_1D ? 1 : 2;
        SchedStd S; S.o.init(M, D, G, bx); S.A = (const char*)HB; S.B = (const char*)Wd1; S.a_tile = (size_t)256 * DFF * EB; S.b_tile = (size_t)256 * DFF * EB; S.b_batch = 0; S.ocol_mul = 256;
        EpiRes<false> E{XB, SS1, F8_1D ? 0.5f / (F8_H * F8_WD) : 0.5f, nullptr}; pg8::gemm_phase<EpiRes<false>, SchedStd, true, F8_1D>(lds, DFF * EB / 2, DFF * EB / 2, DFF * EB / 128, S, E);
    }
    SEAM(2);

    if (IN(3)) {
        MK_PTRS;
        { SchedStd S; S.o.init(M, NQKV, G, bx); S.A = (const char*)XB; S.B = (const char*)Win; S.a_tile = (size_t)256 * D * 2; S.b_tile = (size_t)256 * D * 2; S.b_batch = 0; S.ocol_mul = 256;
          EpiStore E{QKV, 0, SS1, KM, false}; pg8::gemm_phase<EpiStore, SchedStd, true>(lds, D, D, D / 64, S, E); }
    }
    SEAM(3);

    if (IN(4)) {
        MK_PTRS;
        constexpr long HSTR4 = (long)SEQ * 128;
        for (int task = gw; task < NBAT * 4 * (SEQ / 32); task += NGW) { const int bh = task / (SEQ / 32), tl = task % (SEQ / 32), b = bh >> 2, hb = bh & 3, q0 = tl * 32, qb = q0 >> 8;
            const char* qbase = (const char*)QKV + ((size_t)b * 48 + 36 + hb) * HSTR4 + (size_t)q0 * 128;
            const unsigned msk = att::moba_select(qbase, 128, KM + (size_t)b * 16 * 256 + hb * 64, qb);
            if (lane < 32) SEL[(size_t)bh * SEQ + q0 + lane] = msk; }
    }
    SEAM(4);

    if (IN(5)) {
        MK_PTRS;
        LAS float* tab = (LAS float*)(lds + LDS_TAB);
        const int h2 = lane >> 5, q = lane & 31;
        const long rowb = 128;
        constexpr long HSTR = (long)SEQ * 128;
#define ATT_WAITV(n) asm volatile("s_waitcnt vmcnt(" #n ")" ::: "memory")
#define ATT_BAR() do { asm volatile("s_waitcnt lgkmcnt(0)" ::: "memory"); __builtin_amdgcn_s_barrier(); asm volatile("" ::: "memory"); } while (0)
        { constexpr int NKV = NBAT * 8;
          struct SchedOne { const char* A; const char* B; int G_, c_; __device__ __forceinline__ bool next(int i, Unit& uu) const { const int idx = i * G_ + c_; if (idx >= NKV) return false; const int pm = idx >> 3, pn = idx & 7;
              uu.a = A + (size_t)pm * 256 * D * 2; uu.b = B + (size_t)pn * 256 * D * 2; uu.orow = pm * 256; uu.ocol = pn * 256; uu.aux = pn; return true; } };
          SchedOne S1{(const char*)MB, (const char*)Wckv, G, vcu};
          EpiStore Ekv{KVC, 2 * D, SSM, nullptr, false}; pg8::gemm_phase<EpiStore, SchedOne, true>(lds, D, D, D / 64, S1, Ekv);
          __syncthreads(); }
        for (int i = tid; i < 4 * att::TABB_N; i += NWAVES * 64) { const int hb = i / att::TABB_N, e = i % att::TABB_N, dist = e - 32;
            tab[i] = dist >= 0 ? rel_bias[att::rel_bucket(dist) * 16 + 12 + hb] * LOG2E : -INFINITY; }
        __syncthreads();
        {
            constexpr int NBH = NBAT * 4, NUNITS = 16 * NBH;
            LAS unsigned* LQ = (LAS unsigned*)(lds + 65536);
            volatile LAS unsigned* UW = (volatile LAS unsigned*)(lds + 65536 + 16384);
            unsigned* qhead = (unsigned*)(ws + WS_CTL) + CW_QUEUE;
#pragma unroll 1
            for (;;) {
                if (tid == 0) UW[8] = __hip_atomic_fetch_add(qhead, 1u, __ATOMIC_RELAXED, __HIP_MEMORY_SCOPE_AGENT);
                ATT_BAR();
                const int u = (int)UW[8];
                if (u >= NUNITS) break;
                const int n = u / NBH, bh = u % NBH, b = bh >> 2, hb = bh & 3;
                const char* qh = (const char*)QKV + ((size_t)b * 48 + 36 + hb) * HSTR;
                const char* kh = (const char*)QKV + ((size_t)b * 48 + 40 + hb) * HSTR + (size_t)(256 * n) * rowb;
                const unsigned* selp = SEL + (size_t)bh * SEQ;
                ATT_WAITV(0);
#pragma unroll
                for (int k = wave; k < 32; k += NWAVES) { const int row = 8 * k + (lane >> 3); att::dma_rows8(kh + (long)row * rowb, (int)(4 * HSTR), row, (LAS char*)(lds + k * 1024), (LAS char*)(lds + 32768 + k * 1024), lane); }
                int total = 0;
                if (n < 15) {
                    const int lo = 256 * (n + 1) + wave * 32 * (15 - n), R = 32 * (15 - n);
                    int cnt = 0;
#pragma unroll 1
                    for (int i = 0; i < R; i += 64) { const bool pr = (i + lane < R) && ((selp[lo + i + lane] >> n) & 1u); cnt += __popcll(__ballot(pr)); }
                    if (lane == 0) UW[wave] = (unsigned)cnt;
                    ATT_BAR();
                    int basew = 0;
#pragma unroll
                    for (int w2 = 0; w2 < NWAVES; ++w2) { const int cw = (int)UW[w2]; basew += (w2 < wave) ? cw : 0; total += cw; }
#pragma unroll 1
                    for (int i = 0; i < R; i += 64) { const bool pr = (i + lane < R) && ((selp[lo + i + lane] >> n) & 1u); const unsigned long long bal = __ballot(pr);
                        if (pr) LQ[basew + __popcll(bal & ((1ull << lane) - 1ull))] = (unsigned)(lo + i + lane); basew += __popcll(bal); }
                }
                const int ntiles = (total + 31) >> 5;
                ATT_WAITV(0); ATT_BAR();
                const LAS float* tb = tab + hb * att::TABB_N;
#pragma unroll 1
                for (int tile = -1; tile < ntiles; tile = (tile < 0 ? wave : tile + NWAVES)) {
                    const bool own = tile < 0;
                    int tq; bool valid = true;
                    if (own) tq = 256 * n + 32 * wave + q; else { const int e = 32 * tile + q; valid = e < total; tq = (int)LQ[valid ? e : total - 1]; }
                    att::bf16x8 qf[4];
#pragma unroll
                    for (int d0 = 0; d0 < 4; ++d0) qf[d0] = *(const att::bf16x8*)(qh + (long)tq * rowb + (16 * d0 + 8 * h2) * 2);
                    const int slot = own ? 3 : __popc(selp[tq] & ((1u << n) - 1u));
                    att::f32x16 o[2]; o[0] = att::f32x16{}; o[1] = att::f32x16{}; float mo = -1e30f, lo_ = 0.f;
                    const int Bq = (tq - 256 * n + 32) - 4 * h2;
#pragma unroll 1
                    for (int g = own ? wave : 7; g >= 0; --g) { int B = Bq - 32 * g; B = B < (att::TABB_N - 1) ? B : (att::TABB_N - 1);
                        att::attn_group(qf, o, mo, lo_, (const LAS char*)(lds + g * 4096), (const LAS char*)(lds + 32768 + g * 4096), tb + B, lane); }
                    lo_ += __shfl_xor(lo_, 32);
                    const size_t prow = (size_t)slot * M + (size_t)b * SEQ + tq;
                    att::store_o<MK_NT_PART>(o, lo_, (char*)OBP + (prow * 256 + hb * 64) * 2, h2, valid);
                    if (h2 == 0 && valid) *(f32x2*)(MLB + (prow * 4 + hb) * 2) = (f32x2){mo, lo_};
                }
                ATT_BAR();
            }
        }
        __syncthreads();
        LAS float* rbl = (LAS float*)(lds + LDS_TAB); LAS float* tabI = (LAS float*)(lds + LDS_TAB + 2048);
        LAS char* ostg = (LAS char*)(lds + LDS_TAB + 3072 + wave * 4096);
        static_assert(LDS_TAB + 3072 + NWAVES * 4096 <= LDS_MISC, "dilated LDS map");
        for (int i = tid; i < 512; i += NWAVES * 64) rbl[i] = rel_bias[i] * LOG2E;
        __syncthreads();
        constexpr int NDIL = NBAT * 12 * 48;
        struct DilItem { int b, h, p, d, res, m0, mbase; };
        auto decode = [&](int it, DilItem& I) { const int bh = it / 48, j = it % 48; I.b = bh / 12; I.h = bh % 12; I.p = j >> 4; const int jj = j & 15;
            I.d = I.p == 0 ? 1 : (I.p == 1 ? 4 : 16); I.res = I.p == 0 ? 0 : (I.p == 1 ? (jj & 3) : jj); const int mblk = I.p == 0 ? jj : (I.p == 1 ? (jj >> 2) : 0);
            I.mbase = mblk * 256 - 128; I.m0 = mblk * 256 + wave * 32; };
        att::bf16x8 qf[4];
        auto issue_k = [&](const DilItem& I) {
            const char* kb = (const char*)QKV + ((size_t)I.b * 48 + 12 + I.h) * HSTR + (size_t)I.res * rowb; const long st = (long)I.d * rowb;
#pragma unroll 1
            for (int k = wave; k < 48; k += NWAVES) { if (I.mbase + 8 * k < 0) continue; const int row = 8 * k + (lane >> 3); att::dma_k_rows8(kb + (long)(I.mbase + row) * st, row, (LAS char*)(lds + k * 1024), lane); } };
        auto issue_v = [&](const DilItem& I) {
            const char* vb = (const char*)QKV + ((size_t)I.b * 48 + 24 + I.h) * HSTR + (size_t)I.res * rowb; const long st = (long)I.d * rowb;
#pragma unroll 1
            for (int k = wave; k < 48; k += NWAVES) { if (I.mbase + 8 * k < 0) continue; const int row = 8 * k + (lane >> 3); att::dma_v_rows8(vb + (long)(I.mbase + row) * st, row, (LAS char*)(lds + 49152 + k * 1024), lane); } };
        auto load_q = [&](const DilItem& I) {
            const char* qp = (const char*)QKV + ((size_t)I.b * 48 + I.h) * HSTR + (size_t)I.res * rowb + (long)I.m0 * I.d * rowb + (long)q * I.d * rowb + 16 * h2;
            asm volatile("global_load_dwordx4 %0, %4, off\n\tglobal_load_dwordx4 %1, %4, off offset:32\n\tglobal_load_dwordx4 %2, %4, off offset:64\n\tglobal_load_dwordx4 %3, %4, off offset:96"
                         : "=&v"(qf[0]), "=&v"(qf[1]), "=&v"(qf[2]), "=&v"(qf[3]) : "v"(qp) : "memory"); };
        auto build_tab = [&](const DilItem& I) { if (tid < att::TABA_N) { const int delta = tid - 32; tabI[tid] = (delta >= 0 && delta <= 128) ? rbl[att::rel_bucket(delta * I.d) * 16 + I.h] : -INFINITY; } };
        att::u32x4 vr[6];
        auto load_v = [&](const DilItem& I) {
            const char* vb = (const char*)QKV + ((size_t)I.b * 48 + 24 + I.h) * HSTR + (size_t)I.res * rowb; const long st = (long)I.d * rowb;
#pragma unroll
            for (int j = 0; j < 6; ++j) { const int k = wave + NWAVES * j; if (I.mbase + 8 * k < 0) continue; const int row = 8 * k + (lane >> 3);
                const char* src = vb + (long)(I.mbase + row) * st + 16 * ((lane & 7) ^ (((row >> 1) & 1) << 2));
                asm volatile("global_load_dwordx4 %0, %1, off" : "=&v"(vr[j]) : "v"(src) : "memory"); } };
        DilItem cur; int it = vcu;
        if (it < NDIL) { decode(it, cur); build_tab(cur); ATT_WAITV(0); issue_k(cur); load_q(cur); issue_v(cur); }
        att::f32x16 po[2]; po[0] = att::f32x16{}; po[1] = att::f32x16{}; float pmo = 0.f, plo = 1.f; DilItem pdone = cur; int pm0 = 0; bool pvalid = false;
#define FLUSH_PREV() do { const size_t tok_ = (size_t)pdone.b * SEQ + (size_t)(pm0 + q) * pdone.d + pdone.res; \
            att::store_o_staged<MK_NT_PART>(po, plo, ostg, (char*)(pdone.p == 0 ? OA0 : (pdone.p == 1 ? OA1 : OA2)) + (((size_t)pdone.b * SEQ + (size_t)pm0 * pdone.d + pdone.res) * 768 + pdone.h * 64) * 2, (long)pdone.d * 768 * 2, lane); \
            if (h2 == 0) *(f32x2*)(ML + (((size_t)pdone.p * M + tok_) * 12 + pdone.h) * 2) = (f32x2){pmo, plo}; } while (0)
#pragma unroll 1
        for (; it < NDIL; it += G) {
            ATT_WAITV(0);
            asm volatile("" : "+v"(qf[0]), "+v"(qf[1]), "+v"(qf[2]), "+v"(qf[3]));
            ATT_BAR();
            const bool has_next = it + G < NDIL; DilItem nxt = cur; if (has_next) decode(it + G, nxt);
            if (pvalid) FLUSH_PREV();
            if (has_next) load_v(nxt);
            const int m0 = cur.m0, gend = (m0 - 128) > 0 ? (m0 - 128) : 0, ng = ((m0 - gend) >> 5) + 1;
            att::u32x4 pw[5][2]; float mo, lo_;
            { att::bf16x8 qc[4] = {qf[0], qf[1], qf[2], qf[3]};
              att::dil_pass1(qc, ng, (const LAS char*)(lds + (m0 - cur.mbase) * 128), tabI + 32 + q - 4 * h2, pw, mo, lo_, lane); }
            ATT_BAR();
            const DilItem done = cur;
            if (has_next) { cur = nxt; issue_k(cur); build_tab(cur); load_q(cur); }
            att::f32x16 o[2];
            att::dil_pass2(ng, (const LAS char*)(lds + 49152 + (m0 - done.mbase) * 128), pw, o, lane);
            ATT_BAR();
            po[0] = o[0]; po[1] = o[1]; pmo = mo; plo = lo_; pdone = done; pm0 = m0; pvalid = true;
            if (has_next) {
                if (cur.mbase < 0) ATT_WAITV(8); else ATT_WAITV(10);
                asm volatile("" : "+v"(vr[0]), "+v"(vr[1]), "+v"(vr[2]), "+v"(vr[3]), "+v"(vr[4]), "+v"(vr[5]));
#pragma unroll
                for (int j = 0; j < 6; ++j) { const int k = wave + NWAVES * j; if (cur.mbase + 8 * k < 0) continue; *(LAS att::u32x4*)(lds + 49152 + k * 1024 + lane * 16) = vr[j]; }
            }
        }
        if (pvalid) FLUSH_PREV();
#undef FLUSH_PREV
#undef ATT_WAITV
#undef ATT_BAR
    }
    SEAM(5);

    if (IN(6)) {
        MK_PTRS;
        for (int row0 = gw; row0 < M; row0 += 2 * NGW) {
            f32x2 ml[2][3][3]; u32x2 oa[2][3][3]; f32x2 mlb[2][4]; u32x2 obp[2][4];
#pragma unroll
            for (int r = 0; r < 2; ++r) { const int row = (row0 + r * NGW) < M ? (row0 + r * NGW) : row0;
#pragma unroll
                for (int k = 0; k < 3; ++k) { const int col = 256 * k + 4 * lane, hd = col >> 6;
#pragma unroll
                    for (int p = 0; p < 3; ++p) ml[r][k][p] = __builtin_nontemporal_load((const f32x2*)(ML + (((size_t)p * M + row) * 12 + hd) * 2));
                    oa[r][k][0] = __builtin_nontemporal_load((const u32x2*)(OA0 + (size_t)row * 768 + col)); oa[r][k][1] = __builtin_nontemporal_load((const u32x2*)(OA1 + (size_t)row * 768 + col)); oa[r][k][2] = __builtin_nontemporal_load((const u32x2*)(OA2 + (size_t)row * 768 + col)); }
#pragma unroll
                for (int s = 0; s < 4; ++s) { mlb[r][s] = __builtin_nontemporal_load((const f32x2*)(MLB + (((size_t)s * M + row) * 4 + (lane >> 4)) * 2)); obp[r][s] = __builtin_nontemporal_load((const u32x2*)(OBP + ((size_t)s * M + row) * 256 + 4 * lane)); } }
            float va[2][3][4], vb[2][4], ssa[2], ssb[2];
#pragma unroll
            for (int r = 0; r < 2; ++r) { ssa[r] = 0.f; ssb[r] = 0.f;
#pragma unroll
                for (int k = 0; k < 3; ++k) {
                    const float Mx = fmaxf(ml[r][k][0][0], fmaxf(ml[r][k][1][0], ml[r][k][2][0]));
                    const float w0 = ml[r][k][0][1] * __builtin_amdgcn_exp2f(ml[r][k][0][0] - Mx), w1 = ml[r][k][1][1] * __builtin_amdgcn_exp2f(ml[r][k][1][0] - Mx), w2 = ml[r][k][2][1] * __builtin_amdgcn_exp2f(ml[r][k][2][0] - Mx);
                    const float iw = 1.0f / (w0 + w1 + w2);
#pragma unroll
                    for (int e = 0; e < 4; ++e) { const unsigned s0 = oa[r][k][0][e >> 1], s1 = oa[r][k][1][e >> 1], s2 = oa[r][k][2][e >> 1];
                        const float f0 = __builtin_bit_cast(float, (e & 1) ? (s0 & 0xffff0000u) : (s0 << 16)), f1 = __builtin_bit_cast(float, (e & 1) ? (s1 & 0xffff0000u) : (s1 << 16)), f2 = __builtin_bit_cast(float, (e & 1) ? (s2 & 0xffff0000u) : (s2 << 16));
                        const float v = (w0 * f0 + w1 * f1 + w2 * f2) * iw; va[r][k][e] = v; ssa[r] += v * v; } }
                { const int rowq = (row0 + r * NGW) < M ? (row0 + r * NGW) : row0, nsel = (((rowq % SEQ) >> 8) < 3) ? ((rowq % SEQ) >> 8) : 3;
                  float wq[4], Mq = -INFINITY;
#pragma unroll
                  for (int s = 0; s < 4; ++s) { const bool use = (s == 3) || (s < nsel); Mq = use ? fmaxf(Mq, mlb[r][s][0]) : Mq; }
                  float wsum = 0.f;
#pragma unroll
                  for (int s = 0; s < 4; ++s) { const bool use = (s == 3) || (s < nsel); wq[s] = use ? mlb[r][s][1] * __builtin_amdgcn_exp2f(mlb[r][s][0] - Mq) : 0.f; wsum += wq[s]; }
                  const float iwq = 1.0f / wsum;
#pragma unroll
                  for (int e = 0; e < 4; ++e) { float acc_ = 0.f;
#pragma unroll
                      for (int s = 0; s < 4; ++s) { const bool use = (s == 3) || (s < nsel); const unsigned s0 = obp[r][s][e >> 1]; const float f = __builtin_bit_cast(float, (e & 1) ? (s0 & 0xffff0000u) : (s0 << 16)); acc_ += use ? wq[s] * f : 0.f; }
                      vb[r][e] = acc_ * iwq; ssb[r] += vb[r][e] * vb[r][e]; } } }
#pragma unroll
            for (int of = 1; of < 64; of <<= 1)
#pragma unroll
                for (int r = 0; r < 2; ++r) { ssa[r] += __shfl_xor(ssa[r], of); ssb[r] += __shfl_xor(ssb[r], of); }
#pragma unroll
            for (int r = 0; r < 2; ++r) { const int row = row0 + r * NGW; if (row < M) {
                const float ra = __builtin_amdgcn_rsqf(ssa[r] * (1.0f / 768.0f) + EPS), rb = __builtin_amdgcn_rsqf(ssb[r] * (1.0f / 256.0f) + EPS);
#pragma unroll
                for (int k = 0; k < 3; ++k) { u32x2 w; w[0] = cvt_pk_bf16(va[r][k][0] * ra, va[r][k][1] * ra); w[1] = cvt_pk_bf16(va[r][k][2] * ra, va[r][k][3] * ra); *(u32x2*)(YN + (size_t)row * D + 256 * k + 4 * lane) = w; }
                { u32x2 w; w[0] = cvt_pk_bf16(vb[r][0] * rb, vb[r][1] * rb); w[1] = cvt_pk_bf16(vb[r][2] * rb, vb[r][3] * rb); *(u32x2*)(YN + (size_t)row * D + 768 + 4 * lane) = w; } } }
        }
    }
    SEAM(6);

    if (IN(7)) {
        MK_PTRS;
        { SchedWK S{G, bx, (const char*)KVC, (const char*)Wcqs}; EpiStore E{WKT, D, nullptr, nullptr, false}; pg8::gemm_phase<EpiStore, SchedWK, true>(lds, 2 * D, D, 4, S, E); }
        { SchedVW S{G, (bx + G / 2) % G, (const char*)KVC, (const char*)Wco}; EpiStore E{VWT, D, nullptr, nullptr, false}; pg8::gemm_phase<EpiStore, SchedVW, true>(lds, D, 2 * D, 4, S, E); }
        SchedStd S; S.o.init(M, D, G, bx); S.A = (const char*)YN; S.B = (const char*)Wout; S.a_tile = (size_t)256 * D * 2; S.b_tile = (size_t)256 * D * 2; S.b_batch = 0; S.ocol_mul = 256;
        EpiRes<false> E{XB, SS2, 1.0f, nullptr}; pg8::gemm_phase<EpiRes<false>, SchedStd, true>(lds, D, D, D / 64, S, E);
    }
    SEAM(7);

    if (IN(8)) {
        MK_PTRS;
        SchedStd S; S.o.init(M, D, G, bx); S.A = (const char*)XB; S.B = (const char*)WKT; S.a_tile = (size_t)256 * D * 2; S.b_tile = (size_t)256 * D * 2; S.b_batch = (size_t)D * D * 2; S.ocol_mul = 256;
        EpiSoftmax E{PB, SS2}; pg8::gemm_phase<EpiSoftmax, SchedStd, true>(lds, D, D, D / 64, S, E);
    }
    SEAM(8);

    if (IN(9)) {
        MK_PTRS;
        SchedStd S; S.o.init(M, D, G, bx); S.A = (const char*)PB; S.B = (const char*)VWT; S.a_tile = (size_t)256 * D * 2; S.b_tile = (size_t)256 * D * 2; S.b_batch = (size_t)D * D * 2; S.ocol_mul = 256;
        EpiRes<F8_2G> E{XB, SS3, 1.0f, X8}; pg8::gemm_phase<EpiRes<F8_2G>, SchedStd, true>(lds, D, D, D / 64, S, E);
    }
    SEAM(9);

    if (IN(10)) {
        MK_PTRS;
        STAGGER();
        constexpr int EB = F8_2G ? 1 : 2;
        SchedStd S; S.o.init(M, 2 * DFF, G, bx); S.A = F8_2G ? (const char*)X8 : (const char*)XB; S.B = (const char*)Wgu2; S.a_tile = (size_t)256 * D * EB; S.b_tile = (size_t)256 * D * EB; S.b_batch = 0; S.ocol_mul = 128;
        EpiGU<F8_2G, F8_2D, false> E{HB, SS3, nullptr, nullptr}; pg8::gemm_phase<EpiGU<F8_2G, F8_2D, false>, SchedStd, true, F8_2G ? 1 : 0>(lds, D * EB / 2, D * EB / 2, D * EB / 128, S, E);
    }
    SEAM(10);

    if (IN(11)) {
        MK_PTRS;
        constexpr int EB = F8_2D ? 1 : 2;
        SchedStd S; S.o.init(M, D, G, bx); S.A = (const char*)HB; S.B = (const char*)Wd2; S.a_tile = (size_t)256 * DFF * EB; S.b_tile = (size_t)256 * DFF * EB; S.b_batch = 0; S.ocol_mul = 256;
        EpiRes<false> E{XB, SS4, F8_2D ? 0.5f / (F8_H * F8_WD) : 0.5f, nullptr}; pg8::gemm_phase<EpiRes<false>, SchedStd, true, F8_2D>(lds, DFF * EB / 2, DFF * EB / 2, DFF * EB / 128, S, E);
    }
    SEAM(11);

    if (IN(12)) {
        MK_PTRS;
        const float* gf = args.in[19];
        for (int row0 = gw; row0 < M; row0 += 4 * NGW) {
            u32x2 w[4][4]; float rs[4]; const f32x4* gr = (const f32x4*)gf + lane;
#pragma unroll
            for (int r = 0; r < 4; ++r) { const int row = (row0 + r * NGW) < M ? (row0 + r * NGW) : row0; const u32x2* xr = (const u32x2*)(XB + (size_t)row * D) + lane;
#pragma unroll
                for (int j = 0; j < 4; ++j) w[r][j] = __builtin_nontemporal_load(xr + 64 * j);
                rs[r] = row_rstd(SS4, row); }
#pragma unroll
            for (int r = 0; r < 4; ++r) { const int row = row0 + r * NGW; if (row < M) { f32x4* orow = (f32x4*)(out + (size_t)row * D) + lane;
#pragma unroll
                for (int j = 0; j < 4; ++j) { f32x4 v; v[0] = __builtin_bit_cast(float, w[r][j][0] << 16); v[1] = __builtin_bit_cast(float, w[r][j][0] & 0xffff0000u); v[2] = __builtin_bit_cast(float, w[r][j][1] << 16); v[3] = __builtin_bit_cast(float, w[r][j][1] & 0xffff0000u);
                    __builtin_nontemporal_store(v * rs[r] * gr[64 * j], orow + 64 * j); } } }
        }
    }
#undef IN
#undef SEAM
}
}


#if MK_DEBUG
namespace dbg {
__global__ void __launch_bounds__(256) cmp_f32(const float* a, const float* r, size_t n, float* acc) {
    float num = 0.f, den = 0.f;
    for (size_t i = (size_t)blockIdx.x * 256 + threadIdx.x; i < n; i += (size_t)gridDim.x * 256) { const float d = a[i] - r[i]; num += d * d; den += r[i] * r[i]; }
    for (int o = 32; o > 0; o >>= 1) { num += __shfl_xor(num, o); den += __shfl_xor(den, o); }
    if ((threadIdx.x & 63) == 0) { atomicAdd(acc, num); atomicAdd(acc + 1, den); }
}
__global__ void __launch_bounds__(256) cmp_bf16(const unsigned short* a, int lda, const float* colscale, const float* r, int ldr, int rows, int cols, float* acc) {
    float num = 0.f, den = 0.f; const size_t n = (size_t)rows * cols;
    for (size_t i = (size_t)blockIdx.x * 256 + threadIdx.x; i < n; i += (size_t)gridDim.x * 256) { const size_t row = i / cols; const int c = (int)(i % cols);
        const float av = __builtin_bit_cast(float, (unsigned)a[row * lda + c] << 16) * (colscale ? colscale[c] : 1.0f); const float rv = r[row * ldr + c]; const float d = av - rv; num += d * d; den += rv * rv; }
    for (int o = 32; o > 0; o >>= 1) { num += __shfl_xor(num, o); den += __shfl_xor(den, o); }
    if ((threadIdx.x & 63) == 0) { atomicAdd(acc, num); atomicAdd(acc + 1, den); }
}
__global__ void __launch_bounds__(256) cmp_p(const unsigned short* a, const float* r, float* acc) {
    float num = 0.f, den = 0.f; const size_t n = (size_t)4096 * 1024;
    for (size_t i = (size_t)blockIdx.x * 256 + threadIdx.x; i < n; i += (size_t)gridDim.x * 256) { const size_t row = i / 1024; const int c = (int)(i % 1024);
        const float av = __builtin_bit_cast(float, (unsigned)a[i] << 16); const float rv = r[(size_t)(c >> 8) * 4096 * 256 + row * 256 + (c & 255)]; const float d = av - rv; num += d * d; den += rv * rv; }
    for (int o = 32; o > 0; o >>= 1) { num += __shfl_xor(num, o); den += __shfl_xor(den, o); }
    if ((threadIdx.x & 63) == 0) { atomicAdd(acc, num); atomicAdd(acc + 1, den); }
}
__global__ void build_scales(float* qkvs, float* gcat, const float* goa, const float* gob) {
    const int i = blockIdx.x * 256 + threadIdx.x;
    if (i < 3072) qkvs[i] = ((i < 768) || (i >= 2304 && i < 2560)) ? 8.0f : 1.0f;
    if (i < 1024) gcat[i] = i < 768 ? goa[i] : gob[i - 768];
}
constexpr int NST = 8;
__global__ void __launch_bounds__(256) finalize(float* out, size_t n, const float* acc, int report) {
    const float tol[NST] = {0.03f, 0.03f, 1e9f  , 0.08f, 0.03f, 0.05f, 0.03f, 0.03f};
    float E = 0.f;
    if (report > 0) { const float e = sqrtf(acc[2 * (report - 1)] / acc[2 * (report - 1) + 1]); E = (e == e) ? fminf(e, 3.0f) : 3.0f; }
    else { for (int k = NST - 1; k >= 0; --k) { const float e = sqrtf(acc[2 * k] / acc[2 * k + 1]); if (!(e <= tol[k])) E = 0.1f * (k + 1); } }
    for (size_t i = (size_t)blockIdx.x * 256 + threadIdx.x; i < n; i += (size_t)gridDim.x * 256) out[i] *= (1.0f + E);
}
}
#endif

static void mk_launch(const mk::Args& a0, int lo, int hi, int grid, hipStream_t st) {
    mk::Args a = a0; a.ph_lo = lo; a.ph_hi = hi;
    hipLaunchKernelGGL(mk::mk_fwd, dim3(grid), dim3(mk::NWAVES * 64), mk::LDS_BYTES, st, a);
    const hipError_t le = hipPeekAtLastError();
    if (le != hipSuccess) fprintf(stderr, "kernel_launch: launch of phases [%d,%d) failed: %s\n", lo, hi, hipGetErrorName(le));
}

extern "C" void kernel_launch(void* const* d_in, const int* in_sizes, int n_in, void* d_out, int out_size, void* d_ws, size_t ws_size, hipStream_t stream) {
    static int grid = 0;
    if (grid == 0) {
        if (n_in != 20 || out_size != 8 * 4096 * 1024) { fprintf(stderr, "kernel_launch: unexpected shapes (n_in %d out %d)\n", n_in, out_size); grid = -1; return; }
        int dev = 0, cus = 0, per_cu = 0;
        if (hipGetDevice(&dev) != hipSuccess || hipDeviceGetAttribute(&cus, hipDeviceAttributeMultiprocessorCount, dev) != hipSuccess) { grid = -1; return; }
        if (hipFuncSetAttribute((const void*)mk::mk_fwd, hipFuncAttributeMaxDynamicSharedMemorySize, mk::LDS_BYTES) != hipSuccess) { fprintf(stderr, "kernel_launch: hipFuncSetAttribute failed\n"); grid = -1; return; }
        if (hipOccupancyMaxActiveBlocksPerMultiprocessor(&per_cu, (const void*)mk::mk_fwd, mk::NWAVES * 64, mk::LDS_BYTES) != hipSuccess || per_cu < 1) fprintf(stderr, "kernel_launch: occupancy query reports %d workgroups per CU\n", per_cu);
        (void)hipGetLastError();
        grid = cus;
    }
    if (grid < 0) return;
    unsigned char* ws = (unsigned char*)d_ws;
#if MK_DEBUG
    const size_t ref_off = (mk::WS_END + 4095) / 4096 * 4096;
    size_t off = ref_off + (size_t)290 * 1024 * 1024;
    auto take = [&](size_t bytes) { unsigned char* p = ws + off; off += (bytes + 255) / 256 * 256; return p; };
    float* sx1 = (float*)take((size_t)4096 * 1024 * 4); float* sx2 = (float*)take((size_t)4096 * 1024 * 4); float* sx3 = (float*)take((size_t)4096 * 1024 * 4);
    float* mkout = (float*)take((size_t)4096 * 1024 * 4); float* qkvs = (float*)take(3072 * 4); float* gcat = (float*)take(1024 * 4); float* acc = (float*)take(256);
    if (off > ws_size) { fprintf(stderr, "kernel_launch: debug build needs %zu bytes of workspace, got %zu\n", off, ws_size); return; }
    ref::Snap snap{sx1, sx2, sx3};
    ref::forward(d_in, (float*)d_out, ws + ref_off, stream, &snap);
    (void)hipMemsetAsync(ws + mk::WS_CTL, 0, mk::CTL_BYTES, stream);
    (void)hipMemsetAsync(acc, 0, 256, stream);
    dbg::build_scales<<<12, 256, 0, stream>>>(qkvs, gcat, (const float*)d_in[8], (const float*)d_in[9]);
    mk::Args a{};
    for (int i = 0; i < 20; ++i) a.in[i] = (const float*)d_in[i];
    a.in[0] = (const float*)d_in[0] + (size_t)7 * 4096 * 1024; a.in[1] = (const float*)d_in[1] + (size_t)7 * 256 * 1024;
    a.out = mkout; a.ws = ws;
    const ref::Bufs& rb = ref::g_bufs;
    for (int ph = 0; ph < mk::NPH; ++ph) {
        mk_launch(a, ph, ph + 1, grid, stream);
        if (ph == 5) dbg::cmp_bf16<<<512, 256, 0, stream>>>((const unsigned short*)(ws + mk::WS_KVC), 2048, nullptr, rb.kvc, 2048, 256, 2048, acc + 0);
        if (ph == 2) dbg::cmp_bf16<<<512, 256, 0, stream>>>((const unsigned short*)(ws + mk::WS_XB), 1024, nullptr, sx1, 1024, 4096, 1024, acc + 2);
        if (ph == 3) dbg::cmp_bf16<<<512, 256, 0, stream>>>((const unsigned short*)(ws + mk::WS_R1), 3072, qkvs, rb.proj, 3072, 4096, 3072, acc + 4);
        if (ph == 6) dbg::cmp_bf16<<<512, 256, 0, stream>>>((const unsigned short*)(ws + mk::WS_R1), 1024, gcat, rb.yn, 1024, 4096, 1024, acc + 6);
        if (ph == 7) dbg::cmp_bf16<<<512, 256, 0, stream>>>((const unsigned short*)(ws + mk::WS_XB), 1024, nullptr, sx2, 1024, 4096, 1024, acc + 8);
        if (ph == 8) dbg::cmp_p<<<512, 256, 0, stream>>>((const unsigned short*)(ws + mk::WS_R1), rb.sc, acc + 10);
        if (ph == 9) dbg::cmp_bf16<<<512, 256, 0, stream>>>((const unsigned short*)(ws + mk::WS_XB), 1024, nullptr, sx3, 1024, 4096, 1024, acc + 12);
        if (ph == 12) dbg::cmp_f32<<<512, 256, 0, stream>>>(mkout, (const float*)d_out + (size_t)7 * 4096 * 1024, (size_t)4096 * 1024, acc + 14);
    }
    dbg::finalize<<<1024, 256, 0, stream>>>((float*)d_out, (size_t)8 * 4096 * 1024, acc, MK_REPORT);
#else
    if (ws_size < mk::WS_END) { fprintf(stderr, "kernel_launch: needs %zu bytes of workspace, got %zu\n", (size_t)mk::WS_END, ws_size); return; }
    if (hipMemsetAsync(ws + mk::WS_CTL, 0, mk::CTL_BYTES, stream) != hipSuccess) return;
    mk::Args a{};
    for (int i = 0; i < 20; ++i) a.in[i] = (const float*)d_in[i];
    a.out = (float*)d_out; a.ws = ws;
#if MK_N_LAUNCHES == 1
    mk_launch(a, 0, mk::NPH, grid, stream);
#else
    for (int ph = 0; ph < mk::NPH; ++ph) {
        for (int r = 0; r < MK_REPEAT_N; ++r) if (ph == MK_REPEAT) { mk::Args a2 = a; a2.flags = MK_REPEAT_FLAGS; mk_launch(a2, ph, ph + 1, grid, stream); }
        mk_launch(a, ph, ph + 1, grid, stream); }
#endif
#endif
}
```

```cpp
#include <hip/hip_runtime.h>
#include <cstdio>
#include <cstdint>
#include <cmath>
#define MK_REPEAT -1
#define MK_REPEAT_N 1
#define MK_REPEAT_FLAGS 0
#define MK_STAGGER_TICKS 0
#define MK_NT_PART false
#define MK_TIMING 0
#define MK_TQ 0.02f
#define MK_PROBE_SAME 0
#define MK_FP8_FFN1 6
#define MK_FP8_FFN2 3
#define MK_DEBUG 0
#define MK_REPORT 0
#define MK_N_LAUNCHES 1
#define MK_NBAT 8

namespace pg8 {
#define PG8_LAS __attribute__((address_space(3)))
typedef unsigned short bf16_t;
typedef short bf16x8 __attribute__((ext_vector_type(8)));
typedef float f32x4 __attribute__((ext_vector_type(4)));
typedef float f32x2 __attribute__((ext_vector_type(2)));
typedef unsigned u32x4 __attribute__((ext_vector_type(4)));
typedef unsigned u32x2 __attribute__((ext_vector_type(2)));
typedef int i32x4 __attribute__((ext_vector_type(4)));
typedef int i32x8 __attribute__((ext_vector_type(8)));
constexpr int BM = 256, BK = 64, HALF = 128, HTB = HALF * BK * 2  , STAGE_BYTES = 8 * HTB, NXCD = 8, WGM = 8;

__host__ __device__ __forceinline__ int lds_byte(int r, int c) { const int st = (r >> 4) * 2 + (c >> 5), rr = r & 15, cc = c & 31, ob = rr * 64 + cc * 2; return st * 1024 + (ob ^ (((ob >> 9) & 1) << 5)); }
__host__ __device__ __forceinline__ void stage_rc(int b, int& R, int& C) { const int st = b / 1024, sb = b % 1024, swz = sb ^ (((sb >> 9) & 1) << 5); R = (st >> 1) * 16 + swz / 64; C = (st & 1) * 32 + (swz % 64) / 2; }
__host__ __device__ __forceinline__ int perm32(int rho) { const int n = rho >> 4, i = rho & 15; return 8 * (i >> 2) + 4 * n + (i & 3); }

struct Unit { const char* a; const char* b; int orow, ocol, aux; };

struct Order {
    int nM, nN, nwg, G, c;
    __device__ __forceinline__ void init(int M, int N, int G_, int c_) { nM = M / BM; nN = N / BM; nwg = nM * nN; G = G_; c = c_; }
    __device__ __forceinline__ bool tile(int i, int& pm, int& pn) const {
        const long L = (long)i * G + c; if (L >= nwg) return false;
        int wgid = (int)L; { const int q = nwg / NXCD, r = nwg % NXCD, xcd = wgid % NXCD, off = wgid / NXCD; wgid = (xcd < r ? xcd * (q + 1) : r * (q + 1) + (xcd - r) * q) + off; }
        const int nig = WGM * nN, gid = wgid / nig, fm = gid * WGM, gsz = (nM - fm) < WGM ? (nM - fm) : WGM;
        pm = fm + ((wgid % nig) % gsz); pn = (wgid % nig) / gsz; return true;
    }
};

__device__ __forceinline__ unsigned cvt_pk_bf16(float lo, float hi) { unsigned r; asm volatile("v_cvt_pk_bf16_f32 %0, %1, %2" : "=v"(r) : "v"(lo), "v"(hi)); return r; }

template <class Epi, class Sched, bool ALIGN_EPI, int MODE = 0>
__device__ __forceinline__ void gemm_phase(PG8_LAS unsigned char* lds, const int lda, const int ldb, const int nt, const Sched& S, const Epi& E) {
    int tid_ = threadIdx.x; asm volatile("" : "+v"(tid_));
    const int tid = tid_, wid = __builtin_amdgcn_readfirstlane(tid >> 6), lane = tid & 63, wr = wid >> 2, wc = wid & 3, fr = lane & 15, fq = lane >> 4;
    unsigned voffA[2], voffB[2];
#pragma unroll
    for (int i = 0; i < 2; ++i) { int R, C; stage_rc(tid * 16 + i * 8192, R, C); const int Rb = Epi::PERM ? ((R & ~31) + perm32(R & 31)) : R;
        voffA[i] = (unsigned)(R * lda + C) * 2u; voffB[i] = (unsigned)(Rb * ldb + C) * 2u; }
    const size_t kstep = (size_t)(BK * 2);
    const size_t hstepA = (size_t)HALF * lda * 2, hstepB = (size_t)HALF * ldb * 2;
    const unsigned ldsw = (unsigned)wid * 1024u;
    const int aoff = lds_byte(wr * 64 + fr, fq * 8), boff = lds_byte(wc * 32 + fr, fq * 8);
#define PG8_SA(b, h) (((b) * 2 + (h)) * HTB)
#define PG8_SB(b, h) ((4 + (b) * 2 + (h)) * HTB)
#define PG8_STAGE(bufoff, gbase, voff) do { _Pragma("unroll") for (int _i = 0; _i < 2; ++_i) \
        __builtin_amdgcn_global_load_lds((const unsigned*)((const char*)(gbase) + (voff)[_i]), (PG8_LAS unsigned*)(lds + (bufoff) + ldsw + _i * 8192), 16, 0, 0); } while (0)
#define PG8_LDA(dst, b, h) do { _Pragma("unroll") for (int m = 0; m < 4; ++m) _Pragma("unroll") for (int k = 0; k < 2; ++k) dst[m][k] = *(const PG8_LAS bf16x8*)(lds + PG8_SA(b, h) + aoff + m * 2048 + k * 1024); } while (0)
#define PG8_LDB(dst, b, h) do { _Pragma("unroll") for (int n = 0; n < 2; ++n) _Pragma("unroll") for (int k = 0; k < 2; ++k) dst[n][k] = *(const PG8_LAS bf16x8*)(lds + PG8_SB(b, h) + boff + n * 2048 + k * 1024); } while (0)
#define PG8_MMA(ai, bj, At, Bt) do { __builtin_amdgcn_s_setprio(1); _Pragma("unroll") for (int m = 0; m < 4; ++m) _Pragma("unroll") for (int n = 0; n < 2; ++n) { \
        if constexpr (FP8) { const i32x8 bb_ = __builtin_shufflevector(__builtin_bit_cast(i32x4, Bt[n][0]), __builtin_bit_cast(i32x4, Bt[n][1]), 0, 1, 2, 3, 4, 5, 6, 7); \
            const i32x8 aa_ = __builtin_shufflevector(__builtin_bit_cast(i32x4, At[m][0]), __builtin_bit_cast(i32x4, At[m][1]), 0, 1, 2, 3, 4, 5, 6, 7); \
            asm volatile("v_mfma_scale_f32_16x16x128_f8f6f4 %0, %1, %2, %0, %3, %3 op_sel_hi:[0,0,0]" : "+v"(acc[ai][bj][m][n]) : "v"(bb_), "v"(aa_), "v"(sc1)); } \
        else if constexpr (I8) { _Pragma("unroll") for (int k = 0; k < 2; ++k) acc[ai][bj][m][n] = __builtin_bit_cast(f32x4, __builtin_amdgcn_mfma_i32_16x16x64_i8(__builtin_bit_cast(i32x4, Bt[n][k]), __builtin_bit_cast(i32x4, At[m][k]), __builtin_bit_cast(i32x4, acc[ai][bj][m][n]), 0, 0, 0)); } \
        else { _Pragma("unroll") for (int k = 0; k < 2; ++k) acc[ai][bj][m][n] = __builtin_amdgcn_mfma_f32_16x16x32_bf16(Bt[n][k], At[m][k], acc[ai][bj][m][n], 0, 0, 0); } } \
        __builtin_amdgcn_s_setprio(0); } while (0)
#define PG8_WAIT_V(n) asm volatile("s_waitcnt vmcnt(" #n ")" ::: "memory")
#define PG8_WAIT_L(n) asm volatile("s_waitcnt lgkmcnt(" #n ")" ::: "memory")
#define PG8_BAR __builtin_amdgcn_s_barrier()
#define PG8_SCHED __builtin_amdgcn_sched_barrier(0)
    constexpr bool FP8 = MODE == 1, I8 = MODE == 2;
    int sc1 = 0x7F7F7F7F; asm volatile("" : "+v"(sc1)); (void)sc1;
    Unit cur, nxt; int ui = 0;
    if (!S.next(0, cur)) return;
    f32x4 acc[2][2][4][2];
#pragma unroll
    for (int a = 0; a < 2; ++a)
#pragma unroll
        for (int b = 0; b < 2; ++b)
#pragma unroll
            for (int m = 0; m < 4; ++m)
#pragma unroll
                for (int n = 0; n < 2; ++n) acc[a][b][m][n] = (f32x4){0.f, 0.f, 0.f, 0.f};
    bf16x8 At[4][2], B0[2][2], B1[2][2];
    const char* cA = cur.a; const char* cB = cur.b;
    PG8_STAGE(PG8_SB(0, 0), cB, voffB); PG8_STAGE(PG8_SB(0, 1), cB + hstepB, voffB); PG8_STAGE(PG8_SA(0, 0), cA, voffA); PG8_STAGE(PG8_SA(0, 1), cA + hstepA, voffA);
    if (wr == 1) PG8_BAR;
    PG8_WAIT_V(2); PG8_BAR;
    PG8_STAGE(PG8_SB(1, 0), cB + kstep, voffB); PG8_STAGE(PG8_SA(1, 0), cA + kstep, voffA); PG8_STAGE(PG8_SB(1, 1), cB + hstepB + kstep, voffB);
    PG8_WAIT_V(6); PG8_BAR;
    for (;;) {
        const bool has_next = S.next(ui + 1, nxt);
        const char* nA = has_next ? nxt.a : cA; const char* nB = has_next ? nxt.b : cB;
#pragma unroll 1
        for (int t = 0; t < nt; t += 2) {
            const bool last = (t == nt - 2);
            const char* a1 = cA + (size_t)(t + 1) * kstep;
            const char* a2 = last ? nA : cA + (size_t)(t + 2) * kstep; const char* b2 = last ? nB : cB + (size_t)(t + 2) * kstep;
            const char* a3 = a2 + kstep; const char* b3 = b2 + kstep;
            PG8_LDB(B0, 0, 0); PG8_LDB(B1, 0, 1); PG8_SCHED; PG8_LDA(At, 0, 0); PG8_STAGE(PG8_SA(1, 1), a1 + hstepA, voffA);
            PG8_WAIT_V(8); PG8_WAIT_L(0); PG8_BAR; PG8_MMA(0, 0, At, B0); PG8_MMA(0, 1, At, B1); PG8_BAR; PG8_SCHED;
            PG8_LDA(At, 0, 1); PG8_STAGE(PG8_SB(0, 0), b2, voffB); PG8_STAGE(PG8_SB(0, 1), b2 + hstepB, voffB); PG8_STAGE(PG8_SA(0, 0), a2, voffA);
            PG8_WAIT_V(8); PG8_WAIT_L(0); PG8_BAR; PG8_MMA(1, 0, At, B0); PG8_MMA(1, 1, At, B1); PG8_BAR; PG8_SCHED;
            PG8_LDB(B0, 1, 0); PG8_LDB(B1, 1, 1); PG8_SCHED; PG8_LDA(At, 1, 0); PG8_STAGE(PG8_SA(0, 1), a2 + hstepA, voffA);
            PG8_WAIT_V(8); PG8_WAIT_L(0); PG8_BAR; PG8_MMA(0, 0, At, B0); PG8_MMA(0, 1, At, B1); PG8_BAR; PG8_SCHED;
            PG8_LDA(At, 1, 1); PG8_STAGE(PG8_SB(1, 0), b3, voffB); PG8_STAGE(PG8_SB(1, 1), b3 + hstepB, voffB); PG8_STAGE(PG8_SA(1, 0), a3, voffA);
            PG8_WAIT_V(8); PG8_WAIT_L(0); PG8_BAR; PG8_MMA(1, 0, At, B0); PG8_MMA(1, 1, At, B1); PG8_BAR; PG8_SCHED;
        }
        if constexpr (ALIGN_EPI) { if (wr == 0) PG8_BAR; }
        if constexpr (FP8) asm volatile("s_nop 15\n\ts_nop 7" ::: "memory");
        E(acc, cur, wr, wc, fr, fq, lds, wid, lane);
        if (!has_next) break;
#pragma unroll
        for (int a = 0; a < 2; ++a)
#pragma unroll
            for (int b = 0; b < 2; ++b)
#pragma unroll
                for (int m = 0; m < 4; ++m)
#pragma unroll
                    for (int n = 0; n < 2; ++n) acc[a][b][m][n] = (f32x4){0.f, 0.f, 0.f, 0.f};
        cur = nxt; cA = nA; cB = nB; ++ui;
        if constexpr (ALIGN_EPI) { if (wr == 1) PG8_BAR; }
    }
    PG8_WAIT_V(0);
    if constexpr (!ALIGN_EPI) { if (wr == 0) PG8_BAR; }
    PG8_BAR;
#undef PG8_SA
#undef PG8_SB
#undef PG8_STAGE
#undef PG8_LDA
#undef PG8_LDB
#undef PG8_MMA
#undef PG8_WAIT_V
#undef PG8_WAIT_L
#undef PG8_BAR
#undef PG8_SCHED
}
}

namespace att {
#define ATT_LAS __attribute__((address_space(3)))
typedef short bf16x8 __attribute__((ext_vector_type(8)));
typedef short v4i16 __attribute__((ext_vector_type(4)));
typedef float f32x16 __attribute__((ext_vector_type(16)));
typedef float f32x4 __attribute__((ext_vector_type(4)));
typedef unsigned u32x4 __attribute__((ext_vector_type(4)));
typedef unsigned u32x2 __attribute__((ext_vector_type(2)));
constexpr float LOG2E = 1.4426950408889634f;
constexpr int TABA_N = 192, TABB_N = 1600;

__device__ __forceinline__ int rel_bucket(int n) {
    if (n < 16) return n < 0 ? 0 : n;
    int b = 16;
    b += (n >= 22); b += (n >= 30); b += (n >= 40); b += (n >= 54); b += (n >= 73); b += (n >= 99); b += (n >= 134); b += (n >= 182);
    b += (n >= 246); b += (n >= 332); b += (n >= 450); b += (n >= 609); b += (n >= 825); b += (n >= 1117); b += (n >= 1513);
    return b;
}
__device__ __forceinline__ unsigned pk_bf16(float lo, float hi) { unsigned r; asm volatile("v_cvt_pk_bf16_f32 %0, %1, %2" : "=v"(r) : "v"(lo), "v"(hi)); return r; }
__device__ __forceinline__ float bf16_round(float x) { unsigned u = __builtin_bit_cast(unsigned, x); u = (u + 0x7fffu + ((u >> 16) & 1u)) & 0xffff0000u; return __builtin_bit_cast(float, u); }

__device__ __forceinline__ void glds16(const void* gsrc, unsigned lds_dst) { unsigned keep;
    asm volatile("s_mov_b32 %0, m0\n\ts_mov_b32 m0, %2\n\ts_nop 0\n\tglobal_load_lds_dwordx4 %1, off\n\ts_mov_b32 m0, %0" : "=&s"(keep) : "v"(gsrc), "s"(lds_dst) : "memory"); }
__device__ __forceinline__ void dma_rows8(const char* krow0  , const int voff, const int row  ,
                                          ATT_LAS char* kdst  , ATT_LAS char* vdst, const int lane) {
    const int pc = lane & 7;
    glds16(krow0 + 16 * (pc ^ ((row >> 1) & 7)), (unsigned)__builtin_amdgcn_readfirstlane((int)(unsigned)(uintptr_t)kdst));
    glds16(krow0 + voff + 16 * (pc ^ (((row >> 1) & 1) << 2)), (unsigned)__builtin_amdgcn_readfirstlane((int)(unsigned)(uintptr_t)vdst));
}

__device__ __forceinline__ void attn_group(const bf16x8 (&qf)[4], f32x16 (&o)[2], float& m, float& l, const ATT_LAS char* kg, const ATT_LAS char* vg, const ATT_LAS float* tp, const int lane) {
    const int q = lane & 31, h = lane >> 5;
    const ATT_LAS char* kr0 = kg + q * 128; const int kswz = (q >> 1) & 7;
    typedef float f32x2_ __attribute__((ext_vector_type(2)));
    f32x2_ t0, t1, t2, t3, t4, t5, t6, t7;
    { const unsigned ta = (unsigned)(uintptr_t)(tp - 27);
      asm volatile("ds_read2_b32 %0, %8 offset0:27 offset1:26\n\tds_read2_b32 %1, %8 offset0:25 offset1:24\n\tds_read2_b32 %2, %8 offset0:19 offset1:18\n\tds_read2_b32 %3, %8 offset0:17 offset1:16\n\t"
                   "ds_read2_b32 %4, %8 offset0:11 offset1:10\n\tds_read2_b32 %5, %8 offset0:9 offset1:8\n\tds_read2_b32 %6, %8 offset0:3 offset1:2\n\tds_read2_b32 %7, %8 offset0:1 offset1:0"
                   : "=&v"(t0), "=&v"(t1), "=&v"(t2), "=&v"(t3), "=&v"(t4), "=&v"(t5), "=&v"(t6), "=&v"(t7) : "v"(ta) : "memory"); }
    const int q4 = (lane & 15) >> 2, p4 = lane & 3, g1 = (lane >> 4) & 1, vsw = (q4 >> 1) & 1;
    const unsigned va0_ = (unsigned)(uintptr_t)(vg + (4 * h + q4) * 128 + 32 * g1 + 8 * p4 + 64 * vsw), va1_ = (unsigned)(uintptr_t)(vg + (4 * h + q4) * 128 + 32 * g1 + 8 * p4 + 64 * (1 ^ vsw));
    v4i16 a[2][4];
    asm volatile("ds_read_b64_tr_b16 %0, %8\n\tds_read_b64_tr_b16 %1, %8 offset:1024\n\tds_read_b64_tr_b16 %2, %8 offset:2048\n\tds_read_b64_tr_b16 %3, %8 offset:3072\n\t"
                 "ds_read_b64_tr_b16 %4, %9\n\tds_read_b64_tr_b16 %5, %9 offset:1024\n\tds_read_b64_tr_b16 %6, %9 offset:2048\n\tds_read_b64_tr_b16 %7, %9 offset:3072"
                 : "=&v"(a[0][0]), "=&v"(a[0][1]), "=&v"(a[0][2]), "=&v"(a[0][3]), "=&v"(a[1][0]), "=&v"(a[1][1]), "=&v"(a[1][2]), "=&v"(a[1][3]) : "v"(va0_), "v"(va1_) : "memory");
    f32x16 s = f32x16{};
#pragma unroll
    for (int d0 = 0; d0 < 4; ++d0) { const bf16x8 kf = *(const ATT_LAS bf16x8*)(kr0 + 16 * ((2 * d0 + h) ^ kswz)); s = __builtin_amdgcn_mfma_f32_32x32x16_bf16(kf, qf[d0], s, 0, 0, 0); }
    asm volatile("s_waitcnt lgkmcnt(0)" : "+v"(t0), "+v"(t1), "+v"(t2), "+v"(t3), "+v"(t4), "+v"(t5), "+v"(t6), "+v"(t7), "+v"(a[0][0]), "+v"(a[0][1]), "+v"(a[0][2]), "+v"(a[0][3]), "+v"(a[1][0]), "+v"(a[1][1]), "+v"(a[1][2]), "+v"(a[1][3]) :: "memory");
    float mx = -INFINITY;
    { const float tb_[16] = {t0[0], t0[1], t1[0], t1[1], t2[0], t2[1], t3[0], t3[1], t4[0], t4[1], t5[0], t5[1], t6[0], t6[1], t7[0], t7[1]};
#pragma unroll
      for (int r = 0; r < 16; ++r) s[r] = fmaf(s[r], LOG2E, tb_[r]); }
#pragma unroll
    for (int r = 0; r < 16; r += 2) mx = fmaxf(mx, fmaxf(s[r], s[r + 1]));
    mx = fmaxf(mx, __shfl_xor(mx, 32));
    if (__any(mx > m)) {
        const float mnew = fmaxf(m, mx), alpha = __builtin_amdgcn_exp2f(m - mnew);
        l *= alpha; m = mnew;
#pragma unroll
        for (int r = 0; r < 16; ++r) { o[0][r] *= alpha; o[1][r] *= alpha; }
    }
    float ps = 0.f;
#pragma unroll
    for (int r = 0; r < 16; ++r) { s[r] = __builtin_amdgcn_exp2f(s[r] - m); ps += s[r]; }
    l += ps;
    u32x4 pw0, pw1;
    pw0[0] = pk_bf16(s[0], s[1]); pw0[1] = pk_bf16(s[2], s[3]); pw0[2] = pk_bf16(s[4], s[5]); pw0[3] = pk_bf16(s[6], s[7]);
    pw1[0] = pk_bf16(s[8], s[9]); pw1[1] = pk_bf16(s[10], s[11]); pw1[2] = pk_bf16(s[12], s[13]); pw1[3] = pk_bf16(s[14], s[15]);
    const bf16x8 pb0 = __builtin_bit_cast(bf16x8, pw0), pb1 = __builtin_bit_cast(bf16x8, pw1);
#pragma unroll
    for (int dh = 0; dh < 2; ++dh) {
        const bf16x8 va0 = (bf16x8){a[dh][0][0], a[dh][0][1], a[dh][0][2], a[dh][0][3], a[dh][1][0], a[dh][1][1], a[dh][1][2], a[dh][1][3]};
        const bf16x8 va1 = (bf16x8){a[dh][2][0], a[dh][2][1], a[dh][2][2], a[dh][2][3], a[dh][3][0], a[dh][3][1], a[dh][3][2], a[dh][3][3]};
        o[dh] = __builtin_amdgcn_mfma_f32_32x32x16_bf16(va0, pb0, o[dh], 0, 0, 0);
        o[dh] = __builtin_amdgcn_mfma_f32_32x32x16_bf16(va1, pb1, o[dh], 0, 0, 0);
    }
}

__device__ __forceinline__ void dma_k_rows8(const char* krow, const int row, ATT_LAS char* kdst, const int lane) {
    glds16(krow + 16 * ((lane & 7) ^ ((row >> 1) & 7)), (unsigned)__builtin_amdgcn_readfirstlane((int)(unsigned)(uintptr_t)kdst)); }
__device__ __forceinline__ void dma_v_rows8(const char* vrow, const int row, ATT_LAS char* vdst, const int lane) {
    glds16(vrow + 16 * ((lane & 7) ^ (((row >> 1) & 1) << 2)), (unsigned)__builtin_amdgcn_readfirstlane((int)(unsigned)(uintptr_t)vdst)); }
__device__ __forceinline__ void dil_pass1(const bf16x8 (&qf)[4], const int ng, const ATT_LAS char* kimg0  , const ATT_LAS float* tp0  ,
                                          u32x4 (&pw)[5][2], float& m_out, float& l_out, const int lane) {
    const int q = lane & 31, h = lane >> 5, kswz = (q >> 1) & 7;
    typedef float f32x2_ __attribute__((ext_vector_type(2)));
    f32x16 s[5]; float mx = -INFINITY;
#pragma unroll
    for (int g = 0; g < 5; ++g) if (g < ng) {
        f32x2_ t0, t1, t2, t3, t4, t5, t6, t7;
        { const unsigned ta = (unsigned)(uintptr_t)(tp0 + 32 * g - 27);
          asm volatile("ds_read2_b32 %0, %8 offset0:27 offset1:26\n\tds_read2_b32 %1, %8 offset0:25 offset1:24\n\tds_read2_b32 %2, %8 offset0:19 offset1:18\n\tds_read2_b32 %3, %8 offset0:17 offset1:16\n\t"
                       "ds_read2_b32 %4, %8 offset0:11 offset1:10\n\tds_read2_b32 %5, %8 offset0:9 offset1:8\n\tds_read2_b32 %6, %8 offset0:3 offset1:2\n\tds_read2_b32 %7, %8 offset0:1 offset1:0"
                       : "=&v"(t0), "=&v"(t1), "=&v"(t2), "=&v"(t3), "=&v"(t4), "=&v"(t5), "=&v"(t6), "=&v"(t7) : "v"(ta) : "memory"); }
        const ATT_LAS char* kr0 = kimg0 - g * 4096 + q * 128;
        f32x16 sg = f32x16{};
#pragma unroll
        for (int d0 = 0; d0 < 4; ++d0) { const bf16x8 kf = *(const ATT_LAS bf16x8*)(kr0 + 16 * ((2 * d0 + h) ^ kswz)); sg = __builtin_amdgcn_mfma_f32_32x32x16_bf16(kf, qf[d0], sg, 0, 0, 0); }
        asm volatile("s_waitcnt lgkmcnt(0)" : "+v"(t0), "+v"(t1), "+v"(t2), "+v"(t3), "+v"(t4), "+v"(t5), "+v"(t6), "+v"(t7) :: "memory");
        const float tb_[16] = {t0[0], t0[1], t1[0], t1[1], t2[0], t2[1], t3[0], t3[1], t4[0], t4[1], t5[0], t5[1], t6[0], t6[1], t7[0], t7[1]};
#pragma unroll
        for (int r = 0; r < 16; ++r) sg[r] = fmaf(sg[r], LOG2E, tb_[r]);
#pragma unroll
        for (int r = 0; r < 16; r += 2) mx = fmaxf(mx, fmaxf(sg[r], sg[r + 1]));
        s[g] = sg;
    }
    mx = fmaxf(mx, __shfl_xor(mx, 32));
    float ps = 0.f;
#pragma unroll
    for (int g = 0; g < 5; ++g) if (g < ng) {
        f32x16 p = s[g];
#pragma unroll
        for (int r = 0; r < 16; ++r) { p[r] = __builtin_amdgcn_exp2f(p[r] - mx); ps += p[r]; }
        pw[g][0][0] = pk_bf16(p[0], p[1]); pw[g][0][1] = pk_bf16(p[2], p[3]); pw[g][0][2] = pk_bf16(p[4], p[5]); pw[g][0][3] = pk_bf16(p[6], p[7]);
        pw[g][1][0] = pk_bf16(p[8], p[9]); pw[g][1][1] = pk_bf16(p[10], p[11]); pw[g][1][2] = pk_bf16(p[12], p[13]); pw[g][1][3] = pk_bf16(p[14], p[15]);
    }
    ps += __shfl_xor(ps, 32);
    m_out = mx; l_out = ps;
}
__device__ __forceinline__ void dil_pass2(const int ng, const ATT_LAS char* vimg0  , const u32x4 (&pw)[5][2], f32x16 (&o)[2], const int lane) {
    const int h = lane >> 5, q4 = (lane & 15) >> 2, p4 = lane & 3, g1 = (lane >> 4) & 1, vsw = (q4 >> 1) & 1;
    o[0] = f32x16{}; o[1] = f32x16{};
#pragma unroll
    for (int g = 0; g < 5; ++g) if (g < ng) {
        const ATT_LAS char* vg = vimg0 - g * 4096;
        const unsigned va0_ = (unsigned)(uintptr_t)(vg + (4 * h + q4) * 128 + 32 * g1 + 8 * p4 + 64 * vsw), va1_ = (unsigned)(uintptr_t)(vg + (4 * h + q4) * 128 + 32 * g1 + 8 * p4 + 64 * (1 ^ vsw));
        v4i16 a[2][4];
        asm volatile("ds_read_b64_tr_b16 %0, %8\n\tds_read_b64_tr_b16 %1, %8 offset:1024\n\tds_read_b64_tr_b16 %2, %8 offset:2048\n\tds_read_b64_tr_b16 %3, %8 offset:3072\n\t"
                     "ds_read_b64_tr_b16 %4, %9\n\tds_read_b64_tr_b16 %5, %9 offset:1024\n\tds_read_b64_tr_b16 %6, %9 offset:2048\n\tds_read_b64_tr_b16 %7, %9 offset:3072\n\ts_waitcnt lgkmcnt(0)"
                     : "=&v"(a[0][0]), "=&v"(a[0][1]), "=&v"(a[0][2]), "=&v"(a[0][3]), "=&v"(a[1][0]), "=&v"(a[1][1]), "=&v"(a[1][2]), "=&v"(a[1][3]) : "v"(va0_), "v"(va1_) : "memory");
        const bf16x8 pb0 = __builtin_bit_cast(bf16x8, pw[g][0]), pb1 = __builtin_bit_cast(bf16x8, pw[g][1]);
#pragma unroll
        for (int dh = 0; dh < 2; ++dh) {
            const bf16x8 va0 = (bf16x8){a[dh][0][0], a[dh][0][1], a[dh][0][2], a[dh][0][3], a[dh][1][0], a[dh][1][1], a[dh][1][2], a[dh][1][3]};
            const bf16x8 va1 = (bf16x8){a[dh][2][0], a[dh][2][1], a[dh][2][2], a[dh][2][3], a[dh][3][0], a[dh][3][1], a[dh][3][2], a[dh][3][3]};
            o[dh] = __builtin_amdgcn_mfma_f32_32x32x16_bf16(va0, pb0, o[dh], 0, 0, 0);
            o[dh] = __builtin_amdgcn_mfma_f32_32x32x16_bf16(va1, pb1, o[dh], 0, 0, 0);
        }
    }
}

template <bool NT>
__device__ __forceinline__ void store_o(const f32x16 (&o)[2], const float l, char* orow_q, const int h, const bool valid = true) {
    const float il = 1.0f / l;
#pragma unroll
    for (int dh = 0; dh < 2; ++dh)
#pragma unroll
        for (int jj = 0; jj < 2; ++jj) {
            u32x2 we, wo;
            we[0] = pk_bf16(o[dh][8 * jj] * il, o[dh][8 * jj + 1] * il); we[1] = pk_bf16(o[dh][8 * jj + 2] * il, o[dh][8 * jj + 3] * il);
            wo[0] = pk_bf16(o[dh][8 * jj + 4] * il, o[dh][8 * jj + 5] * il); wo[1] = pk_bf16(o[dh][8 * jj + 6] * il, o[dh][8 * jj + 7] * il);
            const unsigned s0 = h ? we[0] : wo[0], s1 = h ? we[1] : wo[1];
            const unsigned r0 = (unsigned)__shfl_xor((int)s0, 32), r1 = (unsigned)__shfl_xor((int)s1, 32);
            u32x4 w; if (h == 0) { w[0] = we[0]; w[1] = we[1]; w[2] = r0; w[3] = r1; } else { w[0] = r0; w[1] = r1; w[2] = wo[0]; w[3] = wo[1]; }
            u32x4* dst = (u32x4*)(orow_q + (32 * dh + 16 * jj + 8 * h) * 2);
            if (valid) { if (NT) __builtin_nontemporal_store(w, dst); else *dst = w; }
        }
}

template <bool NT>
__device__ __forceinline__ void store_o_staged(const f32x16 (&o)[2], const float l, ATT_LAS char* stg, char* base, const long rstride, const int lane) {
    const int q = lane & 31, h = lane >> 5; const float il = 1.0f / l;
#pragma unroll
    for (int dh = 0; dh < 2; ++dh)
#pragma unroll
        for (int jj = 0; jj < 2; ++jj) {
            u32x2 we, wo;
            we[0] = pk_bf16(o[dh][8 * jj] * il, o[dh][8 * jj + 1] * il); we[1] = pk_bf16(o[dh][8 * jj + 2] * il, o[dh][8 * jj + 3] * il);
            wo[0] = pk_bf16(o[dh][8 * jj + 4] * il, o[dh][8 * jj + 5] * il); wo[1] = pk_bf16(o[dh][8 * jj + 6] * il, o[dh][8 * jj + 7] * il);
            const unsigned s0 = h ? we[0] : wo[0], s1 = h ? we[1] : wo[1];
            const unsigned r0 = (unsigned)__shfl_xor((int)s0, 32), r1 = (unsigned)__shfl_xor((int)s1, 32);
            u32x4 w; if (h == 0) { w[0] = we[0]; w[1] = we[1]; w[2] = r0; w[3] = r1; } else { w[0] = r0; w[1] = r1; w[2] = wo[0]; w[3] = wo[1]; }
            *(ATT_LAS u32x4*)(stg + q * 128 + 16 * ((4 * dh + 2 * jj + h) ^ (q & 7))) = w;
        }
    asm volatile("s_waitcnt lgkmcnt(0)" ::: "memory");
#pragma unroll
    for (int i = 0; i < 4; ++i) { const int r = 8 * i + (lane >> 3), c = lane & 7;
        const u32x4 w = *(const ATT_LAS u32x4*)(stg + r * 128 + 16 * (c ^ (r & 7)));
        u32x4* dst = (u32x4*)(base + (long)r * rstride + 16 * c);
        if (NT) __builtin_nontemporal_store(w, dst); else *dst = w; }
    asm volatile("s_waitcnt lgkmcnt(0)" ::: "memory");
}

__device__ __forceinline__ unsigned moba_select(const char* qbase, const long qs, const float* km, const int qb) {
    const int lane = threadIdx.x & 63, q = lane & 31, h = lane >> 5;
    f32x16 g = f32x16{};
    const float* kmrow = km + (size_t)(q & 15) * 256;
    const bool lo_part = q >= 16;
#pragma unroll
    for (int d0 = 0; d0 < 4; ++d0) {
        const bf16x8 qf = *(const bf16x8*)(qbase + (long)q * qs + (16 * d0 + 8 * h) * 2);
        const f32x4 f0 = *(const f32x4*)(kmrow + 16 * d0 + 8 * h), f1 = *(const f32x4*)(kmrow + 16 * d0 + 8 * h + 4);
        float v[8] = {f0[0], f0[1], f0[2], f0[3], f1[0], f1[1], f1[2], f1[3]};
        u32x4 aw;
#pragma unroll
        for (int j = 0; j < 4; ++j) {
            const float h0 = bf16_round(v[2 * j]), h1 = bf16_round(v[2 * j + 1]);
            const float x0 = lo_part ? (v[2 * j] - h0) : h0, x1 = lo_part ? (v[2 * j + 1] - h1) : h1;
            aw[j] = pk_bf16(x0, x1);
        }
        g = __builtin_amdgcn_mfma_f32_32x32x16_bf16(__builtin_bit_cast(bf16x8, aw), qf, g, 0, 0, 0);
    }
    float gate[8], other[8];
#pragma unroll
    for (int r = 0; r < 8; ++r) { gate[r] = g[r] + g[r + 8]; }
#pragma unroll
    for (int r = 0; r < 8; ++r) { other[r] = __shfl_xor(gate[r], 32); }
    unsigned mymask = 0u;
#pragma unroll
    for (int r = 0; r < 8; ++r) {
        const int n = (r & 3) + 8 * (r >> 2) + 4 * h;
        int rank = 0;
#pragma unroll
        for (int r2 = 0; r2 < 8; ++r2) {
            const int n2 = (r2 & 3) + 8 * (r2 >> 2) + 4 * h, n3 = (r2 & 3) + 8 * (r2 >> 2) + 4 * (1 - h);
            if (r2 != r) rank += (n2 < qb && (gate[r2] > gate[r] || (gate[r2] == gate[r] && n2 < n))) ? 1 : 0;
            rank += (n3 < qb && (other[r2] > gate[r] || (other[r2] == gate[r] && n3 < n))) ? 1 : 0;
        }
        if (n < qb && rank < 3) mymask |= 1u << n;
    }
    return mymask | (unsigned)__shfl_xor((int)mymask, 32);
}
}


namespace mk {
using pg8::bf16_t; using pg8::bf16x8; using pg8::f32x4; using pg8::f32x2; using pg8::u32x4; using pg8::u32x2; using pg8::Unit; using pg8::cvt_pk_bf16;
#define LAS __attribute__((address_space(3)))
constexpr int NBAT = MK_NBAT, SEQ = 4096, D = 1024, DFF = 2816, NMEM = 256, M = NBAT * SEQ, MM = NBAT * NMEM, NQKV = 3072;
constexpr float EPS = 1e-6f, LOG2E = 1.4426950408889634f;
constexpr int NWAVES = 8, NPH = 13;
constexpr bool F8_1G = (MK_FP8_FFN1 & 1) != 0, F8_1D = (MK_FP8_FFN1 & 2) != 0, F8_2G = (MK_FP8_FFN2 & 1) != 0, F8_2D = (MK_FP8_FFN2 & 2) != 0;
constexpr bool I8_1G = (MK_FP8_FFN1 & 4) != 0;
static_assert(!(I8_1G && F8_1G), "one operand type per GEMM");
constexpr float F8_WGU = 64.f, F8_H = 4.f, F8_WD = 128.f;

constexpr size_t al256(size_t x) { return (x + 255) / 256 * 256; }
constexpr size_t WS_CTL = 0, CTL_BYTES = 1u << 20;
constexpr size_t WS_WGU1 = WS_CTL + CTL_BYTES;
constexpr size_t WS_WD1 = WS_WGU1 + (size_t)2 * DFF * D * 2;
constexpr size_t WS_WIN = WS_WD1 + (size_t)D * DFF * 2;
constexpr size_t WS_WOUT = WS_WIN + (size_t)NQKV * D * 2;
constexpr size_t WS_WCQS = WS_WOUT + (size_t)D * D * 2;
constexpr size_t WS_WCKV = WS_WCQS + (size_t)D * D * 2;
constexpr size_t WS_WCO = WS_WCKV + (size_t)2 * D * D * 2;
constexpr size_t WS_WGU2 = WS_WCO + (size_t)D * D * 2;
constexpr size_t WS_WD2 = WS_WGU2 + (size_t)2 * DFF * D * 2;
constexpr size_t WS_MB = WS_WD2 + (size_t)D * DFF * 2;
constexpr size_t WS_KVC = WS_MB + (size_t)MM * D * 2;
constexpr size_t WS_WKT = WS_KVC + (size_t)MM * 2 * D * 2;
constexpr size_t WS_VWT = WS_WKT + (size_t)NBAT * D * D * 2;
constexpr size_t SS_BYTES = (size_t)M * 16 * 4;
constexpr size_t WS_SS = WS_VWT + (size_t)NBAT * D * D * 2;
constexpr size_t WS_SSM = WS_SS + 5 * SS_BYTES;
constexpr size_t WS_KM = WS_SSM + (size_t)MM * 16 * 4;
constexpr size_t WS_SX = WS_KM + (size_t)NBAT * 16 * 256 * 4;
constexpr size_t WS_SW = WS_SX + (size_t)M * 4;
constexpr size_t WS_R1 = al256(WS_SW + (size_t)2 * DFF * 4);
constexpr size_t WS_XB = WS_R1 + (size_t)M * NQKV * 2;
constexpr size_t WS_OA2 = WS_XB + (size_t)M * D * 2;
constexpr size_t WS_SEL = WS_OA2 + (size_t)M * 768 * 2;
constexpr size_t WS_OBP = WS_SEL + (size_t)NBAT * 4 * SEQ * 4;
constexpr size_t WS_X8 = WS_OBP;
constexpr size_t WS_MLB = WS_OBP + (size_t)4 * M * 256 * 2;
constexpr size_t WS_END = WS_MLB + (size_t)4 * M * 4 * 2 * 4;
constexpr size_t OUT_OA1 = (size_t)M * 768 * 2, OUT_OB = 2 * OUT_OA1, OUT_ML = OUT_OB + (size_t)M * 256 * 2;
static_assert(OUT_ML + (size_t)3 * M * 12 * 8 <= (size_t)M * D * 4, "attention partials fit in d_out");
constexpr int CW_BAR = 4096, CW_QUEUE = 8192;

constexpr int LDS_XCH = 131072;
constexpr int LDS_MISC = 131072 + 8192;
constexpr int LDS_BYTES = 147456;
constexpr int LDS_TAB = 98304;
static_assert(LDS_TAB + 4 * att::TABB_N * 4 <= LDS_XCH, "attention LDS map");

__device__ __forceinline__ float wave_sum(float v) {
#pragma unroll
    for (int o = 1; o < 64; o <<= 1) v += __shfl_xor(v, o);
    return v;
}
__device__ __forceinline__ unsigned pk_fp8x4(float a, float b, float c, float d) { int r = __builtin_amdgcn_cvt_pk_fp8_f32(a, b, 0, false); r = __builtin_amdgcn_cvt_pk_fp8_f32(c, d, r, true); return (unsigned)r; }
__device__ __forceinline__ unsigned pk_i8x4(float a, float b, float c, float d) { const int ia = (int)__builtin_rintf(a), ib = (int)__builtin_rintf(b), ic = (int)__builtin_rintf(c), id = (int)__builtin_rintf(d);
    return ((unsigned)ia & 255u) | (((unsigned)ib & 255u) << 8) | (((unsigned)ic & 255u) << 16) | ((unsigned)id << 24); }
__device__ __forceinline__ float row_rstd(const float* ss, int row) {
    const f32x4* p = (const f32x4*)(ss + (size_t)row * 16);
    const f32x4 a = p[0], b = p[1], c = p[2], d = p[3];
    const float s = ((a[0] + a[1]) + (a[2] + a[3])) + ((b[0] + b[1]) + (b[2] + b[3])) + ((c[0] + c[1]) + (c[2] + c[3])) + ((d[0] + d[1]) + (d[2] + d[3]));
    return __builtin_amdgcn_rsqf(s * (1.0f / D) + EPS);
}

template <int NROWS> __device__ __forceinline__ void rows_rstd(const float* ss, int row0, int rstep, int fq, float (&rs)[NROWS]) {
    f32x4 a[NROWS];
#pragma unroll
    for (int i = 0; i < NROWS; ++i) a[i] = *((const f32x4*)(ss + (size_t)(row0 + i * rstep) * 16) + fq);
#pragma unroll
    for (int i = 0; i < NROWS; ++i) { float s = (a[i][0] + a[i][1]) + (a[i][2] + a[i][3]); s += __shfl_xor(s, 16); s += __shfl_xor(s, 32); rs[i] = __builtin_amdgcn_rsqf(s * (1.0f / D) + EPS); }
}
struct SchedStd {
    pg8::Order o; const char* A; const char* B; size_t a_tile, b_tile, b_batch; int ocol_mul;
    __device__ __forceinline__ bool next(int i, Unit& u) const { int pm, pn; if (!o.tile(i, pm, pn)) return false;
        u.a = A + (size_t)pm * a_tile; u.b = B + (size_t)pn * b_tile + (size_t)(pm >> 4) * b_batch; u.orow = pm * 256; u.ocol = pn * ocol_mul; u.aux = pn; return true; }
};
struct SchedWK {
    int G, c; const char* kvc; const char* wcqs;
    __device__ __forceinline__ bool next(int i, Unit& u) const { const int L = i * G + c; if (L >= NBAT * 16) return false; const int bh = L >> 2, pn = L & 3, b = bh >> 2, h = bh & 3;
        u.a = kvc + ((size_t)(b * 256) * 2048 + h * 256) * 2; u.b = wcqs + ((size_t)(pn * 256) * 1024 + h * 256) * 2; u.orow = b * 1024 + h * 256; u.ocol = pn * 256; u.aux = 0; return true; }
};
struct SchedVW {
    int G, c; const char* kvc; const char* wcot;
    __device__ __forceinline__ bool next(int i, Unit& u) const { const int L = i * G + c; if (L >= NBAT * 16) return false; const int bh = L >> 2, pm = L & 3, b = bh >> 2, h = bh & 3;
        u.a = wcot + ((size_t)(pm * 256) * 1024 + h * 256) * 2; u.b = kvc + ((size_t)(b * 256) * 2048 + 1024 + h * 256) * 2; u.orow = b * 1024 + pm * 256; u.ocol = h * 256; u.aux = 0; return true; }
};

template <bool F8, bool H8, bool I8> struct EpiGU { static constexpr bool PERM = true;
    void* H; const float* ss; const float* sx; const float* sw;
    __device__ __forceinline__ void operator()(const f32x4 (&acc)[2][2][4][2], const Unit& u, int wr, int wc, int fr, int fq, LAS unsigned char*, int, int) const {
        float rsv[2][4];
#pragma unroll
        for (int ai = 0; ai < 2; ++ai) { float r4[4]; rows_rstd<4>(ss, u.orow + ai * 128 + wr * 64 + fr, 16, fq, r4);
#pragma unroll
            for (int m = 0; m < 4; ++m) { const int row_ = u.orow + ai * 128 + wr * 64 + m * 16 + fr; rsv[ai][m] = r4[m] * (F8 ? 1.0f / F8_WGU : 1.0f); if constexpr (I8) rsv[ai][m] *= sx[row_]; } }
        f32x4 swg[2], swu[2];
        if constexpr (I8) { const f32x4* pg = (const f32x4*)(sw + u.ocol + wc * 32 + 8 * fq); const f32x4* pu = (const f32x4*)(sw + DFF + u.ocol + wc * 32 + 8 * fq); swg[0] = pg[0]; swg[1] = pg[1]; swu[0] = pu[0]; swu[1] = pu[1]; }
#pragma unroll
        for (int ai = 0; ai < 2; ++ai)
#pragma unroll
            for (int m = 0; m < 4; ++m) { const int row = u.orow + ai * 128 + wr * 64 + m * 16 + fr; const float rs = rsv[ai][m];
                const float k1 = -rs * LOG2E, ic2s = __builtin_amdgcn_rcpf(rs * rs * (H8 ? F8_H : 1.0f)); const f32x2 k1v = (f32x2){k1, k1}, ic2 = (f32x2){ic2s, ic2s};
                float hv[8];
#pragma unroll
                for (int n = 0; n < 2; ++n)
#pragma unroll
                    for (int hh = 0; hh < 2; ++hh) { f32x2 av, bv;
                        if constexpr (I8) { const float a0 = acc[ai][0][m][n][2 * hh], a1 = acc[ai][0][m][n][2 * hh + 1], b0 = acc[ai][1][m][n][2 * hh], b1 = acc[ai][1][m][n][2 * hh + 1];
                            av = (f32x2){(float)__builtin_bit_cast(int, a0), (float)__builtin_bit_cast(int, a1)} * (f32x2){swg[n][2 * hh], swg[n][2 * hh + 1]};
                            bv = (f32x2){(float)__builtin_bit_cast(int, b0), (float)__builtin_bit_cast(int, b1)} * (f32x2){swu[n][2 * hh], swu[n][2 * hh + 1]}; }
                        else { av = (f32x2){acc[ai][0][m][n][2 * hh], acc[ai][0][m][n][2 * hh + 1]}; bv = (f32x2){acc[ai][1][m][n][2 * hh], acc[ai][1][m][n][2 * hh + 1]}; }
                        const f32x2 t = av * k1v; f32x2 e; e[0] = __builtin_amdgcn_exp2f(t[0]); e[1] = __builtin_amdgcn_exp2f(t[1]);
                        const f32x2 dd = e * ic2 + ic2; f32x2 q; q[0] = __builtin_amdgcn_rcpf(dd[0]); q[1] = __builtin_amdgcn_rcpf(dd[1]);
                        const f32x2 h2 = (av * bv) * q; hv[4 * n + 2 * hh] = h2[0]; hv[4 * n + 2 * hh + 1] = h2[1]; }
                if constexpr (H8) { u32x2 w; w[0] = pk_fp8x4(hv[0], hv[1], hv[2], hv[3]); w[1] = pk_fp8x4(hv[4], hv[5], hv[6], hv[7]);
                    __builtin_nontemporal_store(w, (u32x2*)((unsigned char*)H + (size_t)row * DFF + u.ocol + wc * 32 + 8 * fq)); }
                else { u32x4 w; w[0] = cvt_pk_bf16(hv[0], hv[1]); w[1] = cvt_pk_bf16(hv[2], hv[3]); w[2] = cvt_pk_bf16(hv[4], hv[5]); w[3] = cvt_pk_bf16(hv[6], hv[7]);
                    __builtin_nontemporal_store(w, (u32x4*)((bf16_t*)H + (size_t)row * DFF + u.ocol + wc * 32 + 8 * fq)); } }
    }
};
template <bool X8> struct EpiRes { static constexpr bool PERM = true;
    bf16_t* xb; float* ssout; float alpha; unsigned char* x8;
    __device__ __forceinline__ void operator()(const f32x4 (&acc)[2][2][4][2], const Unit& u, int wr, int wc, int fr, int fq, LAS unsigned char*, int, int) const {
        const size_t off0 = (size_t)(u.orow + wr * 64 + fr) * D + u.ocol + wc * 32 + 8 * fq;
        u32x4 cur[2], nxt[2];
#pragma unroll
        for (int bj = 0; bj < 2; ++bj) cur[bj] = *(const u32x4*)(xb + off0 + bj * 128);
#pragma unroll
        for (int idx = 0; idx < 8; ++idx) { const int ai = idx >> 2, m = idx & 3; const size_t off = off0 + (size_t)(ai * 128 + m * 16) * D; const int row = u.orow + ai * 128 + wr * 64 + m * 16 + fr;
            if (idx < 7) { const size_t offn = off0 + (size_t)(((idx + 1) >> 2) * 128 + ((idx + 1) & 3) * 16) * D;
#pragma unroll
                for (int bj = 0; bj < 2; ++bj) nxt[bj] = *(const u32x4*)(xb + offn + bj * 128); }
            float sq = 0.f;
#pragma unroll
            for (int bj = 0; bj < 2; ++bj) { float o[8];
#pragma unroll
                for (int n = 0; n < 2; ++n)
#pragma unroll
                    for (int j = 0; j < 4; ++j) { const unsigned wv = cur[bj][2 * n + (j >> 1)]; const float r = __builtin_bit_cast(float, (j & 1) ? (wv & 0xffff0000u) : (wv << 16));
                        const float v = r + acc[ai][bj][m][n][j] * alpha; o[4 * n + j] = v; sq += v * v; }
                u32x4 w; w[0] = cvt_pk_bf16(o[0], o[1]); w[1] = cvt_pk_bf16(o[2], o[3]); w[2] = cvt_pk_bf16(o[4], o[5]); w[3] = cvt_pk_bf16(o[6], o[7]);
                *(u32x4*)(xb + off + bj * 128) = w;
                if constexpr (X8) { u32x2 w8; w8[0] = pk_fp8x4(o[0], o[1], o[2], o[3]); w8[1] = pk_fp8x4(o[4], o[5], o[6], o[7]); *(u32x2*)(x8 + off + bj * 128) = w8; } }
            sq += __shfl_xor(sq, 16); sq += __shfl_xor(sq, 32);
            if (fq == 0) ssout[(size_t)row * 16 + (u.ocol >> 8) * 4 + wc] = sq;
#pragma unroll
            for (int bj = 0; bj < 2; ++bj) cur[bj] = nxt[bj]; }
    }
};
struct EpiStore { static constexpr bool PERM = true;
    bf16_t* O; int ldc; const float* ss; float* km; bool nt;
    __device__ __forceinline__ void operator()(const f32x4 (&acc)[2][2][4][2], const Unit& u, int wr, int wc, int fr, int fq, LAS unsigned char*, int, int) const {
        float rsv[2][4];
#pragma unroll
        for (int ai = 0; ai < 2; ++ai) { if (ss) rows_rstd<4>(ss, u.orow + ai * 128 + wr * 64 + fr, 16, fq, rsv[ai]); else { rsv[ai][0] = 1.0f; rsv[ai][1] = 1.0f; rsv[ai][2] = 1.0f; rsv[ai][3] = 1.0f; } }
#pragma unroll
        for (int ai = 0; ai < 2; ++ai)
#pragma unroll
            for (int m = 0; m < 4; ++m) { const int row = u.orow + ai * 128 + wr * 64 + m * 16 + fr; const float rs = rsv[ai][m];
                const int col0 = u.ocol + wc * 32 + 8 * fq;
                bf16_t* rowp = ldc ? O + (size_t)row * ldc + col0 : O + (((size_t)(row / SEQ) * (NQKV / 64) + (col0 >> 6)) * SEQ + (row % SEQ)) * 64 + (col0 & 63);
                const size_t bjstep = ldc ? 128 : (size_t)2 * SEQ * 64;
#pragma unroll
                for (int bj = 0; bj < 2; ++bj) { const f32x4 v0 = acc[ai][bj][m][0] * rs, v1 = acc[ai][bj][m][1] * rs;
                    u32x4 w; w[0] = cvt_pk_bf16(v0[0], v0[1]); w[1] = cvt_pk_bf16(v0[2], v0[3]); w[2] = cvt_pk_bf16(v1[0], v1[1]); w[3] = cvt_pk_bf16(v1[2], v1[3]);
                    if (nt) __builtin_nontemporal_store(w, (u32x4*)(rowp + bj * bjstep)); else *(u32x4*)(rowp + bj * bjstep) = w; } }
        if ((km != nullptr) && (u.aux == 10)) {
            float* kmb = km + (size_t)(u.orow >> 8) * 256 + wc * 32 + 8 * fq;
#pragma unroll
            for (int bj = 0; bj < 2; ++bj)
#pragma unroll
                for (int n = 0; n < 2; ++n) { f32x4 cs = (f32x4){0.f, 0.f, 0.f, 0.f};
#pragma unroll
                    for (int ai = 0; ai < 2; ++ai)
#pragma unroll
                        for (int m = 0; m < 4; ++m) cs += acc[ai][bj][m][n] * rsv[ai][m];
#pragma unroll
                    for (int j = 0; j < 4; ++j) { float v = cs[j]; v += __shfl_xor(v, 1); v += __shfl_xor(v, 2); v += __shfl_xor(v, 4); v += __shfl_xor(v, 8);
                        if (fr == 0) atomicAdd(kmb + bj * 128 + 4 * n + j, v); } }
        }
    }
};
struct EpiSoftmax { static constexpr bool PERM = true;
    bf16_t* P; const float* ss;
    __device__ __forceinline__ void operator()(const f32x4 (&acc)[2][2][4][2], const Unit& u, int wr, int wc, int fr, int fq, LAS unsigned char* lds, int, int) const {
        LAS f32x2* X = (LAS f32x2*)(lds + LDS_XCH);
        float rsl[2][4], mw[2][4];
#pragma unroll
        for (int ai = 0; ai < 2; ++ai) rows_rstd<4>(ss, u.orow + ai * 128 + wr * 64 + fr, 16, fq, rsl[ai]);
#pragma unroll
        for (int ai = 0; ai < 2; ++ai)
#pragma unroll
            for (int m = 0; m < 4; ++m) { const int rl = ai * 128 + wr * 64 + m * 16 + fr; const float rs = rsl[ai][m] * LOG2E; rsl[ai][m] = rs;
                float mx = -INFINITY;
#pragma unroll
                for (int bj = 0; bj < 2; ++bj)
#pragma unroll
                    for (int n = 0; n < 2; ++n)
#pragma unroll
                        for (int j = 0; j < 4; ++j) mx = fmaxf(mx, acc[ai][bj][m][n][j] * rs);
                mx = fmaxf(mx, __shfl_xor(mx, 16)); mx = fmaxf(mx, __shfl_xor(mx, 32));
                float sm = 0.f;
#pragma unroll
                for (int bj = 0; bj < 2; ++bj)
#pragma unroll
                    for (int n = 0; n < 2; ++n)
#pragma unroll
                        for (int j = 0; j < 4; ++j) sm += __builtin_amdgcn_exp2f(acc[ai][bj][m][n][j] * rs - mx);
                sm += __shfl_xor(sm, 16); sm += __shfl_xor(sm, 32);
                mw[ai][m] = mx;
                if (fq == 0) X[rl * 4 + wc] = (f32x2){mx, sm}; }
        asm volatile("s_waitcnt lgkmcnt(0)" ::: "memory"); __builtin_amdgcn_s_barrier(); asm volatile("" ::: "memory");
#pragma unroll
        for (int ai = 0; ai < 2; ++ai)
#pragma unroll
            for (int m = 0; m < 4; ++m) { const int rl = ai * 128 + wr * 64 + m * 16 + fr; const float rs = rsl[ai][m];
                const f32x2 x0 = X[rl * 4 + 0], x1 = X[rl * 4 + 1], x2 = X[rl * 4 + 2], x3 = X[rl * 4 + 3];
                const float Mx = fmaxf(fmaxf(x0[0], x1[0]), fmaxf(x2[0], x3[0]));
                const float L = x0[1] * __builtin_amdgcn_exp2f(x0[0] - Mx) + x1[1] * __builtin_amdgcn_exp2f(x1[0] - Mx) + x2[1] * __builtin_amdgcn_exp2f(x2[0] - Mx) + x3[1] * __builtin_amdgcn_exp2f(x3[0] - Mx);
                const float il = 1.0f / L;
                bf16_t* rowp = P + (size_t)(u.orow + rl) * D + u.ocol + wc * 32 + 8 * fq;
#pragma unroll
                for (int bj = 0; bj < 2; ++bj) { float pv[8];
#pragma unroll
                    for (int n = 0; n < 2; ++n)
#pragma unroll
                        for (int j = 0; j < 4; ++j) pv[4 * n + j] = __builtin_amdgcn_exp2f(acc[ai][bj][m][n][j] * rs - Mx) * il;
                    u32x4 w; w[0] = cvt_pk_bf16(pv[0], pv[1]); w[1] = cvt_pk_bf16(pv[2], pv[3]); w[2] = cvt_pk_bf16(pv[4], pv[5]); w[3] = cvt_pk_bf16(pv[6], pv[7]);
                    *(u32x4*)(rowp + bj * 128) = w; } }
        (void)mw;
    }
};

#define XB_TMO      128
#define XB_XCNT(j)  (256  + 64 * (j))
#define XB_XSUB(j)  (1280 + 64 * (j))
#define XB_XGEN(j)  (2304 + 64 * (j))
#define XB_TOP      3328
#define XB_TOPGEN   3392
#define XCD_BAR_WORDS 3456
#define XB_SPIN_CAP (1u << 18)
__device__ __forceinline__ unsigned xb_ld(unsigned* p)              { return __hip_atomic_load(p, __ATOMIC_RELAXED, __HIP_MEMORY_SCOPE_AGENT); }
__device__ __forceinline__ unsigned xb_add(unsigned* p, unsigned v) { return __hip_atomic_fetch_add(p, v, __ATOMIC_RELAXED, __HIP_MEMORY_SCOPE_AGENT); }
__device__ __forceinline__ unsigned xb_xcc_id() { return (unsigned)__builtin_amdgcn_s_getreg((3 << 11) | 20) & 0xFu; }
#define XB_SPIN(cond, bar) do { unsigned _sp = 0; while (cond) { __builtin_amdgcn_s_sleep(1); \
    if ((++_sp & 255u) == 0u) { if (xb_ld(&(bar)[XB_TMO])) break; if (_sp > XB_SPIN_CAP) { atomicAdd(&(bar)[XB_TMO], 1u); break; } } } } while (0)
struct XcdBarrier { unsigned* bar; unsigned x; volatile LAS unsigned* st; };
__device__ __forceinline__ XcdBarrier xcd_barrier_post(unsigned* bar, volatile LAS unsigned* st) {
    XcdBarrier b; b.bar = bar; b.x = xb_xcc_id(); b.st = st;
    if (threadIdx.x == 0) (void)xb_add(&bar[XB_XCNT(b.x)], 1u);
    return b;
}
__device__ __forceinline__ void xcd_barrier_complete(unsigned* bar, unsigned x, unsigned& nloc, unsigned& nx) {
    const unsigned G = gridDim.x * gridDim.y * gridDim.z;
    unsigned sum, cnt, mine, sp = 0u;
    for (;;) {
        sum = 0u; cnt = 0u; mine = 0u;
#pragma unroll
        for (unsigned j = 0; j < 16; ++j) { const unsigned c = xb_ld(&bar[XB_XCNT(j)]); sum += c; cnt += (c > 0u) ? 1u : 0u; mine = (j == x) ? c : mine; }
        if (sum == G) break;
        __builtin_amdgcn_s_sleep(1);
        if ((++sp & 255u) == 0u) { if (xb_ld(&bar[XB_TMO])) break; if (sp > XB_SPIN_CAP) { atomicAdd(&bar[XB_TMO], 1u); break; } }
    }
    nloc = mine > 0u ? mine : 1u; nx = cnt > 0u ? cnt : 1u;
}
__device__ __forceinline__ void xcd_barrier(const XcdBarrier& b) {
    asm volatile("s_waitcnt vmcnt(0)" ::: "memory");
    __syncthreads();
    if (threadIdx.x == 0) {
        unsigned* bar = b.bar;
        __builtin_amdgcn_s_waitcnt(0);
        unsigned nloc = b.st[0], nx = b.st[1];
        if (nloc == 0u) { xcd_barrier_complete(bar, b.x, nloc, nx); b.st[0] = nloc; b.st[1] = nx; }
        const unsigned old = xb_add(&bar[XB_XSUB(b.x)], 1u);
        const unsigned gen = old / nloc;
        if (old + 1u == (gen + 1u) * nloc) {
            __builtin_amdgcn_fence(__ATOMIC_RELEASE, "agent");
            asm volatile("s_waitcnt vmcnt(0)" ::: "memory");
            const unsigned og = xb_add(&bar[XB_TOP], 1u);
            const unsigned tg = og / nx;
            if (og + 1u == (tg + 1u) * nx) xb_add(&bar[XB_TOPGEN], 1u);
            else XB_SPIN(xb_ld(&bar[XB_TOPGEN]) == tg, bar);
            __builtin_amdgcn_fence(__ATOMIC_ACQUIRE, "agent");
            xb_add(&bar[XB_XGEN(b.x)], 1u);
            asm volatile("s_waitcnt vmcnt(0)" ::: "memory");
        } else {
            XB_SPIN(xb_ld(&bar[XB_XGEN(b.x)]) == gen, bar);
            __builtin_amdgcn_fence(__ATOMIC_ACQUIRE, "agent");
            asm volatile("s_waitcnt vmcnt(0)" ::: "memory");
        }
    }
    __syncthreads();
}

template <bool F8>
__device__ __forceinline__ void tr_item(const float* W, int N, int k0, int n0, const float* gain, float cscale, void* dst  , int Kd, LAS float* scr, int lane) {
    f32x4 v[8]; float g[8];
#pragma unroll
    for (int i = 0; i < 8; ++i) { const int kk = 8 * i + (lane >> 3); v[i] = __builtin_nontemporal_load((const f32x4*)(W + (size_t)(k0 + kk) * N + n0 + 4 * (lane & 7))); g[i] = gain ? gain[k0 + kk] * cscale : cscale; }
#pragma unroll
    for (int i = 0; i < 8; ++i) { const int kk = 8 * i + (lane >> 3); LAS float* d = scr + kk * 33 + 4 * (lane & 7); d[0] = v[i][0] * g[i]; d[1] = v[i][1] * g[i]; d[2] = v[i][2] * g[i]; d[3] = v[i][3] * g[i]; }
    asm volatile("s_waitcnt lgkmcnt(0)" ::: "memory");
    const int c = lane & 7;
#pragma unroll
    for (int j = 0; j < 4; ++j) { const int n = (lane >> 3) + 8 * j; const LAS float* s = scr + (8 * c) * 33 + n;
        if constexpr (F8) { u32x2 o; o[0] = pk_fp8x4(s[0 * 33], s[1 * 33], s[2 * 33], s[3 * 33]); o[1] = pk_fp8x4(s[4 * 33], s[5 * 33], s[6 * 33], s[7 * 33]); *(u32x2*)((unsigned char*)dst + (size_t)n * Kd + k0 + 8 * c) = o; }
        else { u32x4 o; o[0] = cvt_pk_bf16(s[0 * 33], s[1 * 33]); o[1] = cvt_pk_bf16(s[2 * 33], s[3 * 33]); o[2] = cvt_pk_bf16(s[4 * 33], s[5 * 33]); o[3] = cvt_pk_bf16(s[6 * 33], s[7 * 33]);
            *(u32x4*)((bf16_t*)dst + (size_t)n * Kd + k0 + 8 * c) = o; } }
    asm volatile("s_waitcnt lgkmcnt(0)" ::: "memory");
}
template <int NR, int Q8>
__device__ __forceinline__ void cvt_rows(const float* x, bf16_t* o, unsigned char* o8, float* sx, float* ss, int row0, int stride, int nrows, int lane) {
    f32x4 v[NR][4]; float s[NR];
#pragma unroll
    for (int r = 0; r < NR; ++r) { const int row = row0 + r * stride; const f32x4* xr = (const f32x4*)(x + (size_t)(row < nrows ? row : row0) * D) + lane;
#pragma unroll
        for (int j = 0; j < 4; ++j) v[r][j] = __builtin_nontemporal_load(xr + 64 * j); }
#pragma unroll
    for (int r = 0; r < NR; ++r) { float a = 0.f;
#pragma unroll
        for (int j = 0; j < 4; ++j) a += (v[r][j][0] * v[r][j][0] + v[r][j][1] * v[r][j][1]) + (v[r][j][2] * v[r][j][2] + v[r][j][3] * v[r][j][3]);
        s[r] = a; }
#pragma unroll
    for (int of = 1; of < 64; of <<= 1)
#pragma unroll
        for (int r = 0; r < NR; ++r) s[r] += __shfl_xor(s[r], of);
#pragma unroll
    for (int r = 0; r < NR; ++r) { const int row = row0 + r * stride; if (row < nrows) { u32x2* ob = (u32x2*)(o + (size_t)row * D) + lane;
#pragma unroll
            for (int j = 0; j < 4; ++j) { u32x2 w; w[0] = cvt_pk_bf16(v[r][j][0], v[r][j][1]); w[1] = cvt_pk_bf16(v[r][j][2], v[r][j][3]); ob[64 * j] = w; }
            if constexpr (Q8 == 1) { unsigned* oq = (unsigned*)(o8 + (size_t)row * D) + lane;
#pragma unroll
                for (int j = 0; j < 4; ++j) oq[64 * j] = pk_fp8x4(v[r][j][0], v[r][j][1], v[r][j][2], v[r][j][3]); }
            if constexpr (Q8 == 2) { float mx = 0.f;
#pragma unroll
                for (int j = 0; j < 4; ++j) mx = fmaxf(fmaxf(mx, fmaxf(fabsf(v[r][j][0]), fabsf(v[r][j][1]))), fmaxf(fabsf(v[r][j][2]), fabsf(v[r][j][3])));
#pragma unroll
                for (int of = 1; of < 64; of <<= 1) mx = fmaxf(mx, __shfl_xor(mx, of));
                mx = fmaxf(mx, 1e-30f); const float inv = 127.0f / mx; unsigned* oq = (unsigned*)(o8 + (size_t)row * D) + lane;
#pragma unroll
                for (int j = 0; j < 4; ++j) oq[64 * j] = pk_i8x4(v[r][j][0] * inv, v[r][j][1] * inv, v[r][j][2] * inv, v[r][j][3] * inv);
                if (lane == 0) sx[row] = mx * (1.0f / 127.0f); }
            if (lane < 16) ss[(size_t)row * 16 + lane] = lane == 0 ? s[r] : 0.f; } }
}

struct Args { const float* in[20]; float* out; unsigned char* ws; int ph_lo, ph_hi, flags, pad; };

#define MK_PTRS unsigned char* ws = args.ws; float* out = args.out; asm volatile("" : "+s"(ws), "+s"(out)); \
    const float* x_in = args.in[0]; const float* mem_in = args.in[1]; const float* rel_bias = args.in[7]; \
    bf16_t* Wgu1 = (bf16_t*)(ws + WS_WGU1); bf16_t* Wd1 = (bf16_t*)(ws + WS_WD1); bf16_t* Win = (bf16_t*)(ws + WS_WIN); bf16_t* Wout = (bf16_t*)(ws + WS_WOUT); \
    bf16_t* Wcqs = (bf16_t*)(ws + WS_WCQS); bf16_t* Wckv = (bf16_t*)(ws + WS_WCKV); bf16_t* Wco = (bf16_t*)(ws + WS_WCO); bf16_t* Wgu2 = (bf16_t*)(ws + WS_WGU2); bf16_t* Wd2 = (bf16_t*)(ws + WS_WD2); \
    bf16_t* MB = (bf16_t*)(ws + WS_MB); bf16_t* KVC = (bf16_t*)(ws + WS_KVC); bf16_t* WKT = (bf16_t*)(ws + WS_WKT); bf16_t* VWT = (bf16_t*)(ws + WS_VWT); \
    float* SS0 = (float*)(ws + WS_SS); float* SS1 = SS0 + (size_t)M * 16; float* SS2 = SS1 + (size_t)M * 16; float* SS3 = SS2 + (size_t)M * 16; float* SS4 = SS3 + (size_t)M * 16; \
    float* SSM = (float*)(ws + WS_SSM); float* KM = (float*)(ws + WS_KM); float* SX = (float*)(ws + WS_SX); float* SW = (float*)(ws + WS_SW); (void)SX; (void)SW; \
    bf16_t* HB = (bf16_t*)(ws + WS_R1); bf16_t* QKV = HB; bf16_t* YN = HB; bf16_t* PB = HB; \
    bf16_t* XB = (bf16_t*)(ws + WS_XB); unsigned char* X8 = ws + WS_X8; (void)X8; bf16_t* OA0 = (bf16_t*)out; bf16_t* OA1 = (bf16_t*)((char*)out + OUT_OA1); bf16_t* OA2 = (bf16_t*)(ws + WS_OA2); bf16_t* OB = (bf16_t*)((char*)out + OUT_OB); float* ML = (float*)((char*)out + OUT_ML); unsigned* SEL = (unsigned*)(ws + WS_SEL); bf16_t* OBP = (bf16_t*)(ws + WS_OBP); float* MLB = (float*)(ws + WS_MLB); (void)OB;
__global__ void __launch_bounds__(NWAVES * 64, 2) mk_fwd(Args args) {
    extern __shared__ __attribute__((aligned(16))) unsigned char lds_raw[];
    LAS unsigned char* lds = (LAS unsigned char*)lds_raw;
    const int tid = threadIdx.x, lane = tid & 63, wave = __builtin_amdgcn_readfirstlane(tid >> 6);
    const int G = gridDim.x, bx = blockIdx.x;
    const int vcu = (G % 8 == 0) ? (bx % 8) * (G / 8) + bx / 8 : bx;
    const int gw = vcu * NWAVES + wave, NGW = G * NWAVES;
    unsigned char* const ws0 = args.ws;
    volatile LAS unsigned* MISC = (volatile LAS unsigned*)(lds + LDS_MISC);
    if (tid < 32) MISC[tid] = 0u;
    __syncthreads();
    const int lo = args.ph_lo, hi = args.ph_hi;
    const bool use_bar = (hi - lo) > 1;
    XcdBarrier bar; bar.bar = (unsigned*)(ws0 + WS_CTL) + CW_BAR; bar.x = 0; bar.st = nullptr;
    if (use_bar) bar = xcd_barrier_post((unsigned*)(ws0 + WS_CTL) + CW_BAR, MISC + 8);
#define IN(k) (lo <= (k) && (k) < hi)
#define STAGGER() do { if (MK_STAGGER_TICKS > 0) { const unsigned long long t0_ = __builtin_amdgcn_s_memrealtime(), dl_ = (unsigned long long)((bx >> 3) & 3) * MK_STAGGER_TICKS; while (__builtin_amdgcn_s_memrealtime() - t0_ < dl_) __builtin_amdgcn_s_sleep(8); } } while (0)
#define SEAM(k) do { if (IN(k) && IN((k) + 1)) xcd_barrier(bar); } while (0)

    if (IN(0)) {
        MK_PTRS;
        LAS float* scr = (LAS float*)(lds + wave * 16384);
        constexpr int I_GU = (D / 64) * (2 * DFF / 32), I_DN = (DFF / 64) * (D / 32), I_IN = (D / 64) * (NQKV / 32), I_SQ = (D / 64) * (D / 32), I_KV = (D / 64) * (2 * D / 32);
        constexpr int NITEMS = 2 * I_GU + 2 * I_DN + I_IN + 2 * I_SQ + I_KV;
        for (int it = gw; it < NITEMS; it += NGW) {
            int r = it;
            if (r < 2 * I_GU) {
                const bool second = r >= I_GU; if (second) r -= I_GU;
                if (I8_1G && !second) continue;
                const int nblk = 2 * DFF / 32, kb = r / nblk, nb = r % nblk, n0 = nb * 32;
                const int drow = n0 < DFF ? (n0 / 128) * 256 + (n0 % 128) : ((n0 - DFF) / 128) * 256 + 128 + ((n0 - DFF) % 128);
                if (second ? F8_2G : F8_1G) tr_item<true>(args.in[second ? 17 : 3], 2 * DFF, kb * 64, n0, args.in[second ? 16 : 2], F8_WGU, (unsigned char*)(second ? Wgu2 : Wgu1) + (size_t)drow * D, D, scr, lane);
                else tr_item<false>(args.in[second ? 17 : 3], 2 * DFF, kb * 64, n0, args.in[second ? 16 : 2], 1.0f, (second ? Wgu2 : Wgu1) + (size_t)drow * D, D, scr, lane);
                continue; }
            r -= 2 * I_GU;
            if (r < 2 * I_DN) { const bool second = r >= I_DN; if (second) r -= I_DN; const int nblk = D / 32, kb = r / nblk, nb = r % nblk;
                if (second ? F8_2D : F8_1D) tr_item<true>(args.in[second ? 18 : 4], D, kb * 64, nb * 32, nullptr, F8_WD, (unsigned char*)(second ? Wd2 : Wd1) + (size_t)(nb * 32) * DFF, DFF, scr, lane);
                else tr_item<false>(args.in[second ? 18 : 4], D, kb * 64, nb * 32, nullptr, 1.0f, (second ? Wd2 : Wd1) + (size_t)(nb * 32) * DFF, DFF, scr, lane);
                continue; }
            r -= 2 * I_DN;
            if (r < I_IN) { const int nblk = NQKV / 32, kb = r / nblk, nb = r % nblk, n0 = nb * 32; const bool isq = (n0 < 768) || (n0 >= 2304 && n0 < 2560);
                tr_item<false>(args.in[6], NQKV, kb * 64, n0, args.in[5], isq ? 0.125f : 1.0f, Win + (size_t)n0 * D, D, scr, lane); continue; }
            r -= I_IN;
            if (r < I_SQ) { const int nblk = D / 32, kb = r / nblk, nb = r % nblk, k0 = kb * 64; const float* gp = k0 < 768 ? args.in[8] : args.in[9] - 768;
                tr_item<false>(args.in[10], D, k0, nb * 32, gp, 1.0f, Wout + (size_t)(nb * 32) * D, D, scr, lane); continue; }
            r -= I_SQ;
            if (r < I_SQ) { const int nblk = D / 32, kb = r / nblk, nb = r % nblk; tr_item<false>(args.in[15], D, kb * 64, nb * 32, nullptr, 1.0f, Wco + (size_t)(nb * 32) * D, D, scr, lane); continue; }
            r -= I_SQ;
            { const int nblk = 2 * D / 32, kb = r / nblk, nb = r % nblk; tr_item<false>(args.in[14], 2 * D, kb * 64, nb * 32, args.in[12], 1.0f, Wckv + (size_t)(nb * 32) * D, D, scr, lane); }
        }
        if constexpr (I8_1G) {
            for (int cg = vcu; cg < 2 * DFF / 32; cg += G) {
                const int n0 = cg * 32, drow = n0 < DFF ? (n0 / 128) * 256 + (n0 % 128) : ((n0 - DFF) / 128) * 256 + 128 + ((n0 - DFF) % 128);
                const float* W = args.in[3]; const float* gain = args.in[2];
                f32x4 v[2][8]; f32x4 mx = (f32x4){0.f, 0.f, 0.f, 0.f};
#pragma unroll
                for (int t = 0; t < 2; ++t)
#pragma unroll
                    for (int i = 0; i < 8; ++i) { const int kk = (2 * wave + t) * 64 + 8 * i + (lane >> 3); v[t][i] = __builtin_nontemporal_load((const f32x4*)(W + (size_t)kk * (2 * DFF) + n0 + 4 * (lane & 7))) * gain[kk]; }
#pragma unroll
                for (int t = 0; t < 2; ++t)
#pragma unroll
                    for (int i = 0; i < 8; ++i)
#pragma unroll
                        for (int c = 0; c < 4; ++c) mx[c] = fmaxf(mx[c], fabsf(v[t][i][c]));
#pragma unroll
                for (int c = 0; c < 4; ++c) { float a = mx[c]; a = fmaxf(a, __shfl_xor(a, 8)); a = fmaxf(a, __shfl_xor(a, 16)); a = fmaxf(a, __shfl_xor(a, 32)); mx[c] = a; }
                LAS float* XM = (LAS float*)(lds + LDS_XCH);
                if (lane < 8) { XM[wave * 32 + 4 * lane + 0] = mx[0]; XM[wave * 32 + 4 * lane + 1] = mx[1]; XM[wave * 32 + 4 * lane + 2] = mx[2]; XM[wave * 32 + 4 * lane + 3] = mx[3]; }
                asm volatile("s_waitcnt lgkmcnt(0)" ::: "memory"); __syncthreads();
                float mul[4];
#pragma unroll
                for (int c = 0; c < 4; ++c) { float a = 0.f;
#pragma unroll
                    for (int w2 = 0; w2 < NWAVES; ++w2) a = fmaxf(a, XM[w2 * 32 + 4 * (lane & 7) + c]);
                    a = fmaxf(a, 1e-30f); mul[c] = 127.0f / a; if (wave == 0 && lane < 8) SW[n0 + 4 * lane + c] = a * (1.0f / 127.0f); }
#pragma unroll
                for (int t = 0; t < 2; ++t) { const int k0 = (2 * wave + t) * 64;
#pragma unroll
                    for (int i = 0; i < 8; ++i) { const int kk = 8 * i + (lane >> 3); LAS float* d = scr + kk * 33 + 4 * (lane & 7); d[0] = v[t][i][0] * mul[0]; d[1] = v[t][i][1] * mul[1]; d[2] = v[t][i][2] * mul[2]; d[3] = v[t][i][3] * mul[3]; }
                    asm volatile("s_waitcnt lgkmcnt(0)" ::: "memory");
                    const int c8 = lane & 7;
#pragma unroll
                    for (int j = 0; j < 4; ++j) { const int n = (lane >> 3) + 8 * j; const LAS float* s = scr + (8 * c8) * 33 + n;
                        u32x2 o; o[0] = pk_i8x4(s[0 * 33], s[1 * 33], s[2 * 33], s[3 * 33]); o[1] = pk_i8x4(s[4 * 33], s[5 * 33], s[6 * 33], s[7 * 33]);
                        *(u32x2*)((unsigned char*)Wgu1 + (size_t)(drow + n) * D + k0 + 8 * c8) = o; }
                    asm volatile("s_waitcnt lgkmcnt(0)" ::: "memory"); }
                __syncthreads();
            }
        }
        for (int c = gw; c < D; c += NGW) { const float g = args.in[11][c] * 0.0625f; const f32x4* src = (const f32x4*)(args.in[13] + (size_t)c * D) + lane; u32x2* dst = (u32x2*)(Wcqs + (size_t)c * D) + lane;
#pragma unroll
            for (int j = 0; j < 4; ++j) { const f32x4 v = src[64 * j] * g; u32x2 w; w[0] = cvt_pk_bf16(v[0], v[1]); w[1] = cvt_pk_bf16(v[2], v[3]); dst[64 * j] = w; } }
        for (int m = gw; m < M; m += 4 * NGW) cvt_rows<4, I8_1G ? 2 : (F8_1G ? 1 : 0)>(x_in, XB, X8, SX, SS0, m, NGW, M, lane);
        for (int m = gw; m < MM; m += NGW) cvt_rows<1, 0>(mem_in, MB, nullptr, nullptr, SSM, m, NGW, MM, lane);
        for (int i = gw * 64 + lane; i < NBAT * 16 * 256; i += NGW * 64) KM[i] = 0.f;
    }
    SEAM(0);

    if (IN(1)) {
        MK_PTRS;
        STAGGER();
        { constexpr int EB = (F8_1G || I8_1G) ? 1 : 2;
          SchedStd S; S.o.init(M, 2 * DFF, G, bx); S.A = (F8_1G || I8_1G) ? (const char*)X8 : (const char*)XB; S.B = (const char*)Wgu1; S.a_tile = (size_t)256 * D * EB; S.b_tile = (size_t)256 * D * EB; S.b_batch = 0; S.ocol_mul = 128;
          EpiGU<F8_1G, F8_1D, I8_1G> E{HB, SS0, SX, SW}; pg8::gemm_phase<EpiGU<F8_1G, F8_1D, I8_1G>, SchedStd, true, I8_1G ? 2 : (F8_1G ? 1 : 0)>(lds, D * EB / 2, D * EB / 2, D * EB / 128, S, E); }
    }
    SEAM(1);

    if (IN(2)) {
        MK_PTRS;
        constexpr int EB = F8_1D ? 1 : 2;
        SchedStd S; S.o.init(M, D, G, bx); S.A = (const char*)HB; S.B = (const char*)Wd1; S.a_tile = (size_t)256 * DFF * EB; S.b_tile = (size_t)256 * DFF * EB; S.b_batch = 0; S.ocol_mul = 256;
        EpiRes<false> E{XB, SS1, F8_1D ? 0.5f / (F8_H * F8_WD) : 0.5f, nullptr}; pg8::gemm_phase<EpiRes<false>, SchedStd, true, F8_1D>(lds, DFF * EB / 2, DFF * EB / 2, DFF * EB / 128, S, E);
    }
    SEAM(2);

    if (IN(3)) {
        MK_PTRS;
        { SchedStd S; S.o.init(M, NQKV, G, bx); S.A = (const char*)XB; S.B = (const char*)Win; S.a_tile = (size_t)256 * D * 2; S.b_tile = (size_t)256 * D * 2; S.b_batch = 0; S.ocol_mul = 256;
          EpiStore E{QKV, 0, SS1, KM, false}; pg8::gemm_phase<EpiStore, SchedStd, true>(lds, D, D, D / 64, S, E); }
    }
    SEAM(3);

    if (IN(4)) {
        MK_PTRS;
        constexpr long HSTR4 = (long)SEQ * 128;
        for (int task = gw; task < NBAT * 4 * (SEQ / 32); task += NGW) { const int bh = task / (SEQ / 32), tl = task % (SEQ / 32), b = bh >> 2, hb = bh & 3, q0 = tl * 32, qb = q0 >> 8;
            const char* qbase = (const char*)QKV + ((size_t)b * 48 + 36 + hb) * HSTR4 + (size_t)q0 * 128;
            const unsigned msk = att::moba_select(qbase, 128, KM + (size_t)b * 16 * 256 + hb * 64, qb);
            if (lane < 32) SEL[(size_t)bh * SEQ + q0 + lane] = msk; }
    }
    SEAM(4);

    if (IN(5)) {
        MK_PTRS;
        LAS float* tab = (LAS float*)(lds + LDS_TAB);
        const int h2 = lane >> 5, q = lane & 31;
        const long rowb = 128;
        constexpr long HSTR = (long)SEQ * 128;
#define ATT_WAITV(n) asm volatile("s_waitcnt vmcnt(" #n ")" ::: "memory")
#define ATT_BAR() do { asm volatile("s_waitcnt lgkmcnt(0)" ::: "memory"); __builtin_amdgcn_s_barrier(); asm volatile("" ::: "memory"); } while (0)
        { constexpr int NKV = NBAT * 8;
          struct SchedOne { const char* A; const char* B; int G_, c_; __device__ __forceinline__ bool next(int i, Unit& uu) const { const int idx = i * G_ + c_; if (idx >= NKV) return false; const int pm = idx >> 3, pn = idx & 7;
              uu.a = A + (size_t)pm * 256 * D * 2; uu.b = B + (size_t)pn * 256 * D * 2; uu.orow = pm * 256; uu.ocol = pn * 256; uu.aux = pn; return true; } };
          SchedOne S1{(const char*)MB, (const char*)Wckv, G, vcu};
          EpiStore Ekv{KVC, 2 * D, SSM, nullptr, false}; pg8::gemm_phase<EpiStore, SchedOne, true>(lds, D, D, D / 64, S1, Ekv);
          __syncthreads(); }
        for (int i = tid; i < 4 * att::TABB_N; i += NWAVES * 64) { const int hb = i / att::TABB_N, e = i % att::TABB_N, dist = e - 32;
            tab[i] = dist >= 0 ? rel_bias[att::rel_bucket(dist) * 16 + 12 + hb] * LOG2E : -INFINITY; }
        __syncthreads();
        {
            constexpr int NBH = NBAT * 4, NUNITS = 16 * NBH;
            LAS unsigned* LQ = (LAS unsigned*)(lds + 65536);
            volatile LAS unsigned* UW = (volatile LAS unsigned*)(lds + 65536 + 16384);
            unsigned* qhead = (unsigned*)(ws + WS_CTL) + CW_QUEUE;
#pragma unroll 1
            for (;;) {
                if (tid == 0) UW[8] = __hip_atomic_fetch_add(qhead, 1u, __ATOMIC_RELAXED, __HIP_MEMORY_SCOPE_AGENT);
                ATT_BAR();
                const int u = (int)UW[8];
                if (u >= NUNITS) break;
                const int n = u / NBH, bh = u % NBH, b = bh >> 2, hb = bh & 3;
                const char* qh = (const char*)QKV + ((size_t)b * 48 + 36 + hb) * HSTR;
                const char* kh = (const char*)QKV + ((size_t)b * 48 + 40 + hb) * HSTR + (size_t)(256 * n) * rowb;
                const unsigned* selp = SEL + (size_t)bh * SEQ;
                ATT_WAITV(0);
#pragma unroll
                for (int k = wave; k < 32; k += NWAVES) { const int row = 8 * k + (lane >> 3); att::dma_rows8(kh + (long)row * rowb, (int)(4 * HSTR), row, (LAS char*)(lds + k * 1024), (LAS char*)(lds + 32768 + k * 1024), lane); }
                int total = 0;
                if (n < 15) {
                    const int lo = 256 * (n + 1) + wave * 32 * (15 - n), R = 32 * (15 - n);
                    int cnt = 0;
#pragma unroll 1
                    for (int i = 0; i < R; i += 64) { const bool pr = (i + lane < R) && ((selp[lo + i + lane] >> n) & 1u); cnt += __popcll(__ballot(pr)); }
                    if (lane == 0) UW[wave] = (unsigned)cnt;
                    ATT_BAR();
                    int basew = 0;
#pragma unroll
                    for (int w2 = 0; w2 < NWAVES; ++w2) { const int cw = (int)UW[w2]; basew += (w2 < wave) ? cw : 0; total += cw; }
#pragma unroll 1
                    for (int i = 0; i < R; i += 64) { const bool pr = (i + lane < R) && ((selp[lo + i + lane] >> n) & 1u); const unsigned long long bal = __ballot(pr);
                        if (pr) LQ[basew + __popcll(bal & ((1ull << lane) - 1ull))] = (unsigned)(lo + i + lane); basew += __popcll(bal); }
                }
                const int ntiles = (total + 31) >> 5;
                ATT_WAITV(0); ATT_BAR();
                const LAS float* tb = tab + hb * att::TABB_N;
#pragma unroll 1
                for (int tile = -1; tile < ntiles; tile = (tile < 0 ? wave : tile + NWAVES)) {
                    const bool own = tile < 0;
                    int tq; bool valid = true;
                    if (own) tq = 256 * n + 32 * wave + q; else { const int e = 32 * tile + q; valid = e < total; tq = (int)LQ[valid ? e : total - 1]; }
                    att::bf16x8 qf[4];
#pragma unroll
                    for (int d0 = 0; d0 < 4; ++d0) qf[d0] = *(const att::bf16x8*)(qh + (long)tq * rowb + (16 * d0 + 8 * h2) * 2);
                    const int slot = own ? 3 : __popc(selp[tq] & ((1u << n) - 1u));
                    att::f32x16 o[2]; o[0] = att::f32x16{}; o[1] = att::f32x16{}; float mo = -1e30f, lo_ = 0.f;
                    const int Bq = (tq - 256 * n + 32) - 4 * h2;
#pragma unroll 1
                    for (int g = own ? wave : 7; g >= 0; --g) { int B = Bq - 32 * g; B = B < (att::TABB_N - 1) ? B : (att::TABB_N - 1);
                        att::attn_group(qf, o, mo, lo_, (const LAS char*)(lds + g * 4096), (const LAS char*)(lds + 32768 + g * 4096), tb + B, lane); }
                    lo_ += __shfl_xor(lo_, 32);
                    const size_t prow = (size_t)slot * M + (size_t)b * SEQ + tq;
                    att::store_o<MK_NT_PART>(o, lo_, (char*)OBP + (prow * 256 + hb * 64) * 2, h2, valid);
                    if (h2 == 0 && valid) *(f32x2*)(MLB + (prow * 4 + hb) * 2) = (f32x2){mo, lo_};
                }
                ATT_BAR();
            }
        }
        __syncthreads();
        LAS float* rbl = (LAS float*)(lds + LDS_TAB); LAS float* tabI = (LAS float*)(lds + LDS_TAB + 2048);
        LAS char* ostg = (LAS char*)(lds + LDS_TAB + 3072 + wave * 4096);
        static_assert(LDS_TAB + 3072 + NWAVES * 4096 <= LDS_MISC, "dilated LDS map");
        for (int i = tid; i < 512; i += NWAVES * 64) rbl[i] = rel_bias[i] * LOG2E;
        __syncthreads();
        constexpr int NDIL = NBAT * 12 * 48;
        struct DilItem { int b, h, p, d, res, m0, mbase; };
        auto decode = [&](int it, DilItem& I) { const int bh = it / 48, j = it % 48; I.b = bh / 12; I.h = bh % 12; I.p = j >> 4; const int jj = j & 15;
            I.d = I.p == 0 ? 1 : (I.p == 1 ? 4 : 16); I.res = I.p == 0 ? 0 : (I.p == 1 ? (jj & 3) : jj); const int mblk = I.p == 0 ? jj : (I.p == 1 ? (jj >> 2) : 0);
            I.mbase = mblk * 256 - 128; I.m0 = mblk * 256 + wave * 32; };
        att::bf16x8 qf[4];
        auto issue_k = [&](const DilItem& I) {
            const char* kb = (const char*)QKV + ((size_t)I.b * 48 + 12 + I.h) * HSTR + (size_t)I.res * rowb; const long st = (long)I.d * rowb;
#pragma unroll 1
            for (int k = wave; k < 48; k += NWAVES) { if (I.mbase + 8 * k < 0) continue; const int row = 8 * k + (lane >> 3); att::dma_k_rows8(kb + (long)(I.mbase + row) * st, row, (LAS char*)(lds + k * 1024), lane); } };
        auto issue_v = [&](const DilItem& I) {
            const char* vb = (const char*)QKV + ((size_t)I.b * 48 + 24 + I.h) * HSTR + (size_t)I.res * rowb; const long st = (long)I.d * rowb;
#pragma unroll 1
            for (int k = wave; k < 48; k += NWAVES) { if (I.mbase + 8 * k < 0) continue; const int row = 8 * k + (lane >> 3); att::dma_v_rows8(vb + (long)(I.mbase + row) * st, row, (LAS char*)(lds + 49152 + k * 1024), lane); } };
        auto load_q = [&](const DilItem& I) {
            const char* qp = (const char*)QKV + ((size_t)I.b * 48 + I.h) * HSTR + (size_t)I.res * rowb + (long)I.m0 * I.d * rowb + (long)q * I.d * rowb + 16 * h2;
            asm volatile("global_load_dwordx4 %0, %4, off\n\tglobal_load_dwordx4 %1, %4, off offset:32\n\tglobal_load_dwordx4 %2, %4, off offset:64\n\tglobal_load_dwordx4 %3, %4, off offset:96"
                         : "=&v"(qf[0]), "=&v"(qf[1]), "=&v"(qf[2]), "=&v"(qf[3]) : "v"(qp) : "memory"); };
        auto build_tab = [&](const DilItem& I) { if (tid < att::TABA_N) { const int delta = tid - 32; tabI[tid] = (delta >= 0 && delta <= 128) ? rbl[att::rel_bucket(delta * I.d) * 16 + I.h] : -INFINITY; } };
        att::u32x4 vr[6];
        auto load_v = [&](const DilItem& I) {
            const char* vb = (const char*)QKV + ((size_t)I.b * 48 + 24 + I.h) * HSTR + (size_t)I.res * rowb; const long st = (long)I.d * rowb;
#pragma unroll
            for (int j = 0; j < 6; ++j) { const int k = wave + NWAVES * j; if (I.mbase + 8 * k < 0) continue; const int row = 8 * k + (lane >> 3);
                const char* src = vb + (long)(I.mbase + row) * st + 16 * ((lane & 7) ^ (((row >> 1) & 1) << 2));
                asm volatile("global_load_dwordx4 %0, %1, off" : "=&v"(vr[j]) : "v"(src) : "memory"); } };
        DilItem cur; int it = vcu;
        if (it < NDIL) { decode(it, cur); build_tab(cur); ATT_WAITV(0); issue_k(cur); load_q(cur); issue_v(cur); }
        att::f32x16 po[2]; po[0] = att::f32x16{}; po[1] = att::f32x16{}; float pmo = 0.f, plo = 1.f; DilItem pdone = cur; int pm0 = 0; bool pvalid = false;
#define FLUSH_PREV() do { const size_t tok_ = (size_t)pdone.b * SEQ + (size_t)(pm0 + q) * pdone.d + pdone.res; \
            att::store_o_staged<MK_NT_PART>(po, plo, ostg, (char*)(pdone.p == 0 ? OA0 : (pdone.p == 1 ? OA1 : OA2)) + (((size_t)pdone.b * SEQ + (size_t)pm0 * pdone.d + pdone.res) * 768 + pdone.h * 64) * 2, (long)pdone.d * 768 * 2, lane); \
            if (h2 == 0) *(f32x2*)(ML + (((size_t)pdone.p * M + tok_) * 12 + pdone.h) * 2) = (f32x2){pmo, plo}; } while (0)
#pragma unroll 1
        for (; it < NDIL; it += G) {
            ATT_WAITV(0);
            asm volatile("" : "+v"(qf[0]), "+v"(qf[1]), "+v"(qf[2]), "+v"(qf[3]));
            ATT_BAR();
            const bool has_next = it + G < NDIL; DilItem nxt = cur; if (has_next) decode(it + G, nxt);
            if (pvalid) FLUSH_PREV();
            if (has_next) load_v(nxt);
            const int m0 = cur.m0, gend = (m0 - 128) > 0 ? (m0 - 128) : 0, ng = ((m0 - gend) >> 5) + 1;
            att::u32x4 pw[5][2]; float mo, lo_;
            { att::bf16x8 qc[4] = {qf[0], qf[1], qf[2], qf[3]};
              att::dil_pass1(qc, ng, (const LAS char*)(lds + (m0 - cur.mbase) * 128), tabI + 32 + q - 4 * h2, pw, mo, lo_, lane); }
            ATT_BAR();
            const DilItem done = cur;
            if (has_next) { cur = nxt; issue_k(cur); build_tab(cur); load_q(cur); }
            att::f32x16 o[2];
            att::dil_pass2(ng, (const LAS char*)(lds + 49152 + (m0 - done.mbase) * 128), pw, o, lane);
            ATT_BAR();
            po[0] = o[0]; po[1] = o[1]; pmo = mo; plo = lo_; pdone = done; pm0 = m0; pvalid = true;
            if (has_next) {
                if (cur.mbase < 0) ATT_WAITV(8); else ATT_WAITV(10);
                asm volatile("" : "+v"(vr[0]), "+v"(vr[1]), "+v"(vr[2]), "+v"(vr[3]), "+v"(vr[4]), "+v"(vr[5]));
#pragma unroll
                for (int j = 0; j < 6; ++j) { const int k = wave + NWAVES * j; if (cur.mbase + 8 * k < 0) continue; *(LAS att::u32x4*)(lds + 49152 + k * 1024 + lane * 16) = vr[j]; }
            }
        }
        if (pvalid) FLUSH_PREV();
#undef FLUSH_PREV
#undef ATT_WAITV
#undef ATT_BAR
    }
    SEAM(5);

    if (IN(6)) {
        MK_PTRS;
        for (int row0 = gw; row0 < M; row0 += 2 * NGW) {
            f32x2 ml[2][3][3]; u32x2 oa[2][3][3]; f32x2 mlb[2][4]; u32x2 obp[2][4];
#pragma unroll
            for (int r = 0; r < 2; ++r) { const int row = (row0 + r * NGW) < M ? (row0 + r * NGW) : row0;
#pragma unroll
                for (int k = 0; k < 3; ++k) { const int col = 256 * k + 4 * lane, hd = col >> 6;
#pragma unroll
                    for (int p = 0; p < 3; ++p) ml[r][k][p] = __builtin_nontemporal_load((const f32x2*)(ML + (((size_t)p * M + row) * 12 + hd) * 2));
                    oa[r][k][0] = __builtin_nontemporal_load((const u32x2*)(OA0 + (size_t)row * 768 + col)); oa[r][k][1] = __builtin_nontemporal_load((const u32x2*)(OA1 + (size_t)row * 768 + col)); oa[r][k][2] = __builtin_nontemporal_load((const u32x2*)(OA2 + (size_t)row * 768 + col)); }
#pragma unroll
                for (int s = 0; s < 4; ++s) { mlb[r][s] = __builtin_nontemporal_load((const f32x2*)(MLB + (((size_t)s * M + row) * 4 + (lane >> 4)) * 2)); obp[r][s] = __builtin_nontemporal_load((const u32x2*)(OBP + ((size_t)s * M + row) * 256 + 4 * lane)); } }
            float va[2][3][4], vb[2][4], ssa[2], ssb[2];
#pragma unroll
            for (int r = 0; r < 2; ++r) { ssa[r] = 0.f; ssb[r] = 0.f;
#pragma unroll
                for (int k = 0; k < 3; ++k) {
                    const float Mx = fmaxf(ml[r][k][0][0], fmaxf(ml[r][k][1][0], ml[r][k][2][0]));
                    const float w0 = ml[r][k][0][1] * __builtin_amdgcn_exp2f(ml[r][k][0][0] - Mx), w1 = ml[r][k][1][1] * __builtin_amdgcn_exp2f(ml[r][k][1][0] - Mx), w2 = ml[r][k][2][1] * __builtin_amdgcn_exp2f(ml[r][k][2][0] - Mx);
                    const float iw = 1.0f / (w0 + w1 + w2);
#pragma unroll
                    for (int e = 0; e < 4; ++e) { const unsigned s0 = oa[r][k][0][e >> 1], s1 = oa[r][k][1][e >> 1], s2 = oa[r][k][2][e >> 1];
                        const float f0 = __builtin_bit_cast(float, (e & 1) ? (s0 & 0xffff0000u) : (s0 << 16)), f1 = __builtin_bit_cast(float, (e & 1) ? (s1 & 0xffff0000u) : (s1 << 16)), f2 = __builtin_bit_cast(float, (e & 1) ? (s2 & 0xffff0000u) : (s2 << 16));
                        const float v = (w0 * f0 + w1 * f1 + w2 * f2) * iw; va[r][k][e] = v; ssa[r] += v * v; } }
                { const int rowq = (row0 + r * NGW) < M ? (row0 + r * NGW) : row0, nsel = (((rowq % SEQ) >> 8) < 3) ? ((rowq % SEQ) >> 8) : 3;
                  float wq[4], Mq = -INFINITY;
#pragma unroll
                  for (int s = 0; s < 4; ++s) { const bool use = (s == 3) || (s < nsel); Mq = use ? fmaxf(Mq, mlb[r][s][0]) : Mq; }
                  float wsum = 0.f;
#pragma unroll
                  for (int s = 0; s < 4; ++s) { const bool use = (s == 3) || (s < nsel); wq[s] = use ? mlb[r][s][1] * __builtin_amdgcn_exp2f(mlb[r][s][0] - Mq) : 0.f; wsum += wq[s]; }
                  const float iwq = 1.0f / wsum;
#pragma unroll
                  for (int e = 0; e < 4; ++e) { float acc_ = 0.f;
#pragma unroll
                      for (int s = 0; s < 4; ++s) { const bool use = (s == 3) || (s < nsel); const unsigned s0 = obp[r][s][e >> 1]; const float f = __builtin_bit_cast(float, (e & 1) ? (s0 & 0xffff0000u) : (s0 << 16)); acc_ += use ? wq[s] * f : 0.f; }
                      vb[r][e] = acc_ * iwq; ssb[r] += vb[r][e] * vb[r][e]; } } }
#pragma unroll
            for (int of = 1; of < 64; of <<= 1)
#pragma unroll
                for (int r = 0; r < 2; ++r) { ssa[r] += __shfl_xor(ssa[r], of); ssb[r] += __shfl_xor(ssb[r], of); }
#pragma unroll
            for (int r = 0; r < 2; ++r) { const int row = row0 + r * NGW; if (row < M) {
                const float ra = __builtin_amdgcn_rsqf(ssa[r] * (1.0f / 768.0f) + EPS), rb = __builtin_amdgcn_rsqf(ssb[r] * (1.0f / 256.0f) + EPS);
#pragma unroll
                for (int k = 0; k < 3; ++k) { u32x2 w; w[0] = cvt_pk_bf16(va[r][k][0] * ra, va[r][k][1] * ra); w[1] = cvt_pk_bf16(va[r][k][2] * ra, va[r][k][3] * ra); *(u32x2*)(YN + (size_t)row * D + 256 * k + 4 * lane) = w; }
                { u32x2 w; w[0] = cvt_pk_bf16(vb[r][0] * rb, vb[r][1] * rb); w[1] = cvt_pk_bf16(vb[r][2] * rb, vb[r][3] * rb); *(u32x2*)(YN + (size_t)row * D + 768 + 4 * lane) = w; } } }
        }
    }
    SEAM(6);

    if (IN(7)) {
        MK_PTRS;
        { SchedWK S{G, bx, (const char*)KVC, (const char*)Wcqs}; EpiStore E{WKT, D, nullptr, nullptr, false}; pg8::gemm_phase<EpiStore, SchedWK, true>(lds, 2 * D, D, 4, S, E); }
        { SchedVW S{G, (bx + G / 2) % G, (const char*)KVC, (const char*)Wco}; EpiStore E{VWT, D, nullptr, nullptr, false}; pg8::gemm_phase<EpiStore, SchedVW, true>(lds, D, 2 * D, 4, S, E); }
        SchedStd S; S.o.init(M, D, G, bx); S.A = (const char*)YN; S.B = (const char*)Wout; S.a_tile = (size_t)256 * D * 2; S.b_tile = (size_t)256 * D * 2; S.b_batch = 0; S.ocol_mul = 256;
        EpiRes<false> E{XB, SS2, 1.0f, nullptr}; pg8::gemm_phase<EpiRes<false>, SchedStd, true>(lds, D, D, D / 64, S, E);
    }
    SEAM(7);

    if (IN(8)) {
        MK_PTRS;
        SchedStd S; S.o.init(M, D, G, bx); S.A = (const char*)XB; S.B = (const char*)WKT; S.a_tile = (size_t)256 * D * 2; S.b_tile = (size_t)256 * D * 2; S.b_batch = (size_t)D * D * 2; S.ocol_mul = 256;
        EpiSoftmax E{PB, SS2}; pg8::gemm_phase<EpiSoftmax, SchedStd, true>(lds, D, D, D / 64, S, E);
    }
    SEAM(8);

    if (IN(9)) {
        MK_PTRS;
        SchedStd S; S.o.init(M, D, G, bx); S.A = (const char*)PB; S.B = (const char*)VWT; S.a_tile = (size_t)256 * D * 2; S.b_tile = (size_t)256 * D * 2; S.b_batch = (size_t)D * D * 2; S.ocol_mul = 256;
        EpiRes<F8_2G> E{XB, SS3, 1.0f, X8}; pg8::gemm_phase<EpiRes<F8_2G>, SchedStd, true>(lds, D, D, D / 64, S, E);
    }
    SEAM(9);

    if (IN(10)) {
        MK_PTRS;
        STAGGER();
        constexpr int EB = F8_2G ? 1 : 2;
        SchedStd S; S.o.init(M, 2 * DFF, G, bx); S.A = F8_2G ? (const char*)X8 : (const char*)XB; S.B = (const char*)Wgu2; S.a_tile = (size_t)256 * D * EB; S.b_tile = (size_t)256 * D * EB; S.b_batch = 0; S.ocol_mul = 128;
        EpiGU<F8_2G, F8_2D, false> E{HB, SS3, nullptr, nullptr}; pg8::gemm_phase<EpiGU<F8_2G, F8_2D, false>, SchedStd, true, F8_2G ? 1 : 0>(lds, D * EB / 2, D * EB / 2, D * EB / 128, S, E);
    }
    SEAM(10);

    if (IN(11)) {
        MK_PTRS;
        constexpr int EB = F8_2D ? 1 : 2;
        SchedStd S; S.o.init(M, D, G, bx); S.A = (const char*)HB; S.B = (const char*)Wd2; S.a_tile = (size_t)256 * DFF * EB; S.b_tile = (size_t)256 * DFF * EB; S.b_batch = 0; S.ocol_mul = 256;
        EpiRes<false> E{XB, SS4, F8_2D ? 0.5f / (F8_H * F8_WD) : 0.5f, nullptr}; pg8::gemm_phase<EpiRes<false>, SchedStd, true, F8_2D>(lds, DFF * EB / 2, DFF * EB / 2, DFF * EB / 128, S, E);
    }
    SEAM(11);

    if (IN(12)) {
        MK_PTRS;
        const float* gf = args.in[19];
        for (int row0 = gw; row0 < M; row0 += 4 * NGW) {
            u32x2 w[4][4]; float rs[4]; const f32x4* gr = (const f32x4*)gf + lane;
#pragma unroll
            for (int r = 0; r < 4; ++r) { const int row = (row0 + r * NGW) < M ? (row0 + r * NGW) : row0; const u32x2* xr = (const u32x2*)(XB + (size_t)row * D) + lane;
#pragma unroll
                for (int j = 0; j < 4; ++j) w[r][j] = __builtin_nontemporal_load(xr + 64 * j);
                rs[r] = row_rstd(SS4, row); }
#pragma unroll
            for (int r = 0; r < 4; ++r) { const int row = row0 + r * NGW; if (row < M) { f32x4* orow = (f32x4*)(out + (size_t)row * D) + lane;
#pragma unroll
                for (int j = 0; j < 4; ++j) { f32x4 v; v[0] = __builtin_bit_cast(float, w[r][j][0] << 16); v[1] = __builtin_bit_cast(float, w[r][j][0] & 0xffff0000u); v[2] = __builtin_bit_cast(float, w[r][j][1] << 16); v[3] = __builtin_bit_cast(float, w[r][j][1] & 0xffff0000u);
                    __builtin_nontemporal_store(v * rs[r] * gr[64 * j], orow + 64 * j); } } }
        }
    }
#undef IN
#undef SEAM
}
}


#if MK_DEBUG
namespace dbg {
__global__ void __launch_bounds__(256) cmp_f32(const float* a, const float* r, size_t n, float* acc) {
    float num = 0.f, den = 0.f;
    for (size_t i = (size_t)blockIdx.x * 256 + threadIdx.x; i < n; i += (size_t)gridDim.x * 256) { const float d = a[i] - r[i]; num += d * d; den += r[i] * r[i]; }
    for (int o = 32; o > 0; o >>= 1) { num += __shfl_xor(num, o); den += __shfl_xor(den, o); }
    if ((threadIdx.x & 63) == 0) { atomicAdd(acc, num); atomicAdd(acc + 1, den); }
}
__global__ void __launch_bounds__(256) cmp_bf16(const unsigned short* a, int lda, const float* colscale, const float* r, int ldr, int rows, int cols, float* acc) {
    float num = 0.f, den = 0.f; const size_t n = (size_t)rows * cols;
    for (size_t i = (size_t)blockIdx.x * 256 + threadIdx.x; i < n; i += (size_t)gridDim.x * 256) { const size_t row = i / cols; const int c = (int)(i % cols);
        const float av = __builtin_bit_cast(float, (unsigned)a[row * lda + c] << 16) * (colscale ? colscale[c] : 1.0f); const float rv = r[row * ldr + c]; const float d = av - rv; num += d * d; den += rv * rv; }
    for (int o = 32; o > 0; o >>= 1) { num += __shfl_xor(num, o); den += __shfl_xor(den, o); }
    if ((threadIdx.x & 63) == 0) { atomicAdd(acc, num); atomicAdd(acc + 1, den); }
}
__global__ void __launch_bounds__(256) cmp_p(const unsigned short* a, const float* r, float* acc) {
    float num = 0.f, den = 0.f; const size_t n = (size_t)4096 * 1024;
    for (size_t i = (size_t)blockIdx.x * 256 + threadIdx.x; i < n; i += (size_t)gridDim.x * 256) { const size_t row = i / 1024; const int c = (int)(i % 1024);
        const float av = __builtin_bit_cast(float, (unsigned)a[i] << 16); const float rv = r[(size_t)(c >> 8) * 4096 * 256 + row * 256 + (c & 255)]; const float d = av - rv; num += d * d; den += rv * rv; }
    for (int o = 32; o > 0; o >>= 1) { num += __shfl_xor(num, o); den += __shfl_xor(den, o); }
    if ((threadIdx.x & 63) == 0) { atomicAdd(acc, num); atomicAdd(acc + 1, den); }
}
__global__ void build_scales(float* qkvs, float* gcat, const float* goa, const float* gob) {
    const int i = blockIdx.x * 256 + threadIdx.x;
    if (i < 3072) qkvs[i] = ((i < 768) || (i >= 2304 && i < 2560)) ? 8.0f : 1.0f;
    if (i < 1024) gcat[i] = i < 768 ? goa[i] : gob[i - 768];
}
constexpr int NST = 8;
__global__ void __launch_bounds__(256) finalize(float* out, size_t n, const float* acc, int report) {
    const float tol[NST] = {0.03f, 0.03f, 1e9f  , 0.08f, 0.03f, 0.05f, 0.03f, 0.03f};
    float E = 0.f;
    if (report > 0) { const float e = sqrtf(acc[2 * (report - 1)] / acc[2 * (report - 1) + 1]); E = (e == e) ? fminf(e, 3.0f) : 3.0f; }
    else { for (int k = NST - 1; k >= 0; --k) { const float e = sqrtf(acc[2 * k] / acc[2 * k + 1]); if (!(e <= tol[k])) E = 0.1f * (k + 1); } }
    for (size_t i = (size_t)blockIdx.x * 256 + threadIdx.x; i < n; i += (size_t)gridDim.x * 256) out[i] *= (1.0f + E);
}
}
#endif

static void mk_launch(const mk::Args& a0, int lo, int hi, int grid, hipStream_t st) {
    mk::Args a = a0; a.ph_lo = lo; a.ph_hi = hi;
    hipLaunchKernelGGL(mk::mk_fwd, dim3(grid), dim3(mk::NWAVES * 64), mk::LDS_BYTES, st, a);
    const hipError_t le = hipPeekAtLastError();
    if (le != hipSuccess) fprintf(stderr, "kernel_launch: launch of phases [%d,%d) failed: %s\n", lo, hi, hipGetErrorName(le));
}

extern "C" void kernel_launch(void* const* d_in, const int* in_sizes, int n_in, void* d_out, int out_size, void* d_ws, size_t ws_size, hipStream_t stream) {
    static int grid = 0;
    if (grid == 0) {
        if (n_in != 20 || out_size != 8 * 4096 * 1024) { fprintf(stderr, "kernel_launch: unexpected shapes (n_in %d out %d)\n", n_in, out_size); grid = -1; return; }
        int dev = 0, cus = 0, per_cu = 0;
        if (hipGetDevice(&dev) != hipSuccess || hipDeviceGetAttribute(&cus, hipDeviceAttributeMultiprocessorCount, dev) != hipSuccess) { grid = -1; return; }
        if (hipFuncSetAttribute((const void*)mk::mk_fwd, hipFuncAttributeMaxDynamicSharedMemorySize, mk::LDS_BYTES) != hipSuccess) { fprintf(stderr, "kernel_launch: hipFuncSetAttribute failed\n"); grid = -1; return; }
        if (hipOccupancyMaxActiveBlocksPerMultiprocessor(&per_cu, (const void*)mk::mk_fwd, mk::NWAVES * 64, mk::LDS_BYTES) != hipSuccess || per_cu < 1) fprintf(stderr, "kernel_launch: occupancy query reports %d workgroups per CU\n", per_cu);
        (void)hipGetLastError();
        grid = cus;
    }
    if (grid < 0) return;
    unsigned char* ws = (unsigned char*)d_ws;
#if MK_DEBUG
    const size_t ref_off = (mk::WS_END + 4095) / 4096 * 4096;
    size_t off = ref_off + (size_t)290 * 1024 * 1024;
    auto take = [&](size_t bytes) { unsigned char* p = ws + off; off += (bytes + 255) / 256 * 256; return p; };
    float* sx1 = (float*)take((size_t)4096 * 1024 * 4); float* sx2 = (float*)take((size_t)4096 * 1024 * 4); float* sx3 = (float*)take((size_t)4096 * 1024 * 4);
    float* mkout = (float*)take((size_t)4096 * 1024 * 4); float* qkvs = (float*)take(3072 * 4); float* gcat = (float*)take(1024 * 4); float* acc = (float*)take(256);
    if (off > ws_size) { fprintf(stderr, "kernel_launch: debug build needs %zu bytes of workspace, got %zu\n", off, ws_size); return; }
    ref::Snap snap{sx1, sx2, sx3};
    ref::forward(d_in, (float*)d_out, ws + ref_off, stream, &snap);
    (void)hipMemsetAsync(ws + mk::WS_CTL, 0, mk::CTL_BYTES, stream);
    (void)hipMemsetAsync(acc, 0, 256, stream);
    dbg::build_scales<<<12, 256, 0, stream>>>(qkvs, gcat, (const float*)d_in[8], (const float*)d_in[9]);
    mk::Args a{};
    for (int i = 0; i < 20; ++i) a.in[i] = (const float*)d_in[i];
    a.in[0] = (const float*)d_in[0] + (size_t)7 * 4096 * 1024; a.in[1] = (const float*)d_in[1] + (size_t)7 * 256 * 1024;
    a.out = mkout; a.ws = ws;
    const ref::Bufs& rb = ref::g_bufs;
    for (int ph = 0; ph < mk::NPH; ++ph) {
        mk_launch(a, ph, ph + 1, grid, stream);
        if (ph == 5) dbg::cmp_bf16<<<512, 256, 0, stream>>>((const unsigned short*)(ws + mk::WS_KVC), 2048, nullptr, rb.kvc, 2048, 256, 2048, acc + 0);
        if (ph == 2) dbg::cmp_bf16<<<512, 256, 0, stream>>>((const unsigned short*)(ws + mk::WS_XB), 1024, nullptr, sx1, 1024, 4096, 1024, acc + 2);
        if (ph == 3) dbg::cmp_bf16<<<512, 256, 0, stream>>>((const unsigned short*)(ws + mk::WS_R1), 3072, qkvs, rb.proj, 3072, 4096, 3072, acc + 4);
        if (ph == 6) dbg::cmp_bf16<<<512, 256, 0, stream>>>((const unsigned short*)(ws + mk::WS_R1), 1024, gcat, rb.yn, 1024, 4096, 1024, acc + 6);
        if (ph == 7) dbg::cmp_bf16<<<512, 256, 0, stream>>>((const unsigned short*)(ws + mk::WS_XB), 1024, nullptr, sx2, 1024, 4096, 1024, acc + 8);
        if (ph == 8) dbg::cmp_p<<<512, 256, 0, stream>>>((const unsigned short*)(ws + mk::WS_R1), rb.sc, acc + 10);
        if (ph == 9) dbg::cmp_bf16<<<512, 256, 0, stream>>>((const unsigned short*)(ws + mk::WS_XB), 1024, nullptr, sx3, 1024, 4096, 1024, acc + 12);
        if (ph == 12) dbg::cmp_f32<<<512, 256, 0, stream>>>(mkout, (const float*)d_out + (size_t)7 * 4096 * 1024, (size_t)4096 * 1024, acc + 14);
    }
    dbg::finalize<<<1024, 256, 0, stream>>>((float*)d_out, (size_t)8 * 4096 * 1024, acc, MK_REPORT);
#else
    if (ws_size < mk::WS_END) { fprintf(stderr, "kernel_launch: needs %zu bytes of workspace, got %zu\n", (size_t)mk::WS_END, ws_size); return; }
    if (hipMemsetAsync(ws + mk::WS_CTL, 0, mk::CTL_BYTES, stream) != hipSuccess) return;
    mk::Args a{};
    for (int i = 0; i < 20; ++i) a.in[i] = (const float*)d_in[i];
    a.out = (float*)d_out; a.ws = ws;
#if MK_N_LAUNCHES == 1
    mk_launch(a, 0, mk::NPH, grid, stream);
#else
    for (int ph = 0; ph < mk::NPH; ++ph) {
        for (int r = 0; r < MK_REPEAT_N; ++r) if (ph == MK_REPEAT) { mk::Args a2 = a; a2.flags = MK_REPEAT_FLAGS; mk_launch(a2, ph, ph + 1, grid, stream); }
        mk_launch(a, ph, ph + 1, grid, stream); }
#endif
#endif
}
```

```cpp
#include <hip/hip_runtime.h>
#include <cstdio>
#include <cstdint>
#include <cmath>
#define MK_REPEAT -1
#define MK_REPEAT_N 1
#define MK_REPEAT_FLAGS 0
#define MK_STAGGER_TICKS 0
#define MK_NT_PART false
#define MK_TIMING 0
#define MK_TQ 0.02f
#define MK_PROBE_SAME 0
#define MK_FP8_FFN1 6
#define MK_FP8_FFN2 3
#define MK_PREF 0
#define MK_C8 1
#define MK_O8 1
#define MK_Q8 4
#define MK_DEBUG 0
#define MK_REPORT 0
#define MK_N_LAUNCHES 1
#define MK_NBAT 8

namespace pg8 {
#define PG8_LAS __attribute__((address_space(3)))
typedef unsigned short bf16_t;
typedef short bf16x8 __attribute__((ext_vector_type(8)));
typedef float f32x4 __attribute__((ext_vector_type(4)));
typedef float f32x2 __attribute__((ext_vector_type(2)));
typedef unsigned u32x4 __attribute__((ext_vector_type(4)));
typedef unsigned u32x2 __attribute__((ext_vector_type(2)));
typedef int i32x4 __attribute__((ext_vector_type(4)));
typedef double f64x2 __attribute__((ext_vector_type(2)));
typedef int i32x8 __attribute__((ext_vector_type(8)));
constexpr int BM = 256, BK = 64, HALF = 128, HTB = HALF * BK * 2  , STAGE_BYTES = 8 * HTB, NXCD = 8, WGM = 8;

__host__ __device__ __forceinline__ int lds_byte(int r, int c) { const int st = (r >> 4) * 2 + (c >> 5), rr = r & 15, cc = c & 31, ob = rr * 64 + cc * 2; return st * 1024 + (ob ^ (((ob >> 9) & 1) << 5)); }
__host__ __device__ __forceinline__ void stage_rc(int b, int& R, int& C) { const int st = b / 1024, sb = b % 1024, swz = sb ^ (((sb >> 9) & 1) << 5); R = (st >> 1) * 16 + swz / 64; C = (st & 1) * 32 + (swz % 64) / 2; }
__host__ __device__ __forceinline__ int perm32(int rho) { const int n = rho >> 4, i = rho & 15; return 8 * (i >> 2) + 4 * n + (i & 3); }

struct Unit { const char* a; const char* b; int orow, ocol, aux; };

struct Order {
    int nM, nN, nwg, G, c;
    __device__ __forceinline__ void init(int M, int N, int G_, int c_) { nM = M / BM; nN = N / BM; nwg = nM * nN; G = G_; c = c_; }
    __device__ __forceinline__ bool tile(int i, int& pm, int& pn) const {
        const long L = (long)i * G + c; if (L >= nwg) return false;
        int wgid = (int)L; { const int q = nwg / NXCD, r = nwg % NXCD, xcd = wgid % NXCD, off = wgid / NXCD; wgid = (xcd < r ? xcd * (q + 1) : r * (q + 1) + (xcd - r) * q) + off; }
        const int nig = WGM * nN, gid = wgid / nig, fm = gid * WGM, gsz = (nM - fm) < WGM ? (nM - fm) : WGM;
        pm = fm + ((wgid % nig) % gsz); pn = (wgid % nig) / gsz; return true;
    }
};

__device__ __forceinline__ unsigned cvt_pk_bf16(float lo, float hi) { unsigned r; asm volatile("v_cvt_pk_bf16_f32 %0, %1, %2" : "=v"(r) : "v"(lo), "v"(hi)); return r; }

template <class Epi, class Sched, bool ALIGN_EPI, int MODE = 0>
__device__ __forceinline__ void gemm_phase(PG8_LAS unsigned char* lds, const int lda, const int ldb, const int nt, const Sched& S, const Epi& E) {
    int tid_ = threadIdx.x; asm volatile("" : "+v"(tid_));
    const int tid = tid_, wid = __builtin_amdgcn_readfirstlane(tid >> 6), lane = tid & 63, wr = wid >> 2, wc = wid & 3, fr = lane & 15, fq = lane >> 4;
    unsigned voffA[2], voffB[2];
#pragma unroll
    for (int i = 0; i < 2; ++i) { int R, C; stage_rc(tid * 16 + i * 8192, R, C); const int Rb = Epi::PERM ? ((R & ~31) + perm32(R & 31)) : R;
        voffA[i] = (unsigned)(R * lda + C) * 2u; voffB[i] = (unsigned)(Rb * ldb + C) * 2u; }
    const size_t kstep = (size_t)(BK * 2);
    const size_t hstepA = (size_t)HALF * lda * 2, hstepB = (size_t)HALF * ldb * 2;
    const unsigned ldsw = (unsigned)wid * 1024u;
    const int aoff = lds_byte(wr * 64 + fr, fq * 8), boff = lds_byte(wc * 32 + fr, fq * 8);
#define PG8_SA(b, h) (((b) * 2 + (h)) * HTB)
#define PG8_SB(b, h) ((4 + (b) * 2 + (h)) * HTB)
#define PG8_STAGE(bufoff, gbase, voff) do { _Pragma("unroll") for (int _i = 0; _i < 2; ++_i) \
        __builtin_amdgcn_global_load_lds((const unsigned*)((const char*)(gbase) + (voff)[_i]), (PG8_LAS unsigned*)(lds + (bufoff) + ldsw + _i * 8192), 16, 0, 0); } while (0)
#define PG8_LDA(dst, b, h) do { _Pragma("unroll") for (int m = 0; m < 4; ++m) _Pragma("unroll") for (int k = 0; k < 2; ++k) dst[m][k] = *(const PG8_LAS bf16x8*)(lds + PG8_SA(b, h) + aoff + m * 2048 + k * 1024); } while (0)
#define PG8_LDB(dst, b, h) do { _Pragma("unroll") for (int n = 0; n < 2; ++n) _Pragma("unroll") for (int k = 0; k < 2; ++k) dst[n][k] = *(const PG8_LAS bf16x8*)(lds + PG8_SB(b, h) + boff + n * 2048 + k * 1024); } while (0)
#define PG8_MMA(ai, bj, At, Bt) do { __builtin_amdgcn_s_setprio(1); _Pragma("unroll") for (int m = 0; m < 4; ++m) _Pragma("unroll") for (int n = 0; n < 2; ++n) { \
        if constexpr (FP8) { const i32x8 bb_ = __builtin_shufflevector(__builtin_bit_cast(i32x4, Bt[n][0]), __builtin_bit_cast(i32x4, Bt[n][1]), 0, 1, 2, 3, 4, 5, 6, 7); \
            const i32x8 aa_ = __builtin_shufflevector(__builtin_bit_cast(i32x4, At[m][0]), __builtin_bit_cast(i32x4, At[m][1]), 0, 1, 2, 3, 4, 5, 6, 7); \
            asm volatile("v_mfma_scale_f32_16x16x128_f8f6f4 %0, %1, %2, %0, %3, %3 op_sel_hi:[0,0,0]" : "+v"(acc[ai][bj][m][n]) : "v"(bb_), "v"(aa_), "v"(sc1)); } \
        else if constexpr (I8) { _Pragma("unroll") for (int k = 0; k < 2; ++k) acc[ai][bj][m][n] = __builtin_bit_cast(f32x4, __builtin_amdgcn_mfma_i32_16x16x64_i8(__builtin_bit_cast(i32x4, Bt[n][k]), __builtin_bit_cast(i32x4, At[m][k]), __builtin_bit_cast(i32x4, acc[ai][bj][m][n]), 0, 0, 0)); } \
        else { _Pragma("unroll") for (int k = 0; k < 2; ++k) acc[ai][bj][m][n] = __builtin_amdgcn_mfma_f32_16x16x32_bf16(Bt[n][k], At[m][k], acc[ai][bj][m][n], 0, 0, 0); } } \
        __builtin_amdgcn_s_setprio(0); } while (0)
#define PG8_WAIT_V(n) asm volatile("s_waitcnt vmcnt(" #n ")" ::: "memory")
#define PG8_WAIT_L(n) asm volatile("s_waitcnt lgkmcnt(" #n ")" ::: "memory")
#define PG8_BAR __builtin_amdgcn_s_barrier()
#define PG8_SCHED __builtin_amdgcn_sched_barrier(0)
    constexpr bool FP8 = MODE == 1, I8 = MODE == 2;
    int sc1 = 0x7F7F7F7F; asm volatile("" : "+v"(sc1)); (void)sc1;
    Unit cur, nxt; int ui = 0;
    if (!S.next(0, cur)) return;
    f32x4 acc[2][2][4][2];
#pragma unroll
    for (int a = 0; a < 2; ++a)
#pragma unroll
        for (int b = 0; b < 2; ++b)
#pragma unroll
            for (int m = 0; m < 4; ++m)
#pragma unroll
                for (int n = 0; n < 2; ++n) acc[a][b][m][n] = (f32x4){0.f, 0.f, 0.f, 0.f};
    bf16x8 At[4][2], B0[2][2], B1[2][2];
    const char* cA = cur.a; const char* cB = cur.b;
    PG8_STAGE(PG8_SB(0, 0), cB, voffB); PG8_STAGE(PG8_SB(0, 1), cB + hstepB, voffB); PG8_STAGE(PG8_SA(0, 0), cA, voffA); PG8_STAGE(PG8_SA(0, 1), cA + hstepA, voffA);
    if (wr == 1) PG8_BAR;
    PG8_WAIT_V(2); PG8_BAR;
    PG8_STAGE(PG8_SB(1, 0), cB + kstep, voffB); PG8_STAGE(PG8_SA(1, 0), cA + kstep, voffA); PG8_STAGE(PG8_SB(1, 1), cB + hstepB + kstep, voffB);
    PG8_WAIT_V(6); PG8_BAR;
    for (;;) {
        const bool has_next = S.next(ui + 1, nxt);
        const char* nA = has_next ? nxt.a : cA; const char* nB = has_next ? nxt.b : cB;
#pragma unroll 1
        for (int t = 0; t < nt; t += 2) {
            const bool last = (t == nt - 2);
            const char* a1 = cA + (size_t)(t + 1) * kstep;
            const char* a2 = last ? nA : cA + (size_t)(t + 2) * kstep; const char* b2 = last ? nB : cB + (size_t)(t + 2) * kstep;
            const char* a3 = a2 + kstep; const char* b3 = b2 + kstep;
            if constexpr (Epi::STATS) { if (last) E.stats_dma(lds, cur, wid, lane); }
            PG8_LDB(B0, 0, 0); PG8_LDB(B1, 0, 1); PG8_SCHED; PG8_LDA(At, 0, 0); PG8_STAGE(PG8_SA(1, 1), a1 + hstepA, voffA);
            PG8_WAIT_V(8); PG8_WAIT_L(0); PG8_BAR; PG8_MMA(0, 0, At, B0); PG8_MMA(0, 1, At, B1); PG8_BAR; PG8_SCHED;
            PG8_LDA(At, 0, 1); PG8_STAGE(PG8_SB(0, 0), b2, voffB); PG8_STAGE(PG8_SB(0, 1), b2 + hstepB, voffB); PG8_STAGE(PG8_SA(0, 0), a2, voffA);
            PG8_WAIT_V(8); PG8_WAIT_L(0); PG8_BAR; PG8_MMA(1, 0, At, B0); PG8_MMA(1, 1, At, B1); PG8_BAR; PG8_SCHED;
            PG8_LDB(B0, 1, 0); PG8_LDB(B1, 1, 1); PG8_SCHED; PG8_LDA(At, 1, 0); PG8_STAGE(PG8_SA(0, 1), a2 + hstepA, voffA);
            PG8_WAIT_V(8); PG8_WAIT_L(0); PG8_BAR; PG8_MMA(0, 0, At, B0); PG8_MMA(0, 1, At, B1); PG8_BAR; PG8_SCHED;
            PG8_LDA(At, 1, 1); PG8_STAGE(PG8_SB(1, 0), b3, voffB); PG8_STAGE(PG8_SB(1, 1), b3 + hstepB, voffB); PG8_STAGE(PG8_SA(1, 0), a3, voffA);
            PG8_WAIT_V(8); PG8_WAIT_L(0); PG8_BAR; PG8_MMA(1, 0, At, B0); PG8_MMA(1, 1, At, B1); PG8_BAR; PG8_SCHED;
        }
        if constexpr (ALIGN_EPI) { if (wr == 0) PG8_BAR; }
        if constexpr (Epi::STATS) { static_assert(ALIGN_EPI, ""); PG8_WAIT_V(16); PG8_BAR; E.stats_reduce(lds, tid); PG8_WAIT_L(0); PG8_BAR; }
        if constexpr (FP8) asm volatile("s_nop 15\n\ts_nop 7" ::: "memory");
        E(acc, cur, wr, wc, fr, fq, lds, wid, lane);
        if (!has_next) break;
#pragma unroll
        for (int a = 0; a < 2; ++a)
#pragma unroll
            for (int b = 0; b < 2; ++b)
#pragma unroll
                for (int m = 0; m < 4; ++m)
#pragma unroll
                    for (int n = 0; n < 2; ++n) { f64x2 z; asm volatile("v_mov_b64 %0, 0\n\tv_mov_b64 %1, 0" : "=v"(z[0]), "=v"(z[1])); acc[a][b][m][n] = __builtin_bit_cast(f32x4, z); }
        cur = nxt; cA = nA; cB = nB; ++ui;
        if constexpr (ALIGN_EPI) { if (wr == 1) PG8_BAR; }
    }
    PG8_WAIT_V(0);
    if constexpr (!ALIGN_EPI) { if (wr == 0) PG8_BAR; }
    PG8_BAR;
#undef PG8_SA
#undef PG8_SB
#undef PG8_STAGE
#undef PG8_LDA
#undef PG8_LDB
#undef PG8_MMA
#undef PG8_WAIT_V
#undef PG8_WAIT_L
#undef PG8_BAR
#undef PG8_SCHED
}
}

namespace att {
#define ATT_LAS __attribute__((address_space(3)))
typedef short bf16x8 __attribute__((ext_vector_type(8)));
typedef short v4i16 __attribute__((ext_vector_type(4)));
typedef float f32x16 __attribute__((ext_vector_type(16)));
typedef float f32x4 __attribute__((ext_vector_type(4)));
typedef unsigned u32x4 __attribute__((ext_vector_type(4)));
typedef unsigned u32x2 __attribute__((ext_vector_type(2)));
constexpr float LOG2E = 1.4426950408889634f;
constexpr int TABA_N = 192, TABB_N = 1600;

__device__ __forceinline__ int rel_bucket(int n) {
    if (n < 16) return n < 0 ? 0 : n;
    int b = 16;
    b += (n >= 22); b += (n >= 30); b += (n >= 40); b += (n >= 54); b += (n >= 73); b += (n >= 99); b += (n >= 134); b += (n >= 182);
    b += (n >= 246); b += (n >= 332); b += (n >= 450); b += (n >= 609); b += (n >= 825); b += (n >= 1117); b += (n >= 1513);
    return b;
}
__device__ __forceinline__ unsigned pk_bf16(float lo, float hi) { unsigned r; asm volatile("v_cvt_pk_bf16_f32 %0, %1, %2" : "=v"(r) : "v"(lo), "v"(hi)); return r; }
__device__ __forceinline__ float bf16_round(float x) { unsigned u = __builtin_bit_cast(unsigned, x); u = (u + 0x7fffu + ((u >> 16) & 1u)) & 0xffff0000u; return __builtin_bit_cast(float, u); }

__device__ __forceinline__ void glds16(const void* gsrc, unsigned lds_dst) { unsigned keep;
    asm volatile("s_mov_b32 %0, m0\n\ts_mov_b32 m0, %2\n\ts_nop 0\n\tglobal_load_lds_dwordx4 %1, off\n\ts_mov_b32 m0, %0" : "=&s"(keep) : "v"(gsrc), "s"(lds_dst) : "memory"); }
__device__ __forceinline__ void dma_rows8(const char* krow0  , const int voff, const int row  ,
                                          ATT_LAS char* kdst  , ATT_LAS char* vdst, const int lane) {
    const int pc = lane & 7;
    glds16(krow0 + 16 * (pc ^ ((row >> 1) & 7)), (unsigned)__builtin_amdgcn_readfirstlane((int)(unsigned)(uintptr_t)kdst));
    glds16(krow0 + voff + 16 * (pc ^ (((row >> 1) & 1) << 2)), (unsigned)__builtin_amdgcn_readfirstlane((int)(unsigned)(uintptr_t)vdst));
}

__device__ __forceinline__ void attn_group(const bf16x8 (&qf)[4], f32x16 (&o)[2], float& m, float& l, const ATT_LAS char* kg, const ATT_LAS char* vg, const ATT_LAS float* tp, const int lane) {
    const int q = lane & 31, h = lane >> 5;
    const ATT_LAS char* kr0 = kg + q * 128; const int kswz = (q >> 1) & 7;
    typedef float f32x2_ __attribute__((ext_vector_type(2)));
    f32x2_ t0, t1, t2, t3, t4, t5, t6, t7;
    { const unsigned ta = (unsigned)(uintptr_t)(tp - 27);
      asm volatile("ds_read2_b32 %0, %8 offset0:27 offset1:26\n\tds_read2_b32 %1, %8 offset0:25 offset1:24\n\tds_read2_b32 %2, %8 offset0:19 offset1:18\n\tds_read2_b32 %3, %8 offset0:17 offset1:16\n\t"
                   "ds_read2_b32 %4, %8 offset0:11 offset1:10\n\tds_read2_b32 %5, %8 offset0:9 offset1:8\n\tds_read2_b32 %6, %8 offset0:3 offset1:2\n\tds_read2_b32 %7, %8 offset0:1 offset1:0"
                   : "=&v"(t0), "=&v"(t1), "=&v"(t2), "=&v"(t3), "=&v"(t4), "=&v"(t5), "=&v"(t6), "=&v"(t7) : "v"(ta) : "memory"); }
    const int q4 = (lane & 15) >> 2, p4 = lane & 3, g1 = (lane >> 4) & 1, vsw = (q4 >> 1) & 1;
    const unsigned va0_ = (unsigned)(uintptr_t)(vg + (4 * h + q4) * 128 + 32 * g1 + 8 * p4 + 64 * vsw), va1_ = (unsigned)(uintptr_t)(vg + (4 * h + q4) * 128 + 32 * g1 + 8 * p4 + 64 * (1 ^ vsw));
    v4i16 a[2][4];
    asm volatile("ds_read_b64_tr_b16 %0, %8\n\tds_read_b64_tr_b16 %1, %8 offset:1024\n\tds_read_b64_tr_b16 %2, %8 offset:2048\n\tds_read_b64_tr_b16 %3, %8 offset:3072\n\t"
                 "ds_read_b64_tr_b16 %4, %9\n\tds_read_b64_tr_b16 %5, %9 offset:1024\n\tds_read_b64_tr_b16 %6, %9 offset:2048\n\tds_read_b64_tr_b16 %7, %9 offset:3072"
                 : "=&v"(a[0][0]), "=&v"(a[0][1]), "=&v"(a[0][2]), "=&v"(a[0][3]), "=&v"(a[1][0]), "=&v"(a[1][1]), "=&v"(a[1][2]), "=&v"(a[1][3]) : "v"(va0_), "v"(va1_) : "memory");
    f32x16 s = f32x16{};
#pragma unroll
    for (int d0 = 0; d0 < 4; ++d0) { const bf16x8 kf = *(const ATT_LAS bf16x8*)(kr0 + 16 * ((2 * d0 + h) ^ kswz)); s = __builtin_amdgcn_mfma_f32_32x32x16_bf16(kf, qf[d0], s, 0, 0, 0); }
    asm volatile("s_waitcnt lgkmcnt(0)" : "+v"(t0), "+v"(t1), "+v"(t2), "+v"(t3), "+v"(t4), "+v"(t5), "+v"(t6), "+v"(t7), "+v"(a[0][0]), "+v"(a[0][1]), "+v"(a[0][2]), "+v"(a[0][3]), "+v"(a[1][0]), "+v"(a[1][1]), "+v"(a[1][2]), "+v"(a[1][3]) :: "memory");
    float mx = -INFINITY;
    { const float tb_[16] = {t0[0], t0[1], t1[0], t1[1], t2[0], t2[1], t3[0], t3[1], t4[0], t4[1], t5[0], t5[1], t6[0], t6[1], t7[0], t7[1]};
#pragma unroll
      for (int r = 0; r < 16; ++r) s[r] = fmaf(s[r], LOG2E, tb_[r]); }
#pragma unroll
    for (int r = 0; r < 16; r += 2) mx = fmaxf(mx, fmaxf(s[r], s[r + 1]));
    mx = fmaxf(mx, __shfl_xor(mx, 32));
    if (__any(mx > m)) {
        const float mnew = fmaxf(m, mx), alpha = __builtin_amdgcn_exp2f(m - mnew);
        l *= alpha; m = mnew;
#pragma unroll
        for (int r = 0; r < 16; ++r) { o[0][r] *= alpha; o[1][r] *= alpha; }
    }
    float ps = 0.f;
#pragma unroll
    for (int r = 0; r < 16; ++r) { s[r] = __builtin_amdgcn_exp2f(s[r] - m); ps += s[r]; }
    l += ps;
    u32x4 pw0, pw1;
    pw0[0] = pk_bf16(s[0], s[1]); pw0[1] = pk_bf16(s[2], s[3]); pw0[2] = pk_bf16(s[4], s[5]); pw0[3] = pk_bf16(s[6], s[7]);
    pw1[0] = pk_bf16(s[8], s[9]); pw1[1] = pk_bf16(s[10], s[11]); pw1[2] = pk_bf16(s[12], s[13]); pw1[3] = pk_bf16(s[14], s[15]);
    const bf16x8 pb0 = __builtin_bit_cast(bf16x8, pw0), pb1 = __builtin_bit_cast(bf16x8, pw1);
#pragma unroll
    for (int dh = 0; dh < 2; ++dh) {
        const bf16x8 va0 = (bf16x8){a[dh][0][0], a[dh][0][1], a[dh][0][2], a[dh][0][3], a[dh][1][0], a[dh][1][1], a[dh][1][2], a[dh][1][3]};
        const bf16x8 va1 = (bf16x8){a[dh][2][0], a[dh][2][1], a[dh][2][2], a[dh][2][3], a[dh][3][0], a[dh][3][1], a[dh][3][2], a[dh][3][3]};
        o[dh] = __builtin_amdgcn_mfma_f32_32x32x16_bf16(va0, pb0, o[dh], 0, 0, 0);
        o[dh] = __builtin_amdgcn_mfma_f32_32x32x16_bf16(va1, pb1, o[dh], 0, 0, 0);
    }
}

__device__ __forceinline__ void dma_k_rows8(const char* krow, const int row, ATT_LAS char* kdst, const int lane) {
    glds16(krow + 16 * ((lane & 7) ^ ((row >> 1) & 7)), (unsigned)__builtin_amdgcn_readfirstlane((int)(unsigned)(uintptr_t)kdst)); }
__device__ __forceinline__ void dma_v_rows8(const char* vrow, const int row, ATT_LAS char* vdst, const int lane) {
    glds16(vrow + 16 * ((lane & 7) ^ (((row >> 1) & 1) << 2)), (unsigned)__builtin_amdgcn_readfirstlane((int)(unsigned)(uintptr_t)vdst)); }
template <int NG>
__device__ __forceinline__ void dil_pass1(const bf16x8 (&qf)[4], const int ng, const ATT_LAS char* kimg0  , const ATT_LAS float* tp0  , const ATT_LAS float* tlim,
                                          u32x4 (&pw)[NG][2], float& m_out, float& l_out, const int lane) {
    const int q = lane & 31, h = lane >> 5, kswz = (q >> 1) & 7;
    typedef float f32x2_ __attribute__((ext_vector_type(2)));
    f32x16 s[NG]; float mx = -INFINITY;
#pragma unroll
    for (int g = 0; g < NG; ++g) if (g < ng) {
        f32x2_ t0, t1, t2, t3, t4, t5, t6, t7;
        { const ATT_LAS float* tpg = tp0 + 32 * g; const unsigned ta = (unsigned)(uintptr_t)((tpg < tlim ? tpg : tlim) - 27);
          asm volatile("ds_read2_b32 %0, %8 offset0:27 offset1:26\n\tds_read2_b32 %1, %8 offset0:25 offset1:24\n\tds_read2_b32 %2, %8 offset0:19 offset1:18\n\tds_read2_b32 %3, %8 offset0:17 offset1:16\n\t"
                       "ds_read2_b32 %4, %8 offset0:11 offset1:10\n\tds_read2_b32 %5, %8 offset0:9 offset1:8\n\tds_read2_b32 %6, %8 offset0:3 offset1:2\n\tds_read2_b32 %7, %8 offset0:1 offset1:0"
                       : "=&v"(t0), "=&v"(t1), "=&v"(t2), "=&v"(t3), "=&v"(t4), "=&v"(t5), "=&v"(t6), "=&v"(t7) : "v"(ta) : "memory"); }
        const ATT_LAS char* kr0 = kimg0 - g * 4096 + q * 128;
        f32x16 sg = f32x16{};
#pragma unroll
        for (int d0 = 0; d0 < 4; ++d0) { const bf16x8 kf = *(const ATT_LAS bf16x8*)(kr0 + 16 * ((2 * d0 + h) ^ kswz)); sg = __builtin_amdgcn_mfma_f32_32x32x16_bf16(kf, qf[d0], sg, 0, 0, 0); }
        asm volatile("s_waitcnt lgkmcnt(0)" : "+v"(t0), "+v"(t1), "+v"(t2), "+v"(t3), "+v"(t4), "+v"(t5), "+v"(t6), "+v"(t7) :: "memory");
        const float tb_[16] = {t0[0], t0[1], t1[0], t1[1], t2[0], t2[1], t3[0], t3[1], t4[0], t4[1], t5[0], t5[1], t6[0], t6[1], t7[0], t7[1]};
#pragma unroll
        for (int r = 0; r < 16; ++r) sg[r] = fmaf(sg[r], LOG2E, tb_[r]);
#pragma unroll
        for (int r = 0; r < 16; r += 2) mx = fmaxf(mx, fmaxf(sg[r], sg[r + 1]));
        s[g] = sg;
    }
    mx = fmaxf(mx, __shfl_xor(mx, 32));
    float ps = 0.f;
#pragma unroll
    for (int g = 0; g < NG; ++g) if (g < ng) {
        f32x16 p = s[g];
#pragma unroll
        for (int r = 0; r < 16; ++r) { p[r] = __builtin_amdgcn_exp2f(p[r] - mx); ps += p[r]; }
        pw[g][0][0] = pk_bf16(p[0], p[1]); pw[g][0][1] = pk_bf16(p[2], p[3]); pw[g][0][2] = pk_bf16(p[4], p[5]); pw[g][0][3] = pk_bf16(p[6], p[7]);
        pw[g][1][0] = pk_bf16(p[8], p[9]); pw[g][1][1] = pk_bf16(p[10], p[11]); pw[g][1][2] = pk_bf16(p[12], p[13]); pw[g][1][3] = pk_bf16(p[14], p[15]);
    }
    ps += __shfl_xor(ps, 32);
    m_out = mx; l_out = ps;
}
template <int NG>
__device__ __forceinline__ void dil_pass2(const int ng, const ATT_LAS char* vimg0  , const u32x4 (&pw)[NG][2], f32x16 (&o)[2], const int lane) {
    const int h = lane >> 5, q4 = (lane & 15) >> 2, p4 = lane & 3, g1 = (lane >> 4) & 1, vsw = (q4 >> 1) & 1;
    o[0] = f32x16{}; o[1] = f32x16{};
#pragma unroll
    for (int g = 0; g < NG; ++g) if (g < ng) {
        const ATT_LAS char* vg = vimg0 - g * 4096;
        const unsigned va0_ = (unsigned)(uintptr_t)(vg + (4 * h + q4) * 128 + 32 * g1 + 8 * p4 + 64 * vsw), va1_ = (unsigned)(uintptr_t)(vg + (4 * h + q4) * 128 + 32 * g1 + 8 * p4 + 64 * (1 ^ vsw));
        v4i16 a[2][4];
        asm volatile("ds_read_b64_tr_b16 %0, %8\n\tds_read_b64_tr_b16 %1, %8 offset:1024\n\tds_read_b64_tr_b16 %2, %8 offset:2048\n\tds_read_b64_tr_b16 %3, %8 offset:3072\n\t"
                     "ds_read_b64_tr_b16 %4, %9\n\tds_read_b64_tr_b16 %5, %9 offset:1024\n\tds_read_b64_tr_b16 %6, %9 offset:2048\n\tds_read_b64_tr_b16 %7, %9 offset:3072\n\ts_waitcnt lgkmcnt(0)"
                     : "=&v"(a[0][0]), "=&v"(a[0][1]), "=&v"(a[0][2]), "=&v"(a[0][3]), "=&v"(a[1][0]), "=&v"(a[1][1]), "=&v"(a[1][2]), "=&v"(a[1][3]) : "v"(va0_), "v"(va1_) : "memory");
        const bf16x8 pb0 = __builtin_bit_cast(bf16x8, pw[g][0]), pb1 = __builtin_bit_cast(bf16x8, pw[g][1]);
#pragma unroll
        for (int dh = 0; dh < 2; ++dh) {
            const bf16x8 va0 = (bf16x8){a[dh][0][0], a[dh][0][1], a[dh][0][2], a[dh][0][3], a[dh][1][0], a[dh][1][1], a[dh][1][2], a[dh][1][3]};
            const bf16x8 va1 = (bf16x8){a[dh][2][0], a[dh][2][1], a[dh][2][2], a[dh][2][3], a[dh][3][0], a[dh][3][1], a[dh][3][2], a[dh][3][3]};
            o[dh] = __builtin_amdgcn_mfma_f32_32x32x16_bf16(va0, pb0, o[dh], 0, 0, 0);
            o[dh] = __builtin_amdgcn_mfma_f32_32x32x16_bf16(va1, pb1, o[dh], 0, 0, 0);
        }
    }
}

#define ATT_GAS __attribute__((address_space(1)))
template <bool NT>
__device__ __forceinline__ void store_o(const f32x16 (&o)[2], const float l, char* orow_q, const int h, const bool valid = true) {
    const float il = 1.0f / l;
#pragma unroll
    for (int dh = 0; dh < 2; ++dh)
#pragma unroll
        for (int jj = 0; jj < 2; ++jj) {
            u32x2 we, wo;
            we[0] = pk_bf16(o[dh][8 * jj] * il, o[dh][8 * jj + 1] * il); we[1] = pk_bf16(o[dh][8 * jj + 2] * il, o[dh][8 * jj + 3] * il);
            wo[0] = pk_bf16(o[dh][8 * jj + 4] * il, o[dh][8 * jj + 5] * il); wo[1] = pk_bf16(o[dh][8 * jj + 6] * il, o[dh][8 * jj + 7] * il);
            const unsigned s0 = h ? we[0] : wo[0], s1 = h ? we[1] : wo[1];
            const unsigned r0 = (unsigned)__shfl_xor((int)s0, 32), r1 = (unsigned)__shfl_xor((int)s1, 32);
            u32x4 w; if (h == 0) { w[0] = we[0]; w[1] = we[1]; w[2] = r0; w[3] = r1; } else { w[0] = r0; w[1] = r1; w[2] = wo[0]; w[3] = wo[1]; }
            ATT_GAS u32x4* dst = (ATT_GAS u32x4*)(orow_q + (32 * dh + 16 * jj + 8 * h) * 2);
            if (valid) { if (NT) __builtin_nontemporal_store(w, dst); else *dst = w; }
        }
}

template <bool NT>
__device__ __forceinline__ void store_o_staged(const f32x16 (&o)[2], const float l, ATT_LAS char* stg, char* base, const long rstride, const int lane) {
    const int q = lane & 31, h = lane >> 5; const float il = 1.0f / l;
#pragma unroll
    for (int dh = 0; dh < 2; ++dh)
#pragma unroll
        for (int jj = 0; jj < 2; ++jj) {
            u32x2 we, wo;
            we[0] = pk_bf16(o[dh][8 * jj] * il, o[dh][8 * jj + 1] * il); we[1] = pk_bf16(o[dh][8 * jj + 2] * il, o[dh][8 * jj + 3] * il);
            wo[0] = pk_bf16(o[dh][8 * jj + 4] * il, o[dh][8 * jj + 5] * il); wo[1] = pk_bf16(o[dh][8 * jj + 6] * il, o[dh][8 * jj + 7] * il);
            const unsigned s0 = h ? we[0] : wo[0], s1 = h ? we[1] : wo[1];
            const unsigned r0 = (unsigned)__shfl_xor((int)s0, 32), r1 = (unsigned)__shfl_xor((int)s1, 32);
            u32x4 w; if (h == 0) { w[0] = we[0]; w[1] = we[1]; w[2] = r0; w[3] = r1; } else { w[0] = r0; w[1] = r1; w[2] = wo[0]; w[3] = wo[1]; }
            *(ATT_LAS u32x4*)(stg + q * 128 + 16 * ((4 * dh + 2 * jj + h) ^ (q & 7))) = w;
        }
    asm volatile("s_waitcnt lgkmcnt(0)" ::: "memory");
#pragma unroll
    for (int i = 0; i < 4; ++i) { const int r = 8 * i + (lane >> 3), c = lane & 7;
        const u32x4 w = *(const ATT_LAS u32x4*)(stg + r * 128 + 16 * (c ^ (r & 7)));
        ATT_GAS u32x4* dst = (ATT_GAS u32x4*)(base + (long)r * rstride + 16 * c);
        if (NT) __builtin_nontemporal_store(w, dst); else *dst = w; }
    asm volatile("s_waitcnt lgkmcnt(0)" ::: "memory");
}

__device__ __forceinline__ unsigned moba_select(const char* qbase, const long qs, const float* km, const int qb) {
    const int lane = threadIdx.x & 63, q = lane & 31, h = lane >> 5;
    f32x16 g = f32x16{};
    const float* kmrow = km + (size_t)(q & 15) * 256;
    const bool lo_part = q >= 16;
#pragma unroll
    for (int d0 = 0; d0 < 4; ++d0) {
        const bf16x8 qf = *(const bf16x8*)(qbase + (long)q * qs + (16 * d0 + 8 * h) * 2);
        const f32x4 f0 = *(const f32x4*)(kmrow + 16 * d0 + 8 * h), f1 = *(const f32x4*)(kmrow + 16 * d0 + 8 * h + 4);
        float v[8] = {f0[0], f0[1], f0[2], f0[3], f1[0], f1[1], f1[2], f1[3]};
        u32x4 aw;
#pragma unroll
        for (int j = 0; j < 4; ++j) {
            const float h0 = bf16_round(v[2 * j]), h1 = bf16_round(v[2 * j + 1]);
            const float x0 = lo_part ? (v[2 * j] - h0) : h0, x1 = lo_part ? (v[2 * j + 1] - h1) : h1;
            aw[j] = pk_bf16(x0, x1);
        }
        g = __builtin_amdgcn_mfma_f32_32x32x16_bf16(__builtin_bit_cast(bf16x8, aw), qf, g, 0, 0, 0);
    }
    float gate[8], other[8];
#pragma unroll
    for (int r = 0; r < 8; ++r) { gate[r] = g[r] + g[r + 8]; }
#pragma unroll
    for (int r = 0; r < 8; ++r) { other[r] = __shfl_xor(gate[r], 32); }
    unsigned mymask = 0u;
#pragma unroll
    for (int r = 0; r < 8; ++r) {
        const int n = (r & 3) + 8 * (r >> 2) + 4 * h;
        int rank = 0;
#pragma unroll
        for (int r2 = 0; r2 < 8; ++r2) {
            const int n2 = (r2 & 3) + 8 * (r2 >> 2) + 4 * h, n3 = (r2 & 3) + 8 * (r2 >> 2) + 4 * (1 - h);
            if (r2 != r) rank += (n2 < qb && (gate[r2] > gate[r] || (gate[r2] == gate[r] && n2 < n))) ? 1 : 0;
            rank += (n3 < qb && (other[r2] > gate[r] || (other[r2] == gate[r] && n3 < n))) ? 1 : 0;
        }
        if (n < qb && rank < 3) mymask |= 1u << n;
    }
    return mymask | (unsigned)__shfl_xor((int)mymask, 32);
}
}


namespace mk {
using pg8::bf16_t; using pg8::bf16x8; using pg8::f32x4; using pg8::f32x2; using pg8::u32x4; using pg8::u32x2; using pg8::Unit; using pg8::cvt_pk_bf16;
#define LAS __attribute__((address_space(3)))
#define GAS __attribute__((address_space(1)))
template <class T> __device__ __forceinline__ GAS T* gp(T* p) { return (GAS T*)p; }
template <class T> __device__ __forceinline__ const GAS T* gp(const T* p) { return (const GAS T*)p; }
constexpr int NBAT = MK_NBAT, SEQ = 4096, D = 1024, DFF = 2816, NMEM = 256, M = NBAT * SEQ, MM = NBAT * NMEM, NQKV = 3072;
constexpr float EPS = 1e-6f, LOG2E = 1.4426950408889634f;
constexpr int NWAVES = 8, NPH = 14;
constexpr bool F8_1G = (MK_FP8_FFN1 & 1) != 0, F8_1D = (MK_FP8_FFN1 & 2) != 0, F8_2G = (MK_FP8_FFN2 & 1) != 0, F8_2D = (MK_FP8_FFN2 & 2) != 0;
constexpr bool I8_1G = (MK_FP8_FFN1 & 4) != 0;
static_assert(!(I8_1G && F8_1G), "one operand type per GEMM");
constexpr float F8_WGU = 64.f, F8_H = 4.f, F8_WD = 128.f;
constexpr bool C8 = MK_C8 != 0;
constexpr bool O8I = MK_O8 != 0;
constexpr bool Q8I = MK_Q8 != 0;
constexpr bool Q8CLIP = MK_Q8 == 4;
constexpr float Q8_CLIP = 5.25f;
constexpr float F8_WK = 64.f, F8_VW = 16.f, F8_P = 256.f;

constexpr size_t al256(size_t x) { return (x + 255) / 256 * 256; }
constexpr size_t WS_CTL = 0, CTL_BYTES = 1u << 20;
constexpr size_t WS_WGU1 = WS_CTL + CTL_BYTES;
constexpr size_t WS_WIN8 = WS_WGU1 + (size_t)2 * DFF * D;
static_assert(!Q8I || F8_1G || I8_1G, "Win8 needs the 8-bit first gate/up weights");
constexpr size_t WS_WD1 = WS_WGU1 + (size_t)2 * DFF * D * 2;
constexpr size_t WS_WIN = WS_WD1 + (size_t)D * DFF * 2;
constexpr size_t WS_WOUT = WS_WIN + (size_t)NQKV * D * 2;
constexpr size_t WS_WCQS = WS_WOUT + (size_t)D * D * 2;
constexpr size_t WS_WCKV = WS_WCQS + (size_t)D * D * 2;
constexpr size_t WS_WCO = WS_WCKV + (size_t)2 * D * D * 2;
constexpr size_t WS_WGU2 = WS_WCO + (size_t)D * D * 2;
constexpr size_t WS_WD2 = WS_WGU2 + (size_t)2 * DFF * D * 2;
constexpr size_t WS_MB = WS_WD2 + (size_t)D * DFF * 2;
constexpr size_t WS_KVC = WS_MB + (size_t)MM * D * 2;
constexpr size_t WS_WKT = WS_KVC + (size_t)MM * 2 * D * 2;
constexpr size_t WS_VWT = WS_WKT + (size_t)NBAT * D * D * 2;
constexpr size_t SS_BYTES = (size_t)M * 16 * 4;
constexpr size_t WS_SS = WS_VWT + (size_t)NBAT * D * D * 2;
constexpr size_t WS_SSM = WS_SS + 5 * SS_BYTES;
constexpr size_t WS_KM = WS_SSM + (size_t)MM * 16 * 4;
constexpr size_t WS_SX = WS_KM + (size_t)NBAT * 16 * 256 * 4;
constexpr size_t WS_SW = WS_SX + (size_t)M * 4;
constexpr size_t WS_SY = WS_SW + (size_t)2 * DFF * 4;
constexpr size_t WS_SWO = WS_SY + (size_t)M * 4;
constexpr size_t WS_SWIN = WS_SWO + (size_t)D * 4;
constexpr size_t WS_R1 = al256(WS_SWIN + (size_t)NQKV * 4);
constexpr size_t WS_XB = WS_R1 + (size_t)M * NQKV * 2;
constexpr size_t WS_OA2 = WS_XB + (size_t)M * D * 2;
constexpr size_t WS_SEL = WS_OA2 + (size_t)M * 768 * 2;
constexpr size_t WS_OBP = WS_SEL + (size_t)NBAT * 4 * SEQ * 4;
constexpr size_t WS_X8 = WS_OBP;
constexpr size_t WS_MLB = WS_OBP + (size_t)4 * M * 256 * 2;
constexpr size_t WS_END = WS_MLB + (size_t)4 * M * 4 * 2 * 4;
constexpr size_t OUT_OA1 = (size_t)M * 768 * 2, OUT_OB = 2 * OUT_OA1, OUT_ML = OUT_OB + (size_t)M * 256 * 2;
static_assert(OUT_ML + (size_t)3 * M * 12 * 8 <= (size_t)M * D * 4, "attention partials fit in d_out");
constexpr int CW_BAR = 4096, CW_QUEUE = 8192;

constexpr int LDS_XCH = 131072;
constexpr int LDS_MISC = 131072 + 8192;
constexpr int LDS_STATS = 147456;
constexpr int LDS_BYTES = 163840;
constexpr int LDS_TAB = 98304;
static_assert(LDS_TAB + 4 * att::TABB_N * 4 <= LDS_XCH, "attention LDS map");

__device__ __forceinline__ float wave_sum(float v) {
#pragma unroll
    for (int o = 1; o < 64; o <<= 1) v += __shfl_xor(v, o);
    return v;
}
__device__ __forceinline__ unsigned pk_fp8x4(float a, float b, float c, float d) { int r = __builtin_amdgcn_cvt_pk_fp8_f32(a, b, 0, false); r = __builtin_amdgcn_cvt_pk_fp8_f32(c, d, r, true); return (unsigned)r; }
__device__ __forceinline__ unsigned pk_i8x4(float a, float b, float c, float d) { const int ia = (int)__builtin_rintf(a), ib = (int)__builtin_rintf(b), ic = (int)__builtin_rintf(c), id = (int)__builtin_rintf(d);
    return ((unsigned)ia & 255u) | (((unsigned)ib & 255u) << 8) | (((unsigned)ic & 255u) << 16) | ((unsigned)id << 24); }
__device__ __forceinline__ float row_rstd(const float* ss, int row) {
    const f32x4* p = (const f32x4*)(ss + (size_t)row * 16);
    const f32x4 a = p[0], b = p[1], c = p[2], d = p[3];
    const float s = ((a[0] + a[1]) + (a[2] + a[3])) + ((b[0] + b[1]) + (b[2] + b[3])) + ((c[0] + c[1]) + (c[2] + c[3])) + ((d[0] + d[1]) + (d[2] + d[3]));
    return __builtin_amdgcn_rsqf(s * (1.0f / D) + EPS);
}

template <int NROWS> __device__ __forceinline__ void rows_rstd(const float* ss, int row0, int rstep, int fq, float (&rs)[NROWS]) {
    f32x4 a[NROWS];
#pragma unroll
    for (int i = 0; i < NROWS; ++i) a[i] = *gp((const f32x4*)(ss + (size_t)(row0 + i * rstep) * 16) + fq);
#pragma unroll
    for (int i = 0; i < NROWS; ++i) { float s = (a[i][0] + a[i][1]) + (a[i][2] + a[i][3]); s += __shfl_xor(s, 16); s += __shfl_xor(s, 32); rs[i] = __builtin_amdgcn_rsqf(s * (1.0f / D) + EPS); }
}
__device__ __forceinline__ void stats_dma16(LAS unsigned char* lds, const float* ss, int orow, int wid, int lane) {
#pragma unroll
    for (int i = 0; i < 2; ++i) __builtin_amdgcn_global_load_lds((const unsigned*)(ss + (size_t)(orow + 32 * wid + 16 * i + (lane >> 2)) * 16 + 4 * (lane & 3)), (LAS unsigned*)(lds + LDS_STATS + (32 * wid + 16 * i) * 64), 16, 0, 0);
}
__device__ __forceinline__ void stats_reduce16(LAS unsigned char* lds, int tid, float mul, const LAS float* rowmul) {
    if (tid < 256) { const LAS f32x4* p = (const LAS f32x4*)(lds + LDS_STATS + tid * 64); const f32x4 a = p[0], b = p[1], c = p[2], d = p[3];
        const float s = ((a[0] + a[1]) + (a[2] + a[3])) + ((b[0] + b[1]) + (b[2] + b[3])) + ((c[0] + c[1]) + (c[2] + c[3])) + ((d[0] + d[1]) + (d[2] + d[3]));
        float r = __builtin_amdgcn_rsqf(s * (1.0f / D) + EPS) * mul; if (rowmul) r *= rowmul[tid];
        *(LAS float*)(lds + LDS_STATS + tid * 64) = r; }
}
template <int NROWS> __device__ __forceinline__ void rows_rstd_lds(const LAS unsigned char* lds, int rl0, int fq, float (&rs)[NROWS]) {
#pragma unroll
    for (int i = 0; i < NROWS; ++i) rs[i] = *(const LAS float*)(lds + LDS_STATS + (rl0 + 16 * i) * 64);
    (void)fq;
}
struct SchedStd {
    pg8::Order o; const char* A; const char* B; size_t a_tile, b_tile, b_batch; int ocol_mul; int pn_map = 0;
    __device__ __forceinline__ bool next(int i, Unit& u) const { int pm, pn; if (!o.tile(i, pm, pn)) return false; if (pn_map == 1) pn = pn < 9 ? pn : 11; else if (pn_map == 2) pn += 9;
        u.a = A + (size_t)pm * a_tile; u.b = B + (size_t)pn * b_tile + (size_t)(pm >> 4) * b_batch; u.orow = pm * 256; u.ocol = pn * ocol_mul; u.aux = pn; return true; }
};
struct SchedWK {
    int G, c; const char* kvc; const char* wcqs;
    __device__ __forceinline__ bool next(int i, Unit& u) const { const int L = i * G + c; if (L >= NBAT * 16) return false; const int bh = L >> 2, pn = L & 3, b = bh >> 2, h = bh & 3;
        u.a = kvc + ((size_t)(b * 256) * 2048 + h * 256) * 2; u.b = wcqs + ((size_t)(pn * 256) * 1024 + h * 256) * 2; u.orow = b * 1024 + h * 256; u.ocol = pn * 256; u.aux = 0; return true; }
};
struct SchedVW {
    int G, c; const char* kvc; const char* wcot;
    __device__ __forceinline__ bool next(int i, Unit& u) const { const int L = i * G + c; if (L >= NBAT * 16) return false; const int bh = L >> 2, pm = L & 3, b = bh >> 2, h = bh & 3;
        u.a = wcot + ((size_t)(pm * 256) * 1024 + h * 256) * 2; u.b = kvc + ((size_t)(b * 256) * 2048 + 1024 + h * 256) * 2; u.orow = b * 1024 + pm * 256; u.ocol = h * 256; u.aux = 0; return true; }
};

template <bool F8, bool H8, bool I8> struct EpiGU { static constexpr bool PERM = true, STATS = true;
    void* H; const float* ss; const float* sx; const float* sw; int flags;
    __device__ __forceinline__ void stats_dma(LAS unsigned char* lds, const Unit& u, int wid, int lane) const { stats_dma16(lds, ss, u.orow, wid, lane);
        if constexpr (I8) { if (wid == 0) __builtin_amdgcn_global_load_lds((const unsigned*)(sx + u.orow + 4 * lane), (LAS unsigned*)(lds + LDS_XCH), 16, 0, 0); } }
    __device__ __forceinline__ void stats_reduce(LAS unsigned char* lds, int tid) const { stats_reduce16(lds, tid, F8 ? 1.0f / F8_WGU : 1.0f, I8 ? (const LAS float*)(lds + LDS_XCH) : nullptr); }
    __device__ __forceinline__ void operator()(const f32x4 (&acc)[2][2][4][2], const Unit& u, int wr, int wc, int fr, int fq, LAS unsigned char* lds, int, int) const {
        if (flags & 64) return;
        float rsv[2][4];
#pragma unroll
        for (int ai = 0; ai < 2; ++ai) { float r4[4]; if (flags & 256) { r4[0] = 1.0f + 0.001f * fr; r4[1] = r4[0]; r4[2] = r4[0]; r4[3] = r4[0]; } else rows_rstd_lds<4>(lds, ai * 128 + wr * 64 + fr, fq, r4);
#pragma unroll
            for (int m = 0; m < 4; ++m) { const int row_ = u.orow + ai * 128 + wr * 64 + m * 16 + fr; rsv[ai][m] = r4[m]; (void)row_; } }
        f32x4 swg[2], swu[2];
        if constexpr (I8) { const GAS f32x4* pg = gp((const f32x4*)(sw + u.ocol + wc * 32 + 8 * fq)); const GAS f32x4* pu = gp((const f32x4*)(sw + DFF + u.ocol + wc * 32 + 8 * fq)); swg[0] = pg[0]; swg[1] = pg[1]; swu[0] = pu[0]; swu[1] = pu[1]; }
#pragma unroll
        for (int ai = 0; ai < 2; ++ai)
#pragma unroll
            for (int m = 0; m < 4; ++m) { const int row = u.orow + ai * 128 + wr * 64 + m * 16 + fr; const float rs = rsv[ai][m];
                const float k1 = -rs * LOG2E, ic2s = __builtin_amdgcn_rcpf(rs * rs * (H8 ? F8_H : 1.0f)); const f32x2 k1v = (f32x2){k1, k1}, ic2 = (f32x2){ic2s, ic2s};
                float hv[8];
#pragma unroll
                for (int n = 0; n < 2; ++n)
#pragma unroll
                    for (int hh = 0; hh < 2; ++hh) { f32x2 av, bv;
                        if constexpr (I8) { const float a0 = acc[ai][0][m][n][2 * hh], a1 = acc[ai][0][m][n][2 * hh + 1], b0 = acc[ai][1][m][n][2 * hh], b1 = acc[ai][1][m][n][2 * hh + 1];
                            av = (f32x2){(float)__builtin_bit_cast(int, a0), (float)__builtin_bit_cast(int, a1)} * (f32x2){swg[n][2 * hh], swg[n][2 * hh + 1]};
                            bv = (f32x2){(float)__builtin_bit_cast(int, b0), (float)__builtin_bit_cast(int, b1)} * (f32x2){swu[n][2 * hh], swu[n][2 * hh + 1]}; }
                        else { av = (f32x2){acc[ai][0][m][n][2 * hh], acc[ai][0][m][n][2 * hh + 1]}; bv = (f32x2){acc[ai][1][m][n][2 * hh], acc[ai][1][m][n][2 * hh + 1]}; }
                        const f32x2 t = av * k1v; f32x2 e; e[0] = __builtin_amdgcn_exp2f(t[0]); e[1] = __builtin_amdgcn_exp2f(t[1]);
                        const f32x2 dd = e * ic2 + ic2; f32x2 q; q[0] = __builtin_amdgcn_rcpf(dd[0]); q[1] = __builtin_amdgcn_rcpf(dd[1]);
                        const f32x2 h2 = (av * bv) * q; hv[4 * n + 2 * hh] = h2[0]; hv[4 * n + 2 * hh + 1] = h2[1]; }
                if (flags & 128) { if (hv[0] + hv[1] + hv[2] + hv[3] + hv[4] + hv[5] + hv[6] + hv[7] == 12345.678f) *(float*)H = 1.f; continue; }
                if constexpr (H8) { u32x2 w; w[0] = pk_fp8x4(hv[0], hv[1], hv[2], hv[3]); w[1] = pk_fp8x4(hv[4], hv[5], hv[6], hv[7]);
                    *gp((u32x2*)((unsigned char*)H + (size_t)row * DFF + u.ocol + wc * 32 + 8 * fq)) = w; }
                else { u32x4 w; w[0] = cvt_pk_bf16(hv[0], hv[1]); w[1] = cvt_pk_bf16(hv[2], hv[3]); w[2] = cvt_pk_bf16(hv[4], hv[5]); w[3] = cvt_pk_bf16(hv[6], hv[7]);
                    __builtin_nontemporal_store(w, gp((u32x4*)((bf16_t*)H + (size_t)row * DFF + u.ocol + wc * 32 + 8 * fq))); } }
    }
};
template <bool X8, bool I8 = false, bool XI = false> struct EpiRes { static constexpr bool PERM = true, STATS = false;
    bf16_t* xb; float* ssout; float alpha; unsigned char* x8; const float* sy = nullptr; const float* swc = nullptr; const float* ssin = nullptr; float* sxo = nullptr;
    __device__ __forceinline__ void operator()(const f32x4 (&acc)[2][2][4][2], const Unit& u, int wr, int wc, int fr, int fq, LAS unsigned char*, int, int) const {
        const size_t off0 = (size_t)(u.orow + wr * 64 + fr) * D + u.ocol + wc * 32 + 8 * fq;
        u32x4 cur[2], nxt[2];
#pragma unroll
        for (int bj = 0; bj < 2; ++bj) cur[bj] = *gp((const u32x4*)(xb + off0 + bj * 128));
        float rsc[8]; f32x4 csc[2][2]; float qinv[8];
        if constexpr (XI) {
#pragma unroll
            for (int idx = 0; idx < 8; ++idx) { const int row_ = u.orow + (idx >> 2) * 128 + wr * 64 + (idx & 3) * 16 + fr; const float ms = *gp(ssin + (size_t)row_ * 16) * (1.0f / D) + EPS;
                qinv[idx] = (127.0f / Q8_CLIP) * __builtin_amdgcn_rsqf(ms); if (u.ocol == 0 && wc == 0 && fq == 0) *gp(sxo + row_) = (Q8_CLIP / 127.0f) * __builtin_amdgcn_sqrtf(ms); } }
        if constexpr (I8) {
#pragma unroll
            for (int idx = 0; idx < 8; ++idx) rsc[idx] = *gp(sy + u.orow + (idx >> 2) * 128 + wr * 64 + (idx & 3) * 16 + fr) * alpha;
#pragma unroll
            for (int bj = 0; bj < 2; ++bj) { const GAS f32x4* pc = gp((const f32x4*)(swc + u.ocol + bj * 128 + wc * 32 + 8 * fq)); csc[bj][0] = pc[0]; csc[bj][1] = pc[1]; } }
#pragma unroll
        for (int idx = 0; idx < 8; ++idx) { const int ai = idx >> 2, m = idx & 3; const size_t off = off0 + (size_t)(ai * 128 + m * 16) * D; const int row = u.orow + ai * 128 + wr * 64 + m * 16 + fr;
            if (idx < 7) { const size_t offn = off0 + (size_t)(((idx + 1) >> 2) * 128 + ((idx + 1) & 3) * 16) * D;
#pragma unroll
                for (int bj = 0; bj < 2; ++bj) nxt[bj] = *gp((const u32x4*)(xb + offn + bj * 128)); }
            float sq = 0.f;
#pragma unroll
            for (int bj = 0; bj < 2; ++bj) { float o[8];
#pragma unroll
                for (int n = 0; n < 2; ++n)
#pragma unroll
                    for (int j = 0; j < 4; ++j) { const unsigned wv = cur[bj][2 * n + (j >> 1)]; const float r = __builtin_bit_cast(float, (j & 1) ? (wv & 0xffff0000u) : (wv << 16));
                        float v; if constexpr (I8) { const float af = acc[ai][bj][m][n][j]; v = r + (float)__builtin_bit_cast(int, af) * (rsc[idx] * csc[bj][n][j]); } else v = r + acc[ai][bj][m][n][j] * alpha;
                        o[4 * n + j] = v; sq += v * v; }
                u32x4 w; w[0] = cvt_pk_bf16(o[0], o[1]); w[1] = cvt_pk_bf16(o[2], o[3]); w[2] = cvt_pk_bf16(o[4], o[5]); w[3] = cvt_pk_bf16(o[6], o[7]);
                *gp((u32x4*)(xb + off + bj * 128)) = w;
                if constexpr (X8 && XI) { const float qi = qinv[idx]; float c8[8];
#pragma unroll
                    for (int e = 0; e < 8; ++e) c8[e] = fminf(fmaxf(o[e] * qi, -127.0f), 127.0f);
                    u32x2 w8; w8[0] = pk_i8x4(c8[0], c8[1], c8[2], c8[3]); w8[1] = pk_i8x4(c8[4], c8[5], c8[6], c8[7]); *gp((u32x2*)(x8 + off + bj * 128)) = w8; }
                else if constexpr (X8) { u32x2 w8; w8[0] = pk_fp8x4(o[0], o[1], o[2], o[3]); w8[1] = pk_fp8x4(o[4], o[5], o[6], o[7]); *gp((u32x2*)(x8 + off + bj * 128)) = w8; } }
            sq += __shfl_xor(sq, 16); sq += __shfl_xor(sq, 32);
            if (fq == 0) *gp(ssout + (size_t)row * 16 + (u.ocol >> 8) * 4 + wc) = sq;
#pragma unroll
            for (int bj = 0; bj < 2; ++bj) cur[bj] = nxt[bj]; }
    }
};
template <bool SL, bool O8 = false, bool I8 = false> struct EpiStoreT { static constexpr bool PERM = true, STATS = SL;
    bf16_t* O; int ldc; const float* ss; float* km; bool nt; float cs = 1.0f; const float* sxr = nullptr; const float* swc = nullptr;
    __device__ __forceinline__ void stats_dma(LAS unsigned char* lds, const Unit& u, int wid, int lane) const { stats_dma16(lds, ss, u.orow, wid, lane);
        if constexpr (I8) { if (wid == 0) __builtin_amdgcn_global_load_lds((const unsigned*)(sxr + u.orow + 4 * lane), (LAS unsigned*)(lds + LDS_XCH), 16, 0, 0); } }
    __device__ __forceinline__ void stats_reduce(LAS unsigned char* lds, int tid) const { stats_reduce16(lds, tid, cs, I8 ? (const LAS float*)(lds + LDS_XCH) : nullptr); }
    __device__ __forceinline__ void operator()(const f32x4 (&acc)[2][2][4][2], const Unit& u, int wr, int wc, int fr, int fq, LAS unsigned char* lds, int, int) const {
        float rsv[2][4];
#pragma unroll
        for (int ai = 0; ai < 2; ++ai) { if constexpr (SL) rows_rstd_lds<4>(lds, ai * 128 + wr * 64 + fr, fq, rsv[ai]); else if (ss) rows_rstd<4>(ss, u.orow + ai * 128 + wr * 64 + fr, 16, fq, rsv[ai]); else { rsv[ai][0] = cs; rsv[ai][1] = cs; rsv[ai][2] = cs; rsv[ai][3] = cs; } }
#pragma unroll
        for (int ai = 0; ai < 2; ++ai)
#pragma unroll
            for (int m = 0; m < 4; ++m) { const int row = u.orow + ai * 128 + wr * 64 + m * 16 + fr; const float rs = rsv[ai][m];
                const int col0 = u.ocol + wc * 32 + 8 * fq;
                bf16_t* rowp = ldc ? O + (size_t)row * ldc + col0 : O + (((size_t)(row / SEQ) * (NQKV / 64) + (col0 >> 6)) * SEQ + (row % SEQ)) * 64 + (col0 & 63);
                const size_t bjstep = ldc ? 128 : (size_t)2 * SEQ * 64;
#pragma unroll
                for (int bj = 0; bj < 2; ++bj) { f32x4 v0, v1;
                    if constexpr (I8) { const GAS f32x4* pc = gp((const f32x4*)(swc + col0 + bj * 128));
#pragma unroll
                        for (int j = 0; j < 4; ++j) { const float a0 = acc[ai][bj][m][0][j], a1 = acc[ai][bj][m][1][j]; v0[j] = (float)__builtin_bit_cast(int, a0); v1[j] = (float)__builtin_bit_cast(int, a1); }
                        v0 = v0 * pc[0] * rs; v1 = v1 * pc[1] * rs; }
                    else { v0 = acc[ai][bj][m][0] * rs; v1 = acc[ai][bj][m][1] * rs; }
                    if constexpr (O8) { u32x2 w8; w8[0] = pk_fp8x4(v0[0], v0[1], v0[2], v0[3]); w8[1] = pk_fp8x4(v1[0], v1[1], v1[2], v1[3]); *gp((u32x2*)((unsigned char*)O + (size_t)row * ldc + col0 + bj * 128)) = w8; continue; }
                    u32x4 w; w[0] = cvt_pk_bf16(v0[0], v0[1]); w[1] = cvt_pk_bf16(v0[2], v0[3]); w[2] = cvt_pk_bf16(v1[0], v1[1]); w[3] = cvt_pk_bf16(v1[2], v1[3]);
                    if (nt) __builtin_nontemporal_store(w, gp((u32x4*)(rowp + bj * bjstep))); else *gp((u32x4*)(rowp + bj * bjstep)) = w; } }
        if ((km != nullptr) && (u.aux == 10)) {
            float* kmb = km + (size_t)(u.orow >> 8) * 256 + wc * 32 + 8 * fq;
#pragma unroll
            for (int bj = 0; bj < 2; ++bj)
#pragma unroll
                for (int n = 0; n < 2; ++n) { f32x4 cs = (f32x4){0.f, 0.f, 0.f, 0.f};
#pragma unroll
                    for (int ai = 0; ai < 2; ++ai)
#pragma unroll
                        for (int m = 0; m < 4; ++m) cs += acc[ai][bj][m][n] * rsv[ai][m];
#pragma unroll
                    for (int j = 0; j < 4; ++j) { float v = cs[j]; v += __shfl_xor(v, 1); v += __shfl_xor(v, 2); v += __shfl_xor(v, 4); v += __shfl_xor(v, 8);
                        if (fr == 0) atomicAdd(kmb + bj * 128 + 4 * n + j, v); } }
        }
    }
};
typedef EpiStoreT<false, false> EpiStore;
template <bool O8> struct EpiSoftmaxT { static constexpr bool PERM = true, STATS = true;
    bf16_t* P; const float* ss; float cs;
    __device__ __forceinline__ void stats_dma(LAS unsigned char* lds, const Unit& u, int wid, int lane) const { stats_dma16(lds, ss, u.orow, wid, lane); }
    __device__ __forceinline__ void stats_reduce(LAS unsigned char* lds, int tid) const { stats_reduce16(lds, tid, LOG2E * cs, nullptr); }
    __device__ __forceinline__ void operator()(const f32x4 (&acc)[2][2][4][2], const Unit& u, int wr, int wc, int fr, int fq, LAS unsigned char* lds, int, int) const {
        LAS f32x2* X = (LAS f32x2*)(lds + LDS_XCH);
        float rsl[2][4], mw[2][4];
#pragma unroll
        for (int ai = 0; ai < 2; ++ai) rows_rstd_lds<4>(lds, ai * 128 + wr * 64 + fr, fq, rsl[ai]);
#pragma unroll
        for (int ai = 0; ai < 2; ++ai)
#pragma unroll
            for (int m = 0; m < 4; ++m) { const int rl = ai * 128 + wr * 64 + m * 16 + fr; const float rs = rsl[ai][m];
                float mx = -INFINITY;
#pragma unroll
                for (int bj = 0; bj < 2; ++bj)
#pragma unroll
                    for (int n = 0; n < 2; ++n)
#pragma unroll
                        for (int j = 0; j < 4; ++j) mx = fmaxf(mx, acc[ai][bj][m][n][j] * rs);
                mx = fmaxf(mx, __shfl_xor(mx, 16)); mx = fmaxf(mx, __shfl_xor(mx, 32));
                float sm = 0.f;
#pragma unroll
                for (int bj = 0; bj < 2; ++bj)
#pragma unroll
                    for (int n = 0; n < 2; ++n)
#pragma unroll
                        for (int j = 0; j < 4; ++j) sm += __builtin_amdgcn_exp2f(acc[ai][bj][m][n][j] * rs - mx);
                sm += __shfl_xor(sm, 16); sm += __shfl_xor(sm, 32);
                mw[ai][m] = mx;
                if (fq == 0) X[rl * 4 + wc] = (f32x2){mx, sm}; }
        asm volatile("s_waitcnt lgkmcnt(0)" ::: "memory"); __builtin_amdgcn_s_barrier(); asm volatile("" ::: "memory");
#pragma unroll
        for (int ai = 0; ai < 2; ++ai)
#pragma unroll
            for (int m = 0; m < 4; ++m) { const int rl = ai * 128 + wr * 64 + m * 16 + fr; const float rs = rsl[ai][m];
                const f32x2 x0 = X[rl * 4 + 0], x1 = X[rl * 4 + 1], x2 = X[rl * 4 + 2], x3 = X[rl * 4 + 3];
                const float Mx = fmaxf(fmaxf(x0[0], x1[0]), fmaxf(x2[0], x3[0]));
                const float L = x0[1] * __builtin_amdgcn_exp2f(x0[0] - Mx) + x1[1] * __builtin_amdgcn_exp2f(x1[0] - Mx) + x2[1] * __builtin_amdgcn_exp2f(x2[0] - Mx) + x3[1] * __builtin_amdgcn_exp2f(x3[0] - Mx);
                const float il = __builtin_amdgcn_rcpf(L) * (O8 ? F8_P : 1.0f);
                bf16_t* rowp = P + (size_t)(u.orow + rl) * D + u.ocol + wc * 32 + 8 * fq;
#pragma unroll
                for (int bj = 0; bj < 2; ++bj) { float pv[8];
#pragma unroll
                    for (int n = 0; n < 2; ++n)
#pragma unroll
                        for (int j = 0; j < 4; ++j) pv[4 * n + j] = __builtin_amdgcn_exp2f(acc[ai][bj][m][n][j] * rs - Mx) * il;
                    if constexpr (O8) { u32x2 w8; w8[0] = pk_fp8x4(pv[0], pv[1], pv[2], pv[3]); w8[1] = pk_fp8x4(pv[4], pv[5], pv[6], pv[7]);
                        *gp((u32x2*)((unsigned char*)P + (size_t)(u.orow + rl) * D + u.ocol + wc * 32 + 8 * fq + bj * 128)) = w8; }
                    else { u32x4 w; w[0] = cvt_pk_bf16(pv[0], pv[1]); w[1] = cvt_pk_bf16(pv[2], pv[3]); w[2] = cvt_pk_bf16(pv[4], pv[5]); w[3] = cvt_pk_bf16(pv[6], pv[7]);
                        *gp((u32x4*)(rowp + bj * 128)) = w; } } }
        (void)mw;
    }
};

#define XB_TMO      128
#define XB_XCNT(j)  (256  + 64 * (j))
#define XB_XSUB(j)  (1280 + 64 * (j))
#define XB_XGEN(j)  (2304 + 64 * (j))
#define XB_TOP      3328
#define XB_TOPGEN   3392
#define XCD_BAR_WORDS 3456
#define XB_SPIN_CAP (1u << 18)
__device__ __forceinline__ unsigned xb_ld(unsigned* p)              { return __hip_atomic_load(p, __ATOMIC_RELAXED, __HIP_MEMORY_SCOPE_AGENT); }
__device__ __forceinline__ unsigned xb_add(unsigned* p, unsigned v) { return __hip_atomic_fetch_add(p, v, __ATOMIC_RELAXED, __HIP_MEMORY_SCOPE_AGENT); }
__device__ __forceinline__ unsigned xb_xcc_id() { return (unsigned)__builtin_amdgcn_s_getreg((3 << 11) | 20) & 0xFu; }
#define XB_SPIN(cond, bar) do { unsigned _sp = 0; while (cond) { __builtin_amdgcn_s_sleep(1); \
    if ((++_sp & 255u) == 0u) { if (xb_ld(&(bar)[XB_TMO])) break; if (_sp > XB_SPIN_CAP) { atomicAdd(&(bar)[XB_TMO], 1u); break; } } } } while (0)
struct XcdBarrier { unsigned* bar; unsigned x; volatile LAS unsigned* st; };
__device__ __forceinline__ XcdBarrier xcd_barrier_post(unsigned* bar, volatile LAS unsigned* st) {
    XcdBarrier b; b.bar = bar; b.x = xb_xcc_id(); b.st = st;
    if (threadIdx.x == 0) (void)xb_add(&bar[XB_XCNT(b.x)], 1u);
    return b;
}
__device__ __forceinline__ void xcd_barrier_complete(unsigned* bar, unsigned x, unsigned& nloc, unsigned& nx) {
    const unsigned G = gridDim.x * gridDim.y * gridDim.z;
    unsigned sum, cnt, mine, sp = 0u;
    for (;;) {
        sum = 0u; cnt = 0u; mine = 0u;
#pragma unroll
        for (unsigned j = 0; j < 16; ++j) { const unsigned c = xb_ld(&bar[XB_XCNT(j)]); sum += c; cnt += (c > 0u) ? 1u : 0u; mine = (j == x) ? c : mine; }
        if (sum == G) break;
        __builtin_amdgcn_s_sleep(1);
        if ((++sp & 255u) == 0u) { if (xb_ld(&bar[XB_TMO])) break; if (sp > XB_SPIN_CAP) { atomicAdd(&bar[XB_TMO], 1u); break; } }
    }
    nloc = mine > 0u ? mine : 1u; nx = cnt > 0u ? cnt : 1u;
}
__device__ __forceinline__ void xcd_barrier(const XcdBarrier& b) {
    asm volatile("s_waitcnt vmcnt(0)" ::: "memory");
    __syncthreads();
    if (threadIdx.x == 0) {
        unsigned* bar = b.bar;
        __builtin_amdgcn_s_waitcnt(0);
        unsigned nloc = b.st[0], nx = b.st[1];
        if (nloc == 0u) { xcd_barrier_complete(bar, b.x, nloc, nx); b.st[0] = nloc; b.st[1] = nx; }
        const unsigned old = xb_add(&bar[XB_XSUB(b.x)], 1u);
        const unsigned gen = old / nloc;
        if (old + 1u == (gen + 1u) * nloc) {
            __builtin_amdgcn_fence(__ATOMIC_RELEASE, "agent");
            asm volatile("s_waitcnt vmcnt(0)" ::: "memory");
            const unsigned og = xb_add(&bar[XB_TOP], 1u);
            const unsigned tg = og / nx;
            asm volatile("buffer_inv sc1" ::: "memory");
            if (og + 1u == (tg + 1u) * nx) xb_add(&bar[XB_TOPGEN], 1u);
            else XB_SPIN(xb_ld(&bar[XB_TOPGEN]) == tg, bar);
            asm volatile("" ::: "memory");
            xb_add(&bar[XB_XGEN(b.x)], 1u);
            asm volatile("s_waitcnt vmcnt(0)" ::: "memory");
        } else {
            asm volatile("buffer_inv sc1" ::: "memory");
            XB_SPIN(xb_ld(&bar[XB_XGEN(b.x)]) == gen, bar);
            asm volatile("s_waitcnt vmcnt(0)" ::: "memory");
        }
    }
    __syncthreads();
}

template <bool F8>
__device__ __forceinline__ void tr_item(const float* W, int N, int k0, int n0, const float* gain, float cscale, void* dst  , int Kd, LAS float* scr, int lane) {
    f32x4 v[8]; float g[8];
#pragma unroll
    for (int i = 0; i < 8; ++i) { const int kk = 8 * i + (lane >> 3); v[i] = __builtin_nontemporal_load(gp((const f32x4*)(W + (size_t)(k0 + kk) * N + n0 + 4 * (lane & 7)))); g[i] = gain ? *gp(gain + k0 + kk) * cscale : cscale; }
#pragma unroll
    for (int i = 0; i < 8; ++i) { const int kk = 8 * i + (lane >> 3); LAS float* d = scr + kk * 33 + 4 * (lane & 7); d[0] = v[i][0] * g[i]; d[1] = v[i][1] * g[i]; d[2] = v[i][2] * g[i]; d[3] = v[i][3] * g[i]; }
    asm volatile("s_waitcnt lgkmcnt(0)" ::: "memory");
    const int c = lane & 7;
#pragma unroll
    for (int j = 0; j < 4; ++j) { const int n = (lane >> 3) + 8 * j; const LAS float* s = scr + (8 * c) * 33 + n;
        if constexpr (F8) { u32x2 o; o[0] = pk_fp8x4(s[0 * 33], s[1 * 33], s[2 * 33], s[3 * 33]); o[1] = pk_fp8x4(s[4 * 33], s[5 * 33], s[6 * 33], s[7 * 33]); *gp((u32x2*)((unsigned char*)dst + (size_t)n * Kd + k0 + 8 * c)) = o; }
        else { u32x4 o; o[0] = cvt_pk_bf16(s[0 * 33], s[1 * 33]); o[1] = cvt_pk_bf16(s[2 * 33], s[3 * 33]); o[2] = cvt_pk_bf16(s[4 * 33], s[5 * 33]); o[3] = cvt_pk_bf16(s[6 * 33], s[7 * 33]);
            *gp((u32x4*)((bf16_t*)dst + (size_t)n * Kd + k0 + 8 * c)) = o; } }
    asm volatile("s_waitcnt lgkmcnt(0)" ::: "memory");
}
template <int NR, int Q8>
__device__ __forceinline__ void cvt_rows(const float* x, bf16_t* o, unsigned char* o8, float* sx, float* ss, int row0, int stride, int nrows, int lane) {
    f32x4 v[NR][4]; float s[NR];
#pragma unroll
    for (int r = 0; r < NR; ++r) { const int row = row0 + r * stride; const f32x4* xr = (const f32x4*)(x + (size_t)(row < nrows ? row : row0) * D) + lane;
#pragma unroll
        for (int j = 0; j < 4; ++j) v[r][j] = __builtin_nontemporal_load(gp(xr + 64 * j)); }
#pragma unroll
    for (int r = 0; r < NR; ++r) { float a = 0.f;
#pragma unroll
        for (int j = 0; j < 4; ++j) a += (v[r][j][0] * v[r][j][0] + v[r][j][1] * v[r][j][1]) + (v[r][j][2] * v[r][j][2] + v[r][j][3] * v[r][j][3]);
        s[r] = a; }
#pragma unroll
    for (int of = 1; of < 64; of <<= 1)
#pragma unroll
        for (int r = 0; r < NR; ++r) s[r] += __shfl_xor(s[r], of);
#pragma unroll
    for (int r = 0; r < NR; ++r) { const int row = row0 + r * stride; if (row < nrows) { u32x2* ob = (u32x2*)(o + (size_t)row * D) + lane;
#pragma unroll
            for (int j = 0; j < 4; ++j) { u32x2 w; w[0] = cvt_pk_bf16(v[r][j][0], v[r][j][1]); w[1] = cvt_pk_bf16(v[r][j][2], v[r][j][3]); *gp(ob + 64 * j) = w; }
            if constexpr (Q8 == 1) { unsigned* oq = (unsigned*)(o8 + (size_t)row * D) + lane;
#pragma unroll
                for (int j = 0; j < 4; ++j) *gp(oq + 64 * j) = pk_fp8x4(v[r][j][0], v[r][j][1], v[r][j][2], v[r][j][3]); }
            if constexpr (Q8 == 2) { float mx = 0.f;
#pragma unroll
                for (int j = 0; j < 4; ++j) mx = fmaxf(fmaxf(mx, fmaxf(fabsf(v[r][j][0]), fabsf(v[r][j][1]))), fmaxf(fabsf(v[r][j][2]), fabsf(v[r][j][3])));
#pragma unroll
                for (int of = 1; of < 64; of <<= 1) mx = fmaxf(mx, __shfl_xor(mx, of));
                mx = fmaxf(mx, 1e-30f); const float inv = 127.0f / mx; unsigned* oq = (unsigned*)(o8 + (size_t)row * D) + lane;
#pragma unroll
                for (int j = 0; j < 4; ++j) *gp(oq + 64 * j) = pk_i8x4(v[r][j][0] * inv, v[r][j][1] * inv, v[r][j][2] * inv, v[r][j][3] * inv);
                if (lane == 0) *gp(sx + row) = mx * (1.0f / 127.0f); }
            if (lane < 16) *gp(ss + (size_t)row * 16 + lane) = lane == 0 ? s[r] : 0.f; } }
}

struct Args { const float* in[20]; float* out; unsigned char* ws; int ph_lo, ph_hi, flags, pad; };

#define MK_PTRS unsigned char* ws = args.ws; float* out = args.out; asm volatile("" : "+s"(ws), "+s"(out)); \
    const float* x_in = args.in[0]; const float* mem_in = args.in[1]; const float* rel_bias = args.in[7]; \
    bf16_t* Wgu1 = (bf16_t*)(ws + WS_WGU1); bf16_t* Wd1 = (bf16_t*)(ws + WS_WD1); bf16_t* Win = (bf16_t*)(ws + WS_WIN); bf16_t* Wout = (bf16_t*)(ws + WS_WOUT); \
    bf16_t* Wcqs = (bf16_t*)(ws + WS_WCQS); bf16_t* Wckv = (bf16_t*)(ws + WS_WCKV); bf16_t* Wco = (bf16_t*)(ws + WS_WCO); bf16_t* Wgu2 = (bf16_t*)(ws + WS_WGU2); bf16_t* Wd2 = (bf16_t*)(ws + WS_WD2); \
    bf16_t* MB = (bf16_t*)(ws + WS_MB); bf16_t* KVC = (bf16_t*)(ws + WS_KVC); bf16_t* WKT = (bf16_t*)(ws + WS_WKT); bf16_t* VWT = (bf16_t*)(ws + WS_VWT); \
    float* SS0 = (float*)(ws + WS_SS); float* SS1 = SS0 + (size_t)M * 16; float* SS2 = SS1 + (size_t)M * 16; float* SS3 = SS2 + (size_t)M * 16; float* SS4 = SS3 + (size_t)M * 16; \
    float* SSM = (float*)(ws + WS_SSM); float* KM = (float*)(ws + WS_KM); float* SX = (float*)(ws + WS_SX); float* SW = (float*)(ws + WS_SW); (void)SX; (void)SW; float* SY = (float*)(ws + WS_SY); float* SWO = (float*)(ws + WS_SWO); (void)SY; (void)SWO; float* SWIN = (float*)(ws + WS_SWIN); (void)SWIN; \
    bf16_t* HB = (bf16_t*)(ws + WS_R1); bf16_t* QKV = HB; bf16_t* YN = HB; bf16_t* PB = HB; \
    bf16_t* XB = (bf16_t*)(ws + WS_XB); unsigned char* X8 = ws + WS_X8; (void)X8; bf16_t* OA0 = (bf16_t*)out; bf16_t* OA1 = (bf16_t*)((char*)out + OUT_OA1); bf16_t* OA2 = (bf16_t*)(ws + WS_OA2); bf16_t* OB = (bf16_t*)((char*)out + OUT_OB); float* ML = (float*)((char*)out + OUT_ML); unsigned* SEL = (unsigned*)(ws + WS_SEL); bf16_t* OBP = (bf16_t*)(ws + WS_OBP); float* MLB = (float*)(ws + WS_MLB); (void)OB;
__global__ void __launch_bounds__(NWAVES * 64, 2) mk_fwd(Args args) {
    extern __shared__ __attribute__((aligned(16))) unsigned char lds_raw[];
    LAS unsigned char* lds = (LAS unsigned char*)lds_raw;
    const int tid = threadIdx.x, lane = tid & 63, wave = __builtin_amdgcn_readfirstlane(tid >> 6);
    const int G = gridDim.x, bx = blockIdx.x;
    const int vcu = (G % 8 == 0) ? (bx % 8) * (G / 8) + bx / 8 : bx;
    const int gw = vcu * NWAVES + wave, NGW = G * NWAVES;
    unsigned char* const ws0 = args.ws;
    volatile LAS unsigned* MISC = (volatile LAS unsigned*)(lds + LDS_MISC);
    if (tid < 32) MISC[tid] = 0u;
    __syncthreads();
    const int lo = args.ph_lo, hi = args.ph_hi;
    const bool use_bar = (hi - lo) > 1;
    XcdBarrier bar; bar.bar = (unsigned*)(ws0 + WS_CTL) + CW_BAR; bar.x = 0; bar.st = nullptr;
    if (use_bar) bar = xcd_barrier_post((unsigned*)(ws0 + WS_CTL) + CW_BAR, MISC + 8);
#define IN(k) (lo <= (k) && (k) < hi)
#define STAGGER() do { if (MK_STAGGER_TICKS > 0) { const unsigned long long t0_ = __builtin_amdgcn_s_memrealtime(), dl_ = (unsigned long long)((bx >> 3) & 3) * MK_STAGGER_TICKS; while (__builtin_amdgcn_s_memrealtime() - t0_ < dl_) __builtin_amdgcn_s_sleep(8); } } while (0)
#define SEAM(k) do { if (IN(k) && IN((k) + 1)) xcd_barrier(bar); } while (0)

    if (IN(0)) {
        MK_PTRS;
        LAS float* scr = (LAS float*)(lds + wave * 16384);
        constexpr int I_GU = (D / 64) * (2 * DFF / 32), I_DN = (DFF / 64) * (D / 32), I_IN = (D / 64) * (NQKV / 32), I_SQ = (D / 64) * (D / 32), I_KV = (D / 64) * (2 * D / 32);
        constexpr int NITEMS = 2 * I_GU + 2 * I_DN + I_IN + 2 * I_SQ + I_KV;
        for (int it = gw; it < NITEMS; it += NGW) {
            int r = it;
            if (r < 2 * I_GU) {
                const bool second = r >= I_GU; if (second) r -= I_GU;
                if (I8_1G && !second) continue;
                const int nblk = 2 * DFF / 32, kb = r / nblk, nb = r % nblk, n0 = nb * 32;
                const int drow = n0 < DFF ? (n0 / 128) * 256 + (n0 % 128) : ((n0 - DFF) / 128) * 256 + 128 + ((n0 - DFF) % 128);
                if (second ? F8_2G : F8_1G) tr_item<true>(args.in[second ? 17 : 3], 2 * DFF, kb * 64, n0, args.in[second ? 16 : 2], F8_WGU, (unsigned char*)(second ? Wgu2 : Wgu1) + (size_t)drow * D, D, scr, lane);
                else tr_item<false>(args.in[second ? 17 : 3], 2 * DFF, kb * 64, n0, args.in[second ? 16 : 2], 1.0f, (second ? Wgu2 : Wgu1) + (size_t)drow * D, D, scr, lane);
                continue; }
            r -= 2 * I_GU;
            if (r < 2 * I_DN) { const bool second = r >= I_DN; if (second) r -= I_DN; const int nblk = D / 32, kb = r / nblk, nb = r % nblk;
                if (second ? F8_2D : F8_1D) tr_item<true>(args.in[second ? 18 : 4], D, kb * 64, nb * 32, nullptr, F8_WD, (unsigned char*)(second ? Wd2 : Wd1) + (size_t)(nb * 32) * DFF, DFF, scr, lane);
                else tr_item<false>(args.in[second ? 18 : 4], D, kb * 64, nb * 32, nullptr, 1.0f, (second ? Wd2 : Wd1) + (size_t)(nb * 32) * DFF, DFF, scr, lane);
                continue; }
            r -= 2 * I_DN;
            if (r < I_IN) { const int nblk = NQKV / 32, kb = r / nblk, nb = r % nblk, n0 = nb * 32; const bool isq = (n0 < 768) || (n0 >= 2304 && n0 < 2560);
                if (Q8I && (n0 < 2304 || n0 >= 2816)) continue;
                tr_item<false>(args.in[6], NQKV, kb * 64, n0, args.in[5], isq ? 0.125f : 1.0f, Win + (size_t)n0 * D, D, scr, lane); continue; }
            r -= I_IN;
            if (r < I_SQ) { if (O8I) continue; const int nblk = D / 32, kb = r / nblk, nb = r % nblk, k0 = kb * 64; const float* gp = k0 < 768 ? args.in[8] : args.in[9] - 768;
                tr_item<false>(args.in[10], D, k0, nb * 32, gp, 1.0f, Wout + (size_t)(nb * 32) * D, D, scr, lane); continue; }
            r -= I_SQ;
            if (r < I_SQ) { const int nblk = D / 32, kb = r / nblk, nb = r % nblk; tr_item<false>(args.in[15], D, kb * 64, nb * 32, nullptr, 1.0f, Wco + (size_t)(nb * 32) * D, D, scr, lane); continue; }
            r -= I_SQ;
            { const int nblk = 2 * D / 32, kb = r / nblk, nb = r % nblk; tr_item<false>(args.in[14], 2 * D, kb * 64, nb * 32, args.in[12], 1.0f, Wckv + (size_t)(nb * 32) * D, D, scr, lane); }
        }
        auto coop_i8 = [&](const float* W, const int ldw, const int n0, auto gainf, unsigned char* dst  , float* swout  ) {
                f32x4 v[2][8]; f32x4 mx = (f32x4){0.f, 0.f, 0.f, 0.f};
#pragma unroll
                for (int t = 0; t < 2; ++t)
#pragma unroll
                    for (int i = 0; i < 8; ++i) { const int kk = (2 * wave + t) * 64 + 8 * i + (lane >> 3); v[t][i] = __builtin_nontemporal_load(gp((const f32x4*)(W + (size_t)kk * ldw + n0 + 4 * (lane & 7)))) * gainf(kk); }
#pragma unroll
                for (int t = 0; t < 2; ++t)
#pragma unroll
                    for (int i = 0; i < 8; ++i)
#pragma unroll
                        for (int c = 0; c < 4; ++c) mx[c] = fmaxf(mx[c], fabsf(v[t][i][c]));
#pragma unroll
                for (int c = 0; c < 4; ++c) { float a = mx[c]; a = fmaxf(a, __shfl_xor(a, 8)); a = fmaxf(a, __shfl_xor(a, 16)); a = fmaxf(a, __shfl_xor(a, 32)); mx[c] = a; }
                LAS float* XM = (LAS float*)(lds + LDS_XCH);
                if (lane < 8) { XM[wave * 32 + 4 * lane + 0] = mx[0]; XM[wave * 32 + 4 * lane + 1] = mx[1]; XM[wave * 32 + 4 * lane + 2] = mx[2]; XM[wave * 32 + 4 * lane + 3] = mx[3]; }
                asm volatile("s_waitcnt lgkmcnt(0)" ::: "memory"); __syncthreads();
                float mul[4];
#pragma unroll
                for (int c = 0; c < 4; ++c) { float a = 0.f;
#pragma unroll
                    for (int w2 = 0; w2 < NWAVES; ++w2) a = fmaxf(a, XM[w2 * 32 + 4 * (lane & 7) + c]);
                    a = fmaxf(a, 1e-30f); mul[c] = 127.0f / a; if (wave == 0 && lane < 8) *gp(swout + 4 * lane + c) = a * (1.0f / 127.0f); }
#pragma unroll
                for (int t = 0; t < 2; ++t) { const int k0 = (2 * wave + t) * 64;
#pragma unroll
                    for (int i = 0; i < 8; ++i) { const int kk = 8 * i + (lane >> 3); LAS float* d = scr + kk * 33 + 4 * (lane & 7); d[0] = v[t][i][0] * mul[0]; d[1] = v[t][i][1] * mul[1]; d[2] = v[t][i][2] * mul[2]; d[3] = v[t][i][3] * mul[3]; }
                    asm volatile("s_waitcnt lgkmcnt(0)" ::: "memory");
                    const int c8 = lane & 7;
#pragma unroll
                    for (int j = 0; j < 4; ++j) { const int n = (lane >> 3) + 8 * j; const LAS float* s = scr + (8 * c8) * 33 + n;
                        u32x2 o; o[0] = pk_i8x4(s[0 * 33], s[1 * 33], s[2 * 33], s[3 * 33]); o[1] = pk_i8x4(s[4 * 33], s[5 * 33], s[6 * 33], s[7 * 33]);
                        *gp((u32x2*)(dst + (size_t)n * D + k0 + 8 * c8)) = o; }
                    asm volatile("s_waitcnt lgkmcnt(0)" ::: "memory"); }
                __syncthreads(); };
        if constexpr (I8_1G) {
            for (int cg = vcu; cg < 2 * DFF / 32; cg += G) {
                const int n0 = cg * 32, drow = n0 < DFF ? (n0 / 128) * 256 + (n0 % 128) : ((n0 - DFF) / 128) * 256 + 128 + ((n0 - DFF) % 128);
                const float* gain = args.in[2];
                coop_i8(args.in[3], 2 * DFF, n0, [&](int kk) { return gain[kk]; }, (unsigned char*)Wgu1 + (size_t)drow * D, SW + n0); }
        }
        if constexpr (Q8I) {
            for (int cgi = vcu; cgi < 288; cgi += G) { const int cg = cgi - 208; if (cg < 0) continue;
                const int n0 = cg < 72 ? cg * 32 : 2816 + (cg - 72) * 32; const float* gm = args.in[5]; const float qs = n0 < 768 ? 0.125f : 1.0f;
                coop_i8(args.in[6], NQKV, n0, [&](int kk) { return gm[kk] * qs; }, ws + WS_WIN8 + (size_t)n0 * D, SWIN + n0); }
        }
        if constexpr (O8I) {
            for (int cg = vcu - 2 * DFF / 32; cg < D / 32; cg += G) { if (cg < 0) continue;
                const int n0 = cg * 32; const float* ga = args.in[8]; const float* gb = args.in[9];
                coop_i8(args.in[10], D, n0, [&](int kk) { return kk < 768 ? ga[kk] : gb[kk - 768]; }, (unsigned char*)Wout + (size_t)n0 * D, SWO + n0); }
        }
        for (int c = gw; c < D; c += NGW) { const float g = args.in[11][c] * 0.0625f; const f32x4* src = (const f32x4*)(args.in[13] + (size_t)c * D) + lane; u32x2* dst = (u32x2*)(Wcqs + (size_t)c * D) + lane;
#pragma unroll
            for (int j = 0; j < 4; ++j) { const f32x4 v = src[64 * j] * g; u32x2 w; w[0] = cvt_pk_bf16(v[0], v[1]); w[1] = cvt_pk_bf16(v[2], v[3]); dst[64 * j] = w; } }
        for (int m = gw; m < M; m += 4 * NGW) cvt_rows<4, I8_1G ? 2 : (F8_1G ? 1 : 0)>(x_in, XB, X8, SX, SS0, m, NGW, M, lane);
        for (int m = gw; m < MM; m += NGW) cvt_rows<1, 0>(mem_in, MB, nullptr, nullptr, SSM, m, NGW, MM, lane);
        for (int i = gw * 64 + lane; i < NBAT * 16 * 256; i += NGW * 64) KM[i] = 0.f;
    }
    SEAM(0);

    if (IN(1)) {
        MK_PTRS;
        STAGGER();
        { constexpr int EB = (F8_1G || I8_1G) ? 1 : 2;
          SchedStd S; S.o.init(M, 2 * DFF, G, bx); S.A = (F8_1G || I8_1G) ? (const char*)X8 : (const char*)XB; S.B = (const char*)Wgu1; S.a_tile = (size_t)256 * D * EB; S.b_tile = (size_t)256 * D * EB; S.b_batch = 0; S.ocol_mul = 128;
          EpiGU<F8_1G, F8_1D, I8_1G> E{HB, SS0, SX, SW, MK_N_LAUNCHES == 1 ? 0 : args.flags}; pg8::gemm_phase<EpiGU<F8_1G, F8_1D, I8_1G>, SchedStd, true, I8_1G ? 2 : (F8_1G ? 1 : 0)>(lds, D * EB / 2, D * EB / 2, D * EB / 128, S, E); }
    }
    SEAM(1);

    if (IN(2)) {
        MK_PTRS;
        constexpr int EB = F8_1D ? 1 : 2;
        SchedStd S; S.o.init(M, D, G, bx); S.A = (const char*)HB; S.B = (const char*)Wd1; S.a_tile = (size_t)256 * DFF * EB; S.b_tile = (size_t)256 * DFF * EB; S.b_batch = 0; S.ocol_mul = 256;
        EpiRes<Q8CLIP, false, Q8CLIP> E{XB, SS1, F8_1D ? 0.5f / (F8_H * F8_WD) : 0.5f, X8, nullptr, nullptr, SS0, SX}; pg8::gemm_phase<EpiRes<Q8CLIP, false, Q8CLIP>, SchedStd, true, F8_1D>(lds, DFF * EB / 2, DFF * EB / 2, DFF * EB / 128, S, E);
    }
    SEAM(2);

    if (IN(3)) {
        if constexpr (Q8I && !Q8CLIP) {
            MK_PTRS;
            for (int row0 = gw; row0 < M; row0 += 4 * NGW) {
                u32x4 w[4][2];
#pragma unroll
                for (int r = 0; r < 4; ++r) { const int row = (row0 + r * NGW) < M ? (row0 + r * NGW) : row0; const u32x4* xr = (const u32x4*)(XB + (size_t)row * D) + lane; w[r][0] = xr[0]; w[r][1] = xr[64]; }
#pragma unroll
                for (int r = 0; r < 4; ++r) { const int row = row0 + r * NGW; float f[16]; float mx = 0.f;
#pragma unroll
                    for (int j = 0; j < 2; ++j)
#pragma unroll
                        for (int e = 0; e < 4; ++e) { f[8 * j + 2 * e] = __builtin_bit_cast(float, w[r][j][e] << 16); f[8 * j + 2 * e + 1] = __builtin_bit_cast(float, w[r][j][e] & 0xffff0000u); }
#pragma unroll
                    for (int e = 0; e < 16; ++e) mx = fmaxf(mx, fabsf(f[e]));
#pragma unroll
                    for (int of = 1; of < 64; of <<= 1) mx = fmaxf(mx, __shfl_xor(mx, of));
                    mx = fmaxf(mx, 1e-30f); const float inv = 127.0f / mx;
                    if (row < M) { u32x2* o8 = (u32x2*)(X8 + (size_t)row * D) + lane;
#pragma unroll
                        for (int j = 0; j < 2; ++j) { u32x2 o; o[0] = pk_i8x4(f[8 * j] * inv, f[8 * j + 1] * inv, f[8 * j + 2] * inv, f[8 * j + 3] * inv); o[1] = pk_i8x4(f[8 * j + 4] * inv, f[8 * j + 5] * inv, f[8 * j + 6] * inv, f[8 * j + 7] * inv); o8[64 * j] = o; }
                        if (lane == 0) SX[row] = mx * (1.0f / 127.0f); } }
            }
        }
    }
    if constexpr (Q8I && !Q8CLIP) SEAM(3);

    if (IN(4)) {
        MK_PTRS;
        if constexpr (Q8I) {
          { SchedStd S; S.o.init(M, 512, G, bx); S.A = (const char*)XB; S.B = (const char*)Win; S.a_tile = (size_t)256 * D * 2; S.b_tile = (size_t)256 * D * 2; S.b_batch = 0; S.ocol_mul = 256; S.pn_map = 2;
            EpiStoreT<true> E{QKV, 0, SS1, KM, false}; pg8::gemm_phase<EpiStoreT<true>, SchedStd, true, 0>(lds, D, D, D / 64, S, E); }
          { SchedStd S; S.o.init(M, 2560, G, bx); S.A = (const char*)X8; S.B = (const char*)(ws + WS_WIN8); S.a_tile = (size_t)256 * D; S.b_tile = (size_t)256 * D; S.b_batch = 0; S.ocol_mul = 256; S.pn_map = 1;
            EpiStoreT<true, false, true> E{QKV, 0, SS1, KM, false, 1.0f, SX, SWIN}; pg8::gemm_phase<EpiStoreT<true, false, true>, SchedStd, true, 2>(lds, D / 2, D / 2, D / 128, S, E); }
        } else
        { SchedStd S; S.o.init(M, NQKV, G, bx); S.A = (const char*)XB; S.B = (const char*)Win; S.a_tile = (size_t)256 * D * 2; S.b_tile = (size_t)256 * D * 2; S.b_batch = 0; S.ocol_mul = 256;
          EpiStoreT<true> E{QKV, 0, SS1, KM, false}; pg8::gemm_phase<EpiStoreT<true>, SchedStd, true, 0>(lds, D, D, D / 64, S, E); }
    }
    SEAM(4);

    if (IN(5)) {
        MK_PTRS;
        constexpr long HSTR4 = (long)SEQ * 128;
        for (int task = gw; task < NBAT * 4 * (SEQ / 32); task += NGW) { const int bh = task / (SEQ / 32), tl = task % (SEQ / 32), b = bh >> 2, hb = bh & 3, q0 = tl * 32, qb = q0 >> 8;
            const char* qbase = (const char*)QKV + ((size_t)b * 48 + 36 + hb) * HSTR4 + (size_t)q0 * 128;
            const unsigned msk = att::moba_select(qbase, 128, KM + (size_t)b * 16 * 256 + hb * 64, qb);
            if (lane < 32) SEL[(size_t)bh * SEQ + q0 + lane] = msk; }
    }
    SEAM(5);

    if (IN(6)) {
        MK_PTRS;
        LAS float* tab = (LAS float*)(lds + LDS_TAB);
        const int h2 = lane >> 5, q = lane & 31;
        const long rowb = 128;
        constexpr long HSTR = (long)SEQ * 128;
#define ATT_WAITV(n) asm volatile("s_waitcnt vmcnt(" #n ")" ::: "memory")
#define ATT_BAR() do { asm volatile("s_waitcnt lgkmcnt(0)" ::: "memory"); __builtin_amdgcn_s_barrier(); asm volatile("" ::: "memory"); } while (0)
        {
        LAS float* rbl = (LAS float*)(lds + LDS_TAB); LAS float* tabI = (LAS float*)(lds + LDS_TAB + 2048);
        LAS char* ostg = (LAS char*)(lds + LDS_TAB + 3072 + wave * 4096);
        static_assert(LDS_TAB + 3072 + NWAVES * 4096 <= LDS_MISC, "dilated LDS map");
        for (int i = tid; i < 512; i += NWAVES * 64) rbl[i] = rel_bias[i] * LOG2E;
        __syncthreads();
        constexpr int NDIL = NBAT * 12 * 48;
        struct DilItem { int b, h, p, d, res, m0, mbase; };
        auto decode = [&](int it, DilItem& I) { const int bh = it / 48, j = it % 48; I.b = bh / 12; I.h = bh % 12; I.p = j >> 4; const int jj = j & 15;
            I.d = I.p == 0 ? 1 : (I.p == 1 ? 4 : 16); I.res = I.p == 0 ? 0 : (I.p == 1 ? (jj & 3) : jj); const int mblk = I.p == 0 ? jj : (I.p == 1 ? (jj >> 2) : 0);
            I.mbase = mblk * 256 - 128; I.m0 = mblk * 256 + wave * 32; };
        att::bf16x8 qf[4];
        auto issue_k = [&](const DilItem& I) {
            const char* kb = (const char*)QKV + ((size_t)I.b * 48 + 12 + I.h) * HSTR + (size_t)I.res * rowb; const long st = (long)I.d * rowb;
#pragma unroll 1
            for (int k = wave; k < 48; k += NWAVES) { if (I.mbase + 8 * k < 0) continue; const int row = 8 * k + (lane >> 3); att::dma_k_rows8(kb + (long)(I.mbase + row) * st, row, (LAS char*)(lds + k * 1024), lane); } };
        auto issue_v = [&](const DilItem& I) {
            const char* vb = (const char*)QKV + ((size_t)I.b * 48 + 24 + I.h) * HSTR + (size_t)I.res * rowb; const long st = (long)I.d * rowb;
#pragma unroll 1
            for (int k = wave; k < 48; k += NWAVES) { if (I.mbase + 8 * k < 0) continue; const int row = 8 * k + (lane >> 3); att::dma_v_rows8(vb + (long)(I.mbase + row) * st, row, (LAS char*)(lds + 49152 + k * 1024), lane); } };
        auto load_q = [&](const DilItem& I) {
            const char* qp = (const char*)QKV + ((size_t)I.b * 48 + I.h) * HSTR + (size_t)I.res * rowb + (long)I.m0 * I.d * rowb + (long)q * I.d * rowb + 16 * h2;
            asm volatile("global_load_dwordx4 %0, %4, off\n\tglobal_load_dwordx4 %1, %4, off offset:32\n\tglobal_load_dwordx4 %2, %4, off offset:64\n\tglobal_load_dwordx4 %3, %4, off offset:96"
                         : "=&v"(qf[0]), "=&v"(qf[1]), "=&v"(qf[2]), "=&v"(qf[3]) : "v"(qp) : "memory"); };
        auto build_tab = [&](const DilItem& I) { if (tid < att::TABA_N) { const int delta = tid - 32; tabI[tid] = (delta >= 0 && delta <= 128) ? rbl[att::rel_bucket(delta * I.d) * 16 + I.h] : -INFINITY; } };
        att::u32x4 vr[6];
        auto load_v = [&](const DilItem& I) {
            const char* vb = (const char*)QKV + ((size_t)I.b * 48 + 24 + I.h) * HSTR + (size_t)I.res * rowb; const long st = (long)I.d * rowb;
#pragma unroll
            for (int j = 0; j < 6; ++j) { const int k = wave + NWAVES * j; if (I.mbase + 8 * k < 0) continue; const int row = 8 * k + (lane >> 3);
                const char* src = vb + (long)(I.mbase + row) * st + 16 * ((lane & 7) ^ (((row >> 1) & 1) << 2));
                asm volatile("global_load_dwordx4 %0, %1, off" : "=&v"(vr[j]) : "v"(src) : "memory"); } };
        DilItem cur; int it = vcu;
        if (it < NDIL) { decode(it, cur); build_tab(cur); ATT_WAITV(0); issue_k(cur); load_q(cur); issue_v(cur); }
        att::f32x16 po[2]; po[0] = att::f32x16{}; po[1] = att::f32x16{}; float pmo = 0.f, plo = 1.f; DilItem pdone = cur; int pm0 = 0; bool pvalid = false;
#define FLUSH_PREV() do { const size_t tok_ = (size_t)pdone.b * SEQ + (size_t)(pm0 + q) * pdone.d + pdone.res; \
            att::store_o_staged<MK_NT_PART>(po, plo, ostg, (char*)(pdone.p == 0 ? OA0 : (pdone.p == 1 ? OA1 : OA2)) + (((size_t)pdone.b * SEQ + (size_t)pm0 * pdone.d + pdone.res) * 768 + pdone.h * 64) * 2, (long)pdone.d * 768 * 2, lane); \
            if (h2 == 0) *gp((f32x2*)(ML + (((size_t)pdone.p * M + tok_) * 12 + pdone.h) * 2)) = (f32x2){pmo, plo}; } while (0)
#pragma unroll 1
        for (; it < NDIL; it += G) {
            ATT_WAITV(0);
            asm volatile("" : "+v"(qf[0]), "+v"(qf[1]), "+v"(qf[2]), "+v"(qf[3]));
            ATT_BAR();
            const bool has_next = it + G < NDIL; DilItem nxt = cur; if (has_next) decode(it + G, nxt);
            if (pvalid) FLUSH_PREV();
            if (has_next) load_v(nxt);
            const int m0 = cur.m0, gend = (m0 - 128) > 0 ? (m0 - 128) : 0, ng = ((m0 - gend) >> 5) + 1;
            att::u32x4 pw[5][2]; float mo, lo_;
            { att::bf16x8 qc[4] = {qf[0], qf[1], qf[2], qf[3]};
              att::dil_pass1<5>(qc, ng, (const LAS char*)(lds + (m0 - cur.mbase) * 128), tabI + 32 + q - 4 * h2, tabI + att::TABA_N, pw, mo, lo_, lane); }
            ATT_BAR();
            const DilItem done = cur;
            if (has_next) { cur = nxt; issue_k(cur); build_tab(cur); load_q(cur); }
            att::f32x16 o[2];
            att::dil_pass2<5>(ng, (const LAS char*)(lds + 49152 + (m0 - done.mbase) * 128), pw, o, lane);
            ATT_BAR();
            po[0] = o[0]; po[1] = o[1]; pmo = mo; plo = lo_; pdone = done; pm0 = m0; pvalid = true;
            if (has_next) {
                if (cur.mbase < 0) ATT_WAITV(8); else ATT_WAITV(10);
                asm volatile("" : "+v"(vr[0]), "+v"(vr[1]), "+v"(vr[2]), "+v"(vr[3]), "+v"(vr[4]), "+v"(vr[5]));
#pragma unroll
                for (int j = 0; j < 6; ++j) { const int k = wave + NWAVES * j; if (cur.mbase + 8 * k < 0) continue; *(LAS att::u32x4*)(lds + 49152 + k * 1024 + lane * 16) = vr[j]; }
            }
        }
        if (pvalid) FLUSH_PREV();
#undef FLUSH_PREV
        }
        ATT_WAITV(0); __syncthreads();
        { constexpr int NKV = NBAT * 8;
          struct SchedOne { const char* A; const char* B; int G_, c_; __device__ __forceinline__ bool next(int i, Unit& uu) const { const int idx = i * G_ + c_; if (idx >= NKV) return false; const int pm = idx >> 3, pn = idx & 7;
              uu.a = A + (size_t)pm * 256 * D * 2; uu.b = B + (size_t)pn * 256 * D * 2; uu.orow = pm * 256; uu.ocol = pn * 256; uu.aux = pn; return true; } };
          SchedOne S1{(const char*)MB, (const char*)Wckv, G, vcu};
          EpiStore Ekv{KVC, 2 * D, SSM, nullptr, false}; pg8::gemm_phase<EpiStore, SchedOne, true>(lds, D, D, D / 64, S1, Ekv);
          __syncthreads(); }
        for (int i = tid; i < 4 * att::TABB_N; i += NWAVES * 64) { const int hb = i / att::TABB_N, e = i % att::TABB_N, dist = e - 32;
            tab[i] = dist >= 0 ? rel_bias[att::rel_bucket(dist) * 16 + 12 + hb] * LOG2E : -INFINITY; }
        __syncthreads();
        {
            constexpr int NBH = NBAT * 4, NUNITS = 16 * NBH;
            LAS unsigned* LQ = (LAS unsigned*)(lds + 65536);
            volatile LAS unsigned* UW = (volatile LAS unsigned*)(lds + 65536 + 16384);
            unsigned* qhead = (unsigned*)(ws + WS_CTL) + CW_QUEUE;
#pragma unroll 1
            for (;;) {
                if (tid == 0) UW[8] = __hip_atomic_fetch_add(qhead, 1u, __ATOMIC_RELAXED, __HIP_MEMORY_SCOPE_AGENT);
                ATT_BAR();
                const int u = (int)UW[8];
                if (u >= NUNITS) break;
                const int n = u / NBH, bh = u % NBH, b = bh >> 2, hb = bh & 3;
                const char* qh = (const char*)QKV + ((size_t)b * 48 + 36 + hb) * HSTR;
                const char* kh = (const char*)QKV + ((size_t)b * 48 + 40 + hb) * HSTR + (size_t)(256 * n) * rowb;
                const unsigned* selp = SEL + (size_t)bh * SEQ;
                ATT_WAITV(0);
#pragma unroll
                for (int k = wave; k < 32; k += NWAVES) { const int row = 8 * k + (lane >> 3); att::dma_rows8(kh + (long)row * rowb, (int)(4 * HSTR), row, (LAS char*)(lds + k * 1024), (LAS char*)(lds + 32768 + k * 1024), lane); }
                int total = 0;
                if (n < 15) {
                    const int lo = 256 * (n + 1) + wave * 32 * (15 - n), R = 32 * (15 - n);
                    int cnt = 0;
#pragma unroll 1
                    for (int i = 0; i < R; i += 64) { const bool pr = (i + lane < R) && ((*gp(selp + lo + i + lane) >> n) & 1u); cnt += __popcll(__ballot(pr)); }
                    if (lane == 0) UW[wave] = (unsigned)cnt;
                    ATT_BAR();
                    int basew = 0;
#pragma unroll
                    for (int w2 = 0; w2 < NWAVES; ++w2) { const int cw = (int)UW[w2]; basew += (w2 < wave) ? cw : 0; total += cw; }
#pragma unroll 1
                    for (int i = 0; i < R; i += 64) { const bool pr = (i + lane < R) && ((*gp(selp + lo + i + lane) >> n) & 1u); const unsigned long long bal = __ballot(pr);
                        if (pr) LQ[basew + __popcll(bal & ((1ull << lane) - 1ull))] = (unsigned)(lo + i + lane); basew += __popcll(bal); }
                }
                const int ntiles = (total + 31) >> 5;
                ATT_WAITV(0); ATT_BAR();
                const LAS float* tb = tab + hb * att::TABB_N;
#pragma unroll 1
                for (int tile = -1; tile < ntiles; tile = (tile < 0 ? wave : tile + NWAVES)) {
                    const bool own = tile < 0;
                    int tq; bool valid = true;
                    if (own) tq = 256 * n + 32 * wave + q; else { const int e = 32 * tile + q; valid = e < total; tq = (int)LQ[valid ? e : total - 1]; }
                    att::bf16x8 qf[4];
#pragma unroll
                    for (int d0 = 0; d0 < 4; ++d0) qf[d0] = *gp((const att::bf16x8*)(qh + (long)tq * rowb + (16 * d0 + 8 * h2) * 2));
                    const int slot = own ? 3 : __popc(*gp(selp + tq) & ((1u << n) - 1u));
                    att::f32x16 o[2]; float mo, lo_;
                    const int Bq = (tq - 256 * n + 32) - 4 * h2;
                    { const int gtop = own ? wave : 7; att::u32x4 pw[4][2]; const int nga = gtop < 3 ? gtop + 1 : 4;
                      att::dil_pass1<4>(qf, nga, (const LAS char*)(lds + gtop * 4096), tb + (Bq - 32 * gtop), tb + (att::TABB_N - 1), pw, mo, lo_, lane);
                      att::dil_pass2<4>(nga, (const LAS char*)(lds + 32768 + gtop * 4096), pw, o, lane);
                      if (gtop >= 4) { att::f32x16 o2[2]; float m2, l2;
                          att::dil_pass1<4>(qf, gtop - 3, (const LAS char*)(lds + (gtop - 4) * 4096), tb + (Bq - 32 * gtop) + 128, tb + (att::TABB_N - 1), pw, m2, l2, lane);
                          att::dil_pass2<4>(gtop - 3, (const LAS char*)(lds + 32768 + (gtop - 4) * 4096), pw, o2, lane);
                          const float mm = fmaxf(mo, m2), a1 = __builtin_amdgcn_exp2f(mo - mm), a2 = __builtin_amdgcn_exp2f(m2 - mm);
#pragma unroll
                          for (int r = 0; r < 16; ++r) { o[0][r] = o[0][r] * a1 + o2[0][r] * a2; o[1][r] = o[1][r] * a1 + o2[1][r] * a2; }
                          lo_ = lo_ * a1 + l2 * a2; mo = mm; } }
                    const size_t prow = (size_t)slot * M + (size_t)b * SEQ + tq;
                    att::store_o<MK_NT_PART>(o, lo_, (char*)OBP + (prow * 256 + hb * 64) * 2, h2, valid);
                    if (h2 == 0 && valid) *gp((f32x2*)(MLB + (prow * 4 + hb) * 2)) = (f32x2){mo, lo_};
                }
                ATT_BAR();
            }
        }
#undef ATT_WAITV
#undef ATT_BAR
    }
    SEAM(6);

    if (IN(7)) {
        MK_PTRS;
        for (int row0 = gw; row0 < M; row0 += 2 * NGW) {
            const int r0_ = row0, r1_ = (row0 + NGW) < M ? (row0 + NGW) : row0;
            f32x2 ml[3][3]; u32x4 oa[3][3]; f32x2 mlb[4]; u32x4 obp[4];
            int rsel[3], colA[3];
#pragma unroll
            for (int k = 0; k < 3; ++k) { const int f = 512 * k + 8 * lane; rsel[k] = f >= 768 ? 1 : 0; colA[k] = f - 768 * rsel[k]; const int row = rsel[k] ? r1_ : r0_, hd = colA[k] >> 6;
#pragma unroll
                for (int p = 0; p < 3; ++p) ml[k][p] = __builtin_nontemporal_load(gp((const f32x2*)(ML + (((size_t)p * M + row) * 12 + hd) * 2)));
                oa[k][0] = __builtin_nontemporal_load(gp((const u32x4*)(OA0 + (size_t)row * 768 + colA[k]))); oa[k][1] = __builtin_nontemporal_load(gp((const u32x4*)(OA1 + (size_t)row * 768 + colA[k]))); oa[k][2] = __builtin_nontemporal_load(gp((const u32x4*)(OA2 + (size_t)row * 768 + colA[k]))); }
            const int rselB = lane >> 5, colB = 8 * (lane & 31), rowB = rselB ? r1_ : r0_;
#pragma unroll
            for (int s = 0; s < 4; ++s) { mlb[s] = __builtin_nontemporal_load(gp((const f32x2*)(MLB + (((size_t)s * M + rowB) * 4 + (colB >> 6)) * 2))); obp[s] = __builtin_nontemporal_load(gp((const u32x4*)(OBP + ((size_t)s * M + rowB) * 256 + colB))); }
            float va[3][8], vb[8], ssa[2] = {0.f, 0.f}, ssb[2] = {0.f, 0.f}, amx[2] = {0.f, 0.f}, bmx[2] = {0.f, 0.f};
#pragma unroll
            for (int k = 0; k < 3; ++k) {
                const float Mx = fmaxf(ml[k][0][0], fmaxf(ml[k][1][0], ml[k][2][0]));
                const float w0 = ml[k][0][1] * __builtin_amdgcn_exp2f(ml[k][0][0] - Mx), w1 = ml[k][1][1] * __builtin_amdgcn_exp2f(ml[k][1][0] - Mx), w2 = ml[k][2][1] * __builtin_amdgcn_exp2f(ml[k][2][0] - Mx);
                const float iw = __builtin_amdgcn_rcpf(w0 + w1 + w2); float sq = 0.f, mx = 0.f;
#pragma unroll
                for (int e = 0; e < 8; ++e) { const unsigned s0 = oa[k][0][e >> 1], s1 = oa[k][1][e >> 1], s2 = oa[k][2][e >> 1];
                    const float f0 = __builtin_bit_cast(float, (e & 1) ? (s0 & 0xffff0000u) : (s0 << 16)), f1 = __builtin_bit_cast(float, (e & 1) ? (s1 & 0xffff0000u) : (s1 << 16)), f2 = __builtin_bit_cast(float, (e & 1) ? (s2 & 0xffff0000u) : (s2 << 16));
                    const float v = (w0 * f0 + w1 * f1 + w2 * f2) * iw; va[k][e] = v; sq += v * v; mx = fmaxf(mx, fabsf(v)); }
                ssa[0] += rsel[k] ? 0.f : sq; ssa[1] += rsel[k] ? sq : 0.f; amx[0] = fmaxf(amx[0], rsel[k] ? 0.f : mx); amx[1] = fmaxf(amx[1], rsel[k] ? mx : 0.f); }
            { const int nsel = (((rowB % SEQ) >> 8) < 3) ? ((rowB % SEQ) >> 8) : 3;
              float wq[4], Mq = -INFINITY;
#pragma unroll
              for (int s = 0; s < 4; ++s) { const bool use = (s == 3) || (s < nsel); Mq = use ? fmaxf(Mq, mlb[s][0]) : Mq; }
              float wsum = 0.f;
#pragma unroll
              for (int s = 0; s < 4; ++s) { const bool use = (s == 3) || (s < nsel); wq[s] = use ? mlb[s][1] * __builtin_amdgcn_exp2f(mlb[s][0] - Mq) : 0.f; wsum += wq[s]; }
              const float iwq = __builtin_amdgcn_rcpf(wsum); float sq = 0.f, mx = 0.f;
#pragma unroll
              for (int e = 0; e < 8; ++e) { float acc_ = 0.f;
#pragma unroll
                  for (int s = 0; s < 4; ++s) { const bool use = (s == 3) || (s < nsel); const unsigned s0 = obp[s][e >> 1]; const float f = __builtin_bit_cast(float, (e & 1) ? (s0 & 0xffff0000u) : (s0 << 16)); acc_ += use ? wq[s] * f : 0.f; }
                  vb[e] = acc_ * iwq; sq += vb[e] * vb[e]; mx = fmaxf(mx, fabsf(vb[e])); }
              ssb[0] = rselB ? 0.f : sq; ssb[1] = rselB ? sq : 0.f; bmx[0] = rselB ? 0.f : mx; bmx[1] = rselB ? mx : 0.f; }
#pragma unroll
            for (int of = 1; of < 64; of <<= 1)
#pragma unroll
                for (int r = 0; r < 2; ++r) { ssa[r] += __shfl_xor(ssa[r], of); ssb[r] += __shfl_xor(ssb[r], of); amx[r] = fmaxf(amx[r], __shfl_xor(amx[r], of)); bmx[r] = fmaxf(bmx[r], __shfl_xor(bmx[r], of)); }
            float ra[2], rb[2], ia[2], ib[2];
#pragma unroll
            for (int r = 0; r < 2; ++r) { ra[r] = __builtin_amdgcn_rsqf(ssa[r] * (1.0f / 768.0f) + EPS); rb[r] = __builtin_amdgcn_rsqf(ssb[r] * (1.0f / 256.0f) + EPS);
                const float am = fmaxf(fmaxf(amx[r] * ra[r], bmx[r] * rb[r]), 1e-30f); ia[r] = ra[r] * 127.0f / am; ib[r] = rb[r] * 127.0f / am;
                if (O8I && lane == 0 && (r == 0 || r1_ != r0_)) *gp(SY + (r == 0 ? r0_ : r1_)) = am * (1.0f / 127.0f); }
            const bool two = r1_ != r0_;
#pragma unroll
            for (int k = 0; k < 3; ++k) { const int r = rsel[k]; if (r == 1 && !two) continue; const int rowk = r ? r1_ : r0_;
                if constexpr (O8I) { const float s_ = r ? ia[1] : ia[0]; u32x2 w; w[0] = pk_i8x4(va[k][0] * s_, va[k][1] * s_, va[k][2] * s_, va[k][3] * s_); w[1] = pk_i8x4(va[k][4] * s_, va[k][5] * s_, va[k][6] * s_, va[k][7] * s_);
                    *gp((u32x2*)((unsigned char*)YN + (size_t)rowk * D + colA[k])) = w; }
                else { const float s_ = r ? ra[1] : ra[0]; u32x4 w; w[0] = cvt_pk_bf16(va[k][0] * s_, va[k][1] * s_); w[1] = cvt_pk_bf16(va[k][2] * s_, va[k][3] * s_); w[2] = cvt_pk_bf16(va[k][4] * s_, va[k][5] * s_); w[3] = cvt_pk_bf16(va[k][6] * s_, va[k][7] * s_);
                    *gp((u32x4*)(YN + (size_t)rowk * D + colA[k])) = w; } }
            if (rselB == 0 || two) {
                if constexpr (O8I) { const float s_ = rselB ? ib[1] : ib[0]; u32x2 w; w[0] = pk_i8x4(vb[0] * s_, vb[1] * s_, vb[2] * s_, vb[3] * s_); w[1] = pk_i8x4(vb[4] * s_, vb[5] * s_, vb[6] * s_, vb[7] * s_);
                    *gp((u32x2*)((unsigned char*)YN + (size_t)rowB * D + 768 + colB)) = w; }
                else { const float s_ = rselB ? rb[1] : rb[0]; u32x4 w; w[0] = cvt_pk_bf16(vb[0] * s_, vb[1] * s_); w[1] = cvt_pk_bf16(vb[2] * s_, vb[3] * s_); w[2] = cvt_pk_bf16(vb[4] * s_, vb[5] * s_); w[3] = cvt_pk_bf16(vb[6] * s_, vb[7] * s_);
                    *gp((u32x4*)(YN + (size_t)rowB * D + 768 + colB)) = w; } }
        }
    }
    SEAM(7);

    if (IN(8)) {
        MK_PTRS;
        {
        constexpr int EB = O8I ? 1 : 2;
        SchedStd S; S.o.init(M, D, G, bx); S.A = (const char*)YN; S.B = (const char*)Wout; S.a_tile = (size_t)256 * D * EB; S.b_tile = (size_t)256 * D * EB; S.b_batch = 0; S.ocol_mul = 256;
        EpiRes<C8, O8I> E{XB, SS2, 1.0f, X8, SY, SWO}; pg8::gemm_phase<EpiRes<C8, O8I>, SchedStd, true, O8I ? 2 : 0>(lds, D * EB / 2, D * EB / 2, D * EB / 128, S, E);
        }
        { SchedWK S{G, bx, (const char*)KVC, (const char*)Wcqs}; EpiStoreT<false, C8> E{WKT, D, nullptr, nullptr, false, C8 ? F8_WK : 1.0f}; pg8::gemm_phase<EpiStoreT<false, C8>, SchedWK, true>(lds, 2 * D, D, 4, S, E); }
        { SchedVW S{G, (bx + G / 2) % G, (const char*)KVC, (const char*)Wco}; EpiStoreT<false, C8> E{VWT, D, nullptr, nullptr, false, C8 ? F8_VW : 1.0f}; pg8::gemm_phase<EpiStoreT<false, C8>, SchedVW, true>(lds, D, 2 * D, 4, S, E); }
    }
    SEAM(8);

    if (IN(9)) {
        MK_PTRS;
        constexpr int EB = C8 ? 1 : 2;
        SchedStd S; S.o.init(M, D, G, bx); S.A = C8 ? (const char*)X8 : (const char*)XB; S.B = (const char*)WKT; S.a_tile = (size_t)256 * D * EB; S.b_tile = (size_t)256 * D * EB; S.b_batch = (size_t)D * D * EB; S.ocol_mul = 256;
        EpiSoftmaxT<C8> E{PB, SS2, C8 ? 1.0f / F8_WK : 1.0f}; pg8::gemm_phase<EpiSoftmaxT<C8>, SchedStd, true, C8 ? 1 : 0>(lds, D * EB / 2, D * EB / 2, D * EB / 128, S, E);
    }
    SEAM(9);

    if (IN(10)) {
        MK_PTRS;
        constexpr int EB = C8 ? 1 : 2;
        SchedStd S; S.o.init(M, D, G, bx); S.A = (const char*)PB; S.B = (const char*)VWT; S.a_tile = (size_t)256 * D * EB; S.b_tile = (size_t)256 * D * EB; S.b_batch = (size_t)D * D * EB; S.ocol_mul = 256;
        EpiRes<F8_2G> E{XB, SS3, C8 ? 1.0f / (F8_P * F8_VW) : 1.0f, X8}; pg8::gemm_phase<EpiRes<F8_2G>, SchedStd, true, C8 ? 1 : 0>(lds, D * EB / 2, D * EB / 2, D * EB / 128, S, E);
    }
    SEAM(10);

    if (IN(11)) {
        MK_PTRS;
        STAGGER();
        constexpr int EB = F8_2G ? 1 : 2;
        SchedStd S; S.o.init(M, 2 * DFF, G, bx); S.A = F8_2G ? (const char*)X8 : (const char*)XB; S.B = (const char*)Wgu2; S.a_tile = (size_t)256 * D * EB; S.b_tile = (size_t)256 * D * EB; S.b_batch = 0; S.ocol_mul = 128;
        EpiGU<F8_2G, F8_2D, false> E{HB, SS3, nullptr, nullptr, MK_N_LAUNCHES == 1 ? 0 : args.flags}; pg8::gemm_phase<EpiGU<F8_2G, F8_2D, false>, SchedStd, true, F8_2G ? 1 : 0>(lds, D * EB / 2, D * EB / 2, D * EB / 128, S, E);
    }
    SEAM(11);

    if (IN(12)) {
        MK_PTRS;
        constexpr int EB = F8_2D ? 1 : 2;
        SchedStd S; S.o.init(M, D, G, bx); S.A = (const char*)HB; S.B = (const char*)Wd2; S.a_tile = (size_t)256 * DFF * EB; S.b_tile = (size_t)256 * DFF * EB; S.b_batch = 0; S.ocol_mul = 256;
        EpiRes<false> E{XB, SS4, F8_2D ? 0.5f / (F8_H * F8_WD) : 0.5f, nullptr}; pg8::gemm_phase<EpiRes<false>, SchedStd, true, F8_2D>(lds, DFF * EB / 2, DFF * EB / 2, DFF * EB / 128, S, E);
    }
    SEAM(12);

    if (IN(13)) {
        MK_PTRS;
        const float* gf = args.in[19];
        for (int row0 = gw; row0 < M; row0 += 4 * NGW) {
            u32x2 w[4][4]; float rs[4]; const f32x4* gr = (const f32x4*)gf + lane;
#pragma unroll
            for (int r = 0; r < 4; ++r) { const int row = (row0 + r * NGW) < M ? (row0 + r * NGW) : row0; const u32x2* xr = (const u32x2*)(XB + (size_t)row * D) + lane;
#pragma unroll
                for (int j = 0; j < 4; ++j) w[r][j] = xr[64 * j];
                rs[r] = row_rstd(SS4, row); }
#pragma unroll
            for (int r = 0; r < 4; ++r) { const int row = row0 + r * NGW; if (row < M) { f32x4* orow = (f32x4*)(out + (size_t)row * D) + lane;
#pragma unroll
                for (int j = 0; j < 4; ++j) { f32x4 v; v[0] = __builtin_bit_cast(float, w[r][j][0] << 16); v[1] = __builtin_bit_cast(float, w[r][j][0] & 0xffff0000u); v[2] = __builtin_bit_cast(float, w[r][j][1] << 16); v[3] = __builtin_bit_cast(float, w[r][j][1] & 0xffff0000u);
                    __builtin_nontemporal_store(v * rs[r] * gr[64 * j], orow + 64 * j); } } }
        }
    }
#undef IN
#undef SEAM
}
}


#if MK_DEBUG
namespace dbg {
__global__ void __launch_bounds__(256) cmp_f32(const float* a, const float* r, size_t n, float* acc) {
    float num = 0.f, den = 0.f;
    for (size_t i = (size_t)blockIdx.x * 256 + threadIdx.x; i < n; i += (size_t)gridDim.x * 256) { const float d = a[i] - r[i]; num += d * d; den += r[i] * r[i]; }
    for (int o = 32; o > 0; o >>= 1) { num += __shfl_xor(num, o); den += __shfl_xor(den, o); }
    if ((threadIdx.x & 63) == 0) { atomicAdd(acc, num); atomicAdd(acc + 1, den); }
}
__global__ void __launch_bounds__(256) cmp_bf16(const unsigned short* a, int lda, const float* colscale, const float* r, int ldr, int rows, int cols, float* acc) {
    float num = 0.f, den = 0.f; const size_t n = (size_t)rows * cols;
    for (size_t i = (size_t)blockIdx.x * 256 + threadIdx.x; i < n; i += (size_t)gridDim.x * 256) { const size_t row = i / cols; const int c = (int)(i % cols);
        const float av = __builtin_bit_cast(float, (unsigned)a[row * lda + c] << 16) * (colscale ? colscale[c] : 1.0f); const float rv = r[row * ldr + c]; const float d = av - rv; num += d * d; den += rv * rv; }
    for (int o = 32; o > 0; o >>= 1) { num += __shfl_xor(num, o); den += __shfl_xor(den, o); }
    if ((threadIdx.x & 63) == 0) { atomicAdd(acc, num); atomicAdd(acc + 1, den); }
}
__global__ void __launch_bounds__(256) cmp_p(const unsigned short* a, const float* r, float* acc) {
    float num = 0.f, den = 0.f; const size_t n = (size_t)4096 * 1024;
    for (size_t i = (size_t)blockIdx.x * 256 + threadIdx.x; i < n; i += (size_t)gridDim.x * 256) { const size_t row = i / 1024; const int c = (int)(i % 1024);
        const float av = __builtin_bit_cast(float, (unsigned)a[i] << 16); const float rv = r[(size_t)(c >> 8) * 4096 * 256 + row * 256 + (c & 255)]; const float d = av - rv; num += d * d; den += rv * rv; }
    for (int o = 32; o > 0; o >>= 1) { num += __shfl_xor(num, o); den += __shfl_xor(den, o); }
    if ((threadIdx.x & 63) == 0) { atomicAdd(acc, num); atomicAdd(acc + 1, den); }
}
__global__ void build_scales(float* qkvs, float* gcat, const float* goa, const float* gob) {
    const int i = blockIdx.x * 256 + threadIdx.x;
    if (i < 3072) qkvs[i] = ((i < 768) || (i >= 2304 && i < 2560)) ? 8.0f : 1.0f;
    if (i < 1024) gcat[i] = i < 768 ? goa[i] : gob[i - 768];
}
constexpr int NST = 8;
__global__ void __launch_bounds__(256) finalize(float* out, size_t n, const float* acc, int report) {
    const float tol[NST] = {0.03f, 0.03f, 1e9f  , 0.08f, 0.03f, 0.05f, 0.03f, 0.03f};
    float E = 0.f;
    if (report > 0) { const float e = sqrtf(acc[2 * (report - 1)] / acc[2 * (report - 1) + 1]); E = (e == e) ? fminf(e, 3.0f) : 3.0f; }
    else { for (int k = NST - 1; k >= 0; --k) { const float e = sqrtf(acc[2 * k] / acc[2 * k + 1]); if (!(e <= tol[k])) E = 0.1f * (k + 1); } }
    for (size_t i = (size_t)blockIdx.x * 256 + threadIdx.x; i < n; i += (size_t)gridDim.x * 256) out[i] *= (1.0f + E);
}
}
#endif

static void mk_launch(const mk::Args& a0, int lo, int hi, int grid, hipStream_t st) {
    mk::Args a = a0; a.ph_lo = lo; a.ph_hi = hi;
    hipLaunchKernelGGL(mk::mk_fwd, dim3(grid), dim3(mk::NWAVES * 64), mk::LDS_BYTES, st, a);
    const hipError_t le = hipPeekAtLastError();
    if (le != hipSuccess) fprintf(stderr, "kernel_launch: launch of phases [%d,%d) failed: %s\n", lo, hi, hipGetErrorName(le));
}

extern "C" void kernel_launch(void* const* d_in, const int* in_sizes, int n_in, void* d_out, int out_size, void* d_ws, size_t ws_size, hipStream_t stream) {
    static int grid = 0;
    if (grid == 0) {
        if (n_in != 20 || out_size != 8 * 4096 * 1024) { fprintf(stderr, "kernel_launch: unexpected shapes (n_in %d out %d)\n", n_in, out_size); grid = -1; return; }
        int dev = 0, cus = 0, per_cu = 0;
        if (hipGetDevice(&dev) != hipSuccess || hipDeviceGetAttribute(&cus, hipDeviceAttributeMultiprocessorCount, dev) != hipSuccess) { grid = -1; return; }
        if (hipFuncSetAttribute((const void*)mk::mk_fwd, hipFuncAttributeMaxDynamicSharedMemorySize, mk::LDS_BYTES) != hipSuccess) { fprintf(stderr, "kernel_launch: hipFuncSetAttribute failed\n"); grid = -1; return; }
        if (hipOccupancyMaxActiveBlocksPerMultiprocessor(&per_cu, (const void*)mk::mk_fwd, mk::NWAVES * 64, mk::LDS_BYTES) != hipSuccess || per_cu < 1) fprintf(stderr, "kernel_launch: occupancy query reports %d workgroups per CU\n", per_cu);
        (void)hipGetLastError();
        grid = cus;
    }
    if (grid < 0) return;
    unsigned char* ws = (unsigned char*)d_ws;
#if MK_DEBUG
    const size_t ref_off = (mk::WS_END + 4095) / 4096 * 4096;
    size_t off = ref_off + (size_t)290 * 1024 * 1024;
    auto take = [&](size_t bytes) { unsigned char* p = ws + off; off += (bytes + 255) / 256 * 256; return p; };
    float* sx1 = (float*)take((size_t)4096 * 1024 * 4); float* sx2 = (float*)take((size_t)4096 * 1024 * 4); float* sx3 = (float*)take((size_t)4096 * 1024 * 4);
    float* mkout = (float*)take((size_t)4096 * 1024 * 4); float* qkvs = (float*)take(3072 * 4); float* gcat = (float*)take(1024 * 4); float* acc = (float*)take(256);
    if (off > ws_size) { fprintf(stderr, "kernel_launch: debug build needs %zu bytes of workspace, got %zu\n", off, ws_size); return; }
    ref::Snap snap{sx1, sx2, sx3};
    ref::forward(d_in, (float*)d_out, ws + ref_off, stream, &snap);
    (void)hipMemsetAsync(ws + mk::WS_CTL, 0, mk::CTL_BYTES, stream);
    (void)hipMemsetAsync(acc, 0, 256, stream);
    dbg::build_scales<<<12, 256, 0, stream>>>(qkvs, gcat, (const float*)d_in[8], (const float*)d_in[9]);
    mk::Args a{};
    for (int i = 0; i < 20; ++i) a.in[i] = (const float*)d_in[i];
    a.in[0] = (const float*)d_in[0] + (size_t)7 * 4096 * 1024; a.in[1] = (const float*)d_in[1] + (size_t)7 * 256 * 1024;
    a.out = mkout; a.ws = ws;
    const ref::Bufs& rb = ref::g_bufs;
    for (int ph = 0; ph < mk::NPH; ++ph) {
        mk_launch(a, ph, ph + 1, grid, stream);
        if (ph == 6) dbg::cmp_bf16<<<512, 256, 0, stream>>>((const unsigned short*)(ws + mk::WS_KVC), 2048, nullptr, rb.kvc, 2048, 256, 2048, acc + 0);
        if (ph == 2) dbg::cmp_bf16<<<512, 256, 0, stream>>>((const unsigned short*)(ws + mk::WS_XB), 1024, nullptr, sx1, 1024, 4096, 1024, acc + 2);
        if (ph == 4) dbg::cmp_bf16<<<512, 256, 0, stream>>>((const unsigned short*)(ws + mk::WS_R1), 3072, qkvs, rb.proj, 3072, 4096, 3072, acc + 4);
        if (ph == 7) dbg::cmp_bf16<<<512, 256, 0, stream>>>((const unsigned short*)(ws + mk::WS_R1), 1024, gcat, rb.yn, 1024, 4096, 1024, acc + 6);
        if (ph == 8) dbg::cmp_bf16<<<512, 256, 0, stream>>>((const unsigned short*)(ws + mk::WS_XB), 1024, nullptr, sx2, 1024, 4096, 1024, acc + 8);
        if (ph == 9) dbg::cmp_p<<<512, 256, 0, stream>>>((const unsigned short*)(ws + mk::WS_R1), rb.sc, acc + 10);
        if (ph == 10) dbg::cmp_bf16<<<512, 256, 0, stream>>>((const unsigned short*)(ws + mk::WS_XB), 1024, nullptr, sx3, 1024, 4096, 1024, acc + 12);
        if (ph == 13) dbg::cmp_f32<<<512, 256, 0, stream>>>(mkout, (const float*)d_out + (size_t)7 * 4096 * 1024, (size_t)4096 * 1024, acc + 14);
    }
    dbg::finalize<<<1024, 256, 0, stream>>>((float*)d_out, (size_t)8 * 4096 * 1024, acc, MK_REPORT);
#else
    if (ws_size < mk::WS_END) { fprintf(stderr, "kernel_launch: needs %zu bytes of workspace, got %zu\n", (size_t)mk::WS_END, ws_size); return; }
    if (hipMemsetAsync(ws + mk::WS_CTL, 0, mk::CTL_BYTES, stream) != hipSuccess) return;
    mk::Args a{};
    for (int i = 0; i < 20; ++i) a.in[i] = (const float*)d_in[i];
    a.out = (float*)d_out; a.ws = ws;
#if MK_N_LAUNCHES == 1
    mk_launch(a, 0, mk::NPH, grid, stream);
#else
    for (int ph = 0; ph < mk::NPH; ++ph) {
        for (int r = 0; r < MK_REPEAT_N; ++r) if (ph == MK_REPEAT) { mk::Args a2 = a; a2.flags = MK_REPEAT_FLAGS; mk_launch(a2, ph, ph + 1, grid, stream); }
        mk_launch(a, ph, ph + 1, grid, stream); }
#endif
#endif
}
```
